# Optimizing an MI355X kernel written in HIP

```python
import jax, jax.numpy as jnp
from jax import lax
import numpy as np

D_MODEL = 1024
BATCH = 8
SEQ = 4096
DEPTH = 1
DEC_BATCH = 8
DEC_SEQ = 8192
PAST_LEN = 128

D_POOL = D_MODEL // 2
D_RWKV = D_MODEL - D_POOL
POOL_WINDOWS = (2, 4, 8, 16)
N_POOL_GROUPS = len(POOL_WINDOWS)
POOL_GROUP = D_POOL // N_POOL_GROUPS
HEAD_DIM = 64
N_HEADS = D_RWKV // HEAD_DIM
R_DECAY = 64
R_AAA = 64
R_GATE = 160
N_DIR = 2
D_FF = 2816
P_RWKV = 3 * D_RWKV + N_DIR * R_DECAY + N_DIR * R_AAA + R_GATE
P_IN = D_POOL + P_RWKV
N_MOD = 9
RMS_EPS = 1e-6
GN_EPS = 64e-5
L2_EPS = 1e-12

kernel_name = "hybrid_pool_rwkv7_macaron_encoder"


def rmsnorm(x, g):
    x32 = x.astype(jnp.float32)
    y = x32 * lax.rsqrt(jnp.mean(x32 * x32, axis=-1, keepdims=True) + RMS_EPS) * g.astype(jnp.float32)
    return y.astype(x.dtype)


def modulate(h, shift, scale):
    return h * (1 + scale) + shift


def swiglu(h, w1, w3, w2):
    return (jax.nn.silu(h @ w1) * (h @ w3)) @ w2


def token_shift(z, mu):
    prev = jnp.pad(z[:, :-1], ((0, 0), (1, 0), (0, 0)))
    nxt = jnp.pad(z[:, 1:], ((0, 0), (0, 1), (0, 0)))
    return z + (0.5 * (prev + nxt) - z) * mu


def pool_mixer(z, pool_w, pool_scale):
    B, T, _ = z.shape
    z = z.astype(jnp.float32)
    cs = jnp.concatenate([jnp.zeros((B, 1, D_POOL), jnp.float32), jnp.cumsum(z, axis=1)], axis=1)
    t = jnp.arange(T)
    outs = []
    for gi, win in enumerate(POOL_WINDOWS):
        sl = slice(gi * POOL_GROUP, (gi + 1) * POOL_GROUP)
        lo = jnp.clip(t - win // 2, 0, T)
        hi = jnp.clip(t + win // 2, 0, T)
        csg = cs[..., sl]
        wsum = jnp.take(csg, hi, axis=1) - jnp.take(csg, lo, axis=1)
        count = (hi - lo).astype(jnp.float32)[None, :, None]
        outs.append(wsum / count - z[..., sl])
    p = jnp.stack(outs, axis=2)
    p = jnp.einsum('btgc,gcd->btgd', p, pool_w.astype(jnp.float32))
    return p.reshape(B, T, D_POOL) * pool_scale.astype(jnp.float32)


def wkv_scan(r, decay, k, v, kk, a, reverse):
    B, T, H, N = r.shape
    xs = tuple(jnp.moveaxis(t_, 1, 0) for t_ in (r, decay, k, v, -kk, kk * a))

    def step(S, inp):
        r_t, w_t, k_t, v_t, na_t, b_t = inp
        sa = jnp.einsum('bhvk,bhk->bhv', S, na_t)
        S = S * w_t[:, :, None, :] + sa[..., None] * b_t[:, :, None, :] + v_t[..., None] * k_t[:, :, None, :]
        y = jnp.einsum('bhvk,bhk->bhv', S, r_t)
        return S, y

    S0 = jnp.zeros((B, H, N, N), jnp.float32)
    _, y = lax.scan(step, S0, xs, reverse=reverse)
    return jnp.moveaxis(y, 0, 1)


def rwkv7_mixer(z, w0, w2, a0, a2, g2, k_k, k_a, r_k, lnx_g, lnx_b):
    B, T, _ = z.shape
    f32 = jnp.float32
    z = z.astype(f32)
    hd = lambda t_: t_.reshape(t_.shape[:-1] + (N_HEADS, HEAD_DIM))
    r = hd(z[..., 0:D_RWKV])
    k = hd(z[..., D_RWKV:2 * D_RWKV])
    v = hd(z[..., 2 * D_RWKV:3 * D_RWKV])
    o = 3 * D_RWKV
    zw = (z[..., o:o + R_DECAY], z[..., o + R_DECAY:o + 2 * R_DECAY])
    o += 2 * R_DECAY
    za = (z[..., o:o + R_AAA], z[..., o + R_AAA:o + 2 * R_AAA])
    o += 2 * R_AAA
    zg = z[..., o:o + R_GATE]
    kkh = hd(k_k.astype(f32))
    kah = hd(k_a.astype(f32))
    rkh = hd(r_k.astype(f32))
    kk = k * kkh
    kk = kk / jnp.maximum(jnp.sqrt(jnp.sum(kk * kk, axis=-1, keepdims=True)), L2_EPS)
    ys = []
    bonus = []
    for d in range(N_DIR):
        w_log = -jax.nn.softplus(-(w0[d].astype(f32) + jnp.tanh(zw[d]) @ w2[d].astype(f32))) - 0.5
        decay = hd(jnp.exp(-jnp.exp(w_log)))
        a = hd(jax.nn.sigmoid(a0[d].astype(f32) + za[d] @ a2[d].astype(f32)))
        k_d = k * (1 + (a - 1) * kah)
        ys.append(wkv_scan(r, decay, k_d, v, kk, a, reverse=(d == 1)))
        bonus.append(jnp.sum(r * k_d * rkh, axis=-1, keepdims=True) * v)
    y = ys[0] + ys[1]
    mean = jnp.mean(y, axis=-1, keepdims=True)
    var = jnp.mean(jnp.square(y - mean), axis=-1, keepdims=True)
    y = (y - mean) * lax.rsqrt(var + GN_EPS) * hd(lnx_g.astype(f32)) + hd(lnx_b.astype(f32))
    g = jax.nn.sigmoid(zg) @ g2.astype(f32)
    return (y + bonus[0] + bonus[1]).reshape(B, T, D_RWKV) * g


def encoder_layer(x, c, ada_w, ada_b, n1_pre, n1_post, f1_w1, f1_w3, f1_w2,
                  nm_pre, nm_post, w_in, shift_mu, pool_w, pool_scale,
                  w0, w2, a0, a2, g2, k_k, k_a, r_k, lnx_g, lnx_b, w_out,
                  n2_pre, n2_post, f2_w1, f2_w3, f2_w2):
    B = x.shape[0]
    mod = (jax.nn.silu(c) @ ada_w + ada_b).reshape(B, N_MOD, D_MODEL)[:, :, None, :]
    h = modulate(rmsnorm(x, n1_pre), mod[:, 0], mod[:, 1])
    x = x + 0.5 * mod[:, 2] * rmsnorm(swiglu(h, f1_w1, f1_w3, f1_w2), n1_post)
    h = modulate(rmsnorm(x, nm_pre), mod[:, 3], mod[:, 4])
    z = h @ w_in
    zp = z[..., :D_POOL]
    zr = token_shift(z[..., D_POOL:], shift_mu)
    m = jnp.concatenate([pool_mixer(zp, pool_w, pool_scale),
                         rwkv7_mixer(zr, w0, w2, a0, a2, g2, k_k, k_a, r_k, lnx_g, lnx_b)], axis=-1)
    m = m.astype(x.dtype) @ w_out
    x = x + mod[:, 5] * rmsnorm(m, nm_post)
    h = modulate(rmsnorm(x, n2_pre), mod[:, 6], mod[:, 7])
    x = x + 0.5 * mod[:, 8] * rmsnorm(swiglu(h, f2_w1, f2_w3, f2_w2), n2_post)
    return x


def encoder_trunk(x, c, params):
    for i in range(DEPTH):
        x = encoder_layer(x, c, *[p[i] for p in params])
    return x


def setup_inputs(seed: int = 0) -> dict:
    key = jax.random.key(seed)
    ks = iter(jax.random.split(key, 48))
    f32 = jnp.float32
    nrm = lambda shape, scale: scale * jax.random.normal(next(ks), shape, f32)
    L, D, F = DEPTH, D_MODEL, D_FF
    return {
        "x_prompt": nrm((BATCH, SEQ, D), 1.0),
        "x_sample": nrm((DEC_BATCH, DEC_SEQ, D), 1.0),
        "c_prompt": nrm((BATCH, D), 1.0),
        "c_sample": nrm((DEC_BATCH, D), 1.0),
        "ada_w": nrm((L, D, N_MOD * D), 0.5 * D ** -0.5),
        "ada_b": nrm((L, N_MOD * D), 0.01),
        "n1_pre": 1.0 + nrm((L, D), 0.05),
        "n1_post": 1.0 + nrm((L, D), 0.05),
        "f1_w1": nrm((L, D, F), D ** -0.5),
        "f1_w3": nrm((L, D, F), D ** -0.5),
        "f1_w2": nrm((L, F, D), F ** -0.5),
        "nm_pre": 1.0 + nrm((L, D), 0.05),
        "nm_post": 1.0 + nrm((L, D), 0.05),
        "w_in": nrm((L, D, P_IN), D ** -0.5),
        "shift_mu": jax.random.uniform(next(ks), (L, P_RWKV), f32),
        "pool_w": nrm((L, N_POOL_GROUPS, POOL_GROUP, POOL_GROUP), POOL_GROUP ** -0.5),
        "pool_scale": 1.0 + nrm((L, D_POOL), 0.1),
        "w0": -1.0 + nrm((L, N_DIR, D_RWKV), 0.5),
        "w2": nrm((L, N_DIR, R_DECAY, D_RWKV), R_DECAY ** -0.5),
        "a0": nrm((L, N_DIR, D_RWKV), 0.5),
        "a2": nrm((L, N_DIR, R_AAA, D_RWKV), 0.5 * R_AAA ** -0.5),
        "g2": nrm((L, R_GATE, D_RWKV), R_GATE ** -0.5),
        "k_k": 0.85 + nrm((L, D_RWKV), 0.05),
        "k_a": 1.0 + nrm((L, D_RWKV), 0.05),
        "r_k": nrm((L, D_RWKV), 0.5),
        "lnx_g": 1.0 + nrm((L, D_RWKV), 0.05),
        "lnx_b": nrm((L, D_RWKV), 0.01),
        "w_out": nrm((L, D, D), D ** -0.5),
        "n2_pre": 1.0 + nrm((L, D), 0.05),
        "n2_post": 1.0 + nrm((L, D), 0.05),
        "f2_w1": nrm((L, D, F), D ** -0.5),
        "f2_w3": nrm((L, D, F), D ** -0.5),
        "f2_w2": nrm((L, F, D), F ** -0.5),
    }


def reference(x_prompt, x_sample, c_prompt, c_sample, ada_w, ada_b, n1_pre, n1_post, f1_w1, f1_w3, f1_w2,
              nm_pre, nm_post, w_in, shift_mu, pool_w, pool_scale,
              w0, w2, a0, a2, g2, k_k, k_a, r_k, lnx_g, lnx_b, w_out,
              n2_pre, n2_post, f2_w1, f2_w3, f2_w2):
    params = (ada_w, ada_b, n1_pre, n1_post, f1_w1, f1_w3, f1_w2,
              nm_pre, nm_post, w_in, shift_mu, pool_w, pool_scale,
              w0, w2, a0, a2, g2, k_k, k_a, r_k, lnx_g, lnx_b, w_out,
              n2_pre, n2_post, f2_w1, f2_w3, f2_w2)
    y_prompt = encoder_trunk(x_prompt, c_prompt, params)
    y_sample = encoder_trunk(x_sample, c_sample, params)
    return (y_prompt, y_sample)
```

```cpp
#include <hip/hip_runtime.h>
#include <hip/hip_cooperative_groups.h>
#include <cstdio>
namespace cg = cooperative_groups;

#ifndef ONE_LAUNCH
#define ONE_LAUNCH 0
#endif

typedef unsigned short bf16_t;
typedef short bf16x8 __attribute__((ext_vector_type(8)));
typedef float f32x4 __attribute__((ext_vector_type(4)));
typedef float f32x2 __attribute__((ext_vector_type(2)));
#define LAS __attribute__((address_space(3)))

constexpr int D = 1024, FF = 2816, NTOK = 98304, NPROMPT = 32768, ZLD = 2560, PINW = 2464;
constexpr int NTHR = 512;
constexpr int SMEM_BYTES = 147456;

struct Params {
  const float *x_prompt, *x_sample, *c_prompt, *c_sample, *ada_w, *ada_b, *n1_pre, *n1_post, *f1_w1, *f1_w3, *f1_w2,
      *nm_pre, *nm_post, *w_in, *shift_mu, *pool_w, *pool_scale, *w0, *w2, *a0, *a2, *g2, *k_k, *k_a, *r_k, *lnx_g, *lnx_b,
      *w_out, *n2_pre, *n2_post, *f2_w1, *f2_w3, *f2_w2;
  float* out;
  char* ws;
};
constexpr size_t al256(size_t b) { return (b + 255) & ~(size_t)255; }
constexpr size_t OFF_W13A = 0;
constexpr size_t OFF_W13B = OFF_W13A + al256((size_t)2 * FF * D * 2);
constexpr size_t OFF_W2A = OFF_W13B + al256((size_t)2 * FF * D * 2);
constexpr size_t OFF_W2B = OFF_W2A + al256((size_t)D * FF * 2);
constexpr size_t OFF_WINT = OFF_W2B + al256((size_t)D * FF * 2);
constexpr size_t OFF_WOUTT = OFF_WINT + al256((size_t)ZLD * D * 2);
constexpr size_t OFF_MOD = OFF_WOUTT + al256((size_t)D * D * 2);
constexpr size_t OFF_SBON = OFF_MOD + al256((size_t)16 * 9216 * 4);
constexpr size_t OFF_RH = OFF_SBON + al256((size_t)NTOK * 16 * 4);
constexpr size_t OFF_RY = OFF_RH + al256((size_t)NTOK * D * 2);
constexpr size_t OFF_RU = OFF_RY + al256((size_t)NTOK * D * 2);
constexpr size_t WS_NEED = OFF_RU + al256((size_t)NTOK * FF * 2);
#define P_W13A ((bf16_t*)(p.ws + OFF_W13A))
#define P_W13B ((bf16_t*)(p.ws + OFF_W13B))
#define P_W2A ((bf16_t*)(p.ws + OFF_W2A))
#define P_W2B ((bf16_t*)(p.ws + OFF_W2B))
#define P_WINT ((bf16_t*)(p.ws + OFF_WINT))
#define P_WOUTT ((bf16_t*)(p.ws + OFF_WOUTT))
#define P_MOD ((float*)(p.ws + OFF_MOD))
#define P_SBON ((float*)(p.ws + OFF_SBON))
#define P_RH ((bf16_t*)(p.ws + OFF_RH))
#define P_RY ((bf16_t*)(p.ws + OFF_RY))
#define P_RU ((bf16_t*)(p.ws + OFF_RU))

__device__ __forceinline__ unsigned cvt_pk_bf16(float lo, float hi) {
  unsigned r;
  asm volatile("v_cvt_pk_bf16_f32 %0, %1, %2" : "=v"(r) : "v"(lo), "v"(hi));
  return r;
}
__device__ __forceinline__ float bf_lo(unsigned u) { return __uint_as_float(u << 16); }
__device__ __forceinline__ float bf_hi(unsigned u) { return __uint_as_float(u & 0xffff0000u); }
__device__ __forceinline__ float bf2f(bf16_t b) { return __uint_as_float(((unsigned)b) << 16); }
__device__ __forceinline__ void unpack8(uint4 v, float* o) {
  o[0] = bf_lo(v.x); o[1] = bf_hi(v.x); o[2] = bf_lo(v.y); o[3] = bf_hi(v.y);
  o[4] = bf_lo(v.z); o[5] = bf_hi(v.z); o[6] = bf_lo(v.w); o[7] = bf_hi(v.w);
}
__device__ __forceinline__ uint4 pack8(const float* o) {
  uint4 v; v.x = cvt_pk_bf16(o[0], o[1]); v.y = cvt_pk_bf16(o[2], o[3]); v.z = cvt_pk_bf16(o[4], o[5]); v.w = cvt_pk_bf16(o[6], o[7]);
  return v;
}
__device__ __forceinline__ float sigmoidf_(float x) { return __builtin_amdgcn_rcpf(1.f + __expf(-x)); }
__device__ __forceinline__ float wave_sum(float v) {
#pragma unroll
  for (int o = 32; o > 0; o >>= 1) v += __shfl_xor(v, o);
  return v;
}
template <int CTRL> __device__ __forceinline__ float dpp_f(float x) {
  return __int_as_float(__builtin_amdgcn_update_dpp(0, __float_as_int(x), CTRL, 0xf, 0xf, false));
}
__device__ __forceinline__ float row16_sum(float x) {
  x += dpp_f<0x128>(x); x += dpp_f<0x124>(x); x += dpp_f<0x122>(x); x += dpp_f<0x121>(x);
  return x;
}
template <class T> __device__ __forceinline__ T sel(bool c, T a, T b) { return c ? a : b; }
__device__ __forceinline__ int opaque_tid() { int t = threadIdx.x; asm volatile("" : "+v"(t)); return t; }
__device__ __forceinline__ int seq_start(int s) { return s < 8 ? s * 4096 : NPROMPT + (s - 8) * 8192; }
__device__ __forceinline__ void row_seq(int row, int& s, int& t, int& T) {
  if (row < NPROMPT) { s = row >> 12; t = row & 4095; T = 4096; }
  else { int r = row - NPROMPT; s = 8 + (r >> 13); t = r & 8191; T = 8192; }
}

__device__ __forceinline__ void tr_tile(const float* __restrict__ src, int ldsrc, int k0, int n0, int nvalid, bf16_t* __restrict__ dst, int ldd,
                        int kdst0, int mode, float* sm, const int tid) {
#pragma unroll
  for (int i = 0; i < 2; ++i) {
    const int r = (tid >> 4) + 32 * i, c = (tid & 15) * 4;
    float4 v = make_float4(0.f, 0.f, 0.f, 0.f);
    if (n0 + c < nvalid) v = *(const float4*)(src + (size_t)(k0 + r) * ldsrc + n0 + c);
    float* d = sm + r * 65 + c;
    d[0] = v.x; d[1] = v.y; d[2] = v.z; d[3] = v.w;
  }
  __syncthreads();
  {
    const int n = tid >> 3, kc = (tid & 7) * 8;
    float o[8];
#pragma unroll
    for (int j = 0; j < 8; ++j) o[j] = sm[(kc + j) * 65 + n];
    int nn = n0 + n, drow;
    if (mode == 0) drow = nn;
    else drow = 32 * (nn >> 4) + (nn & 15) + (mode == 2 ? 16 : 0);
    *(uint4*)(dst + (size_t)drow * ldd + kdst0 + k0 + kc) = pack8(o);
  }
  __syncthreads();
}

__device__ __forceinline__ void prep_phase(const Params& p, char* smem) {
  float* sm = (float*)smem;
  const int tid = opaque_tid();
  constexpr int N_MOD = 144, N_EFF = 128, N_W13 = 4 * 704, N_W2 = 2 * 704, N_WIN = 640, N_WOUT = 128;
  constexpr int TOTAL = N_MOD + N_EFF + N_W13 + N_W2 + N_WIN + N_WOUT;
  for (int item = blockIdx.x; item < TOTAL; item += gridDim.x) {
    int it = item;
    if (it < N_MOD) {
      const int j0 = it * 64;
      float* sc = sm;
      float* red = sm + 16384;
      for (int idx = tid; idx < 16384; idx += NTHR) {
        const int s = idx >> 10, k = idx & 1023;
        const float* cp_ = p.c_prompt; const float* cs_ = p.c_sample;
        const float c = s < 8 ? cp_[s * 1024 + k] : cs_[(s - 8) * 1024 + k];
        sc[idx] = c / (1.f + __expf(-c));
      }
      __syncthreads();
      const int col = tid & 63, kg = tid >> 6;
      float acc[16];
#pragma unroll
      for (int s = 0; s < 16; ++s) acc[s] = 0.f;
      for (int k = kg * 128; k < kg * 128 + 128; ++k) {
        const float w = p.ada_w[(size_t)k * 9216 + j0 + col];
#pragma unroll
        for (int s = 0; s < 16; ++s) acc[s] += sc[s * 1024 + k] * w;
      }
#pragma unroll
      for (int s = 0; s < 16; ++s) red[(kg * 16 + s) * 64 + col] = acc[s];
      __syncthreads();
      for (int o = tid; o < 1024; o += NTHR) {
        const int s = o >> 6, c2 = o & 63;
        float v = p.ada_b[j0 + c2];
#pragma unroll
        for (int g = 0; g < 8; ++g) v += red[(g * 16 + s) * 64 + c2];
        P_MOD[s * 9216 + j0 + c2] = v;
      }
      __syncthreads();
      continue;
    }
    it -= N_MOD;
    if (it < N_EFF) {
      const int g = it >> 5, itile = (it >> 4) & 1, ntile = it & 15;
      float* As = sm;
      float* Bs = sm + 64 * 129;
      for (int idx = tid; idx < 64 * 128; idx += NTHR) {
        const int i = idx >> 7, j = idx & 127;
        As[i * 129 + j] = p.pool_w[((size_t)g * 128 + itile * 64 + i) * 128 + j] * p.pool_scale[g * 128 + j];
      }
      for (int idx = tid; idx < 128 * 64; idx += NTHR) {
        const int j = idx >> 6, nn = idx & 63;
        Bs[j * 65 + nn] = p.w_out[(size_t)(g * 128 + j) * 1024 + ntile * 64 + nn];
      }
      __syncthreads();
      const int i = tid >> 3, nn0 = (tid & 7) * 8;
      float acc[8];
#pragma unroll
      for (int q = 0; q < 8; ++q) acc[q] = 0.f;
      for (int j = 0; j < 128; ++j) {
        const float a = As[i * 129 + j];
#pragma unroll
        for (int q = 0; q < 8; ++q) acc[q] += a * Bs[j * 65 + nn0 + q];
      }
#pragma unroll
      for (int q = 0; q < 8; ++q)
        P_WOUTT[(size_t)(ntile * 64 + nn0 + q) * 1024 + g * 128 + itile * 64 + i] = (bf16_t)(cvt_pk_bf16(acc[q], 0.f) & 0xffff);
      __syncthreads();
      continue;
    }
    it -= N_EFF;
    if (it < N_W13) {
      const int which = it / 704, r = it % 704;
      const int kt = r / 44, ntl = r % 44;
      const float* src = sel(which < 2, sel(which == 0, p.f1_w1, p.f1_w3), sel(which == 2, p.f2_w1, p.f2_w3));
      bf16_t* dst = sel(which < 2, P_W13A, P_W13B);
      tr_tile(src, FF, kt * 64, ntl * 64, FF, dst, D, 0, (which & 1) ? 2 : 1, sm, tid);
      continue;
    }
    it -= N_W13;
    if (it < N_W2) {
      const int which = it / 704, r = it % 704;
      const int kt = r / 16, ntl = r % 16;
      tr_tile(sel(which != 0, p.f2_w2, p.f1_w2), D, kt * 64, ntl * 64, D, sel(which != 0, P_W2B, P_W2A), FF, 0, 0, sm, tid);
      continue;
    }
    it -= N_W2;
    if (it < N_WIN) {
      const int kt = it / 40, ntl = it % 40;
      tr_tile(p.w_in, PINW, kt * 64, ntl * 64, PINW, P_WINT, D, 0, 0, sm, tid);
      continue;
    }
    it -= N_WIN;
    {
      const int kt = it / 16, ntl = it % 16;
      tr_tile(p.w_out + (size_t)512 * 1024, D, kt * 64, ntl * 64, D, P_WOUTT, D, 512, 0, sm, tid);
    }
  }
}

template <int MODE>
__device__ __forceinline__ void row_phase(const float* __restrict__ xp, const float* __restrict__ xs, float* __restrict__ xout,
                          const bf16_t* __restrict__ y, bf16_t* __restrict__ h, const float* __restrict__ mod,
                          const float* __restrict__ npost, const float* __restrict__ npre, int gate_idx, float cgate, int shift_idx) {
  const int tid_ = opaque_tid();
  const int lane = tid_ & 63;
  const int gw = blockIdx.x * 8 + (tid_ >> 6), GW = gridDim.x * 8;
  for (int chunk = gw; chunk < NTOK / 16; chunk += GW) {
    const int row0 = chunk * 16;
    int s, t, T;
    row_seq(row0, s, t, T);
    const float* md = mod + s * 9216;
    f32x4 Am[4], Bm[4], Gm[4];
#pragma unroll
    for (int i = 0; i < 4; ++i) {
      const int c = i * 256 + lane * 4;
      if (MODE != 2) {
        f32x4 np = *(const f32x4*)(npre + c), sc = *(const f32x4*)(md + (shift_idx + 1) * 1024 + c);
        Am[i] = np * (sc + 1.f);
        Bm[i] = *(const f32x4*)(md + shift_idx * 1024 + c);
      }
      if (MODE != 0) {
        f32x4 g = *(const f32x4*)(md + gate_idx * 1024 + c), po = *(const f32x4*)(npost + c);
        Gm[i] = g * po * cgate;
      }
    }
    for (int r = 0; r < 16; ++r) {
      const int row = row0 + r;
      const float* xr = (row < NPROMPT) ? xp + (size_t)row * D : xs + (size_t)(row - NPROMPT) * D;
      f32x4 xv[4];
#pragma unroll
      for (int i = 0; i < 4; ++i) xv[i] = *(const f32x4*)(xr + i * 256 + lane * 4);
      if (MODE != 0) {
        f32x4 yv[4];
        float ss = 0.f;
#pragma unroll
        for (int i = 0; i < 4; ++i) {
          uint2 u = *(const uint2*)(y + (size_t)row * D + i * 256 + lane * 4);
          yv[i] = (f32x4){bf_lo(u.x), bf_hi(u.x), bf_lo(u.y), bf_hi(u.y)};
          ss += yv[i][0] * yv[i][0] + yv[i][1] * yv[i][1] + yv[i][2] * yv[i][2] + yv[i][3] * yv[i][3];
        }
        ss = wave_sum(ss);
        const float rs = rsqrtf(ss * (1.f / 1024.f) + 1e-6f);
#pragma unroll
        for (int i = 0; i < 4; ++i) {
          xv[i] = xv[i] + Gm[i] * yv[i] * rs;
          *(f32x4*)(xout + (size_t)row * D + i * 256 + lane * 4) = xv[i];
        }
      }
      if (MODE != 2) {
        float ss = 0.f;
#pragma unroll
        for (int i = 0; i < 4; ++i) ss += xv[i][0] * xv[i][0] + xv[i][1] * xv[i][1] + xv[i][2] * xv[i][2] + xv[i][3] * xv[i][3];
        ss = wave_sum(ss);
        const float rs = rsqrtf(ss * (1.f / 1024.f) + 1e-6f);
#pragma unroll
        for (int i = 0; i < 4; ++i) {
          f32x4 hv = xv[i] * rs * Am[i] + Bm[i];
          uint2 u; u.x = cvt_pk_bf16(hv[0], hv[1]); u.y = cvt_pk_bf16(hv[2], hv[3]);
          *(uint2*)(h + (size_t)row * D + i * 256 + lane * 4) = u;
        }
      }
    }
  }
}

constexpr int BM = 256, BK = 64, HALF = 128, NXCD = 8, WGM = 8, HT = HALF * BK;
__device__ __forceinline__ int lds_byte(int r, int c) {
  int st = (r >> 4) * 2 + (c >> 5), rr = r & 15, cc = c & 31, ob = rr * 64 + cc * 2;
  return st * 1024 + (ob ^ (((ob >> 9) & 1) << 5));
}
__device__ __forceinline__ void stage_rc(int b, int& R, int& C) {
  int st = b / 1024, sb = b % 1024, swz = sb ^ (((sb >> 9) & 1) << 5);
  R = (st >> 1) * 16 + swz / 64; C = (st & 1) * 32 + (swz % 64) / 2;
}

__device__ __forceinline__ void gemm_tile(const bf16_t* __restrict__ A, const bf16_t* __restrict__ Bt, bf16_t* __restrict__ C,
                                          int K, int ldc, int brow, int bcol, LAS bf16_t* shm, const int EPI, const int tid) {
#define SA(b, h) (shm + ((b) * 2 + (h)) * HT)
#define SB(b, h) (shm + (4 + (b) * 2 + (h)) * HT)
#define STAGE(P, BASE, br, kt) do { const char* _gb = (const char*)(BASE) + (((long)(br) * K + (long)(kt) * BK) << 1); \
    _Pragma("unroll") for (int _i = 0; _i < 2; ++_i) { \
      __builtin_amdgcn_global_load_lds((const unsigned*)(_gb + voff[_i]), \
        (LAS unsigned*)((LAS char*)(P) + ldsw + _i * 8192), 16, 0, 0); } } while (0)
#define LDA(dst, b, h) _Pragma("unroll") for (int m = 0; m < 4; ++m) _Pragma("unroll") for (int k = 0; k < 2; ++k) \
    dst[m][k] = *(const LAS bf16x8*)((LAS char*)SA(b, h) + aoff + m * 2048 + k * 1024)
#define LDB(dst, b, h) _Pragma("unroll") for (int n = 0; n < 2; ++n) _Pragma("unroll") for (int k = 0; k < 2; ++k) \
    dst[n][k] = *(const LAS bf16x8*)((LAS char*)SB(b, h) + boff + n * 2048 + k * 1024)
#define MMA(ai, bj, At_, Bt_) do { __builtin_amdgcn_s_setprio(1); \
    _Pragma("unroll") for (int m = 0; m < 4; ++m) _Pragma("unroll") for (int n = 0; n < 2; ++n) _Pragma("unroll") for (int k = 0; k < 2; ++k) \
      acc[ai][bj][m][n] = __builtin_amdgcn_mfma_f32_16x16x32_bf16(Bt_[n][k], At_[m][k], acc[ai][bj][m][n], 0, 0, 0); \
    __builtin_amdgcn_s_setprio(0); } while (0)
#define WAIT_V(n) asm volatile("s_waitcnt vmcnt(" #n ")" ::: "memory")
#define WAIT_L(n) asm volatile("s_waitcnt lgkmcnt(" #n ")" ::: "memory")
#define BAR __builtin_amdgcn_s_barrier()
#define SCHED __builtin_amdgcn_sched_barrier(0)
  const int wid = __builtin_amdgcn_readfirstlane(tid >> 6), lane = tid & 63, wr = wid >> 2, wc = wid & 3, fr = lane & 15, fq = lane >> 4;
  const int aoff = lds_byte(wr * 64 + fr, fq * 8), boff = lds_byte(wc * 32 + fr, fq * 8);
  f32x4 acc[2][2][4][2] = {};
  bf16x8 At[4][2], B0[2][2], B1[2][2];
  unsigned voff[2];
  const int ldsw = wid * 1024;
#pragma unroll
  for (int _i = 0; _i < 2; ++_i) { int _r, _c; stage_rc(tid * 16 + _i * 8192, _r, _c); voff[_i] = (unsigned)(_r * K + _c) * 2u; }
  const int nt = K / BK;
  STAGE(SB(0, 0), Bt, bcol, 0); STAGE(SA(0, 0), A, brow, 0);
  STAGE(SB(0, 1), Bt, bcol + HALF, 0); STAGE(SA(0, 1), A, brow + HALF, 0);
  if (wr == 1) BAR;
  WAIT_V(4); BAR;
  STAGE(SB(1, 0), Bt, bcol, 1); STAGE(SA(1, 0), A, brow, 1); STAGE(SB(1, 1), Bt, bcol + HALF, 1);
  WAIT_V(6); BAR;
  for (int t = 0; t < nt - 2; t += 2) {
    LDB(B0, 0, 0); SCHED; LDA(At, 0, 0); STAGE(SA(1, 1), A, brow + HALF, t + 1);
    WAIT_L(8); BAR; WAIT_L(0); MMA(0, 0, At, B0); BAR; SCHED;
    LDB(B1, 0, 1); STAGE(SB(0, 0), Bt, bcol, t + 2);
    BAR; WAIT_L(0); MMA(0, 1, At, B1); BAR;
    LDA(At, 0, 1); STAGE(SA(0, 0), A, brow, t + 2);
    BAR; WAIT_L(0); MMA(1, 0, At, B0); BAR; SCHED;
    STAGE(SB(0, 1), Bt, bcol + HALF, t + 2);
    WAIT_V(6); BAR; MMA(1, 1, At, B1); BAR;
    LDB(B0, 1, 0); SCHED; LDA(At, 1, 0); STAGE(SA(0, 1), A, brow + HALF, t + 2);
    WAIT_L(8); BAR; WAIT_L(0); MMA(0, 0, At, B0); BAR; SCHED;
    LDB(B1, 1, 1); STAGE(SB(1, 0), Bt, bcol, t + 3);
    BAR; WAIT_L(0); MMA(0, 1, At, B1); BAR;
    LDA(At, 1, 1); STAGE(SA(1, 0), A, brow, t + 3);
    BAR; WAIT_L(0); MMA(1, 0, At, B0); BAR; SCHED;
    STAGE(SB(1, 1), Bt, bcol + HALF, t + 3);
    WAIT_V(6); BAR; MMA(1, 1, At, B1); BAR;
  }
  { LDB(B0, 0, 0); LDA(At, 0, 0); STAGE(SA(1, 1), A, brow + HALF, nt - 1);
    BAR; WAIT_L(0); MMA(0, 0, At, B0); BAR;
    LDB(B1, 0, 1); BAR; WAIT_L(0); MMA(0, 1, At, B1); BAR;
    LDA(At, 0, 1); WAIT_V(4); BAR; WAIT_L(0); MMA(1, 0, At, B0); MMA(1, 1, At, B1); BAR; }
  { LDB(B0, 1, 0); LDA(At, 1, 0); WAIT_V(2); BAR; WAIT_L(0); MMA(0, 0, At, B0); BAR;
    LDB(B1, 1, 1); WAIT_V(0); BAR; WAIT_L(0); MMA(0, 1, At, B1); BAR;
    LDA(At, 1, 1); BAR; WAIT_L(0); MMA(1, 0, At, B0); MMA(1, 1, At, B1); BAR; }
  if (wr == 0) BAR;
#pragma unroll
  for (int ai = 0; ai < 2; ++ai)
#pragma unroll
    for (int m = 0; m < 4; ++m) {
      const size_t row = (size_t)(brow + ai * HALF + wr * 64 + m * 16 + fr);
#pragma unroll
      for (int bj = 0; bj < 2; ++bj) {
        if (EPI == 0) {
#pragma unroll
          for (int n = 0; n < 2; ++n) {
            const f32x4 v = acc[ai][bj][m][n];
            uint2 u; u.x = cvt_pk_bf16(v[0], v[1]); u.y = cvt_pk_bf16(v[2], v[3]);
            *(uint2*)(C + row * ldc + bcol + bj * HALF + wc * 32 + n * 16 + fq * 4) = u;
          }
        } else {
          const f32x4 a = acc[ai][bj][m][0], b = acc[ai][bj][m][1];
          float o[4];
#pragma unroll
          for (int j = 0; j < 4; ++j) o[j] = a[j] * __builtin_amdgcn_rcpf(1.f + __expf(-a[j])) * b[j];
          uint2 u; u.x = cvt_pk_bf16(o[0], o[1]); u.y = cvt_pk_bf16(o[2], o[3]);
          *(uint2*)(C + row * ldc + ((bcol + bj * HALF + wc * 32) >> 1) + fq * 4) = u;
        }
      }
    }
#undef SA
#undef SB
#undef STAGE
#undef LDA
#undef LDB
#undef MMA
}

__device__ __forceinline__ void gemm_phase(const bf16_t* A, const bf16_t* Bt, bf16_t* C, int M, int N, int K, int ldc, int EPI, char* smem) {
  const int nM = M / BM, nN = N / BM, nwg = nM * nN;
  const int tid = opaque_tid();
  for (int L = blockIdx.x; L < nwg; L += gridDim.x) {
    int wgid = L;
    { int q = nwg / NXCD, r = nwg % NXCD, xcd = wgid % NXCD, off = wgid / NXCD;
      wgid = (xcd < r ? xcd * (q + 1) : r * (q + 1) + (xcd - r) * q) + off; }
    const int nig = WGM * nN, gid = wgid / nig, fm = gid * WGM, gsz = min(nM - fm, WGM);
    const int pm = fm + ((wgid % nig) % gsz), pn = (wgid % nig) / gsz;
    gemm_tile(A, Bt, C, K, ldc, pm * BM, pn * BM, (LAS bf16_t*)smem, EPI, tid);
    asm volatile("s_waitcnt vmcnt(0)" ::: "memory");
    __syncthreads();
  }
}

__device__ __forceinline__ void load_shift16(const bf16_t* __restrict__ z, int row, int t, int T, int col, const float* __restrict__ mu, float* o) {
  const bf16_t* pz = z + (size_t)row * ZLD + col;
  uint4 c0 = *(const uint4*)pz, c1 = *(const uint4*)(pz + 8);
  uint4 p0 = make_uint4(0, 0, 0, 0), p1 = p0, n0 = p0, n1 = p0;
  if (t > 0) { p0 = *(const uint4*)(pz - ZLD); p1 = *(const uint4*)(pz - ZLD + 8); }
  if (t < T - 1) { n0 = *(const uint4*)(pz + ZLD); n1 = *(const uint4*)(pz + ZLD + 8); }
  float c[16], pv[16], nx[16];
  unpack8(c0, c); unpack8(c1, c + 8); unpack8(p0, pv); unpack8(p1, pv + 8); unpack8(n0, nx); unpack8(n1, nx + 8);
#pragma unroll
  for (int q = 0; q < 16; ++q) o[q] = c[q] + (0.5f * (pv[q] + nx[q]) - c[q]) * mu[col - 512 + q];
}
__device__ __forceinline__ void load_shift8(const bf16_t* __restrict__ z, int row, int t, int T, int col, const float* __restrict__ mu, float* o) {
  const bf16_t* pz = z + (size_t)row * ZLD + col;
  uint4 c0 = *(const uint4*)pz;
  uint4 p0 = make_uint4(0, 0, 0, 0), n0 = p0;
  if (t > 0) p0 = *(const uint4*)(pz - ZLD);
  if (t < T - 1) n0 = *(const uint4*)(pz + ZLD);
  float c[8], pv[8], nx[8];
  unpack8(c0, c); unpack8(p0, pv); unpack8(n0, nx);
#pragma unroll
  for (int q = 0; q < 8; ++q) o[q] = c[q] + (0.5f * (pv[q] + nx[q]) - c[q]) * mu[col - 512 + q];
}

constexpr int TC = 32;
constexpr int SV = TC * 64;
__device__ __forceinline__ void scan_phase(const Params& p, char* smem) {
  float* stepbuf = (float*)smem;
  float* ybuf = stepbuf + 2 * 6 * SV;
  char* hpriv = (char*)(ybuf + 2 * SV);
  const bf16_t* z = P_RU;
  bf16_t* ydir = P_RY;
  const int tid_ = opaque_tid();
  const int wave = tid_ >> 6, lane = tid_ & 63;
  const int item = blockIdx.x;
  if (item < 256) {
    const int s = item < 128 ? 8 + (item >> 4) : ((item - 128) >> 4);
    const int h = (item & 15) >> 1, d = item & 1;
    const int T = s < 8 ? 4096 : 8192, r0seq = seq_start(s), nch = T / TC;
    bf16_t* yout = ydir + (size_t)d * NTOK * 512;

    if (wave >= 4) {
      const int hw = wave - 4, th = hw & 1, task = hw >> 1;
      const int tl = lane >> 2, cq = lane & 3, fr = lane & 15, fq = lane >> 4;
      bf16_t* Ab = (bf16_t*)(hpriv + hw * 8192);
      float* tmpa = (float*)(hpriv + hw * 8192 + 2560);
      const float* lsrc = sel(task != 0, p.a2, p.w2) + (size_t)d * 64 * 512 + h * 64;
      bf16x8 Bl[4][2];
#pragma unroll
      for (int nt = 0; nt < 4; ++nt)
#pragma unroll
        for (int ks = 0; ks < 2; ++ks) {
          float o[8];
#pragma unroll
          for (int q = 0; q < 8; ++q) o[q] = lsrc[(size_t)(ks * 32 + fq * 8 + q) * 512 + nt * 16 + fr];
          uint4 u = pack8(o);
          Bl[nt][ks] = *reinterpret_cast<bf16x8*>(&u);
        }
      float bias[4];
#pragma unroll
      for (int nt = 0; nt < 4; ++nt) bias[nt] = sel(task != 0, p.a0, p.w0)[d * 512 + h * 64 + nt * 16 + fr];
      const int hyl = (wave - 4) * 64 + lane;

      for (int c = -1; c < nch; ++c) {
        if (c + 1 < nch) {
          const float *mu = p.shift_mu, *kkp = p.k_k + h * 64, *kap = p.k_a + h * 64, *rkp = p.r_k + h * 64;
          asm volatile("" : "+v"(mu), "+v"(kkp), "+v"(kap), "+v"(rkp));
          float* sb = stepbuf + ((c + 1) & 1) * 6 * SV;
          const int j = th * 16 + tl;
          const int istep = (c + 1) * TC + j;
          const int t = d ? T - 1 - istep : istep;
          const int row = r0seq + t;
          float v16[16];
          load_shift16(z, row, t, T, (task ? 2176 : 2048) + d * 64 + cq * 16, mu, v16);
          if (!task) {
#pragma unroll
            for (int q = 0; q < 16; ++q) { const float e = __expf(2.f * v16[q]); v16[q] = 1.f - 2.f * __builtin_amdgcn_rcpf(e + 1.f); }
          }
          *(uint4*)(Ab + tl * 72 + cq * 16) = pack8(v16);
          *(uint4*)(Ab + tl * 72 + cq * 16 + 8) = pack8(v16 + 8);
          __builtin_amdgcn_wave_barrier();
          f32x4 acc[4] = {};
#pragma unroll
          for (int ks = 0; ks < 2; ++ks) {
            const bf16x8 a = *reinterpret_cast<const bf16x8*>(Ab + fr * 72 + ks * 32 + fq * 8);
#pragma unroll
            for (int nt = 0; nt < 4; ++nt) acc[nt] = __builtin_amdgcn_mfma_f32_16x16x32_bf16(a, Bl[nt][ks], acc[nt], 0, 0, 0);
          }
          if (!task) {
#pragma unroll
            for (int nt = 0; nt < 4; ++nt)
#pragma unroll
              for (int jj = 0; jj < 4; ++jj) {
                const float sg = sigmoidf_(bias[nt] + acc[nt][jj]);
                sb[0 * SV + (th * 16 + fq * 4 + jj) * 64 + nt * 16 + fr] = __expf(-0.6065306597126334f * sg);
              }
            load_shift16(z, row, t, T, 512 + h * 64 + cq * 16, mu, v16);
#pragma unroll
            for (int q = 0; q < 4; ++q) *(f32x4*)(sb + 2 * SV + j * 64 + cq * 16 + q * 4) = (f32x4){v16[q * 4], v16[q * 4 + 1], v16[q * 4 + 2], v16[q * 4 + 3]};
            load_shift16(z, row, t, T, 1536 + h * 64 + cq * 16, mu, v16);
#pragma unroll
            for (int q = 0; q < 4; ++q) *(f32x4*)(sb + 5 * SV + j * 64 + cq * 16 + q * 4) = (f32x4){v16[q * 4], v16[q * 4 + 1], v16[q * 4 + 2], v16[q * 4 + 3]};
          } else {
#pragma unroll
            for (int nt = 0; nt < 4; ++nt)
#pragma unroll
              for (int jj = 0; jj < 4; ++jj) tmpa[(fq * 4 + jj) * 68 + nt * 16 + fr] = sigmoidf_(bias[nt] + acc[nt][jj]);
            __builtin_amdgcn_wave_barrier();
            float av[16], kd[16];
#pragma unroll
            for (int q = 0; q < 4; ++q) { f32x4 a4 = *(const f32x4*)(tmpa + tl * 68 + cq * 16 + q * 4); av[q * 4] = a4[0]; av[q * 4 + 1] = a4[1]; av[q * 4 + 2] = a4[2]; av[q * 4 + 3] = a4[3]; }
            load_shift16(z, row, t, T, 1024 + h * 64 + cq * 16, mu, v16);
            float kk[16], ss = 0.f;
#pragma unroll
            for (int q = 0; q < 16; ++q) { kk[q] = v16[q] * kkp[cq * 16 + q]; ss += kk[q] * kk[q]; }
            ss += __shfl_xor(ss, 1); ss += __shfl_xor(ss, 2);
            const float inv = 1.f / fmaxf(sqrtf(ss), 1e-12f);
#pragma unroll
            for (int q = 0; q < 16; ++q) { kk[q] *= inv; kd[q] = v16[q] * (1.f + (av[q] - 1.f) * kap[cq * 16 + q]); }
#pragma unroll
            for (int q = 0; q < 4; ++q) {
              *(f32x4*)(sb + 3 * SV + j * 64 + cq * 16 + q * 4) = (f32x4){-kk[q * 4], -kk[q * 4 + 1], -kk[q * 4 + 2], -kk[q * 4 + 3]};
              *(f32x4*)(sb + 4 * SV + j * 64 + cq * 16 + q * 4) = (f32x4){kk[q * 4] * av[q * 4], kk[q * 4 + 1] * av[q * 4 + 1], kk[q * 4 + 2] * av[q * 4 + 2], kk[q * 4 + 3] * av[q * 4 + 3]};
              *(f32x4*)(sb + 1 * SV + j * 64 + cq * 16 + q * 4) = (f32x4){kd[q * 4], kd[q * 4 + 1], kd[q * 4 + 2], kd[q * 4 + 3]};
            }
            load_shift16(z, row, t, T, 512 + h * 64 + cq * 16, mu, v16);
            float bs = 0.f;
#pragma unroll
            for (int q = 0; q < 16; ++q) bs += v16[q] * kd[q] * rkp[cq * 16 + q];
            bs += __shfl_xor(bs, 1); bs += __shfl_xor(bs, 2);
            if (cq == 0) P_SBON[((size_t)row * 8 + h) * 2 + d] = bs;
          }
        }
        if (c >= 1) {
          const float* yb = ybuf + ((c - 1) & 1) * SV;
          const int j = hyl >> 3, oc = hyl & 7;
          const int istep = (c - 1) * TC + j;
          const int t = d ? T - 1 - istep : istep;
          float o[8];
          f32x4 a = *(const f32x4*)(yb + j * 64 + oc * 8), b = *(const f32x4*)(yb + j * 64 + oc * 8 + 4);
          o[0] = a[0]; o[1] = a[1]; o[2] = a[2]; o[3] = a[3]; o[4] = b[0]; o[5] = b[1]; o[6] = b[2]; o[7] = b[3];
          *(uint4*)(yout + (size_t)(r0seq + t) * 512 + h * 64 + oc * 8) = pack8(o);
        }
        __syncthreads();
      }
      {
        const float* yb = ybuf + ((nch - 1) & 1) * SV;
        const int j = hyl >> 3, oc = hyl & 7;
        const int istep = (nch - 1) * TC + j;
        const int t = d ? T - 1 - istep : istep;
        float o[8];
        f32x4 a = *(const f32x4*)(yb + j * 64 + oc * 8), b = *(const f32x4*)(yb + j * 64 + oc * 8 + 4);
        o[0] = a[0]; o[1] = a[1]; o[2] = a[2]; o[3] = a[3]; o[4] = b[0]; o[5] = b[1]; o[6] = b[2]; o[7] = b[3];
        *(uint4*)(yout + (size_t)(r0seq + t) * 512 + h * 64 + oc * 8) = pack8(o);
      }
      __syncthreads();
    } else {
      const int kseg = lane & 15, rg = lane >> 4, rb = wave * 16 + rg * 4;
      f32x4 S0 = {0.f, 0.f, 0.f, 0.f}, S1 = S0, S2 = S0, S3 = S0;
      __syncthreads();
      for (int c = 0; c < nch; ++c) {
        const float* sb = stepbuf + (c & 1) * 6 * SV;
        float* yb = ybuf + (c & 1) * SV;
#pragma unroll 2
        for (int j = 0; j < TC; ++j) {
          const f32x4 w4 = *(const f32x4*)(sb + 0 * SV + j * 64 + kseg * 4);
          const f32x4 kd4 = *(const f32x4*)(sb + 1 * SV + j * 64 + kseg * 4);
          const f32x4 r4 = *(const f32x4*)(sb + 2 * SV + j * 64 + kseg * 4);
          const f32x4 na4 = *(const f32x4*)(sb + 3 * SV + j * 64 + kseg * 4);
          const f32x4 b4 = *(const f32x4*)(sb + 4 * SV + j * 64 + kseg * 4);
          const f32x4 v4 = *(const f32x4*)(sb + 5 * SV + j * 64 + rb);
          f32x4 t0 = S0 * na4, t1 = S1 * na4, t2 = S2 * na4, t3 = S3 * na4;
          float sa0 = (t0[0] + t0[1]) + (t0[2] + t0[3]), sa1 = (t1[0] + t1[1]) + (t1[2] + t1[3]);
          float sa2 = (t2[0] + t2[1]) + (t2[2] + t2[3]), sa3 = (t3[0] + t3[1]) + (t3[2] + t3[3]);
          sa0 = row16_sum(sa0); sa1 = row16_sum(sa1); sa2 = row16_sum(sa2); sa3 = row16_sum(sa3);
          S0 = S0 * w4 + b4 * sa0 + kd4 * v4[0];
          S1 = S1 * w4 + b4 * sa1 + kd4 * v4[1];
          S2 = S2 * w4 + b4 * sa2 + kd4 * v4[2];
          S3 = S3 * w4 + b4 * sa3 + kd4 * v4[3];
          t0 = S0 * r4; t1 = S1 * r4; t2 = S2 * r4; t3 = S3 * r4;
          float y0 = (t0[0] + t0[1]) + (t0[2] + t0[3]), y1 = (t1[0] + t1[1]) + (t1[2] + t1[3]);
          float y2 = (t2[0] + t2[1]) + (t2[2] + t2[3]), y3 = (t3[0] + t3[1]) + (t3[2] + t3[3]);
          y0 = row16_sum(y0); y1 = row16_sum(y1); y2 = row16_sum(y2); y3 = row16_sum(y3);
          const float yv = kseg == 0 ? y0 : kseg == 1 ? y1 : kseg == 2 ? y2 : y3;
          if (kseg < 4) yb[j * 64 + rb + kseg] = yv;
        }
        __syncthreads();
      }
      __syncthreads();
    }
  }
}

__device__ __forceinline__ void post_phase(const Params& p, char* smem) {
  bf16_t* Ag = (bf16_t*)smem;
  bf16_t* vt = (bf16_t*)(smem + 12800);
  float* ys = (float*)(smem + 12800 + 33280);
  const bf16_t* z = P_RU;
  const bf16_t* yf = P_RY;
  const bf16_t* ybk = P_RY + (size_t)NTOK * 512;
  bf16_t* mo = P_RH;
  const int tid = opaque_tid(), w = tid >> 6, lane = tid & 63, fr = lane & 15, fq = lane >> 4;
  bf16x8 Bg[4][6];
#pragma unroll
  for (int nt = 0; nt < 4; ++nt)
#pragma unroll
    for (int ks = 0; ks < 6; ++ks) {
      float o[8];
#pragma unroll
      for (int q = 0; q < 8; ++q) { const int k = ks * 32 + fq * 8 + q; o[q] = k < 160 ? p.g2[(size_t)k * 512 + w * 64 + nt * 16 + fr] : 0.f; }
      uint4 u = pack8(o);
      Bg[nt][ks] = *reinterpret_cast<bf16x8*>(&u);
    }
  float lng[4], lnb[4];
#pragma unroll
  for (int nt = 0; nt < 4; ++nt) { lng[nt] = p.lnx_g[w * 64 + nt * 16 + fr]; lnb[nt] = p.lnx_b[w * 64 + nt * 16 + fr]; }

  for (int tile = blockIdx.x; tile < NTOK / 32; tile += gridDim.x) {
    const int row0 = tile * 32;
    int s, t0, T;
    row_seq(row0, s, t0, T);
    for (int idx = tid; idx < 32 * 24; idx += NTHR) {
      const int tok = idx / 24, oc = idx % 24;
      float o[8];
      if (oc < 20) {
        load_shift8(z, row0 + tok, t0 + tok, T, 2304 + oc * 8, p.shift_mu, o);
#pragma unroll
        for (int q = 0; q < 8; ++q) o[q] = sigmoidf_(o[q]);
      } else {
#pragma unroll
        for (int q = 0; q < 8; ++q) o[q] = 0.f;
      }
      *(uint4*)(Ag + tok * 200 + oc * 8) = pack8(o);
    }
    for (int idx = tid; idx < 32 * 64; idx += NTHR) {
      const int tok = idx >> 6, oc = idx & 63, row = row0 + tok, t = t0 + tok;
      float o[8];
      load_shift8(z, row, t, T, 1536 + oc * 8, p.shift_mu, o);
      *(uint4*)(vt + tok * 520 + oc * 8) = pack8(o);
      float a[8], b[8];
      unpack8(*(const uint4*)(yf + (size_t)row * 512 + oc * 8), a);
      unpack8(*(const uint4*)(ybk + (size_t)row * 512 + oc * 8), b);
      *(f32x4*)(ys + tok * 516 + oc * 8) = (f32x4){a[0] + b[0], a[1] + b[1], a[2] + b[2], a[3] + b[3]};
      *(f32x4*)(ys + tok * 516 + oc * 8 + 4) = (f32x4){a[4] + b[4], a[5] + b[5], a[6] + b[6], a[7] + b[7]};
      const int c0 = oc * 8, half = 1 << (c0 >> 7);
      const int lo = max(t - half, 0), hi = min(t + half, T);
      float sum[8];
#pragma unroll
      for (int q = 0; q < 8; ++q) sum[q] = 0.f;
      for (int tt = lo; tt < hi; ++tt) {
        float zz[8];
        unpack8(*(const uint4*)(z + (size_t)(row + tt - t) * ZLD + c0), zz);
#pragma unroll
        for (int q = 0; q < 8; ++q) sum[q] += zz[q];
      }
      float zc[8];
      unpack8(*(const uint4*)(z + (size_t)row * ZLD + c0), zc);
      const float ic = 1.f / (float)(hi - lo);
#pragma unroll
      for (int q = 0; q < 8; ++q) sum[q] = sum[q] * ic - zc[q];
      *(uint4*)(mo + (size_t)row * D + c0) = pack8(sum);
    }
    __syncthreads();
    f32x4 acc[2][4] = {};
#pragma unroll
    for (int ks = 0; ks < 6; ++ks) {
      bf16x8 a[2];
#pragma unroll
      for (int mt = 0; mt < 2; ++mt) a[mt] = *reinterpret_cast<const bf16x8*>(Ag + (mt * 16 + fr) * 200 + ks * 32 + fq * 8);
#pragma unroll
      for (int mt = 0; mt < 2; ++mt)
#pragma unroll
        for (int nt = 0; nt < 4; ++nt) acc[mt][nt] = __builtin_amdgcn_mfma_f32_16x16x32_bf16(a[mt], Bg[nt][ks], acc[mt][nt], 0, 0, 0);
    }
#pragma unroll
    for (int mt = 0; mt < 2; ++mt)
#pragma unroll
      for (int jj = 0; jj < 4; ++jj) {
        const int tok = mt * 16 + fq * 4 + jj, row = row0 + tok;
        float yv[4], sm_ = 0.f;
#pragma unroll
        for (int nt = 0; nt < 4; ++nt) { yv[nt] = ys[tok * 516 + w * 64 + nt * 16 + fr]; sm_ += yv[nt]; }
        const float mean = row16_sum(sm_) * (1.f / 64.f);
        float vs = 0.f;
#pragma unroll
        for (int nt = 0; nt < 4; ++nt) { yv[nt] -= mean; vs += yv[nt] * yv[nt]; }
        const float rs = rsqrtf(row16_sum(vs) * (1.f / 64.f) + 64e-5f);
        const float2 sb2 = *(const float2*)(P_SBON + ((size_t)row * 8 + w) * 2);
        const float sbs = sb2.x + sb2.y;
#pragma unroll
        for (int nt = 0; nt < 4; ++nt) {
          const float vv = bf2f(vt[tok * 520 + w * 64 + nt * 16 + fr]);
          const float o = (yv[nt] * rs * lng[nt] + lnb[nt] + sbs * vv) * acc[mt][nt][jj];
          mo[(size_t)row * D + 512 + w * 64 + nt * 16 + fr] = (bf16_t)(cvt_pk_bf16(o, 0.f) & 0xffff);
        }
      }
    __syncthreads();
  }
}

constexpr int NPHASE = 13;
__device__ __forceinline__ void do_phase(const Params& p, int ph, char* smem) {
  if (ph == 0) prep_phase(p, smem);
  else if (ph == 1) row_phase<0>(p.x_prompt, p.x_sample, nullptr, nullptr, P_RH, P_MOD, nullptr, p.n1_pre, 0, 0.f, 0);
  else if (ph == 4 || ph == 9) {
    const bool f = ph == 4;
    float* outp = p.out;
    row_phase<1>(sel(f, p.x_prompt, (const float*)outp), sel(f, p.x_sample, (const float*)(outp + (size_t)NPROMPT * D)), outp, P_RY, P_RH, P_MOD,
                 sel(f, p.n1_post, p.nm_post), sel(f, p.nm_pre, p.n2_pre), f ? 2 : 5, f ? 0.5f : 1.0f, f ? 3 : 6);
  }
  else if (ph == 12) row_phase<2>(p.out, p.out + (size_t)NPROMPT * D, p.out, P_RY, nullptr, P_MOD, p.n2_post, nullptr, 8, 0.5f, 0);
  else if (ph == 6) scan_phase(p, smem);
  else if (ph == 7) post_phase(p, smem);
  else {
    const bf16_t *A, *Bt; bf16_t* C; int N, K, ldc, epi;
    if (ph == 2 || ph == 10) { A = P_RH; Bt = sel(ph == 2, P_W13A, P_W13B); C = P_RU; N = 2 * FF; K = D; ldc = FF; epi = 1; }
    else if (ph == 3 || ph == 11) { A = P_RU; Bt = sel(ph == 3, P_W2A, P_W2B); C = P_RY; N = D; K = FF; ldc = D; epi = 0; }
    else if (ph == 5) { A = P_RH; Bt = P_WINT; C = P_RU; N = ZLD; K = D; ldc = ZLD; epi = 0; }
    else { A = P_RH; Bt = P_WOUTT; C = P_RY; N = D; K = D; ldc = D; epi = 0; }
    gemm_phase(A, Bt, C, NTOK, N, K, ldc, epi, smem);
  }
}

extern __shared__ __attribute__((aligned(16))) char dyn_smem[];

__global__ void __launch_bounds__(NTHR, 2) mega_kernel(Params p) {
  cg::grid_group grid = cg::this_grid();
#pragma unroll 1
  for (int ph = 0; ph < NPHASE; ++ph) {
    do_phase(p, ph, dyn_smem);
    if (ph + 1 < NPHASE) grid.sync();
  }
}

__global__ void __launch_bounds__(NTHR, 2) phase_kernel(Params p, int ph) { do_phase(p, ph, dyn_smem); }

extern "C" void kernel_launch(void* const* d_in, const int* in_sizes, int n_in, void* d_out, int out_size, void* d_ws, size_t ws_size,
                              hipStream_t stream) {
  Params p{};
  const float** f = (const float**)&p;
  for (int i = 0; i < 33; ++i) f[i] = (const float*)d_in[i];
  p.out = (float*)d_out;
  p.ws = (char*)d_ws;
  if (WS_NEED > ws_size) { fprintf(stderr, "workspace too small: need %zu have %zu\n", (size_t)WS_NEED, ws_size); return; }

#if ONE_LAUNCH
  static int grid_blocks = 0;
  if (!grid_blocks) {
    int dev = 0, cus = 0, per_cu = 0;
    (void)hipGetDevice(&dev);
    (void)hipDeviceGetAttribute(&cus, hipDeviceAttributeMultiprocessorCount, dev);
    (void)hipFuncSetAttribute((const void*)mega_kernel, hipFuncAttributeMaxDynamicSharedMemorySize, SMEM_BYTES);
    (void)hipOccupancyMaxActiveBlocksPerMultiprocessor(&per_cu, mega_kernel, NTHR, SMEM_BYTES);
    if (per_cu < 1) per_cu = 1;
    grid_blocks = cus * per_cu;
  }
  void* args[] = {&p};
  hipError_t e = hipLaunchCooperativeKernel((const void*)mega_kernel, dim3(grid_blocks), dim3(NTHR), args, SMEM_BYTES, stream);
  if (e != hipSuccess) fprintf(stderr, "cooperative launch failed: %s (grid %d)\n", hipGetErrorString(e), grid_blocks);
#else
  static bool attr = false;
  if (!attr) { (void)hipFuncSetAttribute((const void*)phase_kernel, hipFuncAttributeMaxDynamicSharedMemorySize, SMEM_BYTES); attr = true; }
  for (int ph = 0; ph < NPHASE; ++ph) phase_kernel<<<256, NTHR, SMEM_BYTES, stream>>>(p, ph);
#endif
}
```

```cpp
#include <hip/hip_runtime.h>
#include <hip/hip_cooperative_groups.h>
#include <cstdio>
namespace cg = cooperative_groups;

#ifndef ONE_LAUNCH
#define ONE_LAUNCH 1
#endif

typedef unsigned short bf16_t;
typedef short bf16x8 __attribute__((ext_vector_type(8)));
typedef float f32x4 __attribute__((ext_vector_type(4)));
typedef float f32x2 __attribute__((ext_vector_type(2)));
#define LAS __attribute__((address_space(3)))

constexpr int D = 1024, FF = 2816, NTOK = 98304, NPROMPT = 32768, ZLD = 2560, PINW = 2464;
constexpr int NTHR = 512;
constexpr int SMEM_BYTES = 147456;

struct Params {
  const float *x_prompt, *x_sample, *c_prompt, *c_sample, *ada_w, *ada_b, *n1_pre, *n1_post, *f1_w1, *f1_w3, *f1_w2,
      *nm_pre, *nm_post, *w_in, *shift_mu, *pool_w, *pool_scale, *w0, *w2, *a0, *a2, *g2, *k_k, *k_a, *r_k, *lnx_g, *lnx_b,
      *w_out, *n2_pre, *n2_post, *f2_w1, *f2_w3, *f2_w2;
  float* out;
  char* ws;
};
constexpr size_t al256(size_t b) { return (b + 255) & ~(size_t)255; }
constexpr size_t OFF_W13A = 0;
constexpr size_t OFF_W13B = OFF_W13A + al256((size_t)2 * FF * D * 2);
constexpr size_t OFF_W2A = OFF_W13B + al256((size_t)2 * FF * D * 2);
constexpr size_t OFF_W2B = OFF_W2A + al256((size_t)D * FF * 2);
constexpr size_t OFF_WINT = OFF_W2B + al256((size_t)D * FF * 2);
constexpr size_t OFF_WOUTT = OFF_WINT + al256((size_t)ZLD * D * 2);
constexpr size_t OFF_MOD = OFF_WOUTT + al256((size_t)D * D * 2);
constexpr size_t OFF_SBON = OFF_MOD + al256((size_t)16 * 9216 * 4);
constexpr size_t OFF_RH = OFF_SBON + al256((size_t)NTOK * 16 * 4);
constexpr size_t OFF_RY = OFF_RH + al256((size_t)NTOK * D * 2);
constexpr size_t OFF_RU = OFF_RY + al256((size_t)NTOK * D * 2);
constexpr size_t WS_NEED = OFF_RU + al256((size_t)NTOK * FF * 2);
#define P_W13A ((bf16_t*)(p.ws + OFF_W13A))
#define P_W13B ((bf16_t*)(p.ws + OFF_W13B))
#define P_W2A ((bf16_t*)(p.ws + OFF_W2A))
#define P_W2B ((bf16_t*)(p.ws + OFF_W2B))
#define P_WINT ((bf16_t*)(p.ws + OFF_WINT))
#define P_WOUTT ((bf16_t*)(p.ws + OFF_WOUTT))
#define P_MOD ((float*)(p.ws + OFF_MOD))
#define P_SBON ((float*)(p.ws + OFF_SBON))
#define P_RH ((bf16_t*)(p.ws + OFF_RH))
#define P_RY ((bf16_t*)(p.ws + OFF_RY))
#define P_RU ((bf16_t*)(p.ws + OFF_RU))

__device__ __forceinline__ unsigned cvt_pk_bf16(float lo, float hi) {
  unsigned r;
  asm volatile("v_cvt_pk_bf16_f32 %0, %1, %2" : "=v"(r) : "v"(lo), "v"(hi));
  return r;
}
__device__ __forceinline__ float bf_lo(unsigned u) { return __uint_as_float(u << 16); }
__device__ __forceinline__ float bf_hi(unsigned u) { return __uint_as_float(u & 0xffff0000u); }
__device__ __forceinline__ float bf2f(bf16_t b) { return __uint_as_float(((unsigned)b) << 16); }
__device__ __forceinline__ void unpack8(uint4 v, float* o) {
  o[0] = bf_lo(v.x); o[1] = bf_hi(v.x); o[2] = bf_lo(v.y); o[3] = bf_hi(v.y);
  o[4] = bf_lo(v.z); o[5] = bf_hi(v.z); o[6] = bf_lo(v.w); o[7] = bf_hi(v.w);
}
__device__ __forceinline__ uint4 pack8(const float* o) {
  uint4 v; v.x = cvt_pk_bf16(o[0], o[1]); v.y = cvt_pk_bf16(o[2], o[3]); v.z = cvt_pk_bf16(o[4], o[5]); v.w = cvt_pk_bf16(o[6], o[7]);
  return v;
}
__device__ __forceinline__ float sigmoidf_(float x) { return __builtin_amdgcn_rcpf(1.f + __expf(-x)); }
__device__ __forceinline__ float wave_sum(float v) {
#pragma unroll
  for (int o = 32; o > 0; o >>= 1) v += __shfl_xor(v, o);
  return v;
}
template <int CTRL> __device__ __forceinline__ float dpp_f(float x) {
  return __int_as_float(__builtin_amdgcn_update_dpp(0, __float_as_int(x), CTRL, 0xf, 0xf, false));
}
__device__ __forceinline__ float row16_sum(float x) {
  x += dpp_f<0x128>(x); x += dpp_f<0x124>(x); x += dpp_f<0x122>(x); x += dpp_f<0x121>(x);
  return x;
}
template <class T> __device__ __forceinline__ T sel(bool c, T a, T b) { return c ? a : b; }
__device__ __forceinline__ int opaque_tid() { int t = threadIdx.x; asm volatile("" : "+v"(t)); return t; }
__device__ __forceinline__ int seq_start(int s) { return s < 8 ? s * 4096 : NPROMPT + (s - 8) * 8192; }
__device__ __forceinline__ void row_seq(int row, int& s, int& t, int& T) {
  if (row < NPROMPT) { s = row >> 12; t = row & 4095; T = 4096; }
  else { int r = row - NPROMPT; s = 8 + (r >> 13); t = r & 8191; T = 8192; }
}

__device__ __forceinline__ void tr_tile(const float* __restrict__ src, int ldsrc, int k0, int n0, int nvalid, bf16_t* __restrict__ dst, int ldd,
                        int kdst0, int mode, float* sm, const int tid) {
#pragma unroll
  for (int i = 0; i < 2; ++i) {
    const int r = (tid >> 4) + 32 * i, c = (tid & 15) * 4;
    float4 v = make_float4(0.f, 0.f, 0.f, 0.f);
    if (n0 + c < nvalid) v = *(const float4*)(src + (size_t)(k0 + r) * ldsrc + n0 + c);
    float* d = sm + r * 65 + c;
    d[0] = v.x; d[1] = v.y; d[2] = v.z; d[3] = v.w;
  }
  __syncthreads();
  {
    const int n = tid >> 3, kc = (tid & 7) * 8;
    float o[8];
#pragma unroll
    for (int j = 0; j < 8; ++j) o[j] = sm[(kc + j) * 65 + n];
    int nn = n0 + n, drow;
    if (mode == 0) drow = nn;
    else drow = 32 * (nn >> 4) + (nn & 15) + (mode == 2 ? 16 : 0);
    *(uint4*)(dst + (size_t)drow * ldd + kdst0 + k0 + kc) = pack8(o);
  }
  __syncthreads();
}

__device__ __forceinline__ void prep_phase(const Params& p, char* smem) {
  float* sm = (float*)smem;
  const int tid = opaque_tid();
  constexpr int N_MOD = 144, N_EFF = 128, N_W13 = 4 * 704, N_W2 = 2 * 704, N_WIN = 640, N_WOUT = 128;
  constexpr int TOTAL = N_MOD + N_EFF + N_W13 + N_W2 + N_WIN + N_WOUT;
  for (int item = blockIdx.x; item < TOTAL; item += gridDim.x) {
    int it = item;
    if (it < N_MOD) {
      const int j0 = it * 64;
      float* sc = sm;
      float* red = sm + 16384;
      for (int idx = tid; idx < 16384; idx += NTHR) {
        const int s = idx >> 10, k = idx & 1023;
        const float* cp_ = p.c_prompt; const float* cs_ = p.c_sample;
        const float c = s < 8 ? cp_[s * 1024 + k] : cs_[(s - 8) * 1024 + k];
        sc[idx] = c / (1.f + __expf(-c));
      }
      __syncthreads();
      const int col = tid & 63, kg = tid >> 6;
      float acc[16];
#pragma unroll
      for (int s = 0; s < 16; ++s) acc[s] = 0.f;
      for (int k = kg * 128; k < kg * 128 + 128; ++k) {
        const float w = p.ada_w[(size_t)k * 9216 + j0 + col];
#pragma unroll
        for (int s = 0; s < 16; ++s) acc[s] += sc[s * 1024 + k] * w;
      }
#pragma unroll
      for (int s = 0; s < 16; ++s) red[(kg * 16 + s) * 64 + col] = acc[s];
      __syncthreads();
      for (int o = tid; o < 1024; o += NTHR) {
        const int s = o >> 6, c2 = o & 63;
        float v = p.ada_b[j0 + c2];
#pragma unroll
        for (int g = 0; g < 8; ++g) v += red[(g * 16 + s) * 64 + c2];
        P_MOD[s * 9216 + j0 + c2] = v;
      }
      __syncthreads();
      continue;
    }
    it -= N_MOD;
    if (it < N_EFF) {
      const int g = it >> 5, itile = (it >> 4) & 1, ntile = it & 15;
      float* As = sm;
      float* Bs = sm + 64 * 129;
      for (int idx = tid; idx < 64 * 128; idx += NTHR) {
        const int i = idx >> 7, j = idx & 127;
        As[i * 129 + j] = p.pool_w[((size_t)g * 128 + itile * 64 + i) * 128 + j] * p.pool_scale[g * 128 + j];
      }
      for (int idx = tid; idx < 128 * 64; idx += NTHR) {
        const int j = idx >> 6, nn = idx & 63;
        Bs[j * 65 + nn] = p.w_out[(size_t)(g * 128 + j) * 1024 + ntile * 64 + nn];
      }
      __syncthreads();
      const int i = tid >> 3, nn0 = (tid & 7) * 8;
      float acc[8];
#pragma unroll
      for (int q = 0; q < 8; ++q) acc[q] = 0.f;
      for (int j = 0; j < 128; ++j) {
        const float a = As[i * 129 + j];
#pragma unroll
        for (int q = 0; q < 8; ++q) acc[q] += a * Bs[j * 65 + nn0 + q];
      }
#pragma unroll
      for (int q = 0; q < 8; ++q)
        P_WOUTT[(size_t)(ntile * 64 + nn0 + q) * 1024 + g * 128 + itile * 64 + i] = (bf16_t)(cvt_pk_bf16(acc[q], 0.f) & 0xffff);
      __syncthreads();
      continue;
    }
    it -= N_EFF;
    if (it < N_W13) {
      const int which = it / 704, r = it % 704;
      const int kt = r / 44, ntl = r % 44;
      const float* src = sel(which < 2, sel(which == 0, p.f1_w1, p.f1_w3), sel(which == 2, p.f2_w1, p.f2_w3));
      bf16_t* dst = sel(which < 2, P_W13A, P_W13B);
      tr_tile(src, FF, kt * 64, ntl * 64, FF, dst, D, 0, (which & 1) ? 2 : 1, sm, tid);
      continue;
    }
    it -= N_W13;
    if (it < N_W2) {
      const int which = it / 704, r = it % 704;
      const int kt = r / 16, ntl = r % 16;
      tr_tile(sel(which != 0, p.f2_w2, p.f1_w2), D, kt * 64, ntl * 64, D, sel(which != 0, P_W2B, P_W2A), FF, 0, 0, sm, tid);
      continue;
    }
    it -= N_W2;
    if (it < N_WIN) {
      const int kt = it / 40, ntl = it % 40;
      tr_tile(p.w_in, PINW, kt * 64, ntl * 64, PINW, P_WINT, D, 0, 0, sm, tid);
      continue;
    }
    it -= N_WIN;
    {
      const int kt = it / 16, ntl = it % 16;
      tr_tile(p.w_out + (size_t)512 * 1024, D, kt * 64, ntl * 64, D, P_WOUTT, D, 512, 0, sm, tid);
    }
  }
}

template <int MODE>
__device__ __forceinline__ void row_phase(const float* __restrict__ xp, const float* __restrict__ xs, float* __restrict__ xout,
                          const bf16_t* __restrict__ y, bf16_t* __restrict__ h, const float* __restrict__ mod,
                          const float* __restrict__ npost, const float* __restrict__ npre, int gate_idx, float cgate, int shift_idx) {
  const int tid_ = opaque_tid();
  const int lane = tid_ & 63;
  const int gw = blockIdx.x * 8 + (tid_ >> 6), GW = gridDim.x * 8;
  for (int chunk = gw; chunk < NTOK / 16; chunk += GW) {
    const int row0 = chunk * 16;
    int s, t, T;
    row_seq(row0, s, t, T);
    const float* md = mod + s * 9216;
    f32x4 Am[4], Bm[4], Gm[4];
#pragma unroll
    for (int i = 0; i < 4; ++i) {
      const int c = i * 256 + lane * 4;
      if (MODE != 2) {
        f32x4 np = *(const f32x4*)(npre + c), sc = *(const f32x4*)(md + (shift_idx + 1) * 1024 + c);
        Am[i] = np * (sc + 1.f);
        Bm[i] = *(const f32x4*)(md + shift_idx * 1024 + c);
      }
      if (MODE != 0) {
        f32x4 g = *(const f32x4*)(md + gate_idx * 1024 + c), po = *(const f32x4*)(npost + c);
        Gm[i] = g * po * cgate;
      }
    }
    for (int r = 0; r < 16; ++r) {
      const int row = row0 + r;
      const float* xr = (row < NPROMPT) ? xp + (size_t)row * D : xs + (size_t)(row - NPROMPT) * D;
      f32x4 xv[4];
#pragma unroll
      for (int i = 0; i < 4; ++i) xv[i] = *(const f32x4*)(xr + i * 256 + lane * 4);
      if (MODE != 0) {
        f32x4 yv[4];
        float ss = 0.f;
#pragma unroll
        for (int i = 0; i < 4; ++i) {
          uint2 u = *(const uint2*)(y + (size_t)row * D + i * 256 + lane * 4);
          yv[i] = (f32x4){bf_lo(u.x), bf_hi(u.x), bf_lo(u.y), bf_hi(u.y)};
          ss += yv[i][0] * yv[i][0] + yv[i][1] * yv[i][1] + yv[i][2] * yv[i][2] + yv[i][3] * yv[i][3];
        }
        ss = wave_sum(ss);
        const float rs = rsqrtf(ss * (1.f / 1024.f) + 1e-6f);
#pragma unroll
        for (int i = 0; i < 4; ++i) {
          xv[i] = xv[i] + Gm[i] * yv[i] * rs;
          *(f32x4*)(xout + (size_t)row * D + i * 256 + lane * 4) = xv[i];
        }
      }
      if (MODE != 2) {
        float ss = 0.f;
#pragma unroll
        for (int i = 0; i < 4; ++i) ss += xv[i][0] * xv[i][0] + xv[i][1] * xv[i][1] + xv[i][2] * xv[i][2] + xv[i][3] * xv[i][3];
        ss = wave_sum(ss);
        const float rs = rsqrtf(ss * (1.f / 1024.f) + 1e-6f);
#pragma unroll
        for (int i = 0; i < 4; ++i) {
          f32x4 hv = xv[i] * rs * Am[i] + Bm[i];
          uint2 u; u.x = cvt_pk_bf16(hv[0], hv[1]); u.y = cvt_pk_bf16(hv[2], hv[3]);
          *(uint2*)(h + (size_t)row * D + i * 256 + lane * 4) = u;
        }
      }
    }
  }
}

constexpr int BM = 256, BK = 64, HALF = 128, NXCD = 8, WGM = 8, HT = HALF * BK;
__device__ __forceinline__ int lds_byte(int r, int c) {
  int st = (r >> 4) * 2 + (c >> 5), rr = r & 15, cc = c & 31, ob = rr * 64 + cc * 2;
  return st * 1024 + (ob ^ (((ob >> 9) & 1) << 5));
}
__device__ __forceinline__ void stage_rc(int b, int& R, int& C) {
  int st = b / 1024, sb = b % 1024, swz = sb ^ (((sb >> 9) & 1) << 5);
  R = (st >> 1) * 16 + swz / 64; C = (st & 1) * 32 + (swz % 64) / 2;
}

__device__ __forceinline__ void gemm_tile(const bf16_t* __restrict__ A, const bf16_t* __restrict__ Bt, bf16_t* __restrict__ C,
                                          int K, int ldc, int brow, int bcol, LAS bf16_t* shm, const int EPI, const int tid) {
#define SA(b, h) (shm + ((b) * 2 + (h)) * HT)
#define SB(b, h) (shm + (4 + (b) * 2 + (h)) * HT)
#define STAGE(P, BASE, br, kt) do { const char* _gb = (const char*)(BASE) + (((long)(br) * K + (long)(kt) * BK) << 1); \
    _Pragma("unroll") for (int _i = 0; _i < 2; ++_i) { \
      __builtin_amdgcn_global_load_lds((const unsigned*)(_gb + voff[_i]), \
        (LAS unsigned*)((LAS char*)(P) + ldsw + _i * 8192), 16, 0, 0); } } while (0)
#define LDA(dst, b, h) _Pragma("unroll") for (int m = 0; m < 4; ++m) _Pragma("unroll") for (int k = 0; k < 2; ++k) \
    dst[m][k] = *(const LAS bf16x8*)((LAS char*)SA(b, h) + aoff + m * 2048 + k * 1024)
#define LDB(dst, b, h) _Pragma("unroll") for (int n = 0; n < 2; ++n) _Pragma("unroll") for (int k = 0; k < 2; ++k) \
    dst[n][k] = *(const LAS bf16x8*)((LAS char*)SB(b, h) + boff + n * 2048 + k * 1024)
#define MMA(ai, bj, At_, Bt_) do { __builtin_amdgcn_s_setprio(1); \
    _Pragma("unroll") for (int m = 0; m < 4; ++m) _Pragma("unroll") for (int n = 0; n < 2; ++n) _Pragma("unroll") for (int k = 0; k < 2; ++k) \
      acc[ai][bj][m][n] = __builtin_amdgcn_mfma_f32_16x16x32_bf16(Bt_[n][k], At_[m][k], acc[ai][bj][m][n], 0, 0, 0); \
    __builtin_amdgcn_s_setprio(0); } while (0)
#define WAIT_V(n) asm volatile("s_waitcnt vmcnt(" #n ")" ::: "memory")
#define WAIT_L(n) asm volatile("s_waitcnt lgkmcnt(" #n ")" ::: "memory")
#define BAR __builtin_amdgcn_s_barrier()
#define SCHED __builtin_amdgcn_sched_barrier(0)
  const int wid = __builtin_amdgcn_readfirstlane(tid >> 6), lane = tid & 63, wr = wid >> 2, wc = wid & 3, fr = lane & 15, fq = lane >> 4;
  const int aoff = lds_byte(wr * 64 + fr, fq * 8), boff = lds_byte(wc * 32 + fr, fq * 8);
  f32x4 acc[2][2][4][2] = {};
  bf16x8 At[4][2], B0[2][2], B1[2][2];
  unsigned voff[2];
  const int ldsw = wid * 1024;
#pragma unroll
  for (int _i = 0; _i < 2; ++_i) { int _r, _c; stage_rc(tid * 16 + _i * 8192, _r, _c); voff[_i] = (unsigned)(_r * K + _c) * 2u; }
  const int nt = K / BK;
  STAGE(SB(0, 0), Bt, bcol, 0); STAGE(SA(0, 0), A, brow, 0);
  STAGE(SB(0, 1), Bt, bcol + HALF, 0); STAGE(SA(0, 1), A, brow + HALF, 0);
  if (wr == 1) BAR;
  WAIT_V(4); BAR;
  STAGE(SB(1, 0), Bt, bcol, 1); STAGE(SA(1, 0), A, brow, 1); STAGE(SB(1, 1), Bt, bcol + HALF, 1);
  WAIT_V(6); BAR;
  for (int t = 0; t < nt - 2; t += 2) {
    LDB(B0, 0, 0); SCHED; LDA(At, 0, 0); STAGE(SA(1, 1), A, brow + HALF, t + 1);
    WAIT_L(8); BAR; WAIT_L(0); MMA(0, 0, At, B0); BAR; SCHED;
    LDB(B1, 0, 1); STAGE(SB(0, 0), Bt, bcol, t + 2);
    BAR; WAIT_L(0); MMA(0, 1, At, B1); BAR;
    LDA(At, 0, 1); STAGE(SA(0, 0), A, brow, t + 2);
    BAR; WAIT_L(0); MMA(1, 0, At, B0); BAR; SCHED;
    STAGE(SB(0, 1), Bt, bcol + HALF, t + 2);
    WAIT_V(6); BAR; MMA(1, 1, At, B1); BAR;
    LDB(B0, 1, 0); SCHED; LDA(At, 1, 0); STAGE(SA(0, 1), A, brow + HALF, t + 2);
    WAIT_L(8); BAR; WAIT_L(0); MMA(0, 0, At, B0); BAR; SCHED;
    LDB(B1, 1, 1); STAGE(SB(1, 0), Bt, bcol, t + 3);
    BAR; WAIT_L(0); MMA(0, 1, At, B1); BAR;
    LDA(At, 1, 1); STAGE(SA(1, 0), A, brow, t + 3);
    BAR; WAIT_L(0); MMA(1, 0, At, B0); BAR; SCHED;
    STAGE(SB(1, 1), Bt, bcol + HALF, t + 3);
    WAIT_V(6); BAR; MMA(1, 1, At, B1); BAR;
  }
  { LDB(B0, 0, 0); LDA(At, 0, 0); STAGE(SA(1, 1), A, brow + HALF, nt - 1);
    BAR; WAIT_L(0); MMA(0, 0, At, B0); BAR;
    LDB(B1, 0, 1); BAR; WAIT_L(0); MMA(0, 1, At, B1); BAR;
    LDA(At, 0, 1); WAIT_V(4); BAR; WAIT_L(0); MMA(1, 0, At, B0); MMA(1, 1, At, B1); BAR; }
  { LDB(B0, 1, 0); LDA(At, 1, 0); WAIT_V(2); BAR; WAIT_L(0); MMA(0, 0, At, B0); BAR;
    LDB(B1, 1, 1); WAIT_V(0); BAR; WAIT_L(0); MMA(0, 1, At, B1); BAR;
    LDA(At, 1, 1); BAR; WAIT_L(0); MMA(1, 0, At, B0); MMA(1, 1, At, B1); BAR; }
  if (wr == 0) BAR;
#pragma unroll
  for (int ai = 0; ai < 2; ++ai)
#pragma unroll
    for (int m = 0; m < 4; ++m) {
      const size_t row = (size_t)(brow + ai * HALF + wr * 64 + m * 16 + fr);
#pragma unroll
      for (int bj = 0; bj < 2; ++bj) {
        if (EPI == 0) {
#pragma unroll
          for (int n = 0; n < 2; ++n) {
            const f32x4 v = acc[ai][bj][m][n];
            uint2 u; u.x = cvt_pk_bf16(v[0], v[1]); u.y = cvt_pk_bf16(v[2], v[3]);
            *(uint2*)(C + row * ldc + bcol + bj * HALF + wc * 32 + n * 16 + fq * 4) = u;
          }
        } else {
          const f32x4 a = acc[ai][bj][m][0], b = acc[ai][bj][m][1];
          float o[4];
#pragma unroll
          for (int j = 0; j < 4; ++j) o[j] = a[j] * __builtin_amdgcn_rcpf(1.f + __expf(-a[j])) * b[j];
          uint2 u; u.x = cvt_pk_bf16(o[0], o[1]); u.y = cvt_pk_bf16(o[2], o[3]);
          *(uint2*)(C + row * ldc + ((bcol + bj * HALF + wc * 32) >> 1) + fq * 4) = u;
        }
      }
    }
#undef SA
#undef SB
#undef STAGE
#undef LDA
#undef LDB
#undef MMA
}

__device__ __forceinline__ void gemm_phase(const bf16_t* A, const bf16_t* Bt, bf16_t* C, int M, int N, int K, int ldc, int EPI, char* smem) {
  const int nM = M / BM, nN = N / BM, nwg = nM * nN;
  const int tid = opaque_tid();
  for (int L = blockIdx.x; L < nwg; L += gridDim.x) {
    int wgid = L;
    { int q = nwg / NXCD, r = nwg % NXCD, xcd = wgid % NXCD, off = wgid / NXCD;
      wgid = (xcd < r ? xcd * (q + 1) : r * (q + 1) + (xcd - r) * q) + off; }
    const int nig = WGM * nN, gid = wgid / nig, fm = gid * WGM, gsz = min(nM - fm, WGM);
    const int pm = fm + ((wgid % nig) % gsz), pn = (wgid % nig) / gsz;
    gemm_tile(A, Bt, C, K, ldc, pm * BM, pn * BM, (LAS bf16_t*)smem, EPI, tid);
    asm volatile("s_waitcnt vmcnt(0)" ::: "memory");
    __syncthreads();
  }
}

__device__ __forceinline__ void load_shift16(const bf16_t* __restrict__ z, int row, int t, int T, int col, const float* __restrict__ mu, float* o) {
  const bf16_t* pz = z + (size_t)row * ZLD + col;
  uint4 c0 = *(const uint4*)pz, c1 = *(const uint4*)(pz + 8);
  uint4 p0 = make_uint4(0, 0, 0, 0), p1 = p0, n0 = p0, n1 = p0;
  if (t > 0) { p0 = *(const uint4*)(pz - ZLD); p1 = *(const uint4*)(pz - ZLD + 8); }
  if (t < T - 1) { n0 = *(const uint4*)(pz + ZLD); n1 = *(const uint4*)(pz + ZLD + 8); }
  float c[16], pv[16], nx[16];
  unpack8(c0, c); unpack8(c1, c + 8); unpack8(p0, pv); unpack8(p1, pv + 8); unpack8(n0, nx); unpack8(n1, nx + 8);
#pragma unroll
  for (int q = 0; q < 16; ++q) o[q] = c[q] + (0.5f * (pv[q] + nx[q]) - c[q]) * mu[col - 512 + q];
}
__device__ __forceinline__ void load_shift8(const bf16_t* __restrict__ z, int row, int t, int T, int col, const float* __restrict__ mu, float* o) {
  const bf16_t* pz = z + (size_t)row * ZLD + col;
  uint4 c0 = *(const uint4*)pz;
  uint4 p0 = make_uint4(0, 0, 0, 0), n0 = p0;
  if (t > 0) p0 = *(const uint4*)(pz - ZLD);
  if (t < T - 1) n0 = *(const uint4*)(pz + ZLD);
  float c[8], pv[8], nx[8];
  unpack8(c0, c); unpack8(p0, pv); unpack8(n0, nx);
#pragma unroll
  for (int q = 0; q < 8; ++q) o[q] = c[q] + (0.5f * (pv[q] + nx[q]) - c[q]) * mu[col - 512 + q];
}

constexpr int TC = 32;
constexpr int SV = TC * 64;
__device__ __forceinline__ void scan_phase(const Params& p, char* smem) {
  float* stepbuf = (float*)smem;
  float* ybuf = stepbuf + 2 * 6 * SV;
  char* hpriv = (char*)(ybuf + 2 * SV);
  const bf16_t* z = P_RU;
  bf16_t* ydir = P_RY;
  const int tid_ = opaque_tid();
  const int wave = tid_ >> 6, lane = tid_ & 63;
  const int item = blockIdx.x;
  if (item < 256) {
    const int s = item < 128 ? 8 + (item >> 4) : ((item - 128) >> 4);
    const int h = (item & 15) >> 1, d = item & 1;
    const int T = s < 8 ? 4096 : 8192, r0seq = seq_start(s), nch = T / TC;
    bf16_t* yout = ydir + (size_t)d * NTOK * 512;

    if (wave >= 4) {
      const int hw = wave - 4, th = hw & 1, task = hw >> 1;
      const int tl = lane >> 2, cq = lane & 3, fr = lane & 15, fq = lane >> 4;
      bf16_t* Ab = (bf16_t*)(hpriv + hw * 8192);
      float* tmpa = (float*)(hpriv + hw * 8192 + 2560);
      const float* lsrc = sel(task != 0, p.a2, p.w2) + (size_t)d * 64 * 512 + h * 64;
      bf16x8 Bl[4][2];
#pragma unroll
      for (int nt = 0; nt < 4; ++nt)
#pragma unroll
        for (int ks = 0; ks < 2; ++ks) {
          float o[8];
#pragma unroll
          for (int q = 0; q < 8; ++q) o[q] = lsrc[(size_t)(ks * 32 + fq * 8 + q) * 512 + nt * 16 + fr];
          uint4 u = pack8(o);
          Bl[nt][ks] = *reinterpret_cast<bf16x8*>(&u);
        }
      float bias[4];
#pragma unroll
      for (int nt = 0; nt < 4; ++nt) bias[nt] = sel(task != 0, p.a0, p.w0)[d * 512 + h * 64 + nt * 16 + fr];
      const int hyl = (wave - 4) * 64 + lane;

      for (int c = -1; c < nch; ++c) {
        if (c + 1 < nch) {
          const float *mu = p.shift_mu, *kkp = p.k_k + h * 64, *kap = p.k_a + h * 64, *rkp = p.r_k + h * 64;
          asm volatile("" : "+v"(mu), "+v"(kkp), "+v"(kap), "+v"(rkp));
          float* sb = stepbuf + ((c + 1) & 1) * 6 * SV;
          const int j = th * 16 + tl;
          const int istep = (c + 1) * TC + j;
          const int t = d ? T - 1 - istep : istep;
          const int row = r0seq + t;
          float v16[16];
          load_shift16(z, row, t, T, (task ? 2176 : 2048) + d * 64 + cq * 16, mu, v16);
          if (!task) {
#pragma unroll
            for (int q = 0; q < 16; ++q) { const float e = __expf(2.f * v16[q]); v16[q] = 1.f - 2.f * __builtin_amdgcn_rcpf(e + 1.f); }
          }
          *(uint4*)(Ab + tl * 72 + cq * 16) = pack8(v16);
          *(uint4*)(Ab + tl * 72 + cq * 16 + 8) = pack8(v16 + 8);
          __builtin_amdgcn_wave_barrier();
          f32x4 acc[4] = {};
#pragma unroll
          for (int ks = 0; ks < 2; ++ks) {
            const bf16x8 a = *reinterpret_cast<const bf16x8*>(Ab + fr * 72 + ks * 32 + fq * 8);
#pragma unroll
            for (int nt = 0; nt < 4; ++nt) acc[nt] = __builtin_amdgcn_mfma_f32_16x16x32_bf16(a, Bl[nt][ks], acc[nt], 0, 0, 0);
          }
          if (!task) {
#pragma unroll
            for (int nt = 0; nt < 4; ++nt)
#pragma unroll
              for (int jj = 0; jj < 4; ++jj) {
                const float sg = sigmoidf_(bias[nt] + acc[nt][jj]);
                sb[0 * SV + (th * 16 + fq * 4 + jj) * 64 + nt * 16 + fr] = __expf(-0.6065306597126334f * sg);
              }
            load_shift16(z, row, t, T, 512 + h * 64 + cq * 16, mu, v16);
#pragma unroll
            for (int q = 0; q < 4; ++q) *(f32x4*)(sb + 2 * SV + j * 64 + cq * 16 + q * 4) = (f32x4){v16[q * 4], v16[q * 4 + 1], v16[q * 4 + 2], v16[q * 4 + 3]};
            load_shift16(z, row, t, T, 1536 + h * 64 + cq * 16, mu, v16);
#pragma unroll
            for (int q = 0; q < 4; ++q) *(f32x4*)(sb + 5 * SV + j * 64 + cq * 16 + q * 4) = (f32x4){v16[q * 4], v16[q * 4 + 1], v16[q * 4 + 2], v16[q * 4 + 3]};
          } else {
#pragma unroll
            for (int nt = 0; nt < 4; ++nt)
#pragma unroll
              for (int jj = 0; jj < 4; ++jj) tmpa[(fq * 4 + jj) * 68 + nt * 16 + fr] = sigmoidf_(bias[nt] + acc[nt][jj]);
            __builtin_amdgcn_wave_barrier();
            float av[16], kd[16];
#pragma unroll
            for (int q = 0; q < 4; ++q) { f32x4 a4 = *(const f32x4*)(tmpa + tl * 68 + cq * 16 + q * 4); av[q * 4] = a4[0]; av[q * 4 + 1] = a4[1]; av[q * 4 + 2] = a4[2]; av[q * 4 + 3] = a4[3]; }
            load_shift16(z, row, t, T, 1024 + h * 64 + cq * 16, mu, v16);
            float kk[16], ss = 0.f;
#pragma unroll
            for (int q = 0; q < 16; ++q) { kk[q] = v16[q] * kkp[cq * 16 + q]; ss += kk[q] * kk[q]; }
            ss += __shfl_xor(ss, 1); ss += __shfl_xor(ss, 2);
            const float inv = 1.f / fmaxf(sqrtf(ss), 1e-12f);
#pragma unroll
            for (int q = 0; q < 16; ++q) { kk[q] *= inv; kd[q] = v16[q] * (1.f + (av[q] - 1.f) * kap[cq * 16 + q]); }
#pragma unroll
            for (int q = 0; q < 4; ++q) {
              *(f32x4*)(sb + 3 * SV + j * 64 + cq * 16 + q * 4) = (f32x4){-kk[q * 4], -kk[q * 4 + 1], -kk[q * 4 + 2], -kk[q * 4 + 3]};
              *(f32x4*)(sb + 4 * SV + j * 64 + cq * 16 + q * 4) = (f32x4){kk[q * 4] * av[q * 4], kk[q * 4 + 1] * av[q * 4 + 1], kk[q * 4 + 2] * av[q * 4 + 2], kk[q * 4 + 3] * av[q * 4 + 3]};
              *(f32x4*)(sb + 1 * SV + j * 64 + cq * 16 + q * 4) = (f32x4){kd[q * 4], kd[q * 4 + 1], kd[q * 4 + 2], kd[q * 4 + 3]};
            }
            load_shift16(z, row, t, T, 512 + h * 64 + cq * 16, mu, v16);
            float bs = 0.f;
#pragma unroll
            for (int q = 0; q < 16; ++q) bs += v16[q] * kd[q] * rkp[cq * 16 + q];
            bs += __shfl_xor(bs, 1); bs += __shfl_xor(bs, 2);
            if (cq == 0) P_SBON[((size_t)row * 8 + h) * 2 + d] = bs;
          }
        }
        if (c >= 1) {
          const float* yb = ybuf + ((c - 1) & 1) * SV;
          const int j = hyl >> 3, oc = hyl & 7;
          const int istep = (c - 1) * TC + j;
          const int t = d ? T - 1 - istep : istep;
          float o[8];
          f32x4 a = *(const f32x4*)(yb + j * 64 + oc * 8), b = *(const f32x4*)(yb + j * 64 + oc * 8 + 4);
          o[0] = a[0]; o[1] = a[1]; o[2] = a[2]; o[3] = a[3]; o[4] = b[0]; o[5] = b[1]; o[6] = b[2]; o[7] = b[3];
          *(uint4*)(yout + (size_t)(r0seq + t) * 512 + h * 64 + oc * 8) = pack8(o);
        }
        __syncthreads();
      }
      {
        const float* yb = ybuf + ((nch - 1) & 1) * SV;
        const int j = hyl >> 3, oc = hyl & 7;
        const int istep = (nch - 1) * TC + j;
        const int t = d ? T - 1 - istep : istep;
        float o[8];
        f32x4 a = *(const f32x4*)(yb + j * 64 + oc * 8), b = *(const f32x4*)(yb + j * 64 + oc * 8 + 4);
        o[0] = a[0]; o[1] = a[1]; o[2] = a[2]; o[3] = a[3]; o[4] = b[0]; o[5] = b[1]; o[6] = b[2]; o[7] = b[3];
        *(uint4*)(yout + (size_t)(r0seq + t) * 512 + h * 64 + oc * 8) = pack8(o);
      }
      __syncthreads();
    } else {
      const int kseg = lane & 15, rg = lane >> 4, rb = wave * 16 + rg * 4;
      f32x4 S0 = {0.f, 0.f, 0.f, 0.f}, S1 = S0, S2 = S0, S3 = S0;
      __syncthreads();
      for (int c = 0; c < nch; ++c) {
        const float* sb = stepbuf + (c & 1) * 6 * SV;
        float* yb = ybuf + (c & 1) * SV;
#pragma unroll 2
        for (int j = 0; j < TC; ++j) {
          const f32x4 w4 = *(const f32x4*)(sb + 0 * SV + j * 64 + kseg * 4);
          const f32x4 kd4 = *(const f32x4*)(sb + 1 * SV + j * 64 + kseg * 4);
          const f32x4 r4 = *(const f32x4*)(sb + 2 * SV + j * 64 + kseg * 4);
          const f32x4 na4 = *(const f32x4*)(sb + 3 * SV + j * 64 + kseg * 4);
          const f32x4 b4 = *(const f32x4*)(sb + 4 * SV + j * 64 + kseg * 4);
          const f32x4 v4 = *(const f32x4*)(sb + 5 * SV + j * 64 + rb);
          f32x4 t0 = S0 * na4, t1 = S1 * na4, t2 = S2 * na4, t3 = S3 * na4;
          float sa0 = (t0[0] + t0[1]) + (t0[2] + t0[3]), sa1 = (t1[0] + t1[1]) + (t1[2] + t1[3]);
          float sa2 = (t2[0] + t2[1]) + (t2[2] + t2[3]), sa3 = (t3[0] + t3[1]) + (t3[2] + t3[3]);
          sa0 = row16_sum(sa0); sa1 = row16_sum(sa1); sa2 = row16_sum(sa2); sa3 = row16_sum(sa3);
          S0 = S0 * w4 + b4 * sa0 + kd4 * v4[0];
          S1 = S1 * w4 + b4 * sa1 + kd4 * v4[1];
          S2 = S2 * w4 + b4 * sa2 + kd4 * v4[2];
          S3 = S3 * w4 + b4 * sa3 + kd4 * v4[3];
          t0 = S0 * r4; t1 = S1 * r4; t2 = S2 * r4; t3 = S3 * r4;
          float y0 = (t0[0] + t0[1]) + (t0[2] + t0[3]), y1 = (t1[0] + t1[1]) + (t1[2] + t1[3]);
          float y2 = (t2[0] + t2[1]) + (t2[2] + t2[3]), y3 = (t3[0] + t3[1]) + (t3[2] + t3[3]);
          y0 = row16_sum(y0); y1 = row16_sum(y1); y2 = row16_sum(y2); y3 = row16_sum(y3);
          const float yv = kseg == 0 ? y0 : kseg == 1 ? y1 : kseg == 2 ? y2 : y3;
          if (kseg < 4) yb[j * 64 + rb + kseg] = yv;
        }
        __syncthreads();
      }
      __syncthreads();
    }
  }
}

__device__ __forceinline__ void post_phase(const Params& p, char* smem) {
  bf16_t* Ag = (bf16_t*)smem;
  bf16_t* vt = (bf16_t*)(smem + 12800);
  float* ys = (float*)(smem + 12800 + 33280);
  const bf16_t* z = P_RU;
  const bf16_t* yf = P_RY;
  const bf16_t* ybk = P_RY + (size_t)NTOK * 512;
  bf16_t* mo = P_RH;
  const int tid = opaque_tid(), w = tid >> 6, lane = tid & 63, fr = lane & 15, fq = lane >> 4;
  bf16x8 Bg[4][6];
#pragma unroll
  for (int nt = 0; nt < 4; ++nt)
#pragma unroll
    for (int ks = 0; ks < 6; ++ks) {
      float o[8];
#pragma unroll
      for (int q = 0; q < 8; ++q) { const int k = ks * 32 + fq * 8 + q; o[q] = k < 160 ? p.g2[(size_t)k * 512 + w * 64 + nt * 16 + fr] : 0.f; }
      uint4 u = pack8(o);
      Bg[nt][ks] = *reinterpret_cast<bf16x8*>(&u);
    }
  float lng[4], lnb[4];
#pragma unroll
  for (int nt = 0; nt < 4; ++nt) { lng[nt] = p.lnx_g[w * 64 + nt * 16 + fr]; lnb[nt] = p.lnx_b[w * 64 + nt * 16 + fr]; }

  for (int tile = blockIdx.x; tile < NTOK / 32; tile += gridDim.x) {
    const int row0 = tile * 32;
    int s, t0, T;
    row_seq(row0, s, t0, T);
    for (int idx = tid; idx < 32 * 24; idx += NTHR) {
      const int tok = idx / 24, oc = idx % 24;
      float o[8];
      if (oc < 20) {
        load_shift8(z, row0 + tok, t0 + tok, T, 2304 + oc * 8, p.shift_mu, o);
#pragma unroll
        for (int q = 0; q < 8; ++q) o[q] = sigmoidf_(o[q]);
      } else {
#pragma unroll
        for (int q = 0; q < 8; ++q) o[q] = 0.f;
      }
      *(uint4*)(Ag + tok * 200 + oc * 8) = pack8(o);
    }
    for (int idx = tid; idx < 32 * 64; idx += NTHR) {
      const int tok = idx >> 6, oc = idx & 63, row = row0 + tok, t = t0 + tok;
      float o[8];
      load_shift8(z, row, t, T, 1536 + oc * 8, p.shift_mu, o);
      *(uint4*)(vt + tok * 520 + oc * 8) = pack8(o);
      float a[8], b[8];
      unpack8(*(const uint4*)(yf + (size_t)row * 512 + oc * 8), a);
      unpack8(*(const uint4*)(ybk + (size_t)row * 512 + oc * 8), b);
      *(f32x4*)(ys + tok * 516 + oc * 8) = (f32x4){a[0] + b[0], a[1] + b[1], a[2] + b[2], a[3] + b[3]};
      *(f32x4*)(ys + tok * 516 + oc * 8 + 4) = (f32x4){a[4] + b[4], a[5] + b[5], a[6] + b[6], a[7] + b[7]};
      const int c0 = oc * 8, half = 1 << (c0 >> 7);
      const int lo = max(t - half, 0), hi = min(t + half, T);
      float sum[8];
#pragma unroll
      for (int q = 0; q < 8; ++q) sum[q] = 0.f;
      for (int tt = lo; tt < hi; ++tt) {
        float zz[8];
        unpack8(*(const uint4*)(z + (size_t)(row + tt - t) * ZLD + c0), zz);
#pragma unroll
        for (int q = 0; q < 8; ++q) sum[q] += zz[q];
      }
      float zc[8];
      unpack8(*(const uint4*)(z + (size_t)row * ZLD + c0), zc);
      const float ic = 1.f / (float)(hi - lo);
#pragma unroll
      for (int q = 0; q < 8; ++q) sum[q] = sum[q] * ic - zc[q];
      *(uint4*)(mo + (size_t)row * D + c0) = pack8(sum);
    }
    __syncthreads();
    f32x4 acc[2][4] = {};
#pragma unroll
    for (int ks = 0; ks < 6; ++ks) {
      bf16x8 a[2];
#pragma unroll
      for (int mt = 0; mt < 2; ++mt) a[mt] = *reinterpret_cast<const bf16x8*>(Ag + (mt * 16 + fr) * 200 + ks * 32 + fq * 8);
#pragma unroll
      for (int mt = 0; mt < 2; ++mt)
#pragma unroll
        for (int nt = 0; nt < 4; ++nt) acc[mt][nt] = __builtin_amdgcn_mfma_f32_16x16x32_bf16(a[mt], Bg[nt][ks], acc[mt][nt], 0, 0, 0);
    }
#pragma unroll
    for (int mt = 0; mt < 2; ++mt)
#pragma unroll
      for (int jj = 0; jj < 4; ++jj) {
        const int tok = mt * 16 + fq * 4 + jj, row = row0 + tok;
        float yv[4], sm_ = 0.f;
#pragma unroll
        for (int nt = 0; nt < 4; ++nt) { yv[nt] = ys[tok * 516 + w * 64 + nt * 16 + fr]; sm_ += yv[nt]; }
        const float mean = row16_sum(sm_) * (1.f / 64.f);
        float vs = 0.f;
#pragma unroll
        for (int nt = 0; nt < 4; ++nt) { yv[nt] -= mean; vs += yv[nt] * yv[nt]; }
        const float rs = rsqrtf(row16_sum(vs) * (1.f / 64.f) + 64e-5f);
        const float2 sb2 = *(const float2*)(P_SBON + ((size_t)row * 8 + w) * 2);
        const float sbs = sb2.x + sb2.y;
#pragma unroll
        for (int nt = 0; nt < 4; ++nt) {
          const float vv = bf2f(vt[tok * 520 + w * 64 + nt * 16 + fr]);
          const float o = (yv[nt] * rs * lng[nt] + lnb[nt] + sbs * vv) * acc[mt][nt][jj];
          mo[(size_t)row * D + 512 + w * 64 + nt * 16 + fr] = (bf16_t)(cvt_pk_bf16(o, 0.f) & 0xffff);
        }
      }
    __syncthreads();
  }
}

constexpr int NPHASE = 13;
__device__ __forceinline__ void do_phase(const Params& p, int ph, char* smem) {
  if (ph == 0) prep_phase(p, smem);
  else if (ph == 1) row_phase<0>(p.x_prompt, p.x_sample, nullptr, nullptr, P_RH, P_MOD, nullptr, p.n1_pre, 0, 0.f, 0);
  else if (ph == 4 || ph == 9) {
    const bool f = ph == 4;
    float* outp = p.out;
    row_phase<1>(sel(f, p.x_prompt, (const float*)outp), sel(f, p.x_sample, (const float*)(outp + (size_t)NPROMPT * D)), outp, P_RY, P_RH, P_MOD,
                 sel(f, p.n1_post, p.nm_post), sel(f, p.nm_pre, p.n2_pre), f ? 2 : 5, f ? 0.5f : 1.0f, f ? 3 : 6);
  }
  else if (ph == 12) row_phase<2>(p.out, p.out + (size_t)NPROMPT * D, p.out, P_RY, nullptr, P_MOD, p.n2_post, nullptr, 8, 0.5f, 0);
  else if (ph == 6) scan_phase(p, smem);
  else if (ph == 7) post_phase(p, smem);
  else {
    const bf16_t *A, *Bt; bf16_t* C; int N, K, ldc, epi;
    if (ph == 2 || ph == 10) { A = P_RH; Bt = sel(ph == 2, P_W13A, P_W13B); C = P_RU; N = 2 * FF; K = D; ldc = FF; epi = 1; }
    else if (ph == 3 || ph == 11) { A = P_RU; Bt = sel(ph == 3, P_W2A, P_W2B); C = P_RY; N = D; K = FF; ldc = D; epi = 0; }
    else if (ph == 5) { A = P_RH; Bt = P_WINT; C = P_RU; N = ZLD; K = D; ldc = ZLD; epi = 0; }
    else { A = P_RH; Bt = P_WOUTT; C = P_RY; N = D; K = D; ldc = D; epi = 0; }
    gemm_phase(A, Bt, C, NTOK, N, K, ldc, epi, smem);
  }
}

extern __shared__ __attribute__((aligned(16))) char dyn_smem[];

__global__ void __launch_bounds__(NTHR, 2) mega_kernel(Params p) {
  cg::grid_group grid = cg::this_grid();
#pragma unroll 1
  for (int ph = 0; ph < NPHASE; ++ph) {
    do_phase(p, ph, dyn_smem);
    if (ph + 1 < NPHASE) grid.sync();
  }
}

__global__ void __launch_bounds__(NTHR, 2) phase_kernel(Params p, int ph) { do_phase(p, ph, dyn_smem); }

extern "C" void kernel_launch(void* const* d_in, const int* in_sizes, int n_in, void* d_out, int out_size, void* d_ws, size_t ws_size,
                              hipStream_t stream) {
  Params p{};
  const float** f = (const float**)&p;
  for (int i = 0; i < 33; ++i) f[i] = (const float*)d_in[i];
  p.out = (float*)d_out;
  p.ws = (char*)d_ws;
  if (WS_NEED > ws_size) { fprintf(stderr, "workspace too small: need %zu have %zu\n", (size_t)WS_NEED, ws_size); return; }

#if ONE_LAUNCH
  static int grid_blocks = 0;
  if (!grid_blocks) {
    int dev = 0, cus = 0, per_cu = 0;
    (void)hipGetDevice(&dev);
    (void)hipDeviceGetAttribute(&cus, hipDeviceAttributeMultiprocessorCount, dev);
    (void)hipFuncSetAttribute((const void*)mega_kernel, hipFuncAttributeMaxDynamicSharedMemorySize, SMEM_BYTES);
    (void)hipOccupancyMaxActiveBlocksPerMultiprocessor(&per_cu, mega_kernel, NTHR, SMEM_BYTES);
    if (per_cu < 1) per_cu = 1;
    grid_blocks = cus * per_cu;
  }
  void* args[] = {&p};
  hipError_t e = hipLaunchCooperativeKernel((const void*)mega_kernel, dim3(grid_blocks), dim3(NTHR), args, SMEM_BYTES, stream);
  if (e != hipSuccess) fprintf(stderr, "cooperative launch failed: %s (grid %d)\n", hipGetErrorString(e), grid_blocks);
#else
  static bool attr = false;
  if (!attr) { (void)hipFuncSetAttribute((const void*)phase_kernel, hipFuncAttributeMaxDynamicSharedMemorySize, SMEM_BYTES); attr = true; }
  for (int ph = 0; ph < NPHASE; ++ph) phase_kernel<<<256, NTHR, SMEM_BYTES, stream>>>(p, ph);
#endif
}
```

```cpp
#include <hip/hip_runtime.h>
#include <hip/hip_cooperative_groups.h>
#include <cstdio>
namespace cg = cooperative_groups;

#ifndef ONE_LAUNCH
#define ONE_LAUNCH 1
#endif

typedef unsigned short bf16_t;
typedef short bf16x8 __attribute__((ext_vector_type(8)));
typedef float f32x4 __attribute__((ext_vector_type(4)));
typedef float f32x2 __attribute__((ext_vector_type(2)));
#define LAS __attribute__((address_space(3)))

constexpr int D = 1024, FF = 2816, NTOK = 98304, NPROMPT = 32768, ZLD = 2560, PINW = 2464;
constexpr int NTHR = 512;
constexpr int SMEM_BYTES = 162048;

struct Params {
  const float *x_prompt, *x_sample, *c_prompt, *c_sample, *ada_w, *ada_b, *n1_pre, *n1_post, *f1_w1, *f1_w3, *f1_w2,
      *nm_pre, *nm_post, *w_in, *shift_mu, *pool_w, *pool_scale, *w0, *w2, *a0, *a2, *g2, *k_k, *k_a, *r_k, *lnx_g, *lnx_b,
      *w_out, *n2_pre, *n2_post, *f2_w1, *f2_w3, *f2_w2;
  float* out;
  char* ws;
};
constexpr size_t al256(size_t b) { return (b + 255) & ~(size_t)255; }
constexpr size_t OFF_W13A = 0;
constexpr size_t OFF_W13B = OFF_W13A + al256((size_t)2 * FF * D * 2);
constexpr size_t OFF_W2A = OFF_W13B + al256((size_t)2 * FF * D * 2);
constexpr size_t OFF_W2B = OFF_W2A + al256((size_t)D * FF * 2);
constexpr size_t OFF_WINT = OFF_W2B + al256((size_t)D * FF * 2);
constexpr size_t OFF_WOUTT = OFF_WINT + al256((size_t)ZLD * D * 2);
constexpr size_t OFF_MOD = OFF_WOUTT + al256((size_t)D * D * 2);
constexpr size_t OFF_SBON = OFF_MOD + al256((size_t)16 * 9216 * 4);
constexpr size_t OFF_RH = OFF_SBON + al256((size_t)NTOK * 16 * 4);
constexpr size_t OFF_RY = OFF_RH + al256((size_t)NTOK * D * 2);
constexpr size_t OFF_RU = OFF_RY + al256((size_t)NTOK * D * 2);
constexpr size_t WS_NEED = OFF_RU + al256((size_t)NTOK * FF * 2);
#define P_W13A ((bf16_t*)(p.ws + OFF_W13A))
#define P_W13B ((bf16_t*)(p.ws + OFF_W13B))
#define P_W2A ((bf16_t*)(p.ws + OFF_W2A))
#define P_W2B ((bf16_t*)(p.ws + OFF_W2B))
#define P_WINT ((bf16_t*)(p.ws + OFF_WINT))
#define P_WOUTT ((bf16_t*)(p.ws + OFF_WOUTT))
#define P_MOD ((float*)(p.ws + OFF_MOD))
#define P_SBON ((float*)(p.ws + OFF_SBON))
#define P_RH ((bf16_t*)(p.ws + OFF_RH))
#define P_RY ((bf16_t*)(p.ws + OFF_RY))
#define P_RU ((bf16_t*)(p.ws + OFF_RU))

typedef __bf16 bf16x2_t __attribute__((ext_vector_type(2)));
__device__ __forceinline__ unsigned cvt_pk_bf16(float lo, float hi) {
  f32x2 v = {lo, hi};
  bf16x2_t b = __builtin_convertvector(v, bf16x2_t);
  return __builtin_bit_cast(unsigned, b);
}
__device__ __forceinline__ float bf_lo(unsigned u) { return __uint_as_float(u << 16); }
__device__ __forceinline__ float bf_hi(unsigned u) { return __uint_as_float(u & 0xffff0000u); }
__device__ __forceinline__ float bf2f(bf16_t b) { return __uint_as_float(((unsigned)b) << 16); }
__device__ __forceinline__ void unpack8(uint4 v, float* o) {
  o[0] = bf_lo(v.x); o[1] = bf_hi(v.x); o[2] = bf_lo(v.y); o[3] = bf_hi(v.y);
  o[4] = bf_lo(v.z); o[5] = bf_hi(v.z); o[6] = bf_lo(v.w); o[7] = bf_hi(v.w);
}
__device__ __forceinline__ uint4 pack8(const float* o) {
  uint4 v; v.x = cvt_pk_bf16(o[0], o[1]); v.y = cvt_pk_bf16(o[2], o[3]); v.z = cvt_pk_bf16(o[4], o[5]); v.w = cvt_pk_bf16(o[6], o[7]);
  return v;
}
__device__ __forceinline__ float sigmoidf_(float x) { return __builtin_amdgcn_rcpf(1.f + __expf(-x)); }
__device__ __forceinline__ float wave_sum(float v) {
#pragma unroll
  for (int o = 32; o > 0; o >>= 1) v += __shfl_xor(v, o);
  return v;
}
template <int CTRL> __device__ __forceinline__ float dpp_f(float x) {
  return __int_as_float(__builtin_amdgcn_update_dpp(0, __float_as_int(x), CTRL, 0xf, 0xf, false));
}
__device__ __forceinline__ float row16_sum(float x) {
  x += dpp_f<0x128>(x); x += dpp_f<0x124>(x); x += dpp_f<0x122>(x); x += dpp_f<0x121>(x);
  return x;
}
template <class T> __device__ __forceinline__ T sel(bool c, T a, T b) { return c ? a : b; }
__device__ __forceinline__ int opaque_tid_w(int wid) {
  int l;
  asm volatile("v_mbcnt_lo_u32_b32 %0, -1, 0\n\tv_mbcnt_hi_u32_b32 %0, -1, %0" : "=v"(l));
  return wid * 64 + l;
}
#define opaque_tid() opaque_tid_w(wid_u)
__device__ __forceinline__ int seq_start(int s) { return s < 8 ? s * 4096 : NPROMPT + (s - 8) * 8192; }
__device__ __forceinline__ void row_seq(int row, int& s, int& t, int& T) {
  if (row < NPROMPT) { s = row >> 12; t = row & 4095; T = 4096; }
  else { int r = row - NPROMPT; s = 8 + (r >> 13); t = r & 8191; T = 8192; }
}

__device__ __forceinline__ void tr_tile(const float* __restrict__ src, int ldsrc, int k0, int n0, int nvalid, bf16_t* __restrict__ dst, int ldd,
                        int kdst0, int mode, float* sm, const int tid) {
#pragma unroll
  for (int i = 0; i < 2; ++i) {
    const int r = (tid >> 4) + 32 * i, c = (tid & 15) * 4;
    float4 v = make_float4(0.f, 0.f, 0.f, 0.f);
    if (n0 + c < nvalid) v = *(const float4*)(src + (size_t)(k0 + r) * ldsrc + n0 + c);
    float* d = sm + r * 65 + c;
    d[0] = v.x; d[1] = v.y; d[2] = v.z; d[3] = v.w;
  }
  __syncthreads();
  {
    const int n = tid >> 3, kc = (tid & 7) * 8;
    float o[8];
#pragma unroll
    for (int j = 0; j < 8; ++j) o[j] = sm[(kc + j) * 65 + n];
    int nn = n0 + n, drow;
    if (mode == 0) drow = nn;
    else drow = 32 * (nn >> 4) + (nn & 15) + (mode == 2 ? 16 : 0);
    *(uint4*)(dst + (size_t)drow * ldd + kdst0 + k0 + kc) = pack8(o);
  }
  __syncthreads();
}

__device__ __forceinline__ void prep_phase(const Params& p, char* smem, const int wid_u) {
  float* sm = (float*)smem;
  const int tid = opaque_tid();
  constexpr int N_MOD = 144, N_EFF = 128, N_W13 = 4 * 704, N_W2 = 2 * 704, N_WIN = 640, N_WOUT = 128;
  constexpr int TOTAL = N_MOD + N_EFF + N_W13 + N_W2 + N_WIN + N_WOUT;
  for (int item = blockIdx.x; item < TOTAL; item += gridDim.x) {
    int it = item;
    if (it < N_MOD) {
      const int j0 = it * 64;
      float* sc = sm;
      float* red = sm + 16384;
      for (int idx = tid; idx < 16384; idx += NTHR) {
        const int s = idx >> 10, k = idx & 1023;
        const float* cp_ = p.c_prompt; const float* cs_ = p.c_sample;
        const float c = s < 8 ? cp_[s * 1024 + k] : cs_[(s - 8) * 1024 + k];
        sc[idx] = c / (1.f + __expf(-c));
      }
      __syncthreads();
      const int col = tid & 63, kg = tid >> 6;
      float acc[16];
#pragma unroll
      for (int s = 0; s < 16; ++s) acc[s] = 0.f;
      for (int k = kg * 128; k < kg * 128 + 128; ++k) {
        const float w = p.ada_w[(size_t)k * 9216 + j0 + col];
#pragma unroll
        for (int s = 0; s < 16; ++s) acc[s] += sc[s * 1024 + k] * w;
      }
#pragma unroll
      for (int s = 0; s < 16; ++s) red[(kg * 16 + s) * 64 + col] = acc[s];
      __syncthreads();
      for (int o = tid; o < 1024; o += NTHR) {
        const int s = o >> 6, c2 = o & 63;
        float v = p.ada_b[j0 + c2];
#pragma unroll
        for (int g = 0; g < 8; ++g) v += red[(g * 16 + s) * 64 + c2];
        P_MOD[s * 9216 + j0 + c2] = v;
      }
      __syncthreads();
      continue;
    }
    it -= N_MOD;
    if (it < N_EFF) {
      const int g = it >> 5, itile = (it >> 4) & 1, ntile = it & 15;
      float* As = sm;
      float* Bs = sm + 64 * 129;
      for (int idx = tid; idx < 64 * 128; idx += NTHR) {
        const int i = idx >> 7, j = idx & 127;
        As[i * 129 + j] = p.pool_w[((size_t)g * 128 + itile * 64 + i) * 128 + j] * p.pool_scale[g * 128 + j];
      }
      for (int idx = tid; idx < 128 * 64; idx += NTHR) {
        const int j = idx >> 6, nn = idx & 63;
        Bs[j * 65 + nn] = p.w_out[(size_t)(g * 128 + j) * 1024 + ntile * 64 + nn];
      }
      __syncthreads();
      const int i = tid >> 3, nn0 = (tid & 7) * 8;
      float acc[8];
#pragma unroll
      for (int q = 0; q < 8; ++q) acc[q] = 0.f;
      for (int j = 0; j < 128; ++j) {
        const float a = As[i * 129 + j];
#pragma unroll
        for (int q = 0; q < 8; ++q) acc[q] += a * Bs[j * 65 + nn0 + q];
      }
#pragma unroll
      for (int q = 0; q < 8; ++q)
        P_WOUTT[(size_t)(ntile * 64 + nn0 + q) * 1024 + g * 128 + itile * 64 + i] = (bf16_t)(cvt_pk_bf16(acc[q], 0.f) & 0xffff);
      __syncthreads();
      continue;
    }
    it -= N_EFF;
    if (it < N_W13) {
      const int which = it / 704, r = it % 704;
      const int kt = r / 44, ntl = r % 44;
      const float* src = sel(which < 2, sel(which == 0, p.f1_w1, p.f1_w3), sel(which == 2, p.f2_w1, p.f2_w3));
      bf16_t* dst = sel(which < 2, P_W13A, P_W13B);
      tr_tile(src, FF, kt * 64, ntl * 64, FF, dst, D, 0, (which & 1) ? 2 : 1, sm, tid);
      continue;
    }
    it -= N_W13;
    if (it < N_W2) {
      const int which = it / 704, r = it % 704;
      const int kt = r / 16, ntl = r % 16;
      tr_tile(sel(which != 0, p.f2_w2, p.f1_w2), D, kt * 64, ntl * 64, D, sel(which != 0, P_W2B, P_W2A), FF, 0, 0, sm, tid);
      continue;
    }
    it -= N_W2;
    if (it < N_WIN) {
      const int kt = it / 40, ntl = it % 40;
      tr_tile(p.w_in, PINW, kt * 64, ntl * 64, PINW, P_WINT, D, 0, 0, sm, tid);
      continue;
    }
    it -= N_WIN;
    {
      const int kt = it / 16, ntl = it % 16;
      tr_tile(p.w_out + (size_t)512 * 1024, D, kt * 64, ntl * 64, D, P_WOUTT, D, 512, 0, sm, tid);
    }
  }
}

template <int MODE>
__device__ __forceinline__ void row_phase(const float* __restrict__ xp, const float* __restrict__ xs, float* __restrict__ xout,
                          const bf16_t* __restrict__ y, bf16_t* __restrict__ h, const float* __restrict__ mod,
                          const float* __restrict__ npost, const float* __restrict__ npre, int gate_idx, float cgate, int shift_idx, const int wid_u) {
  const int tid_ = opaque_tid();
  const int lane = tid_ & 63;
  const int gw = blockIdx.x * 8 + (tid_ >> 6), GW = gridDim.x * 8;
  for (int chunk = gw; chunk < NTOK / 16; chunk += GW) {
    const int row0 = chunk * 16;
    int s, t, T;
    row_seq(row0, s, t, T);
    const float* md = mod + s * 9216;
    f32x4 Am[4], Bm[4], Gm[4];
#pragma unroll
    for (int i = 0; i < 4; ++i) {
      const int c = i * 256 + lane * 4;
      if (MODE != 2) {
        f32x4 np = *(const f32x4*)(npre + c), sc = *(const f32x4*)(md + (shift_idx + 1) * 1024 + c);
        Am[i] = np * (sc + 1.f);
        Bm[i] = *(const f32x4*)(md + shift_idx * 1024 + c);
      }
      if (MODE != 0) {
        f32x4 g = *(const f32x4*)(md + gate_idx * 1024 + c), po = *(const f32x4*)(npost + c);
        Gm[i] = g * po * cgate;
      }
    }
    for (int r = 0; r < 16; ++r) {
      const int row = row0 + r;
      const float* xr = (row < NPROMPT) ? xp + (size_t)row * D : xs + (size_t)(row - NPROMPT) * D;
      f32x4 xv[4];
#pragma unroll
      for (int i = 0; i < 4; ++i) xv[i] = *(const f32x4*)(xr + i * 256 + lane * 4);
      if (MODE != 0) {
        f32x4 yv[4];
        float ss = 0.f;
#pragma unroll
        for (int i = 0; i < 4; ++i) {
          uint2 u = *(const uint2*)(y + (size_t)row * D + i * 256 + lane * 4);
          yv[i] = (f32x4){bf_lo(u.x), bf_hi(u.x), bf_lo(u.y), bf_hi(u.y)};
          ss += yv[i][0] * yv[i][0] + yv[i][1] * yv[i][1] + yv[i][2] * yv[i][2] + yv[i][3] * yv[i][3];
        }
        ss = wave_sum(ss);
        const float rs = rsqrtf(ss * (1.f / 1024.f) + 1e-6f);
#pragma unroll
        for (int i = 0; i < 4; ++i) {
          xv[i] = xv[i] + Gm[i] * yv[i] * rs;
          *(f32x4*)(xout + (size_t)row * D + i * 256 + lane * 4) = xv[i];
        }
      }
      if (MODE != 2) {
        float ss = 0.f;
#pragma unroll
        for (int i = 0; i < 4; ++i) ss += xv[i][0] * xv[i][0] + xv[i][1] * xv[i][1] + xv[i][2] * xv[i][2] + xv[i][3] * xv[i][3];
        ss = wave_sum(ss);
        const float rs = rsqrtf(ss * (1.f / 1024.f) + 1e-6f);
#pragma unroll
        for (int i = 0; i < 4; ++i) {
          f32x4 hv = xv[i] * rs * Am[i] + Bm[i];
          uint2 u; u.x = cvt_pk_bf16(hv[0], hv[1]); u.y = cvt_pk_bf16(hv[2], hv[3]);
          *(uint2*)(h + (size_t)row * D + i * 256 + lane * 4) = u;
        }
      }
    }
  }
}

constexpr int BM = 256, BK = 64, HALF = 128, NXCD = 8, WGM = 8, HT = HALF * BK;
__device__ __forceinline__ int lds_byte(int r, int c) {
  int st = (r >> 4) * 2 + (c >> 5), rr = r & 15, cc = c & 31, ob = rr * 64 + cc * 2;
  return st * 1024 + (ob ^ (((ob >> 9) & 1) << 5));
}
__device__ __forceinline__ void stage_rc(int b, int& R, int& C) {
  int st = b / 1024, sb = b % 1024, swz = sb ^ (((sb >> 9) & 1) << 5);
  R = (st >> 1) * 16 + swz / 64; C = (st & 1) * 32 + (swz % 64) / 2;
}

__device__ __forceinline__ void gemm_tile(const bf16_t* __restrict__ A, const bf16_t* __restrict__ Bt, bf16_t* __restrict__ C,
                                          int K, int ldc, int brow, int bcol, LAS bf16_t* shm, const int EPI, const int tid) {
#define SA(b, h) (shm + ((b) * 2 + (h)) * HT)
#define SB(b, h) (shm + (4 + (b) * 2 + (h)) * HT)
#define STAGE(P, BASE, br, kt) do { const char* _gb = (const char*)(BASE) + (((long)(br) * K + (long)(kt) * BK) << 1); \
    _Pragma("unroll") for (int _i = 0; _i < 2; ++_i) { \
      __builtin_amdgcn_global_load_lds((const unsigned*)(_gb + voff[_i]), \
        (LAS unsigned*)((LAS char*)(P) + ldsw + _i * 8192), 16, 0, 0); } } while (0)
#define LDA(dst, b, h) _Pragma("unroll") for (int m = 0; m < 4; ++m) _Pragma("unroll") for (int k = 0; k < 2; ++k) \
    dst[m][k] = *(const LAS bf16x8*)((LAS char*)SA(b, h) + aoff + m * 2048 + k * 1024)
#define LDB(dst, b, h) _Pragma("unroll") for (int n = 0; n < 2; ++n) _Pragma("unroll") for (int k = 0; k < 2; ++k) \
    dst[n][k] = *(const LAS bf16x8*)((LAS char*)SB(b, h) + boff + n * 2048 + k * 1024)
#define MMA(ai, bj, At_, Bt_) do { __builtin_amdgcn_s_setprio(1); \
    _Pragma("unroll") for (int m = 0; m < 4; ++m) _Pragma("unroll") for (int n = 0; n < 2; ++n) _Pragma("unroll") for (int k = 0; k < 2; ++k) \
      acc[ai][bj][m][n] = __builtin_amdgcn_mfma_f32_16x16x32_bf16(Bt_[n][k], At_[m][k], acc[ai][bj][m][n], 0, 0, 0); \
    __builtin_amdgcn_s_setprio(0); } while (0)
#define WAIT_V(n) asm volatile("s_waitcnt vmcnt(" #n ")" ::: "memory")
#define WAIT_L(n) asm volatile("s_waitcnt lgkmcnt(" #n ")" ::: "memory")
#define BAR __builtin_amdgcn_s_barrier()
#define SCHED __builtin_amdgcn_sched_barrier(0)
  const int wid = __builtin_amdgcn_readfirstlane(tid >> 6), lane = tid & 63, wr = wid >> 2, wc = wid & 3, fr = lane & 15, fq = lane >> 4;
  const int aoff = lds_byte(wr * 64 + fr, fq * 8), boff = lds_byte(wc * 32 + fr, fq * 8);
  f32x4 acc[2][2][4][2] = {};
  bf16x8 At[4][2], B0[2][2], B1[2][2];
  unsigned voff[2];
  const int ldsw = wid * 1024;
#pragma unroll
  for (int _i = 0; _i < 2; ++_i) { int _r, _c; stage_rc(tid * 16 + _i * 8192, _r, _c); voff[_i] = (unsigned)(_r * K + _c) * 2u; }
  const int nt = K / BK;
  STAGE(SB(0, 0), Bt, bcol, 0); STAGE(SA(0, 0), A, brow, 0);
  STAGE(SB(0, 1), Bt, bcol + HALF, 0); STAGE(SA(0, 1), A, brow + HALF, 0);
  if (wr == 1) BAR;
  WAIT_V(4); BAR;
  STAGE(SB(1, 0), Bt, bcol, 1); STAGE(SA(1, 0), A, brow, 1); STAGE(SB(1, 1), Bt, bcol + HALF, 1);
  WAIT_V(6); BAR;
  for (int t = 0; t < nt - 2; t += 2) {
    LDB(B0, 0, 0); SCHED; LDA(At, 0, 0); STAGE(SA(1, 1), A, brow + HALF, t + 1);
    WAIT_L(8); BAR; WAIT_L(0); MMA(0, 0, At, B0); BAR; SCHED;
    LDB(B1, 0, 1); STAGE(SB(0, 0), Bt, bcol, t + 2);
    BAR; WAIT_L(0); MMA(0, 1, At, B1); BAR;
    LDA(At, 0, 1); STAGE(SA(0, 0), A, brow, t + 2);
    BAR; WAIT_L(0); MMA(1, 0, At, B0); BAR; SCHED;
    STAGE(SB(0, 1), Bt, bcol + HALF, t + 2);
    WAIT_V(6); BAR; MMA(1, 1, At, B1); BAR;
    LDB(B0, 1, 0); SCHED; LDA(At, 1, 0); STAGE(SA(0, 1), A, brow + HALF, t + 2);
    WAIT_L(8); BAR; WAIT_L(0); MMA(0, 0, At, B0); BAR; SCHED;
    LDB(B1, 1, 1); STAGE(SB(1, 0), Bt, bcol, t + 3);
    BAR; WAIT_L(0); MMA(0, 1, At, B1); BAR;
    LDA(At, 1, 1); STAGE(SA(1, 0), A, brow, t + 3);
    BAR; WAIT_L(0); MMA(1, 0, At, B0); BAR; SCHED;
    STAGE(SB(1, 1), Bt, bcol + HALF, t + 3);
    WAIT_V(6); BAR; MMA(1, 1, At, B1); BAR;
  }
  { LDB(B0, 0, 0); LDA(At, 0, 0); STAGE(SA(1, 1), A, brow + HALF, nt - 1);
    BAR; WAIT_L(0); MMA(0, 0, At, B0); BAR;
    LDB(B1, 0, 1); BAR; WAIT_L(0); MMA(0, 1, At, B1); BAR;
    LDA(At, 0, 1); WAIT_V(4); BAR; WAIT_L(0); MMA(1, 0, At, B0); MMA(1, 1, At, B1); BAR; }
  { LDB(B0, 1, 0); LDA(At, 1, 0); WAIT_V(2); BAR; WAIT_L(0); MMA(0, 0, At, B0); BAR;
    LDB(B1, 1, 1); WAIT_V(0); BAR; WAIT_L(0); MMA(0, 1, At, B1); BAR;
    LDA(At, 1, 1); BAR; WAIT_L(0); MMA(1, 0, At, B0); MMA(1, 1, At, B1); BAR; }
  if (wr == 0) BAR;
#pragma unroll
  for (int ai = 0; ai < 2; ++ai)
#pragma unroll
    for (int m = 0; m < 4; ++m) {
      const size_t row = (size_t)(brow + ai * HALF + wr * 64 + m * 16 + fr);
#pragma unroll
      for (int bj = 0; bj < 2; ++bj) {
        if (EPI == 0) {
#pragma unroll
          for (int n = 0; n < 2; ++n) {
            const f32x4 v = acc[ai][bj][m][n];
            uint2 u; u.x = cvt_pk_bf16(v[0], v[1]); u.y = cvt_pk_bf16(v[2], v[3]);
            *(uint2*)(C + row * ldc + bcol + bj * HALF + wc * 32 + n * 16 + fq * 4) = u;
          }
        } else {
          const f32x4 a = acc[ai][bj][m][0], b = acc[ai][bj][m][1];
          float o[4];
#pragma unroll
          for (int j = 0; j < 4; ++j) o[j] = a[j] * __builtin_amdgcn_rcpf(1.f + __expf(-a[j])) * b[j];
          uint2 u; u.x = cvt_pk_bf16(o[0], o[1]); u.y = cvt_pk_bf16(o[2], o[3]);
          *(uint2*)(C + row * ldc + ((bcol + bj * HALF + wc * 32) >> 1) + fq * 4) = u;
        }
      }
    }
#undef SA
#undef SB
#undef STAGE
#undef LDA
#undef LDB
#undef MMA
}

__device__ __forceinline__ void gemm_phase(const bf16_t* A, const bf16_t* Bt, bf16_t* C, int M, int N, int K, int ldc, int EPI, char* smem, const int wid_u) {
  const int nM = M / BM, nN = N / BM, nwg = nM * nN;
  const int tid = opaque_tid();
  for (int L = blockIdx.x; L < nwg; L += gridDim.x) {
    int wgid = L;
    { int q = nwg / NXCD, r = nwg % NXCD, xcd = wgid % NXCD, off = wgid / NXCD;
      wgid = (xcd < r ? xcd * (q + 1) : r * (q + 1) + (xcd - r) * q) + off; }
    const int nig = WGM * nN, gid = wgid / nig, fm = gid * WGM, gsz = min(nM - fm, WGM);
    const int pm = fm + ((wgid % nig) % gsz), pn = (wgid % nig) / gsz;
    gemm_tile(A, Bt, C, K, ldc, pm * BM, pn * BM, (LAS bf16_t*)smem, EPI, tid);
    asm volatile("s_waitcnt vmcnt(0)" ::: "memory");
    __syncthreads();
  }
}

__device__ __forceinline__ void load_shift16(const bf16_t* __restrict__ z, int row, int t, int T, int col, const float* __restrict__ mu, float* o) {
  const bf16_t* pz = z + (size_t)row * ZLD + col;
  uint4 c0 = *(const uint4*)pz, c1 = *(const uint4*)(pz + 8);
  uint4 p0 = make_uint4(0, 0, 0, 0), p1 = p0, n0 = p0, n1 = p0;
  if (t > 0) { p0 = *(const uint4*)(pz - ZLD); p1 = *(const uint4*)(pz - ZLD + 8); }
  if (t < T - 1) { n0 = *(const uint4*)(pz + ZLD); n1 = *(const uint4*)(pz + ZLD + 8); }
  float c[16], pv[16], nx[16];
  unpack8(c0, c); unpack8(c1, c + 8); unpack8(p0, pv); unpack8(p1, pv + 8); unpack8(n0, nx); unpack8(n1, nx + 8);
#pragma unroll
  for (int q = 0; q < 16; ++q) o[q] = c[q] + (0.5f * (pv[q] + nx[q]) - c[q]) * mu[col - 512 + q];
}
__device__ __forceinline__ void load_shift8(const bf16_t* __restrict__ z, int row, int t, int T, int col, const float* __restrict__ mu, float* o) {
  const bf16_t* pz = z + (size_t)row * ZLD + col;
  uint4 c0 = *(const uint4*)pz;
  uint4 p0 = make_uint4(0, 0, 0, 0), n0 = p0;
  if (t > 0) p0 = *(const uint4*)(pz - ZLD);
  if (t < T - 1) n0 = *(const uint4*)(pz + ZLD);
  float c[8], pv[8], nx[8];
  unpack8(c0, c); unpack8(p0, pv); unpack8(n0, nx);
#pragma unroll
  for (int q = 0; q < 8; ++q) o[q] = c[q] + (0.5f * (pv[q] + nx[q]) - c[q]) * mu[col - 512 + q];
}

constexpr int TC = 32;
constexpr int SV = TC * 64;
struct Raw16 { uint4 c0, c1, p0, p1, n0, n1; };
__device__ __forceinline__ void load_raw16(Raw16& r, const bf16_t* __restrict__ z, int row, int t, int T, int col) {
  const bf16_t* pz = z + (size_t)row * ZLD + col;
  r.c0 = *(const uint4*)pz; r.c1 = *(const uint4*)(pz + 8);
  r.p0 = make_uint4(0, 0, 0, 0); r.p1 = r.p0; r.n0 = r.p0; r.n1 = r.p0;
  if (t > 0) { r.p0 = *(const uint4*)(pz - ZLD); r.p1 = *(const uint4*)(pz - ZLD + 8); }
  if (t < T - 1) { r.n0 = *(const uint4*)(pz + ZLD); r.n1 = *(const uint4*)(pz + ZLD + 8); }
}
__device__ __forceinline__ void shift16(const Raw16& r, const float* mu, float* o) {
  float c[16], pv[16], nx[16];
  unpack8(r.c0, c); unpack8(r.c1, c + 8); unpack8(r.p0, pv); unpack8(r.p1, pv + 8); unpack8(r.n0, nx); unpack8(r.n1, nx + 8);
#pragma unroll
  for (int q = 0; q < 16; ++q) o[q] = c[q] + (0.5f * (pv[q] + nx[q]) - c[q]) * mu[q];
}
__device__ __forceinline__ bf16x8 ldfrag(const bf16_t* base, int stride, int row0, int k0, int fr, int fq) {
  return *reinterpret_cast<const bf16x8*>(base + (row0 + fr) * stride + k0 + fq * 8);
}
__device__ __forceinline__ uint2 pack4(f32x4 v) { uint2 u; u.x = cvt_pk_bf16(v[0], v[1]); u.y = cvt_pk_bf16(v[2], v[3]); return u; }
#define MFMA16(a, b, c) __builtin_amdgcn_mfma_f32_16x16x32_bf16(a, b, c, 0, 0, 0)

constexpr int CS_NAB = 0, CS_NAK = 4096, CS_NBRT = 8192, CS_NKRT = 10752, CS_QT = 13312, CS_W = 15872, CS_Z = 20992, CS_GT = 26112,
              CS_RYT = 35328;
constexpr int CS_AT = 49152, CS_RT = CS_AT + 4608, CS_BT = CS_RT + 4608, CS_KT = CS_BT + 4608, CS_BB = 67584, CS_KB = CS_BB + 5120,
              CS_VT = CS_KB + 5120, CS_ATT = 82944, CS_PL = 92160, CS_SBF = 92416, CS_PRIV = 110848, CS_CST = 143616, CS_BL = 145664;

template <int Q> __device__ __forceinline__ float quad_bcast(float x) { return dpp_f<Q * 0x55>(x); }

template <int S0> __device__ __forceinline__ void solve_steps(float (&x)[8], const float* nab, int seg) {
  if constexpr (S0 < 32) {
    const float xs = quad_bcast<(S0 >> 3)>(x[S0 & 7]);
    const f32x4 n0 = *(const f32x4*)(nab + S0 * 32 + seg * 8), n1 = *(const f32x4*)(nab + S0 * 32 + seg * 8 + 4);
    x[0] += xs * n0[0]; x[1] += xs * n0[1]; x[2] += xs * n0[2]; x[3] += xs * n0[3];
    x[4] += xs * n1[0]; x[5] += xs * n1[1]; x[6] += xs * n1[2]; x[7] += xs * n1[3];
    solve_steps<S0 + 1>(x, nab, seg);
  }
}

__device__ __forceinline__ void scan_phase(const Params& p, char* smem, const int wid_u) {
  float* stepbuf = (float*)smem;
  float* Nab = (float*)(smem + CS_NAB);
  float* Nak = (float*)(smem + CS_NAK);
  bf16_t* NbrT = (bf16_t*)(smem + CS_NBRT);
  bf16_t* NkrT = (bf16_t*)(smem + CS_NKRT);
  bf16_t* QT = (bf16_t*)(smem + CS_QT);
  bf16_t* Wb = (bf16_t*)(smem + CS_W);
  bf16_t* Zb = (bf16_t*)(smem + CS_Z);
  bf16_t* GT = (bf16_t*)(smem + CS_GT);
  bf16_t* RyT = (bf16_t*)(smem + CS_RYT);
  bf16_t* At = (bf16_t*)(smem + CS_AT);
  bf16_t* Rt = (bf16_t*)(smem + CS_RT);
  bf16_t* Bt = (bf16_t*)(smem + CS_BT);
  bf16_t* Kt = (bf16_t*)(smem + CS_KT);
  bf16_t* Bb = (bf16_t*)(smem + CS_BB);
  bf16_t* Kb = (bf16_t*)(smem + CS_KB);
  bf16_t* VT = (bf16_t*)(smem + CS_VT);
  float* AtT = (float*)(smem + CS_ATT);
  float* PLs = (float*)(smem + CS_PL);
  bf16_t* Sbf = (bf16_t*)(smem + CS_SBF);
  float* cst = (float*)(smem + CS_CST);
  const bf16_t* z = P_RU;
  const int tid = opaque_tid();
  const int wave = __builtin_amdgcn_readfirstlane(tid >> 6), lane = tid & 63, fr = lane & 15, fq = lane >> 4;
  const int item = blockIdx.x;
  if (item < 256) {
    const int s = item < 128 ? 8 + (item >> 4) : ((item - 128) >> 4);
    const int h = (item & 15) >> 1, d = item & 1;
    const int T = s < 8 ? 4096 : 8192, r0seq = seq_start(s), nch = T / 32;
    bf16_t* yout = P_RY + (size_t)d * NTOK * 512;
    {
      const int g = tid >> 6, k = tid & 63;
      float v;
      if (g == 0) v = p.shift_mu[2048 - 512 + d * 64 + k];
      else if (g == 1) v = p.shift_mu[2176 - 512 + d * 64 + k];
      else if (g == 2) v = p.shift_mu[1024 - 512 + h * 64 + k];
      else if (g == 3) v = p.shift_mu[512 - 512 + h * 64 + k];
      else if (g == 4) v = p.shift_mu[1536 - 512 + h * 64 + k];
      else if (g == 5) v = p.k_k[h * 64 + k];
      else if (g == 6) v = p.k_a[h * 64 + k];
      else v = p.r_k[h * 64 + k];
      cst[g * 64 + k] = v;
      for (int i = tid; i < 2 * 64 * 72 / 2; i += NTHR) ((unsigned*)Sbf)[i] = 0u;
    }
    const int role = wave >> 1, th = wave & 1;
    const int tl = lane >> 2, cq = lane & 3;
    bf16_t* Ab = (bf16_t*)(smem + CS_PRIV + (wave & 3) * 8192);
    float* tmpa = (float*)(smem + CS_PRIV + (wave & 3) * 8192 + 2560);
    uint4* Blds = (uint4*)(smem + CS_BL) + (role & 1) * 512;
    float bias[4] = {0.f, 0.f, 0.f, 0.f};
    if (role < 2) {
      const float* lsrc = sel(role != 0, p.a2, p.w2) + (size_t)d * 64 * 512 + h * 64;
      if (th == 0) {
#pragma unroll
        for (int nt = 0; nt < 4; ++nt)
#pragma unroll
          for (int ks = 0; ks < 2; ++ks) {
            float o[8];
#pragma unroll
            for (int q = 0; q < 8; ++q) o[q] = lsrc[(size_t)(ks * 32 + fq * 8 + q) * 512 + nt * 16 + fr];
            Blds[(nt * 2 + ks) * 64 + lane] = pack8(o);
          }
      }
#pragma unroll
      for (int nt = 0; nt < 4; ++nt) bias[nt] = sel(role != 0, p.a0, p.w0)[d * 512 + h * 64 + nt * 16 + fr];
    }
    const int colA = (role == 0 ? 2048 + d * 64 : role == 1 ? 2176 + d * 64 : 512 + h * 64) + cq * 16;
    const int colB = (role == 1 ? 1024 : 1536) + h * 64 + cq * 16;
    Raw16 ra, rb;
    {
      const int j = th * 16 + tl, t = d ? T - 1 - j : j, row = r0seq + t;
      if (role < 3) load_raw16(ra, z, row, t, T, colA);
      if (role == 1 || role == 2) load_raw16(rb, z, row, t, T, colB);
    }
    f32x4 Sa = {0.f, 0.f, 0.f, 0.f}, Sb = Sa;
    const int mt = wave >> 1, hn = wave & 1, nt0 = 2 * hn, nt1 = 2 * hn + 1;
    __syncthreads();

    for (int c = 0; c < nch; ++c) {
      if (role < 3) {
        const int j = th * 16 + tl;
        const int istep = c * 32 + j;
        const int t = d ? T - 1 - istep : istep;
        const int row = r0seq + t;
        float v16[16];
        if (role < 2) {
          shift16(ra, cst + role * 64 + cq * 16, v16);
          if (role == 0) {
#pragma unroll
            for (int q = 0; q < 16; ++q) { const float e = __expf(2.f * v16[q]); v16[q] = 1.f - 2.f * __builtin_amdgcn_rcpf(e + 1.f); }
          }
          *(uint4*)(Ab + tl * 72 + cq * 16) = pack8(v16);
          *(uint4*)(Ab + tl * 72 + cq * 16 + 8) = pack8(v16 + 8);
          __builtin_amdgcn_wave_barrier();
          f32x4 acc[4] = {};
#pragma unroll
          for (int ks = 0; ks < 2; ++ks) {
            const bf16x8 a = *reinterpret_cast<const bf16x8*>(Ab + fr * 72 + ks * 32 + fq * 8);
#pragma unroll
            for (int nt = 0; nt < 4; ++nt) { const uint4 bu = Blds[(nt * 2 + ks) * 64 + lane]; acc[nt] = MFMA16(a, *reinterpret_cast<const bf16x8*>(&bu), acc[nt]); }
          }
          if (role == 0) {
#pragma unroll
            for (int nt = 0; nt < 4; ++nt)
#pragma unroll
              for (int jj = 0; jj < 4; ++jj) {
                const float sg = sigmoidf_(bias[nt] + acc[nt][jj]);
                stepbuf[0 * SV + (th * 16 + fq * 4 + jj) * 64 + nt * 16 + fr] = __expf(-0.6065306597126334f * sg);
              }
          } else {
#pragma unroll
            for (int nt = 0; nt < 4; ++nt)
#pragma unroll
              for (int jj = 0; jj < 4; ++jj) tmpa[(fq * 4 + jj) * 68 + nt * 16 + fr] = sigmoidf_(bias[nt] + acc[nt][jj]);
            __builtin_amdgcn_wave_barrier();
            float av[16], kd[16];
#pragma unroll
            for (int q = 0; q < 4; ++q) { f32x4 a4 = *(const f32x4*)(tmpa + tl * 68 + cq * 16 + q * 4); av[q * 4] = a4[0]; av[q * 4 + 1] = a4[1]; av[q * 4 + 2] = a4[2]; av[q * 4 + 3] = a4[3]; }
            shift16(rb, cst + 2 * 64 + cq * 16, v16);
            float kk[16], ss = 0.f;
#pragma unroll
            for (int q = 0; q < 16; ++q) { kk[q] = v16[q] * cst[5 * 64 + cq * 16 + q]; ss += kk[q] * kk[q]; }
            ss += __shfl_xor(ss, 1); ss += __shfl_xor(ss, 2);
            const float inv = 1.f / fmaxf(sqrtf(ss), 1e-12f);
#pragma unroll
            for (int q = 0; q < 16; ++q) { kk[q] *= inv; kd[q] = v16[q] * (1.f + (av[q] - 1.f) * cst[6 * 64 + cq * 16 + q]); }
#pragma unroll
            for (int q = 0; q < 4; ++q) {
              *(f32x4*)(stepbuf + 3 * SV + j * 64 + cq * 16 + q * 4) = (f32x4){-kk[q * 4], -kk[q * 4 + 1], -kk[q * 4 + 2], -kk[q * 4 + 3]};
              *(f32x4*)(stepbuf + 4 * SV + j * 64 + cq * 16 + q * 4) = (f32x4){kk[q * 4] * av[q * 4], kk[q * 4 + 1] * av[q * 4 + 1], kk[q * 4 + 2] * av[q * 4 + 2], kk[q * 4 + 3] * av[q * 4 + 3]};
              *(f32x4*)(stepbuf + 1 * SV + j * 64 + cq * 16 + q * 4) = (f32x4){kd[q * 4], kd[q * 4 + 1], kd[q * 4 + 2], kd[q * 4 + 3]};
            }
          }
        } else {
          shift16(ra, cst + 3 * 64 + cq * 16, v16);
#pragma unroll
          for (int q = 0; q < 4; ++q) *(f32x4*)(stepbuf + 2 * SV + j * 64 + cq * 16 + q * 4) = (f32x4){v16[q * 4], v16[q * 4 + 1], v16[q * 4 + 2], v16[q * 4 + 3]};
          shift16(rb, cst + 4 * 64 + cq * 16, v16);
#pragma unroll
          for (int q = 0; q < 4; ++q) *(f32x4*)(stepbuf + 5 * SV + j * 64 + cq * 16 + q * 4) = (f32x4){v16[q * 4], v16[q * 4 + 1], v16[q * 4 + 2], v16[q * 4 + 3]};
        }
        if (c + 1 < nch) {
          const int is2 = (c + 1) * 32 + j;
          const int t2 = d ? T - 1 - is2 : is2;
          const int row2 = r0seq + t2;
          load_raw16(ra, z, row2, t2, T, colA);
          if (role >= 1) load_raw16(rb, z, row2, t2, T, colB);
        }
      }
      __syncthreads();
      {
        const int k = lane, seg = wave;
        const float* sw = stepbuf + 0 * SV + k;
        float pre = 1.f;
        for (int t = 0; t < 4 * seg; ++t) pre *= sw[t * 64];
        float P[5];
        P[0] = pre;
#pragma unroll
        for (int i = 0; i < 4; ++i) P[i + 1] = P[i] * sw[(4 * seg + i) * 64];
        float PL = P[4];
        for (int t = 4 * seg + 4; t < 32; ++t) PL *= sw[t * 64];
        f32x4 bb, kb, at, vv;
#pragma unroll
        for (int i = 0; i < 4; ++i) {
          const int t = 4 * seg + i;
          const float inv = __builtin_amdgcn_rcpf(P[i + 1]);
          const float a_ = P[i] * stepbuf[3 * SV + t * 64 + k];
          const float rraw = stepbuf[2 * SV + t * 64 + k], kraw = stepbuf[1 * SV + t * 64 + k];
          const float r_ = P[i + 1] * rraw;
          const float b_ = stepbuf[4 * SV + t * 64 + k] * inv;
          const float k_ = kraw * inv;
          {
            const float bs = wave_sum(rraw * kraw * cst[7 * 64 + k]);
            const int is_ = c * 32 + t, tg = d ? T - 1 - is_ : is_;
            if (lane == 0) P_SBON[((size_t)(r0seq + tg) * 8 + h) * 2 + d] = bs;
          }
          At[t * 72 + k] = (bf16_t)(cvt_pk_bf16(a_, 0.f) & 0xffff);
          Rt[t * 72 + k] = (bf16_t)(cvt_pk_bf16(r_, 0.f) & 0xffff);
          Bt[t * 72 + k] = (bf16_t)(cvt_pk_bf16(b_, 0.f) & 0xffff);
          Kt[t * 72 + k] = (bf16_t)(cvt_pk_bf16(k_, 0.f) & 0xffff);
          bb[i] = b_ * PL; kb[i] = k_ * PL; at[i] = a_;
          vv[i] = stepbuf[5 * SV + t * 64 + k];
        }
        *(uint2*)(Bb + k * 40 + 4 * seg) = pack4(bb);
        *(uint2*)(Kb + k * 40 + 4 * seg) = pack4(kb);
        *(uint2*)(VT + k * 40 + 4 * seg) = pack4(vv);
        *(f32x4*)(AtT + k * 36 + 4 * seg) = at;
        if (seg == 0) PLs[k] = PL;
      }
      __syncthreads();
      {
        const int mat = wave >> 1, mts = wave & 1;
        const bf16_t* As = (mat & 1) ? Kt : Bt;
        const bf16_t* Bs = (mat & 2) ? Rt : At;
        f32x4 acc[2] = {};
#pragma unroll
        for (int ks = 0; ks < 2; ++ks) {
          const bf16x8 a = ldfrag(As, 72, mts * 16, ks * 32, fr, fq);
#pragma unroll
          for (int nt = 0; nt < 2; ++nt) acc[nt] = MFMA16(a, ldfrag(Bs, 72, nt * 16, ks * 32, fr, fq), acc[nt]);
        }
#pragma unroll
        for (int nt = 0; nt < 2; ++nt) {
          const int tcol = nt * 16 + fr;
          f32x4 v = acc[nt];
#pragma unroll
          for (int jj = 0; jj < 4; ++jj) {
            const int srow = mts * 16 + fq * 4 + jj;
            const bool keep = (mat & 2) ? (srow <= tcol) : (srow < tcol);
            v[jj] = keep ? v[jj] : 0.f;
          }
          if (mat < 2) {
            float* dst = mat == 0 ? Nab : Nak;
#pragma unroll
            for (int jj = 0; jj < 4; ++jj) dst[(mts * 16 + fq * 4 + jj) * 32 + tcol] = v[jj];
          } else {
            bf16_t* dst = mat == 2 ? NbrT : NkrT;
            *(uint2*)(dst + tcol * 40 + mts * 16 + fq * 4) = pack4(v);
          }
        }
      }
      __syncthreads();
      if (wave < 6) {
        const int seg = lane & 3, rrow = (wave & 3) * 16 + (lane >> 2);
        const float* src = wave < 4 ? AtT + rrow * 36 + seg * 8 : Nak + rrow * 32 + seg * 8;
        float x[8];
        { const f32x4 a = *(const f32x4*)src, b = *(const f32x4*)(src + 4);
          x[0] = a[0]; x[1] = a[1]; x[2] = a[2]; x[3] = a[3]; x[4] = b[0]; x[5] = b[1]; x[6] = b[2]; x[7] = b[3]; }
        solve_steps<0>(x, Nab, seg);
        if (wave < 4) {
          *(uint4*)(Wb + rrow * 40 + seg * 8) = pack8(x);
        } else {
#pragma unroll
          for (int i = 0; i < 8; ++i) QT[(seg * 8 + i) * 40 + rrow] = (bf16_t)(cvt_pk_bf16(x[i], 0.f) & 0xffff);
        }
      }
      __syncthreads();
      {
        const int tt = wave & 1, vtile = wave >> 1;
        f32x4 acc = {0.f, 0.f, 0.f, 0.f};
        acc = MFMA16(ldfrag(QT, 40, tt * 16, 0, fr, fq), ldfrag(VT, 40, vtile * 16, 0, fr, fq), acc);
        *(uint2*)(Zb + (vtile * 16 + fr) * 40 + tt * 16 + fq * 4) = pack4(acc);
      }
      __syncthreads();
      f32x4 yacc = {0.f, 0.f, 0.f, 0.f};
      {
        const float pl0 = PLs[nt0 * 16 + fr], pl1 = PLs[nt1 * 16 + fr];
        Sa = Sa * pl0; Sb = Sb * pl1;
        const bf16x8 zf = ldfrag(Zb, 40, mt * 16, 0, fr, fq), vf = ldfrag(VT, 40, mt * 16, 0, fr, fq), wf = ldfrag(Wb, 40, mt * 16, 0, fr, fq);
        const bf16x8 bb0 = ldfrag(Bb, 40, nt0 * 16, 0, fr, fq), bb1 = ldfrag(Bb, 40, nt1 * 16, 0, fr, fq);
        const bf16x8 kb0 = ldfrag(Kb, 40, nt0 * 16, 0, fr, fq), kb1 = ldfrag(Kb, 40, nt1 * 16, 0, fr, fq);
        const bf16x8 nbr = ldfrag(NbrT, 40, hn * 16, 0, fr, fq), nkr = ldfrag(NkrT, 40, hn * 16, 0, fr, fq);
        Sa = MFMA16(zf, bb0, Sa); Sa = MFMA16(vf, kb0, Sa);
        Sb = MFMA16(zf, bb1, Sb); Sb = MFMA16(vf, kb1, Sb);
        yacc = MFMA16(zf, nbr, yacc); yacc = MFMA16(vf, nkr, yacc);
        const f32x4 zero = {0.f, 0.f, 0.f, 0.f};
        const f32x4 g0 = MFMA16(wf, bb0, zero), g1 = MFMA16(wf, bb1, zero);
        f32x4 ry = MFMA16(wf, nbr, zero);
        *(uint2*)(GT + (nt0 * 16 + fr) * 72 + mt * 16 + fq * 4) = pack4(g0);
        *(uint2*)(GT + (nt1 * 16 + fr) * 72 + mt * 16 + fq * 4) = pack4(g1);
        const uint2 rr = *(const uint2*)(Rt + (hn * 16 + fr) * 72 + mt * 16 + fq * 4);
        ry[0] += bf_lo(rr.x); ry[1] += bf_hi(rr.x); ry[2] += bf_lo(rr.y); ry[3] += bf_hi(rr.y);
        *(uint2*)(RyT + (hn * 16 + fr) * 72 + mt * 16 + fq * 4) = pack4(ry);
      }
      __syncthreads();
      {
        const bf16_t* Scur = Sbf + (c & 1) * 64 * 72;
        bf16_t* Snext = Sbf + ((c + 1) & 1) * 64 * 72;
#pragma unroll
        for (int ks = 0; ks < 2; ++ks) {
          const bf16x8 af = ldfrag(Scur, 72, mt * 16, ks * 32, fr, fq);
          Sa = MFMA16(af, ldfrag(GT, 72, nt0 * 16, ks * 32, fr, fq), Sa);
          Sb = MFMA16(af, ldfrag(GT, 72, nt1 * 16, ks * 32, fr, fq), Sb);
          yacc = MFMA16(af, ldfrag(RyT, 72, hn * 16, ks * 32, fr, fq), yacc);
        }
        const int istep = c * 32 + hn * 16 + fr;
        const int t = d ? T - 1 - istep : istep;
        *(uint2*)(yout + (size_t)(r0seq + t) * 512 + h * 64 + mt * 16 + fq * 4) = pack4(yacc);
#pragma unroll
        for (int jj = 0; jj < 4; ++jj) {
          Snext[(mt * 16 + fq * 4 + jj) * 72 + nt0 * 16 + fr] = (bf16_t)(cvt_pk_bf16(Sa[jj], 0.f) & 0xffff);
          Snext[(mt * 16 + fq * 4 + jj) * 72 + nt1 * 16 + fr] = (bf16_t)(cvt_pk_bf16(Sb[jj], 0.f) & 0xffff);
        }
      }
      __syncthreads();
    }
  }
}

__device__ __forceinline__ void post_phase(const Params& p, char* smem, const int wid_u) {
  bf16_t* Ag = (bf16_t*)smem;
  bf16_t* vt = (bf16_t*)(smem + 12800);
  float* ys = (float*)(smem + 12800 + 33280);
  const bf16_t* z = P_RU;
  const bf16_t* yf = P_RY;
  const bf16_t* ybk = P_RY + (size_t)NTOK * 512;
  bf16_t* mo = P_RH;
  const int tid = opaque_tid(), w = tid >> 6, lane = tid & 63, fr = lane & 15, fq = lane >> 4;
  bf16x8 Bg[4][6];
#pragma unroll
  for (int nt = 0; nt < 4; ++nt)
#pragma unroll
    for (int ks = 0; ks < 6; ++ks) {
      float o[8];
#pragma unroll
      for (int q = 0; q < 8; ++q) { const int k = ks * 32 + fq * 8 + q; o[q] = k < 160 ? p.g2[(size_t)k * 512 + w * 64 + nt * 16 + fr] : 0.f; }
      uint4 u = pack8(o);
      Bg[nt][ks] = *reinterpret_cast<bf16x8*>(&u);
    }
  float lng[4], lnb[4];
#pragma unroll
  for (int nt = 0; nt < 4; ++nt) { lng[nt] = p.lnx_g[w * 64 + nt * 16 + fr]; lnb[nt] = p.lnx_b[w * 64 + nt * 16 + fr]; }

  for (int tile = blockIdx.x; tile < NTOK / 32; tile += gridDim.x) {
    const int row0 = tile * 32;
    int s, t0, T;
    row_seq(row0, s, t0, T);
    for (int idx = tid; idx < 32 * 24; idx += NTHR) {
      const int tok = idx / 24, oc = idx % 24;
      float o[8];
      if (oc < 20) {
        load_shift8(z, row0 + tok, t0 + tok, T, 2304 + oc * 8, p.shift_mu, o);
#pragma unroll
        for (int q = 0; q < 8; ++q) o[q] = sigmoidf_(o[q]);
      } else {
#pragma unroll
        for (int q = 0; q < 8; ++q) o[q] = 0.f;
      }
      *(uint4*)(Ag + tok * 200 + oc * 8) = pack8(o);
    }
    for (int idx = tid; idx < 32 * 64; idx += NTHR) {
      const int tok = idx >> 6, oc = idx & 63, row = row0 + tok, t = t0 + tok;
      float o[8];
      load_shift8(z, row, t, T, 1536 + oc * 8, p.shift_mu, o);
      *(uint4*)(vt + tok * 520 + oc * 8) = pack8(o);
      float a[8], b[8];
      unpack8(*(const uint4*)(yf + (size_t)row * 512 + oc * 8), a);
      unpack8(*(const uint4*)(ybk + (size_t)row * 512 + oc * 8), b);
      *(f32x4*)(ys + tok * 516 + oc * 8) = (f32x4){a[0] + b[0], a[1] + b[1], a[2] + b[2], a[3] + b[3]};
      *(f32x4*)(ys + tok * 516 + oc * 8 + 4) = (f32x4){a[4] + b[4], a[5] + b[5], a[6] + b[6], a[7] + b[7]};
      const int c0 = oc * 8, half = 1 << (c0 >> 7);
      const int lo = max(t - half, 0), hi = min(t + half, T);
      float sum[8];
#pragma unroll
      for (int q = 0; q < 8; ++q) sum[q] = 0.f;
      for (int tt = lo; tt < hi; ++tt) {
        float zz[8];
        unpack8(*(const uint4*)(z + (size_t)(row + tt - t) * ZLD + c0), zz);
#pragma unroll
        for (int q = 0; q < 8; ++q) sum[q] += zz[q];
      }
      float zc[8];
      unpack8(*(const uint4*)(z + (size_t)row * ZLD + c0), zc);
      const float ic = 1.f / (float)(hi - lo);
#pragma unroll
      for (int q = 0; q < 8; ++q) sum[q] = sum[q] * ic - zc[q];
      *(uint4*)(mo + (size_t)row * D + c0) = pack8(sum);
    }
    __syncthreads();
    f32x4 acc[2][4] = {};
#pragma unroll
    for (int ks = 0; ks < 6; ++ks) {
      bf16x8 a[2];
#pragma unroll
      for (int mt = 0; mt < 2; ++mt) a[mt] = *reinterpret_cast<const bf16x8*>(Ag + (mt * 16 + fr) * 200 + ks * 32 + fq * 8);
#pragma unroll
      for (int mt = 0; mt < 2; ++mt)
#pragma unroll
        for (int nt = 0; nt < 4; ++nt) acc[mt][nt] = __builtin_amdgcn_mfma_f32_16x16x32_bf16(a[mt], Bg[nt][ks], acc[mt][nt], 0, 0, 0);
    }
#pragma unroll
    for (int mt = 0; mt < 2; ++mt)
#pragma unroll
      for (int jj = 0; jj < 4; ++jj) {
        const int tok = mt * 16 + fq * 4 + jj, row = row0 + tok;
        float yv[4], sm_ = 0.f;
#pragma unroll
        for (int nt = 0; nt < 4; ++nt) { yv[nt] = ys[tok * 516 + w * 64 + nt * 16 + fr]; sm_ += yv[nt]; }
        const float mean = row16_sum(sm_) * (1.f / 64.f);
        float vs = 0.f;
#pragma unroll
        for (int nt = 0; nt < 4; ++nt) { yv[nt] -= mean; vs += yv[nt] * yv[nt]; }
        const float rs = rsqrtf(row16_sum(vs) * (1.f / 64.f) + 64e-5f);
        const float2 sb2 = *(const float2*)(P_SBON + ((size_t)row * 8 + w) * 2);
        const float sbs = sb2.x + sb2.y;
#pragma unroll
        for (int nt = 0; nt < 4; ++nt) {
          const float vv = bf2f(vt[tok * 520 + w * 64 + nt * 16 + fr]);
          const float o = (yv[nt] * rs * lng[nt] + lnb[nt] + sbs * vv) * acc[mt][nt][jj];
          mo[(size_t)row * D + 512 + w * 64 + nt * 16 + fr] = (bf16_t)(cvt_pk_bf16(o, 0.f) & 0xffff);
        }
      }
    __syncthreads();
  }
}

constexpr int NPHASE = 13;
__device__ __forceinline__ void do_phase(const Params& p, int ph, char* smem, const int wid_u) {
  if (ph == 0) prep_phase(p, smem, wid_u);
  else if (ph == 1) row_phase<0>(p.x_prompt, p.x_sample, nullptr, nullptr, P_RH, P_MOD, nullptr, p.n1_pre, 0, 0.f, 0, wid_u);
  else if (ph == 4 || ph == 9) {
    const bool f = ph == 4;
    float* outp = p.out;
    row_phase<1>(sel(f, p.x_prompt, (const float*)outp), sel(f, p.x_sample, (const float*)(outp + (size_t)NPROMPT * D)), outp, P_RY, P_RH, P_MOD,
                 sel(f, p.n1_post, p.nm_post), sel(f, p.nm_pre, p.n2_pre), f ? 2 : 5, f ? 0.5f : 1.0f, f ? 3 : 6, wid_u);
  }
  else if (ph == 12) row_phase<2>(p.out, p.out + (size_t)NPROMPT * D, p.out, P_RY, nullptr, P_MOD, p.n2_post, nullptr, 8, 0.5f, 0, wid_u);
  else if (ph == 6) scan_phase(p, smem, wid_u);
  else if (ph == 7) post_phase(p, smem, wid_u);
  else {
    const bf16_t *A, *Bt; bf16_t* C; int N, K, ldc, epi;
    if (ph == 2 || ph == 10) { A = P_RH; Bt = sel(ph == 2, P_W13A, P_W13B); C = P_RU; N = 2 * FF; K = D; ldc = FF; epi = 1; }
    else if (ph == 3 || ph == 11) { A = P_RU; Bt = sel(ph == 3, P_W2A, P_W2B); C = P_RY; N = D; K = FF; ldc = D; epi = 0; }
    else if (ph == 5) { A = P_RH; Bt = P_WINT; C = P_RU; N = ZLD; K = D; ldc = ZLD; epi = 0; }
    else { A = P_RH; Bt = P_WOUTT; C = P_RY; N = D; K = D; ldc = D; epi = 0; }
    gemm_phase(A, Bt, C, NTOK, N, K, ldc, epi, smem, wid_u);
  }
}

extern __shared__ __attribute__((aligned(16))) char dyn_smem[];

__global__ void __launch_bounds__(NTHR, 2) mega_kernel(Params p) {
  cg::grid_group grid = cg::this_grid();
  const int wid_u = __builtin_amdgcn_readfirstlane(threadIdx.x >> 6);
#pragma unroll 1
  for (int ph = 0; ph < NPHASE; ++ph) {
    do_phase(p, ph, dyn_smem, wid_u);
#ifdef PROBE_REPEAT
    if (ph == PROBE_REPEAT) { grid.sync(); do_phase(p, ph, dyn_smem, wid_u); }
#endif
    if (ph + 1 < NPHASE) grid.sync();
  }
}

__global__ void __launch_bounds__(NTHR, 2) phase_kernel(Params p, int ph) { const int wid_u = __builtin_amdgcn_readfirstlane(threadIdx.x >> 6); do_phase(p, ph, dyn_smem, wid_u); }

extern "C" void kernel_launch(void* const* d_in, const int* in_sizes, int n_in, void* d_out, int out_size, void* d_ws, size_t ws_size,
                              hipStream_t stream) {
  Params p{};
  const float** f = (const float**)&p;
  for (int i = 0; i < 33; ++i) f[i] = (const float*)d_in[i];
  p.out = (float*)d_out;
  p.ws = (char*)d_ws;
  if (WS_NEED > ws_size) { fprintf(stderr, "workspace too small: need %zu have %zu\n", (size_t)WS_NEED, ws_size); return; }

#if ONE_LAUNCH
  static int grid_blocks = 0;
  if (!grid_blocks) {
    int dev = 0, cus = 0, per_cu = 0;
    (void)hipGetDevice(&dev);
    (void)hipDeviceGetAttribute(&cus, hipDeviceAttributeMultiprocessorCount, dev);
    (void)hipFuncSetAttribute((const void*)mega_kernel, hipFuncAttributeMaxDynamicSharedMemorySize, SMEM_BYTES);
    (void)hipOccupancyMaxActiveBlocksPerMultiprocessor(&per_cu, mega_kernel, NTHR, SMEM_BYTES);
    if (per_cu < 1) per_cu = 1;
    grid_blocks = cus * per_cu;
  }
  void* args[] = {&p};
  hipError_t e = hipLaunchCooperativeKernel((const void*)mega_kernel, dim3(grid_blocks), dim3(NTHR), args, SMEM_BYTES, stream);
  if (e != hipSuccess) fprintf(stderr, "cooperative launch failed: %s (grid %d)\n", hipGetErrorString(e), grid_blocks);
#else
  static bool attr = false;
  if (!attr) { (void)hipFuncSetAttribute((const void*)phase_kernel, hipFuncAttributeMaxDynamicSharedMemorySize, SMEM_BYTES); attr = true; }
  for (int ph = 0; ph < NPHASE; ++ph) phase_kernel<<<256, NTHR, SMEM_BYTES, stream>>>(p, ph);
#endif
}
```

```cpp
#include <hip/hip_runtime.h>
#include <hip/hip_cooperative_groups.h>
#include <cstdio>
namespace cg = cooperative_groups;

#ifndef ONE_LAUNCH
#define ONE_LAUNCH 1
#endif

typedef unsigned short bf16_t;
typedef short bf16x8 __attribute__((ext_vector_type(8)));
typedef float f32x4 __attribute__((ext_vector_type(4)));
typedef float f32x2 __attribute__((ext_vector_type(2)));
#define LAS __attribute__((address_space(3)))

constexpr int D = 1024, FF = 2816, NTOK = 98304, NPROMPT = 32768, ZLD = 2560, PINW = 2464;
constexpr int NTHR = 512;
constexpr int SMEM_BYTES = 162048;

struct Params {
  const float *x_prompt, *x_sample, *c_prompt, *c_sample, *ada_w, *ada_b, *n1_pre, *n1_post, *f1_w1, *f1_w3, *f1_w2,
      *nm_pre, *nm_post, *w_in, *shift_mu, *pool_w, *pool_scale, *w0, *w2, *a0, *a2, *g2, *k_k, *k_a, *r_k, *lnx_g, *lnx_b,
      *w_out, *n2_pre, *n2_post, *f2_w1, *f2_w3, *f2_w2;
  float* out;
  char* ws;
};
#define PREF const __attribute__((address_space(4))) Params&
constexpr size_t al256(size_t b) { return (b + 255) & ~(size_t)255; }
constexpr size_t OFF_W13A = 0;
constexpr size_t OFF_W13B = OFF_W13A + al256((size_t)2 * FF * D * 2);
constexpr size_t OFF_W2A = OFF_W13B + al256((size_t)2 * FF * D * 2);
constexpr size_t OFF_W2B = OFF_W2A + al256((size_t)D * FF * 2);
constexpr size_t OFF_WINT = OFF_W2B + al256((size_t)D * FF * 2);
constexpr size_t OFF_WOUTT = OFF_WINT + al256((size_t)ZLD * D * 2);
constexpr size_t OFF_MOD = OFF_WOUTT + al256((size_t)D * D * 2);
constexpr size_t OFF_SBON = OFF_MOD + al256((size_t)16 * 9216 * 4);
constexpr size_t OFF_RH = OFF_SBON + al256((size_t)NTOK * 16 * 4);
constexpr size_t OFF_RY = OFF_RH + al256((size_t)NTOK * D * 2);
constexpr size_t OFF_RU = OFF_RY + al256((size_t)NTOK * D * 2);
constexpr size_t WS_NEED = OFF_RU + al256((size_t)NTOK * FF * 2);
#define P_W13A ((bf16_t*)(p.ws + OFF_W13A))
#define P_W13B ((bf16_t*)(p.ws + OFF_W13B))
#define P_W2A ((bf16_t*)(p.ws + OFF_W2A))
#define P_W2B ((bf16_t*)(p.ws + OFF_W2B))
#define P_WINT ((bf16_t*)(p.ws + OFF_WINT))
#define P_WOUTT ((bf16_t*)(p.ws + OFF_WOUTT))
#define P_MOD ((float*)(p.ws + OFF_MOD))
#define P_SBON ((float*)(p.ws + OFF_SBON))
#define P_RH ((bf16_t*)(p.ws + OFF_RH))
#define P_RY ((bf16_t*)(p.ws + OFF_RY))
#define P_RU ((bf16_t*)(p.ws + OFF_RU))

typedef __bf16 bf16x2_t __attribute__((ext_vector_type(2)));
__device__ __forceinline__ unsigned cvt_pk_bf16(float lo, float hi) {
  f32x2 v = {lo, hi};
  bf16x2_t b = __builtin_convertvector(v, bf16x2_t);
  return __builtin_bit_cast(unsigned, b);
}
__device__ __forceinline__ float bf_lo(unsigned u) { return __uint_as_float(u << 16); }
__device__ __forceinline__ float bf_hi(unsigned u) { return __uint_as_float(u & 0xffff0000u); }
__device__ __forceinline__ float bf2f(bf16_t b) { return __uint_as_float(((unsigned)b) << 16); }
__device__ __forceinline__ void unpack8(uint4 v, float* o) {
  o[0] = bf_lo(v.x); o[1] = bf_hi(v.x); o[2] = bf_lo(v.y); o[3] = bf_hi(v.y);
  o[4] = bf_lo(v.z); o[5] = bf_hi(v.z); o[6] = bf_lo(v.w); o[7] = bf_hi(v.w);
}
__device__ __forceinline__ uint4 pack8(const float* o) {
  uint4 v; v.x = cvt_pk_bf16(o[0], o[1]); v.y = cvt_pk_bf16(o[2], o[3]); v.z = cvt_pk_bf16(o[4], o[5]); v.w = cvt_pk_bf16(o[6], o[7]);
  return v;
}
__device__ __forceinline__ float sigmoidf_(float x) { return __builtin_amdgcn_rcpf(1.f + __expf(-x)); }
template <int CTRL> __device__ __forceinline__ float dpp_f(float x) {
  return __int_as_float(__builtin_amdgcn_update_dpp(0, __float_as_int(x), CTRL, 0xf, 0xf, false));
}
__device__ __forceinline__ float row16_sum(float x) {
  x += dpp_f<0x128>(x); x += dpp_f<0x124>(x); x += dpp_f<0x122>(x); x += dpp_f<0x121>(x);
  return x;
}
template <class T> __device__ __forceinline__ T sel(bool c, T a, T b) { return c ? a : b; }
__device__ __forceinline__ int opaque_tid_w(int wid) {
  int l;
  asm volatile("v_mbcnt_lo_u32_b32 %0, -1, 0\n\tv_mbcnt_hi_u32_b32 %0, -1, %0" : "=v"(l));
  return wid * 64 + l;
}
#define opaque_tid() opaque_tid_w(wid_u)
__device__ __forceinline__ float wave_sum(float v) {
  v = row16_sum(v);
  const float a = __int_as_float(__builtin_amdgcn_readlane(__float_as_int(v), 0)), b = __int_as_float(__builtin_amdgcn_readlane(__float_as_int(v), 16));
  const float c = __int_as_float(__builtin_amdgcn_readlane(__float_as_int(v), 32)), d = __int_as_float(__builtin_amdgcn_readlane(__float_as_int(v), 48));
  return (a + b) + (c + d);
}
__device__ __forceinline__ float quad_sum(float x) { x += dpp_f<0xB1>(x); x += dpp_f<0x4E>(x); return x; }
__device__ __forceinline__ int seq_start(int s) { return s < 8 ? s * 4096 : NPROMPT + (s - 8) * 8192; }
__device__ __forceinline__ void row_seq(int row, int& s, int& t, int& T) {
  if (row < NPROMPT) { s = row >> 12; t = row & 4095; T = 4096; }
  else { int r = row - NPROMPT; s = 8 + (r >> 13); t = r & 8191; T = 8192; }
}

__device__ __forceinline__ void tr_tile(const float* __restrict__ src, int ldsrc, int k0, int n0, int nvalid, bf16_t* __restrict__ dst, int ldd,
                        int kdst0, int mode, float* sm, const int tid) {
#pragma unroll
  for (int i = 0; i < 2; ++i) {
    const int r = (tid >> 4) + 32 * i, c = (tid & 15) * 4;
    float4 v = make_float4(0.f, 0.f, 0.f, 0.f);
    if (n0 + c < nvalid) v = *(const float4*)(src + (size_t)(k0 + r) * ldsrc + n0 + c);
    float* d = sm + r * 65 + c;
    d[0] = v.x; d[1] = v.y; d[2] = v.z; d[3] = v.w;
  }
  __syncthreads();
  {
    const int n = tid >> 3, kc = (tid & 7) * 8;
    float o[8];
#pragma unroll
    for (int j = 0; j < 8; ++j) o[j] = sm[(kc + j) * 65 + n];
    int nn = n0 + n, drow;
    if (mode == 0) drow = nn;
    else drow = 32 * (nn >> 4) + (nn & 15) + (mode == 2 ? 16 : 0);
    *(uint4*)(dst + (size_t)drow * ldd + kdst0 + k0 + kc) = pack8(o);
  }
  __syncthreads();
}

__device__ __forceinline__ void prep_phase(PREF p, char* smem, const int wid_u) {
  float* sm = (float*)smem;
  const int tid = opaque_tid();
  constexpr int N_MOD = 144, N_EFF = 128, N_W13 = 4 * 704, N_W2 = 2 * 704, N_WIN = 640, N_WOUT = 128;
  constexpr int TOTAL = N_MOD + N_EFF + N_W13 + N_W2 + N_WIN + N_WOUT;
  for (int item = blockIdx.x; item < TOTAL; item += gridDim.x) {
    int it = item;
    if (it < N_MOD) {
      const int j0 = it * 64;
      float* sc = sm;
      float* red = sm + 16384;
      for (int idx = tid; idx < 16384; idx += NTHR) {
        const int s = idx >> 10, k = idx & 1023;
        const float* cp_ = p.c_prompt; const float* cs_ = p.c_sample;
        const float c = s < 8 ? cp_[s * 1024 + k] : cs_[(s - 8) * 1024 + k];
        sc[idx] = c / (1.f + __expf(-c));
      }
      __syncthreads();
      const int col = tid & 63, kg = tid >> 6;
      float acc[16];
#pragma unroll
      for (int s = 0; s < 16; ++s) acc[s] = 0.f;
      for (int k = kg * 128; k < kg * 128 + 128; ++k) {
        const float w = p.ada_w[(size_t)k * 9216 + j0 + col];
#pragma unroll
        for (int s = 0; s < 16; ++s) acc[s] += sc[s * 1024 + k] * w;
      }
#pragma unroll
      for (int s = 0; s < 16; ++s) red[(kg * 16 + s) * 64 + col] = acc[s];
      __syncthreads();
      for (int o = tid; o < 1024; o += NTHR) {
        const int s = o >> 6, c2 = o & 63;
        float v = p.ada_b[j0 + c2];
#pragma unroll
        for (int g = 0; g < 8; ++g) v += red[(g * 16 + s) * 64 + c2];
        P_MOD[s * 9216 + j0 + c2] = v;
      }
      __syncthreads();
      continue;
    }
    it -= N_MOD;
    if (it < N_EFF) {
      const int g = it >> 5, itile = (it >> 4) & 1, ntile = it & 15;
      float* As = sm;
      float* Bs = sm + 64 * 129;
      for (int idx = tid; idx < 64 * 128; idx += NTHR) {
        const int i = idx >> 7, j = idx & 127;
        As[i * 129 + j] = p.pool_w[((size_t)g * 128 + itile * 64 + i) * 128 + j] * p.pool_scale[g * 128 + j];
      }
      for (int idx = tid; idx < 128 * 64; idx += NTHR) {
        const int j = idx >> 6, nn = idx & 63;
        Bs[j * 65 + nn] = p.w_out[(size_t)(g * 128 + j) * 1024 + ntile * 64 + nn];
      }
      __syncthreads();
      const int i = tid >> 3, nn0 = (tid & 7) * 8;
      float acc[8];
#pragma unroll
      for (int q = 0; q < 8; ++q) acc[q] = 0.f;
      for (int j = 0; j < 128; ++j) {
        const float a = As[i * 129 + j];
#pragma unroll
        for (int q = 0; q < 8; ++q) acc[q] += a * Bs[j * 65 + nn0 + q];
      }
#pragma unroll
      for (int q = 0; q < 8; ++q)
        P_WOUTT[(size_t)(ntile * 64 + nn0 + q) * 1024 + g * 128 + itile * 64 + i] = (bf16_t)(cvt_pk_bf16(acc[q], 0.f) & 0xffff);
      __syncthreads();
      continue;
    }
    it -= N_EFF;
    if (it < N_W13) {
      const int which = it / 704, r = it % 704;
      const int kt = r / 44, ntl = r % 44;
      const float* src = sel(which < 2, sel(which == 0, p.f1_w1, p.f1_w3), sel(which == 2, p.f2_w1, p.f2_w3));
      bf16_t* dst = sel(which < 2, P_W13A, P_W13B);
      tr_tile(src, FF, kt * 64, ntl * 64, FF, dst, D, 0, (which & 1) ? 2 : 1, sm, tid);
      continue;
    }
    it -= N_W13;
    if (it < N_W2) {
      const int which = it / 704, r = it % 704;
      const int kt = r / 16, ntl = r % 16;
      tr_tile(sel(which != 0, p.f2_w2, p.f1_w2), D, kt * 64, ntl * 64, D, sel(which != 0, P_W2B, P_W2A), FF, 0, 0, sm, tid);
      continue;
    }
    it -= N_W2;
    if (it < N_WIN) {
      const int kt = it / 40, ntl = it % 40;
      tr_tile(p.w_in, PINW, kt * 64, ntl * 64, PINW, P_WINT, D, 0, 0, sm, tid);
      continue;
    }
    it -= N_WIN;
    {
      const int kt = it / 16, ntl = it % 16;
      tr_tile(p.w_out + (size_t)512 * 1024, D, kt * 64, ntl * 64, D, P_WOUTT, D, 512, 0, sm, tid);
    }
  }
}

template <int MODE>
__device__ __forceinline__ void row_phase(const float* __restrict__ xp, const float* __restrict__ xs, float* __restrict__ xout,
                          const bf16_t* __restrict__ y, bf16_t* __restrict__ h, const float* __restrict__ mod,
                          const float* __restrict__ npost, const float* __restrict__ npre, int gate_idx, float cgate, int shift_idx, const int wid_u) {
  const int tid_ = opaque_tid();
  const int lane = tid_ & 63;
  const int gw = blockIdx.x * 8 + (tid_ >> 6), GW = gridDim.x * 8;
  for (int chunk = gw; chunk < NTOK / 16; chunk += GW) {
    const int row0 = chunk * 16;
    int s, t, T;
    row_seq(row0, s, t, T);
    const float* md = mod + s * 9216;
    f32x4 Am[4], Bm[4], Gm[4];
#pragma unroll
    for (int i = 0; i < 4; ++i) {
      const int c = i * 256 + lane * 4;
      if (MODE != 2) {
        f32x4 np = *(const f32x4*)(npre + c), sc = *(const f32x4*)(md + (shift_idx + 1) * 1024 + c);
        Am[i] = np * (sc + 1.f);
        Bm[i] = *(const f32x4*)(md + shift_idx * 1024 + c);
      }
      if (MODE != 0) {
        f32x4 g = *(const f32x4*)(md + gate_idx * 1024 + c), po = *(const f32x4*)(npost + c);
        Gm[i] = g * po * cgate;
      }
    }
    for (int r = 0; r < 16; ++r) {
      const int row = row0 + r;
      const float* xr = (row < NPROMPT) ? xp + (size_t)row * D : xs + (size_t)(row - NPROMPT) * D;
      f32x4 xv[4];
#pragma unroll
      for (int i = 0; i < 4; ++i) xv[i] = *(const f32x4*)(xr + i * 256 + lane * 4);
      if (MODE != 0) {
        f32x4 yv[4];
        float ss = 0.f;
#pragma unroll
        for (int i = 0; i < 4; ++i) {
          uint2 u = *(const uint2*)(y + (size_t)row * D + i * 256 + lane * 4);
          yv[i] = (f32x4){bf_lo(u.x), bf_hi(u.x), bf_lo(u.y), bf_hi(u.y)};
          ss += yv[i][0] * yv[i][0] + yv[i][1] * yv[i][1] + yv[i][2] * yv[i][2] + yv[i][3] * yv[i][3];
        }
        ss = wave_sum(ss);
        const float rs = rsqrtf(ss * (1.f / 1024.f) + 1e-6f);
#pragma unroll
        for (int i = 0; i < 4; ++i) {
          xv[i] = xv[i] + Gm[i] * yv[i] * rs;
          *(f32x4*)(xout + (size_t)row * D + i * 256 + lane * 4) = xv[i];
        }
      }
      if (MODE != 2) {
        float ss = 0.f;
#pragma unroll
        for (int i = 0; i < 4; ++i) ss += xv[i][0] * xv[i][0] + xv[i][1] * xv[i][1] + xv[i][2] * xv[i][2] + xv[i][3] * xv[i][3];
        ss = wave_sum(ss);
        const float rs = rsqrtf(ss * (1.f / 1024.f) + 1e-6f);
#pragma unroll
        for (int i = 0; i < 4; ++i) {
          f32x4 hv = xv[i] * rs * Am[i] + Bm[i];
          uint2 u; u.x = cvt_pk_bf16(hv[0], hv[1]); u.y = cvt_pk_bf16(hv[2], hv[3]);
          *(uint2*)(h + (size_t)row * D + i * 256 + lane * 4) = u;
        }
      }
    }
  }
}

constexpr int BM = 256, BK = 64, HALF = 128, NXCD = 8, WGM = 8, HT = HALF * BK;
__device__ __forceinline__ int lds_byte(int r, int c) {
  int st = (r >> 4) * 2 + (c >> 5), rr = r & 15, cc = c & 31, ob = rr * 64 + cc * 2;
  return st * 1024 + (ob ^ (((ob >> 9) & 1) << 5));
}
__device__ __forceinline__ void stage_rc(int b, int& R, int& C) {
  int st = b / 1024, sb = b % 1024, swz = sb ^ (((sb >> 9) & 1) << 5);
  R = (st >> 1) * 16 + swz / 64; C = (st & 1) * 32 + (swz % 64) / 2;
}

__device__ __forceinline__ void gemm_tile(const bf16_t* __restrict__ A, const bf16_t* __restrict__ Bt, bf16_t* __restrict__ C,
                                          int K, int ldc, int brow, int bcol, LAS bf16_t* shm, const int EPI, const int tid) {
#define SA(b, h) (shm + ((b) * 2 + (h)) * HT)
#define SB(b, h) (shm + (4 + (b) * 2 + (h)) * HT)
#define STAGE(P, BASE, br, kt) do { const char* _gb = (const char*)(BASE) + (((long)(br) * K + (long)(kt) * BK) << 1); \
    _Pragma("unroll") for (int _i = 0; _i < 2; ++_i) { \
      __builtin_amdgcn_global_load_lds((const unsigned*)(_gb + voff[_i]), \
        (LAS unsigned*)((LAS char*)(P) + ldsw + _i * 8192), 16, 0, 0); } } while (0)
#define LDA(dst, b, h) _Pragma("unroll") for (int m = 0; m < 4; ++m) _Pragma("unroll") for (int k = 0; k < 2; ++k) \
    dst[m][k] = *(const LAS bf16x8*)((LAS char*)SA(b, h) + aoff + m * 2048 + k * 1024)
#define LDB(dst, b, h) _Pragma("unroll") for (int n = 0; n < 2; ++n) _Pragma("unroll") for (int k = 0; k < 2; ++k) \
    dst[n][k] = *(const LAS bf16x8*)((LAS char*)SB(b, h) + boff + n * 2048 + k * 1024)
#define MMA(ai, bj, At_, Bt_) do { __builtin_amdgcn_s_setprio(1); \
    _Pragma("unroll") for (int m = 0; m < 4; ++m) _Pragma("unroll") for (int n = 0; n < 2; ++n) _Pragma("unroll") for (int k = 0; k < 2; ++k) \
      acc[ai][bj][m][n] = __builtin_amdgcn_mfma_f32_16x16x32_bf16(Bt_[n][k], At_[m][k], acc[ai][bj][m][n], 0, 0, 0); \
    __builtin_amdgcn_s_setprio(0); } while (0)
#define WAIT_V(n) asm volatile("s_waitcnt vmcnt(" #n ")" ::: "memory")
#define WAIT_L(n) asm volatile("s_waitcnt lgkmcnt(" #n ")" ::: "memory")
#define BAR __builtin_amdgcn_s_barrier()
#define SCHED __builtin_amdgcn_sched_barrier(0)
  const int wid = __builtin_amdgcn_readfirstlane(tid >> 6), lane = tid & 63, wr = wid >> 2, wc = wid & 3, fr = lane & 15, fq = lane >> 4;
  const int aoff = lds_byte(wr * 64 + fr, fq * 8), boff = lds_byte(wc * 32 + fr, fq * 8);
  f32x4 acc[2][2][4][2] = {};
  bf16x8 At[4][2], B0[2][2], B1[2][2];
  unsigned voff[2];
  const int ldsw = wid * 1024;
#pragma unroll
  for (int _i = 0; _i < 2; ++_i) { int _r, _c; stage_rc(tid * 16 + _i * 8192, _r, _c); voff[_i] = (unsigned)(_r * K + _c) * 2u; }
  const int nt = K / BK;
  STAGE(SB(0, 0), Bt, bcol, 0); STAGE(SA(0, 0), A, brow, 0);
  STAGE(SB(0, 1), Bt, bcol + HALF, 0); STAGE(SA(0, 1), A, brow + HALF, 0);
  if (wr == 1) BAR;
  WAIT_V(4); BAR;
  STAGE(SB(1, 0), Bt, bcol, 1); STAGE(SA(1, 0), A, brow, 1); STAGE(SB(1, 1), Bt, bcol + HALF, 1);
  WAIT_V(6); BAR;
  for (int t = 0; t < nt - 2; t += 2) {
    LDB(B0, 0, 0); SCHED; LDA(At, 0, 0); STAGE(SA(1, 1), A, brow + HALF, t + 1);
    WAIT_L(8); BAR; WAIT_L(0); MMA(0, 0, At, B0); BAR; SCHED;
    LDB(B1, 0, 1); STAGE(SB(0, 0), Bt, bcol, t + 2);
    BAR; WAIT_L(0); MMA(0, 1, At, B1); BAR;
    LDA(At, 0, 1); STAGE(SA(0, 0), A, brow, t + 2);
    BAR; WAIT_L(0); MMA(1, 0, At, B0); BAR; SCHED;
    STAGE(SB(0, 1), Bt, bcol + HALF, t + 2);
    WAIT_V(6); BAR; MMA(1, 1, At, B1); BAR;
    LDB(B0, 1, 0); SCHED; LDA(At, 1, 0); STAGE(SA(0, 1), A, brow + HALF, t + 2);
    WAIT_L(8); BAR; WAIT_L(0); MMA(0, 0, At, B0); BAR; SCHED;
    LDB(B1, 1, 1); STAGE(SB(1, 0), Bt, bcol, t + 3);
    BAR; WAIT_L(0); MMA(0, 1, At, B1); BAR;
    LDA(At, 1, 1); STAGE(SA(1, 0), A, brow, t + 3);
    BAR; WAIT_L(0); MMA(1, 0, At, B0); BAR; SCHED;
    STAGE(SB(1, 1), Bt, bcol + HALF, t + 3);
    WAIT_V(6); BAR; MMA(1, 1, At, B1); BAR;
  }
  { LDB(B0, 0, 0); LDA(At, 0, 0); STAGE(SA(1, 1), A, brow + HALF, nt - 1);
    BAR; WAIT_L(0); MMA(0, 0, At, B0); BAR;
    LDB(B1, 0, 1); BAR; WAIT_L(0); MMA(0, 1, At, B1); BAR;
    LDA(At, 0, 1); WAIT_V(4); BAR; WAIT_L(0); MMA(1, 0, At, B0); MMA(1, 1, At, B1); BAR; }
  { LDB(B0, 1, 0); LDA(At, 1, 0); WAIT_V(2); BAR; WAIT_L(0); MMA(0, 0, At, B0); BAR;
    LDB(B1, 1, 1); WAIT_V(0); BAR; WAIT_L(0); MMA(0, 1, At, B1); BAR;
    LDA(At, 1, 1); BAR; WAIT_L(0); MMA(1, 0, At, B0); MMA(1, 1, At, B1); BAR; }
  if (wr == 0) BAR;
#pragma unroll
  for (int ai = 0; ai < 2; ++ai)
#pragma unroll
    for (int m = 0; m < 4; ++m) {
      const size_t row = (size_t)(brow + ai * HALF + wr * 64 + m * 16 + fr);
#pragma unroll
      for (int bj = 0; bj < 2; ++bj) {
        if (EPI == 0) {
#pragma unroll
          for (int n = 0; n < 2; ++n) {
            const f32x4 v = acc[ai][bj][m][n];
            uint2 u; u.x = cvt_pk_bf16(v[0], v[1]); u.y = cvt_pk_bf16(v[2], v[3]);
            *(uint2*)(C + row * ldc + bcol + bj * HALF + wc * 32 + n * 16 + fq * 4) = u;
          }
        } else {
          const f32x4 a = acc[ai][bj][m][0], b = acc[ai][bj][m][1];
          float o[4];
#pragma unroll
          for (int j = 0; j < 4; ++j) o[j] = a[j] * __builtin_amdgcn_rcpf(1.f + __expf(-a[j])) * b[j];
          uint2 u; u.x = cvt_pk_bf16(o[0], o[1]); u.y = cvt_pk_bf16(o[2], o[3]);
          *(uint2*)(C + row * ldc + ((bcol + bj * HALF + wc * 32) >> 1) + fq * 4) = u;
        }
      }
    }
#undef SA
#undef SB
#undef STAGE
#undef LDA
#undef LDB
#undef MMA
}

__device__ __forceinline__ void gemm_phase(const bf16_t* A, const bf16_t* Bt, bf16_t* C, int M, int N, int K, int ldc, int EPI, char* smem, const int wid_u) {
  const int nM = M / BM, nN = N / BM, nwg = nM * nN;
  const int tid = opaque_tid();
  for (int L = blockIdx.x; L < nwg; L += gridDim.x) {
    int wgid = L;
    { int q = nwg / NXCD, r = nwg % NXCD, xcd = wgid % NXCD, off = wgid / NXCD;
      wgid = (xcd < r ? xcd * (q + 1) : r * (q + 1) + (xcd - r) * q) + off; }
    const int nig = WGM * nN, gid = wgid / nig, fm = gid * WGM, gsz = min(nM - fm, WGM);
    const int pm = fm + ((wgid % nig) % gsz), pn = (wgid % nig) / gsz;
    gemm_tile(A, Bt, C, K, ldc, pm * BM, pn * BM, (LAS bf16_t*)smem, EPI, tid);
  }
}

__device__ __forceinline__ void load_shift16(const bf16_t* __restrict__ z, int row, int t, int T, int col, const float* __restrict__ mu, float* o) {
  const bf16_t* pz = z + (size_t)row * ZLD + col;
  uint4 c0 = *(const uint4*)pz, c1 = *(const uint4*)(pz + 8);
  uint4 p0 = make_uint4(0, 0, 0, 0), p1 = p0, n0 = p0, n1 = p0;
  if (t > 0) { p0 = *(const uint4*)(pz - ZLD); p1 = *(const uint4*)(pz - ZLD + 8); }
  if (t < T - 1) { n0 = *(const uint4*)(pz + ZLD); n1 = *(const uint4*)(pz + ZLD + 8); }
  float c[16], pv[16], nx[16];
  unpack8(c0, c); unpack8(c1, c + 8); unpack8(p0, pv); unpack8(p1, pv + 8); unpack8(n0, nx); unpack8(n1, nx + 8);
#pragma unroll
  for (int q = 0; q < 16; ++q) o[q] = c[q] + (0.5f * (pv[q] + nx[q]) - c[q]) * mu[col - 512 + q];
}
__device__ __forceinline__ void load_shift8(const bf16_t* __restrict__ z, int row, int t, int T, int col, const float* __restrict__ mu, float* o) {
  const bf16_t* pz = z + (size_t)row * ZLD + col;
  uint4 c0 = *(const uint4*)pz;
  uint4 p0 = make_uint4(0, 0, 0, 0), n0 = p0;
  if (t > 0) p0 = *(const uint4*)(pz - ZLD);
  if (t < T - 1) n0 = *(const uint4*)(pz + ZLD);
  float c[8], pv[8], nx[8];
  unpack8(c0, c); unpack8(p0, pv); unpack8(n0, nx);
#pragma unroll
  for (int q = 0; q < 8; ++q) o[q] = c[q] + (0.5f * (pv[q] + nx[q]) - c[q]) * mu[col - 512 + q];
}

constexpr int TC = 32;
constexpr int SV = TC * 64;
__device__ __forceinline__ void pool_tile(const bf16_t* __restrict__ z, bf16_t* __restrict__ mo, int tile, int tid) {
  const int row0 = tile * 32;
  int s, t0, T;
  row_seq(row0, s, t0, T);
  for (int idx = tid; idx < 32 * 64; idx += NTHR) {
    const int tok = idx >> 6, oc = idx & 63, row = row0 + tok, t = t0 + tok;
    const int c0 = oc * 8, half = 1 << (c0 >> 7);
    const int lo = max(t - half, 0), hi = min(t + half, T);
    float sum[8];
#pragma unroll
    for (int q = 0; q < 8; ++q) sum[q] = 0.f;
    float zc[8];
    for (int tt = lo; tt < hi; ++tt) {
      float zz[8];
      unpack8(*(const uint4*)(z + (size_t)(row + tt - t) * ZLD + c0), zz);
#pragma unroll
      for (int q = 0; q < 8; ++q) sum[q] += zz[q];
      if (tt == t) {
#pragma unroll
        for (int q = 0; q < 8; ++q) zc[q] = zz[q];
      }
    }
    const float ic = 1.f / (float)(hi - lo);
#pragma unroll
    for (int q = 0; q < 8; ++q) sum[q] = sum[q] * ic - zc[q];
    *(uint4*)(mo + (size_t)row * D + c0) = pack8(sum);
  }
}

struct Raw16 { uint4 c0, c1, p0, p1, n0, n1; };
__device__ __forceinline__ void load_raw16(Raw16& r, const bf16_t* __restrict__ z, int row, int t, int T, int col) {
  const bf16_t* pz = z + (size_t)row * ZLD + col;
  r.c0 = *(const uint4*)pz; r.c1 = *(const uint4*)(pz + 8);
  r.p0 = make_uint4(0, 0, 0, 0); r.p1 = r.p0; r.n0 = r.p0; r.n1 = r.p0;
  if (t > 0) { r.p0 = *(const uint4*)(pz - ZLD); r.p1 = *(const uint4*)(pz - ZLD + 8); }
  if (t < T - 1) { r.n0 = *(const uint4*)(pz + ZLD); r.n1 = *(const uint4*)(pz + ZLD + 8); }
}
__device__ __forceinline__ void shift16(const Raw16& r, const float* mu, float* o) {
  float c[16], pv[16], nx[16];
  unpack8(r.c0, c); unpack8(r.c1, c + 8); unpack8(r.p0, pv); unpack8(r.p1, pv + 8); unpack8(r.n0, nx); unpack8(r.n1, nx + 8);
#pragma unroll
  for (int q = 0; q < 16; ++q) o[q] = c[q] + (0.5f * (pv[q] + nx[q]) - c[q]) * mu[q];
}
__device__ __forceinline__ bf16x8 ldfrag(const bf16_t* base, int stride, int row0, int k0, int fr, int fq) {
  return *reinterpret_cast<const bf16x8*>(base + (row0 + fr) * stride + k0 + fq * 8);
}
__device__ __forceinline__ uint2 pack4(f32x4 v) { uint2 u; u.x = cvt_pk_bf16(v[0], v[1]); u.y = cvt_pk_bf16(v[2], v[3]); return u; }
#define MFMA16(a, b, c) __builtin_amdgcn_mfma_f32_16x16x32_bf16(a, b, c, 0, 0, 0)

constexpr int CS_NAB = 0, CS_NAK = 4096, CS_NBRT = 8192, CS_NKRT = 10752, CS_QT = 13312, CS_W = 15872, CS_Z = 20992, CS_GT = 26112,
              CS_RYT = 35328, CS_VN = 39936;
constexpr int CS_AT = 49152, CS_RT = CS_AT + 4608, CS_BT = CS_RT + 4608, CS_KT = CS_BT + 4608, CS_BB = 67584, CS_KB = CS_BB + 5120,
              CS_VT = CS_KB + 5120, CS_ATT = 82944, CS_PL = 92160, CS_SBF = 92416, CS_PRIV = 110848, CS_CST = 143616, CS_BL = 145664;

__device__ __forceinline__ void lds_barrier() {
  asm volatile("s_waitcnt lgkmcnt(0)" ::: "memory");
  __builtin_amdgcn_s_barrier();
  asm volatile("" ::: "memory");
}
template <int Q> __device__ __forceinline__ float quad_bcast(float x) { return dpp_f<Q * 0x55>(x); }

template <int S0> __device__ __forceinline__ void solve_steps(float (&x)[8], const float* nab, int seg) {
  if constexpr (S0 < 32) {
    const float xs = quad_bcast<(S0 >> 3)>(x[S0 & 7]);
    const f32x4 n0 = *(const f32x4*)(nab + S0 * 32 + seg * 8), n1 = *(const f32x4*)(nab + S0 * 32 + seg * 8 + 4);
    x[0] += xs * n0[0]; x[1] += xs * n0[1]; x[2] += xs * n0[2]; x[3] += xs * n0[3];
    x[4] += xs * n1[0]; x[5] += xs * n1[1]; x[6] += xs * n1[2]; x[7] += xs * n1[3];
    solve_steps<S0 + 1>(x, nab, seg);
  }
}

__device__ __forceinline__ void scan_phase(PREF p, char* smem, const int wid_u) {
  float* stepbuf = (float*)smem;
  float* Nab = (float*)(smem + CS_NAB);
  bf16_t* NakT = (bf16_t*)(smem + CS_NAK);
  bf16_t* VNb = (bf16_t*)(smem + CS_VN);
  bf16_t* NbrT = (bf16_t*)(smem + CS_NBRT);
  bf16_t* NkrT = (bf16_t*)(smem + CS_NKRT);
  bf16_t* TT = (bf16_t*)(smem + CS_QT);
  bf16_t* Wb = (bf16_t*)(smem + CS_W);
  bf16_t* Zb = (bf16_t*)(smem + CS_Z);
  bf16_t* GT = (bf16_t*)(smem + CS_GT);
  bf16_t* RyT = (bf16_t*)(smem + CS_RYT);
  bf16_t* At = (bf16_t*)(smem + CS_AT);
  bf16_t* Rt = (bf16_t*)(smem + CS_RT);
  bf16_t* Bt = (bf16_t*)(smem + CS_BT);
  bf16_t* Kt = (bf16_t*)(smem + CS_KT);
  bf16_t* Bb = (bf16_t*)(smem + CS_BB);
  bf16_t* Kb = (bf16_t*)(smem + CS_KB);
  bf16_t* VT = (bf16_t*)(smem + CS_VT);
  bf16_t* AtTb = (bf16_t*)(smem + CS_ATT);
  float* PLs = (float*)(smem + CS_PL);
  bf16_t* Sbf = (bf16_t*)(smem + CS_SBF);
  float* cst = (float*)(smem + CS_CST);
  const bf16_t* z = P_RU;
  const int tid = opaque_tid();
  const int wave = __builtin_amdgcn_readfirstlane(tid >> 6), lane = tid & 63, fr = lane & 15, fq = lane >> 4;
  const int item = blockIdx.x;
  if (item < 256) {
    const int s = item < 128 ? 8 + (item >> 4) : ((item - 128) >> 4);
    const int h = (item & 15) >> 1, d = item & 1;
    const int T = s < 8 ? 4096 : 8192, r0seq = seq_start(s), nch = T / 32;
    bf16_t* yout = P_RY + (size_t)d * NTOK * 512;
    {
      const int g = tid >> 6, k = tid & 63;
      float v;
      if (g == 0) v = p.shift_mu[2048 - 512 + d * 64 + k];
      else if (g == 1) v = p.shift_mu[2176 - 512 + d * 64 + k];
      else if (g == 2) v = p.shift_mu[1024 - 512 + h * 64 + k];
      else if (g == 3) v = p.shift_mu[512 - 512 + h * 64 + k];
      else if (g == 4) v = p.shift_mu[1536 - 512 + h * 64 + k];
      else if (g == 5) v = p.k_k[h * 64 + k];
      else if (g == 6) v = p.k_a[h * 64 + k];
      else v = p.r_k[h * 64 + k];
      cst[g * 64 + k] = v;
      for (int i = tid; i < 2 * 64 * 72 / 2; i += NTHR) ((unsigned*)Sbf)[i] = 0u;
    }
    const int role = wave >> 1, th = wave & 1;
    const int tl = lane >> 2, cq = lane & 3;
    bf16_t* Ab = (bf16_t*)(smem + CS_PRIV + (wave & 3) * 8192);
    float* tmpa = (float*)(smem + CS_PRIV + (wave & 3) * 8192 + 2560);
    uint4* Blds = (uint4*)(smem + CS_BL) + (role & 1) * 512;
    float bias[4] = {0.f, 0.f, 0.f, 0.f};
    if (role < 2) {
      const float* lsrc = sel(role != 0, p.a2, p.w2) + (size_t)d * 64 * 512 + h * 64;
      if (th == 0) {
#pragma unroll
        for (int nt = 0; nt < 4; ++nt)
#pragma unroll
          for (int ks = 0; ks < 2; ++ks) {
            float o[8];
#pragma unroll
            for (int q = 0; q < 8; ++q) o[q] = lsrc[(size_t)(ks * 32 + fq * 8 + q) * 512 + nt * 16 + fr];
            Blds[(nt * 2 + ks) * 64 + lane] = pack8(o);
          }
      }
#pragma unroll
      for (int nt = 0; nt < 4; ++nt) bias[nt] = sel(role != 0, p.a0, p.w0)[d * 512 + h * 64 + nt * 16 + fr];
    }
    const int colA = (role == 0 ? 2048 + d * 64 : role == 1 ? 2176 + d * 64 : 512 + h * 64) + cq * 16;
    const int colB = (role == 1 ? 1024 : 1536) + h * 64 + cq * 16;
    Raw16 ra, rb;
    {
      const int j = th * 16 + tl, t = d ? T - 1 - j : j, row = r0seq + t;
      if (role < 3) load_raw16(ra, z, row, t, T, colA);
      if (role == 1 || role == 2) load_raw16(rb, z, row, t, T, colB);
    }
    f32x4 Sa = {0.f, 0.f, 0.f, 0.f}, Sb = Sa;
    uint2 y_def = make_uint2(0u, 0u);
    float sb_def = 0.f;
    const int mt = wave >> 1, hn = wave & 1, nt0 = 2 * hn, nt1 = 2 * hn + 1;
    __syncthreads();

    for (int c = 0; c < nch; ++c) {
      if (role < 3) {
        const int j = th * 16 + tl;
        const int istep = c * 32 + j;
        const int t = d ? T - 1 - istep : istep;
        const int row = r0seq + t;
        float v16[16];
        if (role < 2) {
          shift16(ra, cst + role * 64 + cq * 16, v16);
          if (role == 0) {
#pragma unroll
            for (int q = 0; q < 16; ++q) { const float e = __expf(2.f * v16[q]); v16[q] = 1.f - 2.f * __builtin_amdgcn_rcpf(e + 1.f); }
          }
          *(uint4*)(Ab + tl * 72 + cq * 16) = pack8(v16);
          *(uint4*)(Ab + tl * 72 + cq * 16 + 8) = pack8(v16 + 8);
          __builtin_amdgcn_wave_barrier();
          f32x4 acc[4] = {};
#pragma unroll
          for (int ks = 0; ks < 2; ++ks) {
            const bf16x8 a = *reinterpret_cast<const bf16x8*>(Ab + fr * 72 + ks * 32 + fq * 8);
#pragma unroll
            for (int nt = 0; nt < 4; ++nt) { const uint4 bu = Blds[(nt * 2 + ks) * 64 + lane]; acc[nt] = MFMA16(a, *reinterpret_cast<const bf16x8*>(&bu), acc[nt]); }
          }
          if (role == 0) {
#pragma unroll
            for (int nt = 0; nt < 4; ++nt)
#pragma unroll
              for (int jj = 0; jj < 4; ++jj) {
                const float sg = sigmoidf_(bias[nt] + acc[nt][jj]);
                stepbuf[0 * SV + (th * 16 + fq * 4 + jj) * 64 + nt * 16 + fr] = __expf(-0.6065306597126334f * sg);
              }
            __builtin_amdgcn_wave_barrier();
            {
              float wl[16];
#pragma unroll
              for (int i = 0; i < 16; ++i) wl[i] = stepbuf[0 * SV + (th * 16 + i) * 64 + lane];
              float pr = 1.f;
#pragma unroll
              for (int i = 0; i < 16; ++i) { pr *= wl[i]; stepbuf[0 * SV + (th * 16 + i) * 64 + lane] = pr; }
            }
          } else {
#pragma unroll
            for (int nt = 0; nt < 4; ++nt)
#pragma unroll
              for (int jj = 0; jj < 4; ++jj) tmpa[(fq * 4 + jj) * 68 + nt * 16 + fr] = sigmoidf_(bias[nt] + acc[nt][jj]);
            __builtin_amdgcn_wave_barrier();
            float av[16], kd[16];
#pragma unroll
            for (int q = 0; q < 4; ++q) { f32x4 a4 = *(const f32x4*)(tmpa + tl * 68 + cq * 16 + q * 4); av[q * 4] = a4[0]; av[q * 4 + 1] = a4[1]; av[q * 4 + 2] = a4[2]; av[q * 4 + 3] = a4[3]; }
            shift16(rb, cst + 2 * 64 + cq * 16, v16);
            float kk[16], ss = 0.f;
#pragma unroll
            for (int q = 0; q < 16; ++q) { kk[q] = v16[q] * cst[5 * 64 + cq * 16 + q]; ss += kk[q] * kk[q]; }
            ss = quad_sum(ss);
            const float inv = 1.f / fmaxf(sqrtf(ss), 1e-12f);
#pragma unroll
            for (int q = 0; q < 16; ++q) { kk[q] *= inv; kd[q] = v16[q] * (1.f + (av[q] - 1.f) * cst[6 * 64 + cq * 16 + q]); }
#pragma unroll
            for (int q = 0; q < 4; ++q) {
              *(f32x4*)(stepbuf + 3 * SV + j * 64 + cq * 16 + q * 4) = (f32x4){-kk[q * 4], -kk[q * 4 + 1], -kk[q * 4 + 2], -kk[q * 4 + 3]};
              *(f32x4*)(stepbuf + 4 * SV + j * 64 + cq * 16 + q * 4) = (f32x4){kk[q * 4] * av[q * 4], kk[q * 4 + 1] * av[q * 4 + 1], kk[q * 4 + 2] * av[q * 4 + 2], kk[q * 4 + 3] * av[q * 4 + 3]};
              *(f32x4*)(stepbuf + 1 * SV + j * 64 + cq * 16 + q * 4) = (f32x4){kd[q * 4], kd[q * 4 + 1], kd[q * 4 + 2], kd[q * 4 + 3]};
            }
          }
        } else {
          shift16(ra, cst + 3 * 64 + cq * 16, v16);
#pragma unroll
          for (int q = 0; q < 4; ++q) *(f32x4*)(stepbuf + 2 * SV + j * 64 + cq * 16 + q * 4) = (f32x4){v16[q * 4], v16[q * 4 + 1], v16[q * 4 + 2], v16[q * 4 + 3]};
          shift16(rb, cst + 4 * 64 + cq * 16, v16);
#pragma unroll
          for (int q = 0; q < 4; ++q) *(f32x4*)(stepbuf + 5 * SV + j * 64 + cq * 16 + q * 4) = (f32x4){v16[q * 4], v16[q * 4 + 1], v16[q * 4 + 2], v16[q * 4 + 3]};
        }
      }
      if (c > 0) {
        const int ip = (c - 1) * 32 + hn * 16 + fr, tp = d ? T - 1 - ip : ip;
        *(uint2*)(yout + (size_t)(r0seq + tp) * 512 + h * 64 + mt * 16 + fq * 4) = y_def;
        if (role == 2 && cq == 0) { const int is_ = (c - 1) * 32 + th * 16 + tl, tg = d ? T - 1 - is_ : is_; P_SBON[((size_t)(r0seq + tg) * 8 + h) * 2 + d] = sb_def; }
      }
      if (role < 3 && c + 1 < nch) {
        const int is2 = (c + 1) * 32 + th * 16 + tl;
        const int t2 = d ? T - 1 - is2 : is2;
        const int row2 = r0seq + t2;
        load_raw16(ra, z, row2, t2, T, colA);
        if (role >= 1) load_raw16(rb, z, row2, t2, T, colB);
      }
      lds_barrier();
      {
        const int k = lane, seg = wave;
        const float* sw = stepbuf + 0 * SV + k;
        const float P15 = sw[15 * 64];
        const float hiF = seg >= 4 ? P15 : 1.f;
        float P[5];
        P[0] = seg == 0 ? 1.f : sw[(4 * seg - 1) * 64] * (seg > 4 ? P15 : 1.f);
#pragma unroll
        for (int i = 0; i < 4; ++i) P[i + 1] = sw[(4 * seg + i) * 64] * hiF;
        const float PL = sw[31 * 64] * P15;
        if (role == 2) {
          const int j = th * 16 + tl;
          float bs = 0.f;
#pragma unroll
          for (int q = 0; q < 16; ++q) bs += stepbuf[2 * SV + j * 64 + cq * 16 + q] * stepbuf[1 * SV + j * 64 + cq * 16 + q] * cst[7 * 64 + cq * 16 + q];
          bs = quad_sum(bs);
          sb_def = bs;
        }
        f32x4 bb, kb, at, vv;
#pragma unroll
        for (int i = 0; i < 4; ++i) {
          const int t = 4 * seg + i;
          const float inv = __builtin_amdgcn_rcpf(P[i + 1]);
          const float a_ = P[i] * stepbuf[3 * SV + t * 64 + k];
          const float rraw = stepbuf[2 * SV + t * 64 + k], kraw = stepbuf[1 * SV + t * 64 + k];
          const float r_ = P[i + 1] * rraw;
          const float b_ = stepbuf[4 * SV + t * 64 + k] * inv;
          const float k_ = kraw * inv;

          At[t * 72 + k] = (bf16_t)(cvt_pk_bf16(a_, 0.f) & 0xffff);
          Rt[t * 72 + k] = (bf16_t)(cvt_pk_bf16(r_, 0.f) & 0xffff);
          Bt[t * 72 + k] = (bf16_t)(cvt_pk_bf16(b_, 0.f) & 0xffff);
          Kt[t * 72 + k] = (bf16_t)(cvt_pk_bf16(k_, 0.f) & 0xffff);
          bb[i] = b_ * PL; kb[i] = k_ * PL; at[i] = a_;
          vv[i] = stepbuf[5 * SV + t * 64 + k];
        }
        *(uint2*)(Bb + k * 40 + 4 * seg) = pack4(bb);
        *(uint2*)(Kb + k * 40 + 4 * seg) = pack4(kb);
        *(uint2*)(VT + k * 40 + 4 * seg) = pack4(vv);
        *(uint2*)(AtTb + k * 40 + 4 * seg) = pack4(at);
        if (seg == 0) PLs[k] = PL;
      }
      lds_barrier();
      {
        const int mat = wave >> 1, mts = wave & 1;
        const bf16_t* As = (mat & 1) ? Kt : Bt;
        const bf16_t* Bs = (mat & 2) ? Rt : At;
        f32x4 acc[2] = {};
#pragma unroll
        for (int ks = 0; ks < 2; ++ks) {
          const bf16x8 a = ldfrag(As, 72, mts * 16, ks * 32, fr, fq);
#pragma unroll
          for (int nt = 0; nt < 2; ++nt) acc[nt] = MFMA16(a, ldfrag(Bs, 72, nt * 16, ks * 32, fr, fq), acc[nt]);
        }
#pragma unroll
        for (int nt = 0; nt < 2; ++nt) {
          const int tcol = nt * 16 + fr;
          f32x4 v = acc[nt];
#pragma unroll
          for (int jj = 0; jj < 4; ++jj) {
            const int srow = mts * 16 + fq * 4 + jj;
            const bool keep = (mat & 2) ? (srow <= tcol) : (srow < tcol);
            v[jj] = keep ? v[jj] : 0.f;
          }
          if (mat == 0) {
#pragma unroll
            for (int jj = 0; jj < 4; ++jj) Nab[(mts * 16 + fq * 4 + jj) * 32 + tcol] = v[jj];
          } else {
            bf16_t* dst = mat == 1 ? NakT : mat == 2 ? NbrT : NkrT;
            *(uint2*)(dst + tcol * 40 + mts * 16 + fq * 4) = pack4(v);
          }
        }
      }
      lds_barrier();
      if (wave < 2) {
        const int seg = lane & 3, rrow = wave * 16 + (lane >> 2);
        float x[8];
#pragma unroll
        for (int i = 0; i < 8; ++i) x[i] = (seg * 8 + i == rrow) ? 1.f : 0.f;
        solve_steps<0>(x, Nab, seg);
#pragma unroll
        for (int i = 0; i < 8; ++i) TT[(seg * 8 + i) * 40 + rrow] = (bf16_t)(cvt_pk_bf16(x[i], 0.f) & 0xffff);
      } else if (wave < 6) {
        const int vtile = wave - 2;
        const bf16x8 vf = ldfrag(VT, 40, vtile * 16, 0, fr, fq);
        const f32x4 zero = {0.f, 0.f, 0.f, 0.f};
#pragma unroll
        for (int tt = 0; tt < 2; ++tt) {
          const f32x4 acc = MFMA16(ldfrag(NakT, 40, tt * 16, 0, fr, fq), vf, zero);
          *(uint2*)(VNb + (vtile * 16 + fr) * 40 + tt * 16 + fq * 4) = pack4(acc);
        }
      }
      lds_barrier();
      {
        const int tt = wave & 1, rt = wave >> 1;
        const f32x4 zero = {0.f, 0.f, 0.f, 0.f};
        const bf16x8 tf = ldfrag(TT, 40, tt * 16, 0, fr, fq);
        const f32x4 zacc = MFMA16(tf, ldfrag(VNb, 40, rt * 16, 0, fr, fq), zero);
        const f32x4 wacc = MFMA16(tf, ldfrag(AtTb, 40, rt * 16, 0, fr, fq), zero);
        *(uint2*)(Zb + (rt * 16 + fr) * 40 + tt * 16 + fq * 4) = pack4(zacc);
        *(uint2*)(Wb + (rt * 16 + fr) * 40 + tt * 16 + fq * 4) = pack4(wacc);
      }
      lds_barrier();
      f32x4 yacc = {0.f, 0.f, 0.f, 0.f};
      {
        const float pl0 = PLs[nt0 * 16 + fr], pl1 = PLs[nt1 * 16 + fr];
        Sa = Sa * pl0; Sb = Sb * pl1;
        const bf16x8 zf = ldfrag(Zb, 40, mt * 16, 0, fr, fq), vf = ldfrag(VT, 40, mt * 16, 0, fr, fq), wf = ldfrag(Wb, 40, mt * 16, 0, fr, fq);
        const bf16x8 bb0 = ldfrag(Bb, 40, nt0 * 16, 0, fr, fq), bb1 = ldfrag(Bb, 40, nt1 * 16, 0, fr, fq);
        const bf16x8 kb0 = ldfrag(Kb, 40, nt0 * 16, 0, fr, fq), kb1 = ldfrag(Kb, 40, nt1 * 16, 0, fr, fq);
        const bf16x8 nbr = ldfrag(NbrT, 40, hn * 16, 0, fr, fq), nkr = ldfrag(NkrT, 40, hn * 16, 0, fr, fq);
        Sa = MFMA16(zf, bb0, Sa); Sa = MFMA16(vf, kb0, Sa);
        Sb = MFMA16(zf, bb1, Sb); Sb = MFMA16(vf, kb1, Sb);
        yacc = MFMA16(zf, nbr, yacc); yacc = MFMA16(vf, nkr, yacc);
        const f32x4 zero = {0.f, 0.f, 0.f, 0.f};
        const f32x4 g0 = MFMA16(wf, bb0, zero), g1 = MFMA16(wf, bb1, zero);
        f32x4 ry = MFMA16(wf, nbr, zero);
        *(uint2*)(GT + (nt0 * 16 + fr) * 72 + mt * 16 + fq * 4) = pack4(g0);
        *(uint2*)(GT + (nt1 * 16 + fr) * 72 + mt * 16 + fq * 4) = pack4(g1);
        const uint2 rr = *(const uint2*)(Rt + (hn * 16 + fr) * 72 + mt * 16 + fq * 4);
        ry[0] += bf_lo(rr.x); ry[1] += bf_hi(rr.x); ry[2] += bf_lo(rr.y); ry[3] += bf_hi(rr.y);
        *(uint2*)(RyT + (hn * 16 + fr) * 72 + mt * 16 + fq * 4) = pack4(ry);
      }
      lds_barrier();
      {
        const bf16_t* Scur = Sbf + (c & 1) * 64 * 72;
        bf16_t* Snext = Sbf + ((c + 1) & 1) * 64 * 72;
#pragma unroll
        for (int ks = 0; ks < 2; ++ks) {
          const bf16x8 af = ldfrag(Scur, 72, mt * 16, ks * 32, fr, fq);
          Sa = MFMA16(af, ldfrag(GT, 72, nt0 * 16, ks * 32, fr, fq), Sa);
          Sb = MFMA16(af, ldfrag(GT, 72, nt1 * 16, ks * 32, fr, fq), Sb);
          yacc = MFMA16(af, ldfrag(RyT, 72, hn * 16, ks * 32, fr, fq), yacc);
        }
        y_def = pack4(yacc);
#pragma unroll
        for (int jj = 0; jj < 4; ++jj) {
          Snext[(mt * 16 + fq * 4 + jj) * 72 + nt0 * 16 + fr] = (bf16_t)(cvt_pk_bf16(Sa[jj], 0.f) & 0xffff);
          Snext[(mt * 16 + fq * 4 + jj) * 72 + nt1 * 16 + fr] = (bf16_t)(cvt_pk_bf16(Sb[jj], 0.f) & 0xffff);
        }
      }
      lds_barrier();
    }
    {
      const int ip = (nch - 1) * 32 + hn * 16 + fr, tp = d ? T - 1 - ip : ip;
      *(uint2*)(yout + (size_t)(r0seq + tp) * 512 + h * 64 + mt * 16 + fq * 4) = y_def;
      if (role == 2 && cq == 0) { const int is_ = (nch - 1) * 32 + th * 16 + tl, tg = d ? T - 1 - is_ : is_; P_SBON[((size_t)(r0seq + tg) * 8 + h) * 2 + d] = sb_def; }
    }
  }
  if (item >= 128) {
    const int nb = gridDim.x - 128;
    for (int tile = item - 128; tile < NTOK / 32; tile += nb) pool_tile(z, P_RH, tile, tid);
  }
}

__device__ __forceinline__ void post_phase(PREF p, char* smem, const int wid_u) {
  bf16_t* Ag = (bf16_t*)smem;
  bf16_t* vt = (bf16_t*)(smem + 12800);
  float* ys = (float*)(smem + 12800 + 33280);
  const bf16_t* z = P_RU;
  const bf16_t* yf = P_RY;
  const bf16_t* ybk = P_RY + (size_t)NTOK * 512;
  bf16_t* mo = P_RH;
  const int tid = opaque_tid(), w = tid >> 6, lane = tid & 63, fr = lane & 15, fq = lane >> 4;
  bf16x8 Bg[4][6];
#pragma unroll
  for (int nt = 0; nt < 4; ++nt)
#pragma unroll
    for (int ks = 0; ks < 6; ++ks) {
      float o[8];
#pragma unroll
      for (int q = 0; q < 8; ++q) { const int k = ks * 32 + fq * 8 + q; o[q] = k < 160 ? p.g2[(size_t)k * 512 + w * 64 + nt * 16 + fr] : 0.f; }
      uint4 u = pack8(o);
      Bg[nt][ks] = *reinterpret_cast<bf16x8*>(&u);
    }
  float lng[4], lnb[4];
#pragma unroll
  for (int nt = 0; nt < 4; ++nt) { lng[nt] = p.lnx_g[w * 64 + nt * 16 + fr]; lnb[nt] = p.lnx_b[w * 64 + nt * 16 + fr]; }

  for (int tile = blockIdx.x; tile < NTOK / 32; tile += gridDim.x) {
    const int row0 = tile * 32;
    int s, t0, T;
    row_seq(row0, s, t0, T);
    for (int idx = tid; idx < 32 * 24; idx += NTHR) {
      const int tok = idx / 24, oc = idx % 24;
      float o[8];
      if (oc < 20) {
        load_shift8(z, row0 + tok, t0 + tok, T, 2304 + oc * 8, p.shift_mu, o);
#pragma unroll
        for (int q = 0; q < 8; ++q) o[q] = sigmoidf_(o[q]);
      } else {
#pragma unroll
        for (int q = 0; q < 8; ++q) o[q] = 0.f;
      }
      *(uint4*)(Ag + tok * 200 + oc * 8) = pack8(o);
    }
    for (int idx = tid; idx < 32 * 64; idx += NTHR) {
      const int tok = idx >> 6, oc = idx & 63, row = row0 + tok, t = t0 + tok;
      float o[8];
      load_shift8(z, row, t, T, 1536 + oc * 8, p.shift_mu, o);
      *(uint4*)(vt + tok * 520 + oc * 8) = pack8(o);
      float a[8], b[8];
      unpack8(*(const uint4*)(yf + (size_t)row * 512 + oc * 8), a);
      unpack8(*(const uint4*)(ybk + (size_t)row * 512 + oc * 8), b);
      *(f32x4*)(ys + tok * 516 + oc * 8) = (f32x4){a[0] + b[0], a[1] + b[1], a[2] + b[2], a[3] + b[3]};
      *(f32x4*)(ys + tok * 516 + oc * 8 + 4) = (f32x4){a[4] + b[4], a[5] + b[5], a[6] + b[6], a[7] + b[7]};
    }
    __syncthreads();
    f32x4 acc[2][4] = {};
#pragma unroll
    for (int ks = 0; ks < 6; ++ks) {
      bf16x8 a[2];
#pragma unroll
      for (int mt = 0; mt < 2; ++mt) a[mt] = *reinterpret_cast<const bf16x8*>(Ag + (mt * 16 + fr) * 200 + ks * 32 + fq * 8);
#pragma unroll
      for (int mt = 0; mt < 2; ++mt)
#pragma unroll
        for (int nt = 0; nt < 4; ++nt) acc[mt][nt] = __builtin_amdgcn_mfma_f32_16x16x32_bf16(a[mt], Bg[nt][ks], acc[mt][nt], 0, 0, 0);
    }
#pragma unroll
    for (int mt = 0; mt < 2; ++mt)
#pragma unroll
      for (int jj = 0; jj < 4; ++jj) {
        const int tok = mt * 16 + fq * 4 + jj, row = row0 + tok;
        float yv[4], sm_ = 0.f;
#pragma unroll
        for (int nt = 0; nt < 4; ++nt) { yv[nt] = ys[tok * 516 + w * 64 + nt * 16 + fr]; sm_ += yv[nt]; }
        const float mean = row16_sum(sm_) * (1.f / 64.f);
        float vs = 0.f;
#pragma unroll
        for (int nt = 0; nt < 4; ++nt) { yv[nt] -= mean; vs += yv[nt] * yv[nt]; }
        const float rs = rsqrtf(row16_sum(vs) * (1.f / 64.f) + 64e-5f);
        const float2 sb2 = *(const float2*)(P_SBON + ((size_t)row * 8 + w) * 2);
        const float sbs = sb2.x + sb2.y;
#pragma unroll
        for (int nt = 0; nt < 4; ++nt) {
          const float vv = bf2f(vt[tok * 520 + w * 64 + nt * 16 + fr]);
          const float o = (yv[nt] * rs * lng[nt] + lnb[nt] + sbs * vv) * acc[mt][nt][jj];
          mo[(size_t)row * D + 512 + w * 64 + nt * 16 + fr] = (bf16_t)(cvt_pk_bf16(o, 0.f) & 0xffff);
        }
      }
    __syncthreads();
  }
}

constexpr int NPHASE = 13;
__device__ __forceinline__ void do_phase(PREF p, int ph, char* smem, const int wid_u) {
  if (ph == 0) prep_phase(p, smem, wid_u);
  else if (ph == 1) row_phase<0>(p.x_prompt, p.x_sample, nullptr, nullptr, P_RH, P_MOD, nullptr, p.n1_pre, 0, 0.f, 0, wid_u);
  else if (ph == 4 || ph == 9) {
    const bool f = ph == 4;
    float* outp = p.out;
    row_phase<1>(sel(f, p.x_prompt, (const float*)outp), sel(f, p.x_sample, (const float*)(outp + (size_t)NPROMPT * D)), outp, P_RY, P_RH, P_MOD,
                 sel(f, p.n1_post, p.nm_post), sel(f, p.nm_pre, p.n2_pre), f ? 2 : 5, f ? 0.5f : 1.0f, f ? 3 : 6, wid_u);
  }
  else if (ph == 12) row_phase<2>(p.out, p.out + (size_t)NPROMPT * D, p.out, P_RY, nullptr, P_MOD, p.n2_post, nullptr, 8, 0.5f, 0, wid_u);
  else if (ph == 6) scan_phase(p, smem, wid_u);
  else if (ph == 7) post_phase(p, smem, wid_u);
  else {
    const bf16_t *A, *Bt; bf16_t* C; int N, K, ldc, epi;
    if (ph == 2 || ph == 10) { A = P_RH; Bt = sel(ph == 2, P_W13A, P_W13B); C = P_RU; N = 2 * FF; K = D; ldc = FF; epi = 1; }
    else if (ph == 3 || ph == 11) { A = P_RU; Bt = sel(ph == 3, P_W2A, P_W2B); C = P_RY; N = D; K = FF; ldc = D; epi = 0; }
    else if (ph == 5) { A = P_RH; Bt = P_WINT; C = P_RU; N = ZLD; K = D; ldc = ZLD; epi = 0; }
    else { A = P_RH; Bt = P_WOUTT; C = P_RY; N = D; K = D; ldc = D; epi = 0; }
    gemm_phase(A, Bt, C, NTOK, N, K, ldc, epi, smem, wid_u);
  }
}

extern __shared__ __attribute__((aligned(16))) char dyn_smem[];

__global__ void __launch_bounds__(NTHR, 2) mega_kernel(Params p) {
  cg::grid_group grid = cg::this_grid();
  const int wid_u = __builtin_amdgcn_readfirstlane(threadIdx.x >> 6);
  typedef const __attribute__((address_space(4))) Params* KP;
  const KP kp0 = (KP)__builtin_amdgcn_kernarg_segment_ptr();
#pragma unroll 1
  for (int ph = 0; ph < NPHASE; ++ph) {
    KP kp = kp0;
    asm volatile("" : "+s"(kp));
    do_phase(*kp, ph, dyn_smem, wid_u);
#ifdef PROBE_REPEAT
    if (ph == PROBE_REPEAT) { grid.sync(); do_phase(*kp, ph, dyn_smem, wid_u); }
#endif
    if (ph + 1 < NPHASE) grid.sync();
  }
}

__global__ void __launch_bounds__(NTHR, 2) phase_kernel(Params p, int ph) {
  const int wid_u = __builtin_amdgcn_readfirstlane(threadIdx.x >> 6);
  do_phase(*(const __attribute__((address_space(4))) Params*)__builtin_amdgcn_kernarg_segment_ptr(), ph, dyn_smem, wid_u);
}

extern "C" void kernel_launch(void* const* d_in, const int* in_sizes, int n_in, void* d_out, int out_size, void* d_ws, size_t ws_size,
                              hipStream_t stream) {
  Params p{};
  const float** f = (const float**)&p;
  for (int i = 0; i < 33; ++i) f[i] = (const float*)d_in[i];
  p.out = (float*)d_out;
  p.ws = (char*)d_ws;
  if (WS_NEED > ws_size) { fprintf(stderr, "workspace too small: need %zu have %zu\n", (size_t)WS_NEED, ws_size); return; }

#if ONE_LAUNCH
  static int grid_blocks = 0;
  if (!grid_blocks) {
    int dev = 0, cus = 0, per_cu = 0;
    (void)hipGetDevice(&dev);
    (void)hipDeviceGetAttribute(&cus, hipDeviceAttributeMultiprocessorCount, dev);
    (void)hipFuncSetAttribute((const void*)mega_kernel, hipFuncAttributeMaxDynamicSharedMemorySize, SMEM_BYTES);
    (void)hipOccupancyMaxActiveBlocksPerMultiprocessor(&per_cu, mega_kernel, NTHR, SMEM_BYTES);
    if (per_cu < 1) per_cu = 1;
    grid_blocks = cus * per_cu;
  }
  void* args[] = {&p};
  hipError_t e = hipLaunchCooperativeKernel((const void*)mega_kernel, dim3(grid_blocks), dim3(NTHR), args, SMEM_BYTES, stream);
  if (e != hipSuccess) fprintf(stderr, "cooperative launch failed: %s (grid %d)\n", hipGetErrorString(e), grid_blocks);
#else
  static bool attr = false;
  if (!attr) { (void)hipFuncSetAttribute((const void*)phase_kernel, hipFuncAttributeMaxDynamicSharedMemorySize, SMEM_BYTES); attr = true; }
  for (int ph = 0; ph < NPHASE; ++ph) phase_kernel<<<256, NTHR, SMEM_BYTES, stream>>>(p, ph);
#endif
}
```

```cpp
#include <hip/hip_runtime.h>
#include <hip/hip_cooperative_groups.h>
#include <cstdio>
namespace cg = cooperative_groups;

#ifndef ONE_LAUNCH
#define ONE_LAUNCH 1
#endif

typedef unsigned short bf16_t;
typedef short bf16x8 __attribute__((ext_vector_type(8)));
typedef float f32x4 __attribute__((ext_vector_type(4)));
typedef float f32x2 __attribute__((ext_vector_type(2)));
#define LAS __attribute__((address_space(3)))

constexpr int D = 1024, FF = 2816, NTOK = 98304, NPROMPT = 32768, ZLD = 2560, PINW = 2464;
constexpr int NTHR = 512;
constexpr int SMEM_BYTES = 162048;

struct Params {
  const float *x_prompt, *x_sample, *c_prompt, *c_sample, *ada_w, *ada_b, *n1_pre, *n1_post, *f1_w1, *f1_w3, *f1_w2,
      *nm_pre, *nm_post, *w_in, *shift_mu, *pool_w, *pool_scale, *w0, *w2, *a0, *a2, *g2, *k_k, *k_a, *r_k, *lnx_g, *lnx_b,
      *w_out, *n2_pre, *n2_post, *f2_w1, *f2_w3, *f2_w2;
  float* out;
  char* ws;
};
#define PREF const __attribute__((address_space(4))) Params&
constexpr size_t al256(size_t b) { return (b + 255) & ~(size_t)255; }
constexpr size_t OFF_W13A = 0;
constexpr size_t OFF_W13B = OFF_W13A + al256((size_t)2 * FF * D * 2);
constexpr size_t OFF_W2A = OFF_W13B + al256((size_t)2 * FF * D * 2);
constexpr size_t OFF_W2B = OFF_W2A + al256((size_t)D * FF * 2);
constexpr size_t OFF_WINT = OFF_W2B + al256((size_t)D * FF * 2);
constexpr size_t OFF_WOUTT = OFF_WINT + al256((size_t)ZLD * D * 2);
constexpr size_t OFF_MOD = OFF_WOUTT + al256((size_t)D * D * 2);
constexpr size_t OFF_SBON = OFF_MOD + al256((size_t)16 * 9216 * 4);
constexpr size_t OFF_RH = OFF_SBON + al256((size_t)NTOK * 16 * 4);
constexpr size_t OFF_RY = OFF_RH + al256((size_t)NTOK * D * 2);
constexpr size_t OFF_RU = OFF_RY + al256((size_t)NTOK * D * 2);
constexpr size_t WS_NEED = OFF_RU + al256((size_t)NTOK * FF * 2);
#define P_W13A ((bf16_t*)(p.ws + OFF_W13A))
#define P_W13B ((bf16_t*)(p.ws + OFF_W13B))
#define P_W2A ((bf16_t*)(p.ws + OFF_W2A))
#define P_W2B ((bf16_t*)(p.ws + OFF_W2B))
#define P_WINT ((bf16_t*)(p.ws + OFF_WINT))
#define P_WOUTT ((bf16_t*)(p.ws + OFF_WOUTT))
#define P_MOD ((float*)(p.ws + OFF_MOD))
#define P_SBON ((float*)(p.ws + OFF_SBON))
#define P_RH ((bf16_t*)(p.ws + OFF_RH))
#define P_RY ((bf16_t*)(p.ws + OFF_RY))
#define P_RU ((bf16_t*)(p.ws + OFF_RU))

typedef __bf16 bf16x2_t __attribute__((ext_vector_type(2)));
__device__ __forceinline__ unsigned cvt_pk_bf16(float lo, float hi) {
  f32x2 v = {lo, hi};
  bf16x2_t b = __builtin_convertvector(v, bf16x2_t);
  return __builtin_bit_cast(unsigned, b);
}
__device__ __forceinline__ float bf_lo(unsigned u) { return __uint_as_float(u << 16); }
__device__ __forceinline__ float bf_hi(unsigned u) { return __uint_as_float(u & 0xffff0000u); }
__device__ __forceinline__ float bf2f(bf16_t b) { return __uint_as_float(((unsigned)b) << 16); }
__device__ __forceinline__ void unpack8(uint4 v, float* o) {
  o[0] = bf_lo(v.x); o[1] = bf_hi(v.x); o[2] = bf_lo(v.y); o[3] = bf_hi(v.y);
  o[4] = bf_lo(v.z); o[5] = bf_hi(v.z); o[6] = bf_lo(v.w); o[7] = bf_hi(v.w);
}
__device__ __forceinline__ uint4 pack8(const float* o) {
  uint4 v; v.x = cvt_pk_bf16(o[0], o[1]); v.y = cvt_pk_bf16(o[2], o[3]); v.z = cvt_pk_bf16(o[4], o[5]); v.w = cvt_pk_bf16(o[6], o[7]);
  return v;
}
__device__ __forceinline__ float sigmoidf_(float x) { return __builtin_amdgcn_rcpf(1.f + __expf(-x)); }
template <int CTRL> __device__ __forceinline__ float dpp_f(float x) {
  return __int_as_float(__builtin_amdgcn_update_dpp(0, __float_as_int(x), CTRL, 0xf, 0xf, false));
}
__device__ __forceinline__ float row16_sum(float x) {
  x += dpp_f<0x128>(x); x += dpp_f<0x124>(x); x += dpp_f<0x122>(x); x += dpp_f<0x121>(x);
  return x;
}
template <class T> __device__ __forceinline__ T sel(bool c, T a, T b) { return c ? a : b; }
__device__ __forceinline__ int opaque_tid_w(int wid) {
  int l;
  asm volatile("v_mbcnt_lo_u32_b32 %0, -1, 0\n\tv_mbcnt_hi_u32_b32 %0, -1, %0" : "=v"(l));
  return wid * 64 + l;
}
#define opaque_tid() opaque_tid_w(wid_u)
__device__ __forceinline__ float wave_sum(float v) {
  v = row16_sum(v);
  const float a = __int_as_float(__builtin_amdgcn_readlane(__float_as_int(v), 0)), b = __int_as_float(__builtin_amdgcn_readlane(__float_as_int(v), 16));
  const float c = __int_as_float(__builtin_amdgcn_readlane(__float_as_int(v), 32)), d = __int_as_float(__builtin_amdgcn_readlane(__float_as_int(v), 48));
  return (a + b) + (c + d);
}
__device__ __forceinline__ float quad_sum(float x) { x += dpp_f<0xB1>(x); x += dpp_f<0x4E>(x); return x; }
__device__ __forceinline__ int seq_start(int s) { return s < 8 ? s * 4096 : NPROMPT + (s - 8) * 8192; }
__device__ __forceinline__ void row_seq(int row, int& s, int& t, int& T) {
  if (row < NPROMPT) { s = row >> 12; t = row & 4095; T = 4096; }
  else { int r = row - NPROMPT; s = 8 + (r >> 13); t = r & 8191; T = 8192; }
}

__device__ __forceinline__ void tr_tile(const float* __restrict__ src, int ldsrc, int k0, int n0, int nvalid, bf16_t* __restrict__ dst, int ldd,
                        int kdst0, int mode, float* sm, const int tid) {
#pragma unroll
  for (int i = 0; i < 2; ++i) {
    const int r = (tid >> 4) + 32 * i, c = (tid & 15) * 4;
    float4 v = make_float4(0.f, 0.f, 0.f, 0.f);
    if (n0 + c < nvalid) v = *(const float4*)(src + (size_t)(k0 + r) * ldsrc + n0 + c);
    float* d = sm + r * 65 + c;
    d[0] = v.x; d[1] = v.y; d[2] = v.z; d[3] = v.w;
  }
  __syncthreads();
  {
    const int n = tid >> 3, kc = (tid & 7) * 8;
    float o[8];
#pragma unroll
    for (int j = 0; j < 8; ++j) o[j] = sm[(kc + j) * 65 + n];
    int nn = n0 + n, drow;
    if (mode == 0) drow = nn;
    else drow = 32 * (nn >> 4) + (nn & 15) + (mode == 2 ? 16 : 0);
    *(uint4*)(dst + (size_t)drow * ldd + kdst0 + k0 + kc) = pack8(o);
  }
  __syncthreads();
}

__device__ __forceinline__ void prep_phase(PREF p, char* smem, const int wid_u) {
  float* sm = (float*)smem;
  const int tid = opaque_tid();
  constexpr int N_MOD = 144, N_EFF = 128, N_W13 = 4 * 704, N_W2 = 2 * 704, N_WIN = 640, N_WOUT = 128;
  constexpr int TOTAL = N_MOD + N_EFF + N_W13 + N_W2 + N_WIN + N_WOUT;
  for (int item = blockIdx.x; item < TOTAL; item += gridDim.x) {
    int it = item;
    if (it < N_MOD) {
      const int j0 = it * 64;
      float* sc = sm;
      float* red = sm + 16384;
      for (int idx = tid; idx < 16384; idx += NTHR) {
        const int s = idx >> 10, k = idx & 1023;
        const float* cp_ = p.c_prompt; const float* cs_ = p.c_sample;
        const float c = s < 8 ? cp_[s * 1024 + k] : cs_[(s - 8) * 1024 + k];
        sc[idx] = c / (1.f + __expf(-c));
      }
      __syncthreads();
      const int col = tid & 63, kg = tid >> 6;
      float acc[16];
#pragma unroll
      for (int s = 0; s < 16; ++s) acc[s] = 0.f;
      for (int k = kg * 128; k < kg * 128 + 128; ++k) {
        const float w = p.ada_w[(size_t)k * 9216 + j0 + col];
#pragma unroll
        for (int s = 0; s < 16; ++s) acc[s] += sc[s * 1024 + k] * w;
      }
#pragma unroll
      for (int s = 0; s < 16; ++s) red[(kg * 16 + s) * 64 + col] = acc[s];
      __syncthreads();
      for (int o = tid; o < 1024; o += NTHR) {
        const int s = o >> 6, c2 = o & 63;
        float v = p.ada_b[j0 + c2];
#pragma unroll
        for (int g = 0; g < 8; ++g) v += red[(g * 16 + s) * 64 + c2];
        P_MOD[s * 9216 + j0 + c2] = v;
      }
      __syncthreads();
      continue;
    }
    it -= N_MOD;
    if (it < N_EFF) {
      const int g = it >> 5, itile = (it >> 4) & 1, ntile = it & 15;
      float* As = sm;
      float* Bs = sm + 64 * 129;
      for (int idx = tid; idx < 64 * 128; idx += NTHR) {
        const int i = idx >> 7, j = idx & 127;
        As[i * 129 + j] = p.pool_w[((size_t)g * 128 + itile * 64 + i) * 128 + j] * p.pool_scale[g * 128 + j];
      }
      for (int idx = tid; idx < 128 * 64; idx += NTHR) {
        const int j = idx >> 6, nn = idx & 63;
        Bs[j * 65 + nn] = p.w_out[(size_t)(g * 128 + j) * 1024 + ntile * 64 + nn];
      }
      __syncthreads();
      const int i = tid >> 3, nn0 = (tid & 7) * 8;
      float acc[8];
#pragma unroll
      for (int q = 0; q < 8; ++q) acc[q] = 0.f;
      for (int j = 0; j < 128; ++j) {
        const float a = As[i * 129 + j];
#pragma unroll
        for (int q = 0; q < 8; ++q) acc[q] += a * Bs[j * 65 + nn0 + q];
      }
#pragma unroll
      for (int q = 0; q < 8; ++q)
        P_WOUTT[(size_t)(ntile * 64 + nn0 + q) * 1024 + g * 128 + itile * 64 + i] = (bf16_t)(cvt_pk_bf16(acc[q], 0.f) & 0xffff);
      __syncthreads();
      continue;
    }
    it -= N_EFF;
    if (it < N_W13) {
      const int which = it / 704, r = it % 704;
      const int kt = r / 44, ntl = r % 44;
      const float* src = sel(which < 2, sel(which == 0, p.f1_w1, p.f1_w3), sel(which == 2, p.f2_w1, p.f2_w3));
      bf16_t* dst = sel(which < 2, P_W13A, P_W13B);
      tr_tile(src, FF, kt * 64, ntl * 64, FF, dst, D, 0, (which & 1) ? 2 : 1, sm, tid);
      continue;
    }
    it -= N_W13;
    if (it < N_W2) {
      const int which = it / 704, r = it % 704;
      const int kt = r / 16, ntl = r % 16;
      tr_tile(sel(which != 0, p.f2_w2, p.f1_w2), D, kt * 64, ntl * 64, D, sel(which != 0, P_W2B, P_W2A), FF, 0, 0, sm, tid);
      continue;
    }
    it -= N_W2;
    if (it < N_WIN) {
      const int kt = it / 40, ntl = it % 40;
      tr_tile(p.w_in, PINW, kt * 64, ntl * 64, PINW, P_WINT, D, 0, 0, sm, tid);
      continue;
    }
    it -= N_WIN;
    {
      const int kt = it / 16, ntl = it % 16;
      tr_tile(p.w_out + (size_t)512 * 1024, D, kt * 64, ntl * 64, D, P_WOUTT, D, 512, 0, sm, tid);
    }
  }
}

template <int MODE>
__device__ __forceinline__ void row_phase(const float* __restrict__ xp, const float* __restrict__ xs, float* __restrict__ xout,
                          const bf16_t* __restrict__ y, bf16_t* __restrict__ h, const float* __restrict__ mod,
                          const float* __restrict__ npost, const float* __restrict__ npre, int gate_idx, float cgate, int shift_idx, const int wid_u) {
  const int tid_ = opaque_tid();
  const int lane = tid_ & 63;
  const int gw = blockIdx.x * 8 + (tid_ >> 6), GW = gridDim.x * 8;
  for (int chunk = gw; chunk < NTOK / 16; chunk += GW) {
    const int row0 = chunk * 16;
    int s, t, T;
    row_seq(row0, s, t, T);
    const float* md = mod + s * 9216;
    f32x4 Am[4], Bm[4], Gm[4];
#pragma unroll
    for (int i = 0; i < 4; ++i) {
      const int c = i * 256 + lane * 4;
      if (MODE != 2) {
        f32x4 np = *(const f32x4*)(npre + c), sc = *(const f32x4*)(md + (shift_idx + 1) * 1024 + c);
        Am[i] = np * (sc + 1.f);
        Bm[i] = *(const f32x4*)(md + shift_idx * 1024 + c);
      }
      if (MODE != 0) {
        f32x4 g = *(const f32x4*)(md + gate_idx * 1024 + c), po = *(const f32x4*)(npost + c);
        Gm[i] = g * po * cgate;
      }
    }
    for (int r = 0; r < 16; ++r) {
      const int row = row0 + r;
      const float* xr = (row < NPROMPT) ? xp + (size_t)row * D : xs + (size_t)(row - NPROMPT) * D;
      f32x4 xv[4];
#pragma unroll
      for (int i = 0; i < 4; ++i) xv[i] = *(const f32x4*)(xr + i * 256 + lane * 4);
      if (MODE != 0) {
        f32x4 yv[4];
        float ss = 0.f;
#pragma unroll
        for (int i = 0; i < 4; ++i) {
          uint2 u = *(const uint2*)(y + (size_t)row * D + i * 256 + lane * 4);
          yv[i] = (f32x4){bf_lo(u.x), bf_hi(u.x), bf_lo(u.y), bf_hi(u.y)};
          ss += yv[i][0] * yv[i][0] + yv[i][1] * yv[i][1] + yv[i][2] * yv[i][2] + yv[i][3] * yv[i][3];
        }
        ss = wave_sum(ss);
        const float rs = rsqrtf(ss * (1.f / 1024.f) + 1e-6f);
#pragma unroll
        for (int i = 0; i < 4; ++i) {
          xv[i] = xv[i] + Gm[i] * yv[i] * rs;
          *(f32x4*)(xout + (size_t)row * D + i * 256 + lane * 4) = xv[i];
        }
      }
      if (MODE != 2) {
        float ss = 0.f;
#pragma unroll
        for (int i = 0; i < 4; ++i) ss += xv[i][0] * xv[i][0] + xv[i][1] * xv[i][1] + xv[i][2] * xv[i][2] + xv[i][3] * xv[i][3];
        ss = wave_sum(ss);
        const float rs = rsqrtf(ss * (1.f / 1024.f) + 1e-6f);
#pragma unroll
        for (int i = 0; i < 4; ++i) {
          f32x4 hv = xv[i] * rs * Am[i] + Bm[i];
          uint2 u; u.x = cvt_pk_bf16(hv[0], hv[1]); u.y = cvt_pk_bf16(hv[2], hv[3]);
          *(uint2*)(h + (size_t)row * D + i * 256 + lane * 4) = u;
        }
      }
    }
  }
}

constexpr int BM = 256, BK = 64, HALF = 128, NXCD = 8, WGM = 8, HT = HALF * BK;
__device__ __forceinline__ int lds_byte(int r, int c) {
  int st = (r >> 4) * 2 + (c >> 5), rr = r & 15, cc = c & 31, ob = rr * 64 + cc * 2;
  return st * 1024 + (ob ^ (((ob >> 9) & 1) << 5));
}
__device__ __forceinline__ void stage_rc(int b, int& R, int& C) {
  int st = b / 1024, sb = b % 1024, swz = sb ^ (((sb >> 9) & 1) << 5);
  R = (st >> 1) * 16 + swz / 64; C = (st & 1) * 32 + (swz % 64) / 2;
}

__device__ __forceinline__ bool gemm_unit(int i, int nM, int nN, int nwg, int& pm, int& pn) {
  const long L = (long)i * gridDim.x + blockIdx.x;
  if (L >= nwg) return false;
  int wgid = (int)L;
  { int q = nwg / NXCD, r = nwg % NXCD, xcd = wgid % NXCD, off = wgid / NXCD;
    wgid = (xcd < r ? xcd * (q + 1) : r * (q + 1) + (xcd - r) * q) + off; }
  const int nig = WGM * nN, gid = wgid / nig, fm = gid * WGM, gsz = min(nM - fm, WGM);
  pm = fm + ((wgid % nig) % gsz); pn = (wgid % nig) / gsz;
  return true;
}

__device__ __forceinline__ void gemm_phase(const bf16_t* __restrict__ A, const bf16_t* __restrict__ Bt, bf16_t* __restrict__ C, int M, int N, int K,
                                           int ldc, const int EPI, char* smem, const int wid_u) {
  const int nM = M / BM, nN = N / BM, nwg = nM * nN;
  const int tid = opaque_tid();
  LAS bf16_t* shm = (LAS bf16_t*)smem;
#define SA(b, h) (shm + ((b) * 2 + (h)) * HT)
#define SB(b, h) (shm + (4 + (b) * 2 + (h)) * HT)
#define STG(P, GB) do { const char* _gb = (GB); \
    _Pragma("unroll") for (int _i = 0; _i < 2; ++_i) { \
      __builtin_amdgcn_global_load_lds((const unsigned*)(_gb + voff[_i]), \
        (LAS unsigned*)((LAS char*)(P) + ldsw + _i * 8192), 16, 0, 0); } } while (0)
#define LDA(dst, b, h) _Pragma("unroll") for (int m = 0; m < 4; ++m) _Pragma("unroll") for (int k = 0; k < 2; ++k) \
    dst[m][k] = *(const LAS bf16x8*)((LAS char*)SA(b, h) + aoff + m * 2048 + k * 1024)
#define LDB(dst, b, h) _Pragma("unroll") for (int n = 0; n < 2; ++n) _Pragma("unroll") for (int k = 0; k < 2; ++k) \
    dst[n][k] = *(const LAS bf16x8*)((LAS char*)SB(b, h) + boff + n * 2048 + k * 1024)
#define MMA(ai, bj, At_, Bt_) do { __builtin_amdgcn_s_setprio(1); \
    _Pragma("unroll") for (int m = 0; m < 4; ++m) _Pragma("unroll") for (int n = 0; n < 2; ++n) _Pragma("unroll") for (int k = 0; k < 2; ++k) \
      acc[ai][bj][m][n] = __builtin_amdgcn_mfma_f32_16x16x32_bf16(Bt_[n][k], At_[m][k], acc[ai][bj][m][n], 0, 0, 0); \
    __builtin_amdgcn_s_setprio(0); } while (0)
#define WAIT_V(n) asm volatile("s_waitcnt vmcnt(" #n ")" ::: "memory")
#define WAIT_L(n) asm volatile("s_waitcnt lgkmcnt(" #n ")" ::: "memory")
#define BAR __builtin_amdgcn_s_barrier()
#define SCHED __builtin_amdgcn_sched_barrier(0)
  const int wid = __builtin_amdgcn_readfirstlane(tid >> 6), lane = tid & 63, wr = wid >> 2, wc = wid & 3, fr = lane & 15, fq = lane >> 4;
  const int aoff = lds_byte(wr * 64 + fr, fq * 8), boff = lds_byte(wc * 32 + fr, fq * 8);
  unsigned voff[2];
  const int ldsw = wid * 1024;
#pragma unroll
  for (int _i = 0; _i < 2; ++_i) { int _r, _c; stage_rc(tid * 16 + _i * 8192, _r, _c); voff[_i] = (unsigned)(_r * K + _c) * 2u; }
  const int nt = K / BK;
  const size_t kstep = (size_t)BK * 2, hstep = (size_t)HALF * K * 2, tstep = 2 * hstep;
  int pm, pn, npm = 0, npn = 0, ui = 0;
  if (!gemm_unit(0, nM, nN, nwg, pm, pn)) return;
  f32x4 acc[2][2][4][2];
#pragma unroll
  for (int a = 0; a < 2; ++a)
#pragma unroll
    for (int b = 0; b < 2; ++b)
#pragma unroll
      for (int m = 0; m < 4; ++m)
#pragma unroll
        for (int n = 0; n < 2; ++n) acc[a][b][m][n] = (f32x4){0.f, 0.f, 0.f, 0.f};
  bf16x8 At[4][2], B0[2][2], B1[2][2];
  const char* cA = (const char*)A + (size_t)pm * tstep;
  const char* cB = (const char*)Bt + (size_t)pn * tstep;
  STG(SB(0, 0), cB); STG(SA(0, 0), cA); STG(SB(0, 1), cB + hstep); STG(SA(0, 1), cA + hstep);
  if (wr == 1) BAR;
  WAIT_V(4); BAR;
  STG(SB(1, 0), cB + kstep); STG(SA(1, 0), cA + kstep); STG(SB(1, 1), cB + hstep + kstep);
  WAIT_V(6); BAR;
  for (;;) {
    const bool has_next = gemm_unit(ui + 1, nM, nN, nwg, npm, npn);
    const char* nA = has_next ? (const char*)A + (size_t)npm * tstep : cA;
    const char* nB = has_next ? (const char*)Bt + (size_t)npn * tstep : cB;
    for (int t = 0; t < nt; t += 2) {
      const bool last = (t == nt - 2);
      const char* a1 = cA + (size_t)(t + 1) * kstep;
      const char* a2 = last ? nA : cA + (size_t)(t + 2) * kstep;
      const char* b2 = last ? nB : cB + (size_t)(t + 2) * kstep;
      const char* a3 = a2 + kstep;
      const char* b3 = b2 + kstep;
      LDB(B0, 0, 0); SCHED; LDA(At, 0, 0); STG(SA(1, 1), a1 + hstep);
      WAIT_L(8); BAR; WAIT_L(0); MMA(0, 0, At, B0); BAR; SCHED;
      LDB(B1, 0, 1); STG(SB(0, 0), b2);
      BAR; WAIT_L(0); MMA(0, 1, At, B1); BAR;
      LDA(At, 0, 1); STG(SA(0, 0), a2);
      BAR; WAIT_L(0); MMA(1, 0, At, B0); BAR; SCHED;
      STG(SB(0, 1), b2 + hstep);
      WAIT_V(6); BAR; MMA(1, 1, At, B1); BAR;
      LDB(B0, 1, 0); SCHED; LDA(At, 1, 0); STG(SA(0, 1), a2 + hstep);
      WAIT_L(8); BAR; WAIT_L(0); MMA(0, 0, At, B0); BAR; SCHED;
      LDB(B1, 1, 1); STG(SB(1, 0), b3);
      BAR; WAIT_L(0); MMA(0, 1, At, B1); BAR;
      LDA(At, 1, 1); STG(SA(1, 0), a3);
      BAR; WAIT_L(0); MMA(1, 0, At, B0); BAR; SCHED;
      STG(SB(1, 1), b3 + hstep);
      WAIT_V(6); BAR; MMA(1, 1, At, B1); BAR;
    }
    {
      const int brow = pm * BM, bcol = pn * BM;
#pragma unroll
      for (int ai = 0; ai < 2; ++ai)
#pragma unroll
        for (int m = 0; m < 4; ++m) {
          const size_t row = (size_t)(brow + ai * HALF + wr * 64 + m * 16 + fr);
#pragma unroll
          for (int bj = 0; bj < 2; ++bj) {
            if (EPI == 0) {
#pragma unroll
              for (int n = 0; n < 2; ++n) {
                const f32x4 v = acc[ai][bj][m][n];
                uint2 u; u.x = cvt_pk_bf16(v[0], v[1]); u.y = cvt_pk_bf16(v[2], v[3]);
                *(uint2*)(C + row * ldc + bcol + bj * HALF + wc * 32 + n * 16 + fq * 4) = u;
              }
            } else {
              const f32x4 a = acc[ai][bj][m][0], b = acc[ai][bj][m][1];
              float o[4];
#pragma unroll
              for (int j = 0; j < 4; ++j) o[j] = a[j] * __builtin_amdgcn_rcpf(1.f + __expf(-a[j])) * b[j];
              uint2 u; u.x = cvt_pk_bf16(o[0], o[1]); u.y = cvt_pk_bf16(o[2], o[3]);
              *(uint2*)(C + row * ldc + ((bcol + bj * HALF + wc * 32) >> 1) + fq * 4) = u;
            }
          }
        }
    }
    if (!has_next) break;
#pragma unroll
    for (int a = 0; a < 2; ++a)
#pragma unroll
      for (int b = 0; b < 2; ++b)
#pragma unroll
        for (int m = 0; m < 4; ++m)
#pragma unroll
          for (int n = 0; n < 2; ++n) acc[a][b][m][n] = (f32x4){0.f, 0.f, 0.f, 0.f};
    pm = npm; pn = npn; cA = nA; cB = nB; ++ui;
  }
  WAIT_V(0);
  if (wr == 0) BAR;
  BAR;
#undef SA
#undef SB
#undef STG
#undef LDA
#undef LDB
#undef MMA
}

__device__ __forceinline__ void load_shift16(const bf16_t* __restrict__ z, int row, int t, int T, int col, const float* __restrict__ mu, float* o) {
  const bf16_t* pz = z + (size_t)row * ZLD + col;
  uint4 c0 = *(const uint4*)pz, c1 = *(const uint4*)(pz + 8);
  uint4 p0 = make_uint4(0, 0, 0, 0), p1 = p0, n0 = p0, n1 = p0;
  if (t > 0) { p0 = *(const uint4*)(pz - ZLD); p1 = *(const uint4*)(pz - ZLD + 8); }
  if (t < T - 1) { n0 = *(const uint4*)(pz + ZLD); n1 = *(const uint4*)(pz + ZLD + 8); }
  float c[16], pv[16], nx[16];
  unpack8(c0, c); unpack8(c1, c + 8); unpack8(p0, pv); unpack8(p1, pv + 8); unpack8(n0, nx); unpack8(n1, nx + 8);
#pragma unroll
  for (int q = 0; q < 16; ++q) o[q] = c[q] + (0.5f * (pv[q] + nx[q]) - c[q]) * mu[col - 512 + q];
}
__device__ __forceinline__ void load_shift8(const bf16_t* __restrict__ z, int row, int t, int T, int col, const float* __restrict__ mu, float* o) {
  const bf16_t* pz = z + (size_t)row * ZLD + col;
  uint4 c0 = *(const uint4*)pz;
  uint4 p0 = make_uint4(0, 0, 0, 0), n0 = p0;
  if (t > 0) p0 = *(const uint4*)(pz - ZLD);
  if (t < T - 1) n0 = *(const uint4*)(pz + ZLD);
  float c[8], pv[8], nx[8];
  unpack8(c0, c); unpack8(p0, pv); unpack8(n0, nx);
#pragma unroll
  for (int q = 0; q < 8; ++q) o[q] = c[q] + (0.5f * (pv[q] + nx[q]) - c[q]) * mu[col - 512 + q];
}

constexpr int TC = 32;
constexpr int SV = TC * 64;
__device__ __forceinline__ void pool_tile(const bf16_t* __restrict__ z, bf16_t* __restrict__ mo, int tile, int tid) {
  const int row0 = tile * 32;
  int s, t0, T;
  row_seq(row0, s, t0, T);
  for (int idx = tid; idx < 32 * 64; idx += NTHR) {
    const int tok = idx >> 6, oc = idx & 63, row = row0 + tok, t = t0 + tok;
    const int c0 = oc * 8, half = 1 << (c0 >> 7);
    const int lo = max(t - half, 0), hi = min(t + half, T);
    float sum[8];
#pragma unroll
    for (int q = 0; q < 8; ++q) sum[q] = 0.f;
    float zc[8];
    for (int tt = lo; tt < hi; ++tt) {
      float zz[8];
      unpack8(*(const uint4*)(z + (size_t)(row + tt - t) * ZLD + c0), zz);
#pragma unroll
      for (int q = 0; q < 8; ++q) sum[q] += zz[q];
      if (tt == t) {
#pragma unroll
        for (int q = 0; q < 8; ++q) zc[q] = zz[q];
      }
    }
    const float ic = 1.f / (float)(hi - lo);
#pragma unroll
    for (int q = 0; q < 8; ++q) sum[q] = sum[q] * ic - zc[q];
    *(uint4*)(mo + (size_t)row * D + c0) = pack8(sum);
  }
}

struct Raw16 { uint4 c0, c1, p0, p1, n0, n1; };
__device__ __forceinline__ void load_raw16(Raw16& r, const bf16_t* __restrict__ z, int row, int t, int T, int col) {
  const bf16_t* pz = z + (size_t)row * ZLD + col;
  r.c0 = *(const uint4*)pz; r.c1 = *(const uint4*)(pz + 8);
  r.p0 = make_uint4(0, 0, 0, 0); r.p1 = r.p0; r.n0 = r.p0; r.n1 = r.p0;
  if (t > 0) { r.p0 = *(const uint4*)(pz - ZLD); r.p1 = *(const uint4*)(pz - ZLD + 8); }
  if (t < T - 1) { r.n0 = *(const uint4*)(pz + ZLD); r.n1 = *(const uint4*)(pz + ZLD + 8); }
}
__device__ __forceinline__ void shift16(const Raw16& r, const float* mu, float* o) {
  float c[16], pv[16], nx[16];
  unpack8(r.c0, c); unpack8(r.c1, c + 8); unpack8(r.p0, pv); unpack8(r.p1, pv + 8); unpack8(r.n0, nx); unpack8(r.n1, nx + 8);
#pragma unroll
  for (int q = 0; q < 16; ++q) o[q] = c[q] + (0.5f * (pv[q] + nx[q]) - c[q]) * mu[q];
}
__device__ __forceinline__ bf16x8 ldfrag(const bf16_t* base, int stride, int row0, int k0, int fr, int fq) {
  return *reinterpret_cast<const bf16x8*>(base + (row0 + fr) * stride + k0 + fq * 8);
}
__device__ __forceinline__ uint2 pack4(f32x4 v) { uint2 u; u.x = cvt_pk_bf16(v[0], v[1]); u.y = cvt_pk_bf16(v[2], v[3]); return u; }
#define MFMA16(a, b, c) __builtin_amdgcn_mfma_f32_16x16x32_bf16(a, b, c, 0, 0, 0)

constexpr int CS_NAB = 0, CS_NAK = 4096, CS_NBRT = 8192, CS_NKRT = 10752, CS_QT = 13312, CS_W = 15872, CS_Z = 20992, CS_GT = 26112,
              CS_RYT = 35328, CS_VN = 39936;
constexpr int CS_AT = 49152, CS_RT = CS_AT + 4608, CS_BT = CS_RT + 4608, CS_KT = CS_BT + 4608, CS_BB = 67584, CS_KB = CS_BB + 5120,
              CS_VT = CS_KB + 5120, CS_ATT = 82944, CS_PL = 92160, CS_SBF = 92416, CS_PRIV = 110848, CS_CST = 143616, CS_BL = 145664;

__device__ __forceinline__ void lds_barrier() {
  asm volatile("s_waitcnt lgkmcnt(0)" ::: "memory");
  __builtin_amdgcn_s_barrier();
  asm volatile("" ::: "memory");
}
template <int Q> __device__ __forceinline__ float quad_bcast(float x) { return dpp_f<Q * 0x55>(x); }

template <int S0> __device__ __forceinline__ void solve_steps(float (&x)[8], const float* nab, int seg) {
  if constexpr (S0 < 32) {
    const float xs = quad_bcast<(S0 >> 3)>(x[S0 & 7]);
    const f32x4 n0 = *(const f32x4*)(nab + S0 * 32 + seg * 8), n1 = *(const f32x4*)(nab + S0 * 32 + seg * 8 + 4);
    x[0] += xs * n0[0]; x[1] += xs * n0[1]; x[2] += xs * n0[2]; x[3] += xs * n0[3];
    x[4] += xs * n1[0]; x[5] += xs * n1[1]; x[6] += xs * n1[2]; x[7] += xs * n1[3];
    solve_steps<S0 + 1>(x, nab, seg);
  }
}

__device__ __forceinline__ void scan_phase(PREF p, char* smem, const int wid_u) {
  float* stepbuf = (float*)smem;
  float* Nab = (float*)(smem + CS_NAB);
  bf16_t* NakT = (bf16_t*)(smem + CS_NAK);
  bf16_t* VNb = (bf16_t*)(smem + CS_VN);
  bf16_t* NbrT = (bf16_t*)(smem + CS_NBRT);
  bf16_t* NkrT = (bf16_t*)(smem + CS_NKRT);
  bf16_t* TT = (bf16_t*)(smem + CS_QT);
  bf16_t* Wb = (bf16_t*)(smem + CS_W);
  bf16_t* Zb = (bf16_t*)(smem + CS_Z);
  bf16_t* GT = (bf16_t*)(smem + CS_GT);
  bf16_t* RyT = (bf16_t*)(smem + CS_RYT);
  bf16_t* At = (bf16_t*)(smem + CS_AT);
  bf16_t* Rt = (bf16_t*)(smem + CS_RT);
  bf16_t* Bt = (bf16_t*)(smem + CS_BT);
  bf16_t* Kt = (bf16_t*)(smem + CS_KT);
  bf16_t* Bb = (bf16_t*)(smem + CS_BB);
  bf16_t* Kb = (bf16_t*)(smem + CS_KB);
  bf16_t* VT = (bf16_t*)(smem + CS_VT);
  bf16_t* AtTb = (bf16_t*)(smem + CS_ATT);
  float* PLs = (float*)(smem + CS_PL);
  bf16_t* Sbf = (bf16_t*)(smem + CS_SBF);
  float* cst = (float*)(smem + CS_CST);
  const bf16_t* z = P_RU;
  const int tid = opaque_tid();
  const int wave = __builtin_amdgcn_readfirstlane(tid >> 6), lane = tid & 63, fr = lane & 15, fq = lane >> 4;
  const int item = blockIdx.x;
  if (item < 256) {
    const int s = item < 128 ? 8 + (item >> 4) : ((item - 128) >> 4);
    const int h = (item & 15) >> 1, d = item & 1;
    const int T = s < 8 ? 4096 : 8192, r0seq = seq_start(s), nch = T / 32;
    bf16_t* yout = P_RY + (size_t)d * NTOK * 512;
    {
      const int g = tid >> 6, k = tid & 63;
      float v;
      if (g == 0) v = p.shift_mu[2048 - 512 + d * 64 + k];
      else if (g == 1) v = p.shift_mu[2176 - 512 + d * 64 + k];
      else if (g == 2) v = p.shift_mu[1024 - 512 + h * 64 + k];
      else if (g == 3) v = p.shift_mu[512 - 512 + h * 64 + k];
      else if (g == 4) v = p.shift_mu[1536 - 512 + h * 64 + k];
      else if (g == 5) v = p.k_k[h * 64 + k];
      else if (g == 6) v = p.k_a[h * 64 + k];
      else v = p.r_k[h * 64 + k];
      cst[g * 64 + k] = v;
      for (int i = tid; i < 2 * 64 * 72 / 2; i += NTHR) ((unsigned*)Sbf)[i] = 0u;
    }
    const int role = wave >> 1, th = wave & 1;
    const int tl = lane >> 2, cq = lane & 3;
    bf16_t* Ab = (bf16_t*)(smem + CS_PRIV + (wave & 3) * 8192);
    float* tmpa = (float*)(smem + CS_PRIV + (wave & 3) * 8192 + 2560);
    uint4* Blds = (uint4*)(smem + CS_BL) + (role & 1) * 512;
    float bias[4] = {0.f, 0.f, 0.f, 0.f};
    if (role < 2) {
      const float* lsrc = sel(role != 0, p.a2, p.w2) + (size_t)d * 64 * 512 + h * 64;
      if (th == 0) {
#pragma unroll
        for (int nt = 0; nt < 4; ++nt)
#pragma unroll
          for (int ks = 0; ks < 2; ++ks) {
            float o[8];
#pragma unroll
            for (int q = 0; q < 8; ++q) o[q] = lsrc[(size_t)(ks * 32 + fq * 8 + q) * 512 + nt * 16 + fr];
            Blds[(nt * 2 + ks) * 64 + lane] = pack8(o);
          }
      }
#pragma unroll
      for (int nt = 0; nt < 4; ++nt) bias[nt] = sel(role != 0, p.a0, p.w0)[d * 512 + h * 64 + nt * 16 + fr];
    }
    const int colA = (role == 0 ? 2048 + d * 64 : role == 1 ? 2176 + d * 64 : 512 + h * 64) + cq * 16;
    const int colB = (role == 1 ? 1024 : 1536) + h * 64 + cq * 16;
    Raw16 ra, rb;
    {
      const int j = th * 16 + tl, t = d ? T - 1 - j : j, row = r0seq + t;
      if (role < 3) load_raw16(ra, z, row, t, T, colA);
      if (role == 1 || role == 2) load_raw16(rb, z, row, t, T, colB);
    }
    f32x4 Sa = {0.f, 0.f, 0.f, 0.f}, Sb = Sa;
    uint2 y_def = make_uint2(0u, 0u);
    float sb_def = 0.f;
    const int mt = wave >> 1, hn = wave & 1, nt0 = 2 * hn, nt1 = 2 * hn + 1;
    __syncthreads();

    for (int c = 0; c < nch; ++c) {
      if (role < 3) {
        const int j = th * 16 + tl;
        const int istep = c * 32 + j;
        const int t = d ? T - 1 - istep : istep;
        const int row = r0seq + t;
        float v16[16];
        if (role < 2) {
          shift16(ra, cst + role * 64 + cq * 16, v16);
          if (role == 0) {
#pragma unroll
            for (int q = 0; q < 16; ++q) { const float e = __expf(2.f * v16[q]); v16[q] = 1.f - 2.f * __builtin_amdgcn_rcpf(e + 1.f); }
          }
          *(uint4*)(Ab + tl * 72 + cq * 16) = pack8(v16);
          *(uint4*)(Ab + tl * 72 + cq * 16 + 8) = pack8(v16 + 8);
          __builtin_amdgcn_wave_barrier();
          f32x4 acc[4] = {};
#pragma unroll
          for (int ks = 0; ks < 2; ++ks) {
            const bf16x8 a = *reinterpret_cast<const bf16x8*>(Ab + fr * 72 + ks * 32 + fq * 8);
#pragma unroll
            for (int nt = 0; nt < 4; ++nt) { const uint4 bu = Blds[(nt * 2 + ks) * 64 + lane]; acc[nt] = MFMA16(a, *reinterpret_cast<const bf16x8*>(&bu), acc[nt]); }
          }
          if (role == 0) {
#pragma unroll
            for (int nt = 0; nt < 4; ++nt)
#pragma unroll
              for (int jj = 0; jj < 4; ++jj) {
                const float sg = sigmoidf_(bias[nt] + acc[nt][jj]);
                stepbuf[0 * SV + (th * 16 + fq * 4 + jj) * 64 + nt * 16 + fr] = __expf(-0.6065306597126334f * sg);
              }
            __builtin_amdgcn_wave_barrier();
            {
              float wl[16];
#pragma unroll
              for (int i = 0; i < 16; ++i) wl[i] = stepbuf[0 * SV + (th * 16 + i) * 64 + lane];
              float pr = 1.f;
#pragma unroll
              for (int i = 0; i < 16; ++i) { pr *= wl[i]; stepbuf[0 * SV + (th * 16 + i) * 64 + lane] = pr; }
            }
          } else {
#pragma unroll
            for (int nt = 0; nt < 4; ++nt)
#pragma unroll
              for (int jj = 0; jj < 4; ++jj) tmpa[(fq * 4 + jj) * 68 + nt * 16 + fr] = sigmoidf_(bias[nt] + acc[nt][jj]);
            __builtin_amdgcn_wave_barrier();
            float av[16], kd[16];
#pragma unroll
            for (int q = 0; q < 4; ++q) { f32x4 a4 = *(const f32x4*)(tmpa + tl * 68 + cq * 16 + q * 4); av[q * 4] = a4[0]; av[q * 4 + 1] = a4[1]; av[q * 4 + 2] = a4[2]; av[q * 4 + 3] = a4[3]; }
            shift16(rb, cst + 2 * 64 + cq * 16, v16);
            float kk[16], ss = 0.f;
#pragma unroll
            for (int q = 0; q < 16; ++q) { kk[q] = v16[q] * cst[5 * 64 + cq * 16 + q]; ss += kk[q] * kk[q]; }
            ss = quad_sum(ss);
            const float inv = 1.f / fmaxf(sqrtf(ss), 1e-12f);
#pragma unroll
            for (int q = 0; q < 16; ++q) { kk[q] *= inv; kd[q] = v16[q] * (1.f + (av[q] - 1.f) * cst[6 * 64 + cq * 16 + q]); }
#pragma unroll
            for (int q = 0; q < 4; ++q) {
              *(f32x4*)(stepbuf + 3 * SV + j * 64 + cq * 16 + q * 4) = (f32x4){-kk[q * 4], -kk[q * 4 + 1], -kk[q * 4 + 2], -kk[q * 4 + 3]};
              *(f32x4*)(stepbuf + 4 * SV + j * 64 + cq * 16 + q * 4) = (f32x4){kk[q * 4] * av[q * 4], kk[q * 4 + 1] * av[q * 4 + 1], kk[q * 4 + 2] * av[q * 4 + 2], kk[q * 4 + 3] * av[q * 4 + 3]};
              *(f32x4*)(stepbuf + 1 * SV + j * 64 + cq * 16 + q * 4) = (f32x4){kd[q * 4], kd[q * 4 + 1], kd[q * 4 + 2], kd[q * 4 + 3]};
            }
          }
        } else {
          shift16(ra, cst + 3 * 64 + cq * 16, v16);
#pragma unroll
          for (int q = 0; q < 4; ++q) *(f32x4*)(stepbuf + 2 * SV + j * 64 + cq * 16 + q * 4) = (f32x4){v16[q * 4], v16[q * 4 + 1], v16[q * 4 + 2], v16[q * 4 + 3]};
          shift16(rb, cst + 4 * 64 + cq * 16, v16);
#pragma unroll
          for (int q = 0; q < 4; ++q) *(f32x4*)(stepbuf + 5 * SV + j * 64 + cq * 16 + q * 4) = (f32x4){v16[q * 4], v16[q * 4 + 1], v16[q * 4 + 2], v16[q * 4 + 3]};
        }
      }
      if (c > 0) {
        const int ip = (c - 1) * 32 + hn * 16 + fr, tp = d ? T - 1 - ip : ip;
        *(uint2*)(yout + (size_t)(r0seq + tp) * 512 + h * 64 + mt * 16 + fq * 4) = y_def;
        if (role == 2 && cq == 0) { const int is_ = (c - 1) * 32 + th * 16 + tl, tg = d ? T - 1 - is_ : is_; P_SBON[((size_t)(r0seq + tg) * 8 + h) * 2 + d] = sb_def; }
      }
      if (role < 3 && c + 1 < nch) {
        const int is2 = (c + 1) * 32 + th * 16 + tl;
        const int t2 = d ? T - 1 - is2 : is2;
        const int row2 = r0seq + t2;
        load_raw16(ra, z, row2, t2, T, colA);
        if (role >= 1) load_raw16(rb, z, row2, t2, T, colB);
      }
      lds_barrier();
      {
        const int k = lane, seg = wave;
        const float* sw = stepbuf + 0 * SV + k;
        const float P15 = sw[15 * 64];
        const float hiF = seg >= 4 ? P15 : 1.f;
        float P[5];
        P[0] = seg == 0 ? 1.f : sw[(4 * seg - 1) * 64] * (seg > 4 ? P15 : 1.f);
#pragma unroll
        for (int i = 0; i < 4; ++i) P[i + 1] = sw[(4 * seg + i) * 64] * hiF;
        const float PL = sw[31 * 64] * P15;
        if (role == 2) {
          const int j = th * 16 + tl;
          float bs = 0.f;
#pragma unroll
          for (int q = 0; q < 16; ++q) bs += stepbuf[2 * SV + j * 64 + cq * 16 + q] * stepbuf[1 * SV + j * 64 + cq * 16 + q] * cst[7 * 64 + cq * 16 + q];
          bs = quad_sum(bs);
          sb_def = bs;
        }
        f32x4 bb, kb, at, vv;
#pragma unroll
        for (int i = 0; i < 4; ++i) {
          const int t = 4 * seg + i;
          const float inv = __builtin_amdgcn_rcpf(P[i + 1]);
          const float a_ = P[i] * stepbuf[3 * SV + t * 64 + k];
          const float rraw = stepbuf[2 * SV + t * 64 + k], kraw = stepbuf[1 * SV + t * 64 + k];
          const float r_ = P[i + 1] * rraw;
          const float b_ = stepbuf[4 * SV + t * 64 + k] * inv;
          const float k_ = kraw * inv;

          At[t * 72 + k] = (bf16_t)(cvt_pk_bf16(a_, 0.f) & 0xffff);
          Rt[t * 72 + k] = (bf16_t)(cvt_pk_bf16(r_, 0.f) & 0xffff);
          Bt[t * 72 + k] = (bf16_t)(cvt_pk_bf16(b_, 0.f) & 0xffff);
          Kt[t * 72 + k] = (bf16_t)(cvt_pk_bf16(k_, 0.f) & 0xffff);
          bb[i] = b_ * PL; kb[i] = k_ * PL; at[i] = a_;
          vv[i] = stepbuf[5 * SV + t * 64 + k];
        }
        *(uint2*)(Bb + k * 40 + 4 * seg) = pack4(bb);
        *(uint2*)(Kb + k * 40 + 4 * seg) = pack4(kb);
        *(uint2*)(VT + k * 40 + 4 * seg) = pack4(vv);
        *(uint2*)(AtTb + k * 40 + 4 * seg) = pack4(at);
        if (seg == 0) PLs[k] = PL;
      }
      lds_barrier();
      {
        const int mat = wave >> 1, mts = wave & 1;
        const bf16_t* As = (mat & 1) ? Kt : Bt;
        const bf16_t* Bs = (mat & 2) ? Rt : At;
        f32x4 acc[2] = {};
#pragma unroll
        for (int ks = 0; ks < 2; ++ks) {
          const bf16x8 a = ldfrag(As, 72, mts * 16, ks * 32, fr, fq);
#pragma unroll
          for (int nt = 0; nt < 2; ++nt) acc[nt] = MFMA16(a, ldfrag(Bs, 72, nt * 16, ks * 32, fr, fq), acc[nt]);
        }
#pragma unroll
        for (int nt = 0; nt < 2; ++nt) {
          const int tcol = nt * 16 + fr;
          f32x4 v = acc[nt];
#pragma unroll
          for (int jj = 0; jj < 4; ++jj) {
            const int srow = mts * 16 + fq * 4 + jj;
            const bool keep = (mat & 2) ? (srow <= tcol) : (srow < tcol);
            v[jj] = keep ? v[jj] : 0.f;
          }
          if (mat == 0) {
#pragma unroll
            for (int jj = 0; jj < 4; ++jj) Nab[(mts * 16 + fq * 4 + jj) * 32 + tcol] = v[jj];
          } else {
            bf16_t* dst = mat == 1 ? NakT : mat == 2 ? NbrT : NkrT;
            *(uint2*)(dst + tcol * 40 + mts * 16 + fq * 4) = pack4(v);
          }
        }
      }
      lds_barrier();
      if (wave < 2) {
        const int seg = lane & 3, rrow = wave * 16 + (lane >> 2);
        float x[8];
#pragma unroll
        for (int i = 0; i < 8; ++i) x[i] = (seg * 8 + i == rrow) ? 1.f : 0.f;
        solve_steps<0>(x, Nab, seg);
#pragma unroll
        for (int i = 0; i < 8; ++i) TT[(seg * 8 + i) * 40 + rrow] = (bf16_t)(cvt_pk_bf16(x[i], 0.f) & 0xffff);
      } else if (wave < 6) {
        const int vtile = wave - 2;
        const bf16x8 vf = ldfrag(VT, 40, vtile * 16, 0, fr, fq);
        const f32x4 zero = {0.f, 0.f, 0.f, 0.f};
#pragma unroll
        for (int tt = 0; tt < 2; ++tt) {
          const f32x4 acc = MFMA16(ldfrag(NakT, 40, tt * 16, 0, fr, fq), vf, zero);
          *(uint2*)(VNb + (vtile * 16 + fr) * 40 + tt * 16 + fq * 4) = pack4(acc);
        }
      }
      lds_barrier();
      {
        const int tt = wave & 1, rt = wave >> 1;
        const f32x4 zero = {0.f, 0.f, 0.f, 0.f};
        const bf16x8 tf = ldfrag(TT, 40, tt * 16, 0, fr, fq);
        const f32x4 zacc = MFMA16(tf, ldfrag(VNb, 40, rt * 16, 0, fr, fq), zero);
        const f32x4 wacc = MFMA16(tf, ldfrag(AtTb, 40, rt * 16, 0, fr, fq), zero);
        *(uint2*)(Zb + (rt * 16 + fr) * 40 + tt * 16 + fq * 4) = pack4(zacc);
        *(uint2*)(Wb + (rt * 16 + fr) * 40 + tt * 16 + fq * 4) = pack4(wacc);
      }
      lds_barrier();
      f32x4 yacc = {0.f, 0.f, 0.f, 0.f};
      {
        const float pl0 = PLs[nt0 * 16 + fr], pl1 = PLs[nt1 * 16 + fr];
        Sa = Sa * pl0; Sb = Sb * pl1;
        const bf16x8 zf = ldfrag(Zb, 40, mt * 16, 0, fr, fq), vf = ldfrag(VT, 40, mt * 16, 0, fr, fq), wf = ldfrag(Wb, 40, mt * 16, 0, fr, fq);
        const bf16x8 bb0 = ldfrag(Bb, 40, nt0 * 16, 0, fr, fq), bb1 = ldfrag(Bb, 40, nt1 * 16, 0, fr, fq);
        const bf16x8 kb0 = ldfrag(Kb, 40, nt0 * 16, 0, fr, fq), kb1 = ldfrag(Kb, 40, nt1 * 16, 0, fr, fq);
        const bf16x8 nbr = ldfrag(NbrT, 40, hn * 16, 0, fr, fq), nkr = ldfrag(NkrT, 40, hn * 16, 0, fr, fq);
        Sa = MFMA16(zf, bb0, Sa); Sa = MFMA16(vf, kb0, Sa);
        Sb = MFMA16(zf, bb1, Sb); Sb = MFMA16(vf, kb1, Sb);
        yacc = MFMA16(zf, nbr, yacc); yacc = MFMA16(vf, nkr, yacc);
        const f32x4 zero = {0.f, 0.f, 0.f, 0.f};
        const f32x4 g0 = MFMA16(wf, bb0, zero), g1 = MFMA16(wf, bb1, zero);
        f32x4 ry = MFMA16(wf, nbr, zero);
        *(uint2*)(GT + (nt0 * 16 + fr) * 72 + mt * 16 + fq * 4) = pack4(g0);
        *(uint2*)(GT + (nt1 * 16 + fr) * 72 + mt * 16 + fq * 4) = pack4(g1);
        const uint2 rr = *(const uint2*)(Rt + (hn * 16 + fr) * 72 + mt * 16 + fq * 4);
        ry[0] += bf_lo(rr.x); ry[1] += bf_hi(rr.x); ry[2] += bf_lo(rr.y); ry[3] += bf_hi(rr.y);
        *(uint2*)(RyT + (hn * 16 + fr) * 72 + mt * 16 + fq * 4) = pack4(ry);
      }
      lds_barrier();
      {
        const bf16_t* Scur = Sbf + (c & 1) * 64 * 72;
        bf16_t* Snext = Sbf + ((c + 1) & 1) * 64 * 72;
#pragma unroll
        for (int ks = 0; ks < 2; ++ks) {
          const bf16x8 af = ldfrag(Scur, 72, mt * 16, ks * 32, fr, fq);
          Sa = MFMA16(af, ldfrag(GT, 72, nt0 * 16, ks * 32, fr, fq), Sa);
          Sb = MFMA16(af, ldfrag(GT, 72, nt1 * 16, ks * 32, fr, fq), Sb);
          yacc = MFMA16(af, ldfrag(RyT, 72, hn * 16, ks * 32, fr, fq), yacc);
        }
        y_def = pack4(yacc);
#pragma unroll
        for (int jj = 0; jj < 4; ++jj) {
          Snext[(mt * 16 + fq * 4 + jj) * 72 + nt0 * 16 + fr] = (bf16_t)(cvt_pk_bf16(Sa[jj], 0.f) & 0xffff);
          Snext[(mt * 16 + fq * 4 + jj) * 72 + nt1 * 16 + fr] = (bf16_t)(cvt_pk_bf16(Sb[jj], 0.f) & 0xffff);
        }
      }
      lds_barrier();
    }
    {
      const int ip = (nch - 1) * 32 + hn * 16 + fr, tp = d ? T - 1 - ip : ip;
      *(uint2*)(yout + (size_t)(r0seq + tp) * 512 + h * 64 + mt * 16 + fq * 4) = y_def;
      if (role == 2 && cq == 0) { const int is_ = (nch - 1) * 32 + th * 16 + tl, tg = d ? T - 1 - is_ : is_; P_SBON[((size_t)(r0seq + tg) * 8 + h) * 2 + d] = sb_def; }
    }
  }
  if (item >= 128) {
    const int nb = gridDim.x - 128;
    for (int tile = item - 128; tile < NTOK / 32; tile += nb) pool_tile(z, P_RH, tile, tid);
  }
}

__device__ __forceinline__ void post_phase(PREF p, char* smem, const int wid_u) {
  bf16_t* Ag = (bf16_t*)smem;
  bf16_t* vt = (bf16_t*)(smem + 12800);
  float* ys = (float*)(smem + 12800 + 33280);
  const bf16_t* z = P_RU;
  const bf16_t* yf = P_RY;
  const bf16_t* ybk = P_RY + (size_t)NTOK * 512;
  bf16_t* mo = P_RH;
  const int tid = opaque_tid(), w = tid >> 6, lane = tid & 63, fr = lane & 15, fq = lane >> 4;
  bf16x8 Bg[4][6];
#pragma unroll
  for (int nt = 0; nt < 4; ++nt)
#pragma unroll
    for (int ks = 0; ks < 6; ++ks) {
      float o[8];
#pragma unroll
      for (int q = 0; q < 8; ++q) { const int k = ks * 32 + fq * 8 + q; o[q] = k < 160 ? p.g2[(size_t)k * 512 + w * 64 + nt * 16 + fr] : 0.f; }
      uint4 u = pack8(o);
      Bg[nt][ks] = *reinterpret_cast<bf16x8*>(&u);
    }
  float lng[4], lnb[4];
#pragma unroll
  for (int nt = 0; nt < 4; ++nt) { lng[nt] = p.lnx_g[w * 64 + nt * 16 + fr]; lnb[nt] = p.lnx_b[w * 64 + nt * 16 + fr]; }

  for (int tile = blockIdx.x; tile < NTOK / 32; tile += gridDim.x) {
    const int row0 = tile * 32;
    int s, t0, T;
    row_seq(row0, s, t0, T);
    for (int idx = tid; idx < 32 * 24; idx += NTHR) {
      const int tok = idx / 24, oc = idx % 24;
      float o[8];
      if (oc < 20) {
        load_shift8(z, row0 + tok, t0 + tok, T, 2304 + oc * 8, p.shift_mu, o);
#pragma unroll
        for (int q = 0; q < 8; ++q) o[q] = sigmoidf_(o[q]);
      } else {
#pragma unroll
        for (int q = 0; q < 8; ++q) o[q] = 0.f;
      }
      *(uint4*)(Ag + tok * 200 + oc * 8) = pack8(o);
    }
    for (int idx = tid; idx < 32 * 64; idx += NTHR) {
      const int tok = idx >> 6, oc = idx & 63, row = row0 + tok, t = t0 + tok;
      float o[8];
      load_shift8(z, row, t, T, 1536 + oc * 8, p.shift_mu, o);
      *(uint4*)(vt + tok * 520 + oc * 8) = pack8(o);
      float a[8], b[8];
      unpack8(*(const uint4*)(yf + (size_t)row * 512 + oc * 8), a);
      unpack8(*(const uint4*)(ybk + (size_t)row * 512 + oc * 8), b);
      *(f32x4*)(ys + tok * 516 + oc * 8) = (f32x4){a[0] + b[0], a[1] + b[1], a[2] + b[2], a[3] + b[3]};
      *(f32x4*)(ys + tok * 516 + oc * 8 + 4) = (f32x4){a[4] + b[4], a[5] + b[5], a[6] + b[6], a[7] + b[7]};
    }
    __syncthreads();
    f32x4 acc[2][4] = {};
#pragma unroll
    for (int ks = 0; ks < 6; ++ks) {
      bf16x8 a[2];
#pragma unroll
      for (int mt = 0; mt < 2; ++mt) a[mt] = *reinterpret_cast<const bf16x8*>(Ag + (mt * 16 + fr) * 200 + ks * 32 + fq * 8);
#pragma unroll
      for (int mt = 0; mt < 2; ++mt)
#pragma unroll
        for (int nt = 0; nt < 4; ++nt) acc[mt][nt] = __builtin_amdgcn_mfma_f32_16x16x32_bf16(a[mt], Bg[nt][ks], acc[mt][nt], 0, 0, 0);
    }
#pragma unroll
    for (int mt = 0; mt < 2; ++mt)
#pragma unroll
      for (int jj = 0; jj < 4; ++jj) {
        const int tok = mt * 16 + fq * 4 + jj, row = row0 + tok;
        float yv[4], sm_ = 0.f;
#pragma unroll
        for (int nt = 0; nt < 4; ++nt) { yv[nt] = ys[tok * 516 + w * 64 + nt * 16 + fr]; sm_ += yv[nt]; }
        const float mean = row16_sum(sm_) * (1.f / 64.f);
        float vs = 0.f;
#pragma unroll
        for (int nt = 0; nt < 4; ++nt) { yv[nt] -= mean; vs += yv[nt] * yv[nt]; }
        const float rs = rsqrtf(row16_sum(vs) * (1.f / 64.f) + 64e-5f);
        const float2 sb2 = *(const float2*)(P_SBON + ((size_t)row * 8 + w) * 2);
        const float sbs = sb2.x + sb2.y;
#pragma unroll
        for (int nt = 0; nt < 4; ++nt) {
          const float vv = bf2f(vt[tok * 520 + w * 64 + nt * 16 + fr]);
          const float o = (yv[nt] * rs * lng[nt] + lnb[nt] + sbs * vv) * acc[mt][nt][jj];
          mo[(size_t)row * D + 512 + w * 64 + nt * 16 + fr] = (bf16_t)(cvt_pk_bf16(o, 0.f) & 0xffff);
        }
      }
    __syncthreads();
  }
}

constexpr int NPHASE = 13;
__device__ __forceinline__ void do_phase(PREF p, int ph, char* smem, const int wid_u) {
  if (ph == 0) prep_phase(p, smem, wid_u);
  else if (ph == 1) row_phase<0>(p.x_prompt, p.x_sample, nullptr, nullptr, P_RH, P_MOD, nullptr, p.n1_pre, 0, 0.f, 0, wid_u);
  else if (ph == 4 || ph == 9) {
    const bool f = ph == 4;
    float* outp = p.out;
    row_phase<1>(sel(f, p.x_prompt, (const float*)outp), sel(f, p.x_sample, (const float*)(outp + (size_t)NPROMPT * D)), outp, P_RY, P_RH, P_MOD,
                 sel(f, p.n1_post, p.nm_post), sel(f, p.nm_pre, p.n2_pre), f ? 2 : 5, f ? 0.5f : 1.0f, f ? 3 : 6, wid_u);
  }
  else if (ph == 12) row_phase<2>(p.out, p.out + (size_t)NPROMPT * D, p.out, P_RY, nullptr, P_MOD, p.n2_post, nullptr, 8, 0.5f, 0, wid_u);
  else if (ph == 6) scan_phase(p, smem, wid_u);
  else if (ph == 7) post_phase(p, smem, wid_u);
  else {
    const bf16_t *A, *Bt; bf16_t* C; int N, K, ldc, epi;
    if (ph == 2 || ph == 10) { A = P_RH; Bt = sel(ph == 2, P_W13A, P_W13B); C = P_RU; N = 2 * FF; K = D; ldc = FF; epi = 1; }
    else if (ph == 3 || ph == 11) { A = P_RU; Bt = sel(ph == 3, P_W2A, P_W2B); C = P_RY; N = D; K = FF; ldc = D; epi = 0; }
    else if (ph == 5) { A = P_RH; Bt = P_WINT; C = P_RU; N = ZLD; K = D; ldc = ZLD; epi = 0; }
    else { A = P_RH; Bt = P_WOUTT; C = P_RY; N = D; K = D; ldc = D; epi = 0; }
    gemm_phase(A, Bt, C, NTOK, N, K, ldc, epi, smem, wid_u);
  }
}

extern __shared__ __attribute__((aligned(16))) char dyn_smem[];

__global__ void __launch_bounds__(NTHR, 2) mega_kernel(Params p) {
  cg::grid_group grid = cg::this_grid();
  const int wid_u = __builtin_amdgcn_readfirstlane(threadIdx.x >> 6);
  typedef const __attribute__((address_space(4))) Params* KP;
  const KP kp0 = (KP)__builtin_amdgcn_kernarg_segment_ptr();
#pragma unroll 1
  for (int ph = 0; ph < NPHASE; ++ph) {
    KP kp = kp0;
    asm volatile("" : "+s"(kp));
    do_phase(*kp, ph, dyn_smem, wid_u);
#ifdef PROBE_REPEAT
    if (ph == PROBE_REPEAT) { grid.sync(); do_phase(*kp, ph, dyn_smem, wid_u); }
#endif
    if (ph + 1 < NPHASE) grid.sync();
  }
}

__global__ void __launch_bounds__(NTHR, 2) phase_kernel(Params p, int ph) {
  const int wid_u = __builtin_amdgcn_readfirstlane(threadIdx.x >> 6);
  do_phase(*(const __attribute__((address_space(4))) Params*)__builtin_amdgcn_kernarg_segment_ptr(), ph, dyn_smem, wid_u);
}

extern "C" void kernel_launch(void* const* d_in, const int* in_sizes, int n_in, void* d_out, int out_size, void* d_ws, size_t ws_size,
                              hipStream_t stream) {
  Params p{};
  const float** f = (const float**)&p;
  for (int i = 0; i < 33; ++i) f[i] = (const float*)d_in[i];
  p.out = (float*)d_out;
  p.ws = (char*)d_ws;
  if (WS_NEED > ws_size) { fprintf(stderr, "workspace too small: need %zu have %zu\n", (size_t)WS_NEED, ws_size); return; }

#if ONE_LAUNCH
  static int grid_blocks = 0;
  if (!grid_blocks) {
    int dev = 0, cus = 0, per_cu = 0;
    (void)hipGetDevice(&dev);
    (void)hipDeviceGetAttribute(&cus, hipDeviceAttributeMultiprocessorCount, dev);
    (void)hipFuncSetAttribute((const void*)mega_kernel, hipFuncAttributeMaxDynamicSharedMemorySize, SMEM_BYTES);
    (void)hipOccupancyMaxActiveBlocksPerMultiprocessor(&per_cu, mega_kernel, NTHR, SMEM_BYTES);
    if (per_cu < 1) per_cu = 1;
    grid_blocks = cus * per_cu;
  }
  void* args[] = {&p};
  hipError_t e = hipLaunchCooperativeKernel((const void*)mega_kernel, dim3(grid_blocks), dim3(NTHR), args, SMEM_BYTES, stream);
  if (e != hipSuccess) fprintf(stderr, "cooperative launch failed: %s (grid %d)\n", hipGetErrorString(e), grid_blocks);
#else
  static bool attr = false;
  if (!attr) { (void)hipFuncSetAttribute((const void*)phase_kernel, hipFuncAttributeMaxDynamicSharedMemorySize, SMEM_BYTES); attr = true; }
  for (int ph = 0; ph < NPHASE; ++ph) phase_kernel<<<256, NTHR, SMEM_BYTES, stream>>>(p, ph);
#endif
}
```

```cpp
#include <hip/hip_runtime.h>
#include <hip/hip_cooperative_groups.h>
#include <cstdio>
namespace cg = cooperative_groups;

#ifndef ONE_LAUNCH
#define ONE_LAUNCH 1
#endif

typedef unsigned short bf16_t;
typedef short bf16x8 __attribute__((ext_vector_type(8)));
typedef float f32x4 __attribute__((ext_vector_type(4)));
typedef float f32x2 __attribute__((ext_vector_type(2)));
#define LAS __attribute__((address_space(3)))

constexpr int D = 1024, FF = 2816, NTOK = 98304, NPROMPT = 32768, ZLD = 2560, PINW = 2464;
constexpr int NTHR = 512;
constexpr int SMEM_BYTES = 162304;

struct Params {
  const float *x_prompt, *x_sample, *c_prompt, *c_sample, *ada_w, *ada_b, *n1_pre, *n1_post, *f1_w1, *f1_w3, *f1_w2,
      *nm_pre, *nm_post, *w_in, *shift_mu, *pool_w, *pool_scale, *w0, *w2, *a0, *a2, *g2, *k_k, *k_a, *r_k, *lnx_g, *lnx_b,
      *w_out, *n2_pre, *n2_post, *f2_w1, *f2_w3, *f2_w2;
  float* out;
  char* ws;
};
#define PREF const __attribute__((address_space(4))) Params&
constexpr size_t al256(size_t b) { return (b + 255) & ~(size_t)255; }
constexpr size_t OFF_W13A = 0;
constexpr size_t OFF_W13B = OFF_W13A + al256((size_t)2 * FF * D * 2);
constexpr size_t OFF_W2A = OFF_W13B + al256((size_t)2 * FF * D * 2);
constexpr size_t OFF_W2B = OFF_W2A + al256((size_t)D * FF * 2);
constexpr size_t OFF_WINT = OFF_W2B + al256((size_t)D * FF * 2);
constexpr size_t OFF_WOUTT = OFF_WINT + al256((size_t)ZLD * D * 2);
constexpr size_t OFF_MOD = OFF_WOUTT + al256((size_t)D * D * 2);
constexpr size_t OFF_SBON = OFF_MOD + al256((size_t)16 * 9216 * 4);
constexpr size_t OFF_RH = OFF_SBON + al256((size_t)NTOK * 16 * 4);
constexpr size_t OFF_RY = OFF_RH + al256((size_t)NTOK * D * 2);
constexpr size_t OFF_RU = OFF_RY + al256((size_t)NTOK * D * 2);
constexpr size_t OFF_ALORA = OFF_RU + al256((size_t)NTOK * FF * 2);
constexpr size_t WS_NEED = OFF_ALORA + al256((size_t)NTOK * 256 * 2);
#define P_W13A ((bf16_t*)(p.ws + OFF_W13A))
#define P_W13B ((bf16_t*)(p.ws + OFF_W13B))
#define P_W2A ((bf16_t*)(p.ws + OFF_W2A))
#define P_W2B ((bf16_t*)(p.ws + OFF_W2B))
#define P_WINT ((bf16_t*)(p.ws + OFF_WINT))
#define P_WOUTT ((bf16_t*)(p.ws + OFF_WOUTT))
#define P_MOD ((float*)(p.ws + OFF_MOD))
#define P_SBON ((float*)(p.ws + OFF_SBON))
#define P_RH ((bf16_t*)(p.ws + OFF_RH))
#define P_RY ((bf16_t*)(p.ws + OFF_RY))
#define P_RU ((bf16_t*)(p.ws + OFF_RU))
#define P_ALORA ((bf16_t*)(p.ws + OFF_ALORA))

typedef __bf16 bf16x2_t __attribute__((ext_vector_type(2)));
__device__ __forceinline__ unsigned cvt_pk_bf16(float lo, float hi) {
  f32x2 v = {lo, hi};
  bf16x2_t b = __builtin_convertvector(v, bf16x2_t);
  return __builtin_bit_cast(unsigned, b);
}
__device__ __forceinline__ float bf_lo(unsigned u) { return __uint_as_float(u << 16); }
__device__ __forceinline__ float bf_hi(unsigned u) { return __uint_as_float(u & 0xffff0000u); }
__device__ __forceinline__ float bf2f(bf16_t b) { return __uint_as_float(((unsigned)b) << 16); }
__device__ __forceinline__ void unpack8(uint4 v, float* o) {
  o[0] = bf_lo(v.x); o[1] = bf_hi(v.x); o[2] = bf_lo(v.y); o[3] = bf_hi(v.y);
  o[4] = bf_lo(v.z); o[5] = bf_hi(v.z); o[6] = bf_lo(v.w); o[7] = bf_hi(v.w);
}
__device__ __forceinline__ uint4 pack8(const float* o) {
  uint4 v; v.x = cvt_pk_bf16(o[0], o[1]); v.y = cvt_pk_bf16(o[2], o[3]); v.z = cvt_pk_bf16(o[4], o[5]); v.w = cvt_pk_bf16(o[6], o[7]);
  return v;
}
__device__ __forceinline__ float sigmoidf_(float x) { return __builtin_amdgcn_rcpf(1.f + __expf(-x)); }
template <int CTRL> __device__ __forceinline__ float dpp_f(float x) {
  return __int_as_float(__builtin_amdgcn_update_dpp(0, __float_as_int(x), CTRL, 0xf, 0xf, false));
}
__device__ __forceinline__ float row16_sum(float x) {
  x += dpp_f<0x128>(x); x += dpp_f<0x124>(x); x += dpp_f<0x122>(x); x += dpp_f<0x121>(x);
  return x;
}
template <class T> __device__ __forceinline__ T sel(bool c, T a, T b) { return c ? a : b; }
__device__ __forceinline__ int opaque_tid_w(int wid) {
  int l;
  asm volatile("v_mbcnt_lo_u32_b32 %0, -1, 0\n\tv_mbcnt_hi_u32_b32 %0, -1, %0" : "=v"(l));
  return wid * 64 + l;
}
#define opaque_tid() opaque_tid_w(wid_u)
__device__ __forceinline__ float wave_sum(float v) {
  v = row16_sum(v);
  const float a = __int_as_float(__builtin_amdgcn_readlane(__float_as_int(v), 0)), b = __int_as_float(__builtin_amdgcn_readlane(__float_as_int(v), 16));
  const float c = __int_as_float(__builtin_amdgcn_readlane(__float_as_int(v), 32)), d = __int_as_float(__builtin_amdgcn_readlane(__float_as_int(v), 48));
  return (a + b) + (c + d);
}
__device__ __forceinline__ float quad_sum(float x) { x += dpp_f<0xB1>(x); x += dpp_f<0x4E>(x); return x; }
__device__ __forceinline__ int seq_start(int s) { return s < 8 ? s * 4096 : NPROMPT + (s - 8) * 8192; }
__device__ __forceinline__ void row_seq(int row, int& s, int& t, int& T) {
  if (row < NPROMPT) { s = row >> 12; t = row & 4095; T = 4096; }
  else { int r = row - NPROMPT; s = 8 + (r >> 13); t = r & 8191; T = 8192; }
}

__device__ __forceinline__ void tr_tile(const float* __restrict__ src, int ldsrc, int k0, int n0, int nvalid, bf16_t* __restrict__ dst, int ldd,
                        int kdst0, int mode, float* sm, const int tid) {
#pragma unroll
  for (int i = 0; i < 2; ++i) {
    const int r = (tid >> 4) + 32 * i, c = (tid & 15) * 4;
    float4 v = make_float4(0.f, 0.f, 0.f, 0.f);
    if (n0 + c < nvalid) v = *(const float4*)(src + (size_t)(k0 + r) * ldsrc + n0 + c);
    float* d = sm + r * 65 + c;
    d[0] = v.x; d[1] = v.y; d[2] = v.z; d[3] = v.w;
  }
  __syncthreads();
  {
    const int n = tid >> 3, kc = (tid & 7) * 8;
    float o[8];
#pragma unroll
    for (int j = 0; j < 8; ++j) o[j] = sm[(kc + j) * 65 + n];
    int nn = n0 + n, drow;
    if (mode == 0) drow = nn;
    else drow = 32 * (nn >> 4) + (nn & 15) + (mode == 2 ? 16 : 0);
    *(uint4*)(dst + (size_t)drow * ldd + kdst0 + k0 + kc) = pack8(o);
  }
  __syncthreads();
}

__device__ __forceinline__ void prep_phase(PREF p, char* smem, const int wid_u) {
  float* sm = (float*)smem;
  const int tid = opaque_tid();
  constexpr int N_MOD = 144, N_EFF = 128, N_W13 = 4 * 704, N_W2 = 2 * 704, N_WIN = 640, N_WOUT = 128;
  constexpr int TOTAL = N_MOD + N_EFF + N_W13 + N_W2 + N_WIN + N_WOUT;
  for (int item = blockIdx.x; item < TOTAL; item += gridDim.x) {
    int it = item;
    if (it < N_MOD) {
      const int j0 = it * 64;
      float* sc = sm;
      float* red = sm + 16384;
      for (int idx = tid; idx < 16384; idx += NTHR) {
        const int s = idx >> 10, k = idx & 1023;
        const float* cp_ = p.c_prompt; const float* cs_ = p.c_sample;
        const float c = s < 8 ? cp_[s * 1024 + k] : cs_[(s - 8) * 1024 + k];
        sc[idx] = c / (1.f + __expf(-c));
      }
      __syncthreads();
      const int col = tid & 63, kg = tid >> 6;
      float acc[16];
#pragma unroll
      for (int s = 0; s < 16; ++s) acc[s] = 0.f;
      for (int k = kg * 128; k < kg * 128 + 128; ++k) {
        const float w = p.ada_w[(size_t)k * 9216 + j0 + col];
#pragma unroll
        for (int s = 0; s < 16; ++s) acc[s] += sc[s * 1024 + k] * w;
      }
#pragma unroll
      for (int s = 0; s < 16; ++s) red[(kg * 16 + s) * 64 + col] = acc[s];
      __syncthreads();
      for (int o = tid; o < 1024; o += NTHR) {
        const int s = o >> 6, c2 = o & 63;
        float v = p.ada_b[j0 + c2];
#pragma unroll
        for (int g = 0; g < 8; ++g) v += red[(g * 16 + s) * 64 + c2];
        P_MOD[s * 9216 + j0 + c2] = v;
      }
      __syncthreads();
      continue;
    }
    it -= N_MOD;
    if (it < N_EFF) {
      const int g = it >> 5, itile = (it >> 4) & 1, ntile = it & 15;
      float* As = sm;
      float* Bs = sm + 64 * 129;
      for (int idx = tid; idx < 64 * 128; idx += NTHR) {
        const int i = idx >> 7, j = idx & 127;
        As[i * 129 + j] = p.pool_w[((size_t)g * 128 + itile * 64 + i) * 128 + j] * p.pool_scale[g * 128 + j];
      }
      for (int idx = tid; idx < 128 * 64; idx += NTHR) {
        const int j = idx >> 6, nn = idx & 63;
        Bs[j * 65 + nn] = p.w_out[(size_t)(g * 128 + j) * 1024 + ntile * 64 + nn];
      }
      __syncthreads();
      const int i = tid >> 3, nn0 = (tid & 7) * 8;
      float acc[8];
#pragma unroll
      for (int q = 0; q < 8; ++q) acc[q] = 0.f;
      for (int j = 0; j < 128; ++j) {
        const float a = As[i * 129 + j];
#pragma unroll
        for (int q = 0; q < 8; ++q) acc[q] += a * Bs[j * 65 + nn0 + q];
      }
#pragma unroll
      for (int q = 0; q < 8; ++q)
        P_WOUTT[(size_t)(ntile * 64 + nn0 + q) * 1024 + g * 128 + itile * 64 + i] = (bf16_t)(cvt_pk_bf16(acc[q], 0.f) & 0xffff);
      __syncthreads();
      continue;
    }
    it -= N_EFF;
    if (it < N_W13) {
      const int which = it / 704, r = it % 704;
      const int kt = r / 44, ntl = r % 44;
      const float* src = sel(which < 2, sel(which == 0, p.f1_w1, p.f1_w3), sel(which == 2, p.f2_w1, p.f2_w3));
      bf16_t* dst = sel(which < 2, P_W13A, P_W13B);
      tr_tile(src, FF, kt * 64, ntl * 64, FF, dst, D, 0, (which & 1) ? 2 : 1, sm, tid);
      continue;
    }
    it -= N_W13;
    if (it < N_W2) {
      const int which = it / 704, r = it % 704;
      const int kt = r / 16, ntl = r % 16;
      tr_tile(sel(which != 0, p.f2_w2, p.f1_w2), D, kt * 64, ntl * 64, D, sel(which != 0, P_W2B, P_W2A), FF, 0, 0, sm, tid);
      continue;
    }
    it -= N_W2;
    if (it < N_WIN) {
      const int kt = it / 40, ntl = it % 40;
      tr_tile(p.w_in, PINW, kt * 64, ntl * 64, PINW, P_WINT, D, 0, 0, sm, tid);
      continue;
    }
    it -= N_WIN;
    {
      const int kt = it / 16, ntl = it % 16;
      tr_tile(p.w_out + (size_t)512 * 1024, D, kt * 64, ntl * 64, D, P_WOUTT, D, 512, 0, sm, tid);
    }
  }
}

template <int MODE>
__device__ __forceinline__ void row_phase(const float* __restrict__ xp, const float* __restrict__ xs, float* __restrict__ xout,
                          const bf16_t* __restrict__ y, bf16_t* __restrict__ h, const float* __restrict__ mod,
                          const float* __restrict__ npost, const float* __restrict__ npre, int gate_idx, float cgate, int shift_idx, const int wid_u) {
  const int tid_ = opaque_tid();
  const int lane = tid_ & 63;
  const int gw = blockIdx.x * 8 + (tid_ >> 6), GW = gridDim.x * 8;
  for (int chunk = gw; chunk < NTOK / 16; chunk += GW) {
    const int row0 = chunk * 16;
    int s, t, T;
    row_seq(row0, s, t, T);
    const float* md = mod + s * 9216;
    f32x4 Am[4], Bm[4], Gm[4];
#pragma unroll
    for (int i = 0; i < 4; ++i) {
      const int c = i * 256 + lane * 4;
      if (MODE != 2) {
        f32x4 np = *(const f32x4*)(npre + c), sc = *(const f32x4*)(md + (shift_idx + 1) * 1024 + c);
        Am[i] = np * (sc + 1.f);
        Bm[i] = *(const f32x4*)(md + shift_idx * 1024 + c);
      }
      if (MODE != 0) {
        f32x4 g = *(const f32x4*)(md + gate_idx * 1024 + c), po = *(const f32x4*)(npost + c);
        Gm[i] = g * po * cgate;
      }
    }
    for (int r = 0; r < 16; ++r) {
      const int row = row0 + r;
      const float* xr = (row < NPROMPT) ? xp + (size_t)row * D : xs + (size_t)(row - NPROMPT) * D;
      f32x4 xv[4];
#pragma unroll
      for (int i = 0; i < 4; ++i) xv[i] = *(const f32x4*)(xr + i * 256 + lane * 4);
      if (MODE != 0) {
        f32x4 yv[4];
        float ss = 0.f;
#pragma unroll
        for (int i = 0; i < 4; ++i) {
          uint2 u = *(const uint2*)(y + (size_t)row * D + i * 256 + lane * 4);
          yv[i] = (f32x4){bf_lo(u.x), bf_hi(u.x), bf_lo(u.y), bf_hi(u.y)};
          ss += yv[i][0] * yv[i][0] + yv[i][1] * yv[i][1] + yv[i][2] * yv[i][2] + yv[i][3] * yv[i][3];
        }
        ss = wave_sum(ss);
        const float rs = rsqrtf(ss * (1.f / 1024.f) + 1e-6f);
#pragma unroll
        for (int i = 0; i < 4; ++i) {
          xv[i] = xv[i] + Gm[i] * yv[i] * rs;
          *(f32x4*)(xout + (size_t)row * D + i * 256 + lane * 4) = xv[i];
        }
      }
      if (MODE != 2) {
        float ss = 0.f;
#pragma unroll
        for (int i = 0; i < 4; ++i) ss += xv[i][0] * xv[i][0] + xv[i][1] * xv[i][1] + xv[i][2] * xv[i][2] + xv[i][3] * xv[i][3];
        ss = wave_sum(ss);
        const float rs = rsqrtf(ss * (1.f / 1024.f) + 1e-6f);
#pragma unroll
        for (int i = 0; i < 4; ++i) {
          f32x4 hv = xv[i] * rs * Am[i] + Bm[i];
          uint2 u; u.x = cvt_pk_bf16(hv[0], hv[1]); u.y = cvt_pk_bf16(hv[2], hv[3]);
          *(uint2*)(h + (size_t)row * D + i * 256 + lane * 4) = u;
        }
      }
    }
  }
}

constexpr int BM = 256, BK = 64, HALF = 128, NXCD = 8, WGM = 8, HT = HALF * BK;
__device__ __forceinline__ int lds_byte(int r, int c) {
  int st = (r >> 4) * 2 + (c >> 5), rr = r & 15, cc = c & 31, ob = rr * 64 + cc * 2;
  return st * 1024 + (ob ^ (((ob >> 9) & 1) << 5));
}
__device__ __forceinline__ void stage_rc(int b, int& R, int& C) {
  int st = b / 1024, sb = b % 1024, swz = sb ^ (((sb >> 9) & 1) << 5);
  R = (st >> 1) * 16 + swz / 64; C = (st & 1) * 32 + (swz % 64) / 2;
}

__device__ __forceinline__ bool gemm_unit(int i, int nM, int nN, int nwg, int& pm, int& pn) {
  const long L = (long)i * gridDim.x + blockIdx.x;
  if (L >= nwg) return false;
  int wgid = (int)L;
  { int q = nwg / NXCD, r = nwg % NXCD, xcd = wgid % NXCD, off = wgid / NXCD;
    wgid = (xcd < r ? xcd * (q + 1) : r * (q + 1) + (xcd - r) * q) + off; }
  const int nig = WGM * nN, gid = wgid / nig, fm = gid * WGM, gsz = min(nM - fm, WGM);
  pm = fm + ((wgid % nig) % gsz); pn = (wgid % nig) / gsz;
  return true;
}

__device__ __forceinline__ void gemm_phase(const bf16_t* __restrict__ A, const bf16_t* __restrict__ Bt, bf16_t* __restrict__ C, int M, int N, int K,
                                           int ldc, const int EPI, char* smem, const int wid_u) {
  const int nM = M / BM, nN = N / BM, nwg = nM * nN;
  const int tid = opaque_tid();
  LAS bf16_t* shm = (LAS bf16_t*)smem;
#define SA(b, h) (shm + ((b) * 2 + (h)) * HT)
#define SB(b, h) (shm + (4 + (b) * 2 + (h)) * HT)
#define STG(P, GB) do { const char* _gb = (GB); \
    _Pragma("unroll") for (int _i = 0; _i < 2; ++_i) { \
      __builtin_amdgcn_global_load_lds((const unsigned*)(_gb + voff[_i]), \
        (LAS unsigned*)((LAS char*)(P) + ldsw + _i * 8192), 16, 0, 0); } } while (0)
#define LDA(dst, b, h) _Pragma("unroll") for (int m = 0; m < 4; ++m) _Pragma("unroll") for (int k = 0; k < 2; ++k) \
    dst[m][k] = *(const LAS bf16x8*)((LAS char*)SA(b, h) + aoff + m * 2048 + k * 1024)
#define LDB(dst, b, h) _Pragma("unroll") for (int n = 0; n < 2; ++n) _Pragma("unroll") for (int k = 0; k < 2; ++k) \
    dst[n][k] = *(const LAS bf16x8*)((LAS char*)SB(b, h) + boff + n * 2048 + k * 1024)
#define MMA(ai, bj, At_, Bt_) do { __builtin_amdgcn_s_setprio(1); \
    _Pragma("unroll") for (int m = 0; m < 4; ++m) _Pragma("unroll") for (int n = 0; n < 2; ++n) _Pragma("unroll") for (int k = 0; k < 2; ++k) \
      acc[ai][bj][m][n] = __builtin_amdgcn_mfma_f32_16x16x32_bf16(Bt_[n][k], At_[m][k], acc[ai][bj][m][n], 0, 0, 0); \
    __builtin_amdgcn_s_setprio(0); } while (0)
#define WAIT_V(n) asm volatile("s_waitcnt vmcnt(" #n ")" ::: "memory")
#define WAIT_L(n) asm volatile("s_waitcnt lgkmcnt(" #n ")" ::: "memory")
#define BAR __builtin_amdgcn_s_barrier()
#define SCHED __builtin_amdgcn_sched_barrier(0)
  const int wid = __builtin_amdgcn_readfirstlane(tid >> 6), lane = tid & 63, wr = wid >> 2, wc = wid & 3, fr = lane & 15, fq = lane >> 4;
  const int aoff = lds_byte(wr * 64 + fr, fq * 8), boff = lds_byte(wc * 32 + fr, fq * 8);
  unsigned voff[2];
  const int ldsw = wid * 1024;
#pragma unroll
  for (int _i = 0; _i < 2; ++_i) { int _r, _c; stage_rc(tid * 16 + _i * 8192, _r, _c); voff[_i] = (unsigned)(_r * K + _c) * 2u; }
  const int nt = K / BK;
  const size_t kstep = (size_t)BK * 2, hstep = (size_t)HALF * K * 2, tstep = 2 * hstep;
  int pm, pn, npm = 0, npn = 0, ui = 0;
  if (!gemm_unit(0, nM, nN, nwg, pm, pn)) return;
  f32x4 acc[2][2][4][2];
#pragma unroll
  for (int a = 0; a < 2; ++a)
#pragma unroll
    for (int b = 0; b < 2; ++b)
#pragma unroll
      for (int m = 0; m < 4; ++m)
#pragma unroll
        for (int n = 0; n < 2; ++n) acc[a][b][m][n] = (f32x4){0.f, 0.f, 0.f, 0.f};
  bf16x8 At[4][2], B0[2][2], B1[2][2];
  const char* cA = (const char*)A + (size_t)pm * tstep;
  const char* cB = (const char*)Bt + (size_t)pn * tstep;
  STG(SB(0, 0), cB); STG(SA(0, 0), cA); STG(SB(0, 1), cB + hstep); STG(SA(0, 1), cA + hstep);
  if (wr == 1) BAR;
  WAIT_V(4); BAR;
  STG(SB(1, 0), cB + kstep); STG(SA(1, 0), cA + kstep); STG(SB(1, 1), cB + hstep + kstep);
  WAIT_V(6); BAR;
  for (;;) {
    const bool has_next = gemm_unit(ui + 1, nM, nN, nwg, npm, npn);
    const char* nA = has_next ? (const char*)A + (size_t)npm * tstep : cA;
    const char* nB = has_next ? (const char*)Bt + (size_t)npn * tstep : cB;
    for (int t = 0; t < nt; t += 2) {
      const bool last = (t == nt - 2);
      const char* a1 = cA + (size_t)(t + 1) * kstep;
      const char* a2 = last ? nA : cA + (size_t)(t + 2) * kstep;
      const char* b2 = last ? nB : cB + (size_t)(t + 2) * kstep;
      const char* a3 = a2 + kstep;
      const char* b3 = b2 + kstep;
      LDB(B0, 0, 0); SCHED; LDA(At, 0, 0); STG(SA(1, 1), a1 + hstep);
      WAIT_L(8); BAR; WAIT_L(0); MMA(0, 0, At, B0); BAR; SCHED;
      LDB(B1, 0, 1); STG(SB(0, 0), b2);
      BAR; WAIT_L(0); MMA(0, 1, At, B1); BAR;
      LDA(At, 0, 1); STG(SA(0, 0), a2);
      BAR; WAIT_L(0); MMA(1, 0, At, B0); BAR; SCHED;
      STG(SB(0, 1), b2 + hstep);
      WAIT_V(6); BAR; MMA(1, 1, At, B1); BAR;
      LDB(B0, 1, 0); SCHED; LDA(At, 1, 0); STG(SA(0, 1), a2 + hstep);
      WAIT_L(8); BAR; WAIT_L(0); MMA(0, 0, At, B0); BAR; SCHED;
      LDB(B1, 1, 1); STG(SB(1, 0), b3);
      BAR; WAIT_L(0); MMA(0, 1, At, B1); BAR;
      LDA(At, 1, 1); STG(SA(1, 0), a3);
      BAR; WAIT_L(0); MMA(1, 0, At, B0); BAR; SCHED;
      STG(SB(1, 1), b3 + hstep);
      WAIT_V(6); BAR; MMA(1, 1, At, B1); BAR;
    }
    {
      const int brow = pm * BM, bcol = pn * BM;
#pragma unroll
      for (int ai = 0; ai < 2; ++ai)
#pragma unroll
        for (int m = 0; m < 4; ++m) {
          const size_t row = (size_t)(brow + ai * HALF + wr * 64 + m * 16 + fr);
#pragma unroll
          for (int bj = 0; bj < 2; ++bj) {
            if (EPI == 0) {
#pragma unroll
              for (int n = 0; n < 2; ++n) {
                const f32x4 v = acc[ai][bj][m][n];
                uint2 u; u.x = cvt_pk_bf16(v[0], v[1]); u.y = cvt_pk_bf16(v[2], v[3]);
                *(uint2*)(C + row * ldc + bcol + bj * HALF + wc * 32 + n * 16 + fq * 4) = u;
              }
            } else {
              const f32x4 a = acc[ai][bj][m][0], b = acc[ai][bj][m][1];
              float o[4];
#pragma unroll
              for (int j = 0; j < 4; ++j) o[j] = a[j] * __builtin_amdgcn_rcpf(1.f + __expf(-a[j])) * b[j];
              uint2 u; u.x = cvt_pk_bf16(o[0], o[1]); u.y = cvt_pk_bf16(o[2], o[3]);
              *(uint2*)(C + row * ldc + ((bcol + bj * HALF + wc * 32) >> 1) + fq * 4) = u;
            }
          }
        }
    }
    if (!has_next) break;
#pragma unroll
    for (int a = 0; a < 2; ++a)
#pragma unroll
      for (int b = 0; b < 2; ++b)
#pragma unroll
        for (int m = 0; m < 4; ++m)
#pragma unroll
          for (int n = 0; n < 2; ++n) acc[a][b][m][n] = (f32x4){0.f, 0.f, 0.f, 0.f};
    pm = npm; pn = npn; cA = nA; cB = nB; ++ui;
  }
  WAIT_V(0);
  if (wr == 0) BAR;
  BAR;
#undef SA
#undef SB
#undef STG
#undef LDA
#undef LDB
#undef MMA
}

__device__ __forceinline__ void load_shift16(const bf16_t* __restrict__ z, int row, int t, int T, int col, const float* __restrict__ mu, float* o) {
  const bf16_t* pz = z + (size_t)row * ZLD + col;
  uint4 c0 = *(const uint4*)pz, c1 = *(const uint4*)(pz + 8);
  uint4 p0 = make_uint4(0, 0, 0, 0), p1 = p0, n0 = p0, n1 = p0;
  if (t > 0) { p0 = *(const uint4*)(pz - ZLD); p1 = *(const uint4*)(pz - ZLD + 8); }
  if (t < T - 1) { n0 = *(const uint4*)(pz + ZLD); n1 = *(const uint4*)(pz + ZLD + 8); }
  float c[16], pv[16], nx[16];
  unpack8(c0, c); unpack8(c1, c + 8); unpack8(p0, pv); unpack8(p1, pv + 8); unpack8(n0, nx); unpack8(n1, nx + 8);
#pragma unroll
  for (int q = 0; q < 16; ++q) o[q] = c[q] + (0.5f * (pv[q] + nx[q]) - c[q]) * mu[col - 512 + q];
}
__device__ __forceinline__ void load_shift8(const bf16_t* __restrict__ z, int row, int t, int T, int col, const float* __restrict__ mu, float* o) {
  const bf16_t* pz = z + (size_t)row * ZLD + col;
  uint4 c0 = *(const uint4*)pz;
  uint4 p0 = make_uint4(0, 0, 0, 0), n0 = p0;
  if (t > 0) p0 = *(const uint4*)(pz - ZLD);
  if (t < T - 1) n0 = *(const uint4*)(pz + ZLD);
  float c[8], pv[8], nx[8];
  unpack8(c0, c); unpack8(p0, pv); unpack8(n0, nx);
#pragma unroll
  for (int q = 0; q < 8; ++q) o[q] = c[q] + (0.5f * (pv[q] + nx[q]) - c[q]) * mu[col - 512 + q];
}

constexpr int TC = 32;
constexpr int SV = TC * 64;
__device__ __forceinline__ void lora_prep_phase(PREF p, const int wid_u) {
  const int tid = opaque_tid();
  const bf16_t* z = P_RU;
  bf16_t* al = P_ALORA;
  const float* mu = p.shift_mu;
  for (int task = blockIdx.x * NTHR + tid; task < NTOK * 32; task += gridDim.x * NTHR) {
    const int row = task >> 5, oc = task & 31;
    int s, t, T;
    row_seq(row, s, t, T);
    float o[8];
    load_shift8(z, row, t, T, 2048 + oc * 8, mu, o);
    if (oc < 16) {
#pragma unroll
      for (int q = 0; q < 8; ++q) { const float e = __expf(2.f * o[q]); o[q] = 1.f - 2.f * __builtin_amdgcn_rcpf(e + 1.f); }
    }
    *(uint4*)(al + (size_t)row * 256 + oc * 8) = pack8(o);
  }
}

template <int HALF>
__device__ __forceinline__ void pool_seg(const bf16_t* __restrict__ z, bf16_t* __restrict__ mo, int row_base, int tbase, int T, int c0) {
  constexpr int NR = 2 * HALF + 3;
  float acc[4][8], zc[4][8];
#pragma unroll
  for (int i = 0; i < 4; ++i)
#pragma unroll
    for (int q = 0; q < 8; ++q) { acc[i][q] = 0.f; zc[i][q] = 0.f; }
#pragma unroll
  for (int r = 0; r < NR; ++r) {
    const int tt = tbase - HALF + r;
    uint4 u = make_uint4(0, 0, 0, 0);
    if (tt >= 0 && tt < T) u = *(const uint4*)(z + (size_t)(row_base - HALF + r) * ZLD + c0);
    float v[8];
    unpack8(u, v);
#pragma unroll
    for (int i = 0; i < 4; ++i) {
      if (r >= i && r < i + 2 * HALF) {
#pragma unroll
        for (int q = 0; q < 8; ++q) acc[i][q] += v[q];
      }
      if (r == HALF + i) {
#pragma unroll
        for (int q = 0; q < 8; ++q) zc[i][q] = v[q];
      }
    }
  }
#pragma unroll
  for (int i = 0; i < 4; ++i) {
    const int ti = tbase + i;
    const float ic = 1.f / (float)(min(ti + HALF, T) - max(ti - HALF, 0));
    float o[8];
#pragma unroll
    for (int q = 0; q < 8; ++q) o[q] = acc[i][q] * ic - zc[i][q];
    *(uint4*)(mo + (size_t)(row_base + i) * D + c0) = pack8(o);
  }
}
__device__ __forceinline__ void pool_tile(const bf16_t* __restrict__ z, bf16_t* __restrict__ mo, int tile, int tid) {
  const int row0 = tile * 32;
  int s, t0, T;
  row_seq(row0, s, t0, T);
  const int oc = tid >> 3, seg = tid & 7, c0 = oc * 8, grp = __builtin_amdgcn_readfirstlane(oc >> 4);
  const int rb = row0 + seg * 4, tb = t0 + seg * 4;
  if (grp == 0) pool_seg<1>(z, mo, rb, tb, T, c0);
  else if (grp == 1) pool_seg<2>(z, mo, rb, tb, T, c0);
  else if (grp == 2) pool_seg<4>(z, mo, rb, tb, T, c0);
  else pool_seg<8>(z, mo, rb, tb, T, c0);
}

struct Raw16 { uint4 c0, c1, p0, p1, n0, n1; };
__device__ __forceinline__ void load_raw16(Raw16& r, const bf16_t* __restrict__ z, int row, int t, int T, int col) {
  const bf16_t* pz = z + (unsigned)(row * ZLD + col);
  r.c0 = *(const uint4*)pz; r.c1 = *(const uint4*)(pz + 8);
  r.p0 = make_uint4(0, 0, 0, 0); r.p1 = r.p0; r.n0 = r.p0; r.n1 = r.p0;
  if (t > 0) { r.p0 = *(const uint4*)(pz - ZLD); r.p1 = *(const uint4*)(pz - ZLD + 8); }
  if (t < T - 1) { r.n0 = *(const uint4*)(pz + ZLD); r.n1 = *(const uint4*)(pz + ZLD + 8); }
}
__device__ __forceinline__ void shift16(const Raw16& r, const float* c1, const float* c2, float* o) {
  float c[16], pv[16], nx[16];
  unpack8(r.c0, c); unpack8(r.c1, c + 8); unpack8(r.p0, pv); unpack8(r.p1, pv + 8); unpack8(r.n0, nx); unpack8(r.n1, nx + 8);
#pragma unroll
  for (int q = 0; q < 16; ++q) o[q] = c[q] * c1[q] + (pv[q] + nx[q]) * c2[q];
}
__device__ __forceinline__ bf16x8 ldfrag(const bf16_t* base, int stride, int row0, int k0, int fr, int fq) {
  return *reinterpret_cast<const bf16x8*>(base + (row0 + fr) * stride + k0 + fq * 8);
}
__device__ __forceinline__ uint2 pack4(f32x4 v) { uint2 u; u.x = cvt_pk_bf16(v[0], v[1]); u.y = cvt_pk_bf16(v[2], v[3]); return u; }
#define MFMA16(a, b, c) __builtin_amdgcn_mfma_f32_16x16x32_bf16(a, b, c, 0, 0, 0)

constexpr int CS_NAB = 0, CS_NAK = 4096, CS_NBRT = 8192, CS_NKRT = 10752, CS_QT = 13312, CS_W = 15872, CS_Z = 20992, CS_GT = 26112,
              CS_RYT = 35328, CS_VN = 39936;
constexpr int CS_AT = 49152, CS_RT = CS_AT + 4608, CS_BT = CS_RT + 4608, CS_KT = CS_BT + 4608, CS_BB = 67584, CS_KB = CS_BB + 5120,
              CS_VT = CS_KB + 5120, CS_ATT = 82944, CS_PL = 92160, CS_SBF = 92416, CS_PRIV = 110848, CS_CST = 143616, CS_BL = 145920;

__device__ __forceinline__ void lds_barrier() {
  asm volatile("s_waitcnt lgkmcnt(0)" ::: "memory");
  __builtin_amdgcn_s_barrier();
  asm volatile("" ::: "memory");
}
template <int Q> __device__ __forceinline__ float quad_bcast(float x) { return dpp_f<Q * 0x55>(x); }

template <int S0> __device__ __forceinline__ void solve_steps(float (&x)[8], const float* nab, int seg) {
  if constexpr (S0 < 32) {
    const float xs = quad_bcast<(S0 >> 3)>(x[S0 & 7]);
    const f32x4 n0 = *(const f32x4*)(nab + S0 * 32 + seg * 8), n1 = *(const f32x4*)(nab + S0 * 32 + seg * 8 + 4);
    x[0] += xs * n0[0]; x[1] += xs * n0[1]; x[2] += xs * n0[2]; x[3] += xs * n0[3];
    x[4] += xs * n1[0]; x[5] += xs * n1[1]; x[6] += xs * n1[2]; x[7] += xs * n1[3];
    solve_steps<S0 + 1>(x, nab, seg);
  }
}

template <int S0> __device__ __forceinline__ void solve16(float (&x)[8], const float* nb) {
  if constexpr (S0 < 16) {
    const float xs = (S0 >> 3) ? dpp_f<0xF5>(x[S0 & 7]) : dpp_f<0xA0>(x[S0 & 7]);
    const f32x4 n0 = *(const f32x4*)(nb + S0 * 32), n1 = *(const f32x4*)(nb + S0 * 32 + 4);
    x[0] += xs * n0[0]; x[1] += xs * n0[1]; x[2] += xs * n0[2]; x[3] += xs * n0[3];
    x[4] += xs * n1[0]; x[5] += xs * n1[1]; x[6] += xs * n1[2]; x[7] += xs * n1[3];
    solve16<S0 + 1>(x, nb);
  }
}

__device__ __forceinline__ void scan_phase(PREF p, char* smem, const int wid_u) {
  float* stepbuf = (float*)smem;
  float* Nab = (float*)(smem + CS_NAB);
  bf16_t* NakT = (bf16_t*)(smem + CS_NAK);
  bf16_t* VNb = (bf16_t*)(smem + CS_VN);
  bf16_t* T11b = (bf16_t*)(smem + CS_VN + 5120);
  bf16_t* M1T = (bf16_t*)(smem + CS_VN + 5120 + 1280);
  bf16_t* NbrT = (bf16_t*)(smem + CS_NBRT);
  bf16_t* NkrT = (bf16_t*)(smem + CS_NKRT);
  bf16_t* TT = (bf16_t*)(smem + CS_QT);
  bf16_t* Wb = (bf16_t*)(smem + CS_W);
  bf16_t* Zb = (bf16_t*)(smem + CS_Z);
  bf16_t* GT = (bf16_t*)(smem + CS_GT);
  bf16_t* RyT = (bf16_t*)(smem + CS_RYT);
  bf16_t* At = (bf16_t*)(smem + CS_AT);
  bf16_t* Rt = (bf16_t*)(smem + CS_RT);
  bf16_t* Bt = (bf16_t*)(smem + CS_BT);
  bf16_t* Kt = (bf16_t*)(smem + CS_KT);
  bf16_t* Bb = (bf16_t*)(smem + CS_BB);
  bf16_t* Kb = (bf16_t*)(smem + CS_KB);
  bf16_t* VT = (bf16_t*)(smem + CS_VT);
  bf16_t* AtTb = (bf16_t*)(smem + CS_ATT);
  float* PLs = (float*)(smem + CS_PL);
  bf16_t* Sbf = (bf16_t*)(smem + CS_SBF);
  float* cst = (float*)(smem + CS_CST);
  const bf16_t* z = P_RU;
  const int tid = opaque_tid();
  const int wave = __builtin_amdgcn_readfirstlane(tid >> 6), lane = tid & 63, fr = lane & 15, fq = lane >> 4;
  const int item = blockIdx.x;
  if (item < 256) {
    const int s = item < 128 ? 8 + (item >> 4) : ((item - 128) >> 4);
    const int h = (item & 15) >> 1, d = item & 1;
    const int T = s < 8 ? 4096 : 8192, r0seq = seq_start(s), nch = T / 32;
    bf16_t* yout = P_RY + (size_t)d * NTOK * 512;
    {
      const int g = tid >> 6, k = tid & 63;
      const float muk = p.shift_mu[1024 - 512 + h * 64 + k], mur = p.shift_mu[512 - 512 + h * 64 + k], muv = p.shift_mu[1536 - 512 + h * 64 + k];
      float v;
      if (g == 0) v = 0.5f * muk;
      else if (g == 1) v = 0.5f * mur;
      else if (g == 2) v = 1.f - muk;
      else if (g == 3) v = 1.f - mur;
      else if (g == 4) v = 1.f - muv;
      else if (g == 5) v = p.k_k[h * 64 + k];
      else if (g == 6) v = p.k_a[h * 64 + k];
      else v = p.r_k[h * 64 + k];
      cst[g * 64 + k] = v;
      if (g == 0) cst[8 * 64 + k] = 0.5f * muv;
      for (int i = tid; i < 2 * 64 * 72 / 2; i += NTHR) ((unsigned*)Sbf)[i] = 0u;
    }
    const int role = wave >> 1, th = wave & 1;
    const int tl = lane >> 2, cq = lane & 3;
    float* tmpa = (float*)(smem + CS_PRIV + (wave & 3) * 8192 + 2560);
    uint4* Blds = (uint4*)(smem + CS_BL) + (role & 1) * 512;
    float bias[4] = {0.f, 0.f, 0.f, 0.f};
    if (role < 2) {
      const float* lsrc = sel(role != 0, p.a2, p.w2) + (size_t)d * 64 * 512 + h * 64;
      if (th == 0) {
#pragma unroll
        for (int nt = 0; nt < 4; ++nt)
#pragma unroll
          for (int ks = 0; ks < 2; ++ks) {
            float o[8];
#pragma unroll
            for (int q = 0; q < 8; ++q) o[q] = lsrc[(size_t)(ks * 32 + fq * 8 + q) * 512 + nt * 16 + fr];
            Blds[(nt * 2 + ks) * 64 + lane] = pack8(o);
          }
      }
#pragma unroll
      for (int nt = 0; nt < 4; ++nt) bias[nt] = sel(role != 0, p.a0, p.w0)[d * 512 + h * 64 + nt * 16 + fr];
    }
    const int colA = 512 + h * 64 + cq * 16;
    const int colB = (role == 1 ? 1024 : 1536) + h * 64 + cq * 16;
    const int alo = (role == 0 ? d * 64 : 128 + d * 64) + fq * 8;
    Raw16 ra, rb;
    {
      const int j = th * 16 + tl, t = d ? T - 1 - j : j, row = r0seq + t;
      if (role == 2) load_raw16(ra, z, row, t, T, colA);
      if (role == 1 || role == 2) load_raw16(rb, z, row, t, T, colB);
      if (role < 2) {
        const int j2 = th * 16 + fr, t2 = d ? T - 1 - j2 : j2;
        const bf16_t* ap = P_ALORA + (unsigned)((r0seq + t2) * 256 + alo);
        ra.c0 = *(const uint4*)ap; ra.c1 = *(const uint4*)(ap + 32);
      }
    }
    f32x4 Sa = {0.f, 0.f, 0.f, 0.f}, Sb = Sa;
    uint2 y_def = make_uint2(0u, 0u);
    float sb_def = 0.f;
    const int mt = wave >> 1, hn = wave & 1, nt0 = 2 * hn, nt1 = 2 * hn + 1;
    __syncthreads();

    for (int c = 0; c < nch; ++c) {
      if (role < 3) {
        const int j = th * 16 + tl;
        const int istep = c * 32 + j;
        const int t = d ? T - 1 - istep : istep;
        const int row = r0seq + t;
        float v16[16];
        if (role < 2) {
          f32x4 acc[4] = {};
#pragma unroll
          for (int ks = 0; ks < 2; ++ks) {
            const uint4 au = ks == 0 ? ra.c0 : ra.c1;
            const bf16x8 a = *reinterpret_cast<const bf16x8*>(&au);
#pragma unroll
            for (int nt = 0; nt < 4; ++nt) { const uint4 bu = Blds[(nt * 2 + ks) * 64 + lane]; acc[nt] = MFMA16(a, *reinterpret_cast<const bf16x8*>(&bu), acc[nt]); }
          }
          if (role == 0) {
#pragma unroll
            for (int nt = 0; nt < 4; ++nt)
#pragma unroll
              for (int jj = 0; jj < 4; ++jj) {
                const float sg = sigmoidf_(bias[nt] + acc[nt][jj]);
                stepbuf[0 * SV + (th * 16 + fq * 4 + jj) * 64 + nt * 16 + fr] = __expf(-0.6065306597126334f * sg);
              }
            __builtin_amdgcn_wave_barrier();
            {
              float wl[16];
#pragma unroll
              for (int i = 0; i < 16; ++i) wl[i] = stepbuf[0 * SV + (th * 16 + i) * 64 + lane];
              float pr = 1.f;
#pragma unroll
              for (int i = 0; i < 16; ++i) { pr *= wl[i]; stepbuf[0 * SV + (th * 16 + i) * 64 + lane] = pr; }
            }
          } else {
#pragma unroll
            for (int nt = 0; nt < 4; ++nt)
#pragma unroll
              for (int jj = 0; jj < 4; ++jj) tmpa[(fq * 4 + jj) * 68 + nt * 16 + fr] = sigmoidf_(bias[nt] + acc[nt][jj]);
            __builtin_amdgcn_wave_barrier();
            float av[16], kd[16];
#pragma unroll
            for (int q = 0; q < 4; ++q) { f32x4 a4 = *(const f32x4*)(tmpa + tl * 68 + cq * 16 + q * 4); av[q * 4] = a4[0]; av[q * 4 + 1] = a4[1]; av[q * 4 + 2] = a4[2]; av[q * 4 + 3] = a4[3]; }
            shift16(rb, cst + 2 * 64 + cq * 16, cst + 0 * 64 + cq * 16, v16);
            float kk[16], ss = 0.f;
#pragma unroll
            for (int q = 0; q < 16; ++q) { kk[q] = v16[q] * cst[5 * 64 + cq * 16 + q]; ss += kk[q] * kk[q]; }
            ss = quad_sum(ss);
            const float inv = 1.f / fmaxf(sqrtf(ss), 1e-12f);
#pragma unroll
            for (int q = 0; q < 16; ++q) { kk[q] *= inv; kd[q] = v16[q] * (1.f + (av[q] - 1.f) * cst[6 * 64 + cq * 16 + q]); }
#pragma unroll
            for (int q = 0; q < 4; ++q) {
              *(f32x4*)(stepbuf + 3 * SV + j * 64 + cq * 16 + q * 4) = (f32x4){-kk[q * 4], -kk[q * 4 + 1], -kk[q * 4 + 2], -kk[q * 4 + 3]};
              *(f32x4*)(stepbuf + 4 * SV + j * 64 + cq * 16 + q * 4) = (f32x4){kk[q * 4] * av[q * 4], kk[q * 4 + 1] * av[q * 4 + 1], kk[q * 4 + 2] * av[q * 4 + 2], kk[q * 4 + 3] * av[q * 4 + 3]};
              *(f32x4*)(stepbuf + 1 * SV + j * 64 + cq * 16 + q * 4) = (f32x4){kd[q * 4], kd[q * 4 + 1], kd[q * 4 + 2], kd[q * 4 + 3]};
            }
          }
        } else {
          shift16(ra, cst + 3 * 64 + cq * 16, cst + 1 * 64 + cq * 16, v16);
#pragma unroll
          for (int q = 0; q < 4; ++q) *(f32x4*)(stepbuf + 2 * SV + j * 64 + cq * 16 + q * 4) = (f32x4){v16[q * 4], v16[q * 4 + 1], v16[q * 4 + 2], v16[q * 4 + 3]};
          shift16(rb, cst + 4 * 64 + cq * 16, cst + 8 * 64 + cq * 16, v16);
#pragma unroll
          for (int q = 0; q < 4; ++q) *(f32x4*)(stepbuf + 5 * SV + j * 64 + cq * 16 + q * 4) = (f32x4){v16[q * 4], v16[q * 4 + 1], v16[q * 4 + 2], v16[q * 4 + 3]};
        }
      }
      if (c > 0) {
        const int ip = (c - 1) * 32 + hn * 16 + fr, tp = d ? T - 1 - ip : ip;
        *(uint2*)(yout + (size_t)(r0seq + tp) * 512 + h * 64 + mt * 16 + fq * 4) = y_def;
        if (role == 2 && cq == 0) { const int is_ = (c - 1) * 32 + th * 16 + tl, tg = d ? T - 1 - is_ : is_; P_SBON[((size_t)(r0seq + tg) * 8 + h) * 2 + d] = sb_def; }
      }
      if (role < 3 && c + 1 < nch) {
        const int is2 = (c + 1) * 32 + th * 16 + tl;
        const int t2 = d ? T - 1 - is2 : is2;
        const int row2 = r0seq + t2;
        if (role == 2) load_raw16(ra, z, row2, t2, T, colA);
        if (role >= 1) load_raw16(rb, z, row2, t2, T, colB);
        if (role < 2) {
          const int is3 = (c + 1) * 32 + th * 16 + fr, t3 = d ? T - 1 - is3 : is3;
          const bf16_t* ap = P_ALORA + (unsigned)((r0seq + t3) * 256 + alo);
          ra.c0 = *(const uint4*)ap; ra.c1 = *(const uint4*)(ap + 32);
        }
      }
      lds_barrier();
      {
        const int k = lane, seg = wave;
        const float* sw = stepbuf + 0 * SV + k;
        const float P15 = sw[15 * 64];
        const float hiF = seg >= 4 ? P15 : 1.f;
        float P[5];
        P[0] = seg == 0 ? 1.f : sw[(4 * seg - 1) * 64] * (seg > 4 ? P15 : 1.f);
#pragma unroll
        for (int i = 0; i < 4; ++i) P[i + 1] = sw[(4 * seg + i) * 64] * hiF;
        const float PL = sw[31 * 64] * P15;
        if (role == 2) {
          const int j = th * 16 + tl;
          float bs = 0.f;
#pragma unroll
          for (int q = 0; q < 16; ++q) bs += stepbuf[2 * SV + j * 64 + cq * 16 + q] * stepbuf[1 * SV + j * 64 + cq * 16 + q] * cst[7 * 64 + cq * 16 + q];
          bs = quad_sum(bs);
          sb_def = bs;
        }
        f32x4 bb, kb, at, vv;
#pragma unroll
        for (int i = 0; i < 4; ++i) {
          const int t = 4 * seg + i;
          const float inv = __builtin_amdgcn_rcpf(P[i + 1]);
          const float a_ = P[i] * stepbuf[3 * SV + t * 64 + k];
          const float rraw = stepbuf[2 * SV + t * 64 + k], kraw = stepbuf[1 * SV + t * 64 + k];
          const float r_ = P[i + 1] * rraw;
          const float b_ = stepbuf[4 * SV + t * 64 + k] * inv;
          const float k_ = kraw * inv;

          At[t * 72 + k] = (bf16_t)(cvt_pk_bf16(a_, 0.f) & 0xffff);
          Rt[t * 72 + k] = (bf16_t)(cvt_pk_bf16(r_, 0.f) & 0xffff);
          Bt[t * 72 + k] = (bf16_t)(cvt_pk_bf16(b_, 0.f) & 0xffff);
          Kt[t * 72 + k] = (bf16_t)(cvt_pk_bf16(k_, 0.f) & 0xffff);
          bb[i] = b_ * PL; kb[i] = k_ * PL; at[i] = a_;
          vv[i] = stepbuf[5 * SV + t * 64 + k];
        }
        *(uint2*)(Bb + k * 40 + 4 * seg) = pack4(bb);
        *(uint2*)(Kb + k * 40 + 4 * seg) = pack4(kb);
        *(uint2*)(VT + k * 40 + 4 * seg) = pack4(vv);
        *(uint2*)(AtTb + k * 40 + 4 * seg) = pack4(at);
        if (seg == 0) PLs[k] = PL;
      }
      lds_barrier();
      {
        const int mat = wave >> 1, mts = wave & 1;
        const bf16_t* As = (mat & 1) ? Kt : Bt;
        const bf16_t* Bs = (mat & 2) ? Rt : At;
        f32x4 acc[2] = {};
#pragma unroll
        for (int ks = 0; ks < 2; ++ks) {
          const bf16x8 a = ldfrag(As, 72, mts * 16, ks * 32, fr, fq);
#pragma unroll
          for (int nt = 0; nt < 2; ++nt) acc[nt] = MFMA16(a, ldfrag(Bs, 72, nt * 16, ks * 32, fr, fq), acc[nt]);
        }
#pragma unroll
        for (int nt = 0; nt < 2; ++nt) {
          const int tcol = nt * 16 + fr;
          f32x4 v = acc[nt];
#pragma unroll
          for (int jj = 0; jj < 4; ++jj) {
            const int srow = mts * 16 + fq * 4 + jj;
            const bool keep = (mat & 2) ? (srow <= tcol) : (srow < tcol);
            v[jj] = keep ? v[jj] : 0.f;
          }
          if (mat == 0) {
#pragma unroll
            for (int jj = 0; jj < 4; ++jj) Nab[(mts * 16 + fq * 4 + jj) * 32 + tcol] = v[jj];
          } else {
            bf16_t* dst = mat == 1 ? NakT : mat == 2 ? NbrT : NkrT;
            *(uint2*)(dst + tcol * 40 + mts * 16 + fq * 4) = pack4(v);
          }
        }
      }
      lds_barrier();
      if (wave == 0) {
        const int irow = lane >> 1, hb = lane & 1, blk = lane >> 5, il = irow & 15;
        float x[8];
#pragma unroll
        for (int i = 0; i < 8; ++i) x[i] = (hb * 8 + i == il) ? 1.f : 0.f;
        const float* nb = Nab + (blk * 16) * 32 + blk * 16 + hb * 8;
        solve16<0>(x, nb);
#pragma unroll
        for (int i = 0; i < 8; ++i) TT[(blk * 16 + hb * 8 + i) * 40 + blk * 16 + il] = (bf16_t)(cvt_pk_bf16(x[i], 0.f) & 0xffff);
        if (blk == 0) *(uint4*)(T11b + il * 40 + hb * 8) = pack8(x);
        __builtin_amdgcn_wave_barrier();
        const f32x4 zero = {0.f, 0.f, 0.f, 0.f};
        bf16x8 zf;
#pragma unroll
        for (int i = 0; i < 8; ++i) zf[i] = 0;
        bf16x8 n12 = zf, t22 = zf, t11 = zf;
        if (fq < 2) {
          float o[8];
          const f32x4 n0 = *(const f32x4*)(Nab + fr * 32 + 16 + fq * 8), n1 = *(const f32x4*)(Nab + fr * 32 + 16 + fq * 8 + 4);
          o[0] = n0[0]; o[1] = n0[1]; o[2] = n0[2]; o[3] = n0[3]; o[4] = n1[0]; o[5] = n1[1]; o[6] = n1[2]; o[7] = n1[3];
          uint4 u = pack8(o);
          n12 = *reinterpret_cast<bf16x8*>(&u);
          t22 = *reinterpret_cast<const bf16x8*>(TT + (16 + fr) * 40 + 16 + fq * 8);
          t11 = *reinterpret_cast<const bf16x8*>(T11b + fr * 40 + fq * 8);
        }
        const f32x4 m1 = MFMA16(n12, t22, zero);
        *(uint2*)(M1T + fr * 40 + fq * 4) = pack4(m1);
        __builtin_amdgcn_wave_barrier();
        bf16x8 m1f = zf;
        if (fq < 2) m1f = *reinterpret_cast<const bf16x8*>(M1T + fr * 40 + fq * 8);
        const f32x4 t12 = MFMA16(t11, m1f, zero);
        *(uint2*)(TT + (16 + fr) * 40 + fq * 4) = pack4(t12);
      } else if (wave == 1) {
        unsigned z0;
        asm volatile("v_mov_b32 %0, 0" : "=v"(z0));
        *(uint2*)(TT + (lane >> 2) * 40 + 16 + (lane & 3) * 4) = make_uint2(z0, z0);
      } else if (wave < 6) {
        const int vtile = wave - 2;
        const bf16x8 vf = ldfrag(VT, 40, vtile * 16, 0, fr, fq);
        const f32x4 zero = {0.f, 0.f, 0.f, 0.f};
#pragma unroll
        for (int tt = 0; tt < 2; ++tt) {
          const f32x4 acc = MFMA16(ldfrag(NakT, 40, tt * 16, 0, fr, fq), vf, zero);
          *(uint2*)(VNb + (vtile * 16 + fr) * 40 + tt * 16 + fq * 4) = pack4(acc);
        }
      }
      lds_barrier();
      {
        const int tt = wave & 1, rt = wave >> 1;
        const f32x4 zero = {0.f, 0.f, 0.f, 0.f};
        const bf16x8 tf = ldfrag(TT, 40, tt * 16, 0, fr, fq);
        const f32x4 zacc = MFMA16(tf, ldfrag(VNb, 40, rt * 16, 0, fr, fq), zero);
        const f32x4 wacc = MFMA16(tf, ldfrag(AtTb, 40, rt * 16, 0, fr, fq), zero);
        *(uint2*)(Zb + (rt * 16 + fr) * 40 + tt * 16 + fq * 4) = pack4(zacc);
        *(uint2*)(Wb + (rt * 16 + fr) * 40 + tt * 16 + fq * 4) = pack4(wacc);
      }
      lds_barrier();
      f32x4 yacc = {0.f, 0.f, 0.f, 0.f};
      {
        const float pl0 = PLs[nt0 * 16 + fr], pl1 = PLs[nt1 * 16 + fr];
        Sa = Sa * pl0; Sb = Sb * pl1;
        const bf16x8 zf = ldfrag(Zb, 40, mt * 16, 0, fr, fq), vf = ldfrag(VT, 40, mt * 16, 0, fr, fq), wf = ldfrag(Wb, 40, mt * 16, 0, fr, fq);
        const bf16x8 bb0 = ldfrag(Bb, 40, nt0 * 16, 0, fr, fq), bb1 = ldfrag(Bb, 40, nt1 * 16, 0, fr, fq);
        const bf16x8 kb0 = ldfrag(Kb, 40, nt0 * 16, 0, fr, fq), kb1 = ldfrag(Kb, 40, nt1 * 16, 0, fr, fq);
        const bf16x8 nbr = ldfrag(NbrT, 40, hn * 16, 0, fr, fq), nkr = ldfrag(NkrT, 40, hn * 16, 0, fr, fq);
        Sa = MFMA16(zf, bb0, Sa); Sa = MFMA16(vf, kb0, Sa);
        Sb = MFMA16(zf, bb1, Sb); Sb = MFMA16(vf, kb1, Sb);
        yacc = MFMA16(zf, nbr, yacc); yacc = MFMA16(vf, nkr, yacc);
        const f32x4 zero = {0.f, 0.f, 0.f, 0.f};
        const f32x4 g0 = MFMA16(wf, bb0, zero), g1 = MFMA16(wf, bb1, zero);
        f32x4 ry = MFMA16(wf, nbr, zero);
        *(uint2*)(GT + (nt0 * 16 + fr) * 72 + mt * 16 + fq * 4) = pack4(g0);
        *(uint2*)(GT + (nt1 * 16 + fr) * 72 + mt * 16 + fq * 4) = pack4(g1);
        const uint2 rr = *(const uint2*)(Rt + (hn * 16 + fr) * 72 + mt * 16 + fq * 4);
        ry[0] += bf_lo(rr.x); ry[1] += bf_hi(rr.x); ry[2] += bf_lo(rr.y); ry[3] += bf_hi(rr.y);
        *(uint2*)(RyT + (hn * 16 + fr) * 72 + mt * 16 + fq * 4) = pack4(ry);
      }
      lds_barrier();
      {
        const bf16_t* Scur = Sbf + (c & 1) * 64 * 72;
        bf16_t* Snext = Sbf + ((c + 1) & 1) * 64 * 72;
#pragma unroll
        for (int ks = 0; ks < 2; ++ks) {
          const bf16x8 af = ldfrag(Scur, 72, mt * 16, ks * 32, fr, fq);
          Sa = MFMA16(af, ldfrag(GT, 72, nt0 * 16, ks * 32, fr, fq), Sa);
          Sb = MFMA16(af, ldfrag(GT, 72, nt1 * 16, ks * 32, fr, fq), Sb);
          yacc = MFMA16(af, ldfrag(RyT, 72, hn * 16, ks * 32, fr, fq), yacc);
        }
        y_def = pack4(yacc);
#pragma unroll
        for (int jj = 0; jj < 4; ++jj) {
          Snext[(mt * 16 + fq * 4 + jj) * 72 + nt0 * 16 + fr] = (bf16_t)(cvt_pk_bf16(Sa[jj], 0.f) & 0xffff);
          Snext[(mt * 16 + fq * 4 + jj) * 72 + nt1 * 16 + fr] = (bf16_t)(cvt_pk_bf16(Sb[jj], 0.f) & 0xffff);
        }
      }
      lds_barrier();
    }
    {
      const int ip = (nch - 1) * 32 + hn * 16 + fr, tp = d ? T - 1 - ip : ip;
      *(uint2*)(yout + (size_t)(r0seq + tp) * 512 + h * 64 + mt * 16 + fq * 4) = y_def;
      if (role == 2 && cq == 0) { const int is_ = (nch - 1) * 32 + th * 16 + tl, tg = d ? T - 1 - is_ : is_; P_SBON[((size_t)(r0seq + tg) * 8 + h) * 2 + d] = sb_def; }
    }
  }
  if (item >= 128) {
    const int nb = gridDim.x - 128;
    for (int tile = item - 128; tile < NTOK / 32; tile += nb) pool_tile(z, P_RH, tile, tid);
  }
}

__device__ __forceinline__ void post_phase(PREF p, char* smem, const int wid_u) {
  bf16_t* Ag = (bf16_t*)smem;
  bf16_t* vt = (bf16_t*)(smem + 12800);
  float* ys = (float*)(smem + 12800 + 33280);
  const bf16_t* z = P_RU;
  const bf16_t* yf = P_RY;
  const bf16_t* ybk = P_RY + (size_t)NTOK * 512;
  bf16_t* mo = P_RH;
  const int tid = opaque_tid(), w = tid >> 6, lane = tid & 63, fr = lane & 15, fq = lane >> 4;
  bf16x8 Bg[4][6];
#pragma unroll
  for (int nt = 0; nt < 4; ++nt)
#pragma unroll
    for (int ks = 0; ks < 6; ++ks) {
      float o[8];
#pragma unroll
      for (int q = 0; q < 8; ++q) { const int k = ks * 32 + fq * 8 + q; o[q] = k < 160 ? p.g2[(size_t)k * 512 + w * 64 + nt * 16 + fr] : 0.f; }
      uint4 u = pack8(o);
      Bg[nt][ks] = *reinterpret_cast<bf16x8*>(&u);
    }
  float lng[4], lnb[4];
#pragma unroll
  for (int nt = 0; nt < 4; ++nt) { lng[nt] = p.lnx_g[w * 64 + nt * 16 + fr]; lnb[nt] = p.lnx_b[w * 64 + nt * 16 + fr]; }

  for (int tile = blockIdx.x; tile < NTOK / 32; tile += gridDim.x) {
    const int row0 = tile * 32;
    int s, t0, T;
    row_seq(row0, s, t0, T);
    for (int idx = tid; idx < 32 * 24; idx += NTHR) {
      const int tok = idx / 24, oc = idx % 24;
      float o[8];
      if (oc < 20) {
        load_shift8(z, row0 + tok, t0 + tok, T, 2304 + oc * 8, p.shift_mu, o);
#pragma unroll
        for (int q = 0; q < 8; ++q) o[q] = sigmoidf_(o[q]);
      } else {
#pragma unroll
        for (int q = 0; q < 8; ++q) o[q] = 0.f;
      }
      *(uint4*)(Ag + tok * 200 + oc * 8) = pack8(o);
    }
    for (int idx = tid; idx < 32 * 64; idx += NTHR) {
      const int tok = idx >> 6, oc = idx & 63, row = row0 + tok, t = t0 + tok;
      float o[8];
      load_shift8(z, row, t, T, 1536 + oc * 8, p.shift_mu, o);
      *(uint4*)(vt + tok * 520 + oc * 8) = pack8(o);
      float a[8], b[8];
      unpack8(*(const uint4*)(yf + (size_t)row * 512 + oc * 8), a);
      unpack8(*(const uint4*)(ybk + (size_t)row * 512 + oc * 8), b);
      *(f32x4*)(ys + tok * 516 + oc * 8) = (f32x4){a[0] + b[0], a[1] + b[1], a[2] + b[2], a[3] + b[3]};
      *(f32x4*)(ys + tok * 516 + oc * 8 + 4) = (f32x4){a[4] + b[4], a[5] + b[5], a[6] + b[6], a[7] + b[7]};
    }
    __syncthreads();
    f32x4 acc[2][4] = {};
#pragma unroll
    for (int ks = 0; ks < 6; ++ks) {
      bf16x8 a[2];
#pragma unroll
      for (int mt = 0; mt < 2; ++mt) a[mt] = *reinterpret_cast<const bf16x8*>(Ag + (mt * 16 + fr) * 200 + ks * 32 + fq * 8);
#pragma unroll
      for (int mt = 0; mt < 2; ++mt)
#pragma unroll
        for (int nt = 0; nt < 4; ++nt) acc[mt][nt] = __builtin_amdgcn_mfma_f32_16x16x32_bf16(a[mt], Bg[nt][ks], acc[mt][nt], 0, 0, 0);
    }
#pragma unroll
    for (int mt = 0; mt < 2; ++mt)
#pragma unroll
      for (int jj = 0; jj < 4; ++jj) {
        const int tok = mt * 16 + fq * 4 + jj, row = row0 + tok;
        float yv[4], sm_ = 0.f;
#pragma unroll
        for (int nt = 0; nt < 4; ++nt) { yv[nt] = ys[tok * 516 + w * 64 + nt * 16 + fr]; sm_ += yv[nt]; }
        const float mean = row16_sum(sm_) * (1.f / 64.f);
        float vs = 0.f;
#pragma unroll
        for (int nt = 0; nt < 4; ++nt) { yv[nt] -= mean; vs += yv[nt] * yv[nt]; }
        const float rs = rsqrtf(row16_sum(vs) * (1.f / 64.f) + 64e-5f);
        const float2 sb2 = *(const float2*)(P_SBON + ((size_t)row * 8 + w) * 2);
        const float sbs = sb2.x + sb2.y;
#pragma unroll
        for (int nt = 0; nt < 4; ++nt) {
          const float vv = bf2f(vt[tok * 520 + w * 64 + nt * 16 + fr]);
          const float o = (yv[nt] * rs * lng[nt] + lnb[nt] + sbs * vv) * acc[mt][nt][jj];
          mo[(size_t)row * D + 512 + w * 64 + nt * 16 + fr] = (bf16_t)(cvt_pk_bf16(o, 0.f) & 0xffff);
        }
      }
    __syncthreads();
  }
}

constexpr int NPHASE = 14;
__device__ __forceinline__ void do_phase(PREF p, int ph, char* smem, const int wid_u) {
  if (ph == 0) prep_phase(p, smem, wid_u);
  else if (ph == 1) row_phase<0>(p.x_prompt, p.x_sample, nullptr, nullptr, P_RH, P_MOD, nullptr, p.n1_pre, 0, 0.f, 0, wid_u);
  else if (ph == 4 || ph == 10) {
    const bool f = ph == 4;
    float* outp = p.out;
    row_phase<1>(sel(f, p.x_prompt, (const float*)outp), sel(f, p.x_sample, (const float*)(outp + (size_t)NPROMPT * D)), outp, P_RY, P_RH, P_MOD,
                 sel(f, p.n1_post, p.nm_post), sel(f, p.nm_pre, p.n2_pre), f ? 2 : 5, f ? 0.5f : 1.0f, f ? 3 : 6, wid_u);
  }
  else if (ph == 13) row_phase<2>(p.out, p.out + (size_t)NPROMPT * D, p.out, P_RY, nullptr, P_MOD, p.n2_post, nullptr, 8, 0.5f, 0, wid_u);
  else if (ph == 6) lora_prep_phase(p, wid_u);
  else if (ph == 7) scan_phase(p, smem, wid_u);
  else if (ph == 8) post_phase(p, smem, wid_u);
  else {
    const bf16_t *A, *Bt; bf16_t* C; int N, K, ldc, epi;
    if (ph == 2 || ph == 11) { A = P_RH; Bt = sel(ph == 2, P_W13A, P_W13B); C = P_RU; N = 2 * FF; K = D; ldc = FF; epi = 1; }
    else if (ph == 3 || ph == 12) { A = P_RU; Bt = sel(ph == 3, P_W2A, P_W2B); C = P_RY; N = D; K = FF; ldc = D; epi = 0; }
    else if (ph == 5) { A = P_RH; Bt = P_WINT; C = P_RU; N = ZLD; K = D; ldc = ZLD; epi = 0; }
    else { A = P_RH; Bt = P_WOUTT; C = P_RY; N = D; K = D; ldc = D; epi = 0; }
    gemm_phase(A, Bt, C, NTOK, N, K, ldc, epi, smem, wid_u);
  }
}

extern __shared__ __attribute__((aligned(16))) char dyn_smem[];

__global__ void __launch_bounds__(NTHR, 2) mega_kernel(Params p) {
  cg::grid_group grid = cg::this_grid();
  const int wid_u = __builtin_amdgcn_readfirstlane(threadIdx.x >> 6);
  typedef const __attribute__((address_space(4))) Params* KP;
  const KP kp0 = (KP)__builtin_amdgcn_kernarg_segment_ptr();
#pragma unroll 1
  for (int ph = 0; ph < NPHASE; ++ph) {
    KP kp = kp0;
    asm volatile("" : "+s"(kp));
    do_phase(*kp, ph, dyn_smem, wid_u);
#ifdef PROBE_REPEAT
    if (ph == PROBE_REPEAT) { grid.sync(); do_phase(*kp, ph, dyn_smem, wid_u); }
#endif
    if (ph + 1 < NPHASE) grid.sync();
  }
}

__global__ void __launch_bounds__(NTHR, 2) phase_kernel(Params p, int ph) {
  const int wid_u = __builtin_amdgcn_readfirstlane(threadIdx.x >> 6);
  do_phase(*(const __attribute__((address_space(4))) Params*)__builtin_amdgcn_kernarg_segment_ptr(), ph, dyn_smem, wid_u);
}

extern "C" void kernel_launch(void* const* d_in, const int* in_sizes, int n_in, void* d_out, int out_size, void* d_ws, size_t ws_size,
                              hipStream_t stream) {
  Params p{};
  const float** f = (const float**)&p;
  for (int i = 0; i < 33; ++i) f[i] = (const float*)d_in[i];
  p.out = (float*)d_out;
  p.ws = (char*)d_ws;
  if (WS_NEED > ws_size) { fprintf(stderr, "workspace too small: need %zu have %zu\n", (size_t)WS_NEED, ws_size); return; }

#if ONE_LAUNCH
  static int grid_blocks = 0;
  if (!grid_blocks) {
    int dev = 0, cus = 0, per_cu = 0;
    (void)hipGetDevice(&dev);
    (void)hipDeviceGetAttribute(&cus, hipDeviceAttributeMultiprocessorCount, dev);
    (void)hipFuncSetAttribute((const void*)mega_kernel, hipFuncAttributeMaxDynamicSharedMemorySize, SMEM_BYTES);
    (void)hipOccupancyMaxActiveBlocksPerMultiprocessor(&per_cu, mega_kernel, NTHR, SMEM_BYTES);
    if (per_cu < 1) per_cu = 1;
    grid_blocks = cus * per_cu;
  }
  void* args[] = {&p};
  hipError_t e = hipLaunchCooperativeKernel((const void*)mega_kernel, dim3(grid_blocks), dim3(NTHR), args, SMEM_BYTES, stream);
  if (e != hipSuccess) fprintf(stderr, "cooperative launch failed: %s (grid %d)\n", hipGetErrorString(e), grid_blocks);
#else
  static bool attr = false;
  if (!attr) { (void)hipFuncSetAttribute((const void*)phase_kernel, hipFuncAttributeMaxDynamicSharedMemorySize, SMEM_BYTES); attr = true; }
  for (int ph = 0; ph < NPHASE; ++ph) phase_kernel<<<256, NTHR, SMEM_BYTES, stream>>>(p, ph);
#endif
}
```

```cpp
#include <hip/hip_runtime.h>
#include <hip/hip_cooperative_groups.h>
#include <cstdio>
namespace cg = cooperative_groups;

#ifndef ONE_LAUNCH
#define ONE_LAUNCH 1
#endif

typedef unsigned short bf16_t;
typedef short bf16x8 __attribute__((ext_vector_type(8)));
typedef float f32x4 __attribute__((ext_vector_type(4)));
typedef float f32x2 __attribute__((ext_vector_type(2)));
#define LAS __attribute__((address_space(3)))

constexpr int D = 1024, FF = 2816, NTOK = 98304, NPROMPT = 32768, ZLD = 2560, PINW = 2464;
constexpr int NTHR = 512;
constexpr int SMEM_BYTES = 162304;

struct Params {
  const float *x_prompt, *x_sample, *c_prompt, *c_sample, *ada_w, *ada_b, *n1_pre, *n1_post, *f1_w1, *f1_w3, *f1_w2,
      *nm_pre, *nm_post, *w_in, *shift_mu, *pool_w, *pool_scale, *w0, *w2, *a0, *a2, *g2, *k_k, *k_a, *r_k, *lnx_g, *lnx_b,
      *w_out, *n2_pre, *n2_post, *f2_w1, *f2_w3, *f2_w2;
  float* out;
  char* ws;
};
#define PREF const __attribute__((address_space(4))) Params&
constexpr size_t al256(size_t b) { return (b + 255) & ~(size_t)255; }
constexpr size_t OFF_W13A = 0;
constexpr size_t OFF_W13B = OFF_W13A + al256((size_t)2 * FF * D * 2);
constexpr size_t OFF_W2A = OFF_W13B + al256((size_t)2 * FF * D * 2);
constexpr size_t OFF_W2B = OFF_W2A + al256((size_t)D * FF * 2);
constexpr size_t OFF_WINT = OFF_W2B + al256((size_t)D * FF * 2);
constexpr size_t OFF_WOUTT = OFF_WINT + al256((size_t)ZLD * D * 2);
constexpr size_t OFF_MOD = OFF_WOUTT + al256((size_t)D * D * 2);
constexpr size_t OFF_SBON = OFF_MOD + al256((size_t)16 * 9216 * 4);
constexpr size_t OFF_RH = OFF_SBON + al256((size_t)NTOK * 16 * 4);
constexpr size_t OFF_RY = OFF_RH + al256((size_t)NTOK * D * 2);
constexpr size_t OFF_RU = OFF_RY + al256((size_t)NTOK * D * 2);
constexpr size_t OFF_ALORA = OFF_RU + al256((size_t)NTOK * FF * 2);
constexpr size_t WS_NEED = OFF_ALORA + al256((size_t)NTOK * 256 * 2);
#define P_W13A ((bf16_t*)(p.ws + OFF_W13A))
#define P_W13B ((bf16_t*)(p.ws + OFF_W13B))
#define P_W2A ((bf16_t*)(p.ws + OFF_W2A))
#define P_W2B ((bf16_t*)(p.ws + OFF_W2B))
#define P_WINT ((bf16_t*)(p.ws + OFF_WINT))
#define P_WOUTT ((bf16_t*)(p.ws + OFF_WOUTT))
#define P_MOD ((float*)(p.ws + OFF_MOD))
#define P_SBON ((float*)(p.ws + OFF_SBON))
#define P_RH ((bf16_t*)(p.ws + OFF_RH))
#define P_RY ((bf16_t*)(p.ws + OFF_RY))
#define P_RU ((bf16_t*)(p.ws + OFF_RU))
#define P_ALORA ((bf16_t*)(p.ws + OFF_ALORA))

typedef __bf16 bf16x2_t __attribute__((ext_vector_type(2)));
__device__ __forceinline__ unsigned cvt_pk_bf16(float lo, float hi) {
  f32x2 v = {lo, hi};
  bf16x2_t b = __builtin_convertvector(v, bf16x2_t);
  return __builtin_bit_cast(unsigned, b);
}
__device__ __forceinline__ float bf_lo(unsigned u) { return __uint_as_float(u << 16); }
__device__ __forceinline__ float bf_hi(unsigned u) { return __uint_as_float(u & 0xffff0000u); }
__device__ __forceinline__ float bf2f(bf16_t b) { return __uint_as_float(((unsigned)b) << 16); }
__device__ __forceinline__ void unpack8(uint4 v, float* o) {
  o[0] = bf_lo(v.x); o[1] = bf_hi(v.x); o[2] = bf_lo(v.y); o[3] = bf_hi(v.y);
  o[4] = bf_lo(v.z); o[5] = bf_hi(v.z); o[6] = bf_lo(v.w); o[7] = bf_hi(v.w);
}
__device__ __forceinline__ uint4 pack8(const float* o) {
  uint4 v; v.x = cvt_pk_bf16(o[0], o[1]); v.y = cvt_pk_bf16(o[2], o[3]); v.z = cvt_pk_bf16(o[4], o[5]); v.w = cvt_pk_bf16(o[6], o[7]);
  return v;
}
__device__ __forceinline__ float sigmoidf_(float x) { return __builtin_amdgcn_rcpf(1.f + __expf(-x)); }
template <int CTRL> __device__ __forceinline__ float dpp_f(float x) {
  return __int_as_float(__builtin_amdgcn_update_dpp(0, __float_as_int(x), CTRL, 0xf, 0xf, false));
}
__device__ __forceinline__ float row16_sum(float x) {
  x += dpp_f<0x128>(x); x += dpp_f<0x124>(x); x += dpp_f<0x122>(x); x += dpp_f<0x121>(x);
  return x;
}
template <class T> __device__ __forceinline__ T sel(bool c, T a, T b) { return c ? a : b; }
__device__ __forceinline__ int opaque_tid_w(int wid) {
  int l;
  asm volatile("v_mbcnt_lo_u32_b32 %0, -1, 0\n\tv_mbcnt_hi_u32_b32 %0, -1, %0" : "=v"(l));
  return wid * 64 + l;
}
#define opaque_tid() opaque_tid_w(wid_u)
__device__ __forceinline__ float wave_sum(float v) {
  v = row16_sum(v);
  const float a = __int_as_float(__builtin_amdgcn_readlane(__float_as_int(v), 0)), b = __int_as_float(__builtin_amdgcn_readlane(__float_as_int(v), 16));
  const float c = __int_as_float(__builtin_amdgcn_readlane(__float_as_int(v), 32)), d = __int_as_float(__builtin_amdgcn_readlane(__float_as_int(v), 48));
  return (a + b) + (c + d);
}
__device__ __forceinline__ float quad_sum(float x) { x += dpp_f<0xB1>(x); x += dpp_f<0x4E>(x); return x; }
__device__ __forceinline__ int seq_start(int s) { return s < 8 ? s * 4096 : NPROMPT + (s - 8) * 8192; }
__device__ __forceinline__ void row_seq(int row, int& s, int& t, int& T) {
  if (row < NPROMPT) { s = row >> 12; t = row & 4095; T = 4096; }
  else { int r = row - NPROMPT; s = 8 + (r >> 13); t = r & 8191; T = 8192; }
}

__device__ __forceinline__ void tr_tile(const float* __restrict__ src, int ldsrc, int k0, int n0, int nvalid, bf16_t* __restrict__ dst, int ldd,
                        int kdst0, int mode, float* sm, const int tid) {
#pragma unroll
  for (int i = 0; i < 2; ++i) {
    const int r = (tid >> 4) + 32 * i, c = (tid & 15) * 4;
    float4 v = make_float4(0.f, 0.f, 0.f, 0.f);
    if (n0 + c < nvalid) v = *(const float4*)(src + (size_t)(k0 + r) * ldsrc + n0 + c);
    float* d = sm + r * 65 + c;
    d[0] = v.x; d[1] = v.y; d[2] = v.z; d[3] = v.w;
  }
  __syncthreads();
  {
    const int n = tid >> 3, kc = (tid & 7) * 8;
    float o[8];
#pragma unroll
    for (int j = 0; j < 8; ++j) o[j] = sm[(kc + j) * 65 + n];
    int nn = n0 + n, drow;
    const int c32 = nn & 31, slot = 16 * ((c32 >> 2) & 1) + 4 * (c32 >> 3) + (c32 & 3);
    if (mode == 0) drow = (nn & ~31) + slot;
    else drow = 256 * (nn >> 7) + (mode == 2 ? 128 : 0) + ((nn & 127) & ~31) + slot;
    *(uint4*)(dst + (size_t)drow * ldd + kdst0 + k0 + kc) = pack8(o);
  }
  __syncthreads();
}

__device__ __forceinline__ void prep_phase(PREF p, char* smem, const int wid_u) {
  float* sm = (float*)smem;
  const int tid = opaque_tid();
  constexpr int N_MOD = 144, N_EFF = 128, N_W13 = 4 * 704, N_W2 = 2 * 704, N_WIN = 640, N_WOUT = 128;
  constexpr int TOTAL = N_MOD + N_EFF + N_W13 + N_W2 + N_WIN + N_WOUT;
  for (int item = blockIdx.x; item < TOTAL; item += gridDim.x) {
    int it = item;
    if (it < N_MOD) {
      const int j0 = it * 64;
      float* sc = sm;
      float* red = sm + 16384;
      for (int idx = tid; idx < 16384; idx += NTHR) {
        const int s = idx >> 10, k = idx & 1023;
        const float* cp_ = p.c_prompt; const float* cs_ = p.c_sample;
        const float c = s < 8 ? cp_[s * 1024 + k] : cs_[(s - 8) * 1024 + k];
        sc[idx] = c / (1.f + __expf(-c));
      }
      __syncthreads();
      const int col = tid & 63, kg = tid >> 6;
      float acc[16];
#pragma unroll
      for (int s = 0; s < 16; ++s) acc[s] = 0.f;
      for (int k = kg * 128; k < kg * 128 + 128; ++k) {
        const float w = p.ada_w[(size_t)k * 9216 + j0 + col];
#pragma unroll
        for (int s = 0; s < 16; ++s) acc[s] += sc[s * 1024 + k] * w;
      }
#pragma unroll
      for (int s = 0; s < 16; ++s) red[(kg * 16 + s) * 64 + col] = acc[s];
      __syncthreads();
      for (int o = tid; o < 1024; o += NTHR) {
        const int s = o >> 6, c2 = o & 63;
        float v = p.ada_b[j0 + c2];
#pragma unroll
        for (int g = 0; g < 8; ++g) v += red[(g * 16 + s) * 64 + c2];
        P_MOD[s * 9216 + j0 + c2] = v;
      }
      __syncthreads();
      continue;
    }
    it -= N_MOD;
    if (it < N_EFF) {
      const int g = it >> 5, itile = (it >> 4) & 1, ntile = it & 15;
      float* As = sm;
      float* Bs = sm + 64 * 129;
      for (int idx = tid; idx < 64 * 128; idx += NTHR) {
        const int i = idx >> 7, j = idx & 127;
        As[i * 129 + j] = p.pool_w[((size_t)g * 128 + itile * 64 + i) * 128 + j] * p.pool_scale[g * 128 + j];
      }
      for (int idx = tid; idx < 128 * 64; idx += NTHR) {
        const int j = idx >> 6, nn = idx & 63;
        Bs[j * 65 + nn] = p.w_out[(size_t)(g * 128 + j) * 1024 + ntile * 64 + nn];
      }
      __syncthreads();
      const int i = tid >> 3, nn0 = (tid & 7) * 8;
      float acc[8];
#pragma unroll
      for (int q = 0; q < 8; ++q) acc[q] = 0.f;
      for (int j = 0; j < 128; ++j) {
        const float a = As[i * 129 + j];
#pragma unroll
        for (int q = 0; q < 8; ++q) acc[q] += a * Bs[j * 65 + nn0 + q];
      }
#pragma unroll
      for (int q = 0; q < 8; ++q)
      {
        const int nn = ntile * 64 + nn0 + q, c32 = nn & 31, slot = 16 * ((c32 >> 2) & 1) + 4 * (c32 >> 3) + (c32 & 3);
        P_WOUTT[(size_t)((nn & ~31) + slot) * 1024 + g * 128 + itile * 64 + i] = (bf16_t)(cvt_pk_bf16(acc[q], 0.f) & 0xffff);
      }
      __syncthreads();
      continue;
    }
    it -= N_EFF;
    if (it < N_W13) {
      const int which = it / 704, r = it % 704;
      const int kt = r / 44, ntl = r % 44;
      const float* src = sel(which < 2, sel(which == 0, p.f1_w1, p.f1_w3), sel(which == 2, p.f2_w1, p.f2_w3));
      bf16_t* dst = sel(which < 2, P_W13A, P_W13B);
      tr_tile(src, FF, kt * 64, ntl * 64, FF, dst, D, 0, (which & 1) ? 2 : 1, sm, tid);
      continue;
    }
    it -= N_W13;
    if (it < N_W2) {
      const int which = it / 704, r = it % 704;
      const int kt = r / 16, ntl = r % 16;
      tr_tile(sel(which != 0, p.f2_w2, p.f1_w2), D, kt * 64, ntl * 64, D, sel(which != 0, P_W2B, P_W2A), FF, 0, 0, sm, tid);
      continue;
    }
    it -= N_W2;
    if (it < N_WIN) {
      const int kt = it / 40, ntl = it % 40;
      tr_tile(p.w_in, PINW, kt * 64, ntl * 64, PINW, P_WINT, D, 0, 0, sm, tid);
      continue;
    }
    it -= N_WIN;
    {
      const int kt = it / 16, ntl = it % 16;
      tr_tile(p.w_out + (size_t)512 * 1024, D, kt * 64, ntl * 64, D, P_WOUTT, D, 512, 0, sm, tid);
    }
  }
}

template <int MODE>
__device__ __forceinline__ void row_phase(const float* __restrict__ xp, const float* __restrict__ xs, float* __restrict__ xout,
                          const bf16_t* __restrict__ y, bf16_t* __restrict__ h, const float* __restrict__ mod,
                          const float* __restrict__ npost, const float* __restrict__ npre, int gate_idx, float cgate, int shift_idx, const int wid_u) {
  const int tid_ = opaque_tid();
  const int lane = tid_ & 63;
  const int gw = blockIdx.x * 8 + (tid_ >> 6), GW = gridDim.x * 8;
  for (int chunk = gw; chunk < NTOK / 16; chunk += GW) {
    const int row0 = chunk * 16;
    int s, t, T;
    row_seq(row0, s, t, T);
    const float* md = mod + s * 9216;
    f32x4 Am[4], Bm[4], Gm[4];
#pragma unroll
    for (int i = 0; i < 4; ++i) {
      const int c = i * 256 + lane * 4;
      if (MODE != 2) {
        f32x4 np = *(const f32x4*)(npre + c), sc = *(const f32x4*)(md + (shift_idx + 1) * 1024 + c);
        Am[i] = np * (sc + 1.f);
        Bm[i] = *(const f32x4*)(md + shift_idx * 1024 + c);
      }
      if (MODE != 0) {
        f32x4 g = *(const f32x4*)(md + gate_idx * 1024 + c), po = *(const f32x4*)(npost + c);
        Gm[i] = g * po * cgate;
      }
    }
    for (int r = 0; r < 16; ++r) {
      const int row = row0 + r;
      const float* xr = (row < NPROMPT) ? xp + (size_t)row * D : xs + (size_t)(row - NPROMPT) * D;
      f32x4 xv[4];
#pragma unroll
      for (int i = 0; i < 4; ++i) xv[i] = *(const f32x4*)(xr + i * 256 + lane * 4);
      if (MODE != 0) {
        f32x4 yv[4];
        float ss = 0.f;
#pragma unroll
        for (int i = 0; i < 4; ++i) {
          uint2 u = *(const uint2*)(y + (size_t)row * D + i * 256 + lane * 4);
          yv[i] = (f32x4){bf_lo(u.x), bf_hi(u.x), bf_lo(u.y), bf_hi(u.y)};
          ss += yv[i][0] * yv[i][0] + yv[i][1] * yv[i][1] + yv[i][2] * yv[i][2] + yv[i][3] * yv[i][3];
        }
        ss = wave_sum(ss);
        const float rs = rsqrtf(ss * (1.f / 1024.f) + 1e-6f);
#pragma unroll
        for (int i = 0; i < 4; ++i) {
          xv[i] = xv[i] + Gm[i] * yv[i] * rs;
          *(f32x4*)(xout + (size_t)row * D + i * 256 + lane * 4) = xv[i];
        }
      }
      if (MODE != 2) {
        float ss = 0.f;
#pragma unroll
        for (int i = 0; i < 4; ++i) ss += xv[i][0] * xv[i][0] + xv[i][1] * xv[i][1] + xv[i][2] * xv[i][2] + xv[i][3] * xv[i][3];
        ss = wave_sum(ss);
        const float rs = rsqrtf(ss * (1.f / 1024.f) + 1e-6f);
#pragma unroll
        for (int i = 0; i < 4; ++i) {
          f32x4 hv = xv[i] * rs * Am[i] + Bm[i];
          uint2 u; u.x = cvt_pk_bf16(hv[0], hv[1]); u.y = cvt_pk_bf16(hv[2], hv[3]);
          *(uint2*)(h + (size_t)row * D + i * 256 + lane * 4) = u;
        }
      }
    }
  }
}

constexpr int BM = 256, BK = 64, HALF = 128, NXCD = 8, WGM = 8, HT = HALF * BK;
__device__ __forceinline__ int lds_byte(int r, int c) {
  int st = (r >> 4) * 2 + (c >> 5), rr = r & 15, cc = c & 31, ob = rr * 64 + cc * 2;
  return st * 1024 + (ob ^ (((ob >> 9) & 1) << 5));
}
__device__ __forceinline__ void stage_rc(int b, int& R, int& C) {
  int st = b / 1024, sb = b % 1024, swz = sb ^ (((sb >> 9) & 1) << 5);
  R = (st >> 1) * 16 + swz / 64; C = (st & 1) * 32 + (swz % 64) / 2;
}

__device__ __forceinline__ bool gemm_unit(int i, int nM, int nN, int nwg, int& pm, int& pn) {
  const long L = (long)i * gridDim.x + blockIdx.x;
  if (L >= nwg) return false;
  int wgid = (int)L;
  { int q = nwg / NXCD, r = nwg % NXCD, xcd = wgid % NXCD, off = wgid / NXCD;
    wgid = (xcd < r ? xcd * (q + 1) : r * (q + 1) + (xcd - r) * q) + off; }
  const int nig = WGM * nN, gid = wgid / nig, fm = gid * WGM, gsz = min(nM - fm, WGM);
  pm = fm + ((wgid % nig) % gsz); pn = (wgid % nig) / gsz;
  return true;
}

__device__ __forceinline__ void gemm_phase(const bf16_t* __restrict__ A, const bf16_t* __restrict__ Bt, bf16_t* __restrict__ C, int M, int N, int K,
                                           int ldc, const int EPI, char* smem, const int wid_u) {
  const int nM = M / BM, nN = N / BM, nwg = nM * nN;
  const int tid = opaque_tid();
  LAS bf16_t* shm = (LAS bf16_t*)smem;
#define SA(b, h) (shm + ((b) * 2 + (h)) * HT)
#define SB(b, h) (shm + (4 + (b) * 2 + (h)) * HT)
#define STG(P, GB) do { const char* _gb = (GB); \
    _Pragma("unroll") for (int _i = 0; _i < 2; ++_i) { \
      __builtin_amdgcn_global_load_lds((const unsigned*)(_gb + voff[_i]), \
        (LAS unsigned*)((LAS char*)(P) + ldsw + _i * 8192), 16, 0, 0); } } while (0)
#define LDA(dst, b, h) _Pragma("unroll") for (int m = 0; m < 4; ++m) _Pragma("unroll") for (int k = 0; k < 2; ++k) \
    dst[m][k] = *(const LAS bf16x8*)((LAS char*)SA(b, h) + aoff + m * 2048 + k * 1024)
#define LDB(dst, b, h) _Pragma("unroll") for (int n = 0; n < 2; ++n) _Pragma("unroll") for (int k = 0; k < 2; ++k) \
    dst[n][k] = *(const LAS bf16x8*)((LAS char*)SB(b, h) + boff + n * 2048 + k * 1024)
#define MMA(ai, bj, At_, Bt_) do { __builtin_amdgcn_s_setprio(1); \
    _Pragma("unroll") for (int m = 0; m < 4; ++m) _Pragma("unroll") for (int n = 0; n < 2; ++n) _Pragma("unroll") for (int k = 0; k < 2; ++k) \
      acc[ai][bj][m][n] = __builtin_amdgcn_mfma_f32_16x16x32_bf16(Bt_[n][k], At_[m][k], acc[ai][bj][m][n], 0, 0, 0); \
    __builtin_amdgcn_s_setprio(0); } while (0)
#define WAIT_V(n) asm volatile("s_waitcnt vmcnt(" #n ")" ::: "memory")
#define WAIT_L(n) asm volatile("s_waitcnt lgkmcnt(" #n ")" ::: "memory")
#define BAR __builtin_amdgcn_s_barrier()
#define SCHED __builtin_amdgcn_sched_barrier(0)
  const int wid = __builtin_amdgcn_readfirstlane(tid >> 6), lane = tid & 63, wr = wid >> 2, wc = wid & 3, fr = lane & 15, fq = lane >> 4;
  const int aoff = lds_byte(wr * 64 + fr, fq * 8), boff = lds_byte(wc * 32 + fr, fq * 8);
  unsigned voff[2];
  const int ldsw = wid * 1024;
#pragma unroll
  for (int _i = 0; _i < 2; ++_i) { int _r, _c; stage_rc(tid * 16 + _i * 8192, _r, _c); voff[_i] = (unsigned)(_r * K + _c) * 2u; }
  const int nt = K / BK;
  const size_t kstep = (size_t)BK * 2, hstep = (size_t)HALF * K * 2, tstep = 2 * hstep;
  int pm, pn, npm = 0, npn = 0, ui = 0;
  if (!gemm_unit(0, nM, nN, nwg, pm, pn)) return;
  f32x4 acc[2][2][4][2];
#pragma unroll
  for (int a = 0; a < 2; ++a)
#pragma unroll
    for (int b = 0; b < 2; ++b)
#pragma unroll
      for (int m = 0; m < 4; ++m)
#pragma unroll
        for (int n = 0; n < 2; ++n) acc[a][b][m][n] = (f32x4){0.f, 0.f, 0.f, 0.f};
  bf16x8 At[4][2], B0[2][2], B1[2][2];
  const char* cA = (const char*)A + (size_t)pm * tstep;
  const char* cB = (const char*)Bt + (size_t)pn * tstep;
  STG(SB(0, 0), cB); STG(SA(0, 0), cA); STG(SB(0, 1), cB + hstep); STG(SA(0, 1), cA + hstep);
  if (wr == 1) BAR;
  WAIT_V(4); BAR;
  STG(SB(1, 0), cB + kstep); STG(SA(1, 0), cA + kstep); STG(SB(1, 1), cB + hstep + kstep);
  WAIT_V(6); BAR;
  for (;;) {
    const bool has_next = gemm_unit(ui + 1, nM, nN, nwg, npm, npn);
    const char* nA = has_next ? (const char*)A + (size_t)npm * tstep : cA;
    const char* nB = has_next ? (const char*)Bt + (size_t)npn * tstep : cB;
    for (int t = 0; t < nt; t += 2) {
      const bool last = (t == nt - 2);
      const char* a1 = cA + (size_t)(t + 1) * kstep;
      const char* a2 = last ? nA : cA + (size_t)(t + 2) * kstep;
      const char* b2 = last ? nB : cB + (size_t)(t + 2) * kstep;
      const char* a3 = a2 + kstep;
      const char* b3 = b2 + kstep;
      LDB(B0, 0, 0); SCHED; LDA(At, 0, 0); STG(SA(1, 1), a1 + hstep);
      WAIT_L(8); BAR; WAIT_L(0); MMA(0, 0, At, B0); BAR; SCHED;
      LDB(B1, 0, 1); STG(SB(0, 0), b2);
      BAR; WAIT_L(0); MMA(0, 1, At, B1); BAR;
      LDA(At, 0, 1); STG(SA(0, 0), a2);
      BAR; WAIT_L(0); MMA(1, 0, At, B0); BAR; SCHED;
      STG(SB(0, 1), b2 + hstep);
      WAIT_V(6); BAR; MMA(1, 1, At, B1); BAR;
      LDB(B0, 1, 0); SCHED; LDA(At, 1, 0); STG(SA(0, 1), a2 + hstep);
      WAIT_L(8); BAR; WAIT_L(0); MMA(0, 0, At, B0); BAR; SCHED;
      LDB(B1, 1, 1); STG(SB(1, 0), b3);
      BAR; WAIT_L(0); MMA(0, 1, At, B1); BAR;
      LDA(At, 1, 1); STG(SA(1, 0), a3);
      BAR; WAIT_L(0); MMA(1, 0, At, B0); BAR; SCHED;
      STG(SB(1, 1), b3 + hstep);
      WAIT_V(6); BAR; MMA(1, 1, At, B1); BAR;
    }
    {
      const int brow = pm * BM, bcol = pn * BM;
#pragma unroll
      for (int ai = 0; ai < 2; ++ai)
#pragma unroll
        for (int m = 0; m < 4; ++m) {
          const size_t row = (size_t)(brow + ai * HALF + wr * 64 + m * 16 + fr);
          if (EPI == 0) {
#pragma unroll
            for (int bj = 0; bj < 2; ++bj) {
              const f32x4 v0 = acc[ai][bj][m][0], v1 = acc[ai][bj][m][1];
              uint4 u; u.x = cvt_pk_bf16(v0[0], v0[1]); u.y = cvt_pk_bf16(v0[2], v0[3]); u.z = cvt_pk_bf16(v1[0], v1[1]); u.w = cvt_pk_bf16(v1[2], v1[3]);
              *(uint4*)(C + row * ldc + bcol + bj * HALF + wc * 32 + fq * 8) = u;
            }
          } else {
            float o[8];
#pragma unroll
            for (int n = 0; n < 2; ++n) {
              const f32x4 a = acc[ai][0][m][n], b = acc[ai][1][m][n];
#pragma unroll
              for (int j = 0; j < 4; ++j) o[n * 4 + j] = a[j] * __builtin_amdgcn_rcpf(1.f + __expf(-a[j])) * b[j];
            }
            *(uint4*)(C + row * ldc + (bcol >> 1) + wc * 32 + fq * 8) = pack8(o);
          }
        }
    }
    if (!has_next) break;
#pragma unroll
    for (int a = 0; a < 2; ++a)
#pragma unroll
      for (int b = 0; b < 2; ++b)
#pragma unroll
        for (int m = 0; m < 4; ++m)
#pragma unroll
          for (int n = 0; n < 2; ++n) acc[a][b][m][n] = (f32x4){0.f, 0.f, 0.f, 0.f};
    pm = npm; pn = npn; cA = nA; cB = nB; ++ui;
  }
  WAIT_V(0);
  if (wr == 0) BAR;
  BAR;
#undef SA
#undef SB
#undef STG
#undef LDA
#undef LDB
#undef MMA
}

__device__ __forceinline__ void load_shift16(const bf16_t* __restrict__ z, int row, int t, int T, int col, const float* __restrict__ mu, float* o) {
  const bf16_t* pz = z + (size_t)row * ZLD + col;
  uint4 c0 = *(const uint4*)pz, c1 = *(const uint4*)(pz + 8);
  uint4 p0 = make_uint4(0, 0, 0, 0), p1 = p0, n0 = p0, n1 = p0;
  if (t > 0) { p0 = *(const uint4*)(pz - ZLD); p1 = *(const uint4*)(pz - ZLD + 8); }
  if (t < T - 1) { n0 = *(const uint4*)(pz + ZLD); n1 = *(const uint4*)(pz + ZLD + 8); }
  float c[16], pv[16], nx[16];
  unpack8(c0, c); unpack8(c1, c + 8); unpack8(p0, pv); unpack8(p1, pv + 8); unpack8(n0, nx); unpack8(n1, nx + 8);
#pragma unroll
  for (int q = 0; q < 16; ++q) o[q] = c[q] + (0.5f * (pv[q] + nx[q]) - c[q]) * mu[col - 512 + q];
}
__device__ __forceinline__ void load_shift8(const bf16_t* __restrict__ z, int row, int t, int T, int col, const float* __restrict__ mu, float* o) {
  const bf16_t* pz = z + (size_t)row * ZLD + col;
  uint4 c0 = *(const uint4*)pz;
  uint4 p0 = make_uint4(0, 0, 0, 0), n0 = p0;
  if (t > 0) p0 = *(const uint4*)(pz - ZLD);
  if (t < T - 1) n0 = *(const uint4*)(pz + ZLD);
  float c[8], pv[8], nx[8];
  unpack8(c0, c); unpack8(p0, pv); unpack8(n0, nx);
#pragma unroll
  for (int q = 0; q < 8; ++q) o[q] = c[q] + (0.5f * (pv[q] + nx[q]) - c[q]) * mu[col - 512 + q];
}

constexpr int TC = 32;
constexpr int SV = TC * 64;
__device__ __forceinline__ void lora_prep_phase(PREF p, const int wid_u) {
  const int tid = opaque_tid();
  const bf16_t* z = P_RU;
  bf16_t* al = P_ALORA;
  const float* mu = p.shift_mu;
  for (int task = blockIdx.x * NTHR + tid; task < NTOK * 32; task += gridDim.x * NTHR) {
    const int row = task >> 5, oc = task & 31;
    int s, t, T;
    row_seq(row, s, t, T);
    float o[8];
    load_shift8(z, row, t, T, 2048 + oc * 8, mu, o);
    if (oc < 16) {
#pragma unroll
      for (int q = 0; q < 8; ++q) { const float e = __expf(2.f * o[q]); o[q] = 1.f - 2.f * __builtin_amdgcn_rcpf(e + 1.f); }
    }
    *(uint4*)(al + (size_t)row * 256 + oc * 8) = pack8(o);
  }
}

template <int HALF>
__device__ __forceinline__ void pool_seg(const bf16_t* __restrict__ z, bf16_t* __restrict__ mo, int row_base, int tbase, int T, int c0) {
  constexpr int NR = 2 * HALF + 3;
  float acc[4][8], zc[4][8];
#pragma unroll
  for (int i = 0; i < 4; ++i)
#pragma unroll
    for (int q = 0; q < 8; ++q) { acc[i][q] = 0.f; zc[i][q] = 0.f; }
#pragma unroll
  for (int r = 0; r < NR; ++r) {
    const int tt = tbase - HALF + r;
    uint4 u = make_uint4(0, 0, 0, 0);
    if (tt >= 0 && tt < T) u = *(const uint4*)(z + (size_t)(row_base - HALF + r) * ZLD + c0);
    float v[8];
    unpack8(u, v);
#pragma unroll
    for (int i = 0; i < 4; ++i) {
      if (r >= i && r < i + 2 * HALF) {
#pragma unroll
        for (int q = 0; q < 8; ++q) acc[i][q] += v[q];
      }
      if (r == HALF + i) {
#pragma unroll
        for (int q = 0; q < 8; ++q) zc[i][q] = v[q];
      }
    }
  }
#pragma unroll
  for (int i = 0; i < 4; ++i) {
    const int ti = tbase + i;
    const float ic = 1.f / (float)(min(ti + HALF, T) - max(ti - HALF, 0));
    float o[8];
#pragma unroll
    for (int q = 0; q < 8; ++q) o[q] = acc[i][q] * ic - zc[i][q];
    *(uint4*)(mo + (size_t)(row_base + i) * D + c0) = pack8(o);
  }
}
__device__ __forceinline__ void pool_tile(const bf16_t* __restrict__ z, bf16_t* __restrict__ mo, int tile, int tid) {
  const int row0 = tile * 32;
  int s, t0, T;
  row_seq(row0, s, t0, T);
  const int oc = tid >> 3, seg = tid & 7, c0 = oc * 8, grp = __builtin_amdgcn_readfirstlane(oc >> 4);
  const int rb = row0 + seg * 4, tb = t0 + seg * 4;
  if (grp == 0) pool_seg<1>(z, mo, rb, tb, T, c0);
  else if (grp == 1) pool_seg<2>(z, mo, rb, tb, T, c0);
  else if (grp == 2) pool_seg<4>(z, mo, rb, tb, T, c0);
  else pool_seg<8>(z, mo, rb, tb, T, c0);
}

struct Raw16 { uint4 c0, c1, p0, p1, n0, n1; };
__device__ __forceinline__ void load_raw16(Raw16& r, const bf16_t* __restrict__ z, int row, int t, int T, int col) {
  const bf16_t* pz = z + (unsigned)(row * ZLD + col);
  r.c0 = *(const uint4*)pz; r.c1 = *(const uint4*)(pz + 8);
  r.p0 = make_uint4(0, 0, 0, 0); r.p1 = r.p0; r.n0 = r.p0; r.n1 = r.p0;
  if (t > 0) { r.p0 = *(const uint4*)(pz - ZLD); r.p1 = *(const uint4*)(pz - ZLD + 8); }
  if (t < T - 1) { r.n0 = *(const uint4*)(pz + ZLD); r.n1 = *(const uint4*)(pz + ZLD + 8); }
}
__device__ __forceinline__ void shift16(const Raw16& r, const float* c1, const float* c2, float* o) {
  float c[16], pv[16], nx[16];
  unpack8(r.c0, c); unpack8(r.c1, c + 8); unpack8(r.p0, pv); unpack8(r.p1, pv + 8); unpack8(r.n0, nx); unpack8(r.n1, nx + 8);
#pragma unroll
  for (int q = 0; q < 16; ++q) o[q] = c[q] * c1[q] + (pv[q] + nx[q]) * c2[q];
}
__device__ __forceinline__ bf16x8 ldfrag(const bf16_t* base, int stride, int row0, int k0, int fr, int fq) {
  return *reinterpret_cast<const bf16x8*>(base + (row0 + fr) * stride + k0 + fq * 8);
}
__device__ __forceinline__ uint2 pack4(f32x4 v) { uint2 u; u.x = cvt_pk_bf16(v[0], v[1]); u.y = cvt_pk_bf16(v[2], v[3]); return u; }
#define MFMA16(a, b, c) __builtin_amdgcn_mfma_f32_16x16x32_bf16(a, b, c, 0, 0, 0)

constexpr int CS_NAB = 0, CS_NAK = 4096, CS_NBRT = 8192, CS_NKRT = 10752, CS_QT = 13312, CS_W = 15872, CS_Z = 20992, CS_GT = 26112,
              CS_RYT = 35328, CS_VN = 39936;
constexpr int CS_AT = 49152, CS_RT = CS_AT + 4608, CS_BT = CS_RT + 4608, CS_KT = CS_BT + 4608, CS_BB = 67584, CS_KB = CS_BB + 5120,
              CS_VT = CS_KB + 5120, CS_ATT = 82944, CS_PL = 92160, CS_SBF = 92416, CS_PRIV = 110848, CS_CST = 143616, CS_BL = 145920;

__device__ __forceinline__ void lds_barrier() {
  asm volatile("s_waitcnt lgkmcnt(0)" ::: "memory");
  __builtin_amdgcn_s_barrier();
  asm volatile("" ::: "memory");
}
template <int Q> __device__ __forceinline__ float quad_bcast(float x) { return dpp_f<Q * 0x55>(x); }

template <int S0> __device__ __forceinline__ void solve_steps(float (&x)[8], const float* nab, int seg) {
  if constexpr (S0 < 32) {
    const float xs = quad_bcast<(S0 >> 3)>(x[S0 & 7]);
    const f32x4 n0 = *(const f32x4*)(nab + S0 * 32 + seg * 8), n1 = *(const f32x4*)(nab + S0 * 32 + seg * 8 + 4);
    x[0] += xs * n0[0]; x[1] += xs * n0[1]; x[2] += xs * n0[2]; x[3] += xs * n0[3];
    x[4] += xs * n1[0]; x[5] += xs * n1[1]; x[6] += xs * n1[2]; x[7] += xs * n1[3];
    solve_steps<S0 + 1>(x, nab, seg);
  }
}

template <int S0> __device__ __forceinline__ void solve16(float (&x)[8], const float* nb) {
  if constexpr (S0 < 16) {
    const float xs = (S0 >> 3) ? dpp_f<0xF5>(x[S0 & 7]) : dpp_f<0xA0>(x[S0 & 7]);
    const f32x4 n0 = *(const f32x4*)(nb + S0 * 32), n1 = *(const f32x4*)(nb + S0 * 32 + 4);
    x[0] += xs * n0[0]; x[1] += xs * n0[1]; x[2] += xs * n0[2]; x[3] += xs * n0[3];
    x[4] += xs * n1[0]; x[5] += xs * n1[1]; x[6] += xs * n1[2]; x[7] += xs * n1[3];
    solve16<S0 + 1>(x, nb);
  }
}

__device__ __forceinline__ void scan_phase(PREF p, char* smem, const int wid_u) {
  float* stepbuf = (float*)smem;
  float* Nab = (float*)(smem + CS_NAB);
  bf16_t* NakT = (bf16_t*)(smem + CS_NAK);
  bf16_t* VNb = (bf16_t*)(smem + CS_VN);
  bf16_t* T11b = (bf16_t*)(smem + CS_VN + 5120);
  bf16_t* M1T = (bf16_t*)(smem + CS_VN + 5120 + 1280);
  bf16_t* NbrT = (bf16_t*)(smem + CS_NBRT);
  bf16_t* NkrT = (bf16_t*)(smem + CS_NKRT);
  bf16_t* TT = (bf16_t*)(smem + CS_QT);
  bf16_t* Wb = (bf16_t*)(smem + CS_W);
  bf16_t* Zb = (bf16_t*)(smem + CS_Z);
  bf16_t* GT = (bf16_t*)(smem + CS_GT);
  bf16_t* RyT = (bf16_t*)(smem + CS_RYT);
  bf16_t* At = (bf16_t*)(smem + CS_AT);
  bf16_t* Rt = (bf16_t*)(smem + CS_RT);
  bf16_t* Bt = (bf16_t*)(smem + CS_BT);
  bf16_t* Kt = (bf16_t*)(smem + CS_KT);
  bf16_t* Bb = (bf16_t*)(smem + CS_BB);
  bf16_t* Kb = (bf16_t*)(smem + CS_KB);
  bf16_t* VT = (bf16_t*)(smem + CS_VT);
  bf16_t* AtTb = (bf16_t*)(smem + CS_ATT);
  float* PLs = (float*)(smem + CS_PL);
  bf16_t* Sbf = (bf16_t*)(smem + CS_SBF);
  float* cst = (float*)(smem + CS_CST);
  const bf16_t* z = P_RU;
  const int tid = opaque_tid();
  const int wave = __builtin_amdgcn_readfirstlane(tid >> 6), lane = tid & 63, fr = lane & 15, fq = lane >> 4;
  const int item = blockIdx.x;
  if (item < 256) {
    const int s = item < 128 ? 8 + (item >> 4) : ((item - 128) >> 4);
    const int h = (item & 15) >> 1, d = item & 1;
    const int T = s < 8 ? 4096 : 8192, r0seq = seq_start(s), nch = T / 32;
    bf16_t* yout = P_RY + (size_t)d * NTOK * 512;
    {
      const int g = tid >> 6, k = tid & 63;
      const float muk = p.shift_mu[1024 - 512 + h * 64 + k], mur = p.shift_mu[512 - 512 + h * 64 + k], muv = p.shift_mu[1536 - 512 + h * 64 + k];
      float v;
      if (g == 0) v = 0.5f * muk;
      else if (g == 1) v = 0.5f * mur;
      else if (g == 2) v = 1.f - muk;
      else if (g == 3) v = 1.f - mur;
      else if (g == 4) v = 1.f - muv;
      else if (g == 5) v = p.k_k[h * 64 + k];
      else if (g == 6) v = p.k_a[h * 64 + k];
      else v = p.r_k[h * 64 + k];
      cst[g * 64 + k] = v;
      if (g == 0) cst[8 * 64 + k] = 0.5f * muv;
      for (int i = tid; i < 2 * 64 * 72 / 2; i += NTHR) ((unsigned*)Sbf)[i] = 0u;
    }
    const int role = wave >> 1, th = wave & 1;
    const int tl = lane >> 2, cq = lane & 3;
    float* tmpa = (float*)(smem + CS_PRIV + (wave & 3) * 8192 + 2560);
    uint4* Blds = (uint4*)(smem + CS_BL) + (role & 1) * 512;
    float bias[4] = {0.f, 0.f, 0.f, 0.f};
    if (role < 2) {
      const float* lsrc = sel(role != 0, p.a2, p.w2) + (size_t)d * 64 * 512 + h * 64;
      if (th == 0) {
#pragma unroll
        for (int nt = 0; nt < 4; ++nt)
#pragma unroll
          for (int ks = 0; ks < 2; ++ks) {
            float o[8];
#pragma unroll
            for (int q = 0; q < 8; ++q) o[q] = lsrc[(size_t)(ks * 32 + fq * 8 + q) * 512 + nt * 16 + fr];
            Blds[(nt * 2 + ks) * 64 + lane] = pack8(o);
          }
      }
#pragma unroll
      for (int nt = 0; nt < 4; ++nt) bias[nt] = sel(role != 0, p.a0, p.w0)[d * 512 + h * 64 + nt * 16 + fr];
    }
    const int colA = 512 + h * 64 + cq * 16;
    const int colB = (role == 1 ? 1024 : 1536) + h * 64 + cq * 16;
    const int alo = (role == 0 ? d * 64 : 128 + d * 64) + fq * 8;
    Raw16 ra, rb;
    {
      const int j = th * 16 + tl, t = d ? T - 1 - j : j, row = r0seq + t;
      if (role == 2) load_raw16(ra, z, row, t, T, colA);
      if (role == 1 || role == 2) load_raw16(rb, z, row, t, T, colB);
      if (role < 2) {
        const int j2 = th * 16 + fr, t2 = d ? T - 1 - j2 : j2;
        const bf16_t* ap = P_ALORA + (unsigned)((r0seq + t2) * 256 + alo);
        ra.c0 = *(const uint4*)ap; ra.c1 = *(const uint4*)(ap + 32);
      }
    }
    f32x4 Sa = {0.f, 0.f, 0.f, 0.f}, Sb = Sa;
    uint2 y_def = make_uint2(0u, 0u);
    float sb_def = 0.f;
    const int mt = wave >> 1, hn = wave & 1, nt0 = 2 * hn, nt1 = 2 * hn + 1;
    __syncthreads();

    for (int c = 0; c < nch; ++c) {
      if (role < 3) {
        const int j = th * 16 + tl;
        const int istep = c * 32 + j;
        const int t = d ? T - 1 - istep : istep;
        const int row = r0seq + t;
        float v16[16];
        if (role < 2) {
          f32x4 acc[4] = {};
#pragma unroll
          for (int ks = 0; ks < 2; ++ks) {
            const uint4 au = ks == 0 ? ra.c0 : ra.c1;
            const bf16x8 a = *reinterpret_cast<const bf16x8*>(&au);
#pragma unroll
            for (int nt = 0; nt < 4; ++nt) { const uint4 bu = Blds[(nt * 2 + ks) * 64 + lane]; acc[nt] = MFMA16(a, *reinterpret_cast<const bf16x8*>(&bu), acc[nt]); }
          }
          if (role == 0) {
#pragma unroll
            for (int nt = 0; nt < 4; ++nt)
#pragma unroll
              for (int jj = 0; jj < 4; ++jj) {
                const float sg = sigmoidf_(bias[nt] + acc[nt][jj]);
                stepbuf[0 * SV + (th * 16 + fq * 4 + jj) * 64 + nt * 16 + fr] = __expf(-0.6065306597126334f * sg);
              }
            __builtin_amdgcn_wave_barrier();
            {
              float wl[16];
#pragma unroll
              for (int i = 0; i < 16; ++i) wl[i] = stepbuf[0 * SV + (th * 16 + i) * 64 + lane];
              float pr = 1.f;
#pragma unroll
              for (int i = 0; i < 16; ++i) { pr *= wl[i]; stepbuf[0 * SV + (th * 16 + i) * 64 + lane] = pr; }
            }
          } else {
#pragma unroll
            for (int nt = 0; nt < 4; ++nt)
#pragma unroll
              for (int jj = 0; jj < 4; ++jj) tmpa[(fq * 4 + jj) * 68 + nt * 16 + fr] = sigmoidf_(bias[nt] + acc[nt][jj]);
            __builtin_amdgcn_wave_barrier();
            float av[16], kd[16];
#pragma unroll
            for (int q = 0; q < 4; ++q) { f32x4 a4 = *(const f32x4*)(tmpa + tl * 68 + cq * 16 + q * 4); av[q * 4] = a4[0]; av[q * 4 + 1] = a4[1]; av[q * 4 + 2] = a4[2]; av[q * 4 + 3] = a4[3]; }
            shift16(rb, cst + 2 * 64 + cq * 16, cst + 0 * 64 + cq * 16, v16);
            float kk[16], ss = 0.f;
#pragma unroll
            for (int q = 0; q < 16; ++q) { kk[q] = v16[q] * cst[5 * 64 + cq * 16 + q]; ss += kk[q] * kk[q]; }
            ss = quad_sum(ss);
            const float inv = 1.f / fmaxf(sqrtf(ss), 1e-12f);
#pragma unroll
            for (int q = 0; q < 16; ++q) { kk[q] *= inv; kd[q] = v16[q] * (1.f + (av[q] - 1.f) * cst[6 * 64 + cq * 16 + q]); }
#pragma unroll
            for (int q = 0; q < 4; ++q) {
              *(f32x4*)(stepbuf + 3 * SV + j * 64 + cq * 16 + q * 4) = (f32x4){-kk[q * 4], -kk[q * 4 + 1], -kk[q * 4 + 2], -kk[q * 4 + 3]};
              *(f32x4*)(stepbuf + 4 * SV + j * 64 + cq * 16 + q * 4) = (f32x4){kk[q * 4] * av[q * 4], kk[q * 4 + 1] * av[q * 4 + 1], kk[q * 4 + 2] * av[q * 4 + 2], kk[q * 4 + 3] * av[q * 4 + 3]};
              *(f32x4*)(stepbuf + 1 * SV + j * 64 + cq * 16 + q * 4) = (f32x4){kd[q * 4], kd[q * 4 + 1], kd[q * 4 + 2], kd[q * 4 + 3]};
            }
          }
        } else {
          shift16(ra, cst + 3 * 64 + cq * 16, cst + 1 * 64 + cq * 16, v16);
#pragma unroll
          for (int q = 0; q < 4; ++q) *(f32x4*)(stepbuf + 2 * SV + j * 64 + cq * 16 + q * 4) = (f32x4){v16[q * 4], v16[q * 4 + 1], v16[q * 4 + 2], v16[q * 4 + 3]};
          shift16(rb, cst + 4 * 64 + cq * 16, cst + 8 * 64 + cq * 16, v16);
#pragma unroll
          for (int q = 0; q < 4; ++q) *(f32x4*)(stepbuf + 5 * SV + j * 64 + cq * 16 + q * 4) = (f32x4){v16[q * 4], v16[q * 4 + 1], v16[q * 4 + 2], v16[q * 4 + 3]};
        }
      }
      if (c > 0) {
        const int ip = (c - 1) * 32 + hn * 16 + fr, tp = d ? T - 1 - ip : ip;
        *(uint2*)(yout + (size_t)(r0seq + tp) * 512 + h * 64 + mt * 16 + fq * 4) = y_def;
        if (role == 2 && cq == 0) { const int is_ = (c - 1) * 32 + th * 16 + tl, tg = d ? T - 1 - is_ : is_; P_SBON[((size_t)(r0seq + tg) * 8 + h) * 2 + d] = sb_def; }
      }
      if (role < 3 && c + 1 < nch) {
        const int is2 = (c + 1) * 32 + th * 16 + tl;
        const int t2 = d ? T - 1 - is2 : is2;
        const int row2 = r0seq + t2;
        if (role == 2) load_raw16(ra, z, row2, t2, T, colA);
        if (role >= 1) load_raw16(rb, z, row2, t2, T, colB);
        if (role < 2) {
          const int is3 = (c + 1) * 32 + th * 16 + fr, t3 = d ? T - 1 - is3 : is3;
          const bf16_t* ap = P_ALORA + (unsigned)((r0seq + t3) * 256 + alo);
          ra.c0 = *(const uint4*)ap; ra.c1 = *(const uint4*)(ap + 32);
        }
      }
      lds_barrier();
      {
        const int k = lane, seg = wave;
        const float* sw = stepbuf + 0 * SV + k;
        const float P15 = sw[15 * 64];
        const float hiF = seg >= 4 ? P15 : 1.f;
        float P[5];
        P[0] = seg == 0 ? 1.f : sw[(4 * seg - 1) * 64] * (seg > 4 ? P15 : 1.f);
#pragma unroll
        for (int i = 0; i < 4; ++i) P[i + 1] = sw[(4 * seg + i) * 64] * hiF;
        const float PL = sw[31 * 64] * P15;
        if (role == 2) {
          const int j = th * 16 + tl;
          float bs = 0.f;
#pragma unroll
          for (int q = 0; q < 16; ++q) bs += stepbuf[2 * SV + j * 64 + cq * 16 + q] * stepbuf[1 * SV + j * 64 + cq * 16 + q] * cst[7 * 64 + cq * 16 + q];
          bs = quad_sum(bs);
          sb_def = bs;
        }
        f32x4 bb, kb, at, vv;
#pragma unroll
        for (int i = 0; i < 4; ++i) {
          const int t = 4 * seg + i;
          const float inv = __builtin_amdgcn_rcpf(P[i + 1]);
          const float a_ = P[i] * stepbuf[3 * SV + t * 64 + k];
          const float rraw = stepbuf[2 * SV + t * 64 + k], kraw = stepbuf[1 * SV + t * 64 + k];
          const float r_ = P[i + 1] * rraw;
          const float b_ = stepbuf[4 * SV + t * 64 + k] * inv;
          const float k_ = kraw * inv;

          At[t * 72 + k] = (bf16_t)(cvt_pk_bf16(a_, 0.f) & 0xffff);
          Rt[t * 72 + k] = (bf16_t)(cvt_pk_bf16(r_, 0.f) & 0xffff);
          Bt[t * 72 + k] = (bf16_t)(cvt_pk_bf16(b_, 0.f) & 0xffff);
          Kt[t * 72 + k] = (bf16_t)(cvt_pk_bf16(k_, 0.f) & 0xffff);
          bb[i] = b_ * PL; kb[i] = k_ * PL; at[i] = a_;
          vv[i] = stepbuf[5 * SV + t * 64 + k];
        }
        *(uint2*)(Bb + k * 40 + 4 * seg) = pack4(bb);
        *(uint2*)(Kb + k * 40 + 4 * seg) = pack4(kb);
        *(uint2*)(VT + k * 40 + 4 * seg) = pack4(vv);
        *(uint2*)(AtTb + k * 40 + 4 * seg) = pack4(at);
        if (seg == 0) PLs[k] = PL;
      }
      lds_barrier();
      {
        const int mat = wave >> 1, mts = wave & 1;
        const bf16_t* As = (mat & 1) ? Kt : Bt;
        const bf16_t* Bs = (mat & 2) ? Rt : At;
        f32x4 acc[2] = {};
#pragma unroll
        for (int ks = 0; ks < 2; ++ks) {
          const bf16x8 a = ldfrag(As, 72, mts * 16, ks * 32, fr, fq);
#pragma unroll
          for (int nt = 0; nt < 2; ++nt) acc[nt] = MFMA16(a, ldfrag(Bs, 72, nt * 16, ks * 32, fr, fq), acc[nt]);
        }
#pragma unroll
        for (int nt = 0; nt < 2; ++nt) {
          const int tcol = nt * 16 + fr;
          f32x4 v = acc[nt];
#pragma unroll
          for (int jj = 0; jj < 4; ++jj) {
            const int srow = mts * 16 + fq * 4 + jj;
            const bool keep = (mat & 2) ? (srow <= tcol) : (srow < tcol);
            v[jj] = keep ? v[jj] : 0.f;
          }
          if (mat == 0) {
#pragma unroll
            for (int jj = 0; jj < 4; ++jj) Nab[(mts * 16 + fq * 4 + jj) * 32 + tcol] = v[jj];
          } else {
            bf16_t* dst = mat == 1 ? NakT : mat == 2 ? NbrT : NkrT;
            *(uint2*)(dst + tcol * 40 + mts * 16 + fq * 4) = pack4(v);
          }
        }
      }
      lds_barrier();
      if (wave == 0) {
        const int irow = lane >> 1, hb = lane & 1, blk = lane >> 5, il = irow & 15;
        float x[8];
#pragma unroll
        for (int i = 0; i < 8; ++i) x[i] = (hb * 8 + i == il) ? 1.f : 0.f;
        const float* nb = Nab + (blk * 16) * 32 + blk * 16 + hb * 8;
        solve16<0>(x, nb);
#pragma unroll
        for (int i = 0; i < 8; ++i) TT[(blk * 16 + hb * 8 + i) * 40 + blk * 16 + il] = (bf16_t)(cvt_pk_bf16(x[i], 0.f) & 0xffff);
        if (blk == 0) *(uint4*)(T11b + il * 40 + hb * 8) = pack8(x);
        __builtin_amdgcn_wave_barrier();
        const f32x4 zero = {0.f, 0.f, 0.f, 0.f};
        bf16x8 zf;
#pragma unroll
        for (int i = 0; i < 8; ++i) zf[i] = 0;
        bf16x8 n12 = zf, t22 = zf, t11 = zf;
        if (fq < 2) {
          float o[8];
          const f32x4 n0 = *(const f32x4*)(Nab + fr * 32 + 16 + fq * 8), n1 = *(const f32x4*)(Nab + fr * 32 + 16 + fq * 8 + 4);
          o[0] = n0[0]; o[1] = n0[1]; o[2] = n0[2]; o[3] = n0[3]; o[4] = n1[0]; o[5] = n1[1]; o[6] = n1[2]; o[7] = n1[3];
          uint4 u = pack8(o);
          n12 = *reinterpret_cast<bf16x8*>(&u);
          t22 = *reinterpret_cast<const bf16x8*>(TT + (16 + fr) * 40 + 16 + fq * 8);
          t11 = *reinterpret_cast<const bf16x8*>(T11b + fr * 40 + fq * 8);
        }
        const f32x4 m1 = MFMA16(n12, t22, zero);
        *(uint2*)(M1T + fr * 40 + fq * 4) = pack4(m1);
        __builtin_amdgcn_wave_barrier();
        bf16x8 m1f = zf;
        if (fq < 2) m1f = *reinterpret_cast<const bf16x8*>(M1T + fr * 40 + fq * 8);
        const f32x4 t12 = MFMA16(t11, m1f, zero);
        *(uint2*)(TT + (16 + fr) * 40 + fq * 4) = pack4(t12);
      } else if (wave == 1) {
        unsigned z0;
        asm volatile("v_mov_b32 %0, 0" : "=v"(z0));
        *(uint2*)(TT + (lane >> 2) * 40 + 16 + (lane & 3) * 4) = make_uint2(z0, z0);
      } else if (wave < 6) {
        const int vtile = wave - 2;
        const bf16x8 vf = ldfrag(VT, 40, vtile * 16, 0, fr, fq);
        const f32x4 zero = {0.f, 0.f, 0.f, 0.f};
#pragma unroll
        for (int tt = 0; tt < 2; ++tt) {
          const f32x4 acc = MFMA16(ldfrag(NakT, 40, tt * 16, 0, fr, fq), vf, zero);
          *(uint2*)(VNb + (vtile * 16 + fr) * 40 + tt * 16 + fq * 4) = pack4(acc);
        }
      }
      lds_barrier();
      {
        const int tt = wave & 1, rt = wave >> 1;
        const f32x4 zero = {0.f, 0.f, 0.f, 0.f};
        const bf16x8 tf = ldfrag(TT, 40, tt * 16, 0, fr, fq);
        const f32x4 zacc = MFMA16(tf, ldfrag(VNb, 40, rt * 16, 0, fr, fq), zero);
        const f32x4 wacc = MFMA16(tf, ldfrag(AtTb, 40, rt * 16, 0, fr, fq), zero);
        *(uint2*)(Zb + (rt * 16 + fr) * 40 + tt * 16 + fq * 4) = pack4(zacc);
        *(uint2*)(Wb + (rt * 16 + fr) * 40 + tt * 16 + fq * 4) = pack4(wacc);
      }
      lds_barrier();
      f32x4 yacc = {0.f, 0.f, 0.f, 0.f};
      {
        const float pl0 = PLs[nt0 * 16 + fr], pl1 = PLs[nt1 * 16 + fr];
        Sa = Sa * pl0; Sb = Sb * pl1;
        const bf16x8 zf = ldfrag(Zb, 40, mt * 16, 0, fr, fq), vf = ldfrag(VT, 40, mt * 16, 0, fr, fq), wf = ldfrag(Wb, 40, mt * 16, 0, fr, fq);
        const bf16x8 bb0 = ldfrag(Bb, 40, nt0 * 16, 0, fr, fq), bb1 = ldfrag(Bb, 40, nt1 * 16, 0, fr, fq);
        const bf16x8 kb0 = ldfrag(Kb, 40, nt0 * 16, 0, fr, fq), kb1 = ldfrag(Kb, 40, nt1 * 16, 0, fr, fq);
        const bf16x8 nbr = ldfrag(NbrT, 40, hn * 16, 0, fr, fq), nkr = ldfrag(NkrT, 40, hn * 16, 0, fr, fq);
        Sa = MFMA16(zf, bb0, Sa); Sa = MFMA16(vf, kb0, Sa);
        Sb = MFMA16(zf, bb1, Sb); Sb = MFMA16(vf, kb1, Sb);
        yacc = MFMA16(zf, nbr, yacc); yacc = MFMA16(vf, nkr, yacc);
        const f32x4 zero = {0.f, 0.f, 0.f, 0.f};
        const f32x4 g0 = MFMA16(wf, bb0, zero), g1 = MFMA16(wf, bb1, zero);
        f32x4 ry = MFMA16(wf, nbr, zero);
        *(uint2*)(GT + (nt0 * 16 + fr) * 72 + mt * 16 + fq * 4) = pack4(g0);
        *(uint2*)(GT + (nt1 * 16 + fr) * 72 + mt * 16 + fq * 4) = pack4(g1);
        const uint2 rr = *(const uint2*)(Rt + (hn * 16 + fr) * 72 + mt * 16 + fq * 4);
        ry[0] += bf_lo(rr.x); ry[1] += bf_hi(rr.x); ry[2] += bf_lo(rr.y); ry[3] += bf_hi(rr.y);
        *(uint2*)(RyT + (hn * 16 + fr) * 72 + mt * 16 + fq * 4) = pack4(ry);
      }
      lds_barrier();
      {
        const bf16_t* Scur = Sbf + (c & 1) * 64 * 72;
        bf16_t* Snext = Sbf + ((c + 1) & 1) * 64 * 72;
#pragma unroll
        for (int ks = 0; ks < 2; ++ks) {
          const bf16x8 af = ldfrag(Scur, 72, mt * 16, ks * 32, fr, fq);
          Sa = MFMA16(af, ldfrag(GT, 72, nt0 * 16, ks * 32, fr, fq), Sa);
          Sb = MFMA16(af, ldfrag(GT, 72, nt1 * 16, ks * 32, fr, fq), Sb);
          yacc = MFMA16(af, ldfrag(RyT, 72, hn * 16, ks * 32, fr, fq), yacc);
        }
        y_def = pack4(yacc);
#pragma unroll
        for (int jj = 0; jj < 4; ++jj) {
          Snext[(mt * 16 + fq * 4 + jj) * 72 + nt0 * 16 + fr] = (bf16_t)(cvt_pk_bf16(Sa[jj], 0.f) & 0xffff);
          Snext[(mt * 16 + fq * 4 + jj) * 72 + nt1 * 16 + fr] = (bf16_t)(cvt_pk_bf16(Sb[jj], 0.f) & 0xffff);
        }
      }
      lds_barrier();
    }
    {
      const int ip = (nch - 1) * 32 + hn * 16 + fr, tp = d ? T - 1 - ip : ip;
      *(uint2*)(yout + (size_t)(r0seq + tp) * 512 + h * 64 + mt * 16 + fq * 4) = y_def;
      if (role == 2 && cq == 0) { const int is_ = (nch - 1) * 32 + th * 16 + tl, tg = d ? T - 1 - is_ : is_; P_SBON[((size_t)(r0seq + tg) * 8 + h) * 2 + d] = sb_def; }
    }
  }
  if (item >= 128) {
    const int nb = gridDim.x - 128;
    for (int tile = item - 128; tile < NTOK / 32; tile += nb) pool_tile(z, P_RH, tile, tid);
  }
}

__device__ __forceinline__ void post_phase(PREF p, char* smem, const int wid_u) {
  bf16_t* Ag = (bf16_t*)smem;
  bf16_t* vt = (bf16_t*)(smem + 12800);
  float* ys = (float*)(smem + 12800 + 33280);
  const bf16_t* z = P_RU;
  const bf16_t* yf = P_RY;
  const bf16_t* ybk = P_RY + (size_t)NTOK * 512;
  bf16_t* mo = P_RH;
  const int tid = opaque_tid(), w = tid >> 6, lane = tid & 63, fr = lane & 15, fq = lane >> 4;
  bf16x8 Bg[4][6];
#pragma unroll
  for (int nt = 0; nt < 4; ++nt)
#pragma unroll
    for (int ks = 0; ks < 6; ++ks) {
      float o[8];
#pragma unroll
      for (int q = 0; q < 8; ++q) { const int k = ks * 32 + fq * 8 + q; o[q] = k < 160 ? p.g2[(size_t)k * 512 + w * 64 + nt * 16 + fr] : 0.f; }
      uint4 u = pack8(o);
      Bg[nt][ks] = *reinterpret_cast<bf16x8*>(&u);
    }
  float lng[4], lnb[4];
#pragma unroll
  for (int nt = 0; nt < 4; ++nt) { lng[nt] = p.lnx_g[w * 64 + nt * 16 + fr]; lnb[nt] = p.lnx_b[w * 64 + nt * 16 + fr]; }

  for (int tile = blockIdx.x; tile < NTOK / 32; tile += gridDim.x) {
    const int row0 = tile * 32;
    int s, t0, T;
    row_seq(row0, s, t0, T);
    for (int idx = tid; idx < 32 * 24; idx += NTHR) {
      const int tok = idx / 24, oc = idx % 24;
      float o[8];
      if (oc < 20) {
        load_shift8(z, row0 + tok, t0 + tok, T, 2304 + oc * 8, p.shift_mu, o);
#pragma unroll
        for (int q = 0; q < 8; ++q) o[q] = sigmoidf_(o[q]);
      } else {
#pragma unroll
        for (int q = 0; q < 8; ++q) o[q] = 0.f;
      }
      *(uint4*)(Ag + tok * 200 + oc * 8) = pack8(o);
    }
    for (int idx = tid; idx < 32 * 64; idx += NTHR) {
      const int tok = idx >> 6, oc = idx & 63, row = row0 + tok, t = t0 + tok;
      float o[8];
      load_shift8(z, row, t, T, 1536 + oc * 8, p.shift_mu, o);
      *(uint4*)(vt + tok * 520 + oc * 8) = pack8(o);
      float a[8], b[8];
      unpack8(*(const uint4*)(yf + (size_t)row * 512 + oc * 8), a);
      unpack8(*(const uint4*)(ybk + (size_t)row * 512 + oc * 8), b);
      *(f32x4*)(ys + tok * 516 + oc * 8) = (f32x4){a[0] + b[0], a[1] + b[1], a[2] + b[2], a[3] + b[3]};
      *(f32x4*)(ys + tok * 516 + oc * 8 + 4) = (f32x4){a[4] + b[4], a[5] + b[5], a[6] + b[6], a[7] + b[7]};
    }
    __syncthreads();
    f32x4 acc[2][4] = {};
#pragma unroll
    for (int ks = 0; ks < 6; ++ks) {
      bf16x8 a[2];
#pragma unroll
      for (int mt = 0; mt < 2; ++mt) a[mt] = *reinterpret_cast<const bf16x8*>(Ag + (mt * 16 + fr) * 200 + ks * 32 + fq * 8);
#pragma unroll
      for (int mt = 0; mt < 2; ++mt)
#pragma unroll
        for (int nt = 0; nt < 4; ++nt) acc[mt][nt] = __builtin_amdgcn_mfma_f32_16x16x32_bf16(a[mt], Bg[nt][ks], acc[mt][nt], 0, 0, 0);
    }
#pragma unroll
    for (int mt = 0; mt < 2; ++mt)
#pragma unroll
      for (int jj = 0; jj < 4; ++jj) {
        const int tok = mt * 16 + fq * 4 + jj, row = row0 + tok;
        float yv[4], sm_ = 0.f;
#pragma unroll
        for (int nt = 0; nt < 4; ++nt) { yv[nt] = ys[tok * 516 + w * 64 + nt * 16 + fr]; sm_ += yv[nt]; }
        const float mean = row16_sum(sm_) * (1.f / 64.f);
        float vs = 0.f;
#pragma unroll
        for (int nt = 0; nt < 4; ++nt) { yv[nt] -= mean; vs += yv[nt] * yv[nt]; }
        const float rs = rsqrtf(row16_sum(vs) * (1.f / 64.f) + 64e-5f);
        const float2 sb2 = *(const float2*)(P_SBON + ((size_t)row * 8 + w) * 2);
        const float sbs = sb2.x + sb2.y;
#pragma unroll
        for (int nt = 0; nt < 4; ++nt) {
          const float vv = bf2f(vt[tok * 520 + w * 64 + nt * 16 + fr]);
          const float o = (yv[nt] * rs * lng[nt] + lnb[nt] + sbs * vv) * acc[mt][nt][jj];
          mo[(size_t)row * D + 512 + w * 64 + nt * 16 + fr] = (bf16_t)(cvt_pk_bf16(o, 0.f) & 0xffff);
        }
      }
    __syncthreads();
  }
}

constexpr int NPHASE = 14;
__device__ __forceinline__ void do_phase(PREF p, int ph, char* smem, const int wid_u) {
  if (ph == 0) prep_phase(p, smem, wid_u);
  else if (ph == 1) row_phase<0>(p.x_prompt, p.x_sample, nullptr, nullptr, P_RH, P_MOD, nullptr, p.n1_pre, 0, 0.f, 0, wid_u);
  else if (ph == 4 || ph == 10) {
    const bool f = ph == 4;
    float* outp = p.out;
    row_phase<1>(sel(f, p.x_prompt, (const float*)outp), sel(f, p.x_sample, (const float*)(outp + (size_t)NPROMPT * D)), outp, P_RY, P_RH, P_MOD,
                 sel(f, p.n1_post, p.nm_post), sel(f, p.nm_pre, p.n2_pre), f ? 2 : 5, f ? 0.5f : 1.0f, f ? 3 : 6, wid_u);
  }
  else if (ph == 13) row_phase<2>(p.out, p.out + (size_t)NPROMPT * D, p.out, P_RY, nullptr, P_MOD, p.n2_post, nullptr, 8, 0.5f, 0, wid_u);
  else if (ph == 6) lora_prep_phase(p, wid_u);
  else if (ph == 7) scan_phase(p, smem, wid_u);
  else if (ph == 8) post_phase(p, smem, wid_u);
  else {
    const bf16_t *A, *Bt; bf16_t* C; int N, K, ldc, epi;
    if (ph == 2 || ph == 11) { A = P_RH; Bt = sel(ph == 2, P_W13A, P_W13B); C = P_RU; N = 2 * FF; K = D; ldc = FF; epi = 1; }
    else if (ph == 3 || ph == 12) { A = P_RU; Bt = sel(ph == 3, P_W2A, P_W2B); C = P_RY; N = D; K = FF; ldc = D; epi = 0; }
    else if (ph == 5) { A = P_RH; Bt = P_WINT; C = P_RU; N = ZLD; K = D; ldc = ZLD; epi = 0; }
    else { A = P_RH; Bt = P_WOUTT; C = P_RY; N = D; K = D; ldc = D; epi = 0; }
    gemm_phase(A, Bt, C, NTOK, N, K, ldc, epi, smem, wid_u);
  }
}

extern __shared__ __attribute__((aligned(16))) char dyn_smem[];

__global__ void __launch_bounds__(NTHR, 2) mega_kernel(Params p) {
  cg::grid_group grid = cg::this_grid();
  const int wid_u = __builtin_amdgcn_readfirstlane(threadIdx.x >> 6);
  typedef const __attribute__((address_space(4))) Params* KP;
  const KP kp0 = (KP)__builtin_amdgcn_kernarg_segment_ptr();
#pragma unroll 1
  for (int ph = 0; ph < NPHASE; ++ph) {
    KP kp = kp0;
    asm volatile("" : "+s"(kp));
    do_phase(*kp, ph, dyn_smem, wid_u);
#ifdef PROBE_REPEAT
    if (ph == PROBE_REPEAT) { grid.sync(); do_phase(*kp, ph, dyn_smem, wid_u); }
#endif
    if (ph + 1 < NPHASE) grid.sync();
  }
}

__global__ void __launch_bounds__(NTHR, 2) phase_kernel(Params p, int ph) {
  const int wid_u = __builtin_amdgcn_readfirstlane(threadIdx.x >> 6);
  do_phase(*(const __attribute__((address_space(4))) Params*)__builtin_amdgcn_kernarg_segment_ptr(), ph, dyn_smem, wid_u);
}

extern "C" void kernel_launch(void* const* d_in, const int* in_sizes, int n_in, void* d_out, int out_size, void* d_ws, size_t ws_size,
                              hipStream_t stream) {
  Params p{};
  const float** f = (const float**)&p;
  for (int i = 0; i < 33; ++i) f[i] = (const float*)d_in[i];
  p.out = (float*)d_out;
  p.ws = (char*)d_ws;
  if (WS_NEED > ws_size) { fprintf(stderr, "workspace too small: need %zu have %zu\n", (size_t)WS_NEED, ws_size); return; }

#if ONE_LAUNCH
  static int grid_blocks = 0;
  if (!grid_blocks) {
    int dev = 0, cus = 0, per_cu = 0;
    (void)hipGetDevice(&dev);
    (void)hipDeviceGetAttribute(&cus, hipDeviceAttributeMultiprocessorCount, dev);
    (void)hipFuncSetAttribute((const void*)mega_kernel, hipFuncAttributeMaxDynamicSharedMemorySize, SMEM_BYTES);
    (void)hipOccupancyMaxActiveBlocksPerMultiprocessor(&per_cu, mega_kernel, NTHR, SMEM_BYTES);
    if (per_cu < 1) per_cu = 1;
    grid_blocks = cus * per_cu;
  }
  void* args[] = {&p};
  hipError_t e = hipLaunchCooperativeKernel((const void*)mega_kernel, dim3(grid_blocks), dim3(NTHR), args, SMEM_BYTES, stream);
  if (e != hipSuccess) fprintf(stderr, "cooperative launch failed: %s (grid %d)\n", hipGetErrorString(e), grid_blocks);
#else
  static bool attr = false;
  if (!attr) { (void)hipFuncSetAttribute((const void*)phase_kernel, hipFuncAttributeMaxDynamicSharedMemorySize, SMEM_BYTES); attr = true; }
  for (int ph = 0; ph < NPHASE; ++ph) phase_kernel<<<256, NTHR, SMEM_BYTES, stream>>>(p, ph);
#endif
}
```

```cpp
#include <hip/hip_runtime.h>
#include <hip/hip_cooperative_groups.h>
#include <cstdio>
namespace cg = cooperative_groups;

#ifndef ONE_LAUNCH
#define ONE_LAUNCH 1
#endif

typedef unsigned short bf16_t;
typedef short bf16x8 __attribute__((ext_vector_type(8)));
typedef float f32x4 __attribute__((ext_vector_type(4)));
typedef float f32x2 __attribute__((ext_vector_type(2)));
#define LAS __attribute__((address_space(3)))

constexpr int D = 1024, FF = 2816, NTOK = 98304, NPROMPT = 32768, ZLD = 2560, PINW = 2464;
constexpr int NTHR = 512;
constexpr int SMEM_BYTES = 162320;

struct Params {
  const float *x_prompt, *x_sample, *c_prompt, *c_sample, *ada_w, *ada_b, *n1_pre, *n1_post, *f1_w1, *f1_w3, *f1_w2,
      *nm_pre, *nm_post, *w_in, *shift_mu, *pool_w, *pool_scale, *w0, *w2, *a0, *a2, *g2, *k_k, *k_a, *r_k, *lnx_g, *lnx_b,
      *w_out, *n2_pre, *n2_post, *f2_w1, *f2_w3, *f2_w2;
  float* out;
  char* ws;
};
#define PREF const __attribute__((address_space(4))) Params&
constexpr size_t al256(size_t b) { return (b + 255) & ~(size_t)255; }
constexpr size_t OFF_W13A = 0;
constexpr size_t OFF_W13B = OFF_W13A + al256((size_t)2 * FF * D * 2);
constexpr size_t OFF_W2A = OFF_W13B + al256((size_t)2 * FF * D * 2);
constexpr size_t OFF_W2B = OFF_W2A + al256((size_t)D * FF * 2);
constexpr size_t OFF_WINT = OFF_W2B + al256((size_t)D * FF * 2);
constexpr size_t OFF_WOUTT = OFF_WINT + al256((size_t)ZLD * D * 2);
constexpr size_t OFF_MOD = OFF_WOUTT + al256((size_t)D * D * 2);
constexpr size_t OFF_SBON = OFF_MOD + al256((size_t)16 * 9216 * 4);
constexpr size_t OFF_RH = OFF_SBON + al256((size_t)NTOK * 16 * 4);
constexpr size_t OFF_RY = OFF_RH + al256((size_t)NTOK * D * 2);
constexpr size_t OFF_RU = OFF_RY + al256((size_t)NTOK * D * 2);
constexpr size_t OFF_ALORA = OFF_RU + al256((size_t)NTOK * FF * 2);
constexpr size_t OFF_BAR = OFF_ALORA + al256((size_t)NTOK * 256 * 2);
constexpr size_t WS_NEED = OFF_BAR + 16384;
#define P_W13A ((bf16_t*)(p.ws + OFF_W13A))
#define P_W13B ((bf16_t*)(p.ws + OFF_W13B))
#define P_W2A ((bf16_t*)(p.ws + OFF_W2A))
#define P_W2B ((bf16_t*)(p.ws + OFF_W2B))
#define P_WINT ((bf16_t*)(p.ws + OFF_WINT))
#define P_WOUTT ((bf16_t*)(p.ws + OFF_WOUTT))
#define P_MOD ((float*)(p.ws + OFF_MOD))
#define P_SBON ((float*)(p.ws + OFF_SBON))
#define P_RH ((bf16_t*)(p.ws + OFF_RH))
#define P_RY ((bf16_t*)(p.ws + OFF_RY))
#define P_RU ((bf16_t*)(p.ws + OFF_RU))
#define P_ALORA ((bf16_t*)(p.ws + OFF_ALORA))

typedef __bf16 bf16x2_t __attribute__((ext_vector_type(2)));
__device__ __forceinline__ unsigned cvt_pk_bf16(float lo, float hi) {
  f32x2 v = {lo, hi};
  bf16x2_t b = __builtin_convertvector(v, bf16x2_t);
  return __builtin_bit_cast(unsigned, b);
}
__device__ __forceinline__ float bf_lo(unsigned u) { return __uint_as_float(u << 16); }
__device__ __forceinline__ float bf_hi(unsigned u) { return __uint_as_float(u & 0xffff0000u); }
__device__ __forceinline__ float bf2f(bf16_t b) { return __uint_as_float(((unsigned)b) << 16); }
__device__ __forceinline__ void unpack8(uint4 v, float* o) {
  o[0] = bf_lo(v.x); o[1] = bf_hi(v.x); o[2] = bf_lo(v.y); o[3] = bf_hi(v.y);
  o[4] = bf_lo(v.z); o[5] = bf_hi(v.z); o[6] = bf_lo(v.w); o[7] = bf_hi(v.w);
}
__device__ __forceinline__ uint4 pack8(const float* o) {
  uint4 v; v.x = cvt_pk_bf16(o[0], o[1]); v.y = cvt_pk_bf16(o[2], o[3]); v.z = cvt_pk_bf16(o[4], o[5]); v.w = cvt_pk_bf16(o[6], o[7]);
  return v;
}
__device__ __forceinline__ float sigmoidf_(float x) { return __builtin_amdgcn_rcpf(1.f + __expf(-x)); }
template <int CTRL> __device__ __forceinline__ float dpp_f(float x) {
  return __int_as_float(__builtin_amdgcn_update_dpp(0, __float_as_int(x), CTRL, 0xf, 0xf, false));
}
__device__ __forceinline__ float row16_sum(float x) {
  x += dpp_f<0x128>(x); x += dpp_f<0x124>(x); x += dpp_f<0x122>(x); x += dpp_f<0x121>(x);
  return x;
}
template <class T> __device__ __forceinline__ T sel(bool c, T a, T b) { return c ? a : b; }
__device__ __forceinline__ int opaque_tid_w(int wid) {
  int l;
  asm volatile("v_mbcnt_lo_u32_b32 %0, -1, 0\n\tv_mbcnt_hi_u32_b32 %0, -1, %0" : "=v"(l));
  return wid * 64 + l;
}
#define opaque_tid() opaque_tid_w(wid_u)
__device__ __forceinline__ float wave_sum(float v) {
  v = row16_sum(v);
  const float a = __int_as_float(__builtin_amdgcn_readlane(__float_as_int(v), 0)), b = __int_as_float(__builtin_amdgcn_readlane(__float_as_int(v), 16));
  const float c = __int_as_float(__builtin_amdgcn_readlane(__float_as_int(v), 32)), d = __int_as_float(__builtin_amdgcn_readlane(__float_as_int(v), 48));
  return (a + b) + (c + d);
}
__device__ __forceinline__ float quad_sum(float x) { x += dpp_f<0xB1>(x); x += dpp_f<0x4E>(x); return x; }
__device__ __forceinline__ int seq_start(int s) { return s < 8 ? s * 4096 : NPROMPT + (s - 8) * 8192; }
__device__ __forceinline__ void row_seq(int row, int& s, int& t, int& T) {
  if (row < NPROMPT) { s = row >> 12; t = row & 4095; T = 4096; }
  else { int r = row - NPROMPT; s = 8 + (r >> 13); t = r & 8191; T = 8192; }
}

__device__ __forceinline__ void tr_tile(const float* __restrict__ src, int ldsrc, int k0, int n0, int nvalid, bf16_t* __restrict__ dst, int ldd,
                        int kdst0, int mode, float* sm, const int tid) {
#pragma unroll
  for (int i = 0; i < 2; ++i) {
    const int r = (tid >> 4) + 32 * i, c = (tid & 15) * 4;
    float4 v = make_float4(0.f, 0.f, 0.f, 0.f);
    if (n0 + c < nvalid) v = *(const float4*)(src + (size_t)(k0 + r) * ldsrc + n0 + c);
    float* d = sm + r * 65 + c;
    d[0] = v.x; d[1] = v.y; d[2] = v.z; d[3] = v.w;
  }
  __syncthreads();
  {
    const int n = tid >> 3, kc = (tid & 7) * 8;
    float o[8];
#pragma unroll
    for (int j = 0; j < 8; ++j) o[j] = sm[(kc + j) * 65 + n];
    int nn = n0 + n, drow;
    const int c32 = nn & 31, slot = 16 * ((c32 >> 2) & 1) + 4 * (c32 >> 3) + (c32 & 3);
    if (mode == 0) drow = (nn & ~31) + slot;
    else drow = 256 * (nn >> 7) + (mode == 2 ? 128 : 0) + ((nn & 127) & ~31) + slot;
    *(uint4*)(dst + (size_t)drow * ldd + kdst0 + k0 + kc) = pack8(o);
  }
  __syncthreads();
}

__device__ __forceinline__ void prep_phase(PREF p, char* smem, const int wid_u) {
  float* sm = (float*)smem;
  const int tid = opaque_tid();
  constexpr int N_MOD = 144, N_EFF = 128, N_W13 = 4 * 704, N_W2 = 2 * 704, N_WIN = 640, N_WOUT = 128;
  constexpr int TOTAL = N_MOD + N_EFF + N_W13 + N_W2 + N_WIN + N_WOUT;
  for (int item = blockIdx.x; item < TOTAL; item += gridDim.x) {
    int it = item;
    if (it < N_MOD) {
      const int j0 = it * 64;
      float* sc = sm;
      float* red = sm + 16384;
      for (int idx = tid; idx < 16384; idx += NTHR) {
        const int s = idx >> 10, k = idx & 1023;
        const float* cp_ = p.c_prompt; const float* cs_ = p.c_sample;
        const float c = s < 8 ? cp_[s * 1024 + k] : cs_[(s - 8) * 1024 + k];
        sc[idx] = c / (1.f + __expf(-c));
      }
      __syncthreads();
      const int col = tid & 63, kg = tid >> 6;
      float acc[16];
#pragma unroll
      for (int s = 0; s < 16; ++s) acc[s] = 0.f;
      for (int k = kg * 128; k < kg * 128 + 128; ++k) {
        const float w = p.ada_w[(size_t)k * 9216 + j0 + col];
#pragma unroll
        for (int s = 0; s < 16; ++s) acc[s] += sc[s * 1024 + k] * w;
      }
#pragma unroll
      for (int s = 0; s < 16; ++s) red[(kg * 16 + s) * 64 + col] = acc[s];
      __syncthreads();
      for (int o = tid; o < 1024; o += NTHR) {
        const int s = o >> 6, c2 = o & 63;
        float v = p.ada_b[j0 + c2];
#pragma unroll
        for (int g = 0; g < 8; ++g) v += red[(g * 16 + s) * 64 + c2];
        P_MOD[s * 9216 + j0 + c2] = v;
      }
      __syncthreads();
      continue;
    }
    it -= N_MOD;
    if (it < N_EFF) {
      const int g = it >> 5, itile = (it >> 4) & 1, ntile = it & 15;
      float* As = sm;
      float* Bs = sm + 64 * 129;
      for (int idx = tid; idx < 64 * 128; idx += NTHR) {
        const int i = idx >> 7, j = idx & 127;
        As[i * 129 + j] = p.pool_w[((size_t)g * 128 + itile * 64 + i) * 128 + j] * p.pool_scale[g * 128 + j];
      }
      for (int idx = tid; idx < 128 * 64; idx += NTHR) {
        const int j = idx >> 6, nn = idx & 63;
        Bs[j * 65 + nn] = p.w_out[(size_t)(g * 128 + j) * 1024 + ntile * 64 + nn];
      }
      __syncthreads();
      const int i = tid >> 3, nn0 = (tid & 7) * 8;
      float acc[8];
#pragma unroll
      for (int q = 0; q < 8; ++q) acc[q] = 0.f;
      for (int j = 0; j < 128; ++j) {
        const float a = As[i * 129 + j];
#pragma unroll
        for (int q = 0; q < 8; ++q) acc[q] += a * Bs[j * 65 + nn0 + q];
      }
#pragma unroll
      for (int q = 0; q < 8; ++q)
      {
        const int nn = ntile * 64 + nn0 + q, c32 = nn & 31, slot = 16 * ((c32 >> 2) & 1) + 4 * (c32 >> 3) + (c32 & 3);
        P_WOUTT[(size_t)((nn & ~31) + slot) * 1024 + g * 128 + itile * 64 + i] = (bf16_t)(cvt_pk_bf16(acc[q], 0.f) & 0xffff);
      }
      __syncthreads();
      continue;
    }
    it -= N_EFF;
    if (it < N_W13) {
      const int which = it / 704, r = it % 704;
      const int kt = r / 44, ntl = r % 44;
      const float* src = sel(which < 2, sel(which == 0, p.f1_w1, p.f1_w3), sel(which == 2, p.f2_w1, p.f2_w3));
      bf16_t* dst = sel(which < 2, P_W13A, P_W13B);
      tr_tile(src, FF, kt * 64, ntl * 64, FF, dst, D, 0, (which & 1) ? 2 : 1, sm, tid);
      continue;
    }
    it -= N_W13;
    if (it < N_W2) {
      const int which = it / 704, r = it % 704;
      const int kt = r / 16, ntl = r % 16;
      tr_tile(sel(which != 0, p.f2_w2, p.f1_w2), D, kt * 64, ntl * 64, D, sel(which != 0, P_W2B, P_W2A), FF, 0, 0, sm, tid);
      continue;
    }
    it -= N_W2;
    if (it < N_WIN) {
      const int kt = it / 40, ntl = it % 40;
      tr_tile(p.w_in, PINW, kt * 64, ntl * 64, PINW, P_WINT, D, 0, 0, sm, tid);
      continue;
    }
    it -= N_WIN;
    {
      const int kt = it / 16, ntl = it % 16;
      tr_tile(p.w_out + (size_t)512 * 1024, D, kt * 64, ntl * 64, D, P_WOUTT, D, 512, 0, sm, tid);
    }
  }
}

template <int MODE>
__device__ __forceinline__ void row_phase(const float* __restrict__ xp, const float* __restrict__ xs, float* __restrict__ xout,
                          const bf16_t* __restrict__ y, bf16_t* __restrict__ h, const float* __restrict__ mod,
                          const float* __restrict__ npost, const float* __restrict__ npre, int gate_idx, float cgate, int shift_idx, const int wid_u) {
  const int tid_ = opaque_tid();
  const int lane = tid_ & 63;
  const int gw = blockIdx.x * 8 + (tid_ >> 6), GW = gridDim.x * 8;
  for (int chunk = gw; chunk < NTOK / 16; chunk += GW) {
    const int row0 = chunk * 16;
    int s, t, T;
    row_seq(row0, s, t, T);
    const float* md = mod + s * 9216;
    f32x4 Am[4], Bm[4], Gm[4];
#pragma unroll
    for (int i = 0; i < 4; ++i) {
      const int c = i * 256 + lane * 4;
      if (MODE != 2) {
        f32x4 np = *(const f32x4*)(npre + c), sc = *(const f32x4*)(md + (shift_idx + 1) * 1024 + c);
        Am[i] = np * (sc + 1.f);
        Bm[i] = *(const f32x4*)(md + shift_idx * 1024 + c);
      }
      if (MODE != 0) {
        f32x4 g = *(const f32x4*)(md + gate_idx * 1024 + c), po = *(const f32x4*)(npost + c);
        Gm[i] = g * po * cgate;
      }
    }
    for (int r = 0; r < 16; ++r) {
      const int row = row0 + r;
      const float* xr = (row < NPROMPT) ? xp + (size_t)row * D : xs + (size_t)(row - NPROMPT) * D;
      f32x4 xv[4];
#pragma unroll
      for (int i = 0; i < 4; ++i) xv[i] = *(const f32x4*)(xr + i * 256 + lane * 4);
      if (MODE != 0) {
        f32x4 yv[4];
        float ss = 0.f;
#pragma unroll
        for (int i = 0; i < 4; ++i) {
          uint2 u = *(const uint2*)(y + (size_t)row * D + i * 256 + lane * 4);
          yv[i] = (f32x4){bf_lo(u.x), bf_hi(u.x), bf_lo(u.y), bf_hi(u.y)};
          ss += yv[i][0] * yv[i][0] + yv[i][1] * yv[i][1] + yv[i][2] * yv[i][2] + yv[i][3] * yv[i][3];
        }
        ss = wave_sum(ss);
        const float rs = rsqrtf(ss * (1.f / 1024.f) + 1e-6f);
#pragma unroll
        for (int i = 0; i < 4; ++i) {
          xv[i] = xv[i] + Gm[i] * yv[i] * rs;
          *(f32x4*)(xout + (size_t)row * D + i * 256 + lane * 4) = xv[i];
        }
      }
      if (MODE != 2) {
        float ss = 0.f;
#pragma unroll
        for (int i = 0; i < 4; ++i) ss += xv[i][0] * xv[i][0] + xv[i][1] * xv[i][1] + xv[i][2] * xv[i][2] + xv[i][3] * xv[i][3];
        ss = wave_sum(ss);
        const float rs = rsqrtf(ss * (1.f / 1024.f) + 1e-6f);
#pragma unroll
        for (int i = 0; i < 4; ++i) {
          f32x4 hv = xv[i] * rs * Am[i] + Bm[i];
          uint2 u; u.x = cvt_pk_bf16(hv[0], hv[1]); u.y = cvt_pk_bf16(hv[2], hv[3]);
          *(uint2*)(h + (size_t)row * D + i * 256 + lane * 4) = u;
        }
      }
    }
  }
}

constexpr int BM = 256, BK = 64, HALF = 128, NXCD = 8, WGM = 8, HT = HALF * BK;
__device__ __forceinline__ int lds_byte(int r, int c) {
  int st = (r >> 4) * 2 + (c >> 5), rr = r & 15, cc = c & 31, ob = rr * 64 + cc * 2;
  return st * 1024 + (ob ^ (((ob >> 9) & 1) << 5));
}
__device__ __forceinline__ void stage_rc(int b, int& R, int& C) {
  int st = b / 1024, sb = b % 1024, swz = sb ^ (((sb >> 9) & 1) << 5);
  R = (st >> 1) * 16 + swz / 64; C = (st & 1) * 32 + (swz % 64) / 2;
}

__device__ __forceinline__ bool gemm_unit(int i, int nM, int nN, int nwg, int& pm, int& pn) {
  const long L = (long)i * gridDim.x + blockIdx.x;
  if (L >= nwg) return false;
  int wgid = (int)L;
  { int q = nwg / NXCD, r = nwg % NXCD, xcd = wgid % NXCD, off = wgid / NXCD;
    wgid = (xcd < r ? xcd * (q + 1) : r * (q + 1) + (xcd - r) * q) + off; }
  const int nig = WGM * nN, gid = wgid / nig, fm = gid * WGM, gsz = min(nM - fm, WGM);
  pm = fm + ((wgid % nig) % gsz); pn = (wgid % nig) / gsz;
  return true;
}

__device__ __forceinline__ void gemm_phase(const bf16_t* __restrict__ A, const bf16_t* __restrict__ Bt, bf16_t* __restrict__ C, int M, int N, int K,
                                           int ldc, const int EPI, char* smem, const int wid_u) {
  const int nM = M / BM, nN = N / BM, nwg = nM * nN;
  const int tid = opaque_tid();
  LAS bf16_t* shm = (LAS bf16_t*)smem;
#define SA(b, h) (shm + ((b) * 2 + (h)) * HT)
#define SB(b, h) (shm + (4 + (b) * 2 + (h)) * HT)
#define STG(P, GB) do { const char* _gb = (GB); \
    _Pragma("unroll") for (int _i = 0; _i < 2; ++_i) { \
      __builtin_amdgcn_global_load_lds((const unsigned*)(_gb + voff[_i]), \
        (LAS unsigned*)((LAS char*)(P) + ldsw + _i * 8192), 16, 0, 0); } } while (0)
#define LDA(dst, b, h) _Pragma("unroll") for (int m = 0; m < 4; ++m) _Pragma("unroll") for (int k = 0; k < 2; ++k) \
    dst[m][k] = *(const LAS bf16x8*)((LAS char*)SA(b, h) + aoff + m * 2048 + k * 1024)
#define LDB(dst, b, h) _Pragma("unroll") for (int n = 0; n < 2; ++n) _Pragma("unroll") for (int k = 0; k < 2; ++k) \
    dst[n][k] = *(const LAS bf16x8*)((LAS char*)SB(b, h) + boff + n * 2048 + k * 1024)
#define MMA(ai, bj, At_, Bt_) do { __builtin_amdgcn_s_setprio(1); \
    _Pragma("unroll") for (int m = 0; m < 4; ++m) _Pragma("unroll") for (int n = 0; n < 2; ++n) _Pragma("unroll") for (int k = 0; k < 2; ++k) \
      acc[ai][bj][m][n] = __builtin_amdgcn_mfma_f32_16x16x32_bf16(Bt_[n][k], At_[m][k], acc[ai][bj][m][n], 0, 0, 0); \
    __builtin_amdgcn_s_setprio(0); } while (0)
#define WAIT_V(n) asm volatile("s_waitcnt vmcnt(" #n ")" ::: "memory")
#define WAIT_L(n) asm volatile("s_waitcnt lgkmcnt(" #n ")" ::: "memory")
#define BAR __builtin_amdgcn_s_barrier()
#define SCHED __builtin_amdgcn_sched_barrier(0)
  const int wid = __builtin_amdgcn_readfirstlane(tid >> 6), lane = tid & 63, wr = wid >> 2, wc = wid & 3, fr = lane & 15, fq = lane >> 4;
  const int aoff = lds_byte(wr * 64 + fr, fq * 8), boff = lds_byte(wc * 32 + fr, fq * 8);
  unsigned voff[2];
  const int ldsw = wid * 1024;
#pragma unroll
  for (int _i = 0; _i < 2; ++_i) { int _r, _c; stage_rc(tid * 16 + _i * 8192, _r, _c); voff[_i] = (unsigned)(_r * K + _c) * 2u; }
  const int nt = K / BK;
  const size_t kstep = (size_t)BK * 2, hstep = (size_t)HALF * K * 2, tstep = 2 * hstep;
  int pm, pn, npm = 0, npn = 0, ui = 0;
  if (!gemm_unit(0, nM, nN, nwg, pm, pn)) return;
  f32x4 acc[2][2][4][2];
#pragma unroll
  for (int a = 0; a < 2; ++a)
#pragma unroll
    for (int b = 0; b < 2; ++b)
#pragma unroll
      for (int m = 0; m < 4; ++m)
#pragma unroll
        for (int n = 0; n < 2; ++n) acc[a][b][m][n] = (f32x4){0.f, 0.f, 0.f, 0.f};
  bf16x8 At[4][2], B0[2][2], B1[2][2];
  const char* cA = (const char*)A + (size_t)pm * tstep;
  const char* cB = (const char*)Bt + (size_t)pn * tstep;
  STG(SB(0, 0), cB); STG(SA(0, 0), cA); STG(SB(0, 1), cB + hstep); STG(SA(0, 1), cA + hstep);
  if (wr == 1) BAR;
  WAIT_V(4); BAR;
  STG(SB(1, 0), cB + kstep); STG(SA(1, 0), cA + kstep); STG(SB(1, 1), cB + hstep + kstep);
  WAIT_V(6); BAR;
  for (;;) {
    const bool has_next = gemm_unit(ui + 1, nM, nN, nwg, npm, npn);
    const char* nA = has_next ? (const char*)A + (size_t)npm * tstep : cA;
    const char* nB = has_next ? (const char*)Bt + (size_t)npn * tstep : cB;
    for (int t = 0; t < nt; t += 2) {
      const bool last = (t == nt - 2);
      const char* a1 = cA + (size_t)(t + 1) * kstep;
      const char* a2 = last ? nA : cA + (size_t)(t + 2) * kstep;
      const char* b2 = last ? nB : cB + (size_t)(t + 2) * kstep;
      const char* a3 = a2 + kstep;
      const char* b3 = b2 + kstep;
      LDB(B0, 0, 0); SCHED; LDA(At, 0, 0); STG(SA(1, 1), a1 + hstep);
      WAIT_L(8); BAR; WAIT_L(0); MMA(0, 0, At, B0); BAR; SCHED;
      LDB(B1, 0, 1); STG(SB(0, 0), b2);
      BAR; WAIT_L(0); MMA(0, 1, At, B1); BAR;
      LDA(At, 0, 1); STG(SA(0, 0), a2);
      BAR; WAIT_L(0); MMA(1, 0, At, B0); BAR; SCHED;
      STG(SB(0, 1), b2 + hstep);
      WAIT_V(6); BAR; MMA(1, 1, At, B1); BAR;
      LDB(B0, 1, 0); SCHED; LDA(At, 1, 0); STG(SA(0, 1), a2 + hstep);
      WAIT_L(8); BAR; WAIT_L(0); MMA(0, 0, At, B0); BAR; SCHED;
      LDB(B1, 1, 1); STG(SB(1, 0), b3);
      BAR; WAIT_L(0); MMA(0, 1, At, B1); BAR;
      LDA(At, 1, 1); STG(SA(1, 0), a3);
      BAR; WAIT_L(0); MMA(1, 0, At, B0); BAR; SCHED;
      STG(SB(1, 1), b3 + hstep);
      WAIT_V(6); BAR; MMA(1, 1, At, B1); BAR;
    }
    {
      const int brow = pm * BM, bcol = pn * BM;
#pragma unroll
      for (int ai = 0; ai < 2; ++ai)
#pragma unroll
        for (int m = 0; m < 4; ++m) {
          const size_t row = (size_t)(brow + ai * HALF + wr * 64 + m * 16 + fr);
          if (EPI == 0) {
#pragma unroll
            for (int bj = 0; bj < 2; ++bj) {
              const f32x4 v0 = acc[ai][bj][m][0], v1 = acc[ai][bj][m][1];
              uint4 u; u.x = cvt_pk_bf16(v0[0], v0[1]); u.y = cvt_pk_bf16(v0[2], v0[3]); u.z = cvt_pk_bf16(v1[0], v1[1]); u.w = cvt_pk_bf16(v1[2], v1[3]);
              *(uint4*)(C + row * ldc + bcol + bj * HALF + wc * 32 + fq * 8) = u;
            }
          } else {
            float o[8];
#pragma unroll
            for (int n = 0; n < 2; ++n) {
              const f32x4 a = acc[ai][0][m][n], b = acc[ai][1][m][n];
#pragma unroll
              for (int j = 0; j < 4; ++j) o[n * 4 + j] = a[j] * __builtin_amdgcn_rcpf(1.f + __expf(-a[j])) * b[j];
            }
            *(uint4*)(C + row * ldc + (bcol >> 1) + wc * 32 + fq * 8) = pack8(o);
          }
        }
    }
    if (!has_next) break;
#pragma unroll
    for (int a = 0; a < 2; ++a)
#pragma unroll
      for (int b = 0; b < 2; ++b)
#pragma unroll
        for (int m = 0; m < 4; ++m)
#pragma unroll
          for (int n = 0; n < 2; ++n) acc[a][b][m][n] = (f32x4){0.f, 0.f, 0.f, 0.f};
    pm = npm; pn = npn; cA = nA; cB = nB; ++ui;
  }
  WAIT_V(0);
  if (wr == 0) BAR;
  BAR;
#undef SA
#undef SB
#undef STG
#undef LDA
#undef LDB
#undef MMA
}

__device__ __forceinline__ void load_shift16(const bf16_t* __restrict__ z, int row, int t, int T, int col, const float* __restrict__ mu, float* o) {
  const bf16_t* pz = z + (size_t)row * ZLD + col;
  uint4 c0 = *(const uint4*)pz, c1 = *(const uint4*)(pz + 8);
  uint4 p0 = make_uint4(0, 0, 0, 0), p1 = p0, n0 = p0, n1 = p0;
  if (t > 0) { p0 = *(const uint4*)(pz - ZLD); p1 = *(const uint4*)(pz - ZLD + 8); }
  if (t < T - 1) { n0 = *(const uint4*)(pz + ZLD); n1 = *(const uint4*)(pz + ZLD + 8); }
  float c[16], pv[16], nx[16];
  unpack8(c0, c); unpack8(c1, c + 8); unpack8(p0, pv); unpack8(p1, pv + 8); unpack8(n0, nx); unpack8(n1, nx + 8);
#pragma unroll
  for (int q = 0; q < 16; ++q) o[q] = c[q] + (0.5f * (pv[q] + nx[q]) - c[q]) * mu[col - 512 + q];
}
__device__ __forceinline__ void load_shift8(const bf16_t* __restrict__ z, int row, int t, int T, int col, const float* __restrict__ mu, float* o) {
  const bf16_t* pz = z + (size_t)row * ZLD + col;
  uint4 c0 = *(const uint4*)pz;
  uint4 p0 = make_uint4(0, 0, 0, 0), n0 = p0;
  if (t > 0) p0 = *(const uint4*)(pz - ZLD);
  if (t < T - 1) n0 = *(const uint4*)(pz + ZLD);
  float c[8], pv[8], nx[8];
  unpack8(c0, c); unpack8(p0, pv); unpack8(n0, nx);
#pragma unroll
  for (int q = 0; q < 8; ++q) o[q] = c[q] + (0.5f * (pv[q] + nx[q]) - c[q]) * mu[col - 512 + q];
}

constexpr int TC = 32;
constexpr int SV = TC * 64;
__device__ __forceinline__ void lora_prep_phase(PREF p, const int wid_u) {
  const int tid = opaque_tid();
  const bf16_t* z = P_RU;
  bf16_t* al = P_ALORA;
  const float* mu = p.shift_mu;
  for (int task = blockIdx.x * NTHR + tid; task < NTOK * 32; task += gridDim.x * NTHR) {
    const int row = task >> 5, oc = task & 31;
    int s, t, T;
    row_seq(row, s, t, T);
    float o[8];
    load_shift8(z, row, t, T, 2048 + oc * 8, mu, o);
    if (oc < 16) {
#pragma unroll
      for (int q = 0; q < 8; ++q) { const float e = __expf(2.f * o[q]); o[q] = 1.f - 2.f * __builtin_amdgcn_rcpf(e + 1.f); }
    }
    *(uint4*)(al + (size_t)row * 256 + oc * 8) = pack8(o);
  }
}

template <int HALF>
__device__ __forceinline__ void pool_seg(const bf16_t* __restrict__ z, bf16_t* __restrict__ mo, int row_base, int tbase, int T, int c0) {
  constexpr int NR = 2 * HALF + 3;
  float acc[4][8], zc[4][8];
#pragma unroll
  for (int i = 0; i < 4; ++i)
#pragma unroll
    for (int q = 0; q < 8; ++q) { acc[i][q] = 0.f; zc[i][q] = 0.f; }
#pragma unroll
  for (int r = 0; r < NR; ++r) {
    const int tt = tbase - HALF + r;
    uint4 u = make_uint4(0, 0, 0, 0);
    if (tt >= 0 && tt < T) u = *(const uint4*)(z + (size_t)(row_base - HALF + r) * ZLD + c0);
    float v[8];
    unpack8(u, v);
#pragma unroll
    for (int i = 0; i < 4; ++i) {
      if (r >= i && r < i + 2 * HALF) {
#pragma unroll
        for (int q = 0; q < 8; ++q) acc[i][q] += v[q];
      }
      if (r == HALF + i) {
#pragma unroll
        for (int q = 0; q < 8; ++q) zc[i][q] = v[q];
      }
    }
  }
#pragma unroll
  for (int i = 0; i < 4; ++i) {
    const int ti = tbase + i;
    const float ic = 1.f / (float)(min(ti + HALF, T) - max(ti - HALF, 0));
    float o[8];
#pragma unroll
    for (int q = 0; q < 8; ++q) o[q] = acc[i][q] * ic - zc[i][q];
    *(uint4*)(mo + (size_t)(row_base + i) * D + c0) = pack8(o);
  }
}
__device__ __forceinline__ void pool_tile(const bf16_t* __restrict__ z, bf16_t* __restrict__ mo, int tile, int tid) {
  const int row0 = tile * 32;
  int s, t0, T;
  row_seq(row0, s, t0, T);
  const int oc = tid >> 3, seg = tid & 7, c0 = oc * 8, grp = __builtin_amdgcn_readfirstlane(oc >> 4);
  const int rb = row0 + seg * 4, tb = t0 + seg * 4;
  if (grp == 0) pool_seg<1>(z, mo, rb, tb, T, c0);
  else if (grp == 1) pool_seg<2>(z, mo, rb, tb, T, c0);
  else if (grp == 2) pool_seg<4>(z, mo, rb, tb, T, c0);
  else pool_seg<8>(z, mo, rb, tb, T, c0);
}

struct Raw16 { uint4 c0, c1, p0, p1, n0, n1; };
__device__ __forceinline__ void load_raw16(Raw16& r, const bf16_t* __restrict__ z, int row, int t, int T, int col) {
  const bf16_t* pz = z + (unsigned)(row * ZLD + col);
  r.c0 = *(const uint4*)pz; r.c1 = *(const uint4*)(pz + 8);
  r.p0 = make_uint4(0, 0, 0, 0); r.p1 = r.p0; r.n0 = r.p0; r.n1 = r.p0;
  if (t > 0) { r.p0 = *(const uint4*)(pz - ZLD); r.p1 = *(const uint4*)(pz - ZLD + 8); }
  if (t < T - 1) { r.n0 = *(const uint4*)(pz + ZLD); r.n1 = *(const uint4*)(pz + ZLD + 8); }
}
__device__ __forceinline__ void shift16(const Raw16& r, const float* c1, const float* c2, float* o) {
  float c[16], pv[16], nx[16];
  unpack8(r.c0, c); unpack8(r.c1, c + 8); unpack8(r.p0, pv); unpack8(r.p1, pv + 8); unpack8(r.n0, nx); unpack8(r.n1, nx + 8);
#pragma unroll
  for (int q = 0; q < 16; ++q) o[q] = c[q] * c1[q] + (pv[q] + nx[q]) * c2[q];
}
__device__ __forceinline__ bf16x8 ldfrag(const bf16_t* base, int stride, int row0, int k0, int fr, int fq) {
  return *reinterpret_cast<const bf16x8*>(base + (row0 + fr) * stride + k0 + fq * 8);
}
__device__ __forceinline__ uint2 pack4(f32x4 v) { uint2 u; u.x = cvt_pk_bf16(v[0], v[1]); u.y = cvt_pk_bf16(v[2], v[3]); return u; }
#define MFMA16(a, b, c) __builtin_amdgcn_mfma_f32_16x16x32_bf16(a, b, c, 0, 0, 0)

constexpr int CS_NAB = 0, CS_NAK = 4096, CS_NBRT = 8192, CS_NKRT = 10752, CS_QT = 13312, CS_W = 15872, CS_Z = 20992, CS_GT = 26112,
              CS_RYT = 35328, CS_VN = 39936;
constexpr int CS_AT = 49152, CS_RT = CS_AT + 4608, CS_BT = CS_RT + 4608, CS_KT = CS_BT + 4608, CS_BB = 67584, CS_KB = CS_BB + 5120,
              CS_VT = CS_KB + 5120, CS_ATT = 82944, CS_PL = 92160, CS_SBF = 92416, CS_PRIV = 110848, CS_CST = 143616, CS_BL = 145920;

__device__ __forceinline__ void lds_barrier() {
  asm volatile("s_waitcnt lgkmcnt(0)" ::: "memory");
  __builtin_amdgcn_s_barrier();
  asm volatile("" ::: "memory");
}
template <int Q> __device__ __forceinline__ float quad_bcast(float x) { return dpp_f<Q * 0x55>(x); }

template <int S0> __device__ __forceinline__ void solve_steps(float (&x)[8], const float* nab, int seg) {
  if constexpr (S0 < 32) {
    const float xs = quad_bcast<(S0 >> 3)>(x[S0 & 7]);
    const f32x4 n0 = *(const f32x4*)(nab + S0 * 32 + seg * 8), n1 = *(const f32x4*)(nab + S0 * 32 + seg * 8 + 4);
    x[0] += xs * n0[0]; x[1] += xs * n0[1]; x[2] += xs * n0[2]; x[3] += xs * n0[3];
    x[4] += xs * n1[0]; x[5] += xs * n1[1]; x[6] += xs * n1[2]; x[7] += xs * n1[3];
    solve_steps<S0 + 1>(x, nab, seg);
  }
}

template <int S0> __device__ __forceinline__ void solve16(float (&x)[8], const float* nb) {
  if constexpr (S0 < 16) {
    const float xs = (S0 >> 3) ? dpp_f<0xF5>(x[S0 & 7]) : dpp_f<0xA0>(x[S0 & 7]);
    const f32x4 n0 = *(const f32x4*)(nb + S0 * 32), n1 = *(const f32x4*)(nb + S0 * 32 + 4);
    x[0] += xs * n0[0]; x[1] += xs * n0[1]; x[2] += xs * n0[2]; x[3] += xs * n0[3];
    x[4] += xs * n1[0]; x[5] += xs * n1[1]; x[6] += xs * n1[2]; x[7] += xs * n1[3];
    solve16<S0 + 1>(x, nb);
  }
}

__device__ __forceinline__ void scan_phase(PREF p, char* smem, const int wid_u) {
  float* stepbuf = (float*)smem;
  float* Nab = (float*)(smem + CS_NAB);
  bf16_t* NakT = (bf16_t*)(smem + CS_NAK);
  bf16_t* VNb = (bf16_t*)(smem + CS_VN);
  bf16_t* T11b = (bf16_t*)(smem + CS_VN + 5120);
  bf16_t* M1T = (bf16_t*)(smem + CS_VN + 5120 + 1280);
  bf16_t* NbrT = (bf16_t*)(smem + CS_NBRT);
  bf16_t* NkrT = (bf16_t*)(smem + CS_NKRT);
  bf16_t* TT = (bf16_t*)(smem + CS_QT);
  bf16_t* Wb = (bf16_t*)(smem + CS_W);
  bf16_t* Zb = (bf16_t*)(smem + CS_Z);
  bf16_t* GT = (bf16_t*)(smem + CS_GT);
  bf16_t* RyT = (bf16_t*)(smem + CS_RYT);
  bf16_t* At = (bf16_t*)(smem + CS_AT);
  bf16_t* Rt = (bf16_t*)(smem + CS_RT);
  bf16_t* Bt = (bf16_t*)(smem + CS_BT);
  bf16_t* Kt = (bf16_t*)(smem + CS_KT);
  bf16_t* Bb = (bf16_t*)(smem + CS_BB);
  bf16_t* Kb = (bf16_t*)(smem + CS_KB);
  bf16_t* VT = (bf16_t*)(smem + CS_VT);
  bf16_t* AtTb = (bf16_t*)(smem + CS_ATT);
  float* PLs = (float*)(smem + CS_PL);
  bf16_t* Sbf = (bf16_t*)(smem + CS_SBF);
  float* cst = (float*)(smem + CS_CST);
  const bf16_t* z = P_RU;
  const int tid = opaque_tid();
  const int wave = __builtin_amdgcn_readfirstlane(tid >> 6), lane = tid & 63, fr = lane & 15, fq = lane >> 4;
  const int item = blockIdx.x;
  if (item < 256) {
    const int s = item < 128 ? 8 + (item >> 4) : ((item - 128) >> 4);
    const int h = (item & 15) >> 1, d = item & 1;
    const int T = s < 8 ? 4096 : 8192, r0seq = seq_start(s), nch = T / 32;
    bf16_t* yout = P_RY + (size_t)d * NTOK * 512;
    {
      const int g = tid >> 6, k = tid & 63;
      const float muk = p.shift_mu[1024 - 512 + h * 64 + k], mur = p.shift_mu[512 - 512 + h * 64 + k], muv = p.shift_mu[1536 - 512 + h * 64 + k];
      float v;
      if (g == 0) v = 0.5f * muk;
      else if (g == 1) v = 0.5f * mur;
      else if (g == 2) v = 1.f - muk;
      else if (g == 3) v = 1.f - mur;
      else if (g == 4) v = 1.f - muv;
      else if (g == 5) v = p.k_k[h * 64 + k];
      else if (g == 6) v = p.k_a[h * 64 + k];
      else v = p.r_k[h * 64 + k];
      cst[g * 64 + k] = v;
      if (g == 0) cst[8 * 64 + k] = 0.5f * muv;
      for (int i = tid; i < 2 * 64 * 72 / 2; i += NTHR) ((unsigned*)Sbf)[i] = 0u;
    }
    const int role = wave >> 1, th = wave & 1;
    const int tl = lane >> 2, cq = lane & 3;
    float* tmpa = (float*)(smem + CS_PRIV + (wave & 3) * 8192 + 2560);
    uint4* Blds = (uint4*)(smem + CS_BL) + (role & 1) * 512;
    float bias[4] = {0.f, 0.f, 0.f, 0.f};
    if (role < 2) {
      const float* lsrc = sel(role != 0, p.a2, p.w2) + (size_t)d * 64 * 512 + h * 64;
      if (th == 0) {
#pragma unroll
        for (int nt = 0; nt < 4; ++nt)
#pragma unroll
          for (int ks = 0; ks < 2; ++ks) {
            float o[8];
#pragma unroll
            for (int q = 0; q < 8; ++q) o[q] = lsrc[(size_t)(ks * 32 + fq * 8 + q) * 512 + nt * 16 + fr];
            Blds[(nt * 2 + ks) * 64 + lane] = pack8(o);
          }
      }
#pragma unroll
      for (int nt = 0; nt < 4; ++nt) bias[nt] = sel(role != 0, p.a0, p.w0)[d * 512 + h * 64 + nt * 16 + fr];
    }
    const int colA = 512 + h * 64 + cq * 16;
    const int colB = (role == 1 ? 1024 : 1536) + h * 64 + cq * 16;
    const int alo = (role == 0 ? d * 64 : 128 + d * 64) + fq * 8;
    Raw16 ra, rb;
    {
      const int j = th * 16 + tl, t = d ? T - 1 - j : j, row = r0seq + t;
      if (role == 2) load_raw16(ra, z, row, t, T, colA);
      if (role == 1 || role == 2) load_raw16(rb, z, row, t, T, colB);
      if (role < 2) {
        const int j2 = th * 16 + fr, t2 = d ? T - 1 - j2 : j2;
        const bf16_t* ap = P_ALORA + (unsigned)((r0seq + t2) * 256 + alo);
        ra.c0 = *(const uint4*)ap; ra.c1 = *(const uint4*)(ap + 32);
      }
    }
    f32x4 Sa = {0.f, 0.f, 0.f, 0.f}, Sb = Sa;
    uint2 y_def = make_uint2(0u, 0u);
    float sb_def = 0.f;
    const int mt = wave >> 1, hn = wave & 1, nt0 = 2 * hn, nt1 = 2 * hn + 1;
    __syncthreads();

    for (int c = 0; c < nch; ++c) {
      if (role < 3) {
        const int j = th * 16 + tl;
        const int istep = c * 32 + j;
        const int t = d ? T - 1 - istep : istep;
        const int row = r0seq + t;
        float v16[16];
        if (role < 2) {
          f32x4 acc[4] = {};
#pragma unroll
          for (int ks = 0; ks < 2; ++ks) {
            const uint4 au = ks == 0 ? ra.c0 : ra.c1;
            const bf16x8 a = *reinterpret_cast<const bf16x8*>(&au);
#pragma unroll
            for (int nt = 0; nt < 4; ++nt) { const uint4 bu = Blds[(nt * 2 + ks) * 64 + lane]; acc[nt] = MFMA16(a, *reinterpret_cast<const bf16x8*>(&bu), acc[nt]); }
          }
          if (role == 0) {
#pragma unroll
            for (int nt = 0; nt < 4; ++nt)
#pragma unroll
              for (int jj = 0; jj < 4; ++jj) {
                const float sg = sigmoidf_(bias[nt] + acc[nt][jj]);
                stepbuf[0 * SV + (th * 16 + fq * 4 + jj) * 64 + nt * 16 + fr] = __expf(-0.6065306597126334f * sg);
              }
            __builtin_amdgcn_wave_barrier();
            {
              float wl[16];
#pragma unroll
              for (int i = 0; i < 16; ++i) wl[i] = stepbuf[0 * SV + (th * 16 + i) * 64 + lane];
              float pr = 1.f;
#pragma unroll
              for (int i = 0; i < 16; ++i) { pr *= wl[i]; stepbuf[0 * SV + (th * 16 + i) * 64 + lane] = pr; }
            }
          } else {
#pragma unroll
            for (int nt = 0; nt < 4; ++nt)
#pragma unroll
              for (int jj = 0; jj < 4; ++jj) tmpa[(fq * 4 + jj) * 68 + nt * 16 + fr] = sigmoidf_(bias[nt] + acc[nt][jj]);
            __builtin_amdgcn_wave_barrier();
            float av[16], kd[16];
#pragma unroll
            for (int q = 0; q < 4; ++q) { f32x4 a4 = *(const f32x4*)(tmpa + tl * 68 + cq * 16 + q * 4); av[q * 4] = a4[0]; av[q * 4 + 1] = a4[1]; av[q * 4 + 2] = a4[2]; av[q * 4 + 3] = a4[3]; }
            shift16(rb, cst + 2 * 64 + cq * 16, cst + 0 * 64 + cq * 16, v16);
            float kk[16], ss = 0.f;
#pragma unroll
            for (int q = 0; q < 16; ++q) { kk[q] = v16[q] * cst[5 * 64 + cq * 16 + q]; ss += kk[q] * kk[q]; }
            ss = quad_sum(ss);
            const float inv = 1.f / fmaxf(sqrtf(ss), 1e-12f);
#pragma unroll
            for (int q = 0; q < 16; ++q) { kk[q] *= inv; kd[q] = v16[q] * (1.f + (av[q] - 1.f) * cst[6 * 64 + cq * 16 + q]); }
#pragma unroll
            for (int q = 0; q < 4; ++q) {
              *(f32x4*)(stepbuf + 3 * SV + j * 64 + cq * 16 + q * 4) = (f32x4){-kk[q * 4], -kk[q * 4 + 1], -kk[q * 4 + 2], -kk[q * 4 + 3]};
              *(f32x4*)(stepbuf + 4 * SV + j * 64 + cq * 16 + q * 4) = (f32x4){kk[q * 4] * av[q * 4], kk[q * 4 + 1] * av[q * 4 + 1], kk[q * 4 + 2] * av[q * 4 + 2], kk[q * 4 + 3] * av[q * 4 + 3]};
              *(f32x4*)(stepbuf + 1 * SV + j * 64 + cq * 16 + q * 4) = (f32x4){kd[q * 4], kd[q * 4 + 1], kd[q * 4 + 2], kd[q * 4 + 3]};
            }
          }
        } else {
          shift16(ra, cst + 3 * 64 + cq * 16, cst + 1 * 64 + cq * 16, v16);
#pragma unroll
          for (int q = 0; q < 4; ++q) *(f32x4*)(stepbuf + 2 * SV + j * 64 + cq * 16 + q * 4) = (f32x4){v16[q * 4], v16[q * 4 + 1], v16[q * 4 + 2], v16[q * 4 + 3]};
          shift16(rb, cst + 4 * 64 + cq * 16, cst + 8 * 64 + cq * 16, v16);
#pragma unroll
          for (int q = 0; q < 4; ++q) *(f32x4*)(stepbuf + 5 * SV + j * 64 + cq * 16 + q * 4) = (f32x4){v16[q * 4], v16[q * 4 + 1], v16[q * 4 + 2], v16[q * 4 + 3]};
        }
      }
      if (c > 0) {
        const int ip = (c - 1) * 32 + hn * 16 + fr, tp = d ? T - 1 - ip : ip;
        *(uint2*)(yout + (size_t)(r0seq + tp) * 512 + h * 64 + mt * 16 + fq * 4) = y_def;
        if (role == 2 && cq == 0) { const int is_ = (c - 1) * 32 + th * 16 + tl, tg = d ? T - 1 - is_ : is_; P_SBON[((size_t)(r0seq + tg) * 8 + h) * 2 + d] = sb_def; }
      }
      if (role < 3 && c + 1 < nch) {
        const int is2 = (c + 1) * 32 + th * 16 + tl;
        const int t2 = d ? T - 1 - is2 : is2;
        const int row2 = r0seq + t2;
        if (role == 2) load_raw16(ra, z, row2, t2, T, colA);
        if (role >= 1) load_raw16(rb, z, row2, t2, T, colB);
        if (role < 2) {
          const int is3 = (c + 1) * 32 + th * 16 + fr, t3 = d ? T - 1 - is3 : is3;
          const bf16_t* ap = P_ALORA + (unsigned)((r0seq + t3) * 256 + alo);
          ra.c0 = *(const uint4*)ap; ra.c1 = *(const uint4*)(ap + 32);
        }
      }
      lds_barrier();
      {
        const int k = lane, seg = wave;
        const float* sw = stepbuf + 0 * SV + k;
        const float P15 = sw[15 * 64];
        const float hiF = seg >= 4 ? P15 : 1.f;
        float P[5];
        P[0] = seg == 0 ? 1.f : sw[(4 * seg - 1) * 64] * (seg > 4 ? P15 : 1.f);
#pragma unroll
        for (int i = 0; i < 4; ++i) P[i + 1] = sw[(4 * seg + i) * 64] * hiF;
        const float PL = sw[31 * 64] * P15;
        if (role == 2) {
          const int j = th * 16 + tl;
          float bs = 0.f;
#pragma unroll
          for (int q = 0; q < 16; ++q) bs += stepbuf[2 * SV + j * 64 + cq * 16 + q] * stepbuf[1 * SV + j * 64 + cq * 16 + q] * cst[7 * 64 + cq * 16 + q];
          bs = quad_sum(bs);
          sb_def = bs;
        }
        f32x4 bb, kb, at, vv;
#pragma unroll
        for (int i = 0; i < 4; ++i) {
          const int t = 4 * seg + i;
          const float inv = __builtin_amdgcn_rcpf(P[i + 1]);
          const float a_ = P[i] * stepbuf[3 * SV + t * 64 + k];
          const float rraw = stepbuf[2 * SV + t * 64 + k], kraw = stepbuf[1 * SV + t * 64 + k];
          const float r_ = P[i + 1] * rraw;
          const float b_ = stepbuf[4 * SV + t * 64 + k] * inv;
          const float k_ = kraw * inv;

          At[t * 72 + k] = (bf16_t)(cvt_pk_bf16(a_, 0.f) & 0xffff);
          Rt[t * 72 + k] = (bf16_t)(cvt_pk_bf16(r_, 0.f) & 0xffff);
          Bt[t * 72 + k] = (bf16_t)(cvt_pk_bf16(b_, 0.f) & 0xffff);
          Kt[t * 72 + k] = (bf16_t)(cvt_pk_bf16(k_, 0.f) & 0xffff);
          bb[i] = b_ * PL; kb[i] = k_ * PL; at[i] = a_;
          vv[i] = stepbuf[5 * SV + t * 64 + k];
        }
        *(uint2*)(Bb + k * 40 + 4 * seg) = pack4(bb);
        *(uint2*)(Kb + k * 40 + 4 * seg) = pack4(kb);
        *(uint2*)(VT + k * 40 + 4 * seg) = pack4(vv);
        *(uint2*)(AtTb + k * 40 + 4 * seg) = pack4(at);
        if (seg == 0) PLs[k] = PL;
      }
      lds_barrier();
      {
        const int mat = wave >> 1, mts = wave & 1;
        const bf16_t* As = (mat & 1) ? Kt : Bt;
        const bf16_t* Bs = (mat & 2) ? Rt : At;
        f32x4 acc[2] = {};
#pragma unroll
        for (int ks = 0; ks < 2; ++ks) {
          const bf16x8 a = ldfrag(As, 72, mts * 16, ks * 32, fr, fq);
#pragma unroll
          for (int nt = 0; nt < 2; ++nt) acc[nt] = MFMA16(a, ldfrag(Bs, 72, nt * 16, ks * 32, fr, fq), acc[nt]);
        }
#pragma unroll
        for (int nt = 0; nt < 2; ++nt) {
          const int tcol = nt * 16 + fr;
          f32x4 v = acc[nt];
#pragma unroll
          for (int jj = 0; jj < 4; ++jj) {
            const int srow = mts * 16 + fq * 4 + jj;
            const bool keep = (mat & 2) ? (srow <= tcol) : (srow < tcol);
            v[jj] = keep ? v[jj] : 0.f;
          }
          if (mat == 0) {
#pragma unroll
            for (int jj = 0; jj < 4; ++jj) Nab[(mts * 16 + fq * 4 + jj) * 32 + tcol] = v[jj];
          } else {
            bf16_t* dst = mat == 1 ? NakT : mat == 2 ? NbrT : NkrT;
            *(uint2*)(dst + tcol * 40 + mts * 16 + fq * 4) = pack4(v);
          }
        }
      }
      lds_barrier();
      if (wave == 0) {
        const int irow = lane >> 1, hb = lane & 1, blk = lane >> 5, il = irow & 15;
        float x[8];
#pragma unroll
        for (int i = 0; i < 8; ++i) x[i] = (hb * 8 + i == il) ? 1.f : 0.f;
        const float* nb = Nab + (blk * 16) * 32 + blk * 16 + hb * 8;
        solve16<0>(x, nb);
#pragma unroll
        for (int i = 0; i < 8; ++i) TT[(blk * 16 + hb * 8 + i) * 40 + blk * 16 + il] = (bf16_t)(cvt_pk_bf16(x[i], 0.f) & 0xffff);
        if (blk == 0) *(uint4*)(T11b + il * 40 + hb * 8) = pack8(x);
        __builtin_amdgcn_wave_barrier();
        const f32x4 zero = {0.f, 0.f, 0.f, 0.f};
        bf16x8 zf;
#pragma unroll
        for (int i = 0; i < 8; ++i) zf[i] = 0;
        bf16x8 n12 = zf, t22 = zf, t11 = zf;
        if (fq < 2) {
          float o[8];
          const f32x4 n0 = *(const f32x4*)(Nab + fr * 32 + 16 + fq * 8), n1 = *(const f32x4*)(Nab + fr * 32 + 16 + fq * 8 + 4);
          o[0] = n0[0]; o[1] = n0[1]; o[2] = n0[2]; o[3] = n0[3]; o[4] = n1[0]; o[5] = n1[1]; o[6] = n1[2]; o[7] = n1[3];
          uint4 u = pack8(o);
          n12 = *reinterpret_cast<bf16x8*>(&u);
          t22 = *reinterpret_cast<const bf16x8*>(TT + (16 + fr) * 40 + 16 + fq * 8);
          t11 = *reinterpret_cast<const bf16x8*>(T11b + fr * 40 + fq * 8);
        }
        const f32x4 m1 = MFMA16(n12, t22, zero);
        *(uint2*)(M1T + fr * 40 + fq * 4) = pack4(m1);
        __builtin_amdgcn_wave_barrier();
        bf16x8 m1f = zf;
        if (fq < 2) m1f = *reinterpret_cast<const bf16x8*>(M1T + fr * 40 + fq * 8);
        const f32x4 t12 = MFMA16(t11, m1f, zero);
        *(uint2*)(TT + (16 + fr) * 40 + fq * 4) = pack4(t12);
      } else if (wave == 1) {
        unsigned z0;
        asm volatile("v_mov_b32 %0, 0" : "=v"(z0));
        *(uint2*)(TT + (lane >> 2) * 40 + 16 + (lane & 3) * 4) = make_uint2(z0, z0);
      } else if (wave < 6) {
        const int vtile = wave - 2;
        const bf16x8 vf = ldfrag(VT, 40, vtile * 16, 0, fr, fq);
        const f32x4 zero = {0.f, 0.f, 0.f, 0.f};
#pragma unroll
        for (int tt = 0; tt < 2; ++tt) {
          const f32x4 acc = MFMA16(ldfrag(NakT, 40, tt * 16, 0, fr, fq), vf, zero);
          *(uint2*)(VNb + (vtile * 16 + fr) * 40 + tt * 16 + fq * 4) = pack4(acc);
        }
      }
      lds_barrier();
      {
        const int tt = wave & 1, rt = wave >> 1;
        const f32x4 zero = {0.f, 0.f, 0.f, 0.f};
        const bf16x8 tf = ldfrag(TT, 40, tt * 16, 0, fr, fq);
        const f32x4 zacc = MFMA16(tf, ldfrag(VNb, 40, rt * 16, 0, fr, fq), zero);
        const f32x4 wacc = MFMA16(tf, ldfrag(AtTb, 40, rt * 16, 0, fr, fq), zero);
        *(uint2*)(Zb + (rt * 16 + fr) * 40 + tt * 16 + fq * 4) = pack4(zacc);
        *(uint2*)(Wb + (rt * 16 + fr) * 40 + tt * 16 + fq * 4) = pack4(wacc);
      }
      lds_barrier();
      f32x4 yacc = {0.f, 0.f, 0.f, 0.f};
      {
        const float pl0 = PLs[nt0 * 16 + fr], pl1 = PLs[nt1 * 16 + fr];
        Sa = Sa * pl0; Sb = Sb * pl1;
        const bf16x8 zf = ldfrag(Zb, 40, mt * 16, 0, fr, fq), vf = ldfrag(VT, 40, mt * 16, 0, fr, fq), wf = ldfrag(Wb, 40, mt * 16, 0, fr, fq);
        const bf16x8 bb0 = ldfrag(Bb, 40, nt0 * 16, 0, fr, fq), bb1 = ldfrag(Bb, 40, nt1 * 16, 0, fr, fq);
        const bf16x8 kb0 = ldfrag(Kb, 40, nt0 * 16, 0, fr, fq), kb1 = ldfrag(Kb, 40, nt1 * 16, 0, fr, fq);
        const bf16x8 nbr = ldfrag(NbrT, 40, hn * 16, 0, fr, fq), nkr = ldfrag(NkrT, 40, hn * 16, 0, fr, fq);
        Sa = MFMA16(zf, bb0, Sa); Sa = MFMA16(vf, kb0, Sa);
        Sb = MFMA16(zf, bb1, Sb); Sb = MFMA16(vf, kb1, Sb);
        yacc = MFMA16(zf, nbr, yacc); yacc = MFMA16(vf, nkr, yacc);
        const f32x4 zero = {0.f, 0.f, 0.f, 0.f};
        const f32x4 g0 = MFMA16(wf, bb0, zero), g1 = MFMA16(wf, bb1, zero);
        f32x4 ry = MFMA16(wf, nbr, zero);
        *(uint2*)(GT + (nt0 * 16 + fr) * 72 + mt * 16 + fq * 4) = pack4(g0);
        *(uint2*)(GT + (nt1 * 16 + fr) * 72 + mt * 16 + fq * 4) = pack4(g1);
        const uint2 rr = *(const uint2*)(Rt + (hn * 16 + fr) * 72 + mt * 16 + fq * 4);
        ry[0] += bf_lo(rr.x); ry[1] += bf_hi(rr.x); ry[2] += bf_lo(rr.y); ry[3] += bf_hi(rr.y);
        *(uint2*)(RyT + (hn * 16 + fr) * 72 + mt * 16 + fq * 4) = pack4(ry);
      }
      lds_barrier();
      {
        const bf16_t* Scur = Sbf + (c & 1) * 64 * 72;
        bf16_t* Snext = Sbf + ((c + 1) & 1) * 64 * 72;
#pragma unroll
        for (int ks = 0; ks < 2; ++ks) {
          const bf16x8 af = ldfrag(Scur, 72, mt * 16, ks * 32, fr, fq);
          Sa = MFMA16(af, ldfrag(GT, 72, nt0 * 16, ks * 32, fr, fq), Sa);
          Sb = MFMA16(af, ldfrag(GT, 72, nt1 * 16, ks * 32, fr, fq), Sb);
          yacc = MFMA16(af, ldfrag(RyT, 72, hn * 16, ks * 32, fr, fq), yacc);
        }
        y_def = pack4(yacc);
#pragma unroll
        for (int jj = 0; jj < 4; ++jj) {
          Snext[(mt * 16 + fq * 4 + jj) * 72 + nt0 * 16 + fr] = (bf16_t)(cvt_pk_bf16(Sa[jj], 0.f) & 0xffff);
          Snext[(mt * 16 + fq * 4 + jj) * 72 + nt1 * 16 + fr] = (bf16_t)(cvt_pk_bf16(Sb[jj], 0.f) & 0xffff);
        }
      }
      lds_barrier();
    }
    {
      const int ip = (nch - 1) * 32 + hn * 16 + fr, tp = d ? T - 1 - ip : ip;
      *(uint2*)(yout + (size_t)(r0seq + tp) * 512 + h * 64 + mt * 16 + fq * 4) = y_def;
      if (role == 2 && cq == 0) { const int is_ = (nch - 1) * 32 + th * 16 + tl, tg = d ? T - 1 - is_ : is_; P_SBON[((size_t)(r0seq + tg) * 8 + h) * 2 + d] = sb_def; }
    }
  }
  if (item >= 128) {
    const int nb = gridDim.x - 128;
    for (int tile = item - 128; tile < NTOK / 32; tile += nb) pool_tile(z, P_RH, tile, tid);
  }
}

__device__ __forceinline__ void post_phase(PREF p, char* smem, const int wid_u) {
  bf16_t* Ag = (bf16_t*)smem;
  bf16_t* vt = (bf16_t*)(smem + 12800);
  float* ys = (float*)(smem + 12800 + 33280);
  const bf16_t* z = P_RU;
  const bf16_t* yf = P_RY;
  const bf16_t* ybk = P_RY + (size_t)NTOK * 512;
  bf16_t* mo = P_RH;
  const int tid = opaque_tid(), w = tid >> 6, lane = tid & 63, fr = lane & 15, fq = lane >> 4;
  bf16x8 Bg[4][6];
#pragma unroll
  for (int nt = 0; nt < 4; ++nt)
#pragma unroll
    for (int ks = 0; ks < 6; ++ks) {
      float o[8];
#pragma unroll
      for (int q = 0; q < 8; ++q) { const int k = ks * 32 + fq * 8 + q; o[q] = k < 160 ? p.g2[(size_t)k * 512 + w * 64 + nt * 16 + fr] : 0.f; }
      uint4 u = pack8(o);
      Bg[nt][ks] = *reinterpret_cast<bf16x8*>(&u);
    }
  float lng[4], lnb[4];
#pragma unroll
  for (int nt = 0; nt < 4; ++nt) { lng[nt] = p.lnx_g[w * 64 + nt * 16 + fr]; lnb[nt] = p.lnx_b[w * 64 + nt * 16 + fr]; }

  for (int tile = blockIdx.x; tile < NTOK / 32; tile += gridDim.x) {
    const int row0 = tile * 32;
    int s, t0, T;
    row_seq(row0, s, t0, T);
    for (int idx = tid; idx < 32 * 24; idx += NTHR) {
      const int tok = idx / 24, oc = idx % 24;
      float o[8];
      if (oc < 20) {
        load_shift8(z, row0 + tok, t0 + tok, T, 2304 + oc * 8, p.shift_mu, o);
#pragma unroll
        for (int q = 0; q < 8; ++q) o[q] = sigmoidf_(o[q]);
      } else {
#pragma unroll
        for (int q = 0; q < 8; ++q) o[q] = 0.f;
      }
      *(uint4*)(Ag + tok * 200 + oc * 8) = pack8(o);
    }
    for (int idx = tid; idx < 32 * 64; idx += NTHR) {
      const int tok = idx >> 6, oc = idx & 63, row = row0 + tok, t = t0 + tok;
      float o[8];
      load_shift8(z, row, t, T, 1536 + oc * 8, p.shift_mu, o);
      *(uint4*)(vt + tok * 520 + oc * 8) = pack8(o);
      float a[8], b[8];
      unpack8(*(const uint4*)(yf + (size_t)row * 512 + oc * 8), a);
      unpack8(*(const uint4*)(ybk + (size_t)row * 512 + oc * 8), b);
      *(f32x4*)(ys + tok * 516 + oc * 8) = (f32x4){a[0] + b[0], a[1] + b[1], a[2] + b[2], a[3] + b[3]};
      *(f32x4*)(ys + tok * 516 + oc * 8 + 4) = (f32x4){a[4] + b[4], a[5] + b[5], a[6] + b[6], a[7] + b[7]};
    }
    __syncthreads();
    f32x4 acc[2][4] = {};
#pragma unroll
    for (int ks = 0; ks < 6; ++ks) {
      bf16x8 a[2];
#pragma unroll
      for (int mt = 0; mt < 2; ++mt) a[mt] = *reinterpret_cast<const bf16x8*>(Ag + (mt * 16 + fr) * 200 + ks * 32 + fq * 8);
#pragma unroll
      for (int mt = 0; mt < 2; ++mt)
#pragma unroll
        for (int nt = 0; nt < 4; ++nt) acc[mt][nt] = __builtin_amdgcn_mfma_f32_16x16x32_bf16(a[mt], Bg[nt][ks], acc[mt][nt], 0, 0, 0);
    }
#pragma unroll
    for (int mt = 0; mt < 2; ++mt)
#pragma unroll
      for (int jj = 0; jj < 4; ++jj) {
        const int tok = mt * 16 + fq * 4 + jj, row = row0 + tok;
        float yv[4], sm_ = 0.f;
#pragma unroll
        for (int nt = 0; nt < 4; ++nt) { yv[nt] = ys[tok * 516 + w * 64 + nt * 16 + fr]; sm_ += yv[nt]; }
        const float mean = row16_sum(sm_) * (1.f / 64.f);
        float vs = 0.f;
#pragma unroll
        for (int nt = 0; nt < 4; ++nt) { yv[nt] -= mean; vs += yv[nt] * yv[nt]; }
        const float rs = rsqrtf(row16_sum(vs) * (1.f / 64.f) + 64e-5f);
        const float2 sb2 = *(const float2*)(P_SBON + ((size_t)row * 8 + w) * 2);
        const float sbs = sb2.x + sb2.y;
#pragma unroll
        for (int nt = 0; nt < 4; ++nt) {
          const float vv = bf2f(vt[tok * 520 + w * 64 + nt * 16 + fr]);
          const float o = (yv[nt] * rs * lng[nt] + lnb[nt] + sbs * vv) * acc[mt][nt][jj];
          mo[(size_t)row * D + 512 + w * 64 + nt * 16 + fr] = (bf16_t)(cvt_pk_bf16(o, 0.f) & 0xffff);
        }
      }
    __syncthreads();
  }
}

#define XB_TMO      128
#define XB_XCNT(j)  (256  + 64 * (j))
#define XB_XSUB(j)  (1280 + 64 * (j))
#define XB_XGEN(j)  (2304 + 64 * (j))
#define XB_TOP      3328
#define XB_TOPGEN   3392
#define XCD_BAR_WORDS 3456
#define XB_SPIN_CAP (1u << 22)
__device__ __forceinline__ unsigned xb_ld(unsigned* p)              { return __hip_atomic_load(p, __ATOMIC_RELAXED, __HIP_MEMORY_SCOPE_AGENT); }
__device__ __forceinline__ unsigned xb_add(unsigned* p, unsigned v) { return __hip_atomic_fetch_add(p, v, __ATOMIC_RELAXED, __HIP_MEMORY_SCOPE_AGENT); }
__device__ __forceinline__ unsigned xb_xcc_id() { return (unsigned)__builtin_amdgcn_s_getreg((3 << 11) | 20) & 0xFu; }
#define XB_SPIN(cond, bar) do { unsigned _sp = 0; while (cond) { __builtin_amdgcn_s_sleep(1); \
    if ((++_sp & 255u) == 0u) { if (xb_ld(&(bar)[XB_TMO])) break; if (_sp > XB_SPIN_CAP) { atomicAdd(&(bar)[XB_TMO], 1u); break; } } } } while (0)
struct XcdBarrier { unsigned* bar; unsigned x; volatile LAS unsigned* st; };
__device__ __forceinline__ void xcd_barrier_complete(unsigned* bar, unsigned x, unsigned& nloc, unsigned& nx) {
  const unsigned G = gridDim.x * gridDim.y * gridDim.z;
  unsigned sum, cnt, mine, sp = 0u;
  for (;;) {
    sum = 0u; cnt = 0u; mine = 0u;
#pragma unroll
    for (unsigned j = 0; j < 16; ++j) { const unsigned c = xb_ld(&bar[XB_XCNT(j)]); sum += c; cnt += (c > 0u) ? 1u : 0u; mine = (j == x) ? c : mine; }
    if (sum == G) break;
    __builtin_amdgcn_s_sleep(1);
    if ((++sp & 255u) == 0u) { if (xb_ld(&bar[XB_TMO])) break; if (sp > XB_SPIN_CAP) { atomicAdd(&bar[XB_TMO], 1u); break; } }
  }
  nloc = mine > 0u ? mine : 1u; nx = cnt > 0u ? cnt : 1u;
}
__device__ __forceinline__ void xcd_barrier(PREF p, volatile LAS unsigned* st_, const int wid_u) {
  asm volatile("s_waitcnt vmcnt(0)" ::: "memory");
  __syncthreads();
  if (opaque_tid() == 0) {
    XcdBarrier b; b.bar = (unsigned*)(p.ws + OFF_BAR); b.x = xb_xcc_id(); b.st = st_;
    unsigned* bar = b.bar;
    __builtin_amdgcn_s_waitcnt(0);
    unsigned nloc = b.st[0], nx = b.st[1];
    if (nloc == 0u) { xcd_barrier_complete(bar, b.x, nloc, nx); b.st[0] = nloc; b.st[1] = nx; }
    const unsigned old = xb_add(&bar[XB_XSUB(b.x)], 1u);
    const unsigned gen = old / nloc;
    if (old + 1u == (gen + 1u) * nloc) {
      __builtin_amdgcn_fence(__ATOMIC_RELEASE, "agent");
      asm volatile("s_waitcnt vmcnt(0)" ::: "memory");
      const unsigned og = xb_add(&bar[XB_TOP], 1u);
      const unsigned tg = og / nx;
      if (og + 1u == (tg + 1u) * nx) xb_add(&bar[XB_TOPGEN], 1u);
      else XB_SPIN(xb_ld(&bar[XB_TOPGEN]) == tg, bar);
      __builtin_amdgcn_fence(__ATOMIC_ACQUIRE, "agent");
      xb_add(&bar[XB_XGEN(b.x)], 1u);
      asm volatile("s_waitcnt vmcnt(0)" ::: "memory");
    } else {
      XB_SPIN(xb_ld(&bar[XB_XGEN(b.x)]) == gen, bar);
      __builtin_amdgcn_fence(__ATOMIC_ACQUIRE, "agent");
      asm volatile("s_waitcnt vmcnt(0)" ::: "memory");
    }
  }
  __syncthreads();
}

constexpr int NPHASE = 14;
__device__ __forceinline__ void do_phase(PREF p, int ph, char* smem, const int wid_u) {
  if (ph == 0) prep_phase(p, smem, wid_u);
  else if (ph == 1) row_phase<0>(p.x_prompt, p.x_sample, nullptr, nullptr, P_RH, P_MOD, nullptr, p.n1_pre, 0, 0.f, 0, wid_u);
  else if (ph == 4 || ph == 10) {
    const bool f = ph == 4;
    float* outp = p.out;
    row_phase<1>(sel(f, p.x_prompt, (const float*)outp), sel(f, p.x_sample, (const float*)(outp + (size_t)NPROMPT * D)), outp, P_RY, P_RH, P_MOD,
                 sel(f, p.n1_post, p.nm_post), sel(f, p.nm_pre, p.n2_pre), f ? 2 : 5, f ? 0.5f : 1.0f, f ? 3 : 6, wid_u);
  }
  else if (ph == 13) row_phase<2>(p.out, p.out + (size_t)NPROMPT * D, p.out, P_RY, nullptr, P_MOD, p.n2_post, nullptr, 8, 0.5f, 0, wid_u);
  else if (ph == 6) lora_prep_phase(p, wid_u);
  else if (ph == 7) scan_phase(p, smem, wid_u);
  else if (ph == 8) post_phase(p, smem, wid_u);
  else {
    const bf16_t *A, *Bt; bf16_t* C; int N, K, ldc, epi;
    if (ph == 2 || ph == 11) { A = P_RH; Bt = sel(ph == 2, P_W13A, P_W13B); C = P_RU; N = 2 * FF; K = D; ldc = FF; epi = 1; }
    else if (ph == 3 || ph == 12) { A = P_RU; Bt = sel(ph == 3, P_W2A, P_W2B); C = P_RY; N = D; K = FF; ldc = D; epi = 0; }
    else if (ph == 5) { A = P_RH; Bt = P_WINT; C = P_RU; N = ZLD; K = D; ldc = ZLD; epi = 0; }
    else { A = P_RH; Bt = P_WOUTT; C = P_RY; N = D; K = D; ldc = D; epi = 0; }
    gemm_phase(A, Bt, C, NTOK, N, K, ldc, epi, smem, wid_u);
  }
}

extern __shared__ __attribute__((aligned(16))) char dyn_smem[];

__global__ void __launch_bounds__(NTHR, 2) mega_kernel(Params p) {
  cg::grid_group grid = cg::this_grid();
  const int wid_u = __builtin_amdgcn_readfirstlane(threadIdx.x >> 6);
  typedef const __attribute__((address_space(4))) Params* KP;
  const KP kp0 = (KP)__builtin_amdgcn_kernarg_segment_ptr();
  volatile LAS unsigned* st = (volatile LAS unsigned*)((LAS char*)dyn_smem + (SMEM_BYTES - 16));
  if (threadIdx.x < 2) st[threadIdx.x] = 0u;
  __syncthreads();
  if (threadIdx.x == 0) (void)xb_add(&((unsigned*)(kp0->ws + OFF_BAR))[XB_XCNT(xb_xcc_id())], 1u);
#pragma unroll 1
  for (int ph = 0; ph < NPHASE; ++ph) {
    KP kp = kp0;
    asm volatile("" : "+s"(kp));
    do_phase(*kp, ph, dyn_smem, wid_u);
#ifdef PROBE_REPEAT
    if (ph == PROBE_REPEAT) { grid.sync(); do_phase(*kp, ph, dyn_smem, wid_u); }
#endif
    if (ph == 0) grid.sync();
    else if (ph + 1 < NPHASE) xcd_barrier(*kp, (volatile LAS unsigned*)((LAS char*)dyn_smem + (SMEM_BYTES - 16)), wid_u);
  }
}

__global__ void __launch_bounds__(NTHR, 2) phase_kernel(Params p, int ph) {
  const int wid_u = __builtin_amdgcn_readfirstlane(threadIdx.x >> 6);
  do_phase(*(const __attribute__((address_space(4))) Params*)__builtin_amdgcn_kernarg_segment_ptr(), ph, dyn_smem, wid_u);
}

extern "C" void kernel_launch(void* const* d_in, const int* in_sizes, int n_in, void* d_out, int out_size, void* d_ws, size_t ws_size,
                              hipStream_t stream) {
  Params p{};
  const float** f = (const float**)&p;
  for (int i = 0; i < 33; ++i) f[i] = (const float*)d_in[i];
  p.out = (float*)d_out;
  p.ws = (char*)d_ws;
  if (WS_NEED > ws_size) { fprintf(stderr, "workspace too small: need %zu have %zu\n", (size_t)WS_NEED, ws_size); return; }

#if ONE_LAUNCH
  static int grid_blocks = 0;
  if (!grid_blocks) {
    int dev = 0, cus = 0, per_cu = 0;
    (void)hipGetDevice(&dev);
    (void)hipDeviceGetAttribute(&cus, hipDeviceAttributeMultiprocessorCount, dev);
    (void)hipFuncSetAttribute((const void*)mega_kernel, hipFuncAttributeMaxDynamicSharedMemorySize, SMEM_BYTES);
    (void)hipOccupancyMaxActiveBlocksPerMultiprocessor(&per_cu, mega_kernel, NTHR, SMEM_BYTES);
    if (per_cu < 1) per_cu = 1;
    grid_blocks = cus * per_cu;
  }
  (void)hipMemsetAsync(p.ws + OFF_BAR, 0, XCD_BAR_WORDS * sizeof(unsigned), stream);
  void* args[] = {&p};
  hipError_t e = hipLaunchCooperativeKernel((const void*)mega_kernel, dim3(grid_blocks), dim3(NTHR), args, SMEM_BYTES, stream);
  if (e != hipSuccess) fprintf(stderr, "cooperative launch failed: %s (grid %d)\n", hipGetErrorString(e), grid_blocks);
#else
  static bool attr = false;
  if (!attr) { (void)hipFuncSetAttribute((const void*)phase_kernel, hipFuncAttributeMaxDynamicSharedMemorySize, SMEM_BYTES); attr = true; }
  for (int ph = 0; ph < NPHASE; ++ph) phase_kernel<<<256, NTHR, SMEM_BYTES, stream>>>(p, ph);
#endif
}
```

```cpp
#include <hip/hip_runtime.h>
#include <hip/hip_cooperative_groups.h>
#include <cstdio>
namespace cg = cooperative_groups;

#ifndef ONE_LAUNCH
#define ONE_LAUNCH 1
#endif

typedef unsigned short bf16_t;
typedef short bf16x8 __attribute__((ext_vector_type(8)));
typedef float f32x4 __attribute__((ext_vector_type(4)));
typedef float f32x2 __attribute__((ext_vector_type(2)));
#define LAS __attribute__((address_space(3)))

constexpr int D = 1024, FF = 2816, NTOK = 98304, NPROMPT = 32768, ZLD = 2560, PINW = 2464;
constexpr int NTHR = 512;
constexpr int SMEM_BYTES = 162320;

struct Params {
  const float *x_prompt, *x_sample, *c_prompt, *c_sample, *ada_w, *ada_b, *n1_pre, *n1_post, *f1_w1, *f1_w3, *f1_w2,
      *nm_pre, *nm_post, *w_in, *shift_mu, *pool_w, *pool_scale, *w0, *w2, *a0, *a2, *g2, *k_k, *k_a, *r_k, *lnx_g, *lnx_b,
      *w_out, *n2_pre, *n2_post, *f2_w1, *f2_w3, *f2_w2;
  float* out;
  char* ws;
};
#define PREF const __attribute__((address_space(4))) Params&
constexpr size_t al256(size_t b) { return (b + 255) & ~(size_t)255; }
constexpr size_t OFF_W13A = 0;
constexpr size_t OFF_W13B = OFF_W13A + al256((size_t)2 * FF * D * 2);
constexpr size_t OFF_W2A = OFF_W13B + al256((size_t)2 * FF * D * 2);
constexpr size_t OFF_W2B = OFF_W2A + al256((size_t)D * FF * 2);
constexpr size_t OFF_WINT = OFF_W2B + al256((size_t)D * FF * 2);
constexpr size_t OFF_WOUTT = OFF_WINT + al256((size_t)ZLD * D * 2);
constexpr size_t OFF_MOD = OFF_WOUTT + al256((size_t)D * D * 2);
constexpr size_t OFF_SBON = OFF_MOD + al256((size_t)16 * 9216 * 4);
constexpr size_t OFF_RH = OFF_SBON + al256((size_t)NTOK * 16 * 4);
constexpr size_t OFF_RY = OFF_RH + al256((size_t)NTOK * D * 2);
constexpr size_t OFF_RU = OFF_RY + al256((size_t)NTOK * D * 2);
constexpr size_t OFF_ALORA = OFF_RU + al256((size_t)NTOK * FF * 2);
constexpr size_t OFF_BAR = OFF_ALORA + al256((size_t)NTOK * 256 * 2);
constexpr size_t WS_NEED = OFF_BAR + 16384;
#define P_W13A ((bf16_t*)(p.ws + OFF_W13A))
#define P_W13B ((bf16_t*)(p.ws + OFF_W13B))
#define P_W2A ((bf16_t*)(p.ws + OFF_W2A))
#define P_W2B ((bf16_t*)(p.ws + OFF_W2B))
#define P_WINT ((bf16_t*)(p.ws + OFF_WINT))
#define P_WOUTT ((bf16_t*)(p.ws + OFF_WOUTT))
#define P_MOD ((float*)(p.ws + OFF_MOD))
#define P_SBON ((float*)(p.ws + OFF_SBON))
#define P_RH ((bf16_t*)(p.ws + OFF_RH))
#define P_RY ((bf16_t*)(p.ws + OFF_RY))
#define P_RU ((bf16_t*)(p.ws + OFF_RU))
#define P_ALORA ((bf16_t*)(p.ws + OFF_ALORA))

typedef __bf16 bf16x2_t __attribute__((ext_vector_type(2)));
__device__ __forceinline__ unsigned cvt_pk_bf16(float lo, float hi) {
  f32x2 v = {lo, hi};
  bf16x2_t b = __builtin_convertvector(v, bf16x2_t);
  return __builtin_bit_cast(unsigned, b);
}
__device__ __forceinline__ float bf_lo(unsigned u) { return __uint_as_float(u << 16); }
__device__ __forceinline__ float bf_hi(unsigned u) { return __uint_as_float(u & 0xffff0000u); }
__device__ __forceinline__ float bf2f(bf16_t b) { return __uint_as_float(((unsigned)b) << 16); }
__device__ __forceinline__ void unpack8(uint4 v, float* o) {
  o[0] = bf_lo(v.x); o[1] = bf_hi(v.x); o[2] = bf_lo(v.y); o[3] = bf_hi(v.y);
  o[4] = bf_lo(v.z); o[5] = bf_hi(v.z); o[6] = bf_lo(v.w); o[7] = bf_hi(v.w);
}
__device__ __forceinline__ uint4 pack8(const float* o) {
  uint4 v; v.x = cvt_pk_bf16(o[0], o[1]); v.y = cvt_pk_bf16(o[2], o[3]); v.z = cvt_pk_bf16(o[4], o[5]); v.w = cvt_pk_bf16(o[6], o[7]);
  return v;
}
__device__ __forceinline__ float sigmoidf_(float x) { return __builtin_amdgcn_rcpf(1.f + __expf(-x)); }
template <int CTRL> __device__ __forceinline__ float dpp_f(float x) {
  return __int_as_float(__builtin_amdgcn_update_dpp(0, __float_as_int(x), CTRL, 0xf, 0xf, false));
}
__device__ __forceinline__ float row16_sum(float x) {
  x += dpp_f<0x128>(x); x += dpp_f<0x124>(x); x += dpp_f<0x122>(x); x += dpp_f<0x121>(x);
  return x;
}
template <class T> __device__ __forceinline__ T sel(bool c, T a, T b) { return c ? a : b; }
__device__ __forceinline__ int opaque_tid_w(int wid) {
  int l;
  asm volatile("v_mbcnt_lo_u32_b32 %0, -1, 0\n\tv_mbcnt_hi_u32_b32 %0, -1, %0" : "=v"(l));
  return wid * 64 + l;
}
#define opaque_tid() opaque_tid_w(wid_u)
__device__ __forceinline__ float wave_sum(float v) {
  v = row16_sum(v);
  const float a = __int_as_float(__builtin_amdgcn_readlane(__float_as_int(v), 0)), b = __int_as_float(__builtin_amdgcn_readlane(__float_as_int(v), 16));
  const float c = __int_as_float(__builtin_amdgcn_readlane(__float_as_int(v), 32)), d = __int_as_float(__builtin_amdgcn_readlane(__float_as_int(v), 48));
  return (a + b) + (c + d);
}
__device__ __forceinline__ float quad_sum(float x) { x += dpp_f<0xB1>(x); x += dpp_f<0x4E>(x); return x; }
__device__ __forceinline__ int seq_start(int s) { return s < 8 ? s * 4096 : NPROMPT + (s - 8) * 8192; }
__device__ __forceinline__ void row_seq(int row, int& s, int& t, int& T) {
  if (row < NPROMPT) { s = row >> 12; t = row & 4095; T = 4096; }
  else { int r = row - NPROMPT; s = 8 + (r >> 13); t = r & 8191; T = 8192; }
}

__device__ __forceinline__ void tr_tile(const float* __restrict__ src, int ldsrc, int k0, int n0, int nvalid, bf16_t* __restrict__ dst, int ldd,
                        int kdst0, int mode, float* sm, const int tid) {
#pragma unroll
  for (int i = 0; i < 2; ++i) {
    const int r = (tid >> 4) + 32 * i, c = (tid & 15) * 4;
    float4 v = make_float4(0.f, 0.f, 0.f, 0.f);
    if (n0 + c < nvalid) v = *(const float4*)(src + (size_t)(k0 + r) * ldsrc + n0 + c);
    float* d = sm + r * 65 + c;
    d[0] = v.x; d[1] = v.y; d[2] = v.z; d[3] = v.w;
  }
  __syncthreads();
  {
    const int n = tid >> 3, kc = (tid & 7) * 8;
    float o[8];
#pragma unroll
    for (int j = 0; j < 8; ++j) o[j] = sm[(kc + j) * 65 + n];
    int nn = n0 + n, drow;
    const int c32 = nn & 31, slot = 16 * ((c32 >> 2) & 1) + 4 * (c32 >> 3) + (c32 & 3);
    if (mode == 0) drow = (nn & ~31) + slot;
    else drow = 256 * (nn >> 7) + (mode == 2 ? 128 : 0) + ((nn & 127) & ~31) + slot;
    *(uint4*)(dst + (size_t)drow * ldd + kdst0 + k0 + kc) = pack8(o);
  }
  __syncthreads();
}

__device__ __forceinline__ void prep_phase(PREF p, char* smem, const int wid_u) {
  float* sm = (float*)smem;
  const int tid = opaque_tid();
  constexpr int N_MOD = 144, N_EFF = 128, N_W13 = 4 * 704, N_W2 = 2 * 704, N_WIN = 640, N_WOUT = 128;
  constexpr int TOTAL = N_MOD + N_EFF + N_W13 + N_W2 + N_WIN + N_WOUT;
  for (int item = blockIdx.x; item < TOTAL; item += gridDim.x) {
    int it = item;
    if (it < N_MOD) {
      const int j0 = it * 64;
      float* sc = sm;
      float* red = sm + 16384;
      for (int idx = tid; idx < 16384; idx += NTHR) {
        const int s = idx >> 10, k = idx & 1023;
        const float* cp_ = p.c_prompt; const float* cs_ = p.c_sample;
        const float c = s < 8 ? cp_[s * 1024 + k] : cs_[(s - 8) * 1024 + k];
        sc[idx] = c / (1.f + __expf(-c));
      }
      __syncthreads();
      const int col = tid & 63, kg = tid >> 6;
      float acc[16];
#pragma unroll
      for (int s = 0; s < 16; ++s) acc[s] = 0.f;
      for (int k = kg * 128; k < kg * 128 + 128; ++k) {
        const float w = p.ada_w[(size_t)k * 9216 + j0 + col];
#pragma unroll
        for (int s = 0; s < 16; ++s) acc[s] += sc[s * 1024 + k] * w;
      }
#pragma unroll
      for (int s = 0; s < 16; ++s) red[(kg * 16 + s) * 64 + col] = acc[s];
      __syncthreads();
      for (int o = tid; o < 1024; o += NTHR) {
        const int s = o >> 6, c2 = o & 63;
        float v = p.ada_b[j0 + c2];
#pragma unroll
        for (int g = 0; g < 8; ++g) v += red[(g * 16 + s) * 64 + c2];
        P_MOD[s * 9216 + j0 + c2] = v;
      }
      __syncthreads();
      continue;
    }
    it -= N_MOD;
    if (it < N_EFF) {
      const int g = it >> 5, itile = (it >> 4) & 1, ntile = it & 15;
      float* As = sm;
      float* Bs = sm + 64 * 129;
      for (int idx = tid; idx < 64 * 128; idx += NTHR) {
        const int i = idx >> 7, j = idx & 127;
        As[i * 129 + j] = p.pool_w[((size_t)g * 128 + itile * 64 + i) * 128 + j] * p.pool_scale[g * 128 + j];
      }
      for (int idx = tid; idx < 128 * 64; idx += NTHR) {
        const int j = idx >> 6, nn = idx & 63;
        Bs[j * 65 + nn] = p.w_out[(size_t)(g * 128 + j) * 1024 + ntile * 64 + nn];
      }
      __syncthreads();
      const int i = tid >> 3, nn0 = (tid & 7) * 8;
      float acc[8];
#pragma unroll
      for (int q = 0; q < 8; ++q) acc[q] = 0.f;
      for (int j = 0; j < 128; ++j) {
        const float a = As[i * 129 + j];
#pragma unroll
        for (int q = 0; q < 8; ++q) acc[q] += a * Bs[j * 65 + nn0 + q];
      }
#pragma unroll
      for (int q = 0; q < 8; ++q)
      {
        const int nn = ntile * 64 + nn0 + q, c32 = nn & 31, slot = 16 * ((c32 >> 2) & 1) + 4 * (c32 >> 3) + (c32 & 3);
        P_WOUTT[(size_t)((nn & ~31) + slot) * 1024 + g * 128 + itile * 64 + i] = (bf16_t)(cvt_pk_bf16(acc[q], 0.f) & 0xffff);
      }
      __syncthreads();
      continue;
    }
    it -= N_EFF;
    if (it < N_W13) {
      const int which = it / 704, r = it % 704;
      const int kt = r / 44, ntl = r % 44;
      const float* src = sel(which < 2, sel(which == 0, p.f1_w1, p.f1_w3), sel(which == 2, p.f2_w1, p.f2_w3));
      bf16_t* dst = sel(which < 2, P_W13A, P_W13B);
      tr_tile(src, FF, kt * 64, ntl * 64, FF, dst, D, 0, (which & 1) ? 2 : 1, sm, tid);
      continue;
    }
    it -= N_W13;
    if (it < N_W2) {
      const int which = it / 704, r = it % 704;
      const int kt = r / 16, ntl = r % 16;
      tr_tile(sel(which != 0, p.f2_w2, p.f1_w2), D, kt * 64, ntl * 64, D, sel(which != 0, P_W2B, P_W2A), FF, 0, 0, sm, tid);
      continue;
    }
    it -= N_W2;
    if (it < N_WIN) {
      const int kt = it / 40, ntl = it % 40;
      tr_tile(p.w_in, PINW, kt * 64, ntl * 64, PINW, P_WINT, D, 0, 0, sm, tid);
      continue;
    }
    it -= N_WIN;
    {
      const int kt = it / 16, ntl = it % 16;
      tr_tile(p.w_out + (size_t)512 * 1024, D, kt * 64, ntl * 64, D, P_WOUTT, D, 512, 0, sm, tid);
    }
  }
}

template <int MODE>
__device__ __forceinline__ void row_phase(const float* __restrict__ xp, const float* __restrict__ xs, float* __restrict__ xout,
                          const bf16_t* __restrict__ y, bf16_t* __restrict__ h, const float* __restrict__ mod,
                          const float* __restrict__ npost, const float* __restrict__ npre, int gate_idx, float cgate, int shift_idx, const int wid_u) {
  const int tid_ = opaque_tid();
  const int lane = tid_ & 63;
  const int gw = blockIdx.x * 8 + (tid_ >> 6), GW = gridDim.x * 8;
  for (int chunk = gw; chunk < NTOK / 16; chunk += GW) {
    const int row0 = chunk * 16;
    int s, t, T;
    row_seq(row0, s, t, T);
    const float* md = mod + s * 9216;
    f32x4 Am[4], Bm[4], Gm[4];
#pragma unroll
    for (int i = 0; i < 4; ++i) {
      const int c = i * 256 + lane * 4;
      if (MODE != 2) {
        f32x4 np = *(const f32x4*)(npre + c), sc = *(const f32x4*)(md + (shift_idx + 1) * 1024 + c);
        Am[i] = np * (sc + 1.f);
        Bm[i] = *(const f32x4*)(md + shift_idx * 1024 + c);
      }
      if (MODE != 0) {
        f32x4 g = *(const f32x4*)(md + gate_idx * 1024 + c), po = *(const f32x4*)(npost + c);
        Gm[i] = g * po * cgate;
      }
    }
    for (int r = 0; r < 16; ++r) {
      const int row = row0 + r;
      const float* xr = (row < NPROMPT) ? xp + (size_t)row * D : xs + (size_t)(row - NPROMPT) * D;
      f32x4 xv[4];
#pragma unroll
      for (int i = 0; i < 4; ++i) xv[i] = *(const f32x4*)(xr + i * 256 + lane * 4);
      if (MODE != 0) {
        f32x4 yv[4];
        float ss = 0.f;
#pragma unroll
        for (int i = 0; i < 4; ++i) {
          uint2 u = *(const uint2*)(y + (size_t)row * D + i * 256 + lane * 4);
          yv[i] = (f32x4){bf_lo(u.x), bf_hi(u.x), bf_lo(u.y), bf_hi(u.y)};
          ss += yv[i][0] * yv[i][0] + yv[i][1] * yv[i][1] + yv[i][2] * yv[i][2] + yv[i][3] * yv[i][3];
        }
        ss = wave_sum(ss);
        const float rs = rsqrtf(ss * (1.f / 1024.f) + 1e-6f);
#pragma unroll
        for (int i = 0; i < 4; ++i) {
          xv[i] = xv[i] + Gm[i] * yv[i] * rs;
          *(f32x4*)(xout + (size_t)row * D + i * 256 + lane * 4) = xv[i];
        }
      }
      if (MODE != 2) {
        float ss = 0.f;
#pragma unroll
        for (int i = 0; i < 4; ++i) ss += xv[i][0] * xv[i][0] + xv[i][1] * xv[i][1] + xv[i][2] * xv[i][2] + xv[i][3] * xv[i][3];
        ss = wave_sum(ss);
        const float rs = rsqrtf(ss * (1.f / 1024.f) + 1e-6f);
#pragma unroll
        for (int i = 0; i < 4; ++i) {
          f32x4 hv = xv[i] * rs * Am[i] + Bm[i];
          uint2 u; u.x = cvt_pk_bf16(hv[0], hv[1]); u.y = cvt_pk_bf16(hv[2], hv[3]);
          *(uint2*)(h + (size_t)row * D + i * 256 + lane * 4) = u;
        }
      }
    }
  }
}

constexpr int BM = 256, BK = 64, HALF = 128, NXCD = 8, WGM = 8, HT = HALF * BK;
__device__ __forceinline__ int lds_byte(int r, int c) {
  int st = (r >> 4) * 2 + (c >> 5), rr = r & 15, cc = c & 31, ob = rr * 64 + cc * 2;
  return st * 1024 + (ob ^ (((ob >> 9) & 1) << 5));
}
__device__ __forceinline__ void stage_rc(int b, int& R, int& C) {
  int st = b / 1024, sb = b % 1024, swz = sb ^ (((sb >> 9) & 1) << 5);
  R = (st >> 1) * 16 + swz / 64; C = (st & 1) * 32 + (swz % 64) / 2;
}

__device__ __forceinline__ bool gemm_unit(int i, int nM, int nN, int nwg, int& pm, int& pn) {
  const long L = (long)i * gridDim.x + blockIdx.x;
  if (L >= nwg) return false;
  int wgid = (int)L;
  { int q = nwg / NXCD, r = nwg % NXCD, xcd = wgid % NXCD, off = wgid / NXCD;
    wgid = (xcd < r ? xcd * (q + 1) : r * (q + 1) + (xcd - r) * q) + off; }
  const int nig = WGM * nN, gid = wgid / nig, fm = gid * WGM, gsz = min(nM - fm, WGM);
  pm = fm + ((wgid % nig) % gsz); pn = (wgid % nig) / gsz;
  return true;
}

__device__ __forceinline__ void gemm_phase(const bf16_t* __restrict__ A, const bf16_t* __restrict__ Bt, bf16_t* __restrict__ C, int M, int N, int K,
                                           int ldc, const int EPI, char* smem, const int wid_u) {
  const int nM = M / BM, nN = N / BM, nwg = nM * nN;
  const int tid = opaque_tid();
  LAS bf16_t* shm = (LAS bf16_t*)smem;
#define SA(b, h) (shm + ((b) * 2 + (h)) * HT)
#define SB(b, h) (shm + (4 + (b) * 2 + (h)) * HT)
#define STG(P, GB) do { const char* _gb = (GB); \
    _Pragma("unroll") for (int _i = 0; _i < 2; ++_i) { \
      __builtin_amdgcn_global_load_lds((const unsigned*)(_gb + voff[_i]), \
        (LAS unsigned*)((LAS char*)(P) + ldsw + _i * 8192), 16, 0, 0); } } while (0)
#define LDA(dst, b, h) _Pragma("unroll") for (int m = 0; m < 4; ++m) _Pragma("unroll") for (int k = 0; k < 2; ++k) \
    dst[m][k] = *(const LAS bf16x8*)((LAS char*)SA(b, h) + aoff + m * 2048 + k * 1024)
#define LDB(dst, b, h) _Pragma("unroll") for (int n = 0; n < 2; ++n) _Pragma("unroll") for (int k = 0; k < 2; ++k) \
    dst[n][k] = *(const LAS bf16x8*)((LAS char*)SB(b, h) + boff + n * 2048 + k * 1024)
#define MMA(ai, bj, At_, Bt_) do { __builtin_amdgcn_s_setprio(1); \
    _Pragma("unroll") for (int m = 0; m < 4; ++m) _Pragma("unroll") for (int n = 0; n < 2; ++n) _Pragma("unroll") for (int k = 0; k < 2; ++k) \
      acc[ai][bj][m][n] = __builtin_amdgcn_mfma_f32_16x16x32_bf16(Bt_[n][k], At_[m][k], acc[ai][bj][m][n], 0, 0, 0); \
    __builtin_amdgcn_s_setprio(0); } while (0)
#define WAIT_V(n) asm volatile("s_waitcnt vmcnt(" #n ")" ::: "memory")
#define WAIT_L(n) asm volatile("s_waitcnt lgkmcnt(" #n ")" ::: "memory")
#define BAR __builtin_amdgcn_s_barrier()
#define SCHED __builtin_amdgcn_sched_barrier(0)
  const int wid = __builtin_amdgcn_readfirstlane(tid >> 6), lane = tid & 63, wr = wid >> 2, wc = wid & 3, fr = lane & 15, fq = lane >> 4;
  const int aoff = lds_byte(wr * 64 + fr, fq * 8), boff = lds_byte(wc * 32 + fr, fq * 8);
  unsigned voff[2];
  const int ldsw = wid * 1024;
#pragma unroll
  for (int _i = 0; _i < 2; ++_i) { int _r, _c; stage_rc(tid * 16 + _i * 8192, _r, _c); voff[_i] = (unsigned)(_r * K + _c) * 2u; }
  const int nt = K / BK;
  const size_t kstep = (size_t)BK * 2, hstep = (size_t)HALF * K * 2, tstep = 2 * hstep;
  int pm, pn, npm = 0, npn = 0, ui = 0;
  if (!gemm_unit(0, nM, nN, nwg, pm, pn)) return;
  f32x4 acc[2][2][4][2];
#pragma unroll
  for (int a = 0; a < 2; ++a)
#pragma unroll
    for (int b = 0; b < 2; ++b)
#pragma unroll
      for (int m = 0; m < 4; ++m)
#pragma unroll
        for (int n = 0; n < 2; ++n) acc[a][b][m][n] = (f32x4){0.f, 0.f, 0.f, 0.f};
  bf16x8 At[4][2], B0[2][2], B1[2][2];
  const char* cA = (const char*)A + (size_t)pm * tstep;
  const char* cB = (const char*)Bt + (size_t)pn * tstep;
  STG(SB(0, 0), cB); STG(SA(0, 0), cA); STG(SB(0, 1), cB + hstep); STG(SA(0, 1), cA + hstep);
  if (wr == 1) BAR;
  WAIT_V(4); BAR;
  STG(SB(1, 0), cB + kstep); STG(SA(1, 0), cA + kstep); STG(SB(1, 1), cB + hstep + kstep);
  WAIT_V(6); BAR;
  for (;;) {
    const bool has_next = gemm_unit(ui + 1, nM, nN, nwg, npm, npn);
    const char* nA = has_next ? (const char*)A + (size_t)npm * tstep : cA;
    const char* nB = has_next ? (const char*)Bt + (size_t)npn * tstep : cB;
    for (int t = 0; t < nt; t += 2) {
      const bool last = (t == nt - 2);
      const char* a1 = cA + (size_t)(t + 1) * kstep;
      const char* a2 = last ? nA : cA + (size_t)(t + 2) * kstep;
      const char* b2 = last ? nB : cB + (size_t)(t + 2) * kstep;
      const char* a3 = a2 + kstep;
      const char* b3 = b2 + kstep;
      LDB(B0, 0, 0); SCHED; LDA(At, 0, 0); STG(SA(1, 1), a1 + hstep);
      WAIT_L(8); BAR; WAIT_L(0); MMA(0, 0, At, B0); BAR; SCHED;
      LDB(B1, 0, 1); STG(SB(0, 0), b2);
      BAR; WAIT_L(0); MMA(0, 1, At, B1); BAR;
      LDA(At, 0, 1); STG(SA(0, 0), a2);
      BAR; WAIT_L(0); MMA(1, 0, At, B0); BAR; SCHED;
      STG(SB(0, 1), b2 + hstep);
      WAIT_V(6); BAR; MMA(1, 1, At, B1); BAR;
      LDB(B0, 1, 0); SCHED; LDA(At, 1, 0); STG(SA(0, 1), a2 + hstep);
      WAIT_L(8); BAR; WAIT_L(0); MMA(0, 0, At, B0); BAR; SCHED;
      LDB(B1, 1, 1); STG(SB(1, 0), b3);
      BAR; WAIT_L(0); MMA(0, 1, At, B1); BAR;
      LDA(At, 1, 1); STG(SA(1, 0), a3);
      BAR; WAIT_L(0); MMA(1, 0, At, B0); BAR; SCHED;
      STG(SB(1, 1), b3 + hstep);
      WAIT_V(6); BAR; MMA(1, 1, At, B1); BAR;
    }
    {
      const int brow = pm * BM, bcol = pn * BM;
#pragma unroll
      for (int ai = 0; ai < 2; ++ai)
#pragma unroll
        for (int m = 0; m < 4; ++m) {
          const size_t row = (size_t)(brow + ai * HALF + wr * 64 + m * 16 + fr);
          if (EPI == 0) {
#pragma unroll
            for (int bj = 0; bj < 2; ++bj) {
              const f32x4 v0 = acc[ai][bj][m][0], v1 = acc[ai][bj][m][1];
              uint4 u; u.x = cvt_pk_bf16(v0[0], v0[1]); u.y = cvt_pk_bf16(v0[2], v0[3]); u.z = cvt_pk_bf16(v1[0], v1[1]); u.w = cvt_pk_bf16(v1[2], v1[3]);
              *(uint4*)(C + row * ldc + bcol + bj * HALF + wc * 32 + fq * 8) = u;
            }
          } else {
            float o[8];
#pragma unroll
            for (int n = 0; n < 2; ++n) {
              const f32x4 a = acc[ai][0][m][n], b = acc[ai][1][m][n];
#pragma unroll
              for (int j = 0; j < 4; ++j) o[n * 4 + j] = a[j] * __builtin_amdgcn_rcpf(1.f + __expf(-a[j])) * b[j];
            }
            *(uint4*)(C + row * ldc + (bcol >> 1) + wc * 32 + fq * 8) = pack8(o);
          }
        }
    }
    if (!has_next) break;
#pragma unroll
    for (int a = 0; a < 2; ++a)
#pragma unroll
      for (int b = 0; b < 2; ++b)
#pragma unroll
        for (int m = 0; m < 4; ++m)
#pragma unroll
          for (int n = 0; n < 2; ++n) acc[a][b][m][n] = (f32x4){0.f, 0.f, 0.f, 0.f};
    pm = npm; pn = npn; cA = nA; cB = nB; ++ui;
  }
  WAIT_V(0);
  if (wr == 0) BAR;
  BAR;
#undef SA
#undef SB
#undef STG
#undef LDA
#undef LDB
#undef MMA
}

__device__ __forceinline__ void load_shift16(const bf16_t* __restrict__ z, int row, int t, int T, int col, const float* __restrict__ mu, float* o) {
  const bf16_t* pz = z + (size_t)row * ZLD + col;
  uint4 c0 = *(const uint4*)pz, c1 = *(const uint4*)(pz + 8);
  uint4 p0 = make_uint4(0, 0, 0, 0), p1 = p0, n0 = p0, n1 = p0;
  if (t > 0) { p0 = *(const uint4*)(pz - ZLD); p1 = *(const uint4*)(pz - ZLD + 8); }
  if (t < T - 1) { n0 = *(const uint4*)(pz + ZLD); n1 = *(const uint4*)(pz + ZLD + 8); }
  float c[16], pv[16], nx[16];
  unpack8(c0, c); unpack8(c1, c + 8); unpack8(p0, pv); unpack8(p1, pv + 8); unpack8(n0, nx); unpack8(n1, nx + 8);
#pragma unroll
  for (int q = 0; q < 16; ++q) o[q] = c[q] + (0.5f * (pv[q] + nx[q]) - c[q]) * mu[col - 512 + q];
}
__device__ __forceinline__ void load_shift8(const bf16_t* __restrict__ z, int row, int t, int T, int col, const float* __restrict__ mu, float* o) {
  const bf16_t* pz = z + (size_t)row * ZLD + col;
  uint4 c0 = *(const uint4*)pz;
  uint4 p0 = make_uint4(0, 0, 0, 0), n0 = p0;
  if (t > 0) p0 = *(const uint4*)(pz - ZLD);
  if (t < T - 1) n0 = *(const uint4*)(pz + ZLD);
  float c[8], pv[8], nx[8];
  unpack8(c0, c); unpack8(p0, pv); unpack8(n0, nx);
#pragma unroll
  for (int q = 0; q < 8; ++q) o[q] = c[q] + (0.5f * (pv[q] + nx[q]) - c[q]) * mu[col - 512 + q];
}

constexpr int TC = 32;
constexpr int SV = TC * 64;
__device__ __forceinline__ void lora_prep_phase(PREF p, const int wid_u) {
  const int tid = opaque_tid();
  const bf16_t* z = P_RU;
  bf16_t* al = P_ALORA;
  const float* mu = p.shift_mu;
  for (int task = blockIdx.x * NTHR + tid; task < NTOK * 32; task += gridDim.x * NTHR) {
    const int row = task >> 5, oc = task & 31;
    int s, t, T;
    row_seq(row, s, t, T);
    float o[8];
    load_shift8(z, row, t, T, 2048 + oc * 8, mu, o);
    if (oc < 16) {
#pragma unroll
      for (int q = 0; q < 8; ++q) { const float e = __expf(2.f * o[q]); o[q] = 1.f - 2.f * __builtin_amdgcn_rcpf(e + 1.f); }
    }
    *(uint4*)(al + (size_t)row * 256 + oc * 8) = pack8(o);
  }
}

template <int HALF>
__device__ __forceinline__ void pool_seg(const bf16_t* __restrict__ z, bf16_t* __restrict__ mo, int row_base, int tbase, int T, int c0) {
  constexpr int NR = 2 * HALF + 3;
  float acc[4][8], zc[4][8];
#pragma unroll
  for (int i = 0; i < 4; ++i)
#pragma unroll
    for (int q = 0; q < 8; ++q) { acc[i][q] = 0.f; zc[i][q] = 0.f; }
#pragma unroll
  for (int r = 0; r < NR; ++r) {
    const int tt = tbase - HALF + r;
    uint4 u = make_uint4(0, 0, 0, 0);
    if (tt >= 0 && tt < T) u = *(const uint4*)(z + (size_t)(row_base - HALF + r) * ZLD + c0);
    float v[8];
    unpack8(u, v);
#pragma unroll
    for (int i = 0; i < 4; ++i) {
      if (r >= i && r < i + 2 * HALF) {
#pragma unroll
        for (int q = 0; q < 8; ++q) acc[i][q] += v[q];
      }
      if (r == HALF + i) {
#pragma unroll
        for (int q = 0; q < 8; ++q) zc[i][q] = v[q];
      }
    }
  }
#pragma unroll
  for (int i = 0; i < 4; ++i) {
    const int ti = tbase + i;
    const float ic = 1.f / (float)(min(ti + HALF, T) - max(ti - HALF, 0));
    float o[8];
#pragma unroll
    for (int q = 0; q < 8; ++q) o[q] = acc[i][q] * ic - zc[i][q];
    *(uint4*)(mo + (size_t)(row_base + i) * D + c0) = pack8(o);
  }
}
__device__ __forceinline__ void pool_tile(const bf16_t* __restrict__ z, bf16_t* __restrict__ mo, int tile, int tid) {
  const int row0 = tile * 32;
  int s, t0, T;
  row_seq(row0, s, t0, T);
  const int oc = tid >> 3, seg = tid & 7, c0 = oc * 8, grp = __builtin_amdgcn_readfirstlane(oc >> 4);
  const int rb = row0 + seg * 4, tb = t0 + seg * 4;
  if (grp == 0) pool_seg<1>(z, mo, rb, tb, T, c0);
  else if (grp == 1) pool_seg<2>(z, mo, rb, tb, T, c0);
  else if (grp == 2) pool_seg<4>(z, mo, rb, tb, T, c0);
  else pool_seg<8>(z, mo, rb, tb, T, c0);
}

struct Raw16 { uint4 c0, c1, p0, p1, n0, n1; };
__device__ __forceinline__ void load_raw16(Raw16& r, const bf16_t* __restrict__ z, int row, int t, int T, int col) {
  const bf16_t* pz = z + (unsigned)(row * ZLD + col);
  r.c0 = *(const uint4*)pz; r.c1 = *(const uint4*)(pz + 8);
  r.p0 = make_uint4(0, 0, 0, 0); r.p1 = r.p0; r.n0 = r.p0; r.n1 = r.p0;
  if (t > 0) { r.p0 = *(const uint4*)(pz - ZLD); r.p1 = *(const uint4*)(pz - ZLD + 8); }
  if (t < T - 1) { r.n0 = *(const uint4*)(pz + ZLD); r.n1 = *(const uint4*)(pz + ZLD + 8); }
}
__device__ __forceinline__ void shift16(const Raw16& r, const float* c1, const float* c2, float* o) {
  float c[16], pv[16], nx[16];
  unpack8(r.c0, c); unpack8(r.c1, c + 8); unpack8(r.p0, pv); unpack8(r.p1, pv + 8); unpack8(r.n0, nx); unpack8(r.n1, nx + 8);
#pragma unroll
  for (int q = 0; q < 16; ++q) o[q] = c[q] * c1[q] + (pv[q] + nx[q]) * c2[q];
}
__device__ __forceinline__ bf16x8 ldfrag(const bf16_t* base, int stride, int row0, int k0, int fr, int fq) {
  return *reinterpret_cast<const bf16x8*>(base + (row0 + fr) * stride + k0 + fq * 8);
}
__device__ __forceinline__ uint2 pack4(f32x4 v) { uint2 u; u.x = cvt_pk_bf16(v[0], v[1]); u.y = cvt_pk_bf16(v[2], v[3]); return u; }
#define MFMA16(a, b, c) __builtin_amdgcn_mfma_f32_16x16x32_bf16(a, b, c, 0, 0, 0)

constexpr int CS_NAB = 0, CS_NAK = 4096, CS_NBRT = 8192, CS_NKRT = 10752, CS_QT = 13312, CS_W = 15872, CS_Z = 20992, CS_GT = 26112,
              CS_RYT = 35328, CS_VN = 39936;
constexpr int CS_AT = 49152, CS_RT = CS_AT + 4608, CS_BT = CS_RT + 4608, CS_KT = CS_BT + 4608, CS_BB = 67584, CS_KB = CS_BB + 5120,
              CS_VT = CS_KB + 5120, CS_ATT = 82944, CS_PL = 92160, CS_SBF = 92416, CS_PRIV = 110848, CS_CST = 143616, CS_BL = 145920;

__device__ __forceinline__ void lds_barrier() {
  asm volatile("s_waitcnt lgkmcnt(0)" ::: "memory");
  __builtin_amdgcn_s_barrier();
  asm volatile("" ::: "memory");
}
template <int Q> __device__ __forceinline__ float quad_bcast(float x) { return dpp_f<Q * 0x55>(x); }

template <int S0> __device__ __forceinline__ void solve_steps(float (&x)[8], const float* nab, int seg) {
  if constexpr (S0 < 32) {
    const float xs = quad_bcast<(S0 >> 3)>(x[S0 & 7]);
    const f32x4 n0 = *(const f32x4*)(nab + S0 * 32 + seg * 8), n1 = *(const f32x4*)(nab + S0 * 32 + seg * 8 + 4);
    x[0] += xs * n0[0]; x[1] += xs * n0[1]; x[2] += xs * n0[2]; x[3] += xs * n0[3];
    x[4] += xs * n1[0]; x[5] += xs * n1[1]; x[6] += xs * n1[2]; x[7] += xs * n1[3];
    solve_steps<S0 + 1>(x, nab, seg);
  }
}

template <int S0> __device__ __forceinline__ void solve16(float (&x)[8], const float* nb) {
  if constexpr (S0 < 16) {
    const float xs = (S0 >> 3) ? dpp_f<0xF5>(x[S0 & 7]) : dpp_f<0xA0>(x[S0 & 7]);
    const f32x4 n0 = *(const f32x4*)(nb + S0 * 32), n1 = *(const f32x4*)(nb + S0 * 32 + 4);
    x[0] += xs * n0[0]; x[1] += xs * n0[1]; x[2] += xs * n0[2]; x[3] += xs * n0[3];
    x[4] += xs * n1[0]; x[5] += xs * n1[1]; x[6] += xs * n1[2]; x[7] += xs * n1[3];
    solve16<S0 + 1>(x, nb);
  }
}

__device__ __forceinline__ void scan_phase(PREF p, char* smem, const int wid_u) {
  float* stepbuf = (float*)smem;
  float* Nab = (float*)(smem + CS_NAB);
  bf16_t* NakT = (bf16_t*)(smem + CS_NAK);
  bf16_t* VNb = (bf16_t*)(smem + CS_VN);
  bf16_t* T11b = (bf16_t*)(smem + CS_VN + 5120);
  bf16_t* M1T = (bf16_t*)(smem + CS_VN + 5120 + 1280);
  bf16_t* NbrT = (bf16_t*)(smem + CS_NBRT);
  bf16_t* NkrT = (bf16_t*)(smem + CS_NKRT);
  bf16_t* TT = (bf16_t*)(smem + CS_QT);
  bf16_t* Wb = (bf16_t*)(smem + CS_W);
  bf16_t* Zb = (bf16_t*)(smem + CS_Z);
  bf16_t* GT = (bf16_t*)(smem + CS_GT);
  bf16_t* RyT = (bf16_t*)(smem + CS_RYT);
  bf16_t* At = (bf16_t*)(smem + CS_AT);
  bf16_t* Rt = (bf16_t*)(smem + CS_RT);
  bf16_t* Bt = (bf16_t*)(smem + CS_BT);
  bf16_t* Kt = (bf16_t*)(smem + CS_KT);
  bf16_t* Bb = (bf16_t*)(smem + CS_BB);
  bf16_t* Kb = (bf16_t*)(smem + CS_KB);
  bf16_t* VT = (bf16_t*)(smem + CS_VT);
  bf16_t* AtTb = (bf16_t*)(smem + CS_ATT);
  float* PLs = (float*)(smem + CS_PL);
  bf16_t* Sbf = (bf16_t*)(smem + CS_SBF);
  float* cst = (float*)(smem + CS_CST);
  const bf16_t* z = P_RU;
  const int tid = opaque_tid();
  const int wave = __builtin_amdgcn_readfirstlane(tid >> 6), lane = tid & 63, fr = lane & 15, fq = lane >> 4;
  const int item = blockIdx.x;
  if (item < 256) {
    const int s = item < 128 ? 8 + (item >> 4) : ((item - 128) >> 4);
    const int h = (item & 15) >> 1, d = item & 1;
    const int T = s < 8 ? 4096 : 8192, r0seq = seq_start(s), nch = T / 32;
    bf16_t* yout = P_RY + (size_t)d * NTOK * 512;
    {
      const int g = tid >> 6, k = tid & 63;
      const float muk = p.shift_mu[1024 - 512 + h * 64 + k], mur = p.shift_mu[512 - 512 + h * 64 + k], muv = p.shift_mu[1536 - 512 + h * 64 + k];
      float v;
      if (g == 0) v = 0.5f * muk;
      else if (g == 1) v = 0.5f * mur;
      else if (g == 2) v = 1.f - muk;
      else if (g == 3) v = 1.f - mur;
      else if (g == 4) v = 1.f - muv;
      else if (g == 5) v = p.k_k[h * 64 + k];
      else if (g == 6) v = p.k_a[h * 64 + k];
      else v = p.r_k[h * 64 + k];
      cst[g * 64 + k] = v;
      if (g == 0) cst[8 * 64 + k] = 0.5f * muv;
      for (int i = tid; i < 2 * 64 * 72 / 2; i += NTHR) ((unsigned*)Sbf)[i] = 0u;
    }
    const int role = wave >> 1, th = wave & 1;
    const int tl = lane >> 2, cq = lane & 3;
    float* tmpa = (float*)(smem + CS_PRIV + (wave & 3) * 8192 + 2560);
    uint4* Blds = (uint4*)(smem + CS_BL) + (role & 1) * 512;
    float bias[4] = {0.f, 0.f, 0.f, 0.f};
    if (role < 2) {
      const float* lsrc = sel(role != 0, p.a2, p.w2) + (size_t)d * 64 * 512 + h * 64;
      if (th == 0) {
#pragma unroll
        for (int nt = 0; nt < 4; ++nt)
#pragma unroll
          for (int ks = 0; ks < 2; ++ks) {
            float o[8];
#pragma unroll
            for (int q = 0; q < 8; ++q) o[q] = lsrc[(size_t)(ks * 32 + fq * 8 + q) * 512 + nt * 16 + fr];
            Blds[(nt * 2 + ks) * 64 + lane] = pack8(o);
          }
      }
#pragma unroll
      for (int nt = 0; nt < 4; ++nt) bias[nt] = sel(role != 0, p.a0, p.w0)[d * 512 + h * 64 + nt * 16 + fr];
    }
    const int colA = 512 + h * 64 + cq * 16;
    const int colB = (role == 1 ? 1024 : 1536) + h * 64 + cq * 16;
    const int alo = (role == 0 ? d * 64 : 128 + d * 64) + fq * 8;
    Raw16 ra, rb;
    {
      const int j = th * 16 + tl, t = d ? T - 1 - j : j, row = r0seq + t;
      if (role == 2) load_raw16(ra, z, row, t, T, colA);
      if (role == 1 || role == 2) load_raw16(rb, z, row, t, T, colB);
      if (role < 2) {
        const int j2 = th * 16 + fr, t2 = d ? T - 1 - j2 : j2;
        const bf16_t* ap = P_ALORA + (unsigned)((r0seq + t2) * 256 + alo);
        ra.c0 = *(const uint4*)ap; ra.c1 = *(const uint4*)(ap + 32);
      }
    }
    f32x4 Sa = {0.f, 0.f, 0.f, 0.f}, Sb = Sa;
    uint2 y_def = make_uint2(0u, 0u);
    float sb_def = 0.f;
    const int mt = wave >> 1, hn = wave & 1, nt0 = 2 * hn, nt1 = 2 * hn + 1;
    __syncthreads();

    for (int c = 0; c < nch; ++c) {
      if (role < 3) {
        const int j = th * 16 + tl;
        const int istep = c * 32 + j;
        const int t = d ? T - 1 - istep : istep;
        const int row = r0seq + t;
        float v16[16];
        if (role < 2) {
          f32x4 acc[4] = {};
#pragma unroll
          for (int ks = 0; ks < 2; ++ks) {
            const uint4 au = ks == 0 ? ra.c0 : ra.c1;
            const bf16x8 a = *reinterpret_cast<const bf16x8*>(&au);
#pragma unroll
            for (int nt = 0; nt < 4; ++nt) { const uint4 bu = Blds[(nt * 2 + ks) * 64 + lane]; acc[nt] = MFMA16(a, *reinterpret_cast<const bf16x8*>(&bu), acc[nt]); }
          }
          if (role == 0) {
#pragma unroll
            for (int nt = 0; nt < 4; ++nt)
#pragma unroll
              for (int jj = 0; jj < 4; ++jj) {
                const float sg = sigmoidf_(bias[nt] + acc[nt][jj]);
                stepbuf[0 * SV + (th * 16 + fq * 4 + jj) * 64 + nt * 16 + fr] = __expf(-0.6065306597126334f * sg);
              }
            __builtin_amdgcn_wave_barrier();
            {
              float wl[16];
#pragma unroll
              for (int i = 0; i < 16; ++i) wl[i] = stepbuf[0 * SV + (th * 16 + i) * 64 + lane];
              float pr = 1.f;
#pragma unroll
              for (int i = 0; i < 16; ++i) { pr *= wl[i]; stepbuf[0 * SV + (th * 16 + i) * 64 + lane] = pr; }
            }
          } else {
#pragma unroll
            for (int nt = 0; nt < 4; ++nt)
#pragma unroll
              for (int jj = 0; jj < 4; ++jj) tmpa[(fq * 4 + jj) * 68 + nt * 16 + fr] = sigmoidf_(bias[nt] + acc[nt][jj]);
            __builtin_amdgcn_wave_barrier();
            float av[16], kd[16];
#pragma unroll
            for (int q = 0; q < 4; ++q) { f32x4 a4 = *(const f32x4*)(tmpa + tl * 68 + cq * 16 + q * 4); av[q * 4] = a4[0]; av[q * 4 + 1] = a4[1]; av[q * 4 + 2] = a4[2]; av[q * 4 + 3] = a4[3]; }
            shift16(rb, cst + 2 * 64 + cq * 16, cst + 0 * 64 + cq * 16, v16);
            float kk[16], ss = 0.f;
#pragma unroll
            for (int q = 0; q < 16; ++q) { kk[q] = v16[q] * cst[5 * 64 + cq * 16 + q]; ss += kk[q] * kk[q]; }
            ss = quad_sum(ss);
            const float inv = 1.f / fmaxf(sqrtf(ss), 1e-12f);
#pragma unroll
            for (int q = 0; q < 16; ++q) { kk[q] *= inv; kd[q] = v16[q] * (1.f + (av[q] - 1.f) * cst[6 * 64 + cq * 16 + q]); }
#pragma unroll
            for (int q = 0; q < 4; ++q) {
              *(f32x4*)(stepbuf + 3 * SV + j * 64 + cq * 16 + q * 4) = (f32x4){-kk[q * 4], -kk[q * 4 + 1], -kk[q * 4 + 2], -kk[q * 4 + 3]};
              *(f32x4*)(stepbuf + 4 * SV + j * 64 + cq * 16 + q * 4) = (f32x4){kk[q * 4] * av[q * 4], kk[q * 4 + 1] * av[q * 4 + 1], kk[q * 4 + 2] * av[q * 4 + 2], kk[q * 4 + 3] * av[q * 4 + 3]};
              *(f32x4*)(stepbuf + 1 * SV + j * 64 + cq * 16 + q * 4) = (f32x4){kd[q * 4], kd[q * 4 + 1], kd[q * 4 + 2], kd[q * 4 + 3]};
            }
          }
        } else {
          shift16(ra, cst + 3 * 64 + cq * 16, cst + 1 * 64 + cq * 16, v16);
#pragma unroll
          for (int q = 0; q < 4; ++q) *(f32x4*)(stepbuf + 2 * SV + j * 64 + cq * 16 + q * 4) = (f32x4){v16[q * 4], v16[q * 4 + 1], v16[q * 4 + 2], v16[q * 4 + 3]};
          shift16(rb, cst + 4 * 64 + cq * 16, cst + 8 * 64 + cq * 16, v16);
#pragma unroll
          for (int q = 0; q < 4; ++q) *(f32x4*)(stepbuf + 5 * SV + j * 64 + cq * 16 + q * 4) = (f32x4){v16[q * 4], v16[q * 4 + 1], v16[q * 4 + 2], v16[q * 4 + 3]};
        }
      }
      if (c > 0) {
        const int ip = (c - 1) * 32 + hn * 16 + fr, tp = d ? T - 1 - ip : ip;
        *(uint2*)(yout + (size_t)(r0seq + tp) * 512 + h * 64 + mt * 16 + fq * 4) = y_def;
        if (role == 2 && cq == 0) { const int is_ = (c - 1) * 32 + th * 16 + tl, tg = d ? T - 1 - is_ : is_; P_SBON[((size_t)(r0seq + tg) * 8 + h) * 2 + d] = sb_def; }
      }
      if (role < 3 && c + 1 < nch) {
        const int is2 = (c + 1) * 32 + th * 16 + tl;
        const int t2 = d ? T - 1 - is2 : is2;
        const int row2 = r0seq + t2;
        if (role == 2) load_raw16(ra, z, row2, t2, T, colA);
        if (role >= 1) load_raw16(rb, z, row2, t2, T, colB);
        if (role < 2) {
          const int is3 = (c + 1) * 32 + th * 16 + fr, t3 = d ? T - 1 - is3 : is3;
          const bf16_t* ap = P_ALORA + (unsigned)((r0seq + t3) * 256 + alo);
          ra.c0 = *(const uint4*)ap; ra.c1 = *(const uint4*)(ap + 32);
        }
      }
      lds_barrier();
      {
        const int k = lane, seg = wave;
        const float* sw = stepbuf + 0 * SV + k;
        const float P15 = sw[15 * 64];
        const float hiF = seg >= 4 ? P15 : 1.f;
        float P[5];
        P[0] = seg == 0 ? 1.f : sw[(4 * seg - 1) * 64] * (seg > 4 ? P15 : 1.f);
#pragma unroll
        for (int i = 0; i < 4; ++i) P[i + 1] = sw[(4 * seg + i) * 64] * hiF;
        const float PL = sw[31 * 64] * P15;
        if (role == 2) {
          const int j = th * 16 + tl;
          float bs = 0.f;
#pragma unroll
          for (int q = 0; q < 16; ++q) bs += stepbuf[2 * SV + j * 64 + cq * 16 + q] * stepbuf[1 * SV + j * 64 + cq * 16 + q] * cst[7 * 64 + cq * 16 + q];
          bs = quad_sum(bs);
          sb_def = bs;
        }
        f32x4 bb, kb, at, vv;
#pragma unroll
        for (int i = 0; i < 4; ++i) {
          const int t = 4 * seg + i;
          const float inv = __builtin_amdgcn_rcpf(P[i + 1]);
          const float a_ = P[i] * stepbuf[3 * SV + t * 64 + k];
          const float rraw = stepbuf[2 * SV + t * 64 + k], kraw = stepbuf[1 * SV + t * 64 + k];
          const float r_ = P[i + 1] * rraw;
          const float b_ = stepbuf[4 * SV + t * 64 + k] * inv;
          const float k_ = kraw * inv;

          At[t * 72 + k] = (bf16_t)(cvt_pk_bf16(a_, 0.f) & 0xffff);
          Rt[t * 72 + k] = (bf16_t)(cvt_pk_bf16(r_, 0.f) & 0xffff);
          Bt[t * 72 + k] = (bf16_t)(cvt_pk_bf16(b_, 0.f) & 0xffff);
          Kt[t * 72 + k] = (bf16_t)(cvt_pk_bf16(k_, 0.f) & 0xffff);
          bb[i] = b_ * PL; kb[i] = k_ * PL; at[i] = a_;
          vv[i] = stepbuf[5 * SV + t * 64 + k];
        }
        *(uint2*)(Bb + k * 40 + 4 * seg) = pack4(bb);
        *(uint2*)(Kb + k * 40 + 4 * seg) = pack4(kb);
        *(uint2*)(VT + k * 40 + 4 * seg) = pack4(vv);
        *(uint2*)(AtTb + k * 40 + 4 * seg) = pack4(at);
        if (seg == 0) PLs[k] = PL;
      }
      lds_barrier();
      {
        const int mat = wave >> 1, mts = wave & 1;
        const bf16_t* As = (mat & 1) ? Kt : Bt;
        const bf16_t* Bs = (mat & 2) ? Rt : At;
        f32x4 acc[2] = {};
#pragma unroll
        for (int ks = 0; ks < 2; ++ks) {
          const bf16x8 a = ldfrag(As, 72, mts * 16, ks * 32, fr, fq);
#pragma unroll
          for (int nt = 0; nt < 2; ++nt) acc[nt] = MFMA16(a, ldfrag(Bs, 72, nt * 16, ks * 32, fr, fq), acc[nt]);
        }
#pragma unroll
        for (int nt = 0; nt < 2; ++nt) {
          const int tcol = nt * 16 + fr;
          f32x4 v = acc[nt];
#pragma unroll
          for (int jj = 0; jj < 4; ++jj) {
            const int srow = mts * 16 + fq * 4 + jj;
            const bool keep = (mat & 2) ? (srow <= tcol) : (srow < tcol);
            v[jj] = keep ? v[jj] : 0.f;
          }
          if (mat == 0) {
#pragma unroll
            for (int jj = 0; jj < 4; ++jj) Nab[(mts * 16 + fq * 4 + jj) * 32 + tcol] = v[jj];
          } else {
            bf16_t* dst = mat == 1 ? NakT : mat == 2 ? NbrT : NkrT;
            *(uint2*)(dst + tcol * 40 + mts * 16 + fq * 4) = pack4(v);
          }
        }
      }
      lds_barrier();
      if (wave == 0) {
        const int irow = lane >> 1, hb = lane & 1, blk = lane >> 5, il = irow & 15;
        float x[8];
#pragma unroll
        for (int i = 0; i < 8; ++i) x[i] = (hb * 8 + i == il) ? 1.f : 0.f;
        const float* nb = Nab + (blk * 16) * 32 + blk * 16 + hb * 8;
        solve16<0>(x, nb);
#pragma unroll
        for (int i = 0; i < 8; ++i) TT[(blk * 16 + hb * 8 + i) * 40 + blk * 16 + il] = (bf16_t)(cvt_pk_bf16(x[i], 0.f) & 0xffff);
        if (blk == 0) *(uint4*)(T11b + il * 40 + hb * 8) = pack8(x);
        __builtin_amdgcn_wave_barrier();
        const f32x4 zero = {0.f, 0.f, 0.f, 0.f};
        bf16x8 zf;
#pragma unroll
        for (int i = 0; i < 8; ++i) zf[i] = 0;
        bf16x8 n12 = zf, t22 = zf, t11 = zf;
        if (fq < 2) {
          float o[8];
          const f32x4 n0 = *(const f32x4*)(Nab + fr * 32 + 16 + fq * 8), n1 = *(const f32x4*)(Nab + fr * 32 + 16 + fq * 8 + 4);
          o[0] = n0[0]; o[1] = n0[1]; o[2] = n0[2]; o[3] = n0[3]; o[4] = n1[0]; o[5] = n1[1]; o[6] = n1[2]; o[7] = n1[3];
          uint4 u = pack8(o);
          n12 = *reinterpret_cast<bf16x8*>(&u);
          t22 = *reinterpret_cast<const bf16x8*>(TT + (16 + fr) * 40 + 16 + fq * 8);
          t11 = *reinterpret_cast<const bf16x8*>(T11b + fr * 40 + fq * 8);
        }
        const f32x4 m1 = MFMA16(n12, t22, zero);
        *(uint2*)(M1T + fr * 40 + fq * 4) = pack4(m1);
        __builtin_amdgcn_wave_barrier();
        bf16x8 m1f = zf;
        if (fq < 2) m1f = *reinterpret_cast<const bf16x8*>(M1T + fr * 40 + fq * 8);
        const f32x4 t12 = MFMA16(t11, m1f, zero);
        *(uint2*)(TT + (16 + fr) * 40 + fq * 4) = pack4(t12);
      } else if (wave == 1) {
        unsigned z0;
        asm volatile("v_mov_b32 %0, 0" : "=v"(z0));
        *(uint2*)(TT + (lane >> 2) * 40 + 16 + (lane & 3) * 4) = make_uint2(z0, z0);
      } else if (wave < 6) {
        const int vtile = wave - 2;
        const bf16x8 vf = ldfrag(VT, 40, vtile * 16, 0, fr, fq);
        const f32x4 zero = {0.f, 0.f, 0.f, 0.f};
#pragma unroll
        for (int tt = 0; tt < 2; ++tt) {
          const f32x4 acc = MFMA16(ldfrag(NakT, 40, tt * 16, 0, fr, fq), vf, zero);
          *(uint2*)(VNb + (vtile * 16 + fr) * 40 + tt * 16 + fq * 4) = pack4(acc);
        }
      }
      lds_barrier();
      {
        const int tt = wave & 1, rt = wave >> 1;
        const f32x4 zero = {0.f, 0.f, 0.f, 0.f};
        const bf16x8 tf = ldfrag(TT, 40, tt * 16, 0, fr, fq);
        const f32x4 zacc = MFMA16(tf, ldfrag(VNb, 40, rt * 16, 0, fr, fq), zero);
        const f32x4 wacc = MFMA16(tf, ldfrag(AtTb, 40, rt * 16, 0, fr, fq), zero);
        *(uint2*)(Zb + (rt * 16 + fr) * 40 + tt * 16 + fq * 4) = pack4(zacc);
        *(uint2*)(Wb + (rt * 16 + fr) * 40 + tt * 16 + fq * 4) = pack4(wacc);
      }
      lds_barrier();
      f32x4 yacc = {0.f, 0.f, 0.f, 0.f};
      {
        const float pl0 = PLs[nt0 * 16 + fr], pl1 = PLs[nt1 * 16 + fr];
        Sa = Sa * pl0; Sb = Sb * pl1;
        const bf16x8 zf = ldfrag(Zb, 40, mt * 16, 0, fr, fq), vf = ldfrag(VT, 40, mt * 16, 0, fr, fq), wf = ldfrag(Wb, 40, mt * 16, 0, fr, fq);
        const bf16x8 bb0 = ldfrag(Bb, 40, nt0 * 16, 0, fr, fq), bb1 = ldfrag(Bb, 40, nt1 * 16, 0, fr, fq);
        const bf16x8 kb0 = ldfrag(Kb, 40, nt0 * 16, 0, fr, fq), kb1 = ldfrag(Kb, 40, nt1 * 16, 0, fr, fq);
        const bf16x8 nbr = ldfrag(NbrT, 40, hn * 16, 0, fr, fq), nkr = ldfrag(NkrT, 40, hn * 16, 0, fr, fq);
        Sa = MFMA16(zf, bb0, Sa); Sa = MFMA16(vf, kb0, Sa);
        Sb = MFMA16(zf, bb1, Sb); Sb = MFMA16(vf, kb1, Sb);
        yacc = MFMA16(zf, nbr, yacc); yacc = MFMA16(vf, nkr, yacc);
        const f32x4 zero = {0.f, 0.f, 0.f, 0.f};
        const f32x4 g0 = MFMA16(wf, bb0, zero), g1 = MFMA16(wf, bb1, zero);
        f32x4 ry = MFMA16(wf, nbr, zero);
        *(uint2*)(GT + (nt0 * 16 + fr) * 72 + mt * 16 + fq * 4) = pack4(g0);
        *(uint2*)(GT + (nt1 * 16 + fr) * 72 + mt * 16 + fq * 4) = pack4(g1);
        const uint2 rr = *(const uint2*)(Rt + (hn * 16 + fr) * 72 + mt * 16 + fq * 4);
        ry[0] += bf_lo(rr.x); ry[1] += bf_hi(rr.x); ry[2] += bf_lo(rr.y); ry[3] += bf_hi(rr.y);
        *(uint2*)(RyT + (hn * 16 + fr) * 72 + mt * 16 + fq * 4) = pack4(ry);
      }
      lds_barrier();
      {
        const bf16_t* Scur = Sbf + (c & 1) * 64 * 72;
        bf16_t* Snext = Sbf + ((c + 1) & 1) * 64 * 72;
#pragma unroll
        for (int ks = 0; ks < 2; ++ks) {
          const bf16x8 af = ldfrag(Scur, 72, mt * 16, ks * 32, fr, fq);
          Sa = MFMA16(af, ldfrag(GT, 72, nt0 * 16, ks * 32, fr, fq), Sa);
          Sb = MFMA16(af, ldfrag(GT, 72, nt1 * 16, ks * 32, fr, fq), Sb);
          yacc = MFMA16(af, ldfrag(RyT, 72, hn * 16, ks * 32, fr, fq), yacc);
        }
        y_def = pack4(yacc);
#pragma unroll
        for (int jj = 0; jj < 4; ++jj) {
          Snext[(mt * 16 + fq * 4 + jj) * 72 + nt0 * 16 + fr] = (bf16_t)(cvt_pk_bf16(Sa[jj], 0.f) & 0xffff);
          Snext[(mt * 16 + fq * 4 + jj) * 72 + nt1 * 16 + fr] = (bf16_t)(cvt_pk_bf16(Sb[jj], 0.f) & 0xffff);
        }
      }
      lds_barrier();
    }
    {
      const int ip = (nch - 1) * 32 + hn * 16 + fr, tp = d ? T - 1 - ip : ip;
      *(uint2*)(yout + (size_t)(r0seq + tp) * 512 + h * 64 + mt * 16 + fq * 4) = y_def;
      if (role == 2 && cq == 0) { const int is_ = (nch - 1) * 32 + th * 16 + tl, tg = d ? T - 1 - is_ : is_; P_SBON[((size_t)(r0seq + tg) * 8 + h) * 2 + d] = sb_def; }
    }
  }
  if (item >= 128) {
    const int nb = gridDim.x - 128;
    for (int tile = item - 128; tile < NTOK / 32; tile += nb) pool_tile(z, P_RH, tile, tid);
  }
}

__device__ __forceinline__ void post_phase(PREF p, char* smem, const int wid_u) {
  bf16_t* Ag = (bf16_t*)smem;
  bf16_t* vt = (bf16_t*)(smem + 12800);
  float* ys = (float*)(smem + 12800 + 33280);
  const bf16_t* z = P_RU;
  const bf16_t* yf = P_RY;
  const bf16_t* ybk = P_RY + (size_t)NTOK * 512;
  bf16_t* mo = P_RH;
  const int tid = opaque_tid(), w = tid >> 6, lane = tid & 63, fr = lane & 15, fq = lane >> 4;
  bf16x8 Bg[4][6];
#pragma unroll
  for (int nt = 0; nt < 4; ++nt)
#pragma unroll
    for (int ks = 0; ks < 6; ++ks) {
      float o[8];
#pragma unroll
      for (int q = 0; q < 8; ++q) { const int k = ks * 32 + fq * 8 + q; o[q] = k < 160 ? p.g2[(size_t)k * 512 + w * 64 + nt * 16 + fr] : 0.f; }
      uint4 u = pack8(o);
      Bg[nt][ks] = *reinterpret_cast<bf16x8*>(&u);
    }
  float lng[4], lnb[4];
#pragma unroll
  for (int nt = 0; nt < 4; ++nt) { lng[nt] = p.lnx_g[w * 64 + nt * 16 + fr]; lnb[nt] = p.lnx_b[w * 64 + nt * 16 + fr]; }

  for (int tile = blockIdx.x; tile < NTOK / 32; tile += gridDim.x) {
    const int row0 = tile * 32;
    int s, t0, T;
    row_seq(row0, s, t0, T);
    for (int idx = tid; idx < 32 * 24; idx += NTHR) {
      const int tok = idx / 24, oc = idx % 24;
      float o[8];
      if (oc < 20) {
        load_shift8(z, row0 + tok, t0 + tok, T, 2304 + oc * 8, p.shift_mu, o);
#pragma unroll
        for (int q = 0; q < 8; ++q) o[q] = sigmoidf_(o[q]);
      } else {
#pragma unroll
        for (int q = 0; q < 8; ++q) o[q] = 0.f;
      }
      *(uint4*)(Ag + tok * 200 + oc * 8) = pack8(o);
    }
#pragma unroll 1
    for (int half_ = 0; half_ < 2; ++half_) {
      uint4 zc[2], zp[2], zn[2], ya[2], yb4[2];
#pragma unroll
      for (int i = 0; i < 2; ++i) {
        const int idx = tid + (half_ * 2 + i) * NTHR, tok = idx >> 6, oc = idx & 63, row = row0 + tok, t = t0 + tok;
        const bf16_t* pz = z + (size_t)row * ZLD + 1536 + oc * 8;
        zc[i] = *(const uint4*)pz;
        zp[i] = make_uint4(0, 0, 0, 0); zn[i] = zp[i];
        if (t > 0) zp[i] = *(const uint4*)(pz - ZLD);
        if (t < T - 1) zn[i] = *(const uint4*)(pz + ZLD);
        ya[i] = *(const uint4*)(yf + (size_t)row * 512 + oc * 8);
        yb4[i] = *(const uint4*)(ybk + (size_t)row * 512 + oc * 8);
      }
#pragma unroll
      for (int i = 0; i < 2; ++i) {
        const int idx = tid + (half_ * 2 + i) * NTHR, tok = idx >> 6, oc = idx & 63;
        float c[8], pv[8], nx[8], o[8];
        unpack8(zc[i], c); unpack8(zp[i], pv); unpack8(zn[i], nx);
#pragma unroll
        for (int q = 0; q < 8; ++q) o[q] = c[q] + (0.5f * (pv[q] + nx[q]) - c[q]) * p.shift_mu[1536 - 512 + oc * 8 + q];
        *(uint4*)(vt + tok * 520 + oc * 8) = pack8(o);
        float a[8], b[8];
        unpack8(ya[i], a); unpack8(yb4[i], b);
        *(f32x4*)(ys + tok * 516 + oc * 8) = (f32x4){a[0] + b[0], a[1] + b[1], a[2] + b[2], a[3] + b[3]};
        *(f32x4*)(ys + tok * 516 + oc * 8 + 4) = (f32x4){a[4] + b[4], a[5] + b[5], a[6] + b[6], a[7] + b[7]};
      }
    }
    __syncthreads();
    f32x4 acc[2][4] = {};
#pragma unroll
    for (int ks = 0; ks < 6; ++ks) {
      bf16x8 a[2];
#pragma unroll
      for (int mt = 0; mt < 2; ++mt) a[mt] = *reinterpret_cast<const bf16x8*>(Ag + (mt * 16 + fr) * 200 + ks * 32 + fq * 8);
#pragma unroll
      for (int mt = 0; mt < 2; ++mt)
#pragma unroll
        for (int nt = 0; nt < 4; ++nt) acc[mt][nt] = __builtin_amdgcn_mfma_f32_16x16x32_bf16(a[mt], Bg[nt][ks], acc[mt][nt], 0, 0, 0);
    }
#pragma unroll
    for (int mt = 0; mt < 2; ++mt)
#pragma unroll
      for (int jj = 0; jj < 4; ++jj) {
        const int tok = mt * 16 + fq * 4 + jj, row = row0 + tok;
        float yv[4], sm_ = 0.f;
#pragma unroll
        for (int nt = 0; nt < 4; ++nt) { yv[nt] = ys[tok * 516 + w * 64 + nt * 16 + fr]; sm_ += yv[nt]; }
        const float mean = row16_sum(sm_) * (1.f / 64.f);
        float vs = 0.f;
#pragma unroll
        for (int nt = 0; nt < 4; ++nt) { yv[nt] -= mean; vs += yv[nt] * yv[nt]; }
        const float rs = rsqrtf(row16_sum(vs) * (1.f / 64.f) + 64e-5f);
        const float2 sb2 = *(const float2*)(P_SBON + ((size_t)row * 8 + w) * 2);
        const float sbs = sb2.x + sb2.y;
#pragma unroll
        for (int nt = 0; nt < 4; ++nt) {
          const float vv = bf2f(vt[tok * 520 + w * 64 + nt * 16 + fr]);
          const float o = (yv[nt] * rs * lng[nt] + lnb[nt] + sbs * vv) * acc[mt][nt][jj];
          mo[(size_t)row * D + 512 + w * 64 + nt * 16 + fr] = (bf16_t)(cvt_pk_bf16(o, 0.f) & 0xffff);
        }
      }
    __syncthreads();
  }
}

#define XB_TMO      128
#define XB_XCNT(j)  (256  + 64 * (j))
#define XB_XSUB(j)  (1280 + 64 * (j))
#define XB_XGEN(j)  (2304 + 64 * (j))
#define XB_TOP      3328
#define XB_TOPGEN   3392
#define XCD_BAR_WORDS 3456
#define XB_SPIN_CAP (1u << 22)
__device__ __forceinline__ unsigned xb_ld(unsigned* p)              { return __hip_atomic_load(p, __ATOMIC_RELAXED, __HIP_MEMORY_SCOPE_AGENT); }
__device__ __forceinline__ unsigned xb_add(unsigned* p, unsigned v) { return __hip_atomic_fetch_add(p, v, __ATOMIC_RELAXED, __HIP_MEMORY_SCOPE_AGENT); }
__device__ __forceinline__ unsigned xb_xcc_id() { return (unsigned)__builtin_amdgcn_s_getreg((3 << 11) | 20) & 0xFu; }
#define XB_SPIN(cond, bar) do { unsigned _sp = 0; while (cond) { __builtin_amdgcn_s_sleep(1); \
    if ((++_sp & 255u) == 0u) { if (xb_ld(&(bar)[XB_TMO])) break; if (_sp > XB_SPIN_CAP) { atomicAdd(&(bar)[XB_TMO], 1u); break; } } } } while (0)
struct XcdBarrier { unsigned* bar; unsigned x; volatile LAS unsigned* st; };
__device__ __forceinline__ void xcd_barrier_complete(unsigned* bar, unsigned x, unsigned& nloc, unsigned& nx) {
  const unsigned G = gridDim.x * gridDim.y * gridDim.z;
  unsigned sum, cnt, mine, sp = 0u;
  for (;;) {
    sum = 0u; cnt = 0u; mine = 0u;
#pragma unroll
    for (unsigned j = 0; j < 16; ++j) { const unsigned c = xb_ld(&bar[XB_XCNT(j)]); sum += c; cnt += (c > 0u) ? 1u : 0u; mine = (j == x) ? c : mine; }
    if (sum == G) break;
    __builtin_amdgcn_s_sleep(1);
    if ((++sp & 255u) == 0u) { if (xb_ld(&bar[XB_TMO])) break; if (sp > XB_SPIN_CAP) { atomicAdd(&bar[XB_TMO], 1u); break; } }
  }
  nloc = mine > 0u ? mine : 1u; nx = cnt > 0u ? cnt : 1u;
}
__device__ __forceinline__ void xcd_barrier(PREF p, volatile LAS unsigned* st_, const int wid_u) {
  asm volatile("s_waitcnt vmcnt(0)" ::: "memory");
  __syncthreads();
  if (opaque_tid() == 0) {
    XcdBarrier b; b.bar = (unsigned*)(p.ws + OFF_BAR); b.x = xb_xcc_id(); b.st = st_;
    unsigned* bar = b.bar;
    __builtin_amdgcn_s_waitcnt(0);
    unsigned nloc = b.st[0], nx = b.st[1];
    if (nloc == 0u) { xcd_barrier_complete(bar, b.x, nloc, nx); b.st[0] = nloc; b.st[1] = nx; }
    const unsigned old = xb_add(&bar[XB_XSUB(b.x)], 1u);
    const unsigned gen = old / nloc;
    if (old + 1u == (gen + 1u) * nloc) {
      __builtin_amdgcn_fence(__ATOMIC_RELEASE, "agent");
      asm volatile("s_waitcnt vmcnt(0)" ::: "memory");
      const unsigned og = xb_add(&bar[XB_TOP], 1u);
      const unsigned tg = og / nx;
      if (og + 1u == (tg + 1u) * nx) xb_add(&bar[XB_TOPGEN], 1u);
      else XB_SPIN(xb_ld(&bar[XB_TOPGEN]) == tg, bar);
      __builtin_amdgcn_fence(__ATOMIC_ACQUIRE, "agent");
      xb_add(&bar[XB_XGEN(b.x)], 1u);
      asm volatile("s_waitcnt vmcnt(0)" ::: "memory");
    } else {
      XB_SPIN(xb_ld(&bar[XB_XGEN(b.x)]) == gen, bar);
      __builtin_amdgcn_fence(__ATOMIC_ACQUIRE, "agent");
      asm volatile("s_waitcnt vmcnt(0)" ::: "memory");
    }
  }
  __syncthreads();
}

constexpr int NPHASE = 14;
__device__ __forceinline__ void do_phase(PREF p, int ph, char* smem, const int wid_u) {
  if (ph == 0) prep_phase(p, smem, wid_u);
  else if (ph == 1) row_phase<0>(p.x_prompt, p.x_sample, nullptr, nullptr, P_RH, P_MOD, nullptr, p.n1_pre, 0, 0.f, 0, wid_u);
  else if (ph == 4 || ph == 10) {
    const bool f = ph == 4;
    float* outp = p.out;
    row_phase<1>(sel(f, p.x_prompt, (const float*)outp), sel(f, p.x_sample, (const float*)(outp + (size_t)NPROMPT * D)), outp, P_RY, P_RH, P_MOD,
                 sel(f, p.n1_post, p.nm_post), sel(f, p.nm_pre, p.n2_pre), f ? 2 : 5, f ? 0.5f : 1.0f, f ? 3 : 6, wid_u);
  }
  else if (ph == 13) row_phase<2>(p.out, p.out + (size_t)NPROMPT * D, p.out, P_RY, nullptr, P_MOD, p.n2_post, nullptr, 8, 0.5f, 0, wid_u);
  else if (ph == 6) lora_prep_phase(p, wid_u);
  else if (ph == 7) scan_phase(p, smem, wid_u);
  else if (ph == 8) post_phase(p, smem, wid_u);
  else {
    const bf16_t *A, *Bt; bf16_t* C; int N, K, ldc, epi;
    if (ph == 2 || ph == 11) { A = P_RH; Bt = sel(ph == 2, P_W13A, P_W13B); C = P_RU; N = 2 * FF; K = D; ldc = FF; epi = 1; }
    else if (ph == 3 || ph == 12) { A = P_RU; Bt = sel(ph == 3, P_W2A, P_W2B); C = P_RY; N = D; K = FF; ldc = D; epi = 0; }
    else if (ph == 5) { A = P_RH; Bt = P_WINT; C = P_RU; N = ZLD; K = D; ldc = ZLD; epi = 0; }
    else { A = P_RH; Bt = P_WOUTT; C = P_RY; N = D; K = D; ldc = D; epi = 0; }
    gemm_phase(A, Bt, C, NTOK, N, K, ldc, epi, smem, wid_u);
  }
}

extern __shared__ __attribute__((aligned(16))) char dyn_smem[];

__global__ void __launch_bounds__(NTHR, 2) mega_kernel(Params p) {
  cg::grid_group grid = cg::this_grid();
  const int wid_u = __builtin_amdgcn_readfirstlane(threadIdx.x >> 6);
  typedef const __attribute__((address_space(4))) Params* KP;
  const KP kp0 = (KP)__builtin_amdgcn_kernarg_segment_ptr();
  volatile LAS unsigned* st = (volatile LAS unsigned*)((LAS char*)dyn_smem + (SMEM_BYTES - 16));
  if (threadIdx.x < 2) st[threadIdx.x] = 0u;
  __syncthreads();
  if (threadIdx.x == 0) (void)xb_add(&((unsigned*)(kp0->ws + OFF_BAR))[XB_XCNT(xb_xcc_id())], 1u);
#pragma unroll 1
  for (int ph = 0; ph < NPHASE; ++ph) {
    KP kp = kp0;
    asm volatile("" : "+s"(kp));
    do_phase(*kp, ph, dyn_smem, wid_u);
#ifdef PROBE_REPEAT
    if (ph == PROBE_REPEAT) { grid.sync(); do_phase(*kp, ph, dyn_smem, wid_u); }
#endif
    if (ph == 0) grid.sync();
    else if (ph + 1 < NPHASE) xcd_barrier(*kp, (volatile LAS unsigned*)((LAS char*)dyn_smem + (SMEM_BYTES - 16)), wid_u);
  }
}

__global__ void __launch_bounds__(NTHR, 2) phase_kernel(Params p, int ph) {
  const int wid_u = __builtin_amdgcn_readfirstlane(threadIdx.x >> 6);
  do_phase(*(const __attribute__((address_space(4))) Params*)__builtin_amdgcn_kernarg_segment_ptr(), ph, dyn_smem, wid_u);
}

extern "C" void kernel_launch(void* const* d_in, const int* in_sizes, int n_in, void* d_out, int out_size, void* d_ws, size_t ws_size,
                              hipStream_t stream) {
  Params p{};
  const float** f = (const float**)&p;
  for (int i = 0; i < 33; ++i) f[i] = (const float*)d_in[i];
  p.out = (float*)d_out;
  p.ws = (char*)d_ws;
  if (WS_NEED > ws_size) { fprintf(stderr, "workspace too small: need %zu have %zu\n", (size_t)WS_NEED, ws_size); return; }

#if ONE_LAUNCH
  static int grid_blocks = 0;
  if (!grid_blocks) {
    int dev = 0, cus = 0, per_cu = 0;
    (void)hipGetDevice(&dev);
    (void)hipDeviceGetAttribute(&cus, hipDeviceAttributeMultiprocessorCount, dev);
    (void)hipFuncSetAttribute((const void*)mega_kernel, hipFuncAttributeMaxDynamicSharedMemorySize, SMEM_BYTES);
    (void)hipOccupancyMaxActiveBlocksPerMultiprocessor(&per_cu, mega_kernel, NTHR, SMEM_BYTES);
    if (per_cu < 1) per_cu = 1;
    grid_blocks = cus * per_cu;
  }
  (void)hipMemsetAsync(p.ws + OFF_BAR, 0, XCD_BAR_WORDS * sizeof(unsigned), stream);
  void* args[] = {&p};
  hipError_t e = hipLaunchCooperativeKernel((const void*)mega_kernel, dim3(grid_blocks), dim3(NTHR), args, SMEM_BYTES, stream);
  if (e != hipSuccess) fprintf(stderr, "cooperative launch failed: %s (grid %d)\n", hipGetErrorString(e), grid_blocks);
#else
  static bool attr = false;
  if (!attr) { (void)hipFuncSetAttribute((const void*)phase_kernel, hipFuncAttributeMaxDynamicSharedMemorySize, SMEM_BYTES); attr = true; }
  for (int ph = 0; ph < NPHASE; ++ph) phase_kernel<<<256, NTHR, SMEM_BYTES, stream>>>(p, ph);
#endif
}
```

```cpp
#include <hip/hip_runtime.h>
#include <hip/hip_cooperative_groups.h>
#include <cstdio>
namespace cg = cooperative_groups;

#ifndef ONE_LAUNCH
#define ONE_LAUNCH 1
#endif

typedef unsigned short bf16_t;
typedef short bf16x8 __attribute__((ext_vector_type(8)));
typedef float f32x4 __attribute__((ext_vector_type(4)));
typedef float f32x2 __attribute__((ext_vector_type(2)));
#define LAS __attribute__((address_space(3)))

constexpr int D = 1024, FF = 2816, NTOK = 98304, NPROMPT = 32768, ZLD = 2560, PINW = 2464;
constexpr int NTHR = 512;
constexpr int SMEM_BYTES = 162320;

struct Params {
  const float *x_prompt, *x_sample, *c_prompt, *c_sample, *ada_w, *ada_b, *n1_pre, *n1_post, *f1_w1, *f1_w3, *f1_w2,
      *nm_pre, *nm_post, *w_in, *shift_mu, *pool_w, *pool_scale, *w0, *w2, *a0, *a2, *g2, *k_k, *k_a, *r_k, *lnx_g, *lnx_b,
      *w_out, *n2_pre, *n2_post, *f2_w1, *f2_w3, *f2_w2;
  float* out;
  char* ws;
};
#define PREF const __attribute__((address_space(4))) Params&
constexpr size_t al256(size_t b) { return (b + 255) & ~(size_t)255; }
constexpr size_t OFF_W13A = 0;
constexpr size_t OFF_W13B = OFF_W13A + al256((size_t)2 * FF * D * 2);
constexpr size_t OFF_W2A = OFF_W13B + al256((size_t)2 * FF * D * 2);
constexpr size_t OFF_W2B = OFF_W2A + al256((size_t)D * FF * 2);
constexpr size_t OFF_WINT = OFF_W2B + al256((size_t)D * FF * 2);
constexpr size_t OFF_WOUTT = OFF_WINT + al256((size_t)ZLD * D * 2);
constexpr size_t OFF_MOD = OFF_WOUTT + al256((size_t)D * D * 2);
constexpr size_t OFF_SBON = OFF_MOD + al256((size_t)16 * 9216 * 4);
constexpr size_t OFF_RH = OFF_SBON + al256((size_t)NTOK * 16 * 4);
constexpr size_t OFF_RY = OFF_RH + al256((size_t)NTOK * D * 2);
constexpr size_t OFF_RU = OFF_RY + al256((size_t)NTOK * D * 2);
constexpr size_t OFF_ALORA = OFF_RU + al256((size_t)NTOK * FF * 2);
constexpr size_t OFF_BAR = OFF_ALORA + al256((size_t)NTOK * 256 * 2);
constexpr size_t WS_NEED = OFF_BAR + 16384;
#define P_W13A ((bf16_t*)(p.ws + OFF_W13A))
#define P_W13B ((bf16_t*)(p.ws + OFF_W13B))
#define P_W2A ((bf16_t*)(p.ws + OFF_W2A))
#define P_W2B ((bf16_t*)(p.ws + OFF_W2B))
#define P_WINT ((bf16_t*)(p.ws + OFF_WINT))
#define P_WOUTT ((bf16_t*)(p.ws + OFF_WOUTT))
#define P_MOD ((float*)(p.ws + OFF_MOD))
#define P_SBON ((float*)(p.ws + OFF_SBON))
#define P_RH ((bf16_t*)(p.ws + OFF_RH))
#define P_RY ((bf16_t*)(p.ws + OFF_RY))
#define P_RU ((bf16_t*)(p.ws + OFF_RU))
#define P_ALORA ((bf16_t*)(p.ws + OFF_ALORA))

typedef __bf16 bf16x2_t __attribute__((ext_vector_type(2)));
__device__ __forceinline__ unsigned cvt_pk_bf16(float lo, float hi) {
  f32x2 v = {lo, hi};
  bf16x2_t b = __builtin_convertvector(v, bf16x2_t);
  return __builtin_bit_cast(unsigned, b);
}
__device__ __forceinline__ float bf_lo(unsigned u) { return __uint_as_float(u << 16); }
__device__ __forceinline__ float bf_hi(unsigned u) { return __uint_as_float(u & 0xffff0000u); }
__device__ __forceinline__ float bf2f(bf16_t b) { return __uint_as_float(((unsigned)b) << 16); }
__device__ __forceinline__ void unpack8(uint4 v, float* o) {
  o[0] = bf_lo(v.x); o[1] = bf_hi(v.x); o[2] = bf_lo(v.y); o[3] = bf_hi(v.y);
  o[4] = bf_lo(v.z); o[5] = bf_hi(v.z); o[6] = bf_lo(v.w); o[7] = bf_hi(v.w);
}
__device__ __forceinline__ uint4 pack8(const float* o) {
  uint4 v; v.x = cvt_pk_bf16(o[0], o[1]); v.y = cvt_pk_bf16(o[2], o[3]); v.z = cvt_pk_bf16(o[4], o[5]); v.w = cvt_pk_bf16(o[6], o[7]);
  return v;
}
__device__ __forceinline__ float sigmoidf_(float x) { return __builtin_amdgcn_rcpf(1.f + __expf(-x)); }
template <int CTRL> __device__ __forceinline__ float dpp_f(float x) {
  return __int_as_float(__builtin_amdgcn_update_dpp(0, __float_as_int(x), CTRL, 0xf, 0xf, false));
}
__device__ __forceinline__ float row16_sum(float x) {
  x += dpp_f<0x128>(x); x += dpp_f<0x124>(x); x += dpp_f<0x122>(x); x += dpp_f<0x121>(x);
  return x;
}
template <class T> __device__ __forceinline__ T sel(bool c, T a, T b) { return c ? a : b; }
__device__ __forceinline__ int opaque_tid_w(int wid) {
  int l;
  asm volatile("v_mbcnt_lo_u32_b32 %0, -1, 0\n\tv_mbcnt_hi_u32_b32 %0, -1, %0" : "=v"(l));
  return wid * 64 + l;
}
#define opaque_tid() opaque_tid_w(wid_u)
__device__ __forceinline__ float wave_sum(float v) {
  v = row16_sum(v);
  const float a = __int_as_float(__builtin_amdgcn_readlane(__float_as_int(v), 0)), b = __int_as_float(__builtin_amdgcn_readlane(__float_as_int(v), 16));
  const float c = __int_as_float(__builtin_amdgcn_readlane(__float_as_int(v), 32)), d = __int_as_float(__builtin_amdgcn_readlane(__float_as_int(v), 48));
  return (a + b) + (c + d);
}
__device__ __forceinline__ float quad_sum(float x) { x += dpp_f<0xB1>(x); x += dpp_f<0x4E>(x); return x; }
__device__ __forceinline__ int seq_start(int s) { return s < 8 ? s * 4096 : NPROMPT + (s - 8) * 8192; }
__device__ __forceinline__ void row_seq(int row, int& s, int& t, int& T) {
  if (row < NPROMPT) { s = row >> 12; t = row & 4095; T = 4096; }
  else { int r = row - NPROMPT; s = 8 + (r >> 13); t = r & 8191; T = 8192; }
}

__device__ __forceinline__ void tr_tile(const float* __restrict__ src, int ldsrc, int k0, int n0, int nvalid, bf16_t* __restrict__ dst, int ldd,
                        int kdst0, int mode, float* sm, const int tid) {
#pragma unroll
  for (int i = 0; i < 2; ++i) {
    const int r = (tid >> 4) + 32 * i, c = (tid & 15) * 4;
    float4 v = make_float4(0.f, 0.f, 0.f, 0.f);
    if (n0 + c < nvalid) v = *(const float4*)(src + (size_t)(k0 + r) * ldsrc + n0 + c);
    float* d = sm + r * 65 + c;
    d[0] = v.x; d[1] = v.y; d[2] = v.z; d[3] = v.w;
  }
  __syncthreads();
  {
    const int n = tid >> 3, kc = (tid & 7) * 8;
    float o[8];
#pragma unroll
    for (int j = 0; j < 8; ++j) o[j] = sm[(kc + j) * 65 + n];
    int nn = n0 + n, drow;
    const int c32 = nn & 31, slot = 16 * ((c32 >> 2) & 1) + 4 * (c32 >> 3) + (c32 & 3);
    if (mode == 0) drow = (nn & ~31) + slot;
    else drow = 256 * (nn >> 7) + (mode == 2 ? 128 : 0) + ((nn & 127) & ~31) + slot;
    *(uint4*)(dst + (size_t)drow * ldd + kdst0 + k0 + kc) = pack8(o);
  }
  __syncthreads();
}

__device__ __forceinline__ void prep_phase(PREF p, char* smem, const int wid_u) {
  float* sm = (float*)smem;
  const int tid = opaque_tid();
  constexpr int N_MOD = 144, N_EFF = 128, N_W13 = 4 * 704, N_W2 = 2 * 704, N_WIN = 640, N_WOUT = 128;
  constexpr int TOTAL = N_MOD + N_EFF + N_W13 + N_W2 + N_WIN + N_WOUT;
  for (int item = blockIdx.x; item < TOTAL; item += gridDim.x) {
    int it = item;
    if (it < N_MOD) {
      const int j0 = it * 64;
      float* sc = sm;
      float* red = sm + 16384;
      for (int idx = tid; idx < 16384; idx += NTHR) {
        const int s = idx >> 10, k = idx & 1023;
        const float* cp_ = p.c_prompt; const float* cs_ = p.c_sample;
        const float c = s < 8 ? cp_[s * 1024 + k] : cs_[(s - 8) * 1024 + k];
        sc[idx] = c / (1.f + __expf(-c));
      }
      __syncthreads();
      const int col = tid & 63, kg = tid >> 6;
      float acc[16];
#pragma unroll
      for (int s = 0; s < 16; ++s) acc[s] = 0.f;
      for (int k = kg * 128; k < kg * 128 + 128; ++k) {
        const float w = p.ada_w[(size_t)k * 9216 + j0 + col];
#pragma unroll
        for (int s = 0; s < 16; ++s) acc[s] += sc[s * 1024 + k] * w;
      }
#pragma unroll
      for (int s = 0; s < 16; ++s) red[(kg * 16 + s) * 64 + col] = acc[s];
      __syncthreads();
      for (int o = tid; o < 1024; o += NTHR) {
        const int s = o >> 6, c2 = o & 63;
        float v = p.ada_b[j0 + c2];
#pragma unroll
        for (int g = 0; g < 8; ++g) v += red[(g * 16 + s) * 64 + c2];
        P_MOD[s * 9216 + j0 + c2] = v;
      }
      __syncthreads();
      continue;
    }
    it -= N_MOD;
    if (it < N_EFF) {
      const int g = it >> 5, itile = (it >> 4) & 1, ntile = it & 15;
      float* As = sm;
      float* Bs = sm + 64 * 129;
      for (int idx = tid; idx < 64 * 128; idx += NTHR) {
        const int i = idx >> 7, j = idx & 127;
        As[i * 129 + j] = p.pool_w[((size_t)g * 128 + itile * 64 + i) * 128 + j] * p.pool_scale[g * 128 + j];
      }
      for (int idx = tid; idx < 128 * 64; idx += NTHR) {
        const int j = idx >> 6, nn = idx & 63;
        Bs[j * 65 + nn] = p.w_out[(size_t)(g * 128 + j) * 1024 + ntile * 64 + nn];
      }
      __syncthreads();
      const int i = tid >> 3, nn0 = (tid & 7) * 8;
      float acc[8];
#pragma unroll
      for (int q = 0; q < 8; ++q) acc[q] = 0.f;
      for (int j = 0; j < 128; ++j) {
        const float a = As[i * 129 + j];
#pragma unroll
        for (int q = 0; q < 8; ++q) acc[q] += a * Bs[j * 65 + nn0 + q];
      }
#pragma unroll
      for (int q = 0; q < 8; ++q)
      {
        const int nn = ntile * 64 + nn0 + q, c32 = nn & 31, slot = 16 * ((c32 >> 2) & 1) + 4 * (c32 >> 3) + (c32 & 3);
        P_WOUTT[(size_t)((nn & ~31) + slot) * 1024 + g * 128 + itile * 64 + i] = (bf16_t)(cvt_pk_bf16(acc[q], 0.f) & 0xffff);
      }
      __syncthreads();
      continue;
    }
    it -= N_EFF;
    if (it < N_W13) {
      const int which = it / 704, r = it % 704;
      const int kt = r / 44, ntl = r % 44;
      const float* src = sel(which < 2, sel(which == 0, p.f1_w1, p.f1_w3), sel(which == 2, p.f2_w1, p.f2_w3));
      bf16_t* dst = sel(which < 2, P_W13A, P_W13B);
      tr_tile(src, FF, kt * 64, ntl * 64, FF, dst, D, 0, (which & 1) ? 2 : 1, sm, tid);
      continue;
    }
    it -= N_W13;
    if (it < N_W2) {
      const int which = it / 704, r = it % 704;
      const int kt = r / 16, ntl = r % 16;
      tr_tile(sel(which != 0, p.f2_w2, p.f1_w2), D, kt * 64, ntl * 64, D, sel(which != 0, P_W2B, P_W2A), FF, 0, 0, sm, tid);
      continue;
    }
    it -= N_W2;
    if (it < N_WIN) {
      const int kt = it / 40, ntl = it % 40;
      tr_tile(p.w_in, PINW, kt * 64, ntl * 64, PINW, P_WINT, D, 0, 0, sm, tid);
      continue;
    }
    it -= N_WIN;
    {
      const int kt = it / 16, ntl = it % 16;
      tr_tile(p.w_out + (size_t)512 * 1024, D, kt * 64, ntl * 64, D, P_WOUTT, D, 512, 0, sm, tid);
    }
  }
}

template <int MODE>
__device__ __forceinline__ void row_phase(const float* __restrict__ xp, const float* __restrict__ xs, float* __restrict__ xout,
                          const bf16_t* __restrict__ y, bf16_t* __restrict__ h, const float* __restrict__ mod,
                          const float* __restrict__ npost, const float* __restrict__ npre, int gate_idx, float cgate, int shift_idx, const int wid_u) {
  const int tid_ = opaque_tid();
  const int lane = tid_ & 63;
  const int gw = blockIdx.x * 8 + (tid_ >> 6), GW = gridDim.x * 8;
  for (int chunk = gw; chunk < NTOK / 16; chunk += GW) {
    const int row0 = chunk * 16;
    int s, t, T;
    row_seq(row0, s, t, T);
    const float* md = mod + s * 9216;
    f32x4 Am[4], Bm[4], Gm[4];
#pragma unroll
    for (int i = 0; i < 4; ++i) {
      const int c = i * 256 + lane * 4;
      if (MODE != 2) {
        f32x4 np = *(const f32x4*)(npre + c), sc = *(const f32x4*)(md + (shift_idx + 1) * 1024 + c);
        Am[i] = np * (sc + 1.f);
        Bm[i] = *(const f32x4*)(md + shift_idx * 1024 + c);
      }
      if (MODE != 0) {
        f32x4 g = *(const f32x4*)(md + gate_idx * 1024 + c), po = *(const f32x4*)(npost + c);
        Gm[i] = g * po * cgate;
      }
    }
    for (int r = 0; r < 16; ++r) {
      const int row = row0 + r;
      const float* xr = (row < NPROMPT) ? xp + (size_t)row * D : xs + (size_t)(row - NPROMPT) * D;
      f32x4 xv[4];
#pragma unroll
      for (int i = 0; i < 4; ++i) xv[i] = *(const f32x4*)(xr + i * 256 + lane * 4);
      if (MODE != 0) {
        f32x4 yv[4];
        float ss = 0.f;
#pragma unroll
        for (int i = 0; i < 4; ++i) {
          uint2 u = *(const uint2*)(y + (size_t)row * D + i * 256 + lane * 4);
          yv[i] = (f32x4){bf_lo(u.x), bf_hi(u.x), bf_lo(u.y), bf_hi(u.y)};
          ss += yv[i][0] * yv[i][0] + yv[i][1] * yv[i][1] + yv[i][2] * yv[i][2] + yv[i][3] * yv[i][3];
        }
        ss = wave_sum(ss);
        const float rs = rsqrtf(ss * (1.f / 1024.f) + 1e-6f);
#pragma unroll
        for (int i = 0; i < 4; ++i) {
          xv[i] = xv[i] + Gm[i] * yv[i] * rs;
          *(f32x4*)(xout + (size_t)row * D + i * 256 + lane * 4) = xv[i];
        }
      }
      if (MODE != 2) {
        float ss = 0.f;
#pragma unroll
        for (int i = 0; i < 4; ++i) ss += xv[i][0] * xv[i][0] + xv[i][1] * xv[i][1] + xv[i][2] * xv[i][2] + xv[i][3] * xv[i][3];
        ss = wave_sum(ss);
        const float rs = rsqrtf(ss * (1.f / 1024.f) + 1e-6f);
#pragma unroll
        for (int i = 0; i < 4; ++i) {
          f32x4 hv = xv[i] * rs * Am[i] + Bm[i];
          uint2 u; u.x = cvt_pk_bf16(hv[0], hv[1]); u.y = cvt_pk_bf16(hv[2], hv[3]);
          *(uint2*)(h + (size_t)row * D + i * 256 + lane * 4) = u;
        }
      }
    }
  }
}

constexpr int BM = 256, BK = 64, HALF = 128, NXCD = 8, WGM = 4, HT = HALF * BK;
__device__ __forceinline__ int lds_byte(int r, int c) {
  int st = (r >> 4) * 2 + (c >> 5), rr = r & 15, cc = c & 31, ob = rr * 64 + cc * 2;
  return st * 1024 + (ob ^ (((ob >> 9) & 1) << 5));
}
__device__ __forceinline__ void stage_rc(int b, int& R, int& C) {
  int st = b / 1024, sb = b % 1024, swz = sb ^ (((sb >> 9) & 1) << 5);
  R = (st >> 1) * 16 + swz / 64; C = (st & 1) * 32 + (swz % 64) / 2;
}

__device__ __forceinline__ bool gemm_unit(int i, int nM, int nN, int nwg, int& pm, int& pn) {
  const long L = (long)i * gridDim.x + blockIdx.x;
  if (L >= nwg) return false;
  int wgid = (int)L;
  { int q = nwg / NXCD, r = nwg % NXCD, xcd = wgid % NXCD, off = wgid / NXCD;
    wgid = (xcd < r ? xcd * (q + 1) : r * (q + 1) + (xcd - r) * q) + off; }
  const int nig = WGM * nN, gid = wgid / nig, fm = gid * WGM, gsz = min(nM - fm, WGM);
  pm = fm + ((wgid % nig) % gsz); pn = (wgid % nig) / gsz;
  return true;
}

__device__ __forceinline__ void gemm_phase(const bf16_t* __restrict__ A, const bf16_t* __restrict__ Bt, bf16_t* __restrict__ C, int M, int N, int K,
                                           int ldc, const int EPI, char* smem, const int wid_u) {
  const int nM = M / BM, nN = N / BM, nwg = nM * nN;
  const int tid = opaque_tid();
  LAS bf16_t* shm = (LAS bf16_t*)smem;
#define SA(b, h) (shm + ((b) * 2 + (h)) * HT)
#define SB(b, h) (shm + (4 + (b) * 2 + (h)) * HT)
#define STG(P, GB) do { const char* _gb = (GB); \
    _Pragma("unroll") for (int _i = 0; _i < 2; ++_i) { \
      __builtin_amdgcn_global_load_lds((const unsigned*)(_gb + voff[_i]), \
        (LAS unsigned*)((LAS char*)(P) + ldsw + _i * 8192), 16, 0, 0); } } while (0)
#define LDA(dst, b, h) _Pragma("unroll") for (int m = 0; m < 4; ++m) _Pragma("unroll") for (int k = 0; k < 2; ++k) \
    dst[m][k] = *(const LAS bf16x8*)((LAS char*)SA(b, h) + aoff + m * 2048 + k * 1024)
#define LDB(dst, b, h) _Pragma("unroll") for (int n = 0; n < 2; ++n) _Pragma("unroll") for (int k = 0; k < 2; ++k) \
    dst[n][k] = *(const LAS bf16x8*)((LAS char*)SB(b, h) + boff + n * 2048 + k * 1024)
#define MMA(ai, bj, At_, Bt_) do { __builtin_amdgcn_s_setprio(1); \
    _Pragma("unroll") for (int m = 0; m < 4; ++m) _Pragma("unroll") for (int n = 0; n < 2; ++n) _Pragma("unroll") for (int k = 0; k < 2; ++k) \
      acc[ai][bj][m][n] = __builtin_amdgcn_mfma_f32_16x16x32_bf16(Bt_[n][k], At_[m][k], acc[ai][bj][m][n], 0, 0, 0); \
    __builtin_amdgcn_s_setprio(0); } while (0)
#define WAIT_V(n) asm volatile("s_waitcnt vmcnt(" #n ")" ::: "memory")
#define WAIT_L(n) asm volatile("s_waitcnt lgkmcnt(" #n ")" ::: "memory")
#define BAR __builtin_amdgcn_s_barrier()
#define SCHED __builtin_amdgcn_sched_barrier(0)
  const int wid = __builtin_amdgcn_readfirstlane(tid >> 6), lane = tid & 63, wr = wid >> 2, wc = wid & 3, fr = lane & 15, fq = lane >> 4;
  const int aoff = lds_byte(wr * 64 + fr, fq * 8), boff = lds_byte(wc * 32 + fr, fq * 8);
  unsigned voff[2];
  const int ldsw = wid * 1024;
#pragma unroll
  for (int _i = 0; _i < 2; ++_i) { int _r, _c; stage_rc(tid * 16 + _i * 8192, _r, _c); voff[_i] = (unsigned)(_r * K + _c) * 2u; }
  const int nt = K / BK;
  const size_t kstep = (size_t)BK * 2, hstep = (size_t)HALF * K * 2, tstep = 2 * hstep;
  int pm, pn, npm = 0, npn = 0, ui = 0;
  if (!gemm_unit(0, nM, nN, nwg, pm, pn)) return;
  f32x4 acc[2][2][4][2];
#pragma unroll
  for (int a = 0; a < 2; ++a)
#pragma unroll
    for (int b = 0; b < 2; ++b)
#pragma unroll
      for (int m = 0; m < 4; ++m)
#pragma unroll
        for (int n = 0; n < 2; ++n) acc[a][b][m][n] = (f32x4){0.f, 0.f, 0.f, 0.f};
  bf16x8 At[4][2], B0[2][2], B1[2][2];
  const char* cA = (const char*)A + (size_t)pm * tstep;
  const char* cB = (const char*)Bt + (size_t)pn * tstep;
  STG(SB(0, 0), cB); STG(SA(0, 0), cA); STG(SB(0, 1), cB + hstep); STG(SA(0, 1), cA + hstep);
  if (wr == 1) BAR;
  WAIT_V(4); BAR;
  STG(SB(1, 0), cB + kstep); STG(SA(1, 0), cA + kstep); STG(SB(1, 1), cB + hstep + kstep);
  WAIT_V(6); BAR;
  for (;;) {
    const bool has_next = gemm_unit(ui + 1, nM, nN, nwg, npm, npn);
    const char* nA = has_next ? (const char*)A + (size_t)npm * tstep : cA;
    const char* nB = has_next ? (const char*)Bt + (size_t)npn * tstep : cB;
    for (int t = 0; t < nt; t += 2) {
      const bool last = (t == nt - 2);
      const char* a1 = cA + (size_t)(t + 1) * kstep;
      const char* a2 = last ? nA : cA + (size_t)(t + 2) * kstep;
      const char* b2 = last ? nB : cB + (size_t)(t + 2) * kstep;
      const char* a3 = a2 + kstep;
      const char* b3 = b2 + kstep;
      LDB(B0, 0, 0); SCHED; LDA(At, 0, 0); STG(SA(1, 1), a1 + hstep);
      WAIT_L(8); BAR; WAIT_L(0); MMA(0, 0, At, B0); BAR; SCHED;
      LDB(B1, 0, 1); STG(SB(0, 0), b2);
      BAR; WAIT_L(0); MMA(0, 1, At, B1); BAR;
      LDA(At, 0, 1); STG(SA(0, 0), a2);
      BAR; WAIT_L(0); MMA(1, 0, At, B0); BAR; SCHED;
      STG(SB(0, 1), b2 + hstep);
      WAIT_V(6); BAR; MMA(1, 1, At, B1); BAR;
      LDB(B0, 1, 0); SCHED; LDA(At, 1, 0); STG(SA(0, 1), a2 + hstep);
      WAIT_L(8); BAR; WAIT_L(0); MMA(0, 0, At, B0); BAR; SCHED;
      LDB(B1, 1, 1); STG(SB(1, 0), b3);
      BAR; WAIT_L(0); MMA(0, 1, At, B1); BAR;
      LDA(At, 1, 1); STG(SA(1, 0), a3);
      BAR; WAIT_L(0); MMA(1, 0, At, B0); BAR; SCHED;
      STG(SB(1, 1), b3 + hstep);
      WAIT_V(6); BAR; MMA(1, 1, At, B1); BAR;
    }
    {
      const int brow = pm * BM, bcol = pn * BM;
#pragma unroll
      for (int ai = 0; ai < 2; ++ai)
#pragma unroll
        for (int m = 0; m < 4; ++m) {
          const size_t row = (size_t)(brow + ai * HALF + wr * 64 + m * 16 + fr);
          if (EPI == 0) {
#pragma unroll
            for (int bj = 0; bj < 2; ++bj) {
              const f32x4 v0 = acc[ai][bj][m][0], v1 = acc[ai][bj][m][1];
              uint4 u; u.x = cvt_pk_bf16(v0[0], v0[1]); u.y = cvt_pk_bf16(v0[2], v0[3]); u.z = cvt_pk_bf16(v1[0], v1[1]); u.w = cvt_pk_bf16(v1[2], v1[3]);
              *(uint4*)(C + row * ldc + bcol + bj * HALF + wc * 32 + fq * 8) = u;
            }
          } else {
            float o[8];
#pragma unroll
            for (int n = 0; n < 2; ++n) {
              const f32x4 a = acc[ai][0][m][n], b = acc[ai][1][m][n];
#pragma unroll
              for (int j = 0; j < 4; ++j) o[n * 4 + j] = a[j] * __builtin_amdgcn_rcpf(1.f + __expf(-a[j])) * b[j];
            }
            *(uint4*)(C + row * ldc + (bcol >> 1) + wc * 32 + fq * 8) = pack8(o);
          }
        }
    }
    if (!has_next) break;
#pragma unroll
    for (int a = 0; a < 2; ++a)
#pragma unroll
      for (int b = 0; b < 2; ++b)
#pragma unroll
        for (int m = 0; m < 4; ++m)
#pragma unroll
          for (int n = 0; n < 2; ++n) acc[a][b][m][n] = (f32x4){0.f, 0.f, 0.f, 0.f};
    pm = npm; pn = npn; cA = nA; cB = nB; ++ui;
  }
  WAIT_V(0);
  if (wr == 0) BAR;
  BAR;
#undef SA
#undef SB
#undef STG
#undef LDA
#undef LDB
#undef MMA
}

__device__ __forceinline__ void load_shift16(const bf16_t* __restrict__ z, int row, int t, int T, int col, const float* __restrict__ mu, float* o) {
  const bf16_t* pz = z + (size_t)row * ZLD + col;
  uint4 c0 = *(const uint4*)pz, c1 = *(const uint4*)(pz + 8);
  uint4 p0 = make_uint4(0, 0, 0, 0), p1 = p0, n0 = p0, n1 = p0;
  if (t > 0) { p0 = *(const uint4*)(pz - ZLD); p1 = *(const uint4*)(pz - ZLD + 8); }
  if (t < T - 1) { n0 = *(const uint4*)(pz + ZLD); n1 = *(const uint4*)(pz + ZLD + 8); }
  float c[16], pv[16], nx[16];
  unpack8(c0, c); unpack8(c1, c + 8); unpack8(p0, pv); unpack8(p1, pv + 8); unpack8(n0, nx); unpack8(n1, nx + 8);
#pragma unroll
  for (int q = 0; q < 16; ++q) o[q] = c[q] + (0.5f * (pv[q] + nx[q]) - c[q]) * mu[col - 512 + q];
}
__device__ __forceinline__ void load_shift8(const bf16_t* __restrict__ z, int row, int t, int T, int col, const float* __restrict__ mu, float* o) {
  const bf16_t* pz = z + (size_t)row * ZLD + col;
  uint4 c0 = *(const uint4*)pz;
  uint4 p0 = make_uint4(0, 0, 0, 0), n0 = p0;
  if (t > 0) p0 = *(const uint4*)(pz - ZLD);
  if (t < T - 1) n0 = *(const uint4*)(pz + ZLD);
  float c[8], pv[8], nx[8];
  unpack8(c0, c); unpack8(p0, pv); unpack8(n0, nx);
#pragma unroll
  for (int q = 0; q < 8; ++q) o[q] = c[q] + (0.5f * (pv[q] + nx[q]) - c[q]) * mu[col - 512 + q];
}

constexpr int TC = 32;
constexpr int SV = TC * 64;
__device__ __forceinline__ void lora_prep_phase(PREF p, const int wid_u) {
  const int tid = opaque_tid();
  const bf16_t* z = P_RU;
  bf16_t* al = P_ALORA;
  const float* mu = p.shift_mu;
  for (int task = blockIdx.x * NTHR + tid; task < NTOK * 32; task += gridDim.x * NTHR) {
    const int row = task >> 5, oc = task & 31;
    int s, t, T;
    row_seq(row, s, t, T);
    float o[8];
    load_shift8(z, row, t, T, 2048 + oc * 8, mu, o);
    if (oc < 16) {
#pragma unroll
      for (int q = 0; q < 8; ++q) { const float e = __expf(2.f * o[q]); o[q] = 1.f - 2.f * __builtin_amdgcn_rcpf(e + 1.f); }
    }
    *(uint4*)(al + (size_t)row * 256 + oc * 8) = pack8(o);
  }
}

template <int HALF>
__device__ __forceinline__ void pool_seg(const bf16_t* __restrict__ z, bf16_t* __restrict__ mo, int row_base, int tbase, int T, int c0) {
  constexpr int NR = 2 * HALF + 3;
  float acc[4][8], zc[4][8];
#pragma unroll
  for (int i = 0; i < 4; ++i)
#pragma unroll
    for (int q = 0; q < 8; ++q) { acc[i][q] = 0.f; zc[i][q] = 0.f; }
#pragma unroll
  for (int r = 0; r < NR; ++r) {
    const int tt = tbase - HALF + r;
    uint4 u = make_uint4(0, 0, 0, 0);
    if (tt >= 0 && tt < T) u = *(const uint4*)(z + (size_t)(row_base - HALF + r) * ZLD + c0);
    float v[8];
    unpack8(u, v);
#pragma unroll
    for (int i = 0; i < 4; ++i) {
      if (r >= i && r < i + 2 * HALF) {
#pragma unroll
        for (int q = 0; q < 8; ++q) acc[i][q] += v[q];
      }
      if (r == HALF + i) {
#pragma unroll
        for (int q = 0; q < 8; ++q) zc[i][q] = v[q];
      }
    }
  }
#pragma unroll
  for (int i = 0; i < 4; ++i) {
    const int ti = tbase + i;
    const float ic = 1.f / (float)(min(ti + HALF, T) - max(ti - HALF, 0));
    float o[8];
#pragma unroll
    for (int q = 0; q < 8; ++q) o[q] = acc[i][q] * ic - zc[i][q];
    *(uint4*)(mo + (size_t)(row_base + i) * D + c0) = pack8(o);
  }
}
__device__ __forceinline__ void pool_tile(const bf16_t* __restrict__ z, bf16_t* __restrict__ mo, int tile, int tid) {
  const int row0 = tile * 32;
  int s, t0, T;
  row_seq(row0, s, t0, T);
  const int oc = tid >> 3, seg = tid & 7, c0 = oc * 8, grp = __builtin_amdgcn_readfirstlane(oc >> 4);
  const int rb = row0 + seg * 4, tb = t0 + seg * 4;
  if (grp == 0) pool_seg<1>(z, mo, rb, tb, T, c0);
  else if (grp == 1) pool_seg<2>(z, mo, rb, tb, T, c0);
  else if (grp == 2) pool_seg<4>(z, mo, rb, tb, T, c0);
  else pool_seg<8>(z, mo, rb, tb, T, c0);
}

struct Raw16 { uint4 c0, c1, p0, p1, n0, n1; };
__device__ __forceinline__ void load_raw16(Raw16& r, const bf16_t* __restrict__ z, int row, int t, int T, int col) {
  const bf16_t* pz = z + (unsigned)(row * ZLD + col);
  r.c0 = *(const uint4*)pz; r.c1 = *(const uint4*)(pz + 8);
  r.p0 = make_uint4(0, 0, 0, 0); r.p1 = r.p0; r.n0 = r.p0; r.n1 = r.p0;
  if (t > 0) { r.p0 = *(const uint4*)(pz - ZLD); r.p1 = *(const uint4*)(pz - ZLD + 8); }
  if (t < T - 1) { r.n0 = *(const uint4*)(pz + ZLD); r.n1 = *(const uint4*)(pz + ZLD + 8); }
}
__device__ __forceinline__ void shift16(const Raw16& r, const float* c1, const float* c2, float* o) {
  float c[16], pv[16], nx[16];
  unpack8(r.c0, c); unpack8(r.c1, c + 8); unpack8(r.p0, pv); unpack8(r.p1, pv + 8); unpack8(r.n0, nx); unpack8(r.n1, nx + 8);
#pragma unroll
  for (int q = 0; q < 16; ++q) o[q] = c[q] * c1[q] + (pv[q] + nx[q]) * c2[q];
}
__device__ __forceinline__ bf16x8 ldfrag(const bf16_t* base, int stride, int row0, int k0, int fr, int fq) {
  return *reinterpret_cast<const bf16x8*>(base + (row0 + fr) * stride + k0 + fq * 8);
}
__device__ __forceinline__ uint2 pack4(f32x4 v) { uint2 u; u.x = cvt_pk_bf16(v[0], v[1]); u.y = cvt_pk_bf16(v[2], v[3]); return u; }
#define MFMA16(a, b, c) __builtin_amdgcn_mfma_f32_16x16x32_bf16(a, b, c, 0, 0, 0)

constexpr int CS_NAB = 0, CS_NAK = 4096, CS_NBRT = 8192, CS_NKRT = 10752, CS_QT = 13312, CS_W = 15872, CS_Z = 20992, CS_GT = 26112,
              CS_RYT = 35328, CS_VN = 39936;
constexpr int CS_AT = 49152, CS_RT = CS_AT + 4608, CS_BT = CS_RT + 4608, CS_KT = CS_BT + 4608, CS_BB = 67584, CS_KB = CS_BB + 5120,
              CS_VT = CS_KB + 5120, CS_ATT = 82944, CS_PL = 92160, CS_SBF = 92416, CS_PRIV = 110848, CS_CST = 143616, CS_BL = 145920;

__device__ __forceinline__ void lds_barrier() {
  asm volatile("s_waitcnt lgkmcnt(0)" ::: "memory");
  __builtin_amdgcn_s_barrier();
  asm volatile("" ::: "memory");
}
template <int Q> __device__ __forceinline__ float quad_bcast(float x) { return dpp_f<Q * 0x55>(x); }

template <int S0> __device__ __forceinline__ void solve_steps(float (&x)[8], const float* nab, int seg) {
  if constexpr (S0 < 32) {
    const float xs = quad_bcast<(S0 >> 3)>(x[S0 & 7]);
    const f32x4 n0 = *(const f32x4*)(nab + S0 * 32 + seg * 8), n1 = *(const f32x4*)(nab + S0 * 32 + seg * 8 + 4);
    x[0] += xs * n0[0]; x[1] += xs * n0[1]; x[2] += xs * n0[2]; x[3] += xs * n0[3];
    x[4] += xs * n1[0]; x[5] += xs * n1[1]; x[6] += xs * n1[2]; x[7] += xs * n1[3];
    solve_steps<S0 + 1>(x, nab, seg);
  }
}

template <int S0> __device__ __forceinline__ void solve16(float (&x)[8], const float* nb) {
  if constexpr (S0 < 16) {
    const float xs = (S0 >> 3) ? dpp_f<0xF5>(x[S0 & 7]) : dpp_f<0xA0>(x[S0 & 7]);
    const f32x4 n0 = *(const f32x4*)(nb + S0 * 32), n1 = *(const f32x4*)(nb + S0 * 32 + 4);
    x[0] += xs * n0[0]; x[1] += xs * n0[1]; x[2] += xs * n0[2]; x[3] += xs * n0[3];
    x[4] += xs * n1[0]; x[5] += xs * n1[1]; x[6] += xs * n1[2]; x[7] += xs * n1[3];
    solve16<S0 + 1>(x, nb);
  }
}

__device__ __forceinline__ void scan_phase(PREF p, char* smem, const int wid_u) {
  float* stepbuf = (float*)smem;
  float* Nab = (float*)(smem + CS_NAB);
  bf16_t* NakT = (bf16_t*)(smem + CS_NAK);
  bf16_t* VNb = (bf16_t*)(smem + CS_VN);
  bf16_t* T11b = (bf16_t*)(smem + CS_VN + 5120);
  bf16_t* M1T = (bf16_t*)(smem + CS_VN + 5120 + 1280);
  bf16_t* NbrT = (bf16_t*)(smem + CS_NBRT);
  bf16_t* NkrT = (bf16_t*)(smem + CS_NKRT);
  bf16_t* TT = (bf16_t*)(smem + CS_QT);
  bf16_t* Wb = (bf16_t*)(smem + CS_W);
  bf16_t* Zb = (bf16_t*)(smem + CS_Z);
  bf16_t* GT = (bf16_t*)(smem + CS_GT);
  bf16_t* RyT = (bf16_t*)(smem + CS_RYT);
  bf16_t* At = (bf16_t*)(smem + CS_AT);
  bf16_t* Rt = (bf16_t*)(smem + CS_RT);
  bf16_t* Bt = (bf16_t*)(smem + CS_BT);
  bf16_t* Kt = (bf16_t*)(smem + CS_KT);
  bf16_t* Bb = (bf16_t*)(smem + CS_BB);
  bf16_t* Kb = (bf16_t*)(smem + CS_KB);
  bf16_t* VT = (bf16_t*)(smem + CS_VT);
  bf16_t* AtTb = (bf16_t*)(smem + CS_ATT);
  float* PLs = (float*)(smem + CS_PL);
  bf16_t* Sbf = (bf16_t*)(smem + CS_SBF);
  float* cst = (float*)(smem + CS_CST);
  const bf16_t* z = P_RU;
  const int tid = opaque_tid();
  const int wave = __builtin_amdgcn_readfirstlane(tid >> 6), lane = tid & 63, fr = lane & 15, fq = lane >> 4;
  const int item = blockIdx.x;
  if (item < 256) {
    const int s = item < 128 ? 8 + (item >> 4) : ((item - 128) >> 4);
    const int h = (item & 15) >> 1, d = item & 1;
    const int T = s < 8 ? 4096 : 8192, r0seq = seq_start(s), nch = T / 32;
    bf16_t* yout = P_RY + (size_t)d * NTOK * 512;
    {
      const int g = tid >> 6, k = tid & 63;
      const float muk = p.shift_mu[1024 - 512 + h * 64 + k], mur = p.shift_mu[512 - 512 + h * 64 + k], muv = p.shift_mu[1536 - 512 + h * 64 + k];
      float v;
      if (g == 0) v = 0.5f * muk;
      else if (g == 1) v = 0.5f * mur;
      else if (g == 2) v = 1.f - muk;
      else if (g == 3) v = 1.f - mur;
      else if (g == 4) v = 1.f - muv;
      else if (g == 5) v = p.k_k[h * 64 + k];
      else if (g == 6) v = p.k_a[h * 64 + k];
      else v = p.r_k[h * 64 + k];
      cst[g * 64 + k] = v;
      if (g == 0) cst[8 * 64 + k] = 0.5f * muv;
      for (int i = tid; i < 2 * 64 * 72 / 2; i += NTHR) ((unsigned*)Sbf)[i] = 0u;
    }
    const int role = wave >> 1, th = wave & 1;
    const int tl = lane >> 2, cq = lane & 3;
    float* tmpa = (float*)(smem + CS_PRIV + (wave & 3) * 8192 + 2560);
    uint4* Blds = (uint4*)(smem + CS_BL) + (role & 1) * 512;
    float bias[4] = {0.f, 0.f, 0.f, 0.f};
    if (role < 2) {
      const float* lsrc = sel(role != 0, p.a2, p.w2) + (size_t)d * 64 * 512 + h * 64;
      if (th == 0) {
#pragma unroll
        for (int nt = 0; nt < 4; ++nt)
#pragma unroll
          for (int ks = 0; ks < 2; ++ks) {
            float o[8];
#pragma unroll
            for (int q = 0; q < 8; ++q) o[q] = lsrc[(size_t)(ks * 32 + fq * 8 + q) * 512 + nt * 16 + fr];
            Blds[(nt * 2 + ks) * 64 + lane] = pack8(o);
          }
      }
#pragma unroll
      for (int nt = 0; nt < 4; ++nt) bias[nt] = sel(role != 0, p.a0, p.w0)[d * 512 + h * 64 + nt * 16 + fr];
    }
    const int colA = 512 + h * 64 + cq * 16;
    const int colB = (role == 1 ? 1024 : 1536) + h * 64 + cq * 16;
    const int alo = (role == 0 ? d * 64 : 128 + d * 64) + fq * 8;
    Raw16 ra, rb;
    {
      const int j = th * 16 + tl, t = d ? T - 1 - j : j, row = r0seq + t;
      if (role == 2) load_raw16(ra, z, row, t, T, colA);
      if (role == 1 || role == 2) load_raw16(rb, z, row, t, T, colB);
      if (role < 2) {
        const int j2 = th * 16 + fr, t2 = d ? T - 1 - j2 : j2;
        const bf16_t* ap = P_ALORA + (unsigned)((r0seq + t2) * 256 + alo);
        ra.c0 = *(const uint4*)ap; ra.c1 = *(const uint4*)(ap + 32);
      }
    }
    f32x4 Sa = {0.f, 0.f, 0.f, 0.f}, Sb = Sa;
    uint2 y_def = make_uint2(0u, 0u);
    float sb_def = 0.f;
    const int mt = wave >> 1, hn = wave & 1, nt0 = 2 * hn, nt1 = 2 * hn + 1;
    __syncthreads();

    for (int c = 0; c < nch; ++c) {
      if (role < 3) {
        const int j = th * 16 + tl;
        const int istep = c * 32 + j;
        const int t = d ? T - 1 - istep : istep;
        const int row = r0seq + t;
        float v16[16];
        if (role < 2) {
          f32x4 acc[4] = {};
#pragma unroll
          for (int ks = 0; ks < 2; ++ks) {
            const uint4 au = ks == 0 ? ra.c0 : ra.c1;
            const bf16x8 a = *reinterpret_cast<const bf16x8*>(&au);
#pragma unroll
            for (int nt = 0; nt < 4; ++nt) { const uint4 bu = Blds[(nt * 2 + ks) * 64 + lane]; acc[nt] = MFMA16(a, *reinterpret_cast<const bf16x8*>(&bu), acc[nt]); }
          }
          if (role == 0) {
#pragma unroll
            for (int nt = 0; nt < 4; ++nt)
#pragma unroll
              for (int jj = 0; jj < 4; ++jj) {
                const float sg = sigmoidf_(bias[nt] + acc[nt][jj]);
                stepbuf[0 * SV + (th * 16 + fq * 4 + jj) * 64 + nt * 16 + fr] = __expf(-0.6065306597126334f * sg);
              }
            __builtin_amdgcn_wave_barrier();
            {
              float wl[16];
#pragma unroll
              for (int i = 0; i < 16; ++i) wl[i] = stepbuf[0 * SV + (th * 16 + i) * 64 + lane];
              float pr = 1.f;
#pragma unroll
              for (int i = 0; i < 16; ++i) { pr *= wl[i]; stepbuf[0 * SV + (th * 16 + i) * 64 + lane] = pr; }
            }
          } else {
#pragma unroll
            for (int nt = 0; nt < 4; ++nt)
#pragma unroll
              for (int jj = 0; jj < 4; ++jj) tmpa[(fq * 4 + jj) * 68 + nt * 16 + fr] = sigmoidf_(bias[nt] + acc[nt][jj]);
            __builtin_amdgcn_wave_barrier();
            float av[16], kd[16];
#pragma unroll
            for (int q = 0; q < 4; ++q) { f32x4 a4 = *(const f32x4*)(tmpa + tl * 68 + cq * 16 + q * 4); av[q * 4] = a4[0]; av[q * 4 + 1] = a4[1]; av[q * 4 + 2] = a4[2]; av[q * 4 + 3] = a4[3]; }
            shift16(rb, cst + 2 * 64 + cq * 16, cst + 0 * 64 + cq * 16, v16);
            float kk[16], ss = 0.f;
#pragma unroll
            for (int q = 0; q < 16; ++q) { kk[q] = v16[q] * cst[5 * 64 + cq * 16 + q]; ss += kk[q] * kk[q]; }
            ss = quad_sum(ss);
            const float inv = 1.f / fmaxf(sqrtf(ss), 1e-12f);
#pragma unroll
            for (int q = 0; q < 16; ++q) { kk[q] *= inv; kd[q] = v16[q] * (1.f + (av[q] - 1.f) * cst[6 * 64 + cq * 16 + q]); }
#pragma unroll
            for (int q = 0; q < 4; ++q) {
              *(f32x4*)(stepbuf + 3 * SV + j * 64 + cq * 16 + q * 4) = (f32x4){-kk[q * 4], -kk[q * 4 + 1], -kk[q * 4 + 2], -kk[q * 4 + 3]};
              *(f32x4*)(stepbuf + 4 * SV + j * 64 + cq * 16 + q * 4) = (f32x4){kk[q * 4] * av[q * 4], kk[q * 4 + 1] * av[q * 4 + 1], kk[q * 4 + 2] * av[q * 4 + 2], kk[q * 4 + 3] * av[q * 4 + 3]};
              *(f32x4*)(stepbuf + 1 * SV + j * 64 + cq * 16 + q * 4) = (f32x4){kd[q * 4], kd[q * 4 + 1], kd[q * 4 + 2], kd[q * 4 + 3]};
            }
          }
        } else {
          shift16(ra, cst + 3 * 64 + cq * 16, cst + 1 * 64 + cq * 16, v16);
#pragma unroll
          for (int q = 0; q < 4; ++q) *(f32x4*)(stepbuf + 2 * SV + j * 64 + cq * 16 + q * 4) = (f32x4){v16[q * 4], v16[q * 4 + 1], v16[q * 4 + 2], v16[q * 4 + 3]};
          shift16(rb, cst + 4 * 64 + cq * 16, cst + 8 * 64 + cq * 16, v16);
#pragma unroll
          for (int q = 0; q < 4; ++q) *(f32x4*)(stepbuf + 5 * SV + j * 64 + cq * 16 + q * 4) = (f32x4){v16[q * 4], v16[q * 4 + 1], v16[q * 4 + 2], v16[q * 4 + 3]};
        }
      }
      if (c > 0) {
        const int ip = (c - 1) * 32 + hn * 16 + fr, tp = d ? T - 1 - ip : ip;
        *(uint2*)(yout + (size_t)(r0seq + tp) * 512 + h * 64 + mt * 16 + fq * 4) = y_def;
        if (role == 2 && cq == 0) { const int is_ = (c - 1) * 32 + th * 16 + tl, tg = d ? T - 1 - is_ : is_; P_SBON[((size_t)(r0seq + tg) * 8 + h) * 2 + d] = sb_def; }
      }
      if (role < 3 && c + 1 < nch) {
        const int is2 = (c + 1) * 32 + th * 16 + tl;
        const int t2 = d ? T - 1 - is2 : is2;
        const int row2 = r0seq + t2;
        if (role == 2) load_raw16(ra, z, row2, t2, T, colA);
        if (role >= 1) load_raw16(rb, z, row2, t2, T, colB);
        if (role < 2) {
          const int is3 = (c + 1) * 32 + th * 16 + fr, t3 = d ? T - 1 - is3 : is3;
          const bf16_t* ap = P_ALORA + (unsigned)((r0seq + t3) * 256 + alo);
          ra.c0 = *(const uint4*)ap; ra.c1 = *(const uint4*)(ap + 32);
        }
      }
      lds_barrier();
      {
        const int k = lane, seg = wave;
        const float* sw = stepbuf + 0 * SV + k;
        const float P15 = sw[15 * 64];
        const float hiF = seg >= 4 ? P15 : 1.f;
        float P[5];
        P[0] = seg == 0 ? 1.f : sw[(4 * seg - 1) * 64] * (seg > 4 ? P15 : 1.f);
#pragma unroll
        for (int i = 0; i < 4; ++i) P[i + 1] = sw[(4 * seg + i) * 64] * hiF;
        const float PL = sw[31 * 64] * P15;
        if (role == 2) {
          const int j = th * 16 + tl;
          float bs = 0.f;
#pragma unroll
          for (int q = 0; q < 16; ++q) bs += stepbuf[2 * SV + j * 64 + cq * 16 + q] * stepbuf[1 * SV + j * 64 + cq * 16 + q] * cst[7 * 64 + cq * 16 + q];
          bs = quad_sum(bs);
          sb_def = bs;
        }
        f32x4 bb, kb, at, vv;
#pragma unroll
        for (int i = 0; i < 4; ++i) {
          const int t = 4 * seg + i;
          const float inv = __builtin_amdgcn_rcpf(P[i + 1]);
          const float a_ = P[i] * stepbuf[3 * SV + t * 64 + k];
          const float rraw = stepbuf[2 * SV + t * 64 + k], kraw = stepbuf[1 * SV + t * 64 + k];
          const float r_ = P[i + 1] * rraw;
          const float b_ = stepbuf[4 * SV + t * 64 + k] * inv;
          const float k_ = kraw * inv;

          At[t * 72 + k] = (bf16_t)(cvt_pk_bf16(a_, 0.f) & 0xffff);
          Rt[t * 72 + k] = (bf16_t)(cvt_pk_bf16(r_, 0.f) & 0xffff);
          Bt[t * 72 + k] = (bf16_t)(cvt_pk_bf16(b_, 0.f) & 0xffff);
          Kt[t * 72 + k] = (bf16_t)(cvt_pk_bf16(k_, 0.f) & 0xffff);
          bb[i] = b_ * PL; kb[i] = k_ * PL; at[i] = a_;
          vv[i] = stepbuf[5 * SV + t * 64 + k];
        }
        *(uint2*)(Bb + k * 40 + 4 * seg) = pack4(bb);
        *(uint2*)(Kb + k * 40 + 4 * seg) = pack4(kb);
        *(uint2*)(VT + k * 40 + 4 * seg) = pack4(vv);
        *(uint2*)(AtTb + k * 40 + 4 * seg) = pack4(at);
        if (seg == 0) PLs[k] = PL;
      }
      lds_barrier();
      {
        const int mat = wave >> 1, mts = wave & 1;
        const bf16_t* As = (mat & 1) ? Kt : Bt;
        const bf16_t* Bs = (mat & 2) ? Rt : At;
        f32x4 acc[2] = {};
#pragma unroll
        for (int ks = 0; ks < 2; ++ks) {
          const bf16x8 a = ldfrag(As, 72, mts * 16, ks * 32, fr, fq);
#pragma unroll
          for (int nt = 0; nt < 2; ++nt) acc[nt] = MFMA16(a, ldfrag(Bs, 72, nt * 16, ks * 32, fr, fq), acc[nt]);
        }
#pragma unroll
        for (int nt = 0; nt < 2; ++nt) {
          const int tcol = nt * 16 + fr;
          f32x4 v = acc[nt];
#pragma unroll
          for (int jj = 0; jj < 4; ++jj) {
            const int srow = mts * 16 + fq * 4 + jj;
            const bool keep = (mat & 2) ? (srow <= tcol) : (srow < tcol);
            v[jj] = keep ? v[jj] : 0.f;
          }
          if (mat == 0) {
#pragma unroll
            for (int jj = 0; jj < 4; ++jj) Nab[(mts * 16 + fq * 4 + jj) * 32 + tcol] = v[jj];
          } else {
            bf16_t* dst = mat == 1 ? NakT : mat == 2 ? NbrT : NkrT;
            *(uint2*)(dst + tcol * 40 + mts * 16 + fq * 4) = pack4(v);
          }
        }
      }
      lds_barrier();
      if (wave == 0) {
        const int irow = lane >> 1, hb = lane & 1, blk = lane >> 5, il = irow & 15;
        float x[8];
#pragma unroll
        for (int i = 0; i < 8; ++i) x[i] = (hb * 8 + i == il) ? 1.f : 0.f;
        const float* nb = Nab + (blk * 16) * 32 + blk * 16 + hb * 8;
        solve16<0>(x, nb);
#pragma unroll
        for (int i = 0; i < 8; ++i) TT[(blk * 16 + hb * 8 + i) * 40 + blk * 16 + il] = (bf16_t)(cvt_pk_bf16(x[i], 0.f) & 0xffff);
        if (blk == 0) *(uint4*)(T11b + il * 40 + hb * 8) = pack8(x);
        __builtin_amdgcn_wave_barrier();
        const f32x4 zero = {0.f, 0.f, 0.f, 0.f};
        bf16x8 zf;
#pragma unroll
        for (int i = 0; i < 8; ++i) zf[i] = 0;
        bf16x8 n12 = zf, t22 = zf, t11 = zf;
        if (fq < 2) {
          float o[8];
          const f32x4 n0 = *(const f32x4*)(Nab + fr * 32 + 16 + fq * 8), n1 = *(const f32x4*)(Nab + fr * 32 + 16 + fq * 8 + 4);
          o[0] = n0[0]; o[1] = n0[1]; o[2] = n0[2]; o[3] = n0[3]; o[4] = n1[0]; o[5] = n1[1]; o[6] = n1[2]; o[7] = n1[3];
          uint4 u = pack8(o);
          n12 = *reinterpret_cast<bf16x8*>(&u);
          t22 = *reinterpret_cast<const bf16x8*>(TT + (16 + fr) * 40 + 16 + fq * 8);
          t11 = *reinterpret_cast<const bf16x8*>(T11b + fr * 40 + fq * 8);
        }
        const f32x4 m1 = MFMA16(n12, t22, zero);
        *(uint2*)(M1T + fr * 40 + fq * 4) = pack4(m1);
        __builtin_amdgcn_wave_barrier();
        bf16x8 m1f = zf;
        if (fq < 2) m1f = *reinterpret_cast<const bf16x8*>(M1T + fr * 40 + fq * 8);
        const f32x4 t12 = MFMA16(t11, m1f, zero);
        *(uint2*)(TT + (16 + fr) * 40 + fq * 4) = pack4(t12);
      } else if (wave == 1) {
        unsigned z0;
        asm volatile("v_mov_b32 %0, 0" : "=v"(z0));
        *(uint2*)(TT + (lane >> 2) * 40 + 16 + (lane & 3) * 4) = make_uint2(z0, z0);
      } else if (wave < 6) {
        const int vtile = wave - 2;
        const bf16x8 vf = ldfrag(VT, 40, vtile * 16, 0, fr, fq);
        const f32x4 zero = {0.f, 0.f, 0.f, 0.f};
#pragma unroll
        for (int tt = 0; tt < 2; ++tt) {
          const f32x4 acc = MFMA16(ldfrag(NakT, 40, tt * 16, 0, fr, fq), vf, zero);
          *(uint2*)(VNb + (vtile * 16 + fr) * 40 + tt * 16 + fq * 4) = pack4(acc);
        }
      }
      lds_barrier();
      {
        const int tt = wave & 1, rt = wave >> 1;
        const f32x4 zero = {0.f, 0.f, 0.f, 0.f};
        const bf16x8 tf = ldfrag(TT, 40, tt * 16, 0, fr, fq);
        const f32x4 zacc = MFMA16(tf, ldfrag(VNb, 40, rt * 16, 0, fr, fq), zero);
        const f32x4 wacc = MFMA16(tf, ldfrag(AtTb, 40, rt * 16, 0, fr, fq), zero);
        *(uint2*)(Zb + (rt * 16 + fr) * 40 + tt * 16 + fq * 4) = pack4(zacc);
        *(uint2*)(Wb + (rt * 16 + fr) * 40 + tt * 16 + fq * 4) = pack4(wacc);
      }
      lds_barrier();
      f32x4 yacc = {0.f, 0.f, 0.f, 0.f};
      {
        const float pl0 = PLs[nt0 * 16 + fr], pl1 = PLs[nt1 * 16 + fr];
        Sa = Sa * pl0; Sb = Sb * pl1;
        const bf16x8 zf = ldfrag(Zb, 40, mt * 16, 0, fr, fq), vf = ldfrag(VT, 40, mt * 16, 0, fr, fq), wf = ldfrag(Wb, 40, mt * 16, 0, fr, fq);
        const bf16x8 bb0 = ldfrag(Bb, 40, nt0 * 16, 0, fr, fq), bb1 = ldfrag(Bb, 40, nt1 * 16, 0, fr, fq);
        const bf16x8 kb0 = ldfrag(Kb, 40, nt0 * 16, 0, fr, fq), kb1 = ldfrag(Kb, 40, nt1 * 16, 0, fr, fq);
        const bf16x8 nbr = ldfrag(NbrT, 40, hn * 16, 0, fr, fq), nkr = ldfrag(NkrT, 40, hn * 16, 0, fr, fq);
        Sa = MFMA16(zf, bb0, Sa); Sa = MFMA16(vf, kb0, Sa);
        Sb = MFMA16(zf, bb1, Sb); Sb = MFMA16(vf, kb1, Sb);
        yacc = MFMA16(zf, nbr, yacc); yacc = MFMA16(vf, nkr, yacc);
        const f32x4 zero = {0.f, 0.f, 0.f, 0.f};
        const f32x4 g0 = MFMA16(wf, bb0, zero), g1 = MFMA16(wf, bb1, zero);
        f32x4 ry = MFMA16(wf, nbr, zero);
        *(uint2*)(GT + (nt0 * 16 + fr) * 72 + mt * 16 + fq * 4) = pack4(g0);
        *(uint2*)(GT + (nt1 * 16 + fr) * 72 + mt * 16 + fq * 4) = pack4(g1);
        const uint2 rr = *(const uint2*)(Rt + (hn * 16 + fr) * 72 + mt * 16 + fq * 4);
        ry[0] += bf_lo(rr.x); ry[1] += bf_hi(rr.x); ry[2] += bf_lo(rr.y); ry[3] += bf_hi(rr.y);
        *(uint2*)(RyT + (hn * 16 + fr) * 72 + mt * 16 + fq * 4) = pack4(ry);
      }
      lds_barrier();
      {
        const bf16_t* Scur = Sbf + (c & 1) * 64 * 72;
        bf16_t* Snext = Sbf + ((c + 1) & 1) * 64 * 72;
#pragma unroll
        for (int ks = 0; ks < 2; ++ks) {
          const bf16x8 af = ldfrag(Scur, 72, mt * 16, ks * 32, fr, fq);
          Sa = MFMA16(af, ldfrag(GT, 72, nt0 * 16, ks * 32, fr, fq), Sa);
          Sb = MFMA16(af, ldfrag(GT, 72, nt1 * 16, ks * 32, fr, fq), Sb);
          yacc = MFMA16(af, ldfrag(RyT, 72, hn * 16, ks * 32, fr, fq), yacc);
        }
        y_def = pack4(yacc);
#pragma unroll
        for (int jj = 0; jj < 4; ++jj) {
          Snext[(mt * 16 + fq * 4 + jj) * 72 + nt0 * 16 + fr] = (bf16_t)(cvt_pk_bf16(Sa[jj], 0.f) & 0xffff);
          Snext[(mt * 16 + fq * 4 + jj) * 72 + nt1 * 16 + fr] = (bf16_t)(cvt_pk_bf16(Sb[jj], 0.f) & 0xffff);
        }
      }
      lds_barrier();
    }
    {
      const int ip = (nch - 1) * 32 + hn * 16 + fr, tp = d ? T - 1 - ip : ip;
      *(uint2*)(yout + (size_t)(r0seq + tp) * 512 + h * 64 + mt * 16 + fq * 4) = y_def;
      if (role == 2 && cq == 0) { const int is_ = (nch - 1) * 32 + th * 16 + tl, tg = d ? T - 1 - is_ : is_; P_SBON[((size_t)(r0seq + tg) * 8 + h) * 2 + d] = sb_def; }
    }
  }
  if (item >= 128) {
    const int nb = gridDim.x - 128;
    for (int tile = item - 128; tile < NTOK / 32; tile += nb) pool_tile(z, P_RH, tile, tid);
  }
}

__device__ __forceinline__ void post_phase(PREF p, char* smem, const int wid_u) {
  bf16_t* Ag = (bf16_t*)smem;
  bf16_t* vt = (bf16_t*)(smem + 12800);
  float* ys = (float*)(smem + 12800 + 33280);
  const bf16_t* z = P_RU;
  const bf16_t* yf = P_RY;
  const bf16_t* ybk = P_RY + (size_t)NTOK * 512;
  bf16_t* mo = P_RH;
  const int tid = opaque_tid(), w = tid >> 6, lane = tid & 63, fr = lane & 15, fq = lane >> 4;
  bf16x8 Bg[4][6];
#pragma unroll
  for (int nt = 0; nt < 4; ++nt)
#pragma unroll
    for (int ks = 0; ks < 6; ++ks) {
      float o[8];
#pragma unroll
      for (int q = 0; q < 8; ++q) { const int k = ks * 32 + fq * 8 + q; o[q] = k < 160 ? p.g2[(size_t)k * 512 + w * 64 + nt * 16 + fr] : 0.f; }
      uint4 u = pack8(o);
      Bg[nt][ks] = *reinterpret_cast<bf16x8*>(&u);
    }
  float lng[4], lnb[4];
#pragma unroll
  for (int nt = 0; nt < 4; ++nt) { lng[nt] = p.lnx_g[w * 64 + nt * 16 + fr]; lnb[nt] = p.lnx_b[w * 64 + nt * 16 + fr]; }

  for (int tile = blockIdx.x; tile < NTOK / 32; tile += gridDim.x) {
    const int row0 = tile * 32;
    int s, t0, T;
    row_seq(row0, s, t0, T);
    for (int idx = tid; idx < 32 * 24; idx += NTHR) {
      const int tok = idx / 24, oc = idx % 24;
      float o[8];
      if (oc < 20) {
        load_shift8(z, row0 + tok, t0 + tok, T, 2304 + oc * 8, p.shift_mu, o);
#pragma unroll
        for (int q = 0; q < 8; ++q) o[q] = sigmoidf_(o[q]);
      } else {
#pragma unroll
        for (int q = 0; q < 8; ++q) o[q] = 0.f;
      }
      *(uint4*)(Ag + tok * 200 + oc * 8) = pack8(o);
    }
#pragma unroll 1
    for (int half_ = 0; half_ < 2; ++half_) {
      uint4 zc[2], zp[2], zn[2], ya[2], yb4[2];
#pragma unroll
      for (int i = 0; i < 2; ++i) {
        const int idx = tid + (half_ * 2 + i) * NTHR, tok = idx >> 6, oc = idx & 63, row = row0 + tok, t = t0 + tok;
        const bf16_t* pz = z + (size_t)row * ZLD + 1536 + oc * 8;
        zc[i] = *(const uint4*)pz;
        zp[i] = make_uint4(0, 0, 0, 0); zn[i] = zp[i];
        if (t > 0) zp[i] = *(const uint4*)(pz - ZLD);
        if (t < T - 1) zn[i] = *(const uint4*)(pz + ZLD);
        ya[i] = *(const uint4*)(yf + (size_t)row * 512 + oc * 8);
        yb4[i] = *(const uint4*)(ybk + (size_t)row * 512 + oc * 8);
      }
#pragma unroll
      for (int i = 0; i < 2; ++i) {
        const int idx = tid + (half_ * 2 + i) * NTHR, tok = idx >> 6, oc = idx & 63;
        float c[8], pv[8], nx[8], o[8];
        unpack8(zc[i], c); unpack8(zp[i], pv); unpack8(zn[i], nx);
#pragma unroll
        for (int q = 0; q < 8; ++q) o[q] = c[q] + (0.5f * (pv[q] + nx[q]) - c[q]) * p.shift_mu[1536 - 512 + oc * 8 + q];
        *(uint4*)(vt + tok * 520 + oc * 8) = pack8(o);
        float a[8], b[8];
        unpack8(ya[i], a); unpack8(yb4[i], b);
        *(f32x4*)(ys + tok * 516 + oc * 8) = (f32x4){a[0] + b[0], a[1] + b[1], a[2] + b[2], a[3] + b[3]};
        *(f32x4*)(ys + tok * 516 + oc * 8 + 4) = (f32x4){a[4] + b[4], a[5] + b[5], a[6] + b[6], a[7] + b[7]};
      }
    }
    __syncthreads();
    f32x4 acc[2][4] = {};
#pragma unroll
    for (int ks = 0; ks < 6; ++ks) {
      bf16x8 a[2];
#pragma unroll
      for (int mt = 0; mt < 2; ++mt) a[mt] = *reinterpret_cast<const bf16x8*>(Ag + (mt * 16 + fr) * 200 + ks * 32 + fq * 8);
#pragma unroll
      for (int mt = 0; mt < 2; ++mt)
#pragma unroll
        for (int nt = 0; nt < 4; ++nt) acc[mt][nt] = __builtin_amdgcn_mfma_f32_16x16x32_bf16(a[mt], Bg[nt][ks], acc[mt][nt], 0, 0, 0);
    }
#pragma unroll
    for (int mt = 0; mt < 2; ++mt)
#pragma unroll
      for (int jj = 0; jj < 4; ++jj) {
        const int tok = mt * 16 + fq * 4 + jj, row = row0 + tok;
        float yv[4], sm_ = 0.f;
#pragma unroll
        for (int nt = 0; nt < 4; ++nt) { yv[nt] = ys[tok * 516 + w * 64 + nt * 16 + fr]; sm_ += yv[nt]; }
        const float mean = row16_sum(sm_) * (1.f / 64.f);
        float vs = 0.f;
#pragma unroll
        for (int nt = 0; nt < 4; ++nt) { yv[nt] -= mean; vs += yv[nt] * yv[nt]; }
        const float rs = rsqrtf(row16_sum(vs) * (1.f / 64.f) + 64e-5f);
        const float2 sb2 = *(const float2*)(P_SBON + ((size_t)row * 8 + w) * 2);
        const float sbs = sb2.x + sb2.y;
#pragma unroll
        for (int nt = 0; nt < 4; ++nt) {
          const float vv = bf2f(vt[tok * 520 + w * 64 + nt * 16 + fr]);
          const float o = (yv[nt] * rs * lng[nt] + lnb[nt] + sbs * vv) * acc[mt][nt][jj];
          mo[(size_t)row * D + 512 + w * 64 + nt * 16 + fr] = (bf16_t)(cvt_pk_bf16(o, 0.f) & 0xffff);
        }
      }
    __syncthreads();
  }
}

#define XB_TMO      128
#define XB_XCNT(j)  (256  + 64 * (j))
#define XB_XSUB(j)  (1280 + 64 * (j))
#define XB_XGEN(j)  (2304 + 64 * (j))
#define XB_TOP      3328
#define XB_TOPGEN   3392
#define XCD_BAR_WORDS 3456
#define XB_SPIN_CAP (1u << 22)
__device__ __forceinline__ unsigned xb_ld(unsigned* p)              { return __hip_atomic_load(p, __ATOMIC_RELAXED, __HIP_MEMORY_SCOPE_AGENT); }
__device__ __forceinline__ unsigned xb_add(unsigned* p, unsigned v) { return __hip_atomic_fetch_add(p, v, __ATOMIC_RELAXED, __HIP_MEMORY_SCOPE_AGENT); }
__device__ __forceinline__ unsigned xb_xcc_id() { return (unsigned)__builtin_amdgcn_s_getreg((3 << 11) | 20) & 0xFu; }
#define XB_SPIN(cond, bar) do { unsigned _sp = 0; while (cond) { __builtin_amdgcn_s_sleep(1); \
    if ((++_sp & 255u) == 0u) { if (xb_ld(&(bar)[XB_TMO])) break; if (_sp > XB_SPIN_CAP) { atomicAdd(&(bar)[XB_TMO], 1u); break; } } } } while (0)
struct XcdBarrier { unsigned* bar; unsigned x; volatile LAS unsigned* st; };
__device__ __forceinline__ void xcd_barrier_complete(unsigned* bar, unsigned x, unsigned& nloc, unsigned& nx) {
  const unsigned G = gridDim.x * gridDim.y * gridDim.z;
  unsigned sum, cnt, mine, sp = 0u;
  for (;;) {
    sum = 0u; cnt = 0u; mine = 0u;
#pragma unroll
    for (unsigned j = 0; j < 16; ++j) { const unsigned c = xb_ld(&bar[XB_XCNT(j)]); sum += c; cnt += (c > 0u) ? 1u : 0u; mine = (j == x) ? c : mine; }
    if (sum == G) break;
    __builtin_amdgcn_s_sleep(1);
    if ((++sp & 255u) == 0u) { if (xb_ld(&bar[XB_TMO])) break; if (sp > XB_SPIN_CAP) { atomicAdd(&bar[XB_TMO], 1u); break; } }
  }
  nloc = mine > 0u ? mine : 1u; nx = cnt > 0u ? cnt : 1u;
}
__device__ __forceinline__ void xcd_barrier(PREF p, volatile LAS unsigned* st_, const int wid_u) {
  asm volatile("s_waitcnt vmcnt(0)" ::: "memory");
  __syncthreads();
  if (opaque_tid() == 0) {
    XcdBarrier b; b.bar = (unsigned*)(p.ws + OFF_BAR); b.x = xb_xcc_id(); b.st = st_;
    unsigned* bar = b.bar;
    __builtin_amdgcn_s_waitcnt(0);
    unsigned nloc = b.st[0], nx = b.st[1];
    if (nloc == 0u) { xcd_barrier_complete(bar, b.x, nloc, nx); b.st[0] = nloc; b.st[1] = nx; }
    const unsigned old = xb_add(&bar[XB_XSUB(b.x)], 1u);
    const unsigned gen = old / nloc;
    if (old + 1u == (gen + 1u) * nloc) {
      __builtin_amdgcn_fence(__ATOMIC_RELEASE, "agent");
      asm volatile("s_waitcnt vmcnt(0)" ::: "memory");
      const unsigned og = xb_add(&bar[XB_TOP], 1u);
      const unsigned tg = og / nx;
      if (og + 1u == (tg + 1u) * nx) xb_add(&bar[XB_TOPGEN], 1u);
      else XB_SPIN(xb_ld(&bar[XB_TOPGEN]) == tg, bar);
      __builtin_amdgcn_fence(__ATOMIC_ACQUIRE, "agent");
      xb_add(&bar[XB_XGEN(b.x)], 1u);
      asm volatile("s_waitcnt vmcnt(0)" ::: "memory");
    } else {
      XB_SPIN(xb_ld(&bar[XB_XGEN(b.x)]) == gen, bar);
      __builtin_amdgcn_fence(__ATOMIC_ACQUIRE, "agent");
      asm volatile("s_waitcnt vmcnt(0)" ::: "memory");
    }
  }
  __syncthreads();
}

constexpr int NPHASE = 14;
__device__ __forceinline__ void do_phase(PREF p, int ph, char* smem, const int wid_u) {
  if (ph == 0) prep_phase(p, smem, wid_u);
  else if (ph == 1) row_phase<0>(p.x_prompt, p.x_sample, nullptr, nullptr, P_RH, P_MOD, nullptr, p.n1_pre, 0, 0.f, 0, wid_u);
  else if (ph == 4 || ph == 10) {
    const bool f = ph == 4;
    float* outp = p.out;
    row_phase<1>(sel(f, p.x_prompt, (const float*)outp), sel(f, p.x_sample, (const float*)(outp + (size_t)NPROMPT * D)), outp, P_RY, P_RH, P_MOD,
                 sel(f, p.n1_post, p.nm_post), sel(f, p.nm_pre, p.n2_pre), f ? 2 : 5, f ? 0.5f : 1.0f, f ? 3 : 6, wid_u);
  }
  else if (ph == 13) row_phase<2>(p.out, p.out + (size_t)NPROMPT * D, p.out, P_RY, nullptr, P_MOD, p.n2_post, nullptr, 8, 0.5f, 0, wid_u);
  else if (ph == 6) lora_prep_phase(p, wid_u);
  else if (ph == 7) scan_phase(p, smem, wid_u);
  else if (ph == 8) post_phase(p, smem, wid_u);
  else {
    const bf16_t *A, *Bt; bf16_t* C; int N, K, ldc, epi;
    if (ph == 2 || ph == 11) { A = P_RH; Bt = sel(ph == 2, P_W13A, P_W13B); C = P_RU; N = 2 * FF; K = D; ldc = FF; epi = 1; }
    else if (ph == 3 || ph == 12) { A = P_RU; Bt = sel(ph == 3, P_W2A, P_W2B); C = P_RY; N = D; K = FF; ldc = D; epi = 0; }
    else if (ph == 5) { A = P_RH; Bt = P_WINT; C = P_RU; N = ZLD; K = D; ldc = ZLD; epi = 0; }
    else { A = P_RH; Bt = P_WOUTT; C = P_RY; N = D; K = D; ldc = D; epi = 0; }
    gemm_phase(A, Bt, C, NTOK, N, K, ldc, epi, smem, wid_u);
  }
}

extern __shared__ __attribute__((aligned(16))) char dyn_smem[];

__global__ void __launch_bounds__(NTHR, 2) mega_kernel(Params p) {
  cg::grid_group grid = cg::this_grid();
  const int wid_u = __builtin_amdgcn_readfirstlane(threadIdx.x >> 6);
  typedef const __attribute__((address_space(4))) Params* KP;
  const KP kp0 = (KP)__builtin_amdgcn_kernarg_segment_ptr();
  volatile LAS unsigned* st = (volatile LAS unsigned*)((LAS char*)dyn_smem + (SMEM_BYTES - 16));
  if (threadIdx.x < 2) st[threadIdx.x] = 0u;
  __syncthreads();
  if (threadIdx.x == 0) (void)xb_add(&((unsigned*)(kp0->ws + OFF_BAR))[XB_XCNT(xb_xcc_id())], 1u);
#pragma unroll 1
  for (int ph = 0; ph < NPHASE; ++ph) {
    KP kp = kp0;
    asm volatile("" : "+s"(kp));
    do_phase(*kp, ph, dyn_smem, wid_u);
#ifdef PROBE_REPEAT
    if (ph == PROBE_REPEAT) { grid.sync(); do_phase(*kp, ph, dyn_smem, wid_u); }
#endif
    if (ph == 0) grid.sync();
    else if (ph + 1 < NPHASE) xcd_barrier(*kp, (volatile LAS unsigned*)((LAS char*)dyn_smem + (SMEM_BYTES - 16)), wid_u);
  }
}

__global__ void __launch_bounds__(NTHR, 2) phase_kernel(Params p, int ph) {
  const int wid_u = __builtin_amdgcn_readfirstlane(threadIdx.x >> 6);
  do_phase(*(const __attribute__((address_space(4))) Params*)__builtin_amdgcn_kernarg_segment_ptr(), ph, dyn_smem, wid_u);
}

extern "C" void kernel_launch(void* const* d_in, const int* in_sizes, int n_in, void* d_out, int out_size, void* d_ws, size_t ws_size,
                              hipStream_t stream) {
  Params p{};
  const float** f = (const float**)&p;
  for (int i = 0; i < 33; ++i) f[i] = (const float*)d_in[i];
  p.out = (float*)d_out;
  p.ws = (char*)d_ws;
  if (WS_NEED > ws_size) { fprintf(stderr, "workspace too small: need %zu have %zu\n", (size_t)WS_NEED, ws_size); return; }

#if ONE_LAUNCH
  static int grid_blocks = 0;
  if (!grid_blocks) {
    int dev = 0, cus = 0, per_cu = 0;
    (void)hipGetDevice(&dev);
    (void)hipDeviceGetAttribute(&cus, hipDeviceAttributeMultiprocessorCount, dev);
    (void)hipFuncSetAttribute((const void*)mega_kernel, hipFuncAttributeMaxDynamicSharedMemorySize, SMEM_BYTES);
    (void)hipOccupancyMaxActiveBlocksPerMultiprocessor(&per_cu, mega_kernel, NTHR, SMEM_BYTES);
    if (per_cu < 1) per_cu = 1;
    grid_blocks = cus * per_cu;
  }
  (void)hipMemsetAsync(p.ws + OFF_BAR, 0, XCD_BAR_WORDS * sizeof(unsigned), stream);
  void* args[] = {&p};
  hipError_t e = hipLaunchCooperativeKernel((const void*)mega_kernel, dim3(grid_blocks), dim3(NTHR), args, SMEM_BYTES, stream);
  if (e != hipSuccess) fprintf(stderr, "cooperative launch failed: %s (grid %d)\n", hipGetErrorString(e), grid_blocks);
#else
  static bool attr = false;
  if (!attr) { (void)hipFuncSetAttribute((const void*)phase_kernel, hipFuncAttributeMaxDynamicSharedMemorySize, SMEM_BYTES); attr = true; }
  for (int ph = 0; ph < NPHASE; ++ph) phase_kernel<<<256, NTHR, SMEM_BYTES, stream>>>(p, ph);
#endif
}
```

```cpp
#include <hip/hip_runtime.h>
#include <hip/hip_cooperative_groups.h>
#include <cstdio>
namespace cg = cooperative_groups;

#ifndef ONE_LAUNCH
#define ONE_LAUNCH 1
#endif

typedef unsigned short bf16_t;
typedef short bf16x8 __attribute__((ext_vector_type(8)));
typedef float f32x4 __attribute__((ext_vector_type(4)));
typedef float f32x2 __attribute__((ext_vector_type(2)));
#define LAS __attribute__((address_space(3)))

constexpr int D = 1024, FF = 2816, NTOK = 98304, NPROMPT = 32768, ZLD = 2560, PINW = 2464;
constexpr int NTHR = 512;
constexpr int SMEM_BYTES = 162320;

struct Params {
  const float *x_prompt, *x_sample, *c_prompt, *c_sample, *ada_w, *ada_b, *n1_pre, *n1_post, *f1_w1, *f1_w3, *f1_w2,
      *nm_pre, *nm_post, *w_in, *shift_mu, *pool_w, *pool_scale, *w0, *w2, *a0, *a2, *g2, *k_k, *k_a, *r_k, *lnx_g, *lnx_b,
      *w_out, *n2_pre, *n2_post, *f2_w1, *f2_w3, *f2_w2;
  float* out;
  char* ws;
};
#define PREF const __attribute__((address_space(4))) Params&
constexpr size_t al256(size_t b) { return (b + 255) & ~(size_t)255; }
constexpr size_t OFF_W13A = 0;
constexpr size_t OFF_W13B = OFF_W13A + al256((size_t)2 * FF * D * 2);
constexpr size_t OFF_W2A = OFF_W13B + al256((size_t)2 * FF * D * 2);
constexpr size_t OFF_W2B = OFF_W2A + al256((size_t)D * FF * 2);
constexpr size_t OFF_WINT = OFF_W2B + al256((size_t)D * FF * 2);
constexpr size_t OFF_WOUTT = OFF_WINT + al256((size_t)ZLD * D * 2);
constexpr size_t OFF_MOD = OFF_WOUTT + al256((size_t)D * D * 2);
constexpr size_t OFF_SBON = OFF_MOD + al256((size_t)16 * 9216 * 4);
constexpr size_t OFF_RH = OFF_SBON + al256((size_t)NTOK * 16 * 4);
constexpr size_t OFF_RY = OFF_RH + al256((size_t)NTOK * D * 2);
constexpr size_t OFF_RU = OFF_RY + al256((size_t)NTOK * D * 2);
constexpr size_t OFF_ALORA = OFF_RU + al256((size_t)NTOK * FF * 2);
constexpr size_t OFF_BAR = OFF_ALORA + al256((size_t)NTOK * 256 * 2);
constexpr size_t WS_NEED = OFF_BAR + 16384;
#define P_W13A ((bf16_t*)(p.ws + OFF_W13A))
#define P_W13B ((bf16_t*)(p.ws + OFF_W13B))
#define P_W2A ((bf16_t*)(p.ws + OFF_W2A))
#define P_W2B ((bf16_t*)(p.ws + OFF_W2B))
#define P_WINT ((bf16_t*)(p.ws + OFF_WINT))
#define P_WOUTT ((bf16_t*)(p.ws + OFF_WOUTT))
#define P_MOD ((float*)(p.ws + OFF_MOD))
#define P_SBON ((float*)(p.ws + OFF_SBON))
#define P_RH ((bf16_t*)(p.ws + OFF_RH))
#define P_RY ((bf16_t*)(p.ws + OFF_RY))
#define P_RU ((bf16_t*)(p.ws + OFF_RU))
#define P_ALORA ((bf16_t*)(p.ws + OFF_ALORA))

typedef __bf16 bf16x2_t __attribute__((ext_vector_type(2)));
__device__ __forceinline__ unsigned cvt_pk_bf16(float lo, float hi) {
  f32x2 v = {lo, hi};
  bf16x2_t b = __builtin_convertvector(v, bf16x2_t);
  return __builtin_bit_cast(unsigned, b);
}
__device__ __forceinline__ float bf_lo(unsigned u) { return __uint_as_float(u << 16); }
__device__ __forceinline__ float bf_hi(unsigned u) { return __uint_as_float(u & 0xffff0000u); }
__device__ __forceinline__ float bf2f(bf16_t b) { return __uint_as_float(((unsigned)b) << 16); }
__device__ __forceinline__ void unpack8(uint4 v, float* o) {
  o[0] = bf_lo(v.x); o[1] = bf_hi(v.x); o[2] = bf_lo(v.y); o[3] = bf_hi(v.y);
  o[4] = bf_lo(v.z); o[5] = bf_hi(v.z); o[6] = bf_lo(v.w); o[7] = bf_hi(v.w);
}
__device__ __forceinline__ uint4 pack8(const float* o) {
  uint4 v; v.x = cvt_pk_bf16(o[0], o[1]); v.y = cvt_pk_bf16(o[2], o[3]); v.z = cvt_pk_bf16(o[4], o[5]); v.w = cvt_pk_bf16(o[6], o[7]);
  return v;
}
__device__ __forceinline__ float sigmoidf_(float x) { return __builtin_amdgcn_rcpf(1.f + __expf(-x)); }
template <int CTRL> __device__ __forceinline__ float dpp_f(float x) {
  return __int_as_float(__builtin_amdgcn_update_dpp(0, __float_as_int(x), CTRL, 0xf, 0xf, false));
}
__device__ __forceinline__ float row16_sum(float x) {
  x += dpp_f<0x128>(x); x += dpp_f<0x124>(x); x += dpp_f<0x122>(x); x += dpp_f<0x121>(x);
  return x;
}
template <class T> __device__ __forceinline__ T sel(bool c, T a, T b) { return c ? a : b; }
__device__ __forceinline__ int opaque_tid_w(int wid) {
  int l;
  asm volatile("v_mbcnt_lo_u32_b32 %0, -1, 0\n\tv_mbcnt_hi_u32_b32 %0, -1, %0" : "=v"(l));
  return wid * 64 + l;
}
#define opaque_tid() opaque_tid_w(wid_u)
__device__ __forceinline__ float wave_sum(float v) {
  v = row16_sum(v);
  const float a = __int_as_float(__builtin_amdgcn_readlane(__float_as_int(v), 0)), b = __int_as_float(__builtin_amdgcn_readlane(__float_as_int(v), 16));
  const float c = __int_as_float(__builtin_amdgcn_readlane(__float_as_int(v), 32)), d = __int_as_float(__builtin_amdgcn_readlane(__float_as_int(v), 48));
  return (a + b) + (c + d);
}
__device__ __forceinline__ float quad_sum(float x) { x += dpp_f<0xB1>(x); x += dpp_f<0x4E>(x); return x; }
__device__ __forceinline__ int seq_start(int s) { return s < 8 ? s * 4096 : NPROMPT + (s - 8) * 8192; }
__device__ __forceinline__ void row_seq(int row, int& s, int& t, int& T) {
  if (row < NPROMPT) { s = row >> 12; t = row & 4095; T = 4096; }
  else { int r = row - NPROMPT; s = 8 + (r >> 13); t = r & 8191; T = 8192; }
}

__device__ __forceinline__ void tr_tile(const float* __restrict__ src, int ldsrc, int k0, int n0, int nvalid, bf16_t* __restrict__ dst, int ldd,
                        int kdst0, int mode, float* sm, const int tid) {
#pragma unroll
  for (int i = 0; i < 2; ++i) {
    const int r = (tid >> 4) + 32 * i, c = (tid & 15) * 4;
    float4 v = make_float4(0.f, 0.f, 0.f, 0.f);
    if (n0 + c < nvalid) v = *(const float4*)(src + (size_t)(k0 + r) * ldsrc + n0 + c);
    float* d = sm + r * 65 + c;
    d[0] = v.x; d[1] = v.y; d[2] = v.z; d[3] = v.w;
  }
  __syncthreads();
  {
    const int n = tid >> 3, kc = (tid & 7) * 8;
    float o[8];
#pragma unroll
    for (int j = 0; j < 8; ++j) o[j] = sm[(kc + j) * 65 + n];
    int nn = n0 + n, drow;
    const int c32 = nn & 31, slot = 16 * ((c32 >> 2) & 1) + 4 * (c32 >> 3) + (c32 & 3);
    if (mode == 0) drow = (nn & ~31) + slot;
    else drow = 256 * (nn >> 7) + (mode == 2 ? 128 : 0) + ((nn & 127) & ~31) + slot;
    *(uint4*)(dst + (size_t)drow * ldd + kdst0 + k0 + kc) = pack8(o);
  }
  __syncthreads();
}

__device__ __forceinline__ void prep_phase(PREF p, char* smem, const int wid_u) {
  float* sm = (float*)smem;
  const int tid = opaque_tid();
  constexpr int N_MOD = 144, N_EFF = 128, N_W13 = 4 * 704, N_W2 = 2 * 704, N_WIN = 640, N_WOUT = 128;
  constexpr int TOTAL = N_MOD + N_EFF + N_W13 + N_W2 + N_WIN + N_WOUT;
  for (int item = blockIdx.x; item < TOTAL; item += gridDim.x) {
    int it = item;
    if (it < N_MOD) {
      const int j0 = it * 64;
      float* sc = sm;
      float* red = sm + 16384;
      for (int idx = tid; idx < 16384; idx += NTHR) {
        const int s = idx >> 10, k = idx & 1023;
        const float* cp_ = p.c_prompt; const float* cs_ = p.c_sample;
        const float c = s < 8 ? cp_[s * 1024 + k] : cs_[(s - 8) * 1024 + k];
        sc[idx] = c / (1.f + __expf(-c));
      }
      __syncthreads();
      const int col = tid & 63, kg = tid >> 6;
      float acc[16];
#pragma unroll
      for (int s = 0; s < 16; ++s) acc[s] = 0.f;
      for (int k = kg * 128; k < kg * 128 + 128; ++k) {
        const float w = p.ada_w[(size_t)k * 9216 + j0 + col];
#pragma unroll
        for (int s = 0; s < 16; ++s) acc[s] += sc[s * 1024 + k] * w;
      }
#pragma unroll
      for (int s = 0; s < 16; ++s) red[(kg * 16 + s) * 64 + col] = acc[s];
      __syncthreads();
      for (int o = tid; o < 1024; o += NTHR) {
        const int s = o >> 6, c2 = o & 63;
        float v = p.ada_b[j0 + c2];
#pragma unroll
        for (int g = 0; g < 8; ++g) v += red[(g * 16 + s) * 64 + c2];
        P_MOD[s * 9216 + j0 + c2] = v;
      }
      __syncthreads();
      continue;
    }
    it -= N_MOD;
    if (it < N_EFF) {
      const int g = it >> 5, itile = (it >> 4) & 1, ntile = it & 15;
      float* As = sm;
      float* Bs = sm + 64 * 129;
      for (int idx = tid; idx < 64 * 128; idx += NTHR) {
        const int i = idx >> 7, j = idx & 127;
        As[i * 129 + j] = p.pool_w[((size_t)g * 128 + itile * 64 + i) * 128 + j] * p.pool_scale[g * 128 + j];
      }
      for (int idx = tid; idx < 128 * 64; idx += NTHR) {
        const int j = idx >> 6, nn = idx & 63;
        Bs[j * 65 + nn] = p.w_out[(size_t)(g * 128 + j) * 1024 + ntile * 64 + nn];
      }
      __syncthreads();
      const int i = tid >> 3, nn0 = (tid & 7) * 8;
      float acc[8];
#pragma unroll
      for (int q = 0; q < 8; ++q) acc[q] = 0.f;
      for (int j = 0; j < 128; ++j) {
        const float a = As[i * 129 + j];
#pragma unroll
        for (int q = 0; q < 8; ++q) acc[q] += a * Bs[j * 65 + nn0 + q];
      }
#pragma unroll
      for (int q = 0; q < 8; ++q)
      {
        const int nn = ntile * 64 + nn0 + q, c32 = nn & 31, slot = 16 * ((c32 >> 2) & 1) + 4 * (c32 >> 3) + (c32 & 3);
        P_WOUTT[(size_t)((nn & ~31) + slot) * 1024 + g * 128 + itile * 64 + i] = (bf16_t)(cvt_pk_bf16(acc[q], 0.f) & 0xffff);
      }
      __syncthreads();
      continue;
    }
    it -= N_EFF;
    if (it < N_W13) {
      const int which = it / 704, r = it % 704;
      const int kt = r / 44, ntl = r % 44;
      const float* src = sel(which < 2, sel(which == 0, p.f1_w1, p.f1_w3), sel(which == 2, p.f2_w1, p.f2_w3));
      bf16_t* dst = sel(which < 2, P_W13A, P_W13B);
      tr_tile(src, FF, kt * 64, ntl * 64, FF, dst, D, 0, (which & 1) ? 2 : 1, sm, tid);
      continue;
    }
    it -= N_W13;
    if (it < N_W2) {
      const int which = it / 704, r = it % 704;
      const int kt = r / 16, ntl = r % 16;
      tr_tile(sel(which != 0, p.f2_w2, p.f1_w2), D, kt * 64, ntl * 64, D, sel(which != 0, P_W2B, P_W2A), FF, 0, 0, sm, tid);
      continue;
    }
    it -= N_W2;
    if (it < N_WIN) {
      const int kt = it / 40, ntl = it % 40;
      tr_tile(p.w_in, PINW, kt * 64, ntl * 64, PINW, P_WINT, D, 0, 0, sm, tid);
      continue;
    }
    it -= N_WIN;
    {
      const int kt = it / 16, ntl = it % 16;
      tr_tile(p.w_out + (size_t)512 * 1024, D, kt * 64, ntl * 64, D, P_WOUTT, D, 512, 0, sm, tid);
    }
  }
}

template <int MODE>
__device__ __forceinline__ void row_phase(const float* __restrict__ xp, const float* __restrict__ xs, float* __restrict__ xout,
                          const bf16_t* __restrict__ y, bf16_t* __restrict__ h, const float* __restrict__ mod,
                          const float* __restrict__ npost, const float* __restrict__ npre, int gate_idx, float cgate, int shift_idx, const int wid_u,
                          const bool xin_bf = false) {
  const int tid_ = opaque_tid();
  const int lane = tid_ & 63;
  const int gw = blockIdx.x * 8 + (tid_ >> 6), GW = gridDim.x * 8;
  for (int chunk = gw; chunk < NTOK / 16; chunk += GW) {
    const int row0 = chunk * 16;
    int s, t, T;
    row_seq(row0, s, t, T);
    const float* md = mod + s * 9216;
    f32x4 Am[4], Bm[4], Gm[4];
#pragma unroll
    for (int i = 0; i < 4; ++i) {
      const int c = i * 256 + lane * 4;
      if (MODE != 2) {
        f32x4 np = *(const f32x4*)(npre + c), sc = *(const f32x4*)(md + (shift_idx + 1) * 1024 + c);
        Am[i] = np * (sc + 1.f);
        Bm[i] = *(const f32x4*)(md + shift_idx * 1024 + c);
      }
      if (MODE != 0) {
        f32x4 g = *(const f32x4*)(md + gate_idx * 1024 + c), po = *(const f32x4*)(npost + c);
        Gm[i] = g * po * cgate;
      }
    }
    for (int r = 0; r < 16; ++r) {
      const int row = row0 + r;
      const float* xr = (row < NPROMPT) ? xp + (size_t)row * D : xs + (size_t)(row - NPROMPT) * D;
      f32x4 xv[4];
      if (MODE != 0 && xin_bf) {
        const bf16_t* xb = (const bf16_t*)(xout + (size_t)row * D) + 1024;
#pragma unroll
        for (int i = 0; i < 4; ++i) {
          const uint2 u = *(const uint2*)(xb + i * 256 + lane * 4);
          xv[i] = (f32x4){bf_lo(u.x), bf_hi(u.x), bf_lo(u.y), bf_hi(u.y)};
        }
      } else {
#pragma unroll
        for (int i = 0; i < 4; ++i) xv[i] = *(const f32x4*)(xr + i * 256 + lane * 4);
      }
      if (MODE != 0) {
        f32x4 yv[4];
        float ss = 0.f;
#pragma unroll
        for (int i = 0; i < 4; ++i) {
          uint2 u = *(const uint2*)(y + (size_t)row * D + i * 256 + lane * 4);
          yv[i] = (f32x4){bf_lo(u.x), bf_hi(u.x), bf_lo(u.y), bf_hi(u.y)};
          ss += yv[i][0] * yv[i][0] + yv[i][1] * yv[i][1] + yv[i][2] * yv[i][2] + yv[i][3] * yv[i][3];
        }
        ss = wave_sum(ss);
        const float rs = rsqrtf(ss * (1.f / 1024.f) + 1e-6f);
#pragma unroll
        for (int i = 0; i < 4; ++i) {
          xv[i] = xv[i] + Gm[i] * yv[i] * rs;
          if (MODE == 2) *(f32x4*)(xout + (size_t)row * D + i * 256 + lane * 4) = xv[i];
          else {
            uint2 u; u.x = cvt_pk_bf16(xv[i][0], xv[i][1]); u.y = cvt_pk_bf16(xv[i][2], xv[i][3]);
            *(uint2*)((bf16_t*)(xout + (size_t)row * D) + 1024 + i * 256 + lane * 4) = u;
          }
        }
      }
      if (MODE != 2) {
        float ss = 0.f;
#pragma unroll
        for (int i = 0; i < 4; ++i) ss += xv[i][0] * xv[i][0] + xv[i][1] * xv[i][1] + xv[i][2] * xv[i][2] + xv[i][3] * xv[i][3];
        ss = wave_sum(ss);
        const float rs = rsqrtf(ss * (1.f / 1024.f) + 1e-6f);
#pragma unroll
        for (int i = 0; i < 4; ++i) {
          f32x4 hv = xv[i] * rs * Am[i] + Bm[i];
          uint2 u; u.x = cvt_pk_bf16(hv[0], hv[1]); u.y = cvt_pk_bf16(hv[2], hv[3]);
          *(uint2*)(h + (size_t)row * D + i * 256 + lane * 4) = u;
        }
      }
    }
  }
}

constexpr int BM = 256, BK = 64, HALF = 128, NXCD = 8, WGM = 4, HT = HALF * BK;
__device__ __forceinline__ int lds_byte(int r, int c) {
  int st = (r >> 4) * 2 + (c >> 5), rr = r & 15, cc = c & 31, ob = rr * 64 + cc * 2;
  return st * 1024 + (ob ^ (((ob >> 9) & 1) << 5));
}
__device__ __forceinline__ void stage_rc(int b, int& R, int& C) {
  int st = b / 1024, sb = b % 1024, swz = sb ^ (((sb >> 9) & 1) << 5);
  R = (st >> 1) * 16 + swz / 64; C = (st & 1) * 32 + (swz % 64) / 2;
}

__device__ __forceinline__ bool gemm_unit(int i, int nM, int nN, int nwg, int& pm, int& pn) {
  const long L = (long)i * gridDim.x + blockIdx.x;
  if (L >= nwg) return false;
  int wgid = (int)L;
  { int q = nwg / NXCD, r = nwg % NXCD, xcd = wgid % NXCD, off = wgid / NXCD;
    wgid = (xcd < r ? xcd * (q + 1) : r * (q + 1) + (xcd - r) * q) + off; }
  const int nig = WGM * nN, gid = wgid / nig, fm = gid * WGM, gsz = min(nM - fm, WGM);
  pm = fm + ((wgid % nig) % gsz); pn = (wgid % nig) / gsz;
  return true;
}

__device__ __forceinline__ void gemm_phase(const bf16_t* __restrict__ A, const bf16_t* __restrict__ Bt, bf16_t* __restrict__ C, int M, int N, int K,
                                           int ldc, const int EPI, char* smem, const int wid_u) {
  const int nM = M / BM, nN = N / BM, nwg = nM * nN;
  const int tid = opaque_tid();
  LAS bf16_t* shm = (LAS bf16_t*)smem;
#define SA(b, h) (shm + ((b) * 2 + (h)) * HT)
#define SB(b, h) (shm + (4 + (b) * 2 + (h)) * HT)
#define STG(P, GB) do { const char* _gb = (GB); \
    _Pragma("unroll") for (int _i = 0; _i < 2; ++_i) { \
      __builtin_amdgcn_global_load_lds((const unsigned*)(_gb + voff[_i]), \
        (LAS unsigned*)((LAS char*)(P) + ldsw + _i * 8192), 16, 0, 0); } } while (0)
#define LDA(dst, b, h) _Pragma("unroll") for (int m = 0; m < 4; ++m) _Pragma("unroll") for (int k = 0; k < 2; ++k) \
    dst[m][k] = *(const LAS bf16x8*)((LAS char*)SA(b, h) + aoff + m * 2048 + k * 1024)
#define LDB(dst, b, h) _Pragma("unroll") for (int n = 0; n < 2; ++n) _Pragma("unroll") for (int k = 0; k < 2; ++k) \
    dst[n][k] = *(const LAS bf16x8*)((LAS char*)SB(b, h) + boff + n * 2048 + k * 1024)
#define MMA(ai, bj, At_, Bt_) do { __builtin_amdgcn_s_setprio(1); \
    _Pragma("unroll") for (int m = 0; m < 4; ++m) _Pragma("unroll") for (int n = 0; n < 2; ++n) _Pragma("unroll") for (int k = 0; k < 2; ++k) \
      acc[ai][bj][m][n] = __builtin_amdgcn_mfma_f32_16x16x32_bf16(Bt_[n][k], At_[m][k], acc[ai][bj][m][n], 0, 0, 0); \
    __builtin_amdgcn_s_setprio(0); } while (0)
#define WAIT_V(n) asm volatile("s_waitcnt vmcnt(" #n ")" ::: "memory")
#define WAIT_L(n) asm volatile("s_waitcnt lgkmcnt(" #n ")" ::: "memory")
#define BAR __builtin_amdgcn_s_barrier()
#define SCHED __builtin_amdgcn_sched_barrier(0)
  const int wid = __builtin_amdgcn_readfirstlane(tid >> 6), lane = tid & 63, wr = wid >> 2, wc = wid & 3, fr = lane & 15, fq = lane >> 4;
  const int aoff = lds_byte(wr * 64 + fr, fq * 8), boff = lds_byte(wc * 32 + fr, fq * 8);
  unsigned voff[2];
  const int ldsw = wid * 1024;
#pragma unroll
  for (int _i = 0; _i < 2; ++_i) { int _r, _c; stage_rc(tid * 16 + _i * 8192, _r, _c); voff[_i] = (unsigned)(_r * K + _c) * 2u; }
  const int nt = K / BK;
  const size_t kstep = (size_t)BK * 2, hstep = (size_t)HALF * K * 2, tstep = 2 * hstep;
  int pm, pn, npm = 0, npn = 0, ui = 0;
  if (!gemm_unit(0, nM, nN, nwg, pm, pn)) return;
  f32x4 acc[2][2][4][2];
#pragma unroll
  for (int a = 0; a < 2; ++a)
#pragma unroll
    for (int b = 0; b < 2; ++b)
#pragma unroll
      for (int m = 0; m < 4; ++m)
#pragma unroll
        for (int n = 0; n < 2; ++n) acc[a][b][m][n] = (f32x4){0.f, 0.f, 0.f, 0.f};
  bf16x8 At[4][2], B0[2][2], B1[2][2];
  const char* cA = (const char*)A + (size_t)pm * tstep;
  const char* cB = (const char*)Bt + (size_t)pn * tstep;
  STG(SB(0, 0), cB); STG(SA(0, 0), cA); STG(SB(0, 1), cB + hstep); STG(SA(0, 1), cA + hstep);
  if (wr == 1) BAR;
  WAIT_V(4); BAR;
  STG(SB(1, 0), cB + kstep); STG(SA(1, 0), cA + kstep); STG(SB(1, 1), cB + hstep + kstep);
  WAIT_V(6); BAR;
  for (;;) {
    const bool has_next = gemm_unit(ui + 1, nM, nN, nwg, npm, npn);
    const char* nA = has_next ? (const char*)A + (size_t)npm * tstep : cA;
    const char* nB = has_next ? (const char*)Bt + (size_t)npn * tstep : cB;
    for (int t = 0; t < nt; t += 2) {
      const bool last = (t == nt - 2);
      const char* a1 = cA + (size_t)(t + 1) * kstep;
      const char* a2 = last ? nA : cA + (size_t)(t + 2) * kstep;
      const char* b2 = last ? nB : cB + (size_t)(t + 2) * kstep;
      const char* a3 = a2 + kstep;
      const char* b3 = b2 + kstep;
      LDB(B0, 0, 0); SCHED; LDA(At, 0, 0); STG(SA(1, 1), a1 + hstep);
      WAIT_L(8); BAR; WAIT_L(0); MMA(0, 0, At, B0); BAR; SCHED;
      LDB(B1, 0, 1); STG(SB(0, 0), b2);
      BAR; WAIT_L(0); MMA(0, 1, At, B1); BAR;
      LDA(At, 0, 1); STG(SA(0, 0), a2);
      BAR; WAIT_L(0); MMA(1, 0, At, B0); BAR; SCHED;
      STG(SB(0, 1), b2 + hstep);
      WAIT_V(6); BAR; MMA(1, 1, At, B1); BAR;
      LDB(B0, 1, 0); SCHED; LDA(At, 1, 0); STG(SA(0, 1), a2 + hstep);
      WAIT_L(8); BAR; WAIT_L(0); MMA(0, 0, At, B0); BAR; SCHED;
      LDB(B1, 1, 1); STG(SB(1, 0), b3);
      BAR; WAIT_L(0); MMA(0, 1, At, B1); BAR;
      LDA(At, 1, 1); STG(SA(1, 0), a3);
      BAR; WAIT_L(0); MMA(1, 0, At, B0); BAR; SCHED;
      STG(SB(1, 1), b3 + hstep);
      WAIT_V(6); BAR; MMA(1, 1, At, B1); BAR;
    }
    {
      const int brow = pm * BM, bcol = pn * BM;
#pragma unroll
      for (int ai = 0; ai < 2; ++ai)
#pragma unroll
        for (int m = 0; m < 4; ++m) {
          const size_t row = (size_t)(brow + ai * HALF + wr * 64 + m * 16 + fr);
          if (EPI == 0) {
#pragma unroll
            for (int bj = 0; bj < 2; ++bj) {
              const f32x4 v0 = acc[ai][bj][m][0], v1 = acc[ai][bj][m][1];
              uint4 u; u.x = cvt_pk_bf16(v0[0], v0[1]); u.y = cvt_pk_bf16(v0[2], v0[3]); u.z = cvt_pk_bf16(v1[0], v1[1]); u.w = cvt_pk_bf16(v1[2], v1[3]);
              *(uint4*)(C + row * ldc + bcol + bj * HALF + wc * 32 + fq * 8) = u;
            }
          } else {
            float o[8];
#pragma unroll
            for (int n = 0; n < 2; ++n) {
              const f32x4 a = acc[ai][0][m][n], b = acc[ai][1][m][n];
#pragma unroll
              for (int j = 0; j < 4; ++j) o[n * 4 + j] = a[j] * __builtin_amdgcn_rcpf(1.f + __expf(-a[j])) * b[j];
            }
            *(uint4*)(C + row * ldc + (bcol >> 1) + wc * 32 + fq * 8) = pack8(o);
          }
        }
    }
    if (!has_next) break;
#pragma unroll
    for (int a = 0; a < 2; ++a)
#pragma unroll
      for (int b = 0; b < 2; ++b)
#pragma unroll
        for (int m = 0; m < 4; ++m)
#pragma unroll
          for (int n = 0; n < 2; ++n) acc[a][b][m][n] = (f32x4){0.f, 0.f, 0.f, 0.f};
    pm = npm; pn = npn; cA = nA; cB = nB; ++ui;
  }
  WAIT_V(0);
  if (wr == 0) BAR;
  BAR;
#undef SA
#undef SB
#undef STG
#undef LDA
#undef LDB
#undef MMA
}

__device__ __forceinline__ void load_shift16(const bf16_t* __restrict__ z, int row, int t, int T, int col, const float* __restrict__ mu, float* o) {
  const bf16_t* pz = z + (size_t)row * ZLD + col;
  uint4 c0 = *(const uint4*)pz, c1 = *(const uint4*)(pz + 8);
  uint4 p0 = make_uint4(0, 0, 0, 0), p1 = p0, n0 = p0, n1 = p0;
  if (t > 0) { p0 = *(const uint4*)(pz - ZLD); p1 = *(const uint4*)(pz - ZLD + 8); }
  if (t < T - 1) { n0 = *(const uint4*)(pz + ZLD); n1 = *(const uint4*)(pz + ZLD + 8); }
  float c[16], pv[16], nx[16];
  unpack8(c0, c); unpack8(c1, c + 8); unpack8(p0, pv); unpack8(p1, pv + 8); unpack8(n0, nx); unpack8(n1, nx + 8);
#pragma unroll
  for (int q = 0; q < 16; ++q) o[q] = c[q] + (0.5f * (pv[q] + nx[q]) - c[q]) * mu[col - 512 + q];
}
__device__ __forceinline__ void load_shift8(const bf16_t* __restrict__ z, int row, int t, int T, int col, const float* __restrict__ mu, float* o) {
  const bf16_t* pz = z + (size_t)row * ZLD + col;
  uint4 c0 = *(const uint4*)pz;
  uint4 p0 = make_uint4(0, 0, 0, 0), n0 = p0;
  if (t > 0) p0 = *(const uint4*)(pz - ZLD);
  if (t < T - 1) n0 = *(const uint4*)(pz + ZLD);
  float c[8], pv[8], nx[8];
  unpack8(c0, c); unpack8(p0, pv); unpack8(n0, nx);
#pragma unroll
  for (int q = 0; q < 8; ++q) o[q] = c[q] + (0.5f * (pv[q] + nx[q]) - c[q]) * mu[col - 512 + q];
}

constexpr int TC = 32;
constexpr int SV = TC * 64;
__device__ __forceinline__ void lora_prep_phase(PREF p, const int wid_u) {
  const int tid = opaque_tid();
  const bf16_t* z = P_RU;
  bf16_t* al = P_ALORA;
  const float* mu = p.shift_mu;
  for (int task = blockIdx.x * NTHR + tid; task < NTOK * 32; task += gridDim.x * NTHR) {
    const int row = task >> 5, oc = task & 31;
    int s, t, T;
    row_seq(row, s, t, T);
    float o[8];
    load_shift8(z, row, t, T, 2048 + oc * 8, mu, o);
    if (oc < 16) {
#pragma unroll
      for (int q = 0; q < 8; ++q) { const float e = __expf(2.f * o[q]); o[q] = 1.f - 2.f * __builtin_amdgcn_rcpf(e + 1.f); }
    }
    *(uint4*)(al + (size_t)row * 256 + oc * 8) = pack8(o);
  }
}

template <int HALF>
__device__ __forceinline__ void pool_seg(const bf16_t* __restrict__ z, bf16_t* __restrict__ mo, int row_base, int tbase, int T, int c0) {
  constexpr int NR = 2 * HALF + 3;
  float acc[4][8], zc[4][8];
#pragma unroll
  for (int i = 0; i < 4; ++i)
#pragma unroll
    for (int q = 0; q < 8; ++q) { acc[i][q] = 0.f; zc[i][q] = 0.f; }
#pragma unroll
  for (int r = 0; r < NR; ++r) {
    const int tt = tbase - HALF + r;
    uint4 u = make_uint4(0, 0, 0, 0);
    if (tt >= 0 && tt < T) u = *(const uint4*)(z + (size_t)(row_base - HALF + r) * ZLD + c0);
    float v[8];
    unpack8(u, v);
#pragma unroll
    for (int i = 0; i < 4; ++i) {
      if (r >= i && r < i + 2 * HALF) {
#pragma unroll
        for (int q = 0; q < 8; ++q) acc[i][q] += v[q];
      }
      if (r == HALF + i) {
#pragma unroll
        for (int q = 0; q < 8; ++q) zc[i][q] = v[q];
      }
    }
  }
#pragma unroll
  for (int i = 0; i < 4; ++i) {
    const int ti = tbase + i;
    const float ic = 1.f / (float)(min(ti + HALF, T) - max(ti - HALF, 0));
    float o[8];
#pragma unroll
    for (int q = 0; q < 8; ++q) o[q] = acc[i][q] * ic - zc[i][q];
    *(uint4*)(mo + (size_t)(row_base + i) * D + c0) = pack8(o);
  }
}
__device__ __forceinline__ void pool_tile(const bf16_t* __restrict__ z, bf16_t* __restrict__ mo, int tile, int tid) {
  const int row0 = tile * 32;
  int s, t0, T;
  row_seq(row0, s, t0, T);
  const int oc = tid >> 3, seg = tid & 7, c0 = oc * 8, grp = __builtin_amdgcn_readfirstlane(oc >> 4);
  const int rb = row0 + seg * 4, tb = t0 + seg * 4;
  if (grp == 0) pool_seg<1>(z, mo, rb, tb, T, c0);
  else if (grp == 1) pool_seg<2>(z, mo, rb, tb, T, c0);
  else if (grp == 2) pool_seg<4>(z, mo, rb, tb, T, c0);
  else pool_seg<8>(z, mo, rb, tb, T, c0);
}

struct Raw16 { uint4 c0, c1, p0, p1, n0, n1; };
__device__ __forceinline__ void load_raw16(Raw16& r, const bf16_t* __restrict__ z, int row, int t, int T, int col) {
  const bf16_t* pz = z + (unsigned)(row * ZLD + col);
  r.c0 = *(const uint4*)pz; r.c1 = *(const uint4*)(pz + 8);
  r.p0 = make_uint4(0, 0, 0, 0); r.p1 = r.p0; r.n0 = r.p0; r.n1 = r.p0;
  if (t > 0) { r.p0 = *(const uint4*)(pz - ZLD); r.p1 = *(const uint4*)(pz - ZLD + 8); }
  if (t < T - 1) { r.n0 = *(const uint4*)(pz + ZLD); r.n1 = *(const uint4*)(pz + ZLD + 8); }
}
__device__ __forceinline__ void shift16(const Raw16& r, const float* c1, const float* c2, float* o) {
  float c[16], pv[16], nx[16];
  unpack8(r.c0, c); unpack8(r.c1, c + 8); unpack8(r.p0, pv); unpack8(r.p1, pv + 8); unpack8(r.n0, nx); unpack8(r.n1, nx + 8);
#pragma unroll
  for (int q = 0; q < 16; ++q) o[q] = c[q] * c1[q] + (pv[q] + nx[q]) * c2[q];
}
__device__ __forceinline__ bf16x8 ldfrag(const bf16_t* base, int stride, int row0, int k0, int fr, int fq) {
  return *reinterpret_cast<const bf16x8*>(base + (row0 + fr) * stride + k0 + fq * 8);
}
__device__ __forceinline__ uint2 pack4(f32x4 v) { uint2 u; u.x = cvt_pk_bf16(v[0], v[1]); u.y = cvt_pk_bf16(v[2], v[3]); return u; }
#define MFMA16(a, b, c) __builtin_amdgcn_mfma_f32_16x16x32_bf16(a, b, c, 0, 0, 0)

constexpr int CS_NAB = 0, CS_NAK = 4096, CS_NBRT = 8192, CS_NKRT = 10752, CS_QT = 13312, CS_W = 15872, CS_Z = 20992, CS_GT = 26112,
              CS_RYT = 35328, CS_VN = 39936;
constexpr int CS_AT = 49152, CS_RT = CS_AT + 4608, CS_BT = CS_RT + 4608, CS_KT = CS_BT + 4608, CS_BB = 67584, CS_KB = CS_BB + 5120,
              CS_VT = CS_KB + 5120, CS_ATT = 82944, CS_PL = 92160, CS_SBF = 92416, CS_PRIV = 110848, CS_CST = 143616, CS_BL = 145920;

__device__ __forceinline__ void lds_barrier() {
  asm volatile("s_waitcnt lgkmcnt(0)" ::: "memory");
  __builtin_amdgcn_s_barrier();
  asm volatile("" ::: "memory");
}
template <int Q> __device__ __forceinline__ float quad_bcast(float x) { return dpp_f<Q * 0x55>(x); }

template <int S0> __device__ __forceinline__ void solve_steps(float (&x)[8], const float* nab, int seg) {
  if constexpr (S0 < 32) {
    const float xs = quad_bcast<(S0 >> 3)>(x[S0 & 7]);
    const f32x4 n0 = *(const f32x4*)(nab + S0 * 32 + seg * 8), n1 = *(const f32x4*)(nab + S0 * 32 + seg * 8 + 4);
    x[0] += xs * n0[0]; x[1] += xs * n0[1]; x[2] += xs * n0[2]; x[3] += xs * n0[3];
    x[4] += xs * n1[0]; x[5] += xs * n1[1]; x[6] += xs * n1[2]; x[7] += xs * n1[3];
    solve_steps<S0 + 1>(x, nab, seg);
  }
}

template <int S0> __device__ __forceinline__ void solve16(float (&x)[8], const float* nb) {
  if constexpr (S0 < 16) {
    const float xs = (S0 >> 3) ? dpp_f<0xF5>(x[S0 & 7]) : dpp_f<0xA0>(x[S0 & 7]);
    const f32x4 n0 = *(const f32x4*)(nb + S0 * 32), n1 = *(const f32x4*)(nb + S0 * 32 + 4);
    x[0] += xs * n0[0]; x[1] += xs * n0[1]; x[2] += xs * n0[2]; x[3] += xs * n0[3];
    x[4] += xs * n1[0]; x[5] += xs * n1[1]; x[6] += xs * n1[2]; x[7] += xs * n1[3];
    solve16<S0 + 1>(x, nb);
  }
}

__device__ __forceinline__ void scan_phase(PREF p, char* smem, const int wid_u) {
  float* stepbuf = (float*)smem;
  float* Nab = (float*)(smem + CS_NAB);
  bf16_t* NakT = (bf16_t*)(smem + CS_NAK);
  bf16_t* VNb = (bf16_t*)(smem + CS_VN);
  bf16_t* T11b = (bf16_t*)(smem + CS_VN + 5120);
  bf16_t* M1T = (bf16_t*)(smem + CS_VN + 5120 + 1280);
  bf16_t* NbrT = (bf16_t*)(smem + CS_NBRT);
  bf16_t* NkrT = (bf16_t*)(smem + CS_NKRT);
  bf16_t* TT = (bf16_t*)(smem + CS_QT);
  bf16_t* Wb = (bf16_t*)(smem + CS_W);
  bf16_t* Zb = (bf16_t*)(smem + CS_Z);
  bf16_t* GT = (bf16_t*)(smem + CS_GT);
  bf16_t* RyT = (bf16_t*)(smem + CS_RYT);
  bf16_t* At = (bf16_t*)(smem + CS_AT);
  bf16_t* Rt = (bf16_t*)(smem + CS_RT);
  bf16_t* Bt = (bf16_t*)(smem + CS_BT);
  bf16_t* Kt = (bf16_t*)(smem + CS_KT);
  bf16_t* Bb = (bf16_t*)(smem + CS_BB);
  bf16_t* Kb = (bf16_t*)(smem + CS_KB);
  bf16_t* VT = (bf16_t*)(smem + CS_VT);
  bf16_t* AtTb = (bf16_t*)(smem + CS_ATT);
  float* PLs = (float*)(smem + CS_PL);
  bf16_t* Sbf = (bf16_t*)(smem + CS_SBF);
  float* cst = (float*)(smem + CS_CST);
  const bf16_t* z = P_RU;
  const int tid = opaque_tid();
  const int wave = __builtin_amdgcn_readfirstlane(tid >> 6), lane = tid & 63, fr = lane & 15, fq = lane >> 4;
  const int item = blockIdx.x;
  if (item < 256) {
    const int s = item < 128 ? 8 + (item >> 4) : ((item - 128) >> 4);
    const int h = (item & 15) >> 1, d = item & 1;
    const int T = s < 8 ? 4096 : 8192, r0seq = seq_start(s), nch = T / 32;
    bf16_t* yout = P_RY + (size_t)d * NTOK * 512;
    {
      const int g = tid >> 6, k = tid & 63;
      const float muk = p.shift_mu[1024 - 512 + h * 64 + k], mur = p.shift_mu[512 - 512 + h * 64 + k], muv = p.shift_mu[1536 - 512 + h * 64 + k];
      float v;
      if (g == 0) v = 0.5f * muk;
      else if (g == 1) v = 0.5f * mur;
      else if (g == 2) v = 1.f - muk;
      else if (g == 3) v = 1.f - mur;
      else if (g == 4) v = 1.f - muv;
      else if (g == 5) v = p.k_k[h * 64 + k];
      else if (g == 6) v = p.k_a[h * 64 + k];
      else v = p.r_k[h * 64 + k];
      cst[g * 64 + k] = v;
      if (g == 0) cst[8 * 64 + k] = 0.5f * muv;
      for (int i = tid; i < 2 * 64 * 72 / 2; i += NTHR) ((unsigned*)Sbf)[i] = 0u;
    }
    const int role = wave >> 1, th = wave & 1;
    const int tl = lane >> 2, cq = lane & 3;
    float* tmpa = (float*)(smem + CS_PRIV + (wave & 3) * 8192 + 2560);
    uint4* Blds = (uint4*)(smem + CS_BL) + (role & 1) * 512;
    float bias[4] = {0.f, 0.f, 0.f, 0.f};
    if (role < 2) {
      const float* lsrc = sel(role != 0, p.a2, p.w2) + (size_t)d * 64 * 512 + h * 64;
      if (th == 0) {
#pragma unroll
        for (int nt = 0; nt < 4; ++nt)
#pragma unroll
          for (int ks = 0; ks < 2; ++ks) {
            float o[8];
#pragma unroll
            for (int q = 0; q < 8; ++q) o[q] = lsrc[(size_t)(ks * 32 + fq * 8 + q) * 512 + nt * 16 + fr];
            Blds[(nt * 2 + ks) * 64 + lane] = pack8(o);
          }
      }
#pragma unroll
      for (int nt = 0; nt < 4; ++nt) bias[nt] = sel(role != 0, p.a0, p.w0)[d * 512 + h * 64 + nt * 16 + fr];
    }
    const int colA = 512 + h * 64 + cq * 16;
    const int colB = (role == 1 ? 1024 : 1536) + h * 64 + cq * 16;
    const int alo = (role == 0 ? d * 64 : 128 + d * 64) + fq * 8;
    Raw16 ra, rb;
    {
      const int j = th * 16 + tl, t = d ? T - 1 - j : j, row = r0seq + t;
      if (role == 2) load_raw16(ra, z, row, t, T, colA);
      if (role == 1 || role == 2) load_raw16(rb, z, row, t, T, colB);
      if (role < 2) {
        const int j2 = th * 16 + fr, t2 = d ? T - 1 - j2 : j2;
        const bf16_t* ap = P_ALORA + (unsigned)((r0seq + t2) * 256 + alo);
        ra.c0 = *(const uint4*)ap; ra.c1 = *(const uint4*)(ap + 32);
      }
    }
    f32x4 Sa = {0.f, 0.f, 0.f, 0.f}, Sb = Sa;
    uint2 y_def = make_uint2(0u, 0u);
    float sb_def = 0.f;
    const int mt = wave >> 1, hn = wave & 1, nt0 = 2 * hn, nt1 = 2 * hn + 1;
    __syncthreads();

    for (int c = 0; c < nch; ++c) {
      if (role < 3) {
        const int j = th * 16 + tl;
        const int istep = c * 32 + j;
        const int t = d ? T - 1 - istep : istep;
        const int row = r0seq + t;
        float v16[16];
        if (role < 2) {
          f32x4 acc[4] = {};
#pragma unroll
          for (int ks = 0; ks < 2; ++ks) {
            const uint4 au = ks == 0 ? ra.c0 : ra.c1;
            const bf16x8 a = *reinterpret_cast<const bf16x8*>(&au);
#pragma unroll
            for (int nt = 0; nt < 4; ++nt) { const uint4 bu = Blds[(nt * 2 + ks) * 64 + lane]; acc[nt] = MFMA16(a, *reinterpret_cast<const bf16x8*>(&bu), acc[nt]); }
          }
          if (role == 0) {
#pragma unroll
            for (int nt = 0; nt < 4; ++nt)
#pragma unroll
              for (int jj = 0; jj < 4; ++jj) {
                const float sg = sigmoidf_(bias[nt] + acc[nt][jj]);
                stepbuf[0 * SV + (th * 16 + fq * 4 + jj) * 64 + nt * 16 + fr] = __expf(-0.6065306597126334f * sg);
              }
            __builtin_amdgcn_wave_barrier();
            {
              float wl[16];
#pragma unroll
              for (int i = 0; i < 16; ++i) wl[i] = stepbuf[0 * SV + (th * 16 + i) * 64 + lane];
              float pr = 1.f;
#pragma unroll
              for (int i = 0; i < 16; ++i) { pr *= wl[i]; stepbuf[0 * SV + (th * 16 + i) * 64 + lane] = pr; }
            }
          } else {
#pragma unroll
            for (int nt = 0; nt < 4; ++nt)
#pragma unroll
              for (int jj = 0; jj < 4; ++jj) tmpa[(fq * 4 + jj) * 68 + nt * 16 + fr] = sigmoidf_(bias[nt] + acc[nt][jj]);
            __builtin_amdgcn_wave_barrier();
            float av[16], kd[16];
#pragma unroll
            for (int q = 0; q < 4; ++q) { f32x4 a4 = *(const f32x4*)(tmpa + tl * 68 + cq * 16 + q * 4); av[q * 4] = a4[0]; av[q * 4 + 1] = a4[1]; av[q * 4 + 2] = a4[2]; av[q * 4 + 3] = a4[3]; }
            shift16(rb, cst + 2 * 64 + cq * 16, cst + 0 * 64 + cq * 16, v16);
            float kk[16], ss = 0.f;
#pragma unroll
            for (int q = 0; q < 16; ++q) { kk[q] = v16[q] * cst[5 * 64 + cq * 16 + q]; ss += kk[q] * kk[q]; }
            ss = quad_sum(ss);
            const float inv = 1.f / fmaxf(sqrtf(ss), 1e-12f);
#pragma unroll
            for (int q = 0; q < 16; ++q) { kk[q] *= inv; kd[q] = v16[q] * (1.f + (av[q] - 1.f) * cst[6 * 64 + cq * 16 + q]); }
#pragma unroll
            for (int q = 0; q < 4; ++q) {
              *(f32x4*)(stepbuf + 3 * SV + j * 64 + cq * 16 + q * 4) = (f32x4){-kk[q * 4], -kk[q * 4 + 1], -kk[q * 4 + 2], -kk[q * 4 + 3]};
              *(f32x4*)(stepbuf + 4 * SV + j * 64 + cq * 16 + q * 4) = (f32x4){kk[q * 4] * av[q * 4], kk[q * 4 + 1] * av[q * 4 + 1], kk[q * 4 + 2] * av[q * 4 + 2], kk[q * 4 + 3] * av[q * 4 + 3]};
              *(f32x4*)(stepbuf + 1 * SV + j * 64 + cq * 16 + q * 4) = (f32x4){kd[q * 4], kd[q * 4 + 1], kd[q * 4 + 2], kd[q * 4 + 3]};
            }
          }
        } else {
          shift16(ra, cst + 3 * 64 + cq * 16, cst + 1 * 64 + cq * 16, v16);
#pragma unroll
          for (int q = 0; q < 4; ++q) *(f32x4*)(stepbuf + 2 * SV + j * 64 + cq * 16 + q * 4) = (f32x4){v16[q * 4], v16[q * 4 + 1], v16[q * 4 + 2], v16[q * 4 + 3]};
          shift16(rb, cst + 4 * 64 + cq * 16, cst + 8 * 64 + cq * 16, v16);
#pragma unroll
          for (int q = 0; q < 4; ++q) *(f32x4*)(stepbuf + 5 * SV + j * 64 + cq * 16 + q * 4) = (f32x4){v16[q * 4], v16[q * 4 + 1], v16[q * 4 + 2], v16[q * 4 + 3]};
        }
      }
      if (c > 0) {
        const int ip = (c - 1) * 32 + hn * 16 + fr, tp = d ? T - 1 - ip : ip;
        *(uint2*)(yout + (size_t)(r0seq + tp) * 512 + h * 64 + mt * 16 + fq * 4) = y_def;
        if (role == 2 && cq == 0) { const int is_ = (c - 1) * 32 + th * 16 + tl, tg = d ? T - 1 - is_ : is_; P_SBON[((size_t)(r0seq + tg) * 8 + h) * 2 + d] = sb_def; }
      }
      if (role < 3 && c + 1 < nch) {
        const int is2 = (c + 1) * 32 + th * 16 + tl;
        const int t2 = d ? T - 1 - is2 : is2;
        const int row2 = r0seq + t2;
        if (role == 2) load_raw16(ra, z, row2, t2, T, colA);
        if (role >= 1) load_raw16(rb, z, row2, t2, T, colB);
        if (role < 2) {
          const int is3 = (c + 1) * 32 + th * 16 + fr, t3 = d ? T - 1 - is3 : is3;
          const bf16_t* ap = P_ALORA + (unsigned)((r0seq + t3) * 256 + alo);
          ra.c0 = *(const uint4*)ap; ra.c1 = *(const uint4*)(ap + 32);
        }
      }
      lds_barrier();
      {
        const int k = lane, seg = wave;
        const float* sw = stepbuf + 0 * SV + k;
        const float P15 = sw[15 * 64];
        const float hiF = seg >= 4 ? P15 : 1.f;
        float P[5];
        P[0] = seg == 0 ? 1.f : sw[(4 * seg - 1) * 64] * (seg > 4 ? P15 : 1.f);
#pragma unroll
        for (int i = 0; i < 4; ++i) P[i + 1] = sw[(4 * seg + i) * 64] * hiF;
        const float PL = sw[31 * 64] * P15;
        if (role == 2) {
          const int j = th * 16 + tl;
          float bs = 0.f;
#pragma unroll
          for (int q = 0; q < 16; ++q) bs += stepbuf[2 * SV + j * 64 + cq * 16 + q] * stepbuf[1 * SV + j * 64 + cq * 16 + q] * cst[7 * 64 + cq * 16 + q];
          bs = quad_sum(bs);
          sb_def = bs;
        }
        f32x4 bb, kb, at, vv;
#pragma unroll
        for (int i = 0; i < 4; ++i) {
          const int t = 4 * seg + i;
          const float inv = __builtin_amdgcn_rcpf(P[i + 1]);
          const float a_ = P[i] * stepbuf[3 * SV + t * 64 + k];
          const float rraw = stepbuf[2 * SV + t * 64 + k], kraw = stepbuf[1 * SV + t * 64 + k];
          const float r_ = P[i + 1] * rraw;
          const float b_ = stepbuf[4 * SV + t * 64 + k] * inv;
          const float k_ = kraw * inv;

          At[t * 72 + k] = (bf16_t)(cvt_pk_bf16(a_, 0.f) & 0xffff);
          Rt[t * 72 + k] = (bf16_t)(cvt_pk_bf16(r_, 0.f) & 0xffff);
          Bt[t * 72 + k] = (bf16_t)(cvt_pk_bf16(b_, 0.f) & 0xffff);
          Kt[t * 72 + k] = (bf16_t)(cvt_pk_bf16(k_, 0.f) & 0xffff);
          bb[i] = b_ * PL; kb[i] = k_ * PL; at[i] = a_;
          vv[i] = stepbuf[5 * SV + t * 64 + k];
        }
        *(uint2*)(Bb + k * 40 + 4 * seg) = pack4(bb);
        *(uint2*)(Kb + k * 40 + 4 * seg) = pack4(kb);
        *(uint2*)(VT + k * 40 + 4 * seg) = pack4(vv);
        *(uint2*)(AtTb + k * 40 + 4 * seg) = pack4(at);
        if (seg == 0) PLs[k] = PL;
      }
      lds_barrier();
      {
        const int mat = wave >> 1, mts = wave & 1;
        const bf16_t* As = (mat & 1) ? Kt : Bt;
        const bf16_t* Bs = (mat & 2) ? Rt : At;
        f32x4 acc[2] = {};
#pragma unroll
        for (int ks = 0; ks < 2; ++ks) {
          const bf16x8 a = ldfrag(As, 72, mts * 16, ks * 32, fr, fq);
#pragma unroll
          for (int nt = 0; nt < 2; ++nt) acc[nt] = MFMA16(a, ldfrag(Bs, 72, nt * 16, ks * 32, fr, fq), acc[nt]);
        }
#pragma unroll
        for (int nt = 0; nt < 2; ++nt) {
          const int tcol = nt * 16 + fr;
          f32x4 v = acc[nt];
#pragma unroll
          for (int jj = 0; jj < 4; ++jj) {
            const int srow = mts * 16 + fq * 4 + jj;
            const bool keep = (mat & 2) ? (srow <= tcol) : (srow < tcol);
            v[jj] = keep ? v[jj] : 0.f;
          }
          if (mat == 0) {
#pragma unroll
            for (int jj = 0; jj < 4; ++jj) Nab[(mts * 16 + fq * 4 + jj) * 32 + tcol] = v[jj];
          } else {
            bf16_t* dst = mat == 1 ? NakT : mat == 2 ? NbrT : NkrT;
            *(uint2*)(dst + tcol * 40 + mts * 16 + fq * 4) = pack4(v);
          }
        }
      }
      lds_barrier();
      if (wave == 0) {
        const int irow = lane >> 1, hb = lane & 1, blk = lane >> 5, il = irow & 15;
        float x[8];
#pragma unroll
        for (int i = 0; i < 8; ++i) x[i] = (hb * 8 + i == il) ? 1.f : 0.f;
        const float* nb = Nab + (blk * 16) * 32 + blk * 16 + hb * 8;
        solve16<0>(x, nb);
#pragma unroll
        for (int i = 0; i < 8; ++i) TT[(blk * 16 + hb * 8 + i) * 40 + blk * 16 + il] = (bf16_t)(cvt_pk_bf16(x[i], 0.f) & 0xffff);
        if (blk == 0) *(uint4*)(T11b + il * 40 + hb * 8) = pack8(x);
        __builtin_amdgcn_wave_barrier();
        const f32x4 zero = {0.f, 0.f, 0.f, 0.f};
        bf16x8 zf;
#pragma unroll
        for (int i = 0; i < 8; ++i) zf[i] = 0;
        bf16x8 n12 = zf, t22 = zf, t11 = zf;
        if (fq < 2) {
          float o[8];
          const f32x4 n0 = *(const f32x4*)(Nab + fr * 32 + 16 + fq * 8), n1 = *(const f32x4*)(Nab + fr * 32 + 16 + fq * 8 + 4);
          o[0] = n0[0]; o[1] = n0[1]; o[2] = n0[2]; o[3] = n0[3]; o[4] = n1[0]; o[5] = n1[1]; o[6] = n1[2]; o[7] = n1[3];
          uint4 u = pack8(o);
          n12 = *reinterpret_cast<bf16x8*>(&u);
          t22 = *reinterpret_cast<const bf16x8*>(TT + (16 + fr) * 40 + 16 + fq * 8);
          t11 = *reinterpret_cast<const bf16x8*>(T11b + fr * 40 + fq * 8);
        }
        const f32x4 m1 = MFMA16(n12, t22, zero);
        *(uint2*)(M1T + fr * 40 + fq * 4) = pack4(m1);
        __builtin_amdgcn_wave_barrier();
        bf16x8 m1f = zf;
        if (fq < 2) m1f = *reinterpret_cast<const bf16x8*>(M1T + fr * 40 + fq * 8);
        const f32x4 t12 = MFMA16(t11, m1f, zero);
        *(uint2*)(TT + (16 + fr) * 40 + fq * 4) = pack4(t12);
      } else if (wave == 1) {
        unsigned z0;
        asm volatile("v_mov_b32 %0, 0" : "=v"(z0));
        *(uint2*)(TT + (lane >> 2) * 40 + 16 + (lane & 3) * 4) = make_uint2(z0, z0);
      } else if (wave < 6) {
        const int vtile = wave - 2;
        const bf16x8 vf = ldfrag(VT, 40, vtile * 16, 0, fr, fq);
        const f32x4 zero = {0.f, 0.f, 0.f, 0.f};
#pragma unroll
        for (int tt = 0; tt < 2; ++tt) {
          const f32x4 acc = MFMA16(ldfrag(NakT, 40, tt * 16, 0, fr, fq), vf, zero);
          *(uint2*)(VNb + (vtile * 16 + fr) * 40 + tt * 16 + fq * 4) = pack4(acc);
        }
      }
      lds_barrier();
      {
        const int tt = wave & 1, rt = wave >> 1;
        const f32x4 zero = {0.f, 0.f, 0.f, 0.f};
        const bf16x8 tf = ldfrag(TT, 40, tt * 16, 0, fr, fq);
        const f32x4 zacc = MFMA16(tf, ldfrag(VNb, 40, rt * 16, 0, fr, fq), zero);
        const f32x4 wacc = MFMA16(tf, ldfrag(AtTb, 40, rt * 16, 0, fr, fq), zero);
        *(uint2*)(Zb + (rt * 16 + fr) * 40 + tt * 16 + fq * 4) = pack4(zacc);
        *(uint2*)(Wb + (rt * 16 + fr) * 40 + tt * 16 + fq * 4) = pack4(wacc);
      }
      lds_barrier();
      f32x4 yacc = {0.f, 0.f, 0.f, 0.f};
      {
        const float pl0 = PLs[nt0 * 16 + fr], pl1 = PLs[nt1 * 16 + fr];
        Sa = Sa * pl0; Sb = Sb * pl1;
        const bf16x8 zf = ldfrag(Zb, 40, mt * 16, 0, fr, fq), vf = ldfrag(VT, 40, mt * 16, 0, fr, fq), wf = ldfrag(Wb, 40, mt * 16, 0, fr, fq);
        const bf16x8 bb0 = ldfrag(Bb, 40, nt0 * 16, 0, fr, fq), bb1 = ldfrag(Bb, 40, nt1 * 16, 0, fr, fq);
        const bf16x8 kb0 = ldfrag(Kb, 40, nt0 * 16, 0, fr, fq), kb1 = ldfrag(Kb, 40, nt1 * 16, 0, fr, fq);
        const bf16x8 nbr = ldfrag(NbrT, 40, hn * 16, 0, fr, fq), nkr = ldfrag(NkrT, 40, hn * 16, 0, fr, fq);
        Sa = MFMA16(zf, bb0, Sa); Sa = MFMA16(vf, kb0, Sa);
        Sb = MFMA16(zf, bb1, Sb); Sb = MFMA16(vf, kb1, Sb);
        yacc = MFMA16(zf, nbr, yacc); yacc = MFMA16(vf, nkr, yacc);
        const f32x4 zero = {0.f, 0.f, 0.f, 0.f};
        const f32x4 g0 = MFMA16(wf, bb0, zero), g1 = MFMA16(wf, bb1, zero);
        f32x4 ry = MFMA16(wf, nbr, zero);
        *(uint2*)(GT + (nt0 * 16 + fr) * 72 + mt * 16 + fq * 4) = pack4(g0);
        *(uint2*)(GT + (nt1 * 16 + fr) * 72 + mt * 16 + fq * 4) = pack4(g1);
        const uint2 rr = *(const uint2*)(Rt + (hn * 16 + fr) * 72 + mt * 16 + fq * 4);
        ry[0] += bf_lo(rr.x); ry[1] += bf_hi(rr.x); ry[2] += bf_lo(rr.y); ry[3] += bf_hi(rr.y);
        *(uint2*)(RyT + (hn * 16 + fr) * 72 + mt * 16 + fq * 4) = pack4(ry);
      }
      lds_barrier();
      {
        const bf16_t* Scur = Sbf + (c & 1) * 64 * 72;
        bf16_t* Snext = Sbf + ((c + 1) & 1) * 64 * 72;
#pragma unroll
        for (int ks = 0; ks < 2; ++ks) {
          const bf16x8 af = ldfrag(Scur, 72, mt * 16, ks * 32, fr, fq);
          Sa = MFMA16(af, ldfrag(GT, 72, nt0 * 16, ks * 32, fr, fq), Sa);
          Sb = MFMA16(af, ldfrag(GT, 72, nt1 * 16, ks * 32, fr, fq), Sb);
          yacc = MFMA16(af, ldfrag(RyT, 72, hn * 16, ks * 32, fr, fq), yacc);
        }
        y_def = pack4(yacc);
#pragma unroll
        for (int jj = 0; jj < 4; ++jj) {
          Snext[(mt * 16 + fq * 4 + jj) * 72 + nt0 * 16 + fr] = (bf16_t)(cvt_pk_bf16(Sa[jj], 0.f) & 0xffff);
          Snext[(mt * 16 + fq * 4 + jj) * 72 + nt1 * 16 + fr] = (bf16_t)(cvt_pk_bf16(Sb[jj], 0.f) & 0xffff);
        }
      }
      lds_barrier();
    }
    {
      const int ip = (nch - 1) * 32 + hn * 16 + fr, tp = d ? T - 1 - ip : ip;
      *(uint2*)(yout + (size_t)(r0seq + tp) * 512 + h * 64 + mt * 16 + fq * 4) = y_def;
      if (role == 2 && cq == 0) { const int is_ = (nch - 1) * 32 + th * 16 + tl, tg = d ? T - 1 - is_ : is_; P_SBON[((size_t)(r0seq + tg) * 8 + h) * 2 + d] = sb_def; }
    }
  }
  if (item >= 128) {
    const int nb = gridDim.x - 128;
    for (int tile = item - 128; tile < NTOK / 32; tile += nb) pool_tile(z, P_RH, tile, tid);
  }
}

__device__ __forceinline__ void post_phase(PREF p, char* smem, const int wid_u) {
  bf16_t* Ag = (bf16_t*)smem;
  bf16_t* vt = (bf16_t*)(smem + 12800);
  float* ys = (float*)(smem + 12800 + 33280);
  const bf16_t* z = P_RU;
  const bf16_t* yf = P_RY;
  const bf16_t* ybk = P_RY + (size_t)NTOK * 512;
  bf16_t* mo = P_RH;
  const int tid = opaque_tid(), w = tid >> 6, lane = tid & 63, fr = lane & 15, fq = lane >> 4;
  bf16x8 Bg[4][6];
#pragma unroll
  for (int nt = 0; nt < 4; ++nt)
#pragma unroll
    for (int ks = 0; ks < 6; ++ks) {
      float o[8];
#pragma unroll
      for (int q = 0; q < 8; ++q) { const int k = ks * 32 + fq * 8 + q; o[q] = k < 160 ? p.g2[(size_t)k * 512 + w * 64 + nt * 16 + fr] : 0.f; }
      uint4 u = pack8(o);
      Bg[nt][ks] = *reinterpret_cast<bf16x8*>(&u);
    }
  float lng[4], lnb[4];
#pragma unroll
  for (int nt = 0; nt < 4; ++nt) { lng[nt] = p.lnx_g[w * 64 + nt * 16 + fr]; lnb[nt] = p.lnx_b[w * 64 + nt * 16 + fr]; }

  for (int tile = blockIdx.x; tile < NTOK / 32; tile += gridDim.x) {
    const int row0 = tile * 32;
    int s, t0, T;
    row_seq(row0, s, t0, T);
    for (int idx = tid; idx < 32 * 24; idx += NTHR) {
      const int tok = idx / 24, oc = idx % 24;
      float o[8];
      if (oc < 20) {
        load_shift8(z, row0 + tok, t0 + tok, T, 2304 + oc * 8, p.shift_mu, o);
#pragma unroll
        for (int q = 0; q < 8; ++q) o[q] = sigmoidf_(o[q]);
      } else {
#pragma unroll
        for (int q = 0; q < 8; ++q) o[q] = 0.f;
      }
      *(uint4*)(Ag + tok * 200 + oc * 8) = pack8(o);
    }
#pragma unroll 1
    for (int half_ = 0; half_ < 2; ++half_) {
      uint4 zc[2], zp[2], zn[2], ya[2], yb4[2];
#pragma unroll
      for (int i = 0; i < 2; ++i) {
        const int idx = tid + (half_ * 2 + i) * NTHR, tok = idx >> 6, oc = idx & 63, row = row0 + tok, t = t0 + tok;
        const bf16_t* pz = z + (size_t)row * ZLD + 1536 + oc * 8;
        zc[i] = *(const uint4*)pz;
        zp[i] = make_uint4(0, 0, 0, 0); zn[i] = zp[i];
        if (t > 0) zp[i] = *(const uint4*)(pz - ZLD);
        if (t < T - 1) zn[i] = *(const uint4*)(pz + ZLD);
        ya[i] = *(const uint4*)(yf + (size_t)row * 512 + oc * 8);
        yb4[i] = *(const uint4*)(ybk + (size_t)row * 512 + oc * 8);
      }
#pragma unroll
      for (int i = 0; i < 2; ++i) {
        const int idx = tid + (half_ * 2 + i) * NTHR, tok = idx >> 6, oc = idx & 63;
        float c[8], pv[8], nx[8], o[8];
        unpack8(zc[i], c); unpack8(zp[i], pv); unpack8(zn[i], nx);
#pragma unroll
        for (int q = 0; q < 8; ++q) o[q] = c[q] + (0.5f * (pv[q] + nx[q]) - c[q]) * p.shift_mu[1536 - 512 + oc * 8 + q];
        *(uint4*)(vt + tok * 520 + oc * 8) = pack8(o);
        float a[8], b[8];
        unpack8(ya[i], a); unpack8(yb4[i], b);
        *(f32x4*)(ys + tok * 516 + oc * 8) = (f32x4){a[0] + b[0], a[1] + b[1], a[2] + b[2], a[3] + b[3]};
        *(f32x4*)(ys + tok * 516 + oc * 8 + 4) = (f32x4){a[4] + b[4], a[5] + b[5], a[6] + b[6], a[7] + b[7]};
      }
    }
    __syncthreads();
    f32x4 acc[2][4] = {};
#pragma unroll
    for (int ks = 0; ks < 6; ++ks) {
      bf16x8 a[2];
#pragma unroll
      for (int mt = 0; mt < 2; ++mt) a[mt] = *reinterpret_cast<const bf16x8*>(Ag + (mt * 16 + fr) * 200 + ks * 32 + fq * 8);
#pragma unroll
      for (int mt = 0; mt < 2; ++mt)
#pragma unroll
        for (int nt = 0; nt < 4; ++nt) acc[mt][nt] = __builtin_amdgcn_mfma_f32_16x16x32_bf16(a[mt], Bg[nt][ks], acc[mt][nt], 0, 0, 0);
    }
#pragma unroll
    for (int mt = 0; mt < 2; ++mt)
#pragma unroll
      for (int jj = 0; jj < 4; ++jj) {
        const int tok = mt * 16 + fq * 4 + jj, row = row0 + tok;
        float yv[4], sm_ = 0.f;
#pragma unroll
        for (int nt = 0; nt < 4; ++nt) { yv[nt] = ys[tok * 516 + w * 64 + nt * 16 + fr]; sm_ += yv[nt]; }
        const float mean = row16_sum(sm_) * (1.f / 64.f);
        float vs = 0.f;
#pragma unroll
        for (int nt = 0; nt < 4; ++nt) { yv[nt] -= mean; vs += yv[nt] * yv[nt]; }
        const float rs = rsqrtf(row16_sum(vs) * (1.f / 64.f) + 64e-5f);
        const float2 sb2 = *(const float2*)(P_SBON + ((size_t)row * 8 + w) * 2);
        const float sbs = sb2.x + sb2.y;
#pragma unroll
        for (int nt = 0; nt < 4; ++nt) {
          const float vv = bf2f(vt[tok * 520 + w * 64 + nt * 16 + fr]);
          const float o = (yv[nt] * rs * lng[nt] + lnb[nt] + sbs * vv) * acc[mt][nt][jj];
          mo[(size_t)row * D + 512 + w * 64 + nt * 16 + fr] = (bf16_t)(cvt_pk_bf16(o, 0.f) & 0xffff);
        }
      }
    __syncthreads();
  }
}

#define XB_TMO      128
#define XB_XCNT(j)  (256  + 64 * (j))
#define XB_XSUB(j)  (1280 + 64 * (j))
#define XB_XGEN(j)  (2304 + 64 * (j))
#define XB_TOP      3328
#define XB_TOPGEN   3392
#define XCD_BAR_WORDS 3456
#define XB_SPIN_CAP (1u << 22)
__device__ __forceinline__ unsigned xb_ld(unsigned* p)              { return __hip_atomic_load(p, __ATOMIC_RELAXED, __HIP_MEMORY_SCOPE_AGENT); }
__device__ __forceinline__ unsigned xb_add(unsigned* p, unsigned v) { return __hip_atomic_fetch_add(p, v, __ATOMIC_RELAXED, __HIP_MEMORY_SCOPE_AGENT); }
__device__ __forceinline__ unsigned xb_xcc_id() { return (unsigned)__builtin_amdgcn_s_getreg((3 << 11) | 20) & 0xFu; }
#define XB_SPIN(cond, bar) do { unsigned _sp = 0; while (cond) { __builtin_amdgcn_s_sleep(1); \
    if ((++_sp & 255u) == 0u) { if (xb_ld(&(bar)[XB_TMO])) break; if (_sp > XB_SPIN_CAP) { atomicAdd(&(bar)[XB_TMO], 1u); break; } } } } while (0)
struct XcdBarrier { unsigned* bar; unsigned x; volatile LAS unsigned* st; };
__device__ __forceinline__ void xcd_barrier_complete(unsigned* bar, unsigned x, unsigned& nloc, unsigned& nx) {
  const unsigned G = gridDim.x * gridDim.y * gridDim.z;
  unsigned sum, cnt, mine, sp = 0u;
  for (;;) {
    sum = 0u; cnt = 0u; mine = 0u;
#pragma unroll
    for (unsigned j = 0; j < 16; ++j) { const unsigned c = xb_ld(&bar[XB_XCNT(j)]); sum += c; cnt += (c > 0u) ? 1u : 0u; mine = (j == x) ? c : mine; }
    if (sum == G) break;
    __builtin_amdgcn_s_sleep(1);
    if ((++sp & 255u) == 0u) { if (xb_ld(&bar[XB_TMO])) break; if (sp > XB_SPIN_CAP) { atomicAdd(&bar[XB_TMO], 1u); break; } }
  }
  nloc = mine > 0u ? mine : 1u; nx = cnt > 0u ? cnt : 1u;
}
__device__ __forceinline__ void xcd_barrier(PREF p, volatile LAS unsigned* st_, const int wid_u) {
  asm volatile("s_waitcnt vmcnt(0)" ::: "memory");
  __syncthreads();
  if (opaque_tid() == 0) {
    XcdBarrier b; b.bar = (unsigned*)(p.ws + OFF_BAR); b.x = xb_xcc_id(); b.st = st_;
    unsigned* bar = b.bar;
    __builtin_amdgcn_s_waitcnt(0);
    unsigned nloc = b.st[0], nx = b.st[1];
    if (nloc == 0u) { xcd_barrier_complete(bar, b.x, nloc, nx); b.st[0] = nloc; b.st[1] = nx; }
    const unsigned old = xb_add(&bar[XB_XSUB(b.x)], 1u);
    const unsigned gen = old / nloc;
    if (old + 1u == (gen + 1u) * nloc) {
      __builtin_amdgcn_fence(__ATOMIC_RELEASE, "agent");
      asm volatile("s_waitcnt vmcnt(0)" ::: "memory");
      const unsigned og = xb_add(&bar[XB_TOP], 1u);
      const unsigned tg = og / nx;
      if (og + 1u == (tg + 1u) * nx) xb_add(&bar[XB_TOPGEN], 1u);
      else XB_SPIN(xb_ld(&bar[XB_TOPGEN]) == tg, bar);
      __builtin_amdgcn_fence(__ATOMIC_ACQUIRE, "agent");
      xb_add(&bar[XB_XGEN(b.x)], 1u);
      asm volatile("s_waitcnt vmcnt(0)" ::: "memory");
    } else {
      XB_SPIN(xb_ld(&bar[XB_XGEN(b.x)]) == gen, bar);
      __builtin_amdgcn_fence(__ATOMIC_ACQUIRE, "agent");
      asm volatile("s_waitcnt vmcnt(0)" ::: "memory");
    }
  }
  __syncthreads();
}

constexpr int NPHASE = 14;
__device__ __forceinline__ void do_phase(PREF p, int ph, char* smem, const int wid_u) {
  if (ph == 0) prep_phase(p, smem, wid_u);
  else if (ph == 1) row_phase<0>(p.x_prompt, p.x_sample, nullptr, nullptr, P_RH, P_MOD, nullptr, p.n1_pre, 0, 0.f, 0, wid_u);
  else if (ph == 4 || ph == 10) {
    const bool f = ph == 4;
    float* outp = p.out;
    row_phase<1>(sel(f, p.x_prompt, (const float*)outp), sel(f, p.x_sample, (const float*)(outp + (size_t)NPROMPT * D)), outp, P_RY, P_RH, P_MOD,
                 sel(f, p.n1_post, p.nm_post), sel(f, p.nm_pre, p.n2_pre), f ? 2 : 5, f ? 0.5f : 1.0f, f ? 3 : 6, wid_u, !f);
  }
  else if (ph == 13) row_phase<2>(p.out, p.out + (size_t)NPROMPT * D, p.out, P_RY, nullptr, P_MOD, p.n2_post, nullptr, 8, 0.5f, 0, wid_u, true);
  else if (ph == 6) lora_prep_phase(p, wid_u);
  else if (ph == 7) scan_phase(p, smem, wid_u);
  else if (ph == 8) post_phase(p, smem, wid_u);
  else {
    const bf16_t *A, *Bt; bf16_t* C; int N, K, ldc, epi;
    if (ph == 2 || ph == 11) { A = P_RH; Bt = sel(ph == 2, P_W13A, P_W13B); C = P_RU; N = 2 * FF; K = D; ldc = FF; epi = 1; }
    else if (ph == 3 || ph == 12) { A = P_RU; Bt = sel(ph == 3, P_W2A, P_W2B); C = P_RY; N = D; K = FF; ldc = D; epi = 0; }
    else if (ph == 5) { A = P_RH; Bt = P_WINT; C = P_RU; N = ZLD; K = D; ldc = ZLD; epi = 0; }
    else { A = P_RH; Bt = P_WOUTT; C = P_RY; N = D; K = D; ldc = D; epi = 0; }
    gemm_phase(A, Bt, C, NTOK, N, K, ldc, epi, smem, wid_u);
  }
}

extern __shared__ __attribute__((aligned(16))) char dyn_smem[];

__global__ void __launch_bounds__(NTHR, 2) mega_kernel(Params p) {
  cg::grid_group grid = cg::this_grid();
  const int wid_u = __builtin_amdgcn_readfirstlane(threadIdx.x >> 6);
  typedef const __attribute__((address_space(4))) Params* KP;
  const KP kp0 = (KP)__builtin_amdgcn_kernarg_segment_ptr();
  volatile LAS unsigned* st = (volatile LAS unsigned*)((LAS char*)dyn_smem + (SMEM_BYTES - 16));
  if (threadIdx.x < 2) st[threadIdx.x] = 0u;
  __syncthreads();
  if (threadIdx.x == 0) (void)xb_add(&((unsigned*)(kp0->ws + OFF_BAR))[XB_XCNT(xb_xcc_id())], 1u);
#pragma unroll 1
  for (int ph = 0; ph < NPHASE; ++ph) {
    KP kp = kp0;
    asm volatile("" : "+s"(kp));
    do_phase(*kp, ph, dyn_smem, wid_u);
#ifdef PROBE_REPEAT
    if (ph == PROBE_REPEAT) { grid.sync(); do_phase(*kp, ph, dyn_smem, wid_u); }
#endif
    if (ph == 0) grid.sync();
    else if (ph + 1 < NPHASE) xcd_barrier(*kp, (volatile LAS unsigned*)((LAS char*)dyn_smem + (SMEM_BYTES - 16)), wid_u);
  }
}

__global__ void __launch_bounds__(NTHR, 2) phase_kernel(Params p, int ph) {
  const int wid_u = __builtin_amdgcn_readfirstlane(threadIdx.x >> 6);
  do_phase(*(const __attribute__((address_space(4))) Params*)__builtin_amdgcn_kernarg_segment_ptr(), ph, dyn_smem, wid_u);
}

extern "C" void kernel_launch(void* const* d_in, const int* in_sizes, int n_in, void* d_out, int out_size, void* d_ws, size_t ws_size,
                              hipStream_t stream) {
  Params p{};
  const float** f = (const float**)&p;
  for (int i = 0; i < 33; ++i) f[i] = (const float*)d_in[i];
  p.out = (float*)d_out;
  p.ws = (char*)d_ws;
  if (WS_NEED > ws_size) { fprintf(stderr, "workspace too small: need %zu have %zu\n", (size_t)WS_NEED, ws_size); return; }

#if ONE_LAUNCH
  static int grid_blocks = 0;
  if (!grid_blocks) {
    int dev = 0, cus = 0, per_cu = 0;
    (void)hipGetDevice(&dev);
    (void)hipDeviceGetAttribute(&cus, hipDeviceAttributeMultiprocessorCount, dev);
    (void)hipFuncSetAttribute((const void*)mega_kernel, hipFuncAttributeMaxDynamicSharedMemorySize, SMEM_BYTES);
    (void)hipOccupancyMaxActiveBlocksPerMultiprocessor(&per_cu, mega_kernel, NTHR, SMEM_BYTES);
    if (per_cu < 1) per_cu = 1;
    grid_blocks = cus * per_cu;
  }
  (void)hipMemsetAsync(p.ws + OFF_BAR, 0, XCD_BAR_WORDS * sizeof(unsigned), stream);
  void* args[] = {&p};
  hipError_t e = hipLaunchCooperativeKernel((const void*)mega_kernel, dim3(grid_blocks), dim3(NTHR), args, SMEM_BYTES, stream);
  if (e != hipSuccess) fprintf(stderr, "cooperative launch failed: %s (grid %d)\n", hipGetErrorString(e), grid_blocks);
#else
  static bool attr = false;
  if (!attr) { (void)hipFuncSetAttribute((const void*)phase_kernel, hipFuncAttributeMaxDynamicSharedMemorySize, SMEM_BYTES); attr = true; }
  for (int ph = 0; ph < NPHASE; ++ph) phase_kernel<<<256, NTHR, SMEM_BYTES, stream>>>(p, ph);
#endif
}
```

```cpp
#include <hip/hip_runtime.h>
#include <hip/hip_cooperative_groups.h>
#include <cstdio>
namespace cg = cooperative_groups;

#ifndef ONE_LAUNCH
#define ONE_LAUNCH 1
#endif

typedef unsigned short bf16_t;
typedef short bf16x8 __attribute__((ext_vector_type(8)));
typedef float f32x4 __attribute__((ext_vector_type(4)));
typedef float f32x2 __attribute__((ext_vector_type(2)));
typedef unsigned u32x2 __attribute__((ext_vector_type(2)));
#define LAS __attribute__((address_space(3)))

constexpr int D = 1024, FF = 2816, NTOK = 98304, NPROMPT = 32768, ZLD = 2560, PINW = 2464;
constexpr int NTHR = 512;
constexpr int SMEM_BYTES = 162320;

struct Params {
  const float *x_prompt, *x_sample, *c_prompt, *c_sample, *ada_w, *ada_b, *n1_pre, *n1_post, *f1_w1, *f1_w3, *f1_w2,
      *nm_pre, *nm_post, *w_in, *shift_mu, *pool_w, *pool_scale, *w0, *w2, *a0, *a2, *g2, *k_k, *k_a, *r_k, *lnx_g, *lnx_b,
      *w_out, *n2_pre, *n2_post, *f2_w1, *f2_w3, *f2_w2;
  float* out;
  char* ws;
};
#define PREF const __attribute__((address_space(4))) Params&
constexpr size_t al256(size_t b) { return (b + 255) & ~(size_t)255; }
constexpr size_t OFF_W13A = 0;
constexpr size_t OFF_W13B = OFF_W13A + al256((size_t)2 * FF * D * 2);
constexpr size_t OFF_W2A = OFF_W13B + al256((size_t)2 * FF * D * 2);
constexpr size_t OFF_W2B = OFF_W2A + al256((size_t)D * FF * 2);
constexpr size_t OFF_WINT = OFF_W2B + al256((size_t)D * FF * 2);
constexpr size_t OFF_WOUTT = OFF_WINT + al256((size_t)ZLD * D * 2);
constexpr size_t OFF_MOD = OFF_WOUTT + al256((size_t)D * D * 2);
constexpr size_t OFF_SBON = OFF_MOD + al256((size_t)16 * 9216 * 4);
constexpr size_t OFF_RH = OFF_SBON + al256((size_t)NTOK * 16 * 4);
constexpr size_t OFF_RY = OFF_RH + al256((size_t)NTOK * D * 2);
constexpr size_t OFF_RU = OFF_RY + al256((size_t)NTOK * D * 2);
constexpr size_t OFF_ALORA = OFF_RU + al256((size_t)NTOK * FF * 2);
constexpr size_t OFF_BAR = OFF_ALORA + al256((size_t)NTOK * 256 * 2);
constexpr size_t WS_NEED = OFF_BAR + 16384;
#define P_W13A ((bf16_t*)(p.ws + OFF_W13A))
#define P_W13B ((bf16_t*)(p.ws + OFF_W13B))
#define P_W2A ((bf16_t*)(p.ws + OFF_W2A))
#define P_W2B ((bf16_t*)(p.ws + OFF_W2B))
#define P_WINT ((bf16_t*)(p.ws + OFF_WINT))
#define P_WOUTT ((bf16_t*)(p.ws + OFF_WOUTT))
#define P_MOD ((float*)(p.ws + OFF_MOD))
#define P_SBON ((float*)(p.ws + OFF_SBON))
#define P_RH ((bf16_t*)(p.ws + OFF_RH))
#define P_RY ((bf16_t*)(p.ws + OFF_RY))
#define P_RU ((bf16_t*)(p.ws + OFF_RU))
#define P_ALORA ((bf16_t*)(p.ws + OFF_ALORA))

typedef __bf16 bf16x2_t __attribute__((ext_vector_type(2)));
__device__ __forceinline__ unsigned cvt_pk_bf16(float lo, float hi) {
  f32x2 v = {lo, hi};
  bf16x2_t b = __builtin_convertvector(v, bf16x2_t);
  return __builtin_bit_cast(unsigned, b);
}
__device__ __forceinline__ float bf_lo(unsigned u) { return __uint_as_float(u << 16); }
__device__ __forceinline__ float bf_hi(unsigned u) { return __uint_as_float(u & 0xffff0000u); }
__device__ __forceinline__ float bf2f(bf16_t b) { return __uint_as_float(((unsigned)b) << 16); }
__device__ __forceinline__ void unpack8(uint4 v, float* o) {
  o[0] = bf_lo(v.x); o[1] = bf_hi(v.x); o[2] = bf_lo(v.y); o[3] = bf_hi(v.y);
  o[4] = bf_lo(v.z); o[5] = bf_hi(v.z); o[6] = bf_lo(v.w); o[7] = bf_hi(v.w);
}
__device__ __forceinline__ uint4 pack8(const float* o) {
  uint4 v; v.x = cvt_pk_bf16(o[0], o[1]); v.y = cvt_pk_bf16(o[2], o[3]); v.z = cvt_pk_bf16(o[4], o[5]); v.w = cvt_pk_bf16(o[6], o[7]);
  return v;
}
__device__ __forceinline__ float sigmoidf_(float x) { return __builtin_amdgcn_rcpf(1.f + __expf(-x)); }
template <int CTRL> __device__ __forceinline__ float dpp_f(float x) {
  return __int_as_float(__builtin_amdgcn_update_dpp(0, __float_as_int(x), CTRL, 0xf, 0xf, false));
}
__device__ __forceinline__ float row16_sum(float x) {
  x += dpp_f<0x128>(x); x += dpp_f<0x124>(x); x += dpp_f<0x122>(x); x += dpp_f<0x121>(x);
  return x;
}
template <class T> __device__ __forceinline__ T sel(bool c, T a, T b) { return c ? a : b; }
__device__ __forceinline__ int opaque_tid_w(int wid) {
  int l;
  asm volatile("v_mbcnt_lo_u32_b32 %0, -1, 0\n\tv_mbcnt_hi_u32_b32 %0, -1, %0" : "=v"(l));
  return wid * 64 + l;
}
#define opaque_tid() opaque_tid_w(wid_u)
__device__ __forceinline__ float wave_sum(float v) {
  v = row16_sum(v);
  const float a = __int_as_float(__builtin_amdgcn_readlane(__float_as_int(v), 0)), b = __int_as_float(__builtin_amdgcn_readlane(__float_as_int(v), 16));
  const float c = __int_as_float(__builtin_amdgcn_readlane(__float_as_int(v), 32)), d = __int_as_float(__builtin_amdgcn_readlane(__float_as_int(v), 48));
  return (a + b) + (c + d);
}
__device__ __forceinline__ float quad_sum(float x) { x += dpp_f<0xB1>(x); x += dpp_f<0x4E>(x); return x; }
__device__ __forceinline__ int seq_start(int s) { return s < 8 ? s * 4096 : NPROMPT + (s - 8) * 8192; }
__device__ __forceinline__ void row_seq(int row, int& s, int& t, int& T) {
  if (row < NPROMPT) { s = row >> 12; t = row & 4095; T = 4096; }
  else { int r = row - NPROMPT; s = 8 + (r >> 13); t = r & 8191; T = 8192; }
}

__device__ __forceinline__ void tr_tile(const float* __restrict__ src, int ldsrc, int k0, int n0, int nvalid, bf16_t* __restrict__ dst, int ldd,
                        int kdst0, int mode, float* sm, const int tid) {
#pragma unroll
  for (int i = 0; i < 2; ++i) {
    const int r = (tid >> 4) + 32 * i, c = (tid & 15) * 4;
    float4 v = make_float4(0.f, 0.f, 0.f, 0.f);
    if (n0 + c < nvalid) v = *(const float4*)(src + (size_t)(k0 + r) * ldsrc + n0 + c);
    float* d = sm + r * 65 + c;
    d[0] = v.x; d[1] = v.y; d[2] = v.z; d[3] = v.w;
  }
  __syncthreads();
  {
    const int n = tid >> 3, kc = (tid & 7) * 8;
    float o[8];
#pragma unroll
    for (int j = 0; j < 8; ++j) o[j] = sm[(kc + j) * 65 + n];
    int nn = n0 + n, drow;
    const int c32 = nn & 31, slot = 16 * ((c32 >> 2) & 1) + 4 * (c32 >> 3) + (c32 & 3);
    if (mode == 0) drow = (nn & ~31) + slot;
    else drow = 256 * (nn >> 7) + (mode == 2 ? 128 : 0) + ((nn & 127) & ~31) + slot;
    *(uint4*)(dst + (size_t)drow * ldd + kdst0 + k0 + kc) = pack8(o);
  }
  __syncthreads();
}

__device__ __forceinline__ void prep_phase(PREF p, char* smem, const int wid_u) {
  float* sm = (float*)smem;
  const int tid = opaque_tid();
  constexpr int N_MOD = 144, N_EFF = 128, N_W13 = 4 * 704, N_W2 = 2 * 704, N_WIN = 640, N_WOUT = 128;
  constexpr int TOTAL = N_MOD + N_EFF + N_W13 + N_W2 + N_WIN + N_WOUT;
  for (int item = blockIdx.x; item < TOTAL; item += gridDim.x) {
    int it = item;
    if (it < N_MOD) {
      const int j0 = it * 64;
      float* sc = sm;
      float* red = sm + 16384;
      for (int idx = tid; idx < 16384; idx += NTHR) {
        const int s = idx >> 10, k = idx & 1023;
        const float* cp_ = p.c_prompt; const float* cs_ = p.c_sample;
        const float c = s < 8 ? cp_[s * 1024 + k] : cs_[(s - 8) * 1024 + k];
        sc[idx] = c / (1.f + __expf(-c));
      }
      __syncthreads();
      const int col = tid & 63, kg = tid >> 6;
      float acc[16];
#pragma unroll
      for (int s = 0; s < 16; ++s) acc[s] = 0.f;
      for (int k = kg * 128; k < kg * 128 + 128; ++k) {
        const float w = p.ada_w[(size_t)k * 9216 + j0 + col];
#pragma unroll
        for (int s = 0; s < 16; ++s) acc[s] += sc[s * 1024 + k] * w;
      }
#pragma unroll
      for (int s = 0; s < 16; ++s) red[(kg * 16 + s) * 64 + col] = acc[s];
      __syncthreads();
      for (int o = tid; o < 1024; o += NTHR) {
        const int s = o >> 6, c2 = o & 63;
        float v = p.ada_b[j0 + c2];
#pragma unroll
        for (int g = 0; g < 8; ++g) v += red[(g * 16 + s) * 64 + c2];
        P_MOD[s * 9216 + j0 + c2] = v;
      }
      __syncthreads();
      continue;
    }
    it -= N_MOD;
    if (it < N_EFF) {
      const int g = it >> 5, itile = (it >> 4) & 1, ntile = it & 15;
      float* As = sm;
      float* Bs = sm + 64 * 129;
      for (int idx = tid; idx < 64 * 128; idx += NTHR) {
        const int i = idx >> 7, j = idx & 127;
        As[i * 129 + j] = p.pool_w[((size_t)g * 128 + itile * 64 + i) * 128 + j] * p.pool_scale[g * 128 + j];
      }
      for (int idx = tid; idx < 128 * 64; idx += NTHR) {
        const int j = idx >> 6, nn = idx & 63;
        Bs[j * 65 + nn] = p.w_out[(size_t)(g * 128 + j) * 1024 + ntile * 64 + nn];
      }
      __syncthreads();
      const int i = tid >> 3, nn0 = (tid & 7) * 8;
      float acc[8];
#pragma unroll
      for (int q = 0; q < 8; ++q) acc[q] = 0.f;
      for (int j = 0; j < 128; ++j) {
        const float a = As[i * 129 + j];
#pragma unroll
        for (int q = 0; q < 8; ++q) acc[q] += a * Bs[j * 65 + nn0 + q];
      }
#pragma unroll
      for (int q = 0; q < 8; ++q)
      {
        const int nn = ntile * 64 + nn0 + q, c32 = nn & 31, slot = 16 * ((c32 >> 2) & 1) + 4 * (c32 >> 3) + (c32 & 3);
        P_WOUTT[(size_t)((nn & ~31) + slot) * 1024 + g * 128 + itile * 64 + i] = (bf16_t)(cvt_pk_bf16(acc[q], 0.f) & 0xffff);
      }
      __syncthreads();
      continue;
    }
    it -= N_EFF;
    if (it < N_W13) {
      const int which = it / 704, r = it % 704;
      const int kt = r / 44, ntl = r % 44;
      const float* src = sel(which < 2, sel(which == 0, p.f1_w1, p.f1_w3), sel(which == 2, p.f2_w1, p.f2_w3));
      bf16_t* dst = sel(which < 2, P_W13A, P_W13B);
      tr_tile(src, FF, kt * 64, ntl * 64, FF, dst, D, 0, (which & 1) ? 2 : 1, sm, tid);
      continue;
    }
    it -= N_W13;
    if (it < N_W2) {
      const int which = it / 704, r = it % 704;
      const int kt = r / 16, ntl = r % 16;
      tr_tile(sel(which != 0, p.f2_w2, p.f1_w2), D, kt * 64, ntl * 64, D, sel(which != 0, P_W2B, P_W2A), FF, 0, 0, sm, tid);
      continue;
    }
    it -= N_W2;
    if (it < N_WIN) {
      const int kt = it / 40, ntl = it % 40;
      tr_tile(p.w_in, PINW, kt * 64, ntl * 64, PINW, P_WINT, D, 0, 0, sm, tid);
      continue;
    }
    it -= N_WIN;
    {
      const int kt = it / 16, ntl = it % 16;
      tr_tile(p.w_out + (size_t)512 * 1024, D, kt * 64, ntl * 64, D, P_WOUTT, D, 512, 0, sm, tid);
    }
  }
}

template <int MODE>
__device__ __forceinline__ void row_phase(const float* __restrict__ xp, const float* __restrict__ xs, float* __restrict__ xout,
                          const bf16_t* __restrict__ y, bf16_t* __restrict__ h, const float* __restrict__ mod,
                          const float* __restrict__ npost, const float* __restrict__ npre, int gate_idx, float cgate, int shift_idx, const int wid_u,
                          const bool xin_bf = false) {
  const int tid_ = opaque_tid();
  const int lane = tid_ & 63;
  const int gw = blockIdx.x * 8 + (tid_ >> 6), GW = gridDim.x * 8;
  for (int chunk = gw; chunk < NTOK / 16; chunk += GW) {
    const int row0 = chunk * 16;
    int s, t, T;
    row_seq(row0, s, t, T);
    const float* md = mod + s * 9216;
    f32x4 Am[4], Bm[4], Gm[4];
#pragma unroll
    for (int i = 0; i < 4; ++i) {
      const int c = i * 256 + lane * 4;
      if (MODE != 2) {
        f32x4 np = *(const f32x4*)(npre + c), sc = *(const f32x4*)(md + (shift_idx + 1) * 1024 + c);
        Am[i] = np * (sc + 1.f);
        Bm[i] = *(const f32x4*)(md + shift_idx * 1024 + c);
      }
      if (MODE != 0) {
        f32x4 g = *(const f32x4*)(md + gate_idx * 1024 + c), po = *(const f32x4*)(npost + c);
        Gm[i] = g * po * cgate;
      }
    }
    for (int r = 0; r < 16; ++r) {
      const int row = row0 + r;
      const float* xr = (row < NPROMPT) ? xp + (size_t)row * D : xs + (size_t)(row - NPROMPT) * D;
      f32x4 xv[4];
      if (MODE != 0 && xin_bf) {
        const bf16_t* xb = (const bf16_t*)(xout + (size_t)row * D) + 1024;
#pragma unroll
        for (int i = 0; i < 4; ++i) {
          const u32x2 u = __builtin_nontemporal_load((const u32x2*)(xb + i * 256 + lane * 4));
          xv[i] = (f32x4){bf_lo(u.x), bf_hi(u.x), bf_lo(u.y), bf_hi(u.y)};
        }
      } else {
#pragma unroll
        for (int i = 0; i < 4; ++i) xv[i] = __builtin_nontemporal_load((const f32x4*)(xr + i * 256 + lane * 4));
      }
      if (MODE != 0) {
        f32x4 yv[4];
        float ss = 0.f;
#pragma unroll
        for (int i = 0; i < 4; ++i) {
          const u32x2 u = __builtin_nontemporal_load((const u32x2*)(y + (size_t)row * D + i * 256 + lane * 4));
          yv[i] = (f32x4){bf_lo(u.x), bf_hi(u.x), bf_lo(u.y), bf_hi(u.y)};
          ss += yv[i][0] * yv[i][0] + yv[i][1] * yv[i][1] + yv[i][2] * yv[i][2] + yv[i][3] * yv[i][3];
        }
        ss = wave_sum(ss);
        const float rs = rsqrtf(ss * (1.f / 1024.f) + 1e-6f);
#pragma unroll
        for (int i = 0; i < 4; ++i) {
          xv[i] = xv[i] + Gm[i] * yv[i] * rs;
          if (MODE == 2) __builtin_nontemporal_store(xv[i], (f32x4*)(xout + (size_t)row * D + i * 256 + lane * 4));
          else {
            uint2 u; u.x = cvt_pk_bf16(xv[i][0], xv[i][1]); u.y = cvt_pk_bf16(xv[i][2], xv[i][3]);
            *(uint2*)((bf16_t*)(xout + (size_t)row * D) + 1024 + i * 256 + lane * 4) = u;
          }
        }
      }
      if (MODE != 2) {
        float ss = 0.f;
#pragma unroll
        for (int i = 0; i < 4; ++i) ss += xv[i][0] * xv[i][0] + xv[i][1] * xv[i][1] + xv[i][2] * xv[i][2] + xv[i][3] * xv[i][3];
        ss = wave_sum(ss);
        const float rs = rsqrtf(ss * (1.f / 1024.f) + 1e-6f);
#pragma unroll
        for (int i = 0; i < 4; ++i) {
          f32x4 hv = xv[i] * rs * Am[i] + Bm[i];
          uint2 u; u.x = cvt_pk_bf16(hv[0], hv[1]); u.y = cvt_pk_bf16(hv[2], hv[3]);
          *(uint2*)(h + (size_t)row * D + i * 256 + lane * 4) = u;
        }
      }
    }
  }
}

constexpr int BM = 256, BK = 64, HALF = 128, NXCD = 8, WGM = 4, HT = HALF * BK;
__device__ __forceinline__ int lds_byte(int r, int c) {
  int st = (r >> 4) * 2 + (c >> 5), rr = r & 15, cc = c & 31, ob = rr * 64 + cc * 2;
  return st * 1024 + (ob ^ (((ob >> 9) & 1) << 5));
}
__device__ __forceinline__ void stage_rc(int b, int& R, int& C) {
  int st = b / 1024, sb = b % 1024, swz = sb ^ (((sb >> 9) & 1) << 5);
  R = (st >> 1) * 16 + swz / 64; C = (st & 1) * 32 + (swz % 64) / 2;
}

__device__ __forceinline__ bool gemm_unit(int i, int nM, int nN, int nwg, int& pm, int& pn) {
  const long L = (long)i * gridDim.x + blockIdx.x;
  if (L >= nwg) return false;
  int wgid = (int)L;
  { int q = nwg / NXCD, r = nwg % NXCD, xcd = wgid % NXCD, off = wgid / NXCD;
    wgid = (xcd < r ? xcd * (q + 1) : r * (q + 1) + (xcd - r) * q) + off; }
  const int nig = WGM * nN, gid = wgid / nig, fm = gid * WGM, gsz = min(nM - fm, WGM);
  pm = fm + ((wgid % nig) % gsz); pn = (wgid % nig) / gsz;
  return true;
}

__device__ __forceinline__ void gemm_phase(const bf16_t* __restrict__ A, const bf16_t* __restrict__ Bt, bf16_t* __restrict__ C, int M, int N, int K,
                                           int ldc, const int EPI, char* smem, const int wid_u) {
  const int nM = M / BM, nN = N / BM, nwg = nM * nN;
  const int tid = opaque_tid();
  LAS bf16_t* shm = (LAS bf16_t*)smem;
#define SA(b, h) (shm + ((b) * 2 + (h)) * HT)
#define SB(b, h) (shm + (4 + (b) * 2 + (h)) * HT)
#define STG(P, GB) do { const char* _gb = (GB); \
    _Pragma("unroll") for (int _i = 0; _i < 2; ++_i) { \
      __builtin_amdgcn_global_load_lds((const unsigned*)(_gb + voff[_i]), \
        (LAS unsigned*)((LAS char*)(P) + ldsw + _i * 8192), 16, 0, 0); } } while (0)
#define LDA(dst, b, h) _Pragma("unroll") for (int m = 0; m < 4; ++m) _Pragma("unroll") for (int k = 0; k < 2; ++k) \
    dst[m][k] = *(const LAS bf16x8*)((LAS char*)SA(b, h) + aoff + m * 2048 + k * 1024)
#define LDB(dst, b, h) _Pragma("unroll") for (int n = 0; n < 2; ++n) _Pragma("unroll") for (int k = 0; k < 2; ++k) \
    dst[n][k] = *(const LAS bf16x8*)((LAS char*)SB(b, h) + boff + n * 2048 + k * 1024)
#define MMA(ai, bj, At_, Bt_) do { __builtin_amdgcn_s_setprio(1); \
    _Pragma("unroll") for (int m = 0; m < 4; ++m) _Pragma("unroll") for (int n = 0; n < 2; ++n) _Pragma("unroll") for (int k = 0; k < 2; ++k) \
      acc[ai][bj][m][n] = __builtin_amdgcn_mfma_f32_16x16x32_bf16(Bt_[n][k], At_[m][k], acc[ai][bj][m][n], 0, 0, 0); \
    __builtin_amdgcn_s_setprio(0); } while (0)
#define WAIT_V(n) asm volatile("s_waitcnt vmcnt(" #n ")" ::: "memory")
#define WAIT_L(n) asm volatile("s_waitcnt lgkmcnt(" #n ")" ::: "memory")
#define BAR __builtin_amdgcn_s_barrier()
#define SCHED __builtin_amdgcn_sched_barrier(0)
  const int wid = __builtin_amdgcn_readfirstlane(tid >> 6), lane = tid & 63, wr = wid >> 2, wc = wid & 3, fr = lane & 15, fq = lane >> 4;
  const int aoff = lds_byte(wr * 64 + fr, fq * 8), boff = lds_byte(wc * 32 + fr, fq * 8);
  unsigned voff[2];
  const int ldsw = wid * 1024;
#pragma unroll
  for (int _i = 0; _i < 2; ++_i) { int _r, _c; stage_rc(tid * 16 + _i * 8192, _r, _c); voff[_i] = (unsigned)(_r * K + _c) * 2u; }
  const int nt = K / BK;
  const size_t kstep = (size_t)BK * 2, hstep = (size_t)HALF * K * 2, tstep = 2 * hstep;
  int pm, pn, npm = 0, npn = 0, ui = 0;
  if (!gemm_unit(0, nM, nN, nwg, pm, pn)) return;
  f32x4 acc[2][2][4][2];
#pragma unroll
  for (int a = 0; a < 2; ++a)
#pragma unroll
    for (int b = 0; b < 2; ++b)
#pragma unroll
      for (int m = 0; m < 4; ++m)
#pragma unroll
        for (int n = 0; n < 2; ++n) acc[a][b][m][n] = (f32x4){0.f, 0.f, 0.f, 0.f};
  bf16x8 At[4][2], B0[2][2], B1[2][2];
  const char* cA = (const char*)A + (size_t)pm * tstep;
  const char* cB = (const char*)Bt + (size_t)pn * tstep;
  STG(SB(0, 0), cB); STG(SA(0, 0), cA); STG(SB(0, 1), cB + hstep); STG(SA(0, 1), cA + hstep);
  if (wr == 1) BAR;
  WAIT_V(4); BAR;
  STG(SB(1, 0), cB + kstep); STG(SA(1, 0), cA + kstep); STG(SB(1, 1), cB + hstep + kstep);
  WAIT_V(6); BAR;
  for (;;) {
    const bool has_next = gemm_unit(ui + 1, nM, nN, nwg, npm, npn);
    const char* nA = has_next ? (const char*)A + (size_t)npm * tstep : cA;
    const char* nB = has_next ? (const char*)Bt + (size_t)npn * tstep : cB;
    for (int t = 0; t < nt; t += 2) {
      const bool last = (t == nt - 2);
      const char* a1 = cA + (size_t)(t + 1) * kstep;
      const char* a2 = last ? nA : cA + (size_t)(t + 2) * kstep;
      const char* b2 = last ? nB : cB + (size_t)(t + 2) * kstep;
      const char* a3 = a2 + kstep;
      const char* b3 = b2 + kstep;
      LDB(B0, 0, 0); SCHED; LDA(At, 0, 0); STG(SA(1, 1), a1 + hstep);
      WAIT_L(8); BAR; WAIT_L(0); MMA(0, 0, At, B0); BAR; SCHED;
      LDB(B1, 0, 1); STG(SB(0, 0), b2);
      BAR; WAIT_L(0); MMA(0, 1, At, B1); BAR;
      LDA(At, 0, 1); STG(SA(0, 0), a2);
      BAR; WAIT_L(0); MMA(1, 0, At, B0); BAR; SCHED;
      STG(SB(0, 1), b2 + hstep);
      WAIT_V(6); BAR; MMA(1, 1, At, B1); BAR;
      LDB(B0, 1, 0); SCHED; LDA(At, 1, 0); STG(SA(0, 1), a2 + hstep);
      WAIT_L(8); BAR; WAIT_L(0); MMA(0, 0, At, B0); BAR; SCHED;
      LDB(B1, 1, 1); STG(SB(1, 0), b3);
      BAR; WAIT_L(0); MMA(0, 1, At, B1); BAR;
      LDA(At, 1, 1); STG(SA(1, 0), a3);
      BAR; WAIT_L(0); MMA(1, 0, At, B0); BAR; SCHED;
      STG(SB(1, 1), b3 + hstep);
      WAIT_V(6); BAR; MMA(1, 1, At, B1); BAR;
    }
    {
      const int brow = pm * BM, bcol = pn * BM;
#pragma unroll
      for (int ai = 0; ai < 2; ++ai)
#pragma unroll
        for (int m = 0; m < 4; ++m) {
          const size_t row = (size_t)(brow + ai * HALF + wr * 64 + m * 16 + fr);
          if (EPI == 0) {
#pragma unroll
            for (int bj = 0; bj < 2; ++bj) {
              const f32x4 v0 = acc[ai][bj][m][0], v1 = acc[ai][bj][m][1];
              uint4 u; u.x = cvt_pk_bf16(v0[0], v0[1]); u.y = cvt_pk_bf16(v0[2], v0[3]); u.z = cvt_pk_bf16(v1[0], v1[1]); u.w = cvt_pk_bf16(v1[2], v1[3]);
              *(uint4*)(C + row * ldc + bcol + bj * HALF + wc * 32 + fq * 8) = u;
            }
          } else {
            float o[8];
#pragma unroll
            for (int n = 0; n < 2; ++n) {
              const f32x4 a = acc[ai][0][m][n], b = acc[ai][1][m][n];
#pragma unroll
              for (int j = 0; j < 4; ++j) o[n * 4 + j] = a[j] * __builtin_amdgcn_rcpf(1.f + __expf(-a[j])) * b[j];
            }
            *(uint4*)(C + row * ldc + (bcol >> 1) + wc * 32 + fq * 8) = pack8(o);
          }
        }
    }
    if (!has_next) break;
#pragma unroll
    for (int a = 0; a < 2; ++a)
#pragma unroll
      for (int b = 0; b < 2; ++b)
#pragma unroll
        for (int m = 0; m < 4; ++m)
#pragma unroll
          for (int n = 0; n < 2; ++n) acc[a][b][m][n] = (f32x4){0.f, 0.f, 0.f, 0.f};
    pm = npm; pn = npn; cA = nA; cB = nB; ++ui;
  }
  WAIT_V(0);
  if (wr == 0) BAR;
  BAR;
#undef SA
#undef SB
#undef STG
#undef LDA
#undef LDB
#undef MMA
}

__device__ __forceinline__ void load_shift16(const bf16_t* __restrict__ z, int row, int t, int T, int col, const float* __restrict__ mu, float* o) {
  const bf16_t* pz = z + (size_t)row * ZLD + col;
  uint4 c0 = *(const uint4*)pz, c1 = *(const uint4*)(pz + 8);
  uint4 p0 = make_uint4(0, 0, 0, 0), p1 = p0, n0 = p0, n1 = p0;
  if (t > 0) { p0 = *(const uint4*)(pz - ZLD); p1 = *(const uint4*)(pz - ZLD + 8); }
  if (t < T - 1) { n0 = *(const uint4*)(pz + ZLD); n1 = *(const uint4*)(pz + ZLD + 8); }
  float c[16], pv[16], nx[16];
  unpack8(c0, c); unpack8(c1, c + 8); unpack8(p0, pv); unpack8(p1, pv + 8); unpack8(n0, nx); unpack8(n1, nx + 8);
#pragma unroll
  for (int q = 0; q < 16; ++q) o[q] = c[q] + (0.5f * (pv[q] + nx[q]) - c[q]) * mu[col - 512 + q];
}
__device__ __forceinline__ void load_shift8(const bf16_t* __restrict__ z, int row, int t, int T, int col, const float* __restrict__ mu, float* o) {
  const bf16_t* pz = z + (size_t)row * ZLD + col;
  uint4 c0 = *(const uint4*)pz;
  uint4 p0 = make_uint4(0, 0, 0, 0), n0 = p0;
  if (t > 0) p0 = *(const uint4*)(pz - ZLD);
  if (t < T - 1) n0 = *(const uint4*)(pz + ZLD);
  float c[8], pv[8], nx[8];
  unpack8(c0, c); unpack8(p0, pv); unpack8(n0, nx);
#pragma unroll
  for (int q = 0; q < 8; ++q) o[q] = c[q] + (0.5f * (pv[q] + nx[q]) - c[q]) * mu[col - 512 + q];
}

constexpr int TC = 32;
constexpr int SV = TC * 64;
__device__ __forceinline__ void lora_prep_phase(PREF p, const int wid_u) {
  const int tid = opaque_tid();
  const bf16_t* z = P_RU;
  bf16_t* al = P_ALORA;
  const float* mu = p.shift_mu;
  for (int task = blockIdx.x * NTHR + tid; task < NTOK * 32; task += gridDim.x * NTHR) {
    const int row = task >> 5, oc = task & 31;
    int s, t, T;
    row_seq(row, s, t, T);
    float o[8];
    load_shift8(z, row, t, T, 2048 + oc * 8, mu, o);
    if (oc < 16) {
#pragma unroll
      for (int q = 0; q < 8; ++q) { const float e = __expf(2.f * o[q]); o[q] = 1.f - 2.f * __builtin_amdgcn_rcpf(e + 1.f); }
    }
    *(uint4*)(al + (size_t)row * 256 + oc * 8) = pack8(o);
  }
}

template <int HALF>
__device__ __forceinline__ void pool_seg(const bf16_t* __restrict__ z, bf16_t* __restrict__ mo, int row_base, int tbase, int T, int c0) {
  constexpr int NR = 2 * HALF + 3;
  float acc[4][8], zc[4][8];
#pragma unroll
  for (int i = 0; i < 4; ++i)
#pragma unroll
    for (int q = 0; q < 8; ++q) { acc[i][q] = 0.f; zc[i][q] = 0.f; }
#pragma unroll
  for (int r = 0; r < NR; ++r) {
    const int tt = tbase - HALF + r;
    uint4 u = make_uint4(0, 0, 0, 0);
    if (tt >= 0 && tt < T) u = *(const uint4*)(z + (size_t)(row_base - HALF + r) * ZLD + c0);
    float v[8];
    unpack8(u, v);
#pragma unroll
    for (int i = 0; i < 4; ++i) {
      if (r >= i && r < i + 2 * HALF) {
#pragma unroll
        for (int q = 0; q < 8; ++q) acc[i][q] += v[q];
      }
      if (r == HALF + i) {
#pragma unroll
        for (int q = 0; q < 8; ++q) zc[i][q] = v[q];
      }
    }
  }
#pragma unroll
  for (int i = 0; i < 4; ++i) {
    const int ti = tbase + i;
    const float ic = 1.f / (float)(min(ti + HALF, T) - max(ti - HALF, 0));
    float o[8];
#pragma unroll
    for (int q = 0; q < 8; ++q) o[q] = acc[i][q] * ic - zc[i][q];
    *(uint4*)(mo + (size_t)(row_base + i) * D + c0) = pack8(o);
  }
}
__device__ __forceinline__ void pool_tile(const bf16_t* __restrict__ z, bf16_t* __restrict__ mo, int tile, int tid) {
  const int row0 = tile * 32;
  int s, t0, T;
  row_seq(row0, s, t0, T);
  const int oc = tid >> 3, seg = tid & 7, c0 = oc * 8, grp = __builtin_amdgcn_readfirstlane(oc >> 4);
  const int rb = row0 + seg * 4, tb = t0 + seg * 4;
  if (grp == 0) pool_seg<1>(z, mo, rb, tb, T, c0);
  else if (grp == 1) pool_seg<2>(z, mo, rb, tb, T, c0);
  else if (grp == 2) pool_seg<4>(z, mo, rb, tb, T, c0);
  else pool_seg<8>(z, mo, rb, tb, T, c0);
}

struct Raw16 { uint4 c0, c1, p0, p1, n0, n1; };
__device__ __forceinline__ void load_raw16(Raw16& r, const bf16_t* __restrict__ z, int row, int t, int T, int col) {
  const bf16_t* pz = z + (unsigned)(row * ZLD + col);
  r.c0 = *(const uint4*)pz; r.c1 = *(const uint4*)(pz + 8);
  r.p0 = make_uint4(0, 0, 0, 0); r.p1 = r.p0; r.n0 = r.p0; r.n1 = r.p0;
  if (t > 0) { r.p0 = *(const uint4*)(pz - ZLD); r.p1 = *(const uint4*)(pz - ZLD + 8); }
  if (t < T - 1) { r.n0 = *(const uint4*)(pz + ZLD); r.n1 = *(const uint4*)(pz + ZLD + 8); }
}
__device__ __forceinline__ void shift16(const Raw16& r, const float* c1, const float* c2, float* o) {
  float c[16], pv[16], nx[16];
  unpack8(r.c0, c); unpack8(r.c1, c + 8); unpack8(r.p0, pv); unpack8(r.p1, pv + 8); unpack8(r.n0, nx); unpack8(r.n1, nx + 8);
#pragma unroll
  for (int q = 0; q < 16; ++q) o[q] = c[q] * c1[q] + (pv[q] + nx[q]) * c2[q];
}
__device__ __forceinline__ bf16x8 ldfrag(const bf16_t* base, int stride, int row0, int k0, int fr, int fq) {
  return *reinterpret_cast<const bf16x8*>(base + (row0 + fr) * stride + k0 + fq * 8);
}
__device__ __forceinline__ uint2 pack4(f32x4 v) { uint2 u; u.x = cvt_pk_bf16(v[0], v[1]); u.y = cvt_pk_bf16(v[2], v[3]); return u; }
#define MFMA16(a, b, c) __builtin_amdgcn_mfma_f32_16x16x32_bf16(a, b, c, 0, 0, 0)

constexpr int CS_NAB = 0, CS_NAK = 4096, CS_NBRT = 8192, CS_NKRT = 10752, CS_QT = 13312, CS_W = 15872, CS_Z = 20992, CS_GT = 26112,
              CS_RYT = 35328, CS_VN = 39936;
constexpr int CS_AT = 49152, CS_RT = CS_AT + 4608, CS_BT = CS_RT + 4608, CS_KT = CS_BT + 4608, CS_BB = 67584, CS_KB = CS_BB + 5120,
              CS_VT = CS_KB + 5120, CS_ATT = 82944, CS_PL = 92160, CS_SBF = 92416, CS_PRIV = 110848, CS_CST = 143616, CS_BL = 145920;

__device__ __forceinline__ void lds_barrier() {
  asm volatile("s_waitcnt lgkmcnt(0)" ::: "memory");
  __builtin_amdgcn_s_barrier();
  asm volatile("" ::: "memory");
}
template <int Q> __device__ __forceinline__ float quad_bcast(float x) { return dpp_f<Q * 0x55>(x); }

template <int S0> __device__ __forceinline__ void solve_steps(float (&x)[8], const float* nab, int seg) {
  if constexpr (S0 < 32) {
    const float xs = quad_bcast<(S0 >> 3)>(x[S0 & 7]);
    const f32x4 n0 = *(const f32x4*)(nab + S0 * 32 + seg * 8), n1 = *(const f32x4*)(nab + S0 * 32 + seg * 8 + 4);
    x[0] += xs * n0[0]; x[1] += xs * n0[1]; x[2] += xs * n0[2]; x[3] += xs * n0[3];
    x[4] += xs * n1[0]; x[5] += xs * n1[1]; x[6] += xs * n1[2]; x[7] += xs * n1[3];
    solve_steps<S0 + 1>(x, nab, seg);
  }
}

template <int S0> __device__ __forceinline__ void solve16(float (&x)[8], const float* nb) {
  if constexpr (S0 < 16) {
    const float xs = (S0 >> 3) ? dpp_f<0xF5>(x[S0 & 7]) : dpp_f<0xA0>(x[S0 & 7]);
    const f32x4 n0 = *(const f32x4*)(nb + S0 * 32), n1 = *(const f32x4*)(nb + S0 * 32 + 4);
    x[0] += xs * n0[0]; x[1] += xs * n0[1]; x[2] += xs * n0[2]; x[3] += xs * n0[3];
    x[4] += xs * n1[0]; x[5] += xs * n1[1]; x[6] += xs * n1[2]; x[7] += xs * n1[3];
    solve16<S0 + 1>(x, nb);
  }
}

__device__ __forceinline__ void scan_phase(PREF p, char* smem, const int wid_u) {
  float* stepbuf = (float*)smem;
  float* Nab = (float*)(smem + CS_NAB);
  bf16_t* NakT = (bf16_t*)(smem + CS_NAK);
  bf16_t* VNb = (bf16_t*)(smem + CS_VN);
  bf16_t* T11b = (bf16_t*)(smem + CS_VN + 5120);
  bf16_t* M1T = (bf16_t*)(smem + CS_VN + 5120 + 1280);
  bf16_t* NbrT = (bf16_t*)(smem + CS_NBRT);
  bf16_t* NkrT = (bf16_t*)(smem + CS_NKRT);
  bf16_t* TT = (bf16_t*)(smem + CS_QT);
  bf16_t* Wb = (bf16_t*)(smem + CS_W);
  bf16_t* Zb = (bf16_t*)(smem + CS_Z);
  bf16_t* GT = (bf16_t*)(smem + CS_GT);
  bf16_t* RyT = (bf16_t*)(smem + CS_RYT);
  bf16_t* At = (bf16_t*)(smem + CS_AT);
  bf16_t* Rt = (bf16_t*)(smem + CS_RT);
  bf16_t* Bt = (bf16_t*)(smem + CS_BT);
  bf16_t* Kt = (bf16_t*)(smem + CS_KT);
  bf16_t* Bb = (bf16_t*)(smem + CS_BB);
  bf16_t* Kb = (bf16_t*)(smem + CS_KB);
  bf16_t* VT = (bf16_t*)(smem + CS_VT);
  bf16_t* AtTb = (bf16_t*)(smem + CS_ATT);
  float* PLs = (float*)(smem + CS_PL);
  bf16_t* Sbf = (bf16_t*)(smem + CS_SBF);
  float* cst = (float*)(smem + CS_CST);
  const bf16_t* z = P_RU;
  const int tid = opaque_tid();
  const int wave = __builtin_amdgcn_readfirstlane(tid >> 6), lane = tid & 63, fr = lane & 15, fq = lane >> 4;
  const int item = blockIdx.x;
  if (item < 256) {
    const int s = item < 128 ? 8 + (item >> 4) : ((item - 128) >> 4);
    const int h = (item & 15) >> 1, d = item & 1;
    const int T = s < 8 ? 4096 : 8192, r0seq = seq_start(s), nch = T / 32;
    bf16_t* yout = P_RY + (size_t)d * NTOK * 512;
    {
      const int g = tid >> 6, k = tid & 63;
      const float muk = p.shift_mu[1024 - 512 + h * 64 + k], mur = p.shift_mu[512 - 512 + h * 64 + k], muv = p.shift_mu[1536 - 512 + h * 64 + k];
      float v;
      if (g == 0) v = 0.5f * muk;
      else if (g == 1) v = 0.5f * mur;
      else if (g == 2) v = 1.f - muk;
      else if (g == 3) v = 1.f - mur;
      else if (g == 4) v = 1.f - muv;
      else if (g == 5) v = p.k_k[h * 64 + k];
      else if (g == 6) v = p.k_a[h * 64 + k];
      else v = p.r_k[h * 64 + k];
      cst[g * 64 + k] = v;
      if (g == 0) cst[8 * 64 + k] = 0.5f * muv;
      for (int i = tid; i < 2 * 64 * 72 / 2; i += NTHR) ((unsigned*)Sbf)[i] = 0u;
    }
    const int role = wave >> 1, th = wave & 1;
    const int tl = lane >> 2, cq = lane & 3;
    float* tmpa = (float*)(smem + CS_PRIV + (wave & 3) * 8192 + 2560);
    uint4* Blds = (uint4*)(smem + CS_BL) + (role & 1) * 512;
    float bias[4] = {0.f, 0.f, 0.f, 0.f};
    if (role < 2) {
      const float* lsrc = sel(role != 0, p.a2, p.w2) + (size_t)d * 64 * 512 + h * 64;
      if (th == 0) {
#pragma unroll
        for (int nt = 0; nt < 4; ++nt)
#pragma unroll
          for (int ks = 0; ks < 2; ++ks) {
            float o[8];
#pragma unroll
            for (int q = 0; q < 8; ++q) o[q] = lsrc[(size_t)(ks * 32 + fq * 8 + q) * 512 + nt * 16 + fr];
            Blds[(nt * 2 + ks) * 64 + lane] = pack8(o);
          }
      }
#pragma unroll
      for (int nt = 0; nt < 4; ++nt) bias[nt] = sel(role != 0, p.a0, p.w0)[d * 512 + h * 64 + nt * 16 + fr];
    }
    const int colA = 512 + h * 64 + cq * 16;
    const int colB = (role == 1 ? 1024 : 1536) + h * 64 + cq * 16;
    const int alo = (role == 0 ? d * 64 : 128 + d * 64) + fq * 8;
    Raw16 ra, rb;
    {
      const int j = th * 16 + tl, t = d ? T - 1 - j : j, row = r0seq + t;
      if (role == 2) load_raw16(ra, z, row, t, T, colA);
      if (role == 1 || role == 2) load_raw16(rb, z, row, t, T, colB);
      if (role < 2) {
        const int j2 = th * 16 + fr, t2 = d ? T - 1 - j2 : j2;
        const bf16_t* ap = P_ALORA + (unsigned)((r0seq + t2) * 256 + alo);
        ra.c0 = *(const uint4*)ap; ra.c1 = *(const uint4*)(ap + 32);
      }
    }
    f32x4 Sa = {0.f, 0.f, 0.f, 0.f}, Sb = Sa;
    uint2 y_def = make_uint2(0u, 0u);
    float sb_def = 0.f;
    const int mt = wave >> 1, hn = wave & 1, nt0 = 2 * hn, nt1 = 2 * hn + 1;
    __syncthreads();

    for (int c = 0; c < nch; ++c) {
      if (role < 3) {
        const int j = th * 16 + tl;
        const int istep = c * 32 + j;
        const int t = d ? T - 1 - istep : istep;
        const int row = r0seq + t;
        float v16[16];
        if (role < 2) {
          f32x4 acc[4] = {};
#pragma unroll
          for (int ks = 0; ks < 2; ++ks) {
            const uint4 au = ks == 0 ? ra.c0 : ra.c1;
            const bf16x8 a = *reinterpret_cast<const bf16x8*>(&au);
#pragma unroll
            for (int nt = 0; nt < 4; ++nt) { const uint4 bu = Blds[(nt * 2 + ks) * 64 + lane]; acc[nt] = MFMA16(a, *reinterpret_cast<const bf16x8*>(&bu), acc[nt]); }
          }
          if (role == 0) {
#pragma unroll
            for (int nt = 0; nt < 4; ++nt)
#pragma unroll
              for (int jj = 0; jj < 4; ++jj) {
                const float sg = sigmoidf_(bias[nt] + acc[nt][jj]);
                stepbuf[0 * SV + (th * 16 + fq * 4 + jj) * 64 + nt * 16 + fr] = __expf(-0.6065306597126334f * sg);
              }
            __builtin_amdgcn_wave_barrier();
            {
              float wl[16];
#pragma unroll
              for (int i = 0; i < 16; ++i) wl[i] = stepbuf[0 * SV + (th * 16 + i) * 64 + lane];
              float pr = 1.f;
#pragma unroll
              for (int i = 0; i < 16; ++i) { pr *= wl[i]; stepbuf[0 * SV + (th * 16 + i) * 64 + lane] = pr; }
            }
          } else {
#pragma unroll
            for (int nt = 0; nt < 4; ++nt)
#pragma unroll
              for (int jj = 0; jj < 4; ++jj) tmpa[(fq * 4 + jj) * 68 + nt * 16 + fr] = sigmoidf_(bias[nt] + acc[nt][jj]);
            __builtin_amdgcn_wave_barrier();
            float av[16], kd[16];
#pragma unroll
            for (int q = 0; q < 4; ++q) { f32x4 a4 = *(const f32x4*)(tmpa + tl * 68 + cq * 16 + q * 4); av[q * 4] = a4[0]; av[q * 4 + 1] = a4[1]; av[q * 4 + 2] = a4[2]; av[q * 4 + 3] = a4[3]; }
            shift16(rb, cst + 2 * 64 + cq * 16, cst + 0 * 64 + cq * 16, v16);
            float kk[16], ss = 0.f;
#pragma unroll
            for (int q = 0; q < 16; ++q) { kk[q] = v16[q] * cst[5 * 64 + cq * 16 + q]; ss += kk[q] * kk[q]; }
            ss = quad_sum(ss);
            const float inv = 1.f / fmaxf(sqrtf(ss), 1e-12f);
#pragma unroll
            for (int q = 0; q < 16; ++q) { kk[q] *= inv; kd[q] = v16[q] * (1.f + (av[q] - 1.f) * cst[6 * 64 + cq * 16 + q]); }
#pragma unroll
            for (int q = 0; q < 4; ++q) {
              *(f32x4*)(stepbuf + 3 * SV + j * 64 + cq * 16 + q * 4) = (f32x4){-kk[q * 4], -kk[q * 4 + 1], -kk[q * 4 + 2], -kk[q * 4 + 3]};
              *(f32x4*)(stepbuf + 4 * SV + j * 64 + cq * 16 + q * 4) = (f32x4){kk[q * 4] * av[q * 4], kk[q * 4 + 1] * av[q * 4 + 1], kk[q * 4 + 2] * av[q * 4 + 2], kk[q * 4 + 3] * av[q * 4 + 3]};
              *(f32x4*)(stepbuf + 1 * SV + j * 64 + cq * 16 + q * 4) = (f32x4){kd[q * 4], kd[q * 4 + 1], kd[q * 4 + 2], kd[q * 4 + 3]};
            }
          }
        } else {
          shift16(ra, cst + 3 * 64 + cq * 16, cst + 1 * 64 + cq * 16, v16);
#pragma unroll
          for (int q = 0; q < 4; ++q) *(f32x4*)(stepbuf + 2 * SV + j * 64 + cq * 16 + q * 4) = (f32x4){v16[q * 4], v16[q * 4 + 1], v16[q * 4 + 2], v16[q * 4 + 3]};
          shift16(rb, cst + 4 * 64 + cq * 16, cst + 8 * 64 + cq * 16, v16);
#pragma unroll
          for (int q = 0; q < 4; ++q) *(f32x4*)(stepbuf + 5 * SV + j * 64 + cq * 16 + q * 4) = (f32x4){v16[q * 4], v16[q * 4 + 1], v16[q * 4 + 2], v16[q * 4 + 3]};
        }
      }
      if (c > 0) {
        const int ip = (c - 1) * 32 + hn * 16 + fr, tp = d ? T - 1 - ip : ip;
        *(uint2*)(yout + (size_t)(r0seq + tp) * 512 + h * 64 + mt * 16 + fq * 4) = y_def;
        if (role == 2 && cq == 0) { const int is_ = (c - 1) * 32 + th * 16 + tl, tg = d ? T - 1 - is_ : is_; P_SBON[((size_t)(r0seq + tg) * 8 + h) * 2 + d] = sb_def; }
      }
      if (role < 3 && c + 1 < nch) {
        const int is2 = (c + 1) * 32 + th * 16 + tl;
        const int t2 = d ? T - 1 - is2 : is2;
        const int row2 = r0seq + t2;
        if (role == 2) load_raw16(ra, z, row2, t2, T, colA);
        if (role >= 1) load_raw16(rb, z, row2, t2, T, colB);
        if (role < 2) {
          const int is3 = (c + 1) * 32 + th * 16 + fr, t3 = d ? T - 1 - is3 : is3;
          const bf16_t* ap = P_ALORA + (unsigned)((r0seq + t3) * 256 + alo);
          ra.c0 = *(const uint4*)ap; ra.c1 = *(const uint4*)(ap + 32);
        }
      }
      lds_barrier();
      {
        const int k = lane, seg = wave;
        const float* sw = stepbuf + 0 * SV + k;
        const float P15 = sw[15 * 64];
        const float hiF = seg >= 4 ? P15 : 1.f;
        float P[5];
        P[0] = seg == 0 ? 1.f : sw[(4 * seg - 1) * 64] * (seg > 4 ? P15 : 1.f);
#pragma unroll
        for (int i = 0; i < 4; ++i) P[i + 1] = sw[(4 * seg + i) * 64] * hiF;
        const float PL = sw[31 * 64] * P15;
        if (role == 2) {
          const int j = th * 16 + tl;
          float bs = 0.f;
#pragma unroll
          for (int q = 0; q < 16; ++q) bs += stepbuf[2 * SV + j * 64 + cq * 16 + q] * stepbuf[1 * SV + j * 64 + cq * 16 + q] * cst[7 * 64 + cq * 16 + q];
          bs = quad_sum(bs);
          sb_def = bs;
        }
        f32x4 bb, kb, at, vv;
#pragma unroll
        for (int i = 0; i < 4; ++i) {
          const int t = 4 * seg + i;
          const float inv = __builtin_amdgcn_rcpf(P[i + 1]);
          const float a_ = P[i] * stepbuf[3 * SV + t * 64 + k];
          const float rraw = stepbuf[2 * SV + t * 64 + k], kraw = stepbuf[1 * SV + t * 64 + k];
          const float r_ = P[i + 1] * rraw;
          const float b_ = stepbuf[4 * SV + t * 64 + k] * inv;
          const float k_ = kraw * inv;

          At[t * 72 + k] = (bf16_t)(cvt_pk_bf16(a_, 0.f) & 0xffff);
          Rt[t * 72 + k] = (bf16_t)(cvt_pk_bf16(r_, 0.f) & 0xffff);
          Bt[t * 72 + k] = (bf16_t)(cvt_pk_bf16(b_, 0.f) & 0xffff);
          Kt[t * 72 + k] = (bf16_t)(cvt_pk_bf16(k_, 0.f) & 0xffff);
          bb[i] = b_ * PL; kb[i] = k_ * PL; at[i] = a_;
          vv[i] = stepbuf[5 * SV + t * 64 + k];
        }
        *(uint2*)(Bb + k * 40 + 4 * seg) = pack4(bb);
        *(uint2*)(Kb + k * 40 + 4 * seg) = pack4(kb);
        *(uint2*)(VT + k * 40 + 4 * seg) = pack4(vv);
        *(uint2*)(AtTb + k * 40 + 4 * seg) = pack4(at);
        if (seg == 0) PLs[k] = PL;
      }
      lds_barrier();
      {
        const int mat = wave >> 1, mts = wave & 1;
        const bf16_t* As = (mat & 1) ? Kt : Bt;
        const bf16_t* Bs = (mat & 2) ? Rt : At;
        f32x4 acc[2] = {};
#pragma unroll
        for (int ks = 0; ks < 2; ++ks) {
          const bf16x8 a = ldfrag(As, 72, mts * 16, ks * 32, fr, fq);
#pragma unroll
          for (int nt = 0; nt < 2; ++nt) acc[nt] = MFMA16(a, ldfrag(Bs, 72, nt * 16, ks * 32, fr, fq), acc[nt]);
        }
#pragma unroll
        for (int nt = 0; nt < 2; ++nt) {
          const int tcol = nt * 16 + fr;
          f32x4 v = acc[nt];
#pragma unroll
          for (int jj = 0; jj < 4; ++jj) {
            const int srow = mts * 16 + fq * 4 + jj;
            const bool keep = (mat & 2) ? (srow <= tcol) : (srow < tcol);
            v[jj] = keep ? v[jj] : 0.f;
          }
          if (mat == 0) {
#pragma unroll
            for (int jj = 0; jj < 4; ++jj) Nab[(mts * 16 + fq * 4 + jj) * 32 + tcol] = v[jj];
          } else {
            bf16_t* dst = mat == 1 ? NakT : mat == 2 ? NbrT : NkrT;
            *(uint2*)(dst + tcol * 40 + mts * 16 + fq * 4) = pack4(v);
          }
        }
      }
      lds_barrier();
      if (wave == 0) {
        const int irow = lane >> 1, hb = lane & 1, blk = lane >> 5, il = irow & 15;
        float x[8];
#pragma unroll
        for (int i = 0; i < 8; ++i) x[i] = (hb * 8 + i == il) ? 1.f : 0.f;
        const float* nb = Nab + (blk * 16) * 32 + blk * 16 + hb * 8;
        solve16<0>(x, nb);
#pragma unroll
        for (int i = 0; i < 8; ++i) TT[(blk * 16 + hb * 8 + i) * 40 + blk * 16 + il] = (bf16_t)(cvt_pk_bf16(x[i], 0.f) & 0xffff);
        if (blk == 0) *(uint4*)(T11b + il * 40 + hb * 8) = pack8(x);
        __builtin_amdgcn_wave_barrier();
        const f32x4 zero = {0.f, 0.f, 0.f, 0.f};
        bf16x8 zf;
#pragma unroll
        for (int i = 0; i < 8; ++i) zf[i] = 0;
        bf16x8 n12 = zf, t22 = zf, t11 = zf;
        if (fq < 2) {
          float o[8];
          const f32x4 n0 = *(const f32x4*)(Nab + fr * 32 + 16 + fq * 8), n1 = *(const f32x4*)(Nab + fr * 32 + 16 + fq * 8 + 4);
          o[0] = n0[0]; o[1] = n0[1]; o[2] = n0[2]; o[3] = n0[3]; o[4] = n1[0]; o[5] = n1[1]; o[6] = n1[2]; o[7] = n1[3];
          uint4 u = pack8(o);
          n12 = *reinterpret_cast<bf16x8*>(&u);
          t22 = *reinterpret_cast<const bf16x8*>(TT + (16 + fr) * 40 + 16 + fq * 8);
          t11 = *reinterpret_cast<const bf16x8*>(T11b + fr * 40 + fq * 8);
        }
        const f32x4 m1 = MFMA16(n12, t22, zero);
        *(uint2*)(M1T + fr * 40 + fq * 4) = pack4(m1);
        __builtin_amdgcn_wave_barrier();
        bf16x8 m1f = zf;
        if (fq < 2) m1f = *reinterpret_cast<const bf16x8*>(M1T + fr * 40 + fq * 8);
        const f32x4 t12 = MFMA16(t11, m1f, zero);
        *(uint2*)(TT + (16 + fr) * 40 + fq * 4) = pack4(t12);
      } else if (wave == 1) {
        unsigned z0;
        asm volatile("v_mov_b32 %0, 0" : "=v"(z0));
        *(uint2*)(TT + (lane >> 2) * 40 + 16 + (lane & 3) * 4) = make_uint2(z0, z0);
      } else if (wave < 6) {
        const int vtile = wave - 2;
        const bf16x8 vf = ldfrag(VT, 40, vtile * 16, 0, fr, fq);
        const f32x4 zero = {0.f, 0.f, 0.f, 0.f};
#pragma unroll
        for (int tt = 0; tt < 2; ++tt) {
          const f32x4 acc = MFMA16(ldfrag(NakT, 40, tt * 16, 0, fr, fq), vf, zero);
          *(uint2*)(VNb + (vtile * 16 + fr) * 40 + tt * 16 + fq * 4) = pack4(acc);
        }
      }
      lds_barrier();
      {
        const int tt = wave & 1, rt = wave >> 1;
        const f32x4 zero = {0.f, 0.f, 0.f, 0.f};
        const bf16x8 tf = ldfrag(TT, 40, tt * 16, 0, fr, fq);
        const f32x4 zacc = MFMA16(tf, ldfrag(VNb, 40, rt * 16, 0, fr, fq), zero);
        const f32x4 wacc = MFMA16(tf, ldfrag(AtTb, 40, rt * 16, 0, fr, fq), zero);
        *(uint2*)(Zb + (rt * 16 + fr) * 40 + tt * 16 + fq * 4) = pack4(zacc);
        *(uint2*)(Wb + (rt * 16 + fr) * 40 + tt * 16 + fq * 4) = pack4(wacc);
      }
      lds_barrier();
      f32x4 yacc = {0.f, 0.f, 0.f, 0.f};
      {
        const float pl0 = PLs[nt0 * 16 + fr], pl1 = PLs[nt1 * 16 + fr];
        Sa = Sa * pl0; Sb = Sb * pl1;
        const bf16x8 zf = ldfrag(Zb, 40, mt * 16, 0, fr, fq), vf = ldfrag(VT, 40, mt * 16, 0, fr, fq), wf = ldfrag(Wb, 40, mt * 16, 0, fr, fq);
        const bf16x8 bb0 = ldfrag(Bb, 40, nt0 * 16, 0, fr, fq), bb1 = ldfrag(Bb, 40, nt1 * 16, 0, fr, fq);
        const bf16x8 kb0 = ldfrag(Kb, 40, nt0 * 16, 0, fr, fq), kb1 = ldfrag(Kb, 40, nt1 * 16, 0, fr, fq);
        const bf16x8 nbr = ldfrag(NbrT, 40, hn * 16, 0, fr, fq), nkr = ldfrag(NkrT, 40, hn * 16, 0, fr, fq);
        Sa = MFMA16(zf, bb0, Sa); Sa = MFMA16(vf, kb0, Sa);
        Sb = MFMA16(zf, bb1, Sb); Sb = MFMA16(vf, kb1, Sb);
        yacc = MFMA16(zf, nbr, yacc); yacc = MFMA16(vf, nkr, yacc);
        const f32x4 zero = {0.f, 0.f, 0.f, 0.f};
        const f32x4 g0 = MFMA16(wf, bb0, zero), g1 = MFMA16(wf, bb1, zero);
        f32x4 ry = MFMA16(wf, nbr, zero);
        *(uint2*)(GT + (nt0 * 16 + fr) * 72 + mt * 16 + fq * 4) = pack4(g0);
        *(uint2*)(GT + (nt1 * 16 + fr) * 72 + mt * 16 + fq * 4) = pack4(g1);
        const uint2 rr = *(const uint2*)(Rt + (hn * 16 + fr) * 72 + mt * 16 + fq * 4);
        ry[0] += bf_lo(rr.x); ry[1] += bf_hi(rr.x); ry[2] += bf_lo(rr.y); ry[3] += bf_hi(rr.y);
        *(uint2*)(RyT + (hn * 16 + fr) * 72 + mt * 16 + fq * 4) = pack4(ry);
      }
      lds_barrier();
      {
        const bf16_t* Scur = Sbf + (c & 1) * 64 * 72;
        bf16_t* Snext = Sbf + ((c + 1) & 1) * 64 * 72;
#pragma unroll
        for (int ks = 0; ks < 2; ++ks) {
          const bf16x8 af = ldfrag(Scur, 72, mt * 16, ks * 32, fr, fq);
          Sa = MFMA16(af, ldfrag(GT, 72, nt0 * 16, ks * 32, fr, fq), Sa);
          Sb = MFMA16(af, ldfrag(GT, 72, nt1 * 16, ks * 32, fr, fq), Sb);
          yacc = MFMA16(af, ldfrag(RyT, 72, hn * 16, ks * 32, fr, fq), yacc);
        }
        y_def = pack4(yacc);
#pragma unroll
        for (int jj = 0; jj < 4; ++jj) {
          Snext[(mt * 16 + fq * 4 + jj) * 72 + nt0 * 16 + fr] = (bf16_t)(cvt_pk_bf16(Sa[jj], 0.f) & 0xffff);
          Snext[(mt * 16 + fq * 4 + jj) * 72 + nt1 * 16 + fr] = (bf16_t)(cvt_pk_bf16(Sb[jj], 0.f) & 0xffff);
        }
      }
      lds_barrier();
    }
    {
      const int ip = (nch - 1) * 32 + hn * 16 + fr, tp = d ? T - 1 - ip : ip;
      *(uint2*)(yout + (size_t)(r0seq + tp) * 512 + h * 64 + mt * 16 + fq * 4) = y_def;
      if (role == 2 && cq == 0) { const int is_ = (nch - 1) * 32 + th * 16 + tl, tg = d ? T - 1 - is_ : is_; P_SBON[((size_t)(r0seq + tg) * 8 + h) * 2 + d] = sb_def; }
    }
  }
  if (item >= 128) {
    const int nb = gridDim.x - 128;
    for (int tile = item - 128; tile < NTOK / 32; tile += nb) pool_tile(z, P_RH, tile, tid);
  }
}

__device__ __forceinline__ void post_phase(PREF p, char* smem, const int wid_u) {
  bf16_t* Ag = (bf16_t*)smem;
  bf16_t* vt = (bf16_t*)(smem + 12800);
  float* ys = (float*)(smem + 12800 + 33280);
  const bf16_t* z = P_RU;
  const bf16_t* yf = P_RY;
  const bf16_t* ybk = P_RY + (size_t)NTOK * 512;
  bf16_t* mo = P_RH;
  const int tid = opaque_tid(), w = tid >> 6, lane = tid & 63, fr = lane & 15, fq = lane >> 4;
  bf16x8 Bg[4][6];
#pragma unroll
  for (int nt = 0; nt < 4; ++nt)
#pragma unroll
    for (int ks = 0; ks < 6; ++ks) {
      float o[8];
#pragma unroll
      for (int q = 0; q < 8; ++q) { const int k = ks * 32 + fq * 8 + q; o[q] = k < 160 ? p.g2[(size_t)k * 512 + w * 64 + nt * 16 + fr] : 0.f; }
      uint4 u = pack8(o);
      Bg[nt][ks] = *reinterpret_cast<bf16x8*>(&u);
    }
  float lng[4], lnb[4];
#pragma unroll
  for (int nt = 0; nt < 4; ++nt) { lng[nt] = p.lnx_g[w * 64 + nt * 16 + fr]; lnb[nt] = p.lnx_b[w * 64 + nt * 16 + fr]; }

  for (int tile = blockIdx.x; tile < NTOK / 32; tile += gridDim.x) {
    const int row0 = tile * 32;
    int s, t0, T;
    row_seq(row0, s, t0, T);
    for (int idx = tid; idx < 32 * 24; idx += NTHR) {
      const int tok = idx / 24, oc = idx % 24;
      float o[8];
      if (oc < 20) {
        load_shift8(z, row0 + tok, t0 + tok, T, 2304 + oc * 8, p.shift_mu, o);
#pragma unroll
        for (int q = 0; q < 8; ++q) o[q] = sigmoidf_(o[q]);
      } else {
#pragma unroll
        for (int q = 0; q < 8; ++q) o[q] = 0.f;
      }
      *(uint4*)(Ag + tok * 200 + oc * 8) = pack8(o);
    }
#pragma unroll 1
    for (int half_ = 0; half_ < 2; ++half_) {
      uint4 zc[2], zp[2], zn[2], ya[2], yb4[2];
#pragma unroll
      for (int i = 0; i < 2; ++i) {
        const int idx = tid + (half_ * 2 + i) * NTHR, tok = idx >> 6, oc = idx & 63, row = row0 + tok, t = t0 + tok;
        const bf16_t* pz = z + (size_t)row * ZLD + 1536 + oc * 8;
        zc[i] = *(const uint4*)pz;
        zp[i] = make_uint4(0, 0, 0, 0); zn[i] = zp[i];
        if (t > 0) zp[i] = *(const uint4*)(pz - ZLD);
        if (t < T - 1) zn[i] = *(const uint4*)(pz + ZLD);
        ya[i] = *(const uint4*)(yf + (size_t)row * 512 + oc * 8);
        yb4[i] = *(const uint4*)(ybk + (size_t)row * 512 + oc * 8);
      }
#pragma unroll
      for (int i = 0; i < 2; ++i) {
        const int idx = tid + (half_ * 2 + i) * NTHR, tok = idx >> 6, oc = idx & 63;
        float c[8], pv[8], nx[8], o[8];
        unpack8(zc[i], c); unpack8(zp[i], pv); unpack8(zn[i], nx);
#pragma unroll
        for (int q = 0; q < 8; ++q) o[q] = c[q] + (0.5f * (pv[q] + nx[q]) - c[q]) * p.shift_mu[1536 - 512 + oc * 8 + q];
        *(uint4*)(vt + tok * 520 + oc * 8) = pack8(o);
        float a[8], b[8];
        unpack8(ya[i], a); unpack8(yb4[i], b);
        *(f32x4*)(ys + tok * 516 + oc * 8) = (f32x4){a[0] + b[0], a[1] + b[1], a[2] + b[2], a[3] + b[3]};
        *(f32x4*)(ys + tok * 516 + oc * 8 + 4) = (f32x4){a[4] + b[4], a[5] + b[5], a[6] + b[6], a[7] + b[7]};
      }
    }
    __syncthreads();
    f32x4 acc[2][4] = {};
#pragma unroll
    for (int ks = 0; ks < 6; ++ks) {
      bf16x8 a[2];
#pragma unroll
      for (int mt = 0; mt < 2; ++mt) a[mt] = *reinterpret_cast<const bf16x8*>(Ag + (mt * 16 + fr) * 200 + ks * 32 + fq * 8);
#pragma unroll
      for (int mt = 0; mt < 2; ++mt)
#pragma unroll
        for (int nt = 0; nt < 4; ++nt) acc[mt][nt] = __builtin_amdgcn_mfma_f32_16x16x32_bf16(a[mt], Bg[nt][ks], acc[mt][nt], 0, 0, 0);
    }
#pragma unroll
    for (int mt = 0; mt < 2; ++mt)
#pragma unroll
      for (int jj = 0; jj < 4; ++jj) {
        const int tok = mt * 16 + fq * 4 + jj, row = row0 + tok;
        float yv[4], sm_ = 0.f;
#pragma unroll
        for (int nt = 0; nt < 4; ++nt) { yv[nt] = ys[tok * 516 + w * 64 + nt * 16 + fr]; sm_ += yv[nt]; }
        const float mean = row16_sum(sm_) * (1.f / 64.f);
        float vs = 0.f;
#pragma unroll
        for (int nt = 0; nt < 4; ++nt) { yv[nt] -= mean; vs += yv[nt] * yv[nt]; }
        const float rs = rsqrtf(row16_sum(vs) * (1.f / 64.f) + 64e-5f);
        const float2 sb2 = *(const float2*)(P_SBON + ((size_t)row * 8 + w) * 2);
        const float sbs = sb2.x + sb2.y;
#pragma unroll
        for (int nt = 0; nt < 4; ++nt) {
          const float vv = bf2f(vt[tok * 520 + w * 64 + nt * 16 + fr]);
          const float o = (yv[nt] * rs * lng[nt] + lnb[nt] + sbs * vv) * acc[mt][nt][jj];
          mo[(size_t)row * D + 512 + w * 64 + nt * 16 + fr] = (bf16_t)(cvt_pk_bf16(o, 0.f) & 0xffff);
        }
      }
    __syncthreads();
  }
}

#define XB_TMO      128
#define XB_XCNT(j)  (256  + 64 * (j))
#define XB_XSUB(j)  (1280 + 64 * (j))
#define XB_XGEN(j)  (2304 + 64 * (j))
#define XB_TOP      3328
#define XB_TOPGEN   3392
#define XCD_BAR_WORDS 3456
#define XB_SPIN_CAP (1u << 22)
__device__ __forceinline__ unsigned xb_ld(unsigned* p)              { return __hip_atomic_load(p, __ATOMIC_RELAXED, __HIP_MEMORY_SCOPE_AGENT); }
__device__ __forceinline__ unsigned xb_add(unsigned* p, unsigned v) { return __hip_atomic_fetch_add(p, v, __ATOMIC_RELAXED, __HIP_MEMORY_SCOPE_AGENT); }
__device__ __forceinline__ unsigned xb_xcc_id() { return (unsigned)__builtin_amdgcn_s_getreg((3 << 11) | 20) & 0xFu; }
#define XB_SPIN(cond, bar) do { unsigned _sp = 0; while (cond) { __builtin_amdgcn_s_sleep(1); \
    if ((++_sp & 255u) == 0u) { if (xb_ld(&(bar)[XB_TMO])) break; if (_sp > XB_SPIN_CAP) { atomicAdd(&(bar)[XB_TMO], 1u); break; } } } } while (0)
struct XcdBarrier { unsigned* bar; unsigned x; volatile LAS unsigned* st; };
__device__ __forceinline__ void xcd_barrier_complete(unsigned* bar, unsigned x, unsigned& nloc, unsigned& nx) {
  const unsigned G = gridDim.x * gridDim.y * gridDim.z;
  unsigned sum, cnt, mine, sp = 0u;
  for (;;) {
    sum = 0u; cnt = 0u; mine = 0u;
#pragma unroll
    for (unsigned j = 0; j < 16; ++j) { const unsigned c = xb_ld(&bar[XB_XCNT(j)]); sum += c; cnt += (c > 0u) ? 1u : 0u; mine = (j == x) ? c : mine; }
    if (sum == G) break;
    __builtin_amdgcn_s_sleep(1);
    if ((++sp & 255u) == 0u) { if (xb_ld(&bar[XB_TMO])) break; if (sp > XB_SPIN_CAP) { atomicAdd(&bar[XB_TMO], 1u); break; } }
  }
  nloc = mine > 0u ? mine : 1u; nx = cnt > 0u ? cnt : 1u;
}
__device__ __forceinline__ void xcd_barrier(PREF p, volatile LAS unsigned* st_, const int wid_u) {
  asm volatile("s_waitcnt vmcnt(0)" ::: "memory");
  __syncthreads();
  if (opaque_tid() == 0) {
    XcdBarrier b; b.bar = (unsigned*)(p.ws + OFF_BAR); b.x = xb_xcc_id(); b.st = st_;
    unsigned* bar = b.bar;
    __builtin_amdgcn_s_waitcnt(0);
    unsigned nloc = b.st[0], nx = b.st[1];
    if (nloc == 0u) { xcd_barrier_complete(bar, b.x, nloc, nx); b.st[0] = nloc; b.st[1] = nx; }
    const unsigned old = xb_add(&bar[XB_XSUB(b.x)], 1u);
    const unsigned gen = old / nloc;
    if (old + 1u == (gen + 1u) * nloc) {
      __builtin_amdgcn_fence(__ATOMIC_RELEASE, "agent");
      asm volatile("s_waitcnt vmcnt(0)" ::: "memory");
      const unsigned og = xb_add(&bar[XB_TOP], 1u);
      const unsigned tg = og / nx;
      if (og + 1u == (tg + 1u) * nx) xb_add(&bar[XB_TOPGEN], 1u);
      else XB_SPIN(xb_ld(&bar[XB_TOPGEN]) == tg, bar);
      __builtin_amdgcn_fence(__ATOMIC_ACQUIRE, "agent");
      xb_add(&bar[XB_XGEN(b.x)], 1u);
      asm volatile("s_waitcnt vmcnt(0)" ::: "memory");
    } else {
      XB_SPIN(xb_ld(&bar[XB_XGEN(b.x)]) == gen, bar);
      __builtin_amdgcn_fence(__ATOMIC_ACQUIRE, "agent");
      asm volatile("s_waitcnt vmcnt(0)" ::: "memory");
    }
  }
  __syncthreads();
}

constexpr int NPHASE = 14;
__device__ __forceinline__ void do_phase(PREF p, int ph, char* smem, const int wid_u) {
  if (ph == 0) prep_phase(p, smem, wid_u);
  else if (ph == 1) row_phase<0>(p.x_prompt, p.x_sample, nullptr, nullptr, P_RH, P_MOD, nullptr, p.n1_pre, 0, 0.f, 0, wid_u);
  else if (ph == 4 || ph == 10) {
    const bool f = ph == 4;
    float* outp = p.out;
    row_phase<1>(sel(f, p.x_prompt, (const float*)outp), sel(f, p.x_sample, (const float*)(outp + (size_t)NPROMPT * D)), outp, P_RY, P_RH, P_MOD,
                 sel(f, p.n1_post, p.nm_post), sel(f, p.nm_pre, p.n2_pre), f ? 2 : 5, f ? 0.5f : 1.0f, f ? 3 : 6, wid_u, !f);
  }
  else if (ph == 13) row_phase<2>(p.out, p.out + (size_t)NPROMPT * D, p.out, P_RY, nullptr, P_MOD, p.n2_post, nullptr, 8, 0.5f, 0, wid_u, true);
  else if (ph == 6) lora_prep_phase(p, wid_u);
  else if (ph == 7) scan_phase(p, smem, wid_u);
  else if (ph == 8) post_phase(p, smem, wid_u);
  else {
    const bf16_t *A, *Bt; bf16_t* C; int N, K, ldc, epi;
    if (ph == 2 || ph == 11) { A = P_RH; Bt = sel(ph == 2, P_W13A, P_W13B); C = P_RU; N = 2 * FF; K = D; ldc = FF; epi = 1; }
    else if (ph == 3 || ph == 12) { A = P_RU; Bt = sel(ph == 3, P_W2A, P_W2B); C = P_RY; N = D; K = FF; ldc = D; epi = 0; }
    else if (ph == 5) { A = P_RH; Bt = P_WINT; C = P_RU; N = ZLD; K = D; ldc = ZLD; epi = 0; }
    else { A = P_RH; Bt = P_WOUTT; C = P_RY; N = D; K = D; ldc = D; epi = 0; }
    gemm_phase(A, Bt, C, NTOK, N, K, ldc, epi, smem, wid_u);
  }
}

extern __shared__ __attribute__((aligned(16))) char dyn_smem[];

__global__ void __launch_bounds__(NTHR, 2) mega_kernel(Params p) {
  cg::grid_group grid = cg::this_grid();
  const int wid_u = __builtin_amdgcn_readfirstlane(threadIdx.x >> 6);
  typedef const __attribute__((address_space(4))) Params* KP;
  const KP kp0 = (KP)__builtin_amdgcn_kernarg_segment_ptr();
  volatile LAS unsigned* st = (volatile LAS unsigned*)((LAS char*)dyn_smem + (SMEM_BYTES - 16));
  if (threadIdx.x < 2) st[threadIdx.x] = 0u;
  __syncthreads();
  if (threadIdx.x == 0) (void)xb_add(&((unsigned*)(kp0->ws + OFF_BAR))[XB_XCNT(xb_xcc_id())], 1u);
#pragma unroll 1
  for (int ph = 0; ph < NPHASE; ++ph) {
    KP kp = kp0;
    asm volatile("" : "+s"(kp));
    do_phase(*kp, ph, dyn_smem, wid_u);
#ifdef PROBE_REPEAT
    if (ph == PROBE_REPEAT) { grid.sync(); do_phase(*kp, ph, dyn_smem, wid_u); }
#endif
    if (ph == 0) grid.sync();
    else if (ph + 1 < NPHASE) xcd_barrier(*kp, (volatile LAS unsigned*)((LAS char*)dyn_smem + (SMEM_BYTES - 16)), wid_u);
  }
}

__global__ void __launch_bounds__(NTHR, 2) phase_kernel(Params p, int ph) {
  const int wid_u = __builtin_amdgcn_readfirstlane(threadIdx.x >> 6);
  do_phase(*(const __attribute__((address_space(4))) Params*)__builtin_amdgcn_kernarg_segment_ptr(), ph, dyn_smem, wid_u);
}

extern "C" void kernel_launch(void* const* d_in, const int* in_sizes, int n_in, void* d_out, int out_size, void* d_ws, size_t ws_size,
                              hipStream_t stream) {
  Params p{};
  const float** f = (const float**)&p;
  for (int i = 0; i < 33; ++i) f[i] = (const float*)d_in[i];
  p.out = (float*)d_out;
  p.ws = (char*)d_ws;
  if (WS_NEED > ws_size) { fprintf(stderr, "workspace too small: need %zu have %zu\n", (size_t)WS_NEED, ws_size); return; }

#if ONE_LAUNCH
  static int grid_blocks = 0;
  if (!grid_blocks) {
    int dev = 0, cus = 0, per_cu = 0;
    (void)hipGetDevice(&dev);
    (void)hipDeviceGetAttribute(&cus, hipDeviceAttributeMultiprocessorCount, dev);
    (void)hipFuncSetAttribute((const void*)mega_kernel, hipFuncAttributeMaxDynamicSharedMemorySize, SMEM_BYTES);
    (void)hipOccupancyMaxActiveBlocksPerMultiprocessor(&per_cu, mega_kernel, NTHR, SMEM_BYTES);
    if (per_cu < 1) per_cu = 1;
    grid_blocks = cus * per_cu;
  }
  (void)hipMemsetAsync(p.ws + OFF_BAR, 0, XCD_BAR_WORDS * sizeof(unsigned), stream);
  void* args[] = {&p};
  hipError_t e = hipLaunchCooperativeKernel((const void*)mega_kernel, dim3(grid_blocks), dim3(NTHR), args, SMEM_BYTES, stream);
  if (e != hipSuccess) fprintf(stderr, "cooperative launch failed: %s (grid %d)\n", hipGetErrorString(e), grid_blocks);
#else
  static bool attr = false;
  if (!attr) { (void)hipFuncSetAttribute((const void*)phase_kernel, hipFuncAttributeMaxDynamicSharedMemorySize, SMEM_BYTES); attr = true; }
  for (int ph = 0; ph < NPHASE; ++ph) phase_kernel<<<256, NTHR, SMEM_BYTES, stream>>>(p, ph);
#endif
}
```

```cpp
#include <hip/hip_runtime.h>
#include <hip/hip_cooperative_groups.h>
#include <cstdio>
namespace cg = cooperative_groups;

#ifndef ONE_LAUNCH
#define ONE_LAUNCH 1
#endif

typedef unsigned short bf16_t;
typedef short bf16x8 __attribute__((ext_vector_type(8)));
typedef float f32x4 __attribute__((ext_vector_type(4)));
typedef float f32x2 __attribute__((ext_vector_type(2)));
typedef unsigned u32x2 __attribute__((ext_vector_type(2)));
#define LAS __attribute__((address_space(3)))

constexpr int D = 1024, FF = 2816, NTOK = 98304, NPROMPT = 32768, ZLD = 2560, PINW = 2464;
constexpr int NTHR = 512;
constexpr int SMEM_BYTES = 162320;

struct Params {
  const float *x_prompt, *x_sample, *c_prompt, *c_sample, *ada_w, *ada_b, *n1_pre, *n1_post, *f1_w1, *f1_w3, *f1_w2,
      *nm_pre, *nm_post, *w_in, *shift_mu, *pool_w, *pool_scale, *w0, *w2, *a0, *a2, *g2, *k_k, *k_a, *r_k, *lnx_g, *lnx_b,
      *w_out, *n2_pre, *n2_post, *f2_w1, *f2_w3, *f2_w2;
  float* out;
  char* ws;
};
#define PREF const __attribute__((address_space(4))) Params&
constexpr size_t al256(size_t b) { return (b + 255) & ~(size_t)255; }
constexpr size_t OFF_W13A = 0;
constexpr size_t OFF_W13B = OFF_W13A + al256((size_t)2 * FF * D * 2);
constexpr size_t OFF_W2A = OFF_W13B + al256((size_t)2 * FF * D * 2);
constexpr size_t OFF_W2B = OFF_W2A + al256((size_t)D * FF * 2);
constexpr size_t OFF_WINT = OFF_W2B + al256((size_t)D * FF * 2);
constexpr size_t OFF_WOUTT = OFF_WINT + al256((size_t)ZLD * D * 2);
constexpr size_t OFF_MOD = OFF_WOUTT + al256((size_t)D * D * 2);
constexpr size_t OFF_SBON = OFF_MOD + al256((size_t)16 * 9216 * 4);
constexpr size_t OFF_RH = OFF_SBON + al256((size_t)NTOK * 16 * 4);
constexpr size_t OFF_RY = OFF_RH + al256((size_t)NTOK * D * 2);
constexpr size_t OFF_RU = OFF_RY + al256((size_t)NTOK * D * 2);
constexpr size_t OFF_ALORA = OFF_RU + al256((size_t)NTOK * FF * 2);
constexpr size_t OFF_BAR = OFF_ALORA + al256((size_t)NTOK * 256 * 2);
constexpr size_t WS_NEED = OFF_BAR + 16384;
#define P_W13A ((bf16_t*)(p.ws + OFF_W13A))
#define P_W13B ((bf16_t*)(p.ws + OFF_W13B))
#define P_W2A ((bf16_t*)(p.ws + OFF_W2A))
#define P_W2B ((bf16_t*)(p.ws + OFF_W2B))
#define P_WINT ((bf16_t*)(p.ws + OFF_WINT))
#define P_WOUTT ((bf16_t*)(p.ws + OFF_WOUTT))
#define P_MOD ((float*)(p.ws + OFF_MOD))
#define P_SBON ((float*)(p.ws + OFF_SBON))
#define P_RH ((bf16_t*)(p.ws + OFF_RH))
#define P_RY ((bf16_t*)(p.ws + OFF_RY))
#define P_RU ((bf16_t*)(p.ws + OFF_RU))
#define P_ALORA ((bf16_t*)(p.ws + OFF_ALORA))

typedef __bf16 bf16x2_t __attribute__((ext_vector_type(2)));
__device__ __forceinline__ unsigned cvt_pk_bf16(float lo, float hi) {
  f32x2 v = {lo, hi};
  bf16x2_t b = __builtin_convertvector(v, bf16x2_t);
  return __builtin_bit_cast(unsigned, b);
}
__device__ __forceinline__ float bf_lo(unsigned u) { return __uint_as_float(u << 16); }
__device__ __forceinline__ float bf_hi(unsigned u) { return __uint_as_float(u & 0xffff0000u); }
__device__ __forceinline__ float bf2f(bf16_t b) { return __uint_as_float(((unsigned)b) << 16); }
__device__ __forceinline__ void unpack8(uint4 v, float* o) {
  o[0] = bf_lo(v.x); o[1] = bf_hi(v.x); o[2] = bf_lo(v.y); o[3] = bf_hi(v.y);
  o[4] = bf_lo(v.z); o[5] = bf_hi(v.z); o[6] = bf_lo(v.w); o[7] = bf_hi(v.w);
}
__device__ __forceinline__ uint4 pack8(const float* o) {
  uint4 v; v.x = cvt_pk_bf16(o[0], o[1]); v.y = cvt_pk_bf16(o[2], o[3]); v.z = cvt_pk_bf16(o[4], o[5]); v.w = cvt_pk_bf16(o[6], o[7]);
  return v;
}
__device__ __forceinline__ float sigmoidf_(float x) { return __builtin_amdgcn_rcpf(1.f + __expf(-x)); }
template <int CTRL> __device__ __forceinline__ float dpp_f(float x) {
  return __int_as_float(__builtin_amdgcn_update_dpp(0, __float_as_int(x), CTRL, 0xf, 0xf, false));
}
__device__ __forceinline__ float row16_sum(float x) {
  x += dpp_f<0x128>(x); x += dpp_f<0x124>(x); x += dpp_f<0x122>(x); x += dpp_f<0x121>(x);
  return x;
}
template <class T> __device__ __forceinline__ T sel(bool c, T a, T b) { return c ? a : b; }
__device__ __forceinline__ int opaque_tid_w(int wid) {
  int l;
  asm volatile("v_mbcnt_lo_u32_b32 %0, -1, 0\n\tv_mbcnt_hi_u32_b32 %0, -1, %0" : "=v"(l));
  return wid * 64 + l;
}
#define opaque_tid() opaque_tid_w(wid_u)
__device__ __forceinline__ float wave_sum(float v) {
  v = row16_sum(v);
  const float a = __int_as_float(__builtin_amdgcn_readlane(__float_as_int(v), 0)), b = __int_as_float(__builtin_amdgcn_readlane(__float_as_int(v), 16));
  const float c = __int_as_float(__builtin_amdgcn_readlane(__float_as_int(v), 32)), d = __int_as_float(__builtin_amdgcn_readlane(__float_as_int(v), 48));
  return (a + b) + (c + d);
}
__device__ __forceinline__ float quad_sum(float x) { x += dpp_f<0xB1>(x); x += dpp_f<0x4E>(x); return x; }
__device__ __forceinline__ int seq_start(int s) { return s < 8 ? s * 4096 : NPROMPT + (s - 8) * 8192; }
__device__ __forceinline__ void row_seq(int row, int& s, int& t, int& T) {
  if (row < NPROMPT) { s = row >> 12; t = row & 4095; T = 4096; }
  else { int r = row - NPROMPT; s = 8 + (r >> 13); t = r & 8191; T = 8192; }
}

__device__ __forceinline__ void tr_tile(const float* __restrict__ src, int ldsrc, int k0, int n0, int nvalid, bf16_t* __restrict__ dst, int ldd,
                        int kdst0, int mode, float* sm, const int tid) {
#pragma unroll
  for (int i = 0; i < 2; ++i) {
    const int r = (tid >> 4) + 32 * i, c = (tid & 15) * 4;
    float4 v = make_float4(0.f, 0.f, 0.f, 0.f);
    if (n0 + c < nvalid) v = *(const float4*)(src + (size_t)(k0 + r) * ldsrc + n0 + c);
    float* d = sm + r * 65 + c;
    d[0] = v.x; d[1] = v.y; d[2] = v.z; d[3] = v.w;
  }
  __syncthreads();
  {
    const int n = tid >> 3, kc = (tid & 7) * 8;
    float o[8];
#pragma unroll
    for (int j = 0; j < 8; ++j) o[j] = sm[(kc + j) * 65 + n];
    int nn = n0 + n, drow;
    const int c32 = nn & 31, slot = 16 * ((c32 >> 2) & 1) + 4 * (c32 >> 3) + (c32 & 3);
    if (mode == 0) drow = (nn & ~31) + slot;
    else drow = 256 * (nn >> 7) + (mode == 2 ? 128 : 0) + ((nn & 127) & ~31) + slot;
    *(uint4*)(dst + (size_t)drow * ldd + kdst0 + k0 + kc) = pack8(o);
  }
  __syncthreads();
}

__device__ __forceinline__ void prep_phase(PREF p, char* smem, const int wid_u) {
  float* sm = (float*)smem;
  const int tid = opaque_tid();
  constexpr int N_MOD = 144, N_EFF = 128, N_W13 = 4 * 704, N_W2 = 2 * 704, N_WIN = 640, N_WOUT = 128;
  constexpr int TOTAL = N_MOD + N_EFF + N_W13 + N_W2 + N_WIN + N_WOUT;
  for (int item = blockIdx.x; item < TOTAL; item += gridDim.x) {
    int it = item;
    if (it < N_MOD) {
      const int j0 = it * 64;
      float* sc = sm;
      float* red = sm + 16384;
      for (int idx = tid; idx < 16384; idx += NTHR) {
        const int s = idx >> 10, k = idx & 1023;
        const float* cp_ = p.c_prompt; const float* cs_ = p.c_sample;
        const float c = s < 8 ? cp_[s * 1024 + k] : cs_[(s - 8) * 1024 + k];
        sc[idx] = c / (1.f + __expf(-c));
      }
      __syncthreads();
      const int col = tid & 63, kg = tid >> 6;
      float acc[16];
#pragma unroll
      for (int s = 0; s < 16; ++s) acc[s] = 0.f;
      for (int k = kg * 128; k < kg * 128 + 128; ++k) {
        const float w = p.ada_w[(size_t)k * 9216 + j0 + col];
#pragma unroll
        for (int s = 0; s < 16; ++s) acc[s] += sc[s * 1024 + k] * w;
      }
#pragma unroll
      for (int s = 0; s < 16; ++s) red[(kg * 16 + s) * 64 + col] = acc[s];
      __syncthreads();
      for (int o = tid; o < 1024; o += NTHR) {
        const int s = o >> 6, c2 = o & 63;
        float v = p.ada_b[j0 + c2];
#pragma unroll
        for (int g = 0; g < 8; ++g) v += red[(g * 16 + s) * 64 + c2];
        P_MOD[s * 9216 + j0 + c2] = v;
      }
      __syncthreads();
      continue;
    }
    it -= N_MOD;
    if (it < N_EFF) {
      const int g = it >> 5, itile = (it >> 4) & 1, ntile = it & 15;
      float* As = sm;
      float* Bs = sm + 64 * 129;
      for (int idx = tid; idx < 64 * 128; idx += NTHR) {
        const int i = idx >> 7, j = idx & 127;
        As[i * 129 + j] = p.pool_w[((size_t)g * 128 + itile * 64 + i) * 128 + j] * p.pool_scale[g * 128 + j];
      }
      for (int idx = tid; idx < 128 * 64; idx += NTHR) {
        const int j = idx >> 6, nn = idx & 63;
        Bs[j * 65 + nn] = p.w_out[(size_t)(g * 128 + j) * 1024 + ntile * 64 + nn];
      }
      __syncthreads();
      const int i = tid >> 3, nn0 = (tid & 7) * 8;
      float acc[8];
#pragma unroll
      for (int q = 0; q < 8; ++q) acc[q] = 0.f;
      for (int j = 0; j < 128; ++j) {
        const float a = As[i * 129 + j];
#pragma unroll
        for (int q = 0; q < 8; ++q) acc[q] += a * Bs[j * 65 + nn0 + q];
      }
#pragma unroll
      for (int q = 0; q < 8; ++q)
      {
        const int nn = ntile * 64 + nn0 + q, c32 = nn & 31, slot = 16 * ((c32 >> 2) & 1) + 4 * (c32 >> 3) + (c32 & 3);
        P_WOUTT[(size_t)((nn & ~31) + slot) * 1024 + g * 128 + itile * 64 + i] = (bf16_t)(cvt_pk_bf16(acc[q], 0.f) & 0xffff);
      }
      __syncthreads();
      continue;
    }
    it -= N_EFF;
    if (it < N_W13) {
      const int which = it / 704, r = it % 704;
      const int kt = r / 44, ntl = r % 44;
      const float* src = sel(which < 2, sel(which == 0, p.f1_w1, p.f1_w3), sel(which == 2, p.f2_w1, p.f2_w3));
      bf16_t* dst = sel(which < 2, P_W13A, P_W13B);
      tr_tile(src, FF, kt * 64, ntl * 64, FF, dst, D, 0, (which & 1) ? 2 : 1, sm, tid);
      continue;
    }
    it -= N_W13;
    if (it < N_W2) {
      const int which = it / 704, r = it % 704;
      const int kt = r / 16, ntl = r % 16;
      tr_tile(sel(which != 0, p.f2_w2, p.f1_w2), D, kt * 64, ntl * 64, D, sel(which != 0, P_W2B, P_W2A), FF, 0, 0, sm, tid);
      continue;
    }
    it -= N_W2;
    if (it < N_WIN) {
      const int kt = it / 40, ntl = it % 40;
      tr_tile(p.w_in, PINW, kt * 64, ntl * 64, PINW, P_WINT, D, 0, 0, sm, tid);
      continue;
    }
    it -= N_WIN;
    {
      const int kt = it / 16, ntl = it % 16;
      tr_tile(p.w_out + (size_t)512 * 1024, D, kt * 64, ntl * 64, D, P_WOUTT, D, 512, 0, sm, tid);
    }
  }
}

template <int MODE>
__device__ __forceinline__ void row_phase(const float* __restrict__ xp, const float* __restrict__ xs, float* __restrict__ xout,
                          const bf16_t* __restrict__ y, bf16_t* __restrict__ h, const float* __restrict__ mod,
                          const float* __restrict__ npost, const float* __restrict__ npre, int gate_idx, float cgate, int shift_idx, const int wid_u,
                          const bool xin_bf = false) {
  const int tid_ = opaque_tid();
  const int lane = tid_ & 63;
  const int gw = blockIdx.x * 8 + (tid_ >> 6), GW = gridDim.x * 8;
  for (int chunk = gw; chunk < NTOK / 16; chunk += GW) {
    const int row0 = chunk * 16;
    int s, t, T;
    row_seq(row0, s, t, T);
    const float* md = mod + s * 9216;
    f32x4 Am[4], Bm[4], Gm[4];
#pragma unroll
    for (int i = 0; i < 4; ++i) {
      const int c = i * 256 + lane * 4;
      if (MODE != 2) {
        f32x4 np = *(const f32x4*)(npre + c), sc = *(const f32x4*)(md + (shift_idx + 1) * 1024 + c);
        Am[i] = np * (sc + 1.f);
        Bm[i] = *(const f32x4*)(md + shift_idx * 1024 + c);
      }
      if (MODE != 0) {
        f32x4 g = *(const f32x4*)(md + gate_idx * 1024 + c), po = *(const f32x4*)(npost + c);
        Gm[i] = g * po * cgate;
      }
    }
    for (int r = 0; r < 16; ++r) {
      const int row = row0 + r;
      const float* xr = (row < NPROMPT) ? xp + (size_t)row * D : xs + (size_t)(row - NPROMPT) * D;
      f32x4 xv[4];
      if (MODE != 0 && xin_bf) {
        const bf16_t* xb = (const bf16_t*)(xout + (size_t)row * D) + 1024;
#pragma unroll
        for (int i = 0; i < 4; ++i) {
          const u32x2 u = __builtin_nontemporal_load((const u32x2*)(xb + i * 256 + lane * 4));
          xv[i] = (f32x4){bf_lo(u.x), bf_hi(u.x), bf_lo(u.y), bf_hi(u.y)};
        }
      } else {
#pragma unroll
        for (int i = 0; i < 4; ++i) xv[i] = __builtin_nontemporal_load((const f32x4*)(xr + i * 256 + lane * 4));
      }
      if (MODE != 0) {
        f32x4 yv[4];
        float ss = 0.f;
#pragma unroll
        for (int i = 0; i < 4; ++i) {
          const u32x2 u = __builtin_nontemporal_load((const u32x2*)(y + (size_t)row * D + i * 256 + lane * 4));
          yv[i] = (f32x4){bf_lo(u.x), bf_hi(u.x), bf_lo(u.y), bf_hi(u.y)};
          ss += yv[i][0] * yv[i][0] + yv[i][1] * yv[i][1] + yv[i][2] * yv[i][2] + yv[i][3] * yv[i][3];
        }
        ss = wave_sum(ss);
        const float rs = rsqrtf(ss * (1.f / 1024.f) + 1e-6f);
#pragma unroll
        for (int i = 0; i < 4; ++i) {
          xv[i] = xv[i] + Gm[i] * yv[i] * rs;
          if (MODE == 2) __builtin_nontemporal_store(xv[i], (f32x4*)(xout + (size_t)row * D + i * 256 + lane * 4));
          else {
            uint2 u; u.x = cvt_pk_bf16(xv[i][0], xv[i][1]); u.y = cvt_pk_bf16(xv[i][2], xv[i][3]);
            *(uint2*)((bf16_t*)(xout + (size_t)row * D) + 1024 + i * 256 + lane * 4) = u;
          }
        }
      }
      if (MODE != 2) {
        float ss = 0.f;
#pragma unroll
        for (int i = 0; i < 4; ++i) ss += xv[i][0] * xv[i][0] + xv[i][1] * xv[i][1] + xv[i][2] * xv[i][2] + xv[i][3] * xv[i][3];
        ss = wave_sum(ss);
        const float rs = rsqrtf(ss * (1.f / 1024.f) + 1e-6f);
#pragma unroll
        for (int i = 0; i < 4; ++i) {
          f32x4 hv = xv[i] * rs * Am[i] + Bm[i];
          uint2 u; u.x = cvt_pk_bf16(hv[0], hv[1]); u.y = cvt_pk_bf16(hv[2], hv[3]);
          *(uint2*)(h + (size_t)row * D + i * 256 + lane * 4) = u;
        }
      }
    }
  }
}

constexpr int BM = 256, BK = 64, HALF = 128, NXCD = 8, WGM = 4, HT = HALF * BK;
__device__ __forceinline__ int lds_byte(int r, int c) {
  int st = (r >> 4) * 2 + (c >> 5), rr = r & 15, cc = c & 31, ob = rr * 64 + cc * 2;
  return st * 1024 + (ob ^ (((ob >> 9) & 1) << 5));
}
__device__ __forceinline__ void stage_rc(int b, int& R, int& C) {
  int st = b / 1024, sb = b % 1024, swz = sb ^ (((sb >> 9) & 1) << 5);
  R = (st >> 1) * 16 + swz / 64; C = (st & 1) * 32 + (swz % 64) / 2;
}

__device__ __forceinline__ bool gemm_unit(int i, int nM, int nN, int nwg, int& pm, int& pn) {
  const long L = (long)i * gridDim.x + blockIdx.x;
  if (L >= nwg) return false;
  int wgid = (int)L;
  { int q = nwg / NXCD, r = nwg % NXCD, xcd = wgid % NXCD, off = wgid / NXCD;
    wgid = (xcd < r ? xcd * (q + 1) : r * (q + 1) + (xcd - r) * q) + off; }
  const int nig = WGM * nN, gid = wgid / nig, fm = gid * WGM, gsz = min(nM - fm, WGM);
  pm = fm + ((wgid % nig) % gsz); pn = (wgid % nig) / gsz;
  return true;
}

__device__ __forceinline__ void gemm_phase(const bf16_t* __restrict__ A, const bf16_t* __restrict__ Bt, bf16_t* __restrict__ C, int M, int N, int K,
                                           int ldc, const int EPI, char* smem, const int wid_u) {
  const int nM = M / BM, nN = N / BM, nwg = nM * nN;
  const int tid = opaque_tid();
  LAS bf16_t* shm = (LAS bf16_t*)smem;
#define SA(b, h) (shm + ((b) * 2 + (h)) * HT)
#define SB(b, h) (shm + (4 + (b) * 2 + (h)) * HT)
#define STG(P, GB) do { const char* _gb = (GB); \
    _Pragma("unroll") for (int _i = 0; _i < 2; ++_i) { \
      __builtin_amdgcn_global_load_lds((const unsigned*)(_gb + voff[_i]), \
        (LAS unsigned*)((LAS char*)(P) + ldsw + _i * 8192), 16, 0, 0); } } while (0)
#define LDA(dst, b, h) _Pragma("unroll") for (int m = 0; m < 4; ++m) _Pragma("unroll") for (int k = 0; k < 2; ++k) \
    dst[m][k] = *(const LAS bf16x8*)((LAS char*)SA(b, h) + aoff + m * 2048 + k * 1024)
#define LDB(dst, b, h) _Pragma("unroll") for (int n = 0; n < 2; ++n) _Pragma("unroll") for (int k = 0; k < 2; ++k) \
    dst[n][k] = *(const LAS bf16x8*)((LAS char*)SB(b, h) + boff + n * 2048 + k * 1024)
#define MMA(ai, bj, At_, Bt_) do { __builtin_amdgcn_s_setprio(1); \
    _Pragma("unroll") for (int m = 0; m < 4; ++m) _Pragma("unroll") for (int n = 0; n < 2; ++n) _Pragma("unroll") for (int k = 0; k < 2; ++k) \
      acc[ai][bj][m][n] = __builtin_amdgcn_mfma_f32_16x16x32_bf16(Bt_[n][k], At_[m][k], acc[ai][bj][m][n], 0, 0, 0); \
    __builtin_amdgcn_s_setprio(0); } while (0)
#define WAIT_V(n) asm volatile("s_waitcnt vmcnt(" #n ")" ::: "memory")
#define WAIT_L(n) asm volatile("s_waitcnt lgkmcnt(" #n ")" ::: "memory")
#define BAR __builtin_amdgcn_s_barrier()
#define SCHED __builtin_amdgcn_sched_barrier(0)
  const int wid = __builtin_amdgcn_readfirstlane(tid >> 6), lane = tid & 63, wr = wid >> 2, wc = wid & 3, fr = lane & 15, fq = lane >> 4;
  const int aoff = lds_byte(wr * 64 + fr, fq * 8), boff = lds_byte(wc * 32 + fr, fq * 8);
  unsigned voff[2];
  const int ldsw = wid * 1024;
#pragma unroll
  for (int _i = 0; _i < 2; ++_i) { int _r, _c; stage_rc(tid * 16 + _i * 8192, _r, _c); voff[_i] = (unsigned)(_r * K + _c) * 2u; }
  const int nt = K / BK;
  const size_t kstep = (size_t)BK * 2, hstep = (size_t)HALF * K * 2, tstep = 2 * hstep;
  int pm, pn, npm = 0, npn = 0, ui = 0;
  if (!gemm_unit(0, nM, nN, nwg, pm, pn)) return;
  f32x4 acc[2][2][4][2];
#pragma unroll
  for (int a = 0; a < 2; ++a)
#pragma unroll
    for (int b = 0; b < 2; ++b)
#pragma unroll
      for (int m = 0; m < 4; ++m)
#pragma unroll
        for (int n = 0; n < 2; ++n) acc[a][b][m][n] = (f32x4){0.f, 0.f, 0.f, 0.f};
  bf16x8 At[4][2], B0[2][2], B1[2][2];
  const char* cA = (const char*)A + (size_t)pm * tstep;
  const char* cB = (const char*)Bt + (size_t)pn * tstep;
  STG(SB(0, 0), cB); STG(SA(0, 0), cA); STG(SB(0, 1), cB + hstep); STG(SA(0, 1), cA + hstep);
  if (wr == 1) BAR;
  WAIT_V(4); BAR;
  STG(SB(1, 0), cB + kstep); STG(SA(1, 0), cA + kstep); STG(SB(1, 1), cB + hstep + kstep);
  WAIT_V(6); BAR;
  for (;;) {
    const bool has_next = gemm_unit(ui + 1, nM, nN, nwg, npm, npn);
    const char* nA = has_next ? (const char*)A + (size_t)npm * tstep : cA;
    const char* nB = has_next ? (const char*)Bt + (size_t)npn * tstep : cB;
    for (int t = 0; t < nt; t += 2) {
      const bool last = (t == nt - 2);
      const char* a1 = cA + (size_t)(t + 1) * kstep;
      const char* a2 = last ? nA : cA + (size_t)(t + 2) * kstep;
      const char* b2 = last ? nB : cB + (size_t)(t + 2) * kstep;
      const char* a3 = a2 + kstep;
      const char* b3 = b2 + kstep;
      LDB(B0, 0, 0); SCHED; LDA(At, 0, 0); STG(SA(1, 1), a1 + hstep);
      WAIT_L(8); BAR; WAIT_L(0); MMA(0, 0, At, B0); BAR; SCHED;
      LDB(B1, 0, 1); STG(SB(0, 0), b2);
      BAR; WAIT_L(0); MMA(0, 1, At, B1); BAR;
      LDA(At, 0, 1); STG(SA(0, 0), a2);
      BAR; WAIT_L(0); MMA(1, 0, At, B0); BAR; SCHED;
      STG(SB(0, 1), b2 + hstep);
      WAIT_V(6); BAR; MMA(1, 1, At, B1); BAR;
      LDB(B0, 1, 0); SCHED; LDA(At, 1, 0); STG(SA(0, 1), a2 + hstep);
      WAIT_L(8); BAR; WAIT_L(0); MMA(0, 0, At, B0); BAR; SCHED;
      LDB(B1, 1, 1); STG(SB(1, 0), b3);
      BAR; WAIT_L(0); MMA(0, 1, At, B1); BAR;
      LDA(At, 1, 1); STG(SA(1, 0), a3);
      BAR; WAIT_L(0); MMA(1, 0, At, B0); BAR; SCHED;
      STG(SB(1, 1), b3 + hstep);
      WAIT_V(6); BAR; MMA(1, 1, At, B1); BAR;
    }
    {
      const int brow = pm * BM, bcol = pn * BM;
#pragma unroll
      for (int ai = 0; ai < 2; ++ai)
#pragma unroll
        for (int m = 0; m < 4; ++m) {
          const size_t row = (size_t)(brow + ai * HALF + wr * 64 + m * 16 + fr);
          if (EPI == 0) {
#pragma unroll
            for (int bj = 0; bj < 2; ++bj) {
              const f32x4 v0 = acc[ai][bj][m][0], v1 = acc[ai][bj][m][1];
              uint4 u; u.x = cvt_pk_bf16(v0[0], v0[1]); u.y = cvt_pk_bf16(v0[2], v0[3]); u.z = cvt_pk_bf16(v1[0], v1[1]); u.w = cvt_pk_bf16(v1[2], v1[3]);
              *(uint4*)(C + row * ldc + bcol + bj * HALF + wc * 32 + fq * 8) = u;
            }
          } else {
            float o[8];
#pragma unroll
            for (int n = 0; n < 2; ++n) {
              const f32x4 a = acc[ai][0][m][n], b = acc[ai][1][m][n];
#pragma unroll
              for (int j = 0; j < 4; ++j) o[n * 4 + j] = a[j] * __builtin_amdgcn_rcpf(1.f + __expf(-a[j])) * b[j];
            }
            *(uint4*)(C + row * ldc + (bcol >> 1) + wc * 32 + fq * 8) = pack8(o);
          }
        }
    }
    if (!has_next) break;
#pragma unroll
    for (int a = 0; a < 2; ++a)
#pragma unroll
      for (int b = 0; b < 2; ++b)
#pragma unroll
        for (int m = 0; m < 4; ++m)
#pragma unroll
          for (int n = 0; n < 2; ++n) acc[a][b][m][n] = (f32x4){0.f, 0.f, 0.f, 0.f};
    pm = npm; pn = npn; cA = nA; cB = nB; ++ui;
  }
  WAIT_V(0);
  if (wr == 0) BAR;
  BAR;
#undef SA
#undef SB
#undef STG
#undef LDA
#undef LDB
#undef MMA
}

__device__ __forceinline__ void load_shift16(const bf16_t* __restrict__ z, int row, int t, int T, int col, const float* __restrict__ mu, float* o) {
  const bf16_t* pz = z + (size_t)row * ZLD + col;
  uint4 c0 = *(const uint4*)pz, c1 = *(const uint4*)(pz + 8);
  uint4 p0 = make_uint4(0, 0, 0, 0), p1 = p0, n0 = p0, n1 = p0;
  if (t > 0) { p0 = *(const uint4*)(pz - ZLD); p1 = *(const uint4*)(pz - ZLD + 8); }
  if (t < T - 1) { n0 = *(const uint4*)(pz + ZLD); n1 = *(const uint4*)(pz + ZLD + 8); }
  float c[16], pv[16], nx[16];
  unpack8(c0, c); unpack8(c1, c + 8); unpack8(p0, pv); unpack8(p1, pv + 8); unpack8(n0, nx); unpack8(n1, nx + 8);
#pragma unroll
  for (int q = 0; q < 16; ++q) o[q] = c[q] + (0.5f * (pv[q] + nx[q]) - c[q]) * mu[col - 512 + q];
}
__device__ __forceinline__ void load_shift8(const bf16_t* __restrict__ z, int row, int t, int T, int col, const float* __restrict__ mu, float* o) {
  const bf16_t* pz = z + (size_t)row * ZLD + col;
  uint4 c0 = *(const uint4*)pz;
  uint4 p0 = make_uint4(0, 0, 0, 0), n0 = p0;
  if (t > 0) p0 = *(const uint4*)(pz - ZLD);
  if (t < T - 1) n0 = *(const uint4*)(pz + ZLD);
  float c[8], pv[8], nx[8];
  unpack8(c0, c); unpack8(p0, pv); unpack8(n0, nx);
#pragma unroll
  for (int q = 0; q < 8; ++q) o[q] = c[q] + (0.5f * (pv[q] + nx[q]) - c[q]) * mu[col - 512 + q];
}

constexpr int TC = 32;
constexpr int SV = TC * 64;
__device__ __forceinline__ void lora_prep_phase(PREF p, const int wid_u) {
  const int tid = opaque_tid();
  const bf16_t* z = P_RU;
  bf16_t* al = P_ALORA;
  const float* mu = p.shift_mu;
  for (int task = blockIdx.x * NTHR + tid; task < NTOK * 32; task += gridDim.x * NTHR) {
    const int row = task >> 5, oc = task & 31;
    int s, t, T;
    row_seq(row, s, t, T);
    float o[8];
    load_shift8(z, row, t, T, 2048 + oc * 8, mu, o);
    if (oc < 16) {
#pragma unroll
      for (int q = 0; q < 8; ++q) { const float e = __expf(2.f * o[q]); o[q] = 1.f - 2.f * __builtin_amdgcn_rcpf(e + 1.f); }
    }
    *(uint4*)(al + (size_t)row * 256 + oc * 8) = pack8(o);
  }
}

template <int HALF>
__device__ __forceinline__ void pool_seg(const bf16_t* __restrict__ z, bf16_t* __restrict__ mo, int row_base, int tbase, int T, int c0) {
  constexpr int NR = 2 * HALF + 3;
  float acc[4][8], zc[4][8];
#pragma unroll
  for (int i = 0; i < 4; ++i)
#pragma unroll
    for (int q = 0; q < 8; ++q) { acc[i][q] = 0.f; zc[i][q] = 0.f; }
#pragma unroll
  for (int r = 0; r < NR; ++r) {
    const int tt = tbase - HALF + r;
    uint4 u = make_uint4(0, 0, 0, 0);
    if (tt >= 0 && tt < T) u = *(const uint4*)(z + (size_t)(row_base - HALF + r) * ZLD + c0);
    float v[8];
    unpack8(u, v);
#pragma unroll
    for (int i = 0; i < 4; ++i) {
      if (r >= i && r < i + 2 * HALF) {
#pragma unroll
        for (int q = 0; q < 8; ++q) acc[i][q] += v[q];
      }
      if (r == HALF + i) {
#pragma unroll
        for (int q = 0; q < 8; ++q) zc[i][q] = v[q];
      }
    }
  }
#pragma unroll
  for (int i = 0; i < 4; ++i) {
    const int ti = tbase + i;
    const float ic = 1.f / (float)(min(ti + HALF, T) - max(ti - HALF, 0));
    float o[8];
#pragma unroll
    for (int q = 0; q < 8; ++q) o[q] = acc[i][q] * ic - zc[i][q];
    *(uint4*)(mo + (size_t)(row_base + i) * D + c0) = pack8(o);
  }
}
__device__ __forceinline__ void pool_tile(const bf16_t* __restrict__ z, bf16_t* __restrict__ mo, int tile, int tid) {
  const int row0 = tile * 32;
  int s, t0, T;
  row_seq(row0, s, t0, T);
  const int oc = tid >> 3, seg = tid & 7, c0 = oc * 8, grp = __builtin_amdgcn_readfirstlane(oc >> 4);
  const int rb = row0 + seg * 4, tb = t0 + seg * 4;
  if (grp == 0) pool_seg<1>(z, mo, rb, tb, T, c0);
  else if (grp == 1) pool_seg<2>(z, mo, rb, tb, T, c0);
  else if (grp == 2) pool_seg<4>(z, mo, rb, tb, T, c0);
  else pool_seg<8>(z, mo, rb, tb, T, c0);
}

struct Raw16 { uint4 c0, c1, p0, p1, n0, n1; };
__device__ __forceinline__ void load_raw16(Raw16& r, const bf16_t* __restrict__ z, int row, int t, int T, int col) {
  const bf16_t* pz = z + (unsigned)(row * ZLD + col);
  r.c0 = *(const uint4*)pz; r.c1 = *(const uint4*)(pz + 8);
  r.p0 = make_uint4(0, 0, 0, 0); r.p1 = r.p0; r.n0 = r.p0; r.n1 = r.p0;
  if (t > 0) { r.p0 = *(const uint4*)(pz - ZLD); r.p1 = *(const uint4*)(pz - ZLD + 8); }
  if (t < T - 1) { r.n0 = *(const uint4*)(pz + ZLD); r.n1 = *(const uint4*)(pz + ZLD + 8); }
}
__device__ __forceinline__ void shift16(const Raw16& r, const float* c1, const float* c2, float* o) {
  float c[16], pv[16], nx[16];
  unpack8(r.c0, c); unpack8(r.c1, c + 8); unpack8(r.p0, pv); unpack8(r.p1, pv + 8); unpack8(r.n0, nx); unpack8(r.n1, nx + 8);
#pragma unroll
  for (int q = 0; q < 16; ++q) o[q] = c[q] * c1[q] + (pv[q] + nx[q]) * c2[q];
}
__device__ __forceinline__ bf16x8 ldfrag(const bf16_t* base, int stride, int row0, int k0, int fr, int fq) {
  return *reinterpret_cast<const bf16x8*>(base + (row0 + fr) * stride + k0 + fq * 8);
}
__device__ __forceinline__ uint2 pack4(f32x4 v) { uint2 u; u.x = cvt_pk_bf16(v[0], v[1]); u.y = cvt_pk_bf16(v[2], v[3]); return u; }
#define MFMA16(a, b, c) __builtin_amdgcn_mfma_f32_16x16x32_bf16(a, b, c, 0, 0, 0)

constexpr int CS_NAB = 0, CS_NAK = 4096, CS_NBRT = 8192, CS_NKRT = 10752, CS_QT = 13312, CS_W = 15872, CS_Z = 20992, CS_GT = 26112,
              CS_RYT = 35328, CS_VN = 39936;
constexpr int CS_AT = 49152, CS_RT = CS_AT + 4608, CS_BT = CS_RT + 4608, CS_KT = CS_BT + 4608, CS_BB = 67584, CS_KB = CS_BB + 5120,
              CS_VT = CS_KB + 5120, CS_ATT = 82944, CS_PL = 92160, CS_SBF = 92416, CS_PRIV = 110848, CS_CST = 143616, CS_BL = 145920;

__device__ __forceinline__ void lds_barrier() {
  asm volatile("s_waitcnt lgkmcnt(0)" ::: "memory");
  __builtin_amdgcn_s_barrier();
  asm volatile("" ::: "memory");
}
template <int Q> __device__ __forceinline__ float quad_bcast(float x) { return dpp_f<Q * 0x55>(x); }

template <int S0> __device__ __forceinline__ void solve_steps(float (&x)[8], const float* nab, int seg) {
  if constexpr (S0 < 32) {
    const float xs = quad_bcast<(S0 >> 3)>(x[S0 & 7]);
    const f32x4 n0 = *(const f32x4*)(nab + S0 * 32 + seg * 8), n1 = *(const f32x4*)(nab + S0 * 32 + seg * 8 + 4);
    x[0] += xs * n0[0]; x[1] += xs * n0[1]; x[2] += xs * n0[2]; x[3] += xs * n0[3];
    x[4] += xs * n1[0]; x[5] += xs * n1[1]; x[6] += xs * n1[2]; x[7] += xs * n1[3];
    solve_steps<S0 + 1>(x, nab, seg);
  }
}

template <int S0> __device__ __forceinline__ void solve16(float (&x)[8], const float* nb) {
  if constexpr (S0 < 16) {
    const float xs = (S0 >> 3) ? dpp_f<0xF5>(x[S0 & 7]) : dpp_f<0xA0>(x[S0 & 7]);
    const f32x4 n0 = *(const f32x4*)(nb + S0 * 32), n1 = *(const f32x4*)(nb + S0 * 32 + 4);
    x[0] += xs * n0[0]; x[1] += xs * n0[1]; x[2] += xs * n0[2]; x[3] += xs * n0[3];
    x[4] += xs * n1[0]; x[5] += xs * n1[1]; x[6] += xs * n1[2]; x[7] += xs * n1[3];
    solve16<S0 + 1>(x, nb);
  }
}

__device__ __forceinline__ void scan_phase(PREF p, char* smem, const int wid_u) {
  float* stepbuf = (float*)smem;
  float* Nab = (float*)(smem + CS_NAB);
  bf16_t* NakT = (bf16_t*)(smem + CS_NAK);
  bf16_t* VNb = (bf16_t*)(smem + CS_VN);
  bf16_t* T11b = (bf16_t*)(smem + CS_VN + 5120);
  bf16_t* M1T = (bf16_t*)(smem + CS_VN + 5120 + 1280);
  bf16_t* NbrT = (bf16_t*)(smem + CS_NBRT);
  bf16_t* NkrT = (bf16_t*)(smem + CS_NKRT);
  bf16_t* TT = (bf16_t*)(smem + CS_QT);
  bf16_t* Wb = (bf16_t*)(smem + CS_W);
  bf16_t* Zb = (bf16_t*)(smem + CS_Z);
  bf16_t* GT = (bf16_t*)(smem + CS_GT);
  bf16_t* RyT = (bf16_t*)(smem + CS_RYT);
  bf16_t* At = (bf16_t*)(smem + CS_AT);
  bf16_t* Rt = (bf16_t*)(smem + CS_RT);
  bf16_t* Bt = (bf16_t*)(smem + CS_BT);
  bf16_t* Kt = (bf16_t*)(smem + CS_KT);
  bf16_t* Bb = (bf16_t*)(smem + CS_BB);
  bf16_t* Kb = (bf16_t*)(smem + CS_KB);
  bf16_t* VT = (bf16_t*)(smem + CS_VT);
  bf16_t* AtTb = (bf16_t*)(smem + CS_ATT);
  float* PLs = (float*)(smem + CS_PL);
  bf16_t* Sbf = (bf16_t*)(smem + CS_SBF);
  float* cst = (float*)(smem + CS_CST);
  const bf16_t* z = P_RU;
  const int tid = opaque_tid();
  const int wave = __builtin_amdgcn_readfirstlane(tid >> 6), lane = tid & 63, fr = lane & 15, fq = lane >> 4;
  const int item = blockIdx.x;
  if (item < 256) {
    const int s = item < 128 ? 8 + (item >> 4) : ((item - 128) >> 4);
    const int h = (item & 15) >> 1, d = item & 1;
    const int T = s < 8 ? 4096 : 8192, r0seq = seq_start(s), nch = T / 32;
    bf16_t* yout = P_RY + (size_t)d * NTOK * 512;
    {
      const int g = tid >> 6, k = tid & 63;
      const float muk = p.shift_mu[1024 - 512 + h * 64 + k], mur = p.shift_mu[512 - 512 + h * 64 + k], muv = p.shift_mu[1536 - 512 + h * 64 + k];
      float v;
      if (g == 0) v = 0.5f * muk;
      else if (g == 1) v = 0.5f * mur;
      else if (g == 2) v = 1.f - muk;
      else if (g == 3) v = 1.f - mur;
      else if (g == 4) v = 1.f - muv;
      else if (g == 5) v = p.k_k[h * 64 + k];
      else if (g == 6) v = p.k_a[h * 64 + k];
      else v = p.r_k[h * 64 + k];
      cst[g * 64 + k] = v;
      if (g == 0) cst[8 * 64 + k] = 0.5f * muv;
      for (int i = tid; i < 2 * 64 * 72 / 2; i += NTHR) ((unsigned*)Sbf)[i] = 0u;
    }
    const int role = wave >> 1, th = wave & 1;
    const int tl = lane >> 2, cq = lane & 3;
    float* tmpa = (float*)(smem + CS_PRIV + (wave & 3) * 8192 + 2560);
    uint4* Blds = (uint4*)(smem + CS_BL) + (role & 1) * 512;
    float bias[4] = {0.f, 0.f, 0.f, 0.f};
    if (role < 2) {
      const float* lsrc = sel(role != 0, p.a2, p.w2) + (size_t)d * 64 * 512 + h * 64;
      if (th == 0) {
#pragma unroll
        for (int nt = 0; nt < 4; ++nt)
#pragma unroll
          for (int ks = 0; ks < 2; ++ks) {
            float o[8];
#pragma unroll
            for (int q = 0; q < 8; ++q) o[q] = lsrc[(size_t)(ks * 32 + fq * 8 + q) * 512 + nt * 16 + fr];
            Blds[(nt * 2 + ks) * 64 + lane] = pack8(o);
          }
      }
#pragma unroll
      for (int nt = 0; nt < 4; ++nt) bias[nt] = sel(role != 0, p.a0, p.w0)[d * 512 + h * 64 + nt * 16 + fr];
    }
    const int colA = 512 + h * 64 + cq * 16;
    const int colB = (role == 1 ? 1024 : 1536) + h * 64 + cq * 16;
    const int alo = (role == 0 ? d * 64 : 128 + d * 64) + fq * 8;
    Raw16 ra, rb;
    {
      const int j = th * 16 + tl, t = d ? T - 1 - j : j, row = r0seq + t;
      if (role == 2) load_raw16(ra, z, row, t, T, colA);
      if (role == 1 || role == 2) load_raw16(rb, z, row, t, T, colB);
      if (role < 2) {
        const int j2 = th * 16 + fr, t2 = d ? T - 1 - j2 : j2;
        const bf16_t* ap = P_ALORA + (unsigned)((r0seq + t2) * 256 + alo);
        ra.c0 = *(const uint4*)ap; ra.c1 = *(const uint4*)(ap + 32);
      }
    }
    f32x4 Sa = {0.f, 0.f, 0.f, 0.f}, Sb = Sa;
    uint2 y_def = make_uint2(0u, 0u);
    float sb_def = 0.f;
    const int mt = wave >> 1, hn = wave & 1, nt0 = 2 * hn, nt1 = 2 * hn + 1;
    __syncthreads();

    for (int c = 0; c < nch; ++c) {
      if (role < 3) {
        const int j = th * 16 + tl;
        const int istep = c * 32 + j;
        const int t = d ? T - 1 - istep : istep;
        const int row = r0seq + t;
        float v16[16];
        if (role < 2) {
          f32x4 acc[4] = {};
#pragma unroll
          for (int ks = 0; ks < 2; ++ks) {
            const uint4 au = ks == 0 ? ra.c0 : ra.c1;
            const bf16x8 a = *reinterpret_cast<const bf16x8*>(&au);
#pragma unroll
            for (int nt = 0; nt < 4; ++nt) { const uint4 bu = Blds[(nt * 2 + ks) * 64 + lane]; acc[nt] = MFMA16(a, *reinterpret_cast<const bf16x8*>(&bu), acc[nt]); }
          }
          if (role == 0) {
#pragma unroll
            for (int nt = 0; nt < 4; ++nt)
#pragma unroll
              for (int jj = 0; jj < 4; ++jj) {
                const float sg = sigmoidf_(bias[nt] + acc[nt][jj]);
                stepbuf[0 * SV + (th * 16 + fq * 4 + jj) * 64 + nt * 16 + fr] = __expf(-0.6065306597126334f * sg);
              }
            __builtin_amdgcn_wave_barrier();
            {
              float wl[16];
#pragma unroll
              for (int i = 0; i < 16; ++i) wl[i] = stepbuf[0 * SV + (th * 16 + i) * 64 + lane];
              float pr = 1.f;
#pragma unroll
              for (int i = 0; i < 16; ++i) { pr *= wl[i]; stepbuf[0 * SV + (th * 16 + i) * 64 + lane] = pr; }
            }
          } else {
#pragma unroll
            for (int nt = 0; nt < 4; ++nt)
#pragma unroll
              for (int jj = 0; jj < 4; ++jj) tmpa[(fq * 4 + jj) * 68 + nt * 16 + fr] = sigmoidf_(bias[nt] + acc[nt][jj]);
            __builtin_amdgcn_wave_barrier();
            float av[16], kd[16];
#pragma unroll
            for (int q = 0; q < 4; ++q) { f32x4 a4 = *(const f32x4*)(tmpa + tl * 68 + cq * 16 + q * 4); av[q * 4] = a4[0]; av[q * 4 + 1] = a4[1]; av[q * 4 + 2] = a4[2]; av[q * 4 + 3] = a4[3]; }
            shift16(rb, cst + 2 * 64 + cq * 16, cst + 0 * 64 + cq * 16, v16);
            float kk[16], ss = 0.f;
#pragma unroll
            for (int q = 0; q < 16; ++q) { kk[q] = v16[q] * cst[5 * 64 + cq * 16 + q]; ss += kk[q] * kk[q]; }
            ss = quad_sum(ss);
            const float inv = 1.f / fmaxf(sqrtf(ss), 1e-12f);
#pragma unroll
            for (int q = 0; q < 16; ++q) { kk[q] *= inv; kd[q] = v16[q] * (1.f + (av[q] - 1.f) * cst[6 * 64 + cq * 16 + q]); }
#pragma unroll
            for (int q = 0; q < 4; ++q) {
              *(f32x4*)(stepbuf + 3 * SV + j * 64 + cq * 16 + q * 4) = (f32x4){-kk[q * 4], -kk[q * 4 + 1], -kk[q * 4 + 2], -kk[q * 4 + 3]};
              *(f32x4*)(stepbuf + 4 * SV + j * 64 + cq * 16 + q * 4) = (f32x4){kk[q * 4] * av[q * 4], kk[q * 4 + 1] * av[q * 4 + 1], kk[q * 4 + 2] * av[q * 4 + 2], kk[q * 4 + 3] * av[q * 4 + 3]};
              *(f32x4*)(stepbuf + 1 * SV + j * 64 + cq * 16 + q * 4) = (f32x4){kd[q * 4], kd[q * 4 + 1], kd[q * 4 + 2], kd[q * 4 + 3]};
            }
          }
        } else {
          shift16(ra, cst + 3 * 64 + cq * 16, cst + 1 * 64 + cq * 16, v16);
#pragma unroll
          for (int q = 0; q < 4; ++q) *(f32x4*)(stepbuf + 2 * SV + j * 64 + cq * 16 + q * 4) = (f32x4){v16[q * 4], v16[q * 4 + 1], v16[q * 4 + 2], v16[q * 4 + 3]};
          shift16(rb, cst + 4 * 64 + cq * 16, cst + 8 * 64 + cq * 16, v16);
#pragma unroll
          for (int q = 0; q < 4; ++q) *(f32x4*)(stepbuf + 5 * SV + j * 64 + cq * 16 + q * 4) = (f32x4){v16[q * 4], v16[q * 4 + 1], v16[q * 4 + 2], v16[q * 4 + 3]};
        }
      }
      if (c > 0) {
        const int ip = (c - 1) * 32 + hn * 16 + fr, tp = d ? T - 1 - ip : ip;
        *(uint2*)(yout + (size_t)(r0seq + tp) * 512 + h * 64 + mt * 16 + fq * 4) = y_def;
        if (role == 2 && cq == 0) { const int is_ = (c - 1) * 32 + th * 16 + tl, tg = d ? T - 1 - is_ : is_; P_SBON[((size_t)(r0seq + tg) * 8 + h) * 2 + d] = sb_def; }
      }
      if (role < 3 && c + 1 < nch) {
        const int is2 = (c + 1) * 32 + th * 16 + tl;
        const int t2 = d ? T - 1 - is2 : is2;
        const int row2 = r0seq + t2;
        if (role == 2) load_raw16(ra, z, row2, t2, T, colA);
        if (role >= 1) load_raw16(rb, z, row2, t2, T, colB);
        if (role < 2) {
          const int is3 = (c + 1) * 32 + th * 16 + fr, t3 = d ? T - 1 - is3 : is3;
          const bf16_t* ap = P_ALORA + (unsigned)((r0seq + t3) * 256 + alo);
          ra.c0 = *(const uint4*)ap; ra.c1 = *(const uint4*)(ap + 32);
        }
      }
      lds_barrier();
      {
        const int k = lane, seg = wave;
        const float* sw = stepbuf + 0 * SV + k;
        const float P15 = sw[15 * 64];
        const float hiF = seg >= 4 ? P15 : 1.f;
        float P[5];
        P[0] = seg == 0 ? 1.f : sw[(4 * seg - 1) * 64] * (seg > 4 ? P15 : 1.f);
#pragma unroll
        for (int i = 0; i < 4; ++i) P[i + 1] = sw[(4 * seg + i) * 64] * hiF;
        const float PL = sw[31 * 64] * P15;
        if (role == 2) {
          const int j = th * 16 + tl;
          float bs = 0.f;
#pragma unroll
          for (int q = 0; q < 16; ++q) bs += stepbuf[2 * SV + j * 64 + cq * 16 + q] * stepbuf[1 * SV + j * 64 + cq * 16 + q] * cst[7 * 64 + cq * 16 + q];
          bs = quad_sum(bs);
          sb_def = bs;
        }
        f32x4 bb, kb, at, vv;
#pragma unroll
        for (int i = 0; i < 4; ++i) {
          const int t = 4 * seg + i;
          const float inv = __builtin_amdgcn_rcpf(P[i + 1]);
          const float a_ = P[i] * stepbuf[3 * SV + t * 64 + k];
          const float rraw = stepbuf[2 * SV + t * 64 + k], kraw = stepbuf[1 * SV + t * 64 + k];
          const float r_ = P[i + 1] * rraw;
          const float b_ = stepbuf[4 * SV + t * 64 + k] * inv;
          const float k_ = kraw * inv;

          At[t * 72 + k] = (bf16_t)(cvt_pk_bf16(a_, 0.f) & 0xffff);
          Rt[t * 72 + k] = (bf16_t)(cvt_pk_bf16(r_, 0.f) & 0xffff);
          Bt[t * 72 + k] = (bf16_t)(cvt_pk_bf16(b_, 0.f) & 0xffff);
          Kt[t * 72 + k] = (bf16_t)(cvt_pk_bf16(k_, 0.f) & 0xffff);
          bb[i] = b_ * PL; kb[i] = k_ * PL; at[i] = a_;
          vv[i] = stepbuf[5 * SV + t * 64 + k];
        }
        *(uint2*)(Bb + k * 40 + 4 * seg) = pack4(bb);
        *(uint2*)(Kb + k * 40 + 4 * seg) = pack4(kb);
        *(uint2*)(VT + k * 40 + 4 * seg) = pack4(vv);
        *(uint2*)(AtTb + k * 40 + 4 * seg) = pack4(at);
        if (seg == 0) PLs[k] = PL;
      }
      lds_barrier();
      {
        const int mat = wave >> 1, mts = wave & 1;
        const bf16_t* As = (mat & 1) ? Kt : Bt;
        const bf16_t* Bs = (mat & 2) ? Rt : At;
        f32x4 acc[2] = {};
#pragma unroll
        for (int ks = 0; ks < 2; ++ks) {
          const bf16x8 a = ldfrag(As, 72, mts * 16, ks * 32, fr, fq);
#pragma unroll
          for (int nt = 0; nt < 2; ++nt) acc[nt] = MFMA16(a, ldfrag(Bs, 72, nt * 16, ks * 32, fr, fq), acc[nt]);
        }
#pragma unroll
        for (int nt = 0; nt < 2; ++nt) {
          const int tcol = nt * 16 + fr;
          f32x4 v = acc[nt];
#pragma unroll
          for (int jj = 0; jj < 4; ++jj) {
            const int srow = mts * 16 + fq * 4 + jj;
            const bool keep = (mat & 2) ? (srow <= tcol) : (srow < tcol);
            v[jj] = keep ? v[jj] : 0.f;
          }
          if (mat == 0) {
#pragma unroll
            for (int jj = 0; jj < 4; ++jj) Nab[(mts * 16 + fq * 4 + jj) * 32 + tcol] = v[jj];
          } else {
            bf16_t* dst = mat == 1 ? NakT : mat == 2 ? NbrT : NkrT;
            *(uint2*)(dst + tcol * 40 + mts * 16 + fq * 4) = pack4(v);
          }
        }
      }
      lds_barrier();
      if (wave == 0) {
        const int irow = lane >> 1, hb = lane & 1, blk = lane >> 5, il = irow & 15;
        float x[8];
#pragma unroll
        for (int i = 0; i < 8; ++i) x[i] = (hb * 8 + i == il) ? 1.f : 0.f;
        const float* nb = Nab + (blk * 16) * 32 + blk * 16 + hb * 8;
        solve16<0>(x, nb);
#pragma unroll
        for (int i = 0; i < 8; ++i) TT[(blk * 16 + hb * 8 + i) * 40 + blk * 16 + il] = (bf16_t)(cvt_pk_bf16(x[i], 0.f) & 0xffff);
        if (blk == 0) *(uint4*)(T11b + il * 40 + hb * 8) = pack8(x);
        __builtin_amdgcn_wave_barrier();
        const f32x4 zero = {0.f, 0.f, 0.f, 0.f};
        bf16x8 zf;
#pragma unroll
        for (int i = 0; i < 8; ++i) zf[i] = 0;
        bf16x8 n12 = zf, t22 = zf, t11 = zf;
        if (fq < 2) {
          float o[8];
          const f32x4 n0 = *(const f32x4*)(Nab + fr * 32 + 16 + fq * 8), n1 = *(const f32x4*)(Nab + fr * 32 + 16 + fq * 8 + 4);
          o[0] = n0[0]; o[1] = n0[1]; o[2] = n0[2]; o[3] = n0[3]; o[4] = n1[0]; o[5] = n1[1]; o[6] = n1[2]; o[7] = n1[3];
          uint4 u = pack8(o);
          n12 = *reinterpret_cast<bf16x8*>(&u);
          t22 = *reinterpret_cast<const bf16x8*>(TT + (16 + fr) * 40 + 16 + fq * 8);
          t11 = *reinterpret_cast<const bf16x8*>(T11b + fr * 40 + fq * 8);
        }
        const f32x4 m1 = MFMA16(n12, t22, zero);
        *(uint2*)(M1T + fr * 40 + fq * 4) = pack4(m1);
        __builtin_amdgcn_wave_barrier();
        bf16x8 m1f = zf;
        if (fq < 2) m1f = *reinterpret_cast<const bf16x8*>(M1T + fr * 40 + fq * 8);
        const f32x4 t12 = MFMA16(t11, m1f, zero);
        *(uint2*)(TT + (16 + fr) * 40 + fq * 4) = pack4(t12);
      } else if (wave == 1) {
        unsigned z0;
        asm volatile("v_mov_b32 %0, 0" : "=v"(z0));
        *(uint2*)(TT + (lane >> 2) * 40 + 16 + (lane & 3) * 4) = make_uint2(z0, z0);
      } else if (wave < 6) {
        const int vtile = wave - 2;
        const bf16x8 vf = ldfrag(VT, 40, vtile * 16, 0, fr, fq);
        const f32x4 zero = {0.f, 0.f, 0.f, 0.f};
#pragma unroll
        for (int tt = 0; tt < 2; ++tt) {
          const f32x4 acc = MFMA16(ldfrag(NakT, 40, tt * 16, 0, fr, fq), vf, zero);
          *(uint2*)(VNb + (vtile * 16 + fr) * 40 + tt * 16 + fq * 4) = pack4(acc);
        }
      }
      lds_barrier();
      {
        const int tt = wave & 1, rt = wave >> 1;
        const f32x4 zero = {0.f, 0.f, 0.f, 0.f};
        const bf16x8 tf = ldfrag(TT, 40, tt * 16, 0, fr, fq);
        const f32x4 zacc = MFMA16(tf, ldfrag(VNb, 40, rt * 16, 0, fr, fq), zero);
        const f32x4 wacc = MFMA16(tf, ldfrag(AtTb, 40, rt * 16, 0, fr, fq), zero);
        *(uint2*)(Zb + (rt * 16 + fr) * 40 + tt * 16 + fq * 4) = pack4(zacc);
        *(uint2*)(Wb + (rt * 16 + fr) * 40 + tt * 16 + fq * 4) = pack4(wacc);
      }
      lds_barrier();
      f32x4 yacc = {0.f, 0.f, 0.f, 0.f};
      {
        const float pl0 = PLs[nt0 * 16 + fr], pl1 = PLs[nt1 * 16 + fr];
        Sa = Sa * pl0; Sb = Sb * pl1;
        const bf16x8 zf = ldfrag(Zb, 40, mt * 16, 0, fr, fq), vf = ldfrag(VT, 40, mt * 16, 0, fr, fq), wf = ldfrag(Wb, 40, mt * 16, 0, fr, fq);
        const bf16x8 bb0 = ldfrag(Bb, 40, nt0 * 16, 0, fr, fq), bb1 = ldfrag(Bb, 40, nt1 * 16, 0, fr, fq);
        const bf16x8 kb0 = ldfrag(Kb, 40, nt0 * 16, 0, fr, fq), kb1 = ldfrag(Kb, 40, nt1 * 16, 0, fr, fq);
        const bf16x8 nbr = ldfrag(NbrT, 40, hn * 16, 0, fr, fq), nkr = ldfrag(NkrT, 40, hn * 16, 0, fr, fq);
        Sa = MFMA16(zf, bb0, Sa); Sa = MFMA16(vf, kb0, Sa);
        Sb = MFMA16(zf, bb1, Sb); Sb = MFMA16(vf, kb1, Sb);
        yacc = MFMA16(zf, nbr, yacc); yacc = MFMA16(vf, nkr, yacc);
        const f32x4 zero = {0.f, 0.f, 0.f, 0.f};
        const f32x4 g0 = MFMA16(wf, bb0, zero), g1 = MFMA16(wf, bb1, zero);
        f32x4 ry = MFMA16(wf, nbr, zero);
        *(uint2*)(GT + (nt0 * 16 + fr) * 72 + mt * 16 + fq * 4) = pack4(g0);
        *(uint2*)(GT + (nt1 * 16 + fr) * 72 + mt * 16 + fq * 4) = pack4(g1);
        const uint2 rr = *(const uint2*)(Rt + (hn * 16 + fr) * 72 + mt * 16 + fq * 4);
        ry[0] += bf_lo(rr.x); ry[1] += bf_hi(rr.x); ry[2] += bf_lo(rr.y); ry[3] += bf_hi(rr.y);
        *(uint2*)(RyT + (hn * 16 + fr) * 72 + mt * 16 + fq * 4) = pack4(ry);
      }
      lds_barrier();
      {
        const bf16_t* Scur = Sbf + (c & 1) * 64 * 72;
        bf16_t* Snext = Sbf + ((c + 1) & 1) * 64 * 72;
#pragma unroll
        for (int ks = 0; ks < 2; ++ks) {
          const bf16x8 af = ldfrag(Scur, 72, mt * 16, ks * 32, fr, fq);
          Sa = MFMA16(af, ldfrag(GT, 72, nt0 * 16, ks * 32, fr, fq), Sa);
          Sb = MFMA16(af, ldfrag(GT, 72, nt1 * 16, ks * 32, fr, fq), Sb);
          yacc = MFMA16(af, ldfrag(RyT, 72, hn * 16, ks * 32, fr, fq), yacc);
        }
        y_def = pack4(yacc);
#pragma unroll
        for (int jj = 0; jj < 4; ++jj) {
          Snext[(mt * 16 + fq * 4 + jj) * 72 + nt0 * 16 + fr] = (bf16_t)(cvt_pk_bf16(Sa[jj], 0.f) & 0xffff);
          Snext[(mt * 16 + fq * 4 + jj) * 72 + nt1 * 16 + fr] = (bf16_t)(cvt_pk_bf16(Sb[jj], 0.f) & 0xffff);
        }
      }
      lds_barrier();
    }
    {
      const int ip = (nch - 1) * 32 + hn * 16 + fr, tp = d ? T - 1 - ip : ip;
      *(uint2*)(yout + (size_t)(r0seq + tp) * 512 + h * 64 + mt * 16 + fq * 4) = y_def;
      if (role == 2 && cq == 0) { const int is_ = (nch - 1) * 32 + th * 16 + tl, tg = d ? T - 1 - is_ : is_; P_SBON[((size_t)(r0seq + tg) * 8 + h) * 2 + d] = sb_def; }
    }
  }
  if (item >= 128) {
    const int nb = gridDim.x - 128;
    for (int tile = item - 128; tile < NTOK / 32; tile += nb) pool_tile(z, P_RH, tile, tid);
  }
}

__device__ __forceinline__ void post_phase(PREF p, char* smem, const int wid_u) {
  bf16_t* Ag = (bf16_t*)smem;
  bf16_t* vt = (bf16_t*)(smem + 12800);
  float* ys = (float*)(smem + 12800 + 33280);
  const bf16_t* z = P_RU;
  const bf16_t* yf = P_RY;
  const bf16_t* ybk = P_RY + (size_t)NTOK * 512;
  bf16_t* mo = P_RH;
  const int tid = opaque_tid(), w = tid >> 6, lane = tid & 63, fr = lane & 15, fq = lane >> 4;
  bf16x8 Bg[4][6];
#pragma unroll
  for (int nt = 0; nt < 4; ++nt)
#pragma unroll
    for (int ks = 0; ks < 6; ++ks) {
      float o[8];
#pragma unroll
      for (int q = 0; q < 8; ++q) { const int k = ks * 32 + fq * 8 + q; o[q] = k < 160 ? p.g2[(size_t)k * 512 + w * 64 + nt * 16 + fr] : 0.f; }
      uint4 u = pack8(o);
      Bg[nt][ks] = *reinterpret_cast<bf16x8*>(&u);
    }
  float lng[4], lnb[4];
#pragma unroll
  for (int nt = 0; nt < 4; ++nt) { lng[nt] = p.lnx_g[w * 64 + nt * 16 + fr]; lnb[nt] = p.lnx_b[w * 64 + nt * 16 + fr]; }

  for (int tile = blockIdx.x; tile < NTOK / 32; tile += gridDim.x) {
    const int row0 = tile * 32;
    int s, t0, T;
    row_seq(row0, s, t0, T);
    for (int idx = tid; idx < 32 * 24; idx += NTHR) {
      const int tok = idx / 24, oc = idx % 24;
      float o[8];
      if (oc < 20) {
        load_shift8(z, row0 + tok, t0 + tok, T, 2304 + oc * 8, p.shift_mu, o);
#pragma unroll
        for (int q = 0; q < 8; ++q) o[q] = sigmoidf_(o[q]);
      } else {
#pragma unroll
        for (int q = 0; q < 8; ++q) o[q] = 0.f;
      }
      *(uint4*)(Ag + tok * 200 + oc * 8) = pack8(o);
    }
#pragma unroll 1
    for (int half_ = 0; half_ < 2; ++half_) {
      uint4 zc[2], zp[2], zn[2], ya[2], yb4[2];
#pragma unroll
      for (int i = 0; i < 2; ++i) {
        const int idx = tid + (half_ * 2 + i) * NTHR, tok = idx >> 6, oc = idx & 63, row = row0 + tok, t = t0 + tok;
        const bf16_t* pz = z + (size_t)row * ZLD + 1536 + oc * 8;
        zc[i] = *(const uint4*)pz;
        zp[i] = make_uint4(0, 0, 0, 0); zn[i] = zp[i];
        if (t > 0) zp[i] = *(const uint4*)(pz - ZLD);
        if (t < T - 1) zn[i] = *(const uint4*)(pz + ZLD);
        ya[i] = *(const uint4*)(yf + (size_t)row * 512 + oc * 8);
        yb4[i] = *(const uint4*)(ybk + (size_t)row * 512 + oc * 8);
      }
#pragma unroll
      for (int i = 0; i < 2; ++i) {
        const int idx = tid + (half_ * 2 + i) * NTHR, tok = idx >> 6, oc = idx & 63;
        float c[8], pv[8], nx[8], o[8];
        unpack8(zc[i], c); unpack8(zp[i], pv); unpack8(zn[i], nx);
#pragma unroll
        for (int q = 0; q < 8; ++q) o[q] = c[q] + (0.5f * (pv[q] + nx[q]) - c[q]) * p.shift_mu[1536 - 512 + oc * 8 + q];
        *(uint4*)(vt + tok * 520 + oc * 8) = pack8(o);
        float a[8], b[8];
        unpack8(ya[i], a); unpack8(yb4[i], b);
        *(f32x4*)(ys + tok * 516 + oc * 8) = (f32x4){a[0] + b[0], a[1] + b[1], a[2] + b[2], a[3] + b[3]};
        *(f32x4*)(ys + tok * 516 + oc * 8 + 4) = (f32x4){a[4] + b[4], a[5] + b[5], a[6] + b[6], a[7] + b[7]};
      }
    }
    __syncthreads();
    f32x4 acc[2][4] = {};
#pragma unroll
    for (int ks = 0; ks < 6; ++ks) {
      bf16x8 a[2];
#pragma unroll
      for (int mt = 0; mt < 2; ++mt) a[mt] = *reinterpret_cast<const bf16x8*>(Ag + (mt * 16 + fr) * 200 + ks * 32 + fq * 8);
#pragma unroll
      for (int mt = 0; mt < 2; ++mt)
#pragma unroll
        for (int nt = 0; nt < 4; ++nt) acc[mt][nt] = __builtin_amdgcn_mfma_f32_16x16x32_bf16(a[mt], Bg[nt][ks], acc[mt][nt], 0, 0, 0);
    }
#pragma unroll
    for (int mt = 0; mt < 2; ++mt)
#pragma unroll
      for (int jj = 0; jj < 4; ++jj) {
        const int tok = mt * 16 + fq * 4 + jj, row = row0 + tok;
        float yv[4], sm_ = 0.f;
#pragma unroll
        for (int nt = 0; nt < 4; ++nt) { yv[nt] = ys[tok * 516 + w * 64 + nt * 16 + fr]; sm_ += yv[nt]; }
        const float mean = row16_sum(sm_) * (1.f / 64.f);
        float vs = 0.f;
#pragma unroll
        for (int nt = 0; nt < 4; ++nt) { yv[nt] -= mean; vs += yv[nt] * yv[nt]; }
        const float rs = rsqrtf(row16_sum(vs) * (1.f / 64.f) + 64e-5f);
        const float2 sb2 = *(const float2*)(P_SBON + ((size_t)row * 8 + w) * 2);
        const float sbs = sb2.x + sb2.y;
#pragma unroll
        for (int nt = 0; nt < 4; ++nt) {
          const float vv = bf2f(vt[tok * 520 + w * 64 + nt * 16 + fr]);
          const float o = (yv[nt] * rs * lng[nt] + lnb[nt] + sbs * vv) * acc[mt][nt][jj];
          mo[(size_t)row * D + 512 + w * 64 + nt * 16 + fr] = (bf16_t)(cvt_pk_bf16(o, 0.f) & 0xffff);
        }
      }
    __syncthreads();
  }
}

#define XB_TMO      128
#define XB_XCNT(j)  (256  + 64 * (j))
#define XB_XSUB(j)  (1280 + 64 * (j))
#define XB_XGEN(j)  (2304 + 64 * (j))
#define XB_TOP      3328
#define XB_TOPGEN   3392
#define XCD_BAR_WORDS 3456
#define XB_SPIN_CAP (1u << 22)
__device__ __forceinline__ unsigned xb_ld(unsigned* p)              { return __hip_atomic_load(p, __ATOMIC_RELAXED, __HIP_MEMORY_SCOPE_AGENT); }
__device__ __forceinline__ unsigned xb_add(unsigned* p, unsigned v) { return __hip_atomic_fetch_add(p, v, __ATOMIC_RELAXED, __HIP_MEMORY_SCOPE_AGENT); }
__device__ __forceinline__ unsigned xb_xcc_id() { return (unsigned)__builtin_amdgcn_s_getreg((3 << 11) | 20) & 0xFu; }
#define XB_SPIN(cond, bar) do { unsigned _sp = 0; while (cond) { __builtin_amdgcn_s_sleep(1); \
    if ((++_sp & 255u) == 0u) { if (xb_ld(&(bar)[XB_TMO])) break; if (_sp > XB_SPIN_CAP) { atomicAdd(&(bar)[XB_TMO], 1u); break; } } } } while (0)
struct XcdBarrier { unsigned* bar; unsigned x; volatile LAS unsigned* st; };
__device__ __forceinline__ void xcd_barrier_complete(unsigned* bar, unsigned x, unsigned& nloc, unsigned& nx) {
  const unsigned G = gridDim.x * gridDim.y * gridDim.z;
  unsigned sum, cnt, mine, sp = 0u;
  for (;;) {
    sum = 0u; cnt = 0u; mine = 0u;
#pragma unroll
    for (unsigned j = 0; j < 16; ++j) { const unsigned c = xb_ld(&bar[XB_XCNT(j)]); sum += c; cnt += (c > 0u) ? 1u : 0u; mine = (j == x) ? c : mine; }
    if (sum == G) break;
    __builtin_amdgcn_s_sleep(1);
    if ((++sp & 255u) == 0u) { if (xb_ld(&bar[XB_TMO])) break; if (sp > XB_SPIN_CAP) { atomicAdd(&bar[XB_TMO], 1u); break; } }
  }
  nloc = mine > 0u ? mine : 1u; nx = cnt > 0u ? cnt : 1u;
}
__device__ __forceinline__ void xcd_barrier(PREF p, volatile LAS unsigned* st_, const int wid_u) {
  asm volatile("s_waitcnt vmcnt(0)" ::: "memory");
  __syncthreads();
  if (opaque_tid() == 0) {
    XcdBarrier b; b.bar = (unsigned*)(p.ws + OFF_BAR); b.x = xb_xcc_id(); b.st = st_;
    unsigned* bar = b.bar;
    __builtin_amdgcn_s_waitcnt(0);
    unsigned nloc = b.st[0], nx = b.st[1];
    if (nloc == 0u) { xcd_barrier_complete(bar, b.x, nloc, nx); b.st[0] = nloc; b.st[1] = nx; }
    const unsigned old = xb_add(&bar[XB_XSUB(b.x)], 1u);
    const unsigned gen = old / nloc;
    if (old + 1u == (gen + 1u) * nloc) {
      __builtin_amdgcn_fence(__ATOMIC_RELEASE, "agent");
      asm volatile("s_waitcnt vmcnt(0)" ::: "memory");
      const unsigned og = xb_add(&bar[XB_TOP], 1u);
      const unsigned tg = og / nx;
      if (og + 1u == (tg + 1u) * nx) xb_add(&bar[XB_TOPGEN], 1u);
      else XB_SPIN(xb_ld(&bar[XB_TOPGEN]) == tg, bar);
      __builtin_amdgcn_fence(__ATOMIC_ACQUIRE, "agent");
      xb_add(&bar[XB_XGEN(b.x)], 1u);
      asm volatile("s_waitcnt vmcnt(0)" ::: "memory");
    } else {
      XB_SPIN(xb_ld(&bar[XB_XGEN(b.x)]) == gen, bar);
      __builtin_amdgcn_fence(__ATOMIC_ACQUIRE, "agent");
      asm volatile("s_waitcnt vmcnt(0)" ::: "memory");
    }
  }
  __syncthreads();
}

constexpr int NPHASE = 14;
__device__ __forceinline__ void do_phase(PREF p, int ph, char* smem, const int wid_u) {
  if (ph == 0) prep_phase(p, smem, wid_u);
  else if (ph == 1) row_phase<0>(p.x_prompt, p.x_sample, nullptr, nullptr, P_RH, P_MOD, nullptr, p.n1_pre, 0, 0.f, 0, wid_u);
  else if (ph == 4 || ph == 10) {
    const bool f = ph == 4;
    float* outp = p.out;
    row_phase<1>(sel(f, p.x_prompt, (const float*)outp), sel(f, p.x_sample, (const float*)(outp + (size_t)NPROMPT * D)), outp, P_RY, P_RH, P_MOD,
                 sel(f, p.n1_post, p.nm_post), sel(f, p.nm_pre, p.n2_pre), f ? 2 : 5, f ? 0.5f : 1.0f, f ? 3 : 6, wid_u, !f);
  }
  else if (ph == 13) row_phase<2>(p.out, p.out + (size_t)NPROMPT * D, p.out, P_RY, nullptr, P_MOD, p.n2_post, nullptr, 8, 0.5f, 0, wid_u, true);
  else if (ph == 6) lora_prep_phase(p, wid_u);
  else if (ph == 7) scan_phase(p, smem, wid_u);
  else if (ph == 8) post_phase(p, smem, wid_u);
  else {
    const bf16_t *A, *Bt; bf16_t* C; int N, K, ldc, epi;
    if (ph == 2 || ph == 11) { A = P_RH; Bt = sel(ph == 2, P_W13A, P_W13B); C = P_RU; N = 2 * FF; K = D; ldc = FF; epi = 1; }
    else if (ph == 3 || ph == 12) { A = P_RU; Bt = sel(ph == 3, P_W2A, P_W2B); C = P_RY; N = D; K = FF; ldc = D; epi = 0; }
    else if (ph == 5) { A = P_RH; Bt = P_WINT; C = P_RU; N = ZLD; K = D; ldc = ZLD; epi = 0; }
    else { A = P_RH; Bt = P_WOUTT; C = P_RY; N = D; K = D; ldc = D; epi = 0; }
    gemm_phase(A, Bt, C, NTOK, N, K, ldc, epi, smem, wid_u);
  }
}

extern __shared__ __attribute__((aligned(16))) char dyn_smem[];

__global__ void __launch_bounds__(NTHR, 2) mega_kernel(Params p) {
  cg::grid_group grid = cg::this_grid();
  const int wid_u = __builtin_amdgcn_readfirstlane(threadIdx.x >> 6);
  typedef const __attribute__((address_space(4))) Params* KP;
  const KP kp0 = (KP)__builtin_amdgcn_kernarg_segment_ptr();
  volatile LAS unsigned* st = (volatile LAS unsigned*)((LAS char*)dyn_smem + (SMEM_BYTES - 16));
  if (threadIdx.x < 2) st[threadIdx.x] = 0u;
  __syncthreads();
  if (threadIdx.x == 0) (void)xb_add(&((unsigned*)(kp0->ws + OFF_BAR))[XB_XCNT(xb_xcc_id())], 1u);
#define RUN_PHASE(PH) do { KP kp = kp0; asm volatile("" : "+s"(kp)); do_phase(*kp, PH, dyn_smem, wid_u); \
    if (PH == 0) grid.sync(); \
    else if (PH + 1 < NPHASE) xcd_barrier(*kp, (volatile LAS unsigned*)((LAS char*)dyn_smem + (SMEM_BYTES - 16)), wid_u); } while (0)
  RUN_PHASE(0); RUN_PHASE(1); RUN_PHASE(2); RUN_PHASE(3); RUN_PHASE(4); RUN_PHASE(5); RUN_PHASE(6);
  RUN_PHASE(7); RUN_PHASE(8); RUN_PHASE(9); RUN_PHASE(10); RUN_PHASE(11); RUN_PHASE(12); RUN_PHASE(13);
#undef RUN_PHASE
}

__global__ void __launch_bounds__(NTHR, 2) phase_kernel(Params p, int ph) {
  const int wid_u = __builtin_amdgcn_readfirstlane(threadIdx.x >> 6);
  do_phase(*(const __attribute__((address_space(4))) Params*)__builtin_amdgcn_kernarg_segment_ptr(), ph, dyn_smem, wid_u);
}

extern "C" void kernel_launch(void* const* d_in, const int* in_sizes, int n_in, void* d_out, int out_size, void* d_ws, size_t ws_size,
                              hipStream_t stream) {
  Params p{};
  const float** f = (const float**)&p;
  for (int i = 0; i < 33; ++i) f[i] = (const float*)d_in[i];
  p.out = (float*)d_out;
  p.ws = (char*)d_ws;
  if (WS_NEED > ws_size) { fprintf(stderr, "workspace too small: need %zu have %zu\n", (size_t)WS_NEED, ws_size); return; }

#if ONE_LAUNCH
  static int grid_blocks = 0;
  if (!grid_blocks) {
    int dev = 0, cus = 0, per_cu = 0;
    (void)hipGetDevice(&dev);
    (void)hipDeviceGetAttribute(&cus, hipDeviceAttributeMultiprocessorCount, dev);
    (void)hipFuncSetAttribute((const void*)mega_kernel, hipFuncAttributeMaxDynamicSharedMemorySize, SMEM_BYTES);
    (void)hipOccupancyMaxActiveBlocksPerMultiprocessor(&per_cu, mega_kernel, NTHR, SMEM_BYTES);
    if (per_cu < 1) per_cu = 1;
    grid_blocks = cus * per_cu;
  }
  (void)hipMemsetAsync(p.ws + OFF_BAR, 0, XCD_BAR_WORDS * sizeof(unsigned), stream);
  void* args[] = {&p};
  hipError_t e = hipLaunchCooperativeKernel((const void*)mega_kernel, dim3(grid_blocks), dim3(NTHR), args, SMEM_BYTES, stream);
  if (e != hipSuccess) fprintf(stderr, "cooperative launch failed: %s (grid %d)\n", hipGetErrorString(e), grid_blocks);
#else
  static bool attr = false;
  if (!attr) { (void)hipFuncSetAttribute((const void*)phase_kernel, hipFuncAttributeMaxDynamicSharedMemorySize, SMEM_BYTES); attr = true; }
  for (int ph = 0; ph < NPHASE; ++ph) phase_kernel<<<256, NTHR, SMEM_BYTES, stream>>>(p, ph);
#endif
}
```

```cpp
#include <hip/hip_runtime.h>
#include <hip/hip_cooperative_groups.h>
#include <cstdio>
namespace cg = cooperative_groups;

#ifndef ONE_LAUNCH
#define ONE_LAUNCH 1
#endif

typedef unsigned short bf16_t;
typedef short bf16x8 __attribute__((ext_vector_type(8)));
typedef float f32x4 __attribute__((ext_vector_type(4)));
typedef float f32x2 __attribute__((ext_vector_type(2)));
typedef unsigned u32x2 __attribute__((ext_vector_type(2)));
#define LAS __attribute__((address_space(3)))

constexpr int D = 1024, FF = 2816, NTOK = 98304, NPROMPT = 32768, ZLD = 2560, PINW = 2464;
constexpr int NTHR = 512;
constexpr int SMEM_BYTES = 162320;

struct Params {
  const float *x_prompt, *x_sample, *c_prompt, *c_sample, *ada_w, *ada_b, *n1_pre, *n1_post, *f1_w1, *f1_w3, *f1_w2,
      *nm_pre, *nm_post, *w_in, *shift_mu, *pool_w, *pool_scale, *w0, *w2, *a0, *a2, *g2, *k_k, *k_a, *r_k, *lnx_g, *lnx_b,
      *w_out, *n2_pre, *n2_post, *f2_w1, *f2_w3, *f2_w2;
  float* out;
  char* ws;
};
#define PREF const __attribute__((address_space(4))) Params&
constexpr size_t al256(size_t b) { return (b + 255) & ~(size_t)255; }
constexpr size_t OFF_W13A = 0;
constexpr size_t OFF_W13B = OFF_W13A + al256((size_t)2 * FF * D * 2);
constexpr size_t OFF_W2A = OFF_W13B + al256((size_t)2 * FF * D * 2);
constexpr size_t OFF_W2B = OFF_W2A + al256((size_t)D * FF * 2);
constexpr size_t OFF_WINT = OFF_W2B + al256((size_t)D * FF * 2);
constexpr size_t OFF_WOUTT = OFF_WINT + al256((size_t)ZLD * D * 2);
constexpr size_t OFF_MOD = OFF_WOUTT + al256((size_t)D * D * 2);
constexpr size_t OFF_SBON = OFF_MOD + al256((size_t)16 * 9216 * 4);
constexpr size_t OFF_RH = OFF_SBON + al256((size_t)NTOK * 16 * 4);
constexpr size_t OFF_RY = OFF_RH + al256((size_t)NTOK * D * 2);
constexpr size_t OFF_RU = OFF_RY + al256((size_t)NTOK * D * 2);
constexpr size_t OFF_ALORA = OFF_RU + al256((size_t)NTOK * FF * 2);
constexpr size_t OFF_BAR = OFF_ALORA + al256((size_t)NTOK * 256 * 2);
constexpr size_t WS_NEED = OFF_BAR + 16384;
#define P_W13A ((bf16_t*)(p.ws + OFF_W13A))
#define P_W13B ((bf16_t*)(p.ws + OFF_W13B))
#define P_W2A ((bf16_t*)(p.ws + OFF_W2A))
#define P_W2B ((bf16_t*)(p.ws + OFF_W2B))
#define P_WINT ((bf16_t*)(p.ws + OFF_WINT))
#define P_WOUTT ((bf16_t*)(p.ws + OFF_WOUTT))
#define P_MOD ((float*)(p.ws + OFF_MOD))
#define P_SBON ((float*)(p.ws + OFF_SBON))
#define P_RH ((bf16_t*)(p.ws + OFF_RH))
#define P_RY ((bf16_t*)(p.ws + OFF_RY))
#define P_RU ((bf16_t*)(p.ws + OFF_RU))
#define P_ALORA ((bf16_t*)(p.ws + OFF_ALORA))

typedef __bf16 bf16x2_t __attribute__((ext_vector_type(2)));
__device__ __forceinline__ unsigned cvt_pk_bf16(float lo, float hi) {
  f32x2 v = {lo, hi};
  bf16x2_t b = __builtin_convertvector(v, bf16x2_t);
  return __builtin_bit_cast(unsigned, b);
}
__device__ __forceinline__ float bf_lo(unsigned u) { return __uint_as_float(u << 16); }
__device__ __forceinline__ float bf_hi(unsigned u) { return __uint_as_float(u & 0xffff0000u); }
__device__ __forceinline__ float bf2f(bf16_t b) { return __uint_as_float(((unsigned)b) << 16); }
__device__ __forceinline__ void unpack8(uint4 v, float* o) {
  o[0] = bf_lo(v.x); o[1] = bf_hi(v.x); o[2] = bf_lo(v.y); o[3] = bf_hi(v.y);
  o[4] = bf_lo(v.z); o[5] = bf_hi(v.z); o[6] = bf_lo(v.w); o[7] = bf_hi(v.w);
}
__device__ __forceinline__ uint4 pack8(const float* o) {
  uint4 v; v.x = cvt_pk_bf16(o[0], o[1]); v.y = cvt_pk_bf16(o[2], o[3]); v.z = cvt_pk_bf16(o[4], o[5]); v.w = cvt_pk_bf16(o[6], o[7]);
  return v;
}
__device__ __forceinline__ float sigmoidf_(float x) { return __builtin_amdgcn_rcpf(1.f + __expf(-x)); }
template <int CTRL> __device__ __forceinline__ float dpp_f(float x) {
  return __int_as_float(__builtin_amdgcn_update_dpp(0, __float_as_int(x), CTRL, 0xf, 0xf, false));
}
__device__ __forceinline__ float row16_sum(float x) {
  x += dpp_f<0x128>(x); x += dpp_f<0x124>(x); x += dpp_f<0x122>(x); x += dpp_f<0x121>(x);
  return x;
}
template <class T> __device__ __forceinline__ T sel(bool c, T a, T b) { return c ? a : b; }
__device__ __forceinline__ int opaque_tid_w(int wid) {
  int l;
  asm volatile("v_mbcnt_lo_u32_b32 %0, -1, 0\n\tv_mbcnt_hi_u32_b32 %0, -1, %0" : "=v"(l));
  return wid * 64 + l;
}
#define opaque_tid() opaque_tid_w(wid_u)
__device__ __forceinline__ float wave_sum(float v) {
  v = row16_sum(v);
  const float a = __int_as_float(__builtin_amdgcn_readlane(__float_as_int(v), 0)), b = __int_as_float(__builtin_amdgcn_readlane(__float_as_int(v), 16));
  const float c = __int_as_float(__builtin_amdgcn_readlane(__float_as_int(v), 32)), d = __int_as_float(__builtin_amdgcn_readlane(__float_as_int(v), 48));
  return (a + b) + (c + d);
}
__device__ __forceinline__ float quad_sum(float x) { x += dpp_f<0xB1>(x); x += dpp_f<0x4E>(x); return x; }
__device__ __forceinline__ int seq_start(int s) { return s < 8 ? s * 4096 : NPROMPT + (s - 8) * 8192; }
__device__ __forceinline__ void row_seq(int row, int& s, int& t, int& T) {
  if (row < NPROMPT) { s = row >> 12; t = row & 4095; T = 4096; }
  else { int r = row - NPROMPT; s = 8 + (r >> 13); t = r & 8191; T = 8192; }
}

__device__ __forceinline__ void tr_tile(const float* __restrict__ src, int ldsrc, int k0, int n0, int nvalid, bf16_t* __restrict__ dst, int ldd,
                        int kdst0, int mode, float* sm, const int tid) {
#pragma unroll
  for (int i = 0; i < 2; ++i) {
    const int r = (tid >> 4) + 32 * i, c = (tid & 15) * 4;
    float4 v = make_float4(0.f, 0.f, 0.f, 0.f);
    if (n0 + c < nvalid) v = *(const float4*)(src + (size_t)(k0 + r) * ldsrc + n0 + c);
    float* d = sm + r * 65 + c;
    d[0] = v.x; d[1] = v.y; d[2] = v.z; d[3] = v.w;
  }
  __syncthreads();
  {
    const int n = tid >> 3, kc = (tid & 7) * 8;
    float o[8];
#pragma unroll
    for (int j = 0; j < 8; ++j) o[j] = sm[(kc + j) * 65 + n];
    int nn = n0 + n, drow;
    const int c32 = nn & 31, slot = 16 * ((c32 >> 2) & 1) + 4 * (c32 >> 3) + (c32 & 3);
    if (mode == 0) drow = (nn & ~31) + slot;
    else drow = 256 * (nn >> 7) + (mode == 2 ? 128 : 0) + ((nn & 127) & ~31) + slot;
    *(uint4*)(dst + (size_t)drow * ldd + kdst0 + k0 + kc) = pack8(o);
  }
  __syncthreads();
}

__device__ __forceinline__ void prep_phase(PREF p, char* smem, const int wid_u) {
  float* sm = (float*)smem;
  const int tid = opaque_tid();
  constexpr int N_MOD = 144, N_EFF = 128, N_W13 = 4 * 704, N_W2 = 2 * 704, N_WIN = 640, N_WOUT = 128;
  constexpr int TOTAL = N_MOD + N_EFF + N_W13 + N_W2 + N_WIN + N_WOUT;
  for (int item = blockIdx.x; item < TOTAL; item += gridDim.x) {
    int it = item;
    if (it < N_MOD) {
      const int j0 = it * 64;
      float* sc = sm;
      float* red = sm + 16384;
      for (int idx = tid; idx < 16384; idx += NTHR) {
        const int s = idx >> 10, k = idx & 1023;
        const float* cp_ = p.c_prompt; const float* cs_ = p.c_sample;
        const float c = s < 8 ? cp_[s * 1024 + k] : cs_[(s - 8) * 1024 + k];
        sc[idx] = c / (1.f + __expf(-c));
      }
      __syncthreads();
      const int col = tid & 63, kg = tid >> 6;
      float acc[16];
#pragma unroll
      for (int s = 0; s < 16; ++s) acc[s] = 0.f;
      for (int k = kg * 128; k < kg * 128 + 128; ++k) {
        const float w = p.ada_w[(size_t)k * 9216 + j0 + col];
#pragma unroll
        for (int s = 0; s < 16; ++s) acc[s] += sc[s * 1024 + k] * w;
      }
#pragma unroll
      for (int s = 0; s < 16; ++s) red[(kg * 16 + s) * 64 + col] = acc[s];
      __syncthreads();
      for (int o = tid; o < 1024; o += NTHR) {
        const int s = o >> 6, c2 = o & 63;
        float v = p.ada_b[j0 + c2];
#pragma unroll
        for (int g = 0; g < 8; ++g) v += red[(g * 16 + s) * 64 + c2];
        P_MOD[s * 9216 + j0 + c2] = v;
      }
      __syncthreads();
      continue;
    }
    it -= N_MOD;
    if (it < N_EFF) {
      const int g = it >> 5, itile = (it >> 4) & 1, ntile = it & 15;
      float* As = sm;
      float* Bs = sm + 64 * 129;
      for (int idx = tid; idx < 64 * 128; idx += NTHR) {
        const int i = idx >> 7, j = idx & 127;
        As[i * 129 + j] = p.pool_w[((size_t)g * 128 + itile * 64 + i) * 128 + j] * p.pool_scale[g * 128 + j];
      }
      for (int idx = tid; idx < 128 * 64; idx += NTHR) {
        const int j = idx >> 6, nn = idx & 63;
        Bs[j * 65 + nn] = p.w_out[(size_t)(g * 128 + j) * 1024 + ntile * 64 + nn];
      }
      __syncthreads();
      const int i = tid >> 3, nn0 = (tid & 7) * 8;
      float acc[8];
#pragma unroll
      for (int q = 0; q < 8; ++q) acc[q] = 0.f;
      for (int j = 0; j < 128; ++j) {
        const float a = As[i * 129 + j];
#pragma unroll
        for (int q = 0; q < 8; ++q) acc[q] += a * Bs[j * 65 + nn0 + q];
      }
#pragma unroll
      for (int q = 0; q < 8; ++q)
      {
        const int nn = ntile * 64 + nn0 + q, c32 = nn & 31, slot = 16 * ((c32 >> 2) & 1) + 4 * (c32 >> 3) + (c32 & 3);
        P_WOUTT[(size_t)((nn & ~31) + slot) * 1024 + g * 128 + itile * 64 + i] = (bf16_t)(cvt_pk_bf16(acc[q], 0.f) & 0xffff);
      }
      __syncthreads();
      continue;
    }
    it -= N_EFF;
    if (it < N_W13) {
      const int which = it / 704, r = it % 704;
      const int kt = r / 44, ntl = r % 44;
      const float* src = sel(which < 2, sel(which == 0, p.f1_w1, p.f1_w3), sel(which == 2, p.f2_w1, p.f2_w3));
      bf16_t* dst = sel(which < 2, P_W13A, P_W13B);
      tr_tile(src, FF, kt * 64, ntl * 64, FF, dst, D, 0, (which & 1) ? 2 : 1, sm, tid);
      continue;
    }
    it -= N_W13;
    if (it < N_W2) {
      const int which = it / 704, r = it % 704;
      const int kt = r / 16, ntl = r % 16;
      tr_tile(sel(which != 0, p.f2_w2, p.f1_w2), D, kt * 64, ntl * 64, D, sel(which != 0, P_W2B, P_W2A), FF, 0, 0, sm, tid);
      continue;
    }
    it -= N_W2;
    if (it < N_WIN) {
      const int kt = it / 40, ntl = it % 40;
      tr_tile(p.w_in, PINW, kt * 64, ntl * 64, PINW, P_WINT, D, 0, 0, sm, tid);
      continue;
    }
    it -= N_WIN;
    {
      const int kt = it / 16, ntl = it % 16;
      tr_tile(p.w_out + (size_t)512 * 1024, D, kt * 64, ntl * 64, D, P_WOUTT, D, 512, 0, sm, tid);
    }
  }
}

template <int MODE>
__device__ __forceinline__ void row_phase(const float* __restrict__ xp, const float* __restrict__ xs, float* __restrict__ xout,
                          const bf16_t* __restrict__ y, bf16_t* __restrict__ h, const float* __restrict__ mod,
                          const float* __restrict__ npost, const float* __restrict__ npre, int gate_idx, float cgate, int shift_idx, const int wid_u,
                          const bool xin_bf = false) {
  const int tid_ = opaque_tid();
  const int lane = tid_ & 63;
  const int gw = blockIdx.x * 8 + (tid_ >> 6), GW = gridDim.x * 8;
  for (int chunk = gw; chunk < NTOK / 16; chunk += GW) {
    const int row0 = chunk * 16;
    int s, t, T;
    row_seq(row0, s, t, T);
    const float* md = mod + s * 9216;
    f32x4 Am[4], Bm[4], Gm[4];
#pragma unroll
    for (int i = 0; i < 4; ++i) {
      const int c = i * 256 + lane * 4;
      if (MODE != 2) {
        f32x4 np = *(const f32x4*)(npre + c), sc = *(const f32x4*)(md + (shift_idx + 1) * 1024 + c);
        Am[i] = np * (sc + 1.f);
        Bm[i] = *(const f32x4*)(md + shift_idx * 1024 + c);
      }
      if (MODE != 0) {
        f32x4 g = *(const f32x4*)(md + gate_idx * 1024 + c), po = *(const f32x4*)(npost + c);
        Gm[i] = g * po * cgate;
      }
    }
    for (int r = 0; r < 16; ++r) {
      const int row = row0 + r;
      const float* xr = (row < NPROMPT) ? xp + (size_t)row * D : xs + (size_t)(row - NPROMPT) * D;
      f32x4 xv[4];
      if (MODE != 0 && xin_bf) {
        const bf16_t* xb = (const bf16_t*)(xout + (size_t)row * D) + 1024;
#pragma unroll
        for (int i = 0; i < 4; ++i) {
          const u32x2 u = __builtin_nontemporal_load((const u32x2*)(xb + i * 256 + lane * 4));
          xv[i] = (f32x4){bf_lo(u.x), bf_hi(u.x), bf_lo(u.y), bf_hi(u.y)};
        }
      } else {
#pragma unroll
        for (int i = 0; i < 4; ++i) xv[i] = __builtin_nontemporal_load((const f32x4*)(xr + i * 256 + lane * 4));
      }
      if (MODE != 0) {
        f32x4 yv[4];
        float ss = 0.f;
#pragma unroll
        for (int i = 0; i < 4; ++i) {
          const u32x2 u = __builtin_nontemporal_load((const u32x2*)(y + (size_t)row * D + i * 256 + lane * 4));
          yv[i] = (f32x4){bf_lo(u.x), bf_hi(u.x), bf_lo(u.y), bf_hi(u.y)};
          ss += yv[i][0] * yv[i][0] + yv[i][1] * yv[i][1] + yv[i][2] * yv[i][2] + yv[i][3] * yv[i][3];
        }
        ss = wave_sum(ss);
        const float rs = rsqrtf(ss * (1.f / 1024.f) + 1e-6f);
#pragma unroll
        for (int i = 0; i < 4; ++i) {
          xv[i] = xv[i] + Gm[i] * yv[i] * rs;
          if (MODE == 2) __builtin_nontemporal_store(xv[i], (f32x4*)(xout + (size_t)row * D + i * 256 + lane * 4));
          else {
            uint2 u; u.x = cvt_pk_bf16(xv[i][0], xv[i][1]); u.y = cvt_pk_bf16(xv[i][2], xv[i][3]);
            *(uint2*)((bf16_t*)(xout + (size_t)row * D) + 1024 + i * 256 + lane * 4) = u;
          }
        }
      }
      if (MODE != 2) {
        float ss = 0.f;
#pragma unroll
        for (int i = 0; i < 4; ++i) ss += xv[i][0] * xv[i][0] + xv[i][1] * xv[i][1] + xv[i][2] * xv[i][2] + xv[i][3] * xv[i][3];
        ss = wave_sum(ss);
        const float rs = rsqrtf(ss * (1.f / 1024.f) + 1e-6f);
#pragma unroll
        for (int i = 0; i < 4; ++i) {
          f32x4 hv = xv[i] * rs * Am[i] + Bm[i];
          uint2 u; u.x = cvt_pk_bf16(hv[0], hv[1]); u.y = cvt_pk_bf16(hv[2], hv[3]);
          *(uint2*)(h + (size_t)row * D + i * 256 + lane * 4) = u;
        }
      }
    }
  }
}

constexpr int BM = 256, BK = 64, HALF = 128, NXCD = 8, WGM = 4, HT = HALF * BK;
__device__ __forceinline__ int lds_byte(int r, int c) {
  int st = (r >> 4) * 2 + (c >> 5), rr = r & 15, cc = c & 31, ob = rr * 64 + cc * 2;
  return st * 1024 + (ob ^ (((ob >> 9) & 1) << 5));
}
__device__ __forceinline__ void stage_rc(int b, int& R, int& C) {
  int st = b / 1024, sb = b % 1024, swz = sb ^ (((sb >> 9) & 1) << 5);
  R = (st >> 1) * 16 + swz / 64; C = (st & 1) * 32 + (swz % 64) / 2;
}

__device__ __forceinline__ bool gemm_unit(int i, int nM, int nN, int nwg, int& pm, int& pn) {
  const long L = (long)i * gridDim.x + blockIdx.x;
  if (L >= nwg) return false;
  int wgid = (int)L;
  { int q = nwg / NXCD, r = nwg % NXCD, xcd = wgid % NXCD, off = wgid / NXCD;
    wgid = (xcd < r ? xcd * (q + 1) : r * (q + 1) + (xcd - r) * q) + off; }
  const int nig = WGM * nN, gid = wgid / nig, fm = gid * WGM, gsz = min(nM - fm, WGM);
  pm = fm + ((wgid % nig) % gsz); pn = (wgid % nig) / gsz;
  return true;
}

__device__ __forceinline__ void gemm_phase(const bf16_t* __restrict__ A, const bf16_t* __restrict__ Bt, bf16_t* __restrict__ C, int M, int N, int K,
                                           int ldc, const int EPI, char* smem, const int wid_u) {
  const int nM = M / BM, nN = N / BM, nwg = nM * nN;
  const int tid = opaque_tid();
  LAS bf16_t* shm = (LAS bf16_t*)smem;
#define SA(b, h) (shm + ((b) * 2 + (h)) * HT)
#define SB(b, h) (shm + (4 + (b) * 2 + (h)) * HT)
#define STG(P, GB) do { const char* _gb = (GB); \
    _Pragma("unroll") for (int _i = 0; _i < 2; ++_i) { \
      __builtin_amdgcn_global_load_lds((const unsigned*)(_gb + voff[_i]), \
        (LAS unsigned*)((LAS char*)(P) + ldsw + _i * 8192), 16, 0, 0); } } while (0)
#define LDA(dst, b, h) _Pragma("unroll") for (int m = 0; m < 4; ++m) _Pragma("unroll") for (int k = 0; k < 2; ++k) \
    dst[m][k] = *(const LAS bf16x8*)((LAS char*)SA(b, h) + aoff + m * 2048 + k * 1024)
#define LDB(dst, b, h) _Pragma("unroll") for (int n = 0; n < 2; ++n) _Pragma("unroll") for (int k = 0; k < 2; ++k) \
    dst[n][k] = *(const LAS bf16x8*)((LAS char*)SB(b, h) + boff + n * 2048 + k * 1024)
#define MMA(ai, bj, At_, Bt_) do { __builtin_amdgcn_s_setprio(1); \
    _Pragma("unroll") for (int m = 0; m < 4; ++m) _Pragma("unroll") for (int n = 0; n < 2; ++n) _Pragma("unroll") for (int k = 0; k < 2; ++k) \
      acc[ai][bj][m][n] = __builtin_amdgcn_mfma_f32_16x16x32_bf16(Bt_[n][k], At_[m][k], acc[ai][bj][m][n], 0, 0, 0); \
    __builtin_amdgcn_s_setprio(0); } while (0)
#define WAIT_V(n) asm volatile("s_waitcnt vmcnt(" #n ")" ::: "memory")
#define WAIT_L(n) asm volatile("s_waitcnt lgkmcnt(" #n ")" ::: "memory")
#define BAR __builtin_amdgcn_s_barrier()
#define SCHED __builtin_amdgcn_sched_barrier(0)
  const int wid = __builtin_amdgcn_readfirstlane(tid >> 6), lane = tid & 63, wr = wid >> 2, wc = wid & 3, fr = lane & 15, fq = lane >> 4;
  const int aoff = lds_byte(wr * 64 + fr, fq * 8), boff = lds_byte(wc * 32 + fr, fq * 8);
  unsigned voff[2];
  const int ldsw = wid * 1024;
#pragma unroll
  for (int _i = 0; _i < 2; ++_i) { int _r, _c; stage_rc(tid * 16 + _i * 8192, _r, _c); voff[_i] = (unsigned)(_r * K + _c) * 2u; }
  const int nt = K / BK;
  const size_t kstep = (size_t)BK * 2, hstep = (size_t)HALF * K * 2, tstep = 2 * hstep;
  int pm, pn, npm = 0, npn = 0, ui = 0;
  if (!gemm_unit(0, nM, nN, nwg, pm, pn)) return;
  f32x4 acc[2][2][4][2];
#pragma unroll
  for (int a = 0; a < 2; ++a)
#pragma unroll
    for (int b = 0; b < 2; ++b)
#pragma unroll
      for (int m = 0; m < 4; ++m)
#pragma unroll
        for (int n = 0; n < 2; ++n) acc[a][b][m][n] = (f32x4){0.f, 0.f, 0.f, 0.f};
  bf16x8 At[4][2], B0[2][2], B1[2][2];
  const char* cA = (const char*)A + (size_t)pm * tstep;
  const char* cB = (const char*)Bt + (size_t)pn * tstep;
  STG(SB(0, 0), cB); STG(SA(0, 0), cA); STG(SB(0, 1), cB + hstep); STG(SA(0, 1), cA + hstep);
  if (wr == 1) BAR;
  WAIT_V(4); BAR;
  STG(SB(1, 0), cB + kstep); STG(SA(1, 0), cA + kstep); STG(SB(1, 1), cB + hstep + kstep);
  WAIT_V(6); BAR;
  for (;;) {
    const bool has_next = gemm_unit(ui + 1, nM, nN, nwg, npm, npn);
    const char* nA = has_next ? (const char*)A + (size_t)npm * tstep : cA;
    const char* nB = has_next ? (const char*)Bt + (size_t)npn * tstep : cB;
    for (int t = 0; t < nt; t += 2) {
      const bool last = (t == nt - 2);
      const char* a1 = cA + (size_t)(t + 1) * kstep;
      const char* a2 = last ? nA : cA + (size_t)(t + 2) * kstep;
      const char* b2 = last ? nB : cB + (size_t)(t + 2) * kstep;
      const char* a3 = a2 + kstep;
      const char* b3 = b2 + kstep;
      LDB(B0, 0, 0); SCHED; LDA(At, 0, 0); STG(SA(1, 1), a1 + hstep);
      WAIT_L(8); BAR; WAIT_L(0); MMA(0, 0, At, B0); BAR; SCHED;
      LDB(B1, 0, 1); STG(SB(0, 0), b2);
      BAR; WAIT_L(0); MMA(0, 1, At, B1); BAR;
      LDA(At, 0, 1); STG(SA(0, 0), a2);
      BAR; WAIT_L(0); MMA(1, 0, At, B0); BAR; SCHED;
      STG(SB(0, 1), b2 + hstep);
      WAIT_V(6); BAR; MMA(1, 1, At, B1); BAR;
      LDB(B0, 1, 0); SCHED; LDA(At, 1, 0); STG(SA(0, 1), a2 + hstep);
      WAIT_L(8); BAR; WAIT_L(0); MMA(0, 0, At, B0); BAR; SCHED;
      LDB(B1, 1, 1); STG(SB(1, 0), b3);
      BAR; WAIT_L(0); MMA(0, 1, At, B1); BAR;
      LDA(At, 1, 1); STG(SA(1, 0), a3);
      BAR; WAIT_L(0); MMA(1, 0, At, B0); BAR; SCHED;
      STG(SB(1, 1), b3 + hstep);
      WAIT_V(6); BAR; MMA(1, 1, At, B1); BAR;
    }
    {
      const int brow = pm * BM, bcol = pn * BM;
#pragma unroll
      for (int ai = 0; ai < 2; ++ai)
#pragma unroll
        for (int m = 0; m < 4; ++m) {
          const size_t row = (size_t)(brow + ai * HALF + wr * 64 + m * 16 + fr);
          if (EPI == 0) {
#pragma unroll
            for (int bj = 0; bj < 2; ++bj) {
              const f32x4 v0 = acc[ai][bj][m][0], v1 = acc[ai][bj][m][1];
              uint4 u; u.x = cvt_pk_bf16(v0[0], v0[1]); u.y = cvt_pk_bf16(v0[2], v0[3]); u.z = cvt_pk_bf16(v1[0], v1[1]); u.w = cvt_pk_bf16(v1[2], v1[3]);
              *(uint4*)(C + row * ldc + bcol + bj * HALF + wc * 32 + fq * 8) = u;
            }
          } else {
            float o[8];
#pragma unroll
            for (int n = 0; n < 2; ++n) {
              const f32x4 a = acc[ai][0][m][n], b = acc[ai][1][m][n];
#pragma unroll
              for (int j = 0; j < 4; ++j) o[n * 4 + j] = a[j] * __builtin_amdgcn_rcpf(1.f + __expf(-a[j])) * b[j];
            }
            *(uint4*)(C + row * ldc + (bcol >> 1) + wc * 32 + fq * 8) = pack8(o);
          }
        }
    }
    if (!has_next) break;
#pragma unroll
    for (int a = 0; a < 2; ++a)
#pragma unroll
      for (int b = 0; b < 2; ++b)
#pragma unroll
        for (int m = 0; m < 4; ++m)
#pragma unroll
          for (int n = 0; n < 2; ++n) acc[a][b][m][n] = (f32x4){0.f, 0.f, 0.f, 0.f};
    pm = npm; pn = npn; cA = nA; cB = nB; ++ui;
  }
  WAIT_V(0);
  if (wr == 0) BAR;
  BAR;
#undef SA
#undef SB
#undef STG
#undef LDA
#undef LDB
#undef MMA
}

__device__ __forceinline__ void load_shift16(const bf16_t* __restrict__ z, int row, int t, int T, int col, const float* __restrict__ mu, float* o) {
  const bf16_t* pz = z + (size_t)row * ZLD + col;
  uint4 c0 = *(const uint4*)pz, c1 = *(const uint4*)(pz + 8);
  uint4 p0 = make_uint4(0, 0, 0, 0), p1 = p0, n0 = p0, n1 = p0;
  if (t > 0) { p0 = *(const uint4*)(pz - ZLD); p1 = *(const uint4*)(pz - ZLD + 8); }
  if (t < T - 1) { n0 = *(const uint4*)(pz + ZLD); n1 = *(const uint4*)(pz + ZLD + 8); }
  float c[16], pv[16], nx[16];
  unpack8(c0, c); unpack8(c1, c + 8); unpack8(p0, pv); unpack8(p1, pv + 8); unpack8(n0, nx); unpack8(n1, nx + 8);
#pragma unroll
  for (int q = 0; q < 16; ++q) o[q] = c[q] + (0.5f * (pv[q] + nx[q]) - c[q]) * mu[col - 512 + q];
}
__device__ __forceinline__ void load_shift8(const bf16_t* __restrict__ z, int row, int t, int T, int col, const float* __restrict__ mu, float* o) {
  const bf16_t* pz = z + (size_t)row * ZLD + col;
  uint4 c0 = *(const uint4*)pz;
  uint4 p0 = make_uint4(0, 0, 0, 0), n0 = p0;
  if (t > 0) p0 = *(const uint4*)(pz - ZLD);
  if (t < T - 1) n0 = *(const uint4*)(pz + ZLD);
  float c[8], pv[8], nx[8];
  unpack8(c0, c); unpack8(p0, pv); unpack8(n0, nx);
#pragma unroll
  for (int q = 0; q < 8; ++q) o[q] = c[q] + (0.5f * (pv[q] + nx[q]) - c[q]) * mu[col - 512 + q];
}

constexpr int TC = 32;
constexpr int SV = TC * 64;
struct Raw8 { uint4 c, p, n; };
__device__ __forceinline__ void lp_load(Raw8& r, const bf16_t* __restrict__ z, int task) {
  r.c = make_uint4(0, 0, 0, 0); r.p = r.c; r.n = r.c;
  if (task < NTOK * 32) {
    const int row = task >> 5, oc = task & 31;
    int s, t, T;
    row_seq(row, s, t, T);
    const bf16_t* pz = z + (size_t)row * ZLD + 2048 + oc * 8;
    r.c = *(const uint4*)pz;
    if (t > 0) r.p = *(const uint4*)(pz - ZLD);
    if (t < T - 1) r.n = *(const uint4*)(pz + ZLD);
  }
}
__device__ __forceinline__ void lp_store(const Raw8& r, bf16_t* __restrict__ al, const float* __restrict__ mu, int task) {
  if (task < NTOK * 32) {
    const int row = task >> 5, oc = task & 31;
    float c[8], pv[8], nx[8], o[8];
    unpack8(r.c, c); unpack8(r.p, pv); unpack8(r.n, nx);
#pragma unroll
    for (int q = 0; q < 8; ++q) o[q] = c[q] + (0.5f * (pv[q] + nx[q]) - c[q]) * mu[2048 - 512 + oc * 8 + q];
    if (oc < 16) {
#pragma unroll
      for (int q = 0; q < 8; ++q) { const float e = __expf(2.f * o[q]); o[q] = 1.f - 2.f * __builtin_amdgcn_rcpf(e + 1.f); }
    }
    *(uint4*)(al + (size_t)row * 256 + oc * 8) = pack8(o);
  }
}
__device__ __forceinline__ void lora_prep_phase(PREF p, const int wid_u) {
  const int tid = opaque_tid();
  const bf16_t* z = P_RU;
  bf16_t* al = P_ALORA;
  const float* mu = p.shift_mu;
  const int stride = gridDim.x * NTHR;
#pragma unroll 1
  for (int task0 = blockIdx.x * NTHR + tid; task0 < NTOK * 32; task0 += 4 * stride) {
    Raw8 r0, r1, r2, r3;
    lp_load(r0, z, task0); lp_load(r1, z, task0 + stride); lp_load(r2, z, task0 + 2 * stride); lp_load(r3, z, task0 + 3 * stride);
    lp_store(r0, al, mu, task0); lp_store(r1, al, mu, task0 + stride); lp_store(r2, al, mu, task0 + 2 * stride); lp_store(r3, al, mu, task0 + 3 * stride);
  }
}

template <int HALF>
__device__ __forceinline__ void pool_seg(const bf16_t* __restrict__ z, bf16_t* __restrict__ mo, int row_base, int tbase, int T, int c0) {
  constexpr int NR = 2 * HALF + 3;
  float acc[4][8], zc[4][8];
#pragma unroll
  for (int i = 0; i < 4; ++i)
#pragma unroll
    for (int q = 0; q < 8; ++q) { acc[i][q] = 0.f; zc[i][q] = 0.f; }
#pragma unroll
  for (int r = 0; r < NR; ++r) {
    const int tt = tbase - HALF + r;
    uint4 u = make_uint4(0, 0, 0, 0);
    if (tt >= 0 && tt < T) u = *(const uint4*)(z + (size_t)(row_base - HALF + r) * ZLD + c0);
    float v[8];
    unpack8(u, v);
#pragma unroll
    for (int i = 0; i < 4; ++i) {
      if (r >= i && r < i + 2 * HALF) {
#pragma unroll
        for (int q = 0; q < 8; ++q) acc[i][q] += v[q];
      }
      if (r == HALF + i) {
#pragma unroll
        for (int q = 0; q < 8; ++q) zc[i][q] = v[q];
      }
    }
  }
#pragma unroll
  for (int i = 0; i < 4; ++i) {
    const int ti = tbase + i;
    const float ic = 1.f / (float)(min(ti + HALF, T) - max(ti - HALF, 0));
    float o[8];
#pragma unroll
    for (int q = 0; q < 8; ++q) o[q] = acc[i][q] * ic - zc[i][q];
    *(uint4*)(mo + (size_t)(row_base + i) * D + c0) = pack8(o);
  }
}
__device__ __forceinline__ void pool_tile(const bf16_t* __restrict__ z, bf16_t* __restrict__ mo, int tile, int tid) {
  const int row0 = tile * 32;
  int s, t0, T;
  row_seq(row0, s, t0, T);
  const int oc = tid >> 3, seg = tid & 7, c0 = oc * 8, grp = __builtin_amdgcn_readfirstlane(oc >> 4);
  const int rb = row0 + seg * 4, tb = t0 + seg * 4;
  if (grp == 0) pool_seg<1>(z, mo, rb, tb, T, c0);
  else if (grp == 1) pool_seg<2>(z, mo, rb, tb, T, c0);
  else if (grp == 2) pool_seg<4>(z, mo, rb, tb, T, c0);
  else pool_seg<8>(z, mo, rb, tb, T, c0);
}

struct Raw16 { uint4 c0, c1, p0, p1, n0, n1; };
__device__ __forceinline__ void load_raw16(Raw16& r, const bf16_t* __restrict__ z, int row, int t, int T, int col) {
  const bf16_t* pz = z + (unsigned)(row * ZLD + col);
  r.c0 = *(const uint4*)pz; r.c1 = *(const uint4*)(pz + 8);
  r.p0 = make_uint4(0, 0, 0, 0); r.p1 = r.p0; r.n0 = r.p0; r.n1 = r.p0;
  if (t > 0) { r.p0 = *(const uint4*)(pz - ZLD); r.p1 = *(const uint4*)(pz - ZLD + 8); }
  if (t < T - 1) { r.n0 = *(const uint4*)(pz + ZLD); r.n1 = *(const uint4*)(pz + ZLD + 8); }
}
__device__ __forceinline__ void shift16(const Raw16& r, const float* c1, const float* c2, float* o) {
  float c[16], pv[16], nx[16];
  unpack8(r.c0, c); unpack8(r.c1, c + 8); unpack8(r.p0, pv); unpack8(r.p1, pv + 8); unpack8(r.n0, nx); unpack8(r.n1, nx + 8);
#pragma unroll
  for (int q = 0; q < 16; ++q) o[q] = c[q] * c1[q] + (pv[q] + nx[q]) * c2[q];
}
__device__ __forceinline__ bf16x8 ldfrag(const bf16_t* base, int stride, int row0, int k0, int fr, int fq) {
  return *reinterpret_cast<const bf16x8*>(base + (row0 + fr) * stride + k0 + fq * 8);
}
__device__ __forceinline__ uint2 pack4(f32x4 v) { uint2 u; u.x = cvt_pk_bf16(v[0], v[1]); u.y = cvt_pk_bf16(v[2], v[3]); return u; }
#define MFMA16(a, b, c) __builtin_amdgcn_mfma_f32_16x16x32_bf16(a, b, c, 0, 0, 0)

constexpr int CS_NAB = 0, CS_NAK = 4096, CS_NBRT = 8192, CS_NKRT = 10752, CS_QT = 13312, CS_W = 15872, CS_Z = 20992, CS_GT = 26112,
              CS_RYT = 35328, CS_VN = 39936;
constexpr int CS_AT = 49152, CS_RT = CS_AT + 4608, CS_BT = CS_RT + 4608, CS_KT = CS_BT + 4608, CS_BB = 67584, CS_KB = CS_BB + 5120,
              CS_VT = CS_KB + 5120, CS_ATT = 82944, CS_PL = 92160, CS_SBF = 92416, CS_PRIV = 110848, CS_CST = 143616, CS_BL = 145920;

__device__ __forceinline__ void lds_barrier() {
  asm volatile("s_waitcnt lgkmcnt(0)" ::: "memory");
  __builtin_amdgcn_s_barrier();
  asm volatile("" ::: "memory");
}
template <int Q> __device__ __forceinline__ float quad_bcast(float x) { return dpp_f<Q * 0x55>(x); }

template <int S0> __device__ __forceinline__ void solve_steps(float (&x)[8], const float* nab, int seg) {
  if constexpr (S0 < 32) {
    const float xs = quad_bcast<(S0 >> 3)>(x[S0 & 7]);
    const f32x4 n0 = *(const f32x4*)(nab + S0 * 32 + seg * 8), n1 = *(const f32x4*)(nab + S0 * 32 + seg * 8 + 4);
    x[0] += xs * n0[0]; x[1] += xs * n0[1]; x[2] += xs * n0[2]; x[3] += xs * n0[3];
    x[4] += xs * n1[0]; x[5] += xs * n1[1]; x[6] += xs * n1[2]; x[7] += xs * n1[3];
    solve_steps<S0 + 1>(x, nab, seg);
  }
}

template <int S0> __device__ __forceinline__ void solve16(float (&x)[8], const float* nb) {
  if constexpr (S0 < 16) {
    const float xs = (S0 >> 3) ? dpp_f<0xF5>(x[S0 & 7]) : dpp_f<0xA0>(x[S0 & 7]);
    const f32x4 n0 = *(const f32x4*)(nb + S0 * 32), n1 = *(const f32x4*)(nb + S0 * 32 + 4);
    x[0] += xs * n0[0]; x[1] += xs * n0[1]; x[2] += xs * n0[2]; x[3] += xs * n0[3];
    x[4] += xs * n1[0]; x[5] += xs * n1[1]; x[6] += xs * n1[2]; x[7] += xs * n1[3];
    solve16<S0 + 1>(x, nb);
  }
}

__device__ __forceinline__ void scan_phase(PREF p, char* smem, const int wid_u) {
  float* stepbuf = (float*)smem;
  float* Nab = (float*)(smem + CS_NAB);
  bf16_t* NakT = (bf16_t*)(smem + CS_NAK);
  bf16_t* VNb = (bf16_t*)(smem + CS_VN);
  bf16_t* T11b = (bf16_t*)(smem + CS_VN + 5120);
  bf16_t* M1T = (bf16_t*)(smem + CS_VN + 5120 + 1280);
  bf16_t* NbrT = (bf16_t*)(smem + CS_NBRT);
  bf16_t* NkrT = (bf16_t*)(smem + CS_NKRT);
  bf16_t* TT = (bf16_t*)(smem + CS_QT);
  bf16_t* Wb = (bf16_t*)(smem + CS_W);
  bf16_t* Zb = (bf16_t*)(smem + CS_Z);
  bf16_t* GT = (bf16_t*)(smem + CS_GT);
  bf16_t* RyT = (bf16_t*)(smem + CS_RYT);
  bf16_t* At = (bf16_t*)(smem + CS_AT);
  bf16_t* Rt = (bf16_t*)(smem + CS_RT);
  bf16_t* Bt = (bf16_t*)(smem + CS_BT);
  bf16_t* Kt = (bf16_t*)(smem + CS_KT);
  bf16_t* Bb = (bf16_t*)(smem + CS_BB);
  bf16_t* Kb = (bf16_t*)(smem + CS_KB);
  bf16_t* VT = (bf16_t*)(smem + CS_VT);
  bf16_t* AtTb = (bf16_t*)(smem + CS_ATT);
  float* PLs = (float*)(smem + CS_PL);
  bf16_t* Sbf = (bf16_t*)(smem + CS_SBF);
  float* cst = (float*)(smem + CS_CST);
  const bf16_t* z = P_RU;
  const int tid = opaque_tid();
  const int wave = __builtin_amdgcn_readfirstlane(tid >> 6), lane = tid & 63, fr = lane & 15, fq = lane >> 4;
  const int item = blockIdx.x;
  if (item < 256) {
    const int s = item < 128 ? 8 + (item >> 4) : ((item - 128) >> 4);
    const int h = (item & 15) >> 1, d = item & 1;
    const int T = s < 8 ? 4096 : 8192, r0seq = seq_start(s), nch = T / 32;
    bf16_t* yout = P_RY + (size_t)d * NTOK * 512;
    {
      const int g = tid >> 6, k = tid & 63;
      const float muk = p.shift_mu[1024 - 512 + h * 64 + k], mur = p.shift_mu[512 - 512 + h * 64 + k], muv = p.shift_mu[1536 - 512 + h * 64 + k];
      float v;
      if (g == 0) v = 0.5f * muk;
      else if (g == 1) v = 0.5f * mur;
      else if (g == 2) v = 1.f - muk;
      else if (g == 3) v = 1.f - mur;
      else if (g == 4) v = 1.f - muv;
      else if (g == 5) v = p.k_k[h * 64 + k];
      else if (g == 6) v = p.k_a[h * 64 + k];
      else v = p.r_k[h * 64 + k];
      cst[g * 64 + k] = v;
      if (g == 0) cst[8 * 64 + k] = 0.5f * muv;
      for (int i = tid; i < 2 * 64 * 72 / 2; i += NTHR) ((unsigned*)Sbf)[i] = 0u;
    }
    const int role = wave >> 1, th = wave & 1;
    const int tl = lane >> 2, cq = lane & 3;
    float* tmpa = (float*)(smem + CS_PRIV + (wave & 3) * 8192 + 2560);
    uint4* Blds = (uint4*)(smem + CS_BL) + (role & 1) * 512;
    float bias[4] = {0.f, 0.f, 0.f, 0.f};
    if (role < 2) {
      const float* lsrc = sel(role != 0, p.a2, p.w2) + (size_t)d * 64 * 512 + h * 64;
      if (th == 0) {
#pragma unroll
        for (int nt = 0; nt < 4; ++nt)
#pragma unroll
          for (int ks = 0; ks < 2; ++ks) {
            float o[8];
#pragma unroll
            for (int q = 0; q < 8; ++q) o[q] = lsrc[(size_t)(ks * 32 + fq * 8 + q) * 512 + nt * 16 + fr];
            Blds[(nt * 2 + ks) * 64 + lane] = pack8(o);
          }
      }
#pragma unroll
      for (int nt = 0; nt < 4; ++nt) bias[nt] = sel(role != 0, p.a0, p.w0)[d * 512 + h * 64 + nt * 16 + fr];
    }
    const int colA = 512 + h * 64 + cq * 16;
    const int colB = (role == 1 ? 1024 : 1536) + h * 64 + cq * 16;
    const int alo = (role == 0 ? d * 64 : 128 + d * 64) + fq * 8;
    Raw16 ra, rb;
    {
      const int j = th * 16 + tl, t = d ? T - 1 - j : j, row = r0seq + t;
      if (role == 2) load_raw16(ra, z, row, t, T, colA);
      if (role == 1 || role == 2) load_raw16(rb, z, row, t, T, colB);
      if (role < 2) {
        const int j2 = th * 16 + fr, t2 = d ? T - 1 - j2 : j2;
        const bf16_t* ap = P_ALORA + (unsigned)((r0seq + t2) * 256 + alo);
        ra.c0 = *(const uint4*)ap; ra.c1 = *(const uint4*)(ap + 32);
      }
    }
    f32x4 Sa = {0.f, 0.f, 0.f, 0.f}, Sb = Sa;
    uint2 y_def = make_uint2(0u, 0u);
    float sb_def = 0.f;
    const int mt = wave >> 1, hn = wave & 1, nt0 = 2 * hn, nt1 = 2 * hn + 1;
    __syncthreads();

    for (int c = 0; c < nch; ++c) {
      if (role < 3) {
        const int j = th * 16 + tl;
        const int istep = c * 32 + j;
        const int t = d ? T - 1 - istep : istep;
        const int row = r0seq + t;
        float v16[16];
        if (role < 2) {
          f32x4 acc[4] = {};
#pragma unroll
          for (int ks = 0; ks < 2; ++ks) {
            const uint4 au = ks == 0 ? ra.c0 : ra.c1;
            const bf16x8 a = *reinterpret_cast<const bf16x8*>(&au);
#pragma unroll
            for (int nt = 0; nt < 4; ++nt) { const uint4 bu = Blds[(nt * 2 + ks) * 64 + lane]; acc[nt] = MFMA16(a, *reinterpret_cast<const bf16x8*>(&bu), acc[nt]); }
          }
          if (role == 0) {
#pragma unroll
            for (int nt = 0; nt < 4; ++nt)
#pragma unroll
              for (int jj = 0; jj < 4; ++jj) {
                const float sg = sigmoidf_(bias[nt] + acc[nt][jj]);
                stepbuf[0 * SV + (th * 16 + fq * 4 + jj) * 64 + nt * 16 + fr] = __expf(-0.6065306597126334f * sg);
              }
            __builtin_amdgcn_wave_barrier();
            {
              float wl[16];
#pragma unroll
              for (int i = 0; i < 16; ++i) wl[i] = stepbuf[0 * SV + (th * 16 + i) * 64 + lane];
              float pr = 1.f;
#pragma unroll
              for (int i = 0; i < 16; ++i) { pr *= wl[i]; stepbuf[0 * SV + (th * 16 + i) * 64 + lane] = pr; }
            }
          } else {
#pragma unroll
            for (int nt = 0; nt < 4; ++nt)
#pragma unroll
              for (int jj = 0; jj < 4; ++jj) tmpa[(fq * 4 + jj) * 68 + nt * 16 + fr] = sigmoidf_(bias[nt] + acc[nt][jj]);
            __builtin_amdgcn_wave_barrier();
            float av[16], kd[16];
#pragma unroll
            for (int q = 0; q < 4; ++q) { f32x4 a4 = *(const f32x4*)(tmpa + tl * 68 + cq * 16 + q * 4); av[q * 4] = a4[0]; av[q * 4 + 1] = a4[1]; av[q * 4 + 2] = a4[2]; av[q * 4 + 3] = a4[3]; }
            shift16(rb, cst + 2 * 64 + cq * 16, cst + 0 * 64 + cq * 16, v16);
            float kk[16], ss = 0.f;
#pragma unroll
            for (int q = 0; q < 16; ++q) { kk[q] = v16[q] * cst[5 * 64 + cq * 16 + q]; ss += kk[q] * kk[q]; }
            ss = quad_sum(ss);
            const float inv = 1.f / fmaxf(sqrtf(ss), 1e-12f);
#pragma unroll
            for (int q = 0; q < 16; ++q) { kk[q] *= inv; kd[q] = v16[q] * (1.f + (av[q] - 1.f) * cst[6 * 64 + cq * 16 + q]); }
#pragma unroll
            for (int q = 0; q < 4; ++q) {
              *(f32x4*)(stepbuf + 3 * SV + j * 64 + cq * 16 + q * 4) = (f32x4){-kk[q * 4], -kk[q * 4 + 1], -kk[q * 4 + 2], -kk[q * 4 + 3]};
              *(f32x4*)(stepbuf + 4 * SV + j * 64 + cq * 16 + q * 4) = (f32x4){kk[q * 4] * av[q * 4], kk[q * 4 + 1] * av[q * 4 + 1], kk[q * 4 + 2] * av[q * 4 + 2], kk[q * 4 + 3] * av[q * 4 + 3]};
              *(f32x4*)(stepbuf + 1 * SV + j * 64 + cq * 16 + q * 4) = (f32x4){kd[q * 4], kd[q * 4 + 1], kd[q * 4 + 2], kd[q * 4 + 3]};
            }
          }
        } else {
          shift16(ra, cst + 3 * 64 + cq * 16, cst + 1 * 64 + cq * 16, v16);
#pragma unroll
          for (int q = 0; q < 4; ++q) *(f32x4*)(stepbuf + 2 * SV + j * 64 + cq * 16 + q * 4) = (f32x4){v16[q * 4], v16[q * 4 + 1], v16[q * 4 + 2], v16[q * 4 + 3]};
          shift16(rb, cst + 4 * 64 + cq * 16, cst + 8 * 64 + cq * 16, v16);
#pragma unroll
          for (int q = 0; q < 4; ++q) *(f32x4*)(stepbuf + 5 * SV + j * 64 + cq * 16 + q * 4) = (f32x4){v16[q * 4], v16[q * 4 + 1], v16[q * 4 + 2], v16[q * 4 + 3]};
        }
      }
      if (c > 0) {
        const int ip = (c - 1) * 32 + hn * 16 + fr, tp = d ? T - 1 - ip : ip;
        *(uint2*)(yout + (size_t)(r0seq + tp) * 512 + h * 64 + mt * 16 + fq * 4) = y_def;
        if (role == 2 && cq == 0) { const int is_ = (c - 1) * 32 + th * 16 + tl, tg = d ? T - 1 - is_ : is_; P_SBON[((size_t)(r0seq + tg) * 8 + h) * 2 + d] = sb_def; }
      }
      if (role < 3 && c + 1 < nch) {
        const int is2 = (c + 1) * 32 + th * 16 + tl;
        const int t2 = d ? T - 1 - is2 : is2;
        const int row2 = r0seq + t2;
        if (role == 2) load_raw16(ra, z, row2, t2, T, colA);
        if (role >= 1) load_raw16(rb, z, row2, t2, T, colB);
        if (role < 2) {
          const int is3 = (c + 1) * 32 + th * 16 + fr, t3 = d ? T - 1 - is3 : is3;
          const bf16_t* ap = P_ALORA + (unsigned)((r0seq + t3) * 256 + alo);
          ra.c0 = *(const uint4*)ap; ra.c1 = *(const uint4*)(ap + 32);
        }
      }
      lds_barrier();
      {
        const int k = lane, seg = wave;
        const float* sw = stepbuf + 0 * SV + k;
        const float P15 = sw[15 * 64];
        const float hiF = seg >= 4 ? P15 : 1.f;
        float P[5];
        P[0] = seg == 0 ? 1.f : sw[(4 * seg - 1) * 64] * (seg > 4 ? P15 : 1.f);
#pragma unroll
        for (int i = 0; i < 4; ++i) P[i + 1] = sw[(4 * seg + i) * 64] * hiF;
        const float PL = sw[31 * 64] * P15;
        if (role == 2) {
          const int j = th * 16 + tl;
          float bs = 0.f;
#pragma unroll
          for (int q = 0; q < 16; ++q) bs += stepbuf[2 * SV + j * 64 + cq * 16 + q] * stepbuf[1 * SV + j * 64 + cq * 16 + q] * cst[7 * 64 + cq * 16 + q];
          bs = quad_sum(bs);
          sb_def = bs;
        }
        f32x4 bb, kb, at, vv;
#pragma unroll
        for (int i = 0; i < 4; ++i) {
          const int t = 4 * seg + i;
          const float inv = __builtin_amdgcn_rcpf(P[i + 1]);
          const float a_ = P[i] * stepbuf[3 * SV + t * 64 + k];
          const float rraw = stepbuf[2 * SV + t * 64 + k], kraw = stepbuf[1 * SV + t * 64 + k];
          const float r_ = P[i + 1] * rraw;
          const float b_ = stepbuf[4 * SV + t * 64 + k] * inv;
          const float k_ = kraw * inv;

          At[t * 72 + k] = (bf16_t)(cvt_pk_bf16(a_, 0.f) & 0xffff);
          Rt[t * 72 + k] = (bf16_t)(cvt_pk_bf16(r_, 0.f) & 0xffff);
          Bt[t * 72 + k] = (bf16_t)(cvt_pk_bf16(b_, 0.f) & 0xffff);
          Kt[t * 72 + k] = (bf16_t)(cvt_pk_bf16(k_, 0.f) & 0xffff);
          bb[i] = b_ * PL; kb[i] = k_ * PL; at[i] = a_;
          vv[i] = stepbuf[5 * SV + t * 64 + k];
        }
        *(uint2*)(Bb + k * 40 + 4 * seg) = pack4(bb);
        *(uint2*)(Kb + k * 40 + 4 * seg) = pack4(kb);
        *(uint2*)(VT + k * 40 + 4 * seg) = pack4(vv);
        *(uint2*)(AtTb + k * 40 + 4 * seg) = pack4(at);
        if (seg == 0) PLs[k] = PL;
      }
      lds_barrier();
      {
        const int mat = wave >> 1, mts = wave & 1;
        const bf16_t* As = (mat & 1) ? Kt : Bt;
        const bf16_t* Bs = (mat & 2) ? Rt : At;
        f32x4 acc[2] = {};
#pragma unroll
        for (int ks = 0; ks < 2; ++ks) {
          const bf16x8 a = ldfrag(As, 72, mts * 16, ks * 32, fr, fq);
#pragma unroll
          for (int nt = 0; nt < 2; ++nt) acc[nt] = MFMA16(a, ldfrag(Bs, 72, nt * 16, ks * 32, fr, fq), acc[nt]);
        }
#pragma unroll
        for (int nt = 0; nt < 2; ++nt) {
          const int tcol = nt * 16 + fr;
          f32x4 v = acc[nt];
#pragma unroll
          for (int jj = 0; jj < 4; ++jj) {
            const int srow = mts * 16 + fq * 4 + jj;
            const bool keep = (mat & 2) ? (srow <= tcol) : (srow < tcol);
            v[jj] = keep ? v[jj] : 0.f;
          }
          if (mat == 0) {
#pragma unroll
            for (int jj = 0; jj < 4; ++jj) Nab[(mts * 16 + fq * 4 + jj) * 32 + tcol] = v[jj];
          } else {
            bf16_t* dst = mat == 1 ? NakT : mat == 2 ? NbrT : NkrT;
            *(uint2*)(dst + tcol * 40 + mts * 16 + fq * 4) = pack4(v);
          }
        }
      }
      lds_barrier();
      if (wave == 0) {
        const int irow = lane >> 1, hb = lane & 1, blk = lane >> 5, il = irow & 15;
        float x[8];
#pragma unroll
        for (int i = 0; i < 8; ++i) x[i] = (hb * 8 + i == il) ? 1.f : 0.f;
        const float* nb = Nab + (blk * 16) * 32 + blk * 16 + hb * 8;
        solve16<0>(x, nb);
#pragma unroll
        for (int i = 0; i < 8; ++i) TT[(blk * 16 + hb * 8 + i) * 40 + blk * 16 + il] = (bf16_t)(cvt_pk_bf16(x[i], 0.f) & 0xffff);
        if (blk == 0) *(uint4*)(T11b + il * 40 + hb * 8) = pack8(x);
        __builtin_amdgcn_wave_barrier();
        const f32x4 zero = {0.f, 0.f, 0.f, 0.f};
        bf16x8 zf;
#pragma unroll
        for (int i = 0; i < 8; ++i) zf[i] = 0;
        bf16x8 n12 = zf, t22 = zf, t11 = zf;
        if (fq < 2) {
          float o[8];
          const f32x4 n0 = *(const f32x4*)(Nab + fr * 32 + 16 + fq * 8), n1 = *(const f32x4*)(Nab + fr * 32 + 16 + fq * 8 + 4);
          o[0] = n0[0]; o[1] = n0[1]; o[2] = n0[2]; o[3] = n0[3]; o[4] = n1[0]; o[5] = n1[1]; o[6] = n1[2]; o[7] = n1[3];
          uint4 u = pack8(o);
          n12 = *reinterpret_cast<bf16x8*>(&u);
          t22 = *reinterpret_cast<const bf16x8*>(TT + (16 + fr) * 40 + 16 + fq * 8);
          t11 = *reinterpret_cast<const bf16x8*>(T11b + fr * 40 + fq * 8);
        }
        const f32x4 m1 = MFMA16(n12, t22, zero);
        *(uint2*)(M1T + fr * 40 + fq * 4) = pack4(m1);
        __builtin_amdgcn_wave_barrier();
        bf16x8 m1f = zf;
        if (fq < 2) m1f = *reinterpret_cast<const bf16x8*>(M1T + fr * 40 + fq * 8);
        const f32x4 t12 = MFMA16(t11, m1f, zero);
        *(uint2*)(TT + (16 + fr) * 40 + fq * 4) = pack4(t12);
      } else if (wave == 1) {
        unsigned z0;
        asm volatile("v_mov_b32 %0, 0" : "=v"(z0));
        *(uint2*)(TT + (lane >> 2) * 40 + 16 + (lane & 3) * 4) = make_uint2(z0, z0);
      } else if (wave < 6) {
        const int vtile = wave - 2;
        const bf16x8 vf = ldfrag(VT, 40, vtile * 16, 0, fr, fq);
        const f32x4 zero = {0.f, 0.f, 0.f, 0.f};
#pragma unroll
        for (int tt = 0; tt < 2; ++tt) {
          const f32x4 acc = MFMA16(ldfrag(NakT, 40, tt * 16, 0, fr, fq), vf, zero);
          *(uint2*)(VNb + (vtile * 16 + fr) * 40 + tt * 16 + fq * 4) = pack4(acc);
        }
      }
      lds_barrier();
      {
        const int tt = wave & 1, rt = wave >> 1;
        const f32x4 zero = {0.f, 0.f, 0.f, 0.f};
        const bf16x8 tf = ldfrag(TT, 40, tt * 16, 0, fr, fq);
        const f32x4 zacc = MFMA16(tf, ldfrag(VNb, 40, rt * 16, 0, fr, fq), zero);
        const f32x4 wacc = MFMA16(tf, ldfrag(AtTb, 40, rt * 16, 0, fr, fq), zero);
        *(uint2*)(Zb + (rt * 16 + fr) * 40 + tt * 16 + fq * 4) = pack4(zacc);
        *(uint2*)(Wb + (rt * 16 + fr) * 40 + tt * 16 + fq * 4) = pack4(wacc);
      }
      lds_barrier();
      f32x4 yacc = {0.f, 0.f, 0.f, 0.f};
      {
        const float pl0 = PLs[nt0 * 16 + fr], pl1 = PLs[nt1 * 16 + fr];
        Sa = Sa * pl0; Sb = Sb * pl1;
        const bf16x8 zf = ldfrag(Zb, 40, mt * 16, 0, fr, fq), vf = ldfrag(VT, 40, mt * 16, 0, fr, fq), wf = ldfrag(Wb, 40, mt * 16, 0, fr, fq);
        const bf16x8 bb0 = ldfrag(Bb, 40, nt0 * 16, 0, fr, fq), bb1 = ldfrag(Bb, 40, nt1 * 16, 0, fr, fq);
        const bf16x8 kb0 = ldfrag(Kb, 40, nt0 * 16, 0, fr, fq), kb1 = ldfrag(Kb, 40, nt1 * 16, 0, fr, fq);
        const bf16x8 nbr = ldfrag(NbrT, 40, hn * 16, 0, fr, fq), nkr = ldfrag(NkrT, 40, hn * 16, 0, fr, fq);
        Sa = MFMA16(zf, bb0, Sa); Sa = MFMA16(vf, kb0, Sa);
        Sb = MFMA16(zf, bb1, Sb); Sb = MFMA16(vf, kb1, Sb);
        yacc = MFMA16(zf, nbr, yacc); yacc = MFMA16(vf, nkr, yacc);
        const f32x4 zero = {0.f, 0.f, 0.f, 0.f};
        const f32x4 g0 = MFMA16(wf, bb0, zero), g1 = MFMA16(wf, bb1, zero);
        f32x4 ry = MFMA16(wf, nbr, zero);
        *(uint2*)(GT + (nt0 * 16 + fr) * 72 + mt * 16 + fq * 4) = pack4(g0);
        *(uint2*)(GT + (nt1 * 16 + fr) * 72 + mt * 16 + fq * 4) = pack4(g1);
        const uint2 rr = *(const uint2*)(Rt + (hn * 16 + fr) * 72 + mt * 16 + fq * 4);
        ry[0] += bf_lo(rr.x); ry[1] += bf_hi(rr.x); ry[2] += bf_lo(rr.y); ry[3] += bf_hi(rr.y);
        *(uint2*)(RyT + (hn * 16 + fr) * 72 + mt * 16 + fq * 4) = pack4(ry);
      }
      lds_barrier();
      {
        const bf16_t* Scur = Sbf + (c & 1) * 64 * 72;
        bf16_t* Snext = Sbf + ((c + 1) & 1) * 64 * 72;
#pragma unroll
        for (int ks = 0; ks < 2; ++ks) {
          const bf16x8 af = ldfrag(Scur, 72, mt * 16, ks * 32, fr, fq);
          Sa = MFMA16(af, ldfrag(GT, 72, nt0 * 16, ks * 32, fr, fq), Sa);
          Sb = MFMA16(af, ldfrag(GT, 72, nt1 * 16, ks * 32, fr, fq), Sb);
          yacc = MFMA16(af, ldfrag(RyT, 72, hn * 16, ks * 32, fr, fq), yacc);
        }
        y_def = pack4(yacc);
#pragma unroll
        for (int jj = 0; jj < 4; ++jj) {
          Snext[(mt * 16 + fq * 4 + jj) * 72 + nt0 * 16 + fr] = (bf16_t)(cvt_pk_bf16(Sa[jj], 0.f) & 0xffff);
          Snext[(mt * 16 + fq * 4 + jj) * 72 + nt1 * 16 + fr] = (bf16_t)(cvt_pk_bf16(Sb[jj], 0.f) & 0xffff);
        }
      }
      lds_barrier();
    }
    {
      const int ip = (nch - 1) * 32 + hn * 16 + fr, tp = d ? T - 1 - ip : ip;
      *(uint2*)(yout + (size_t)(r0seq + tp) * 512 + h * 64 + mt * 16 + fq * 4) = y_def;
      if (role == 2 && cq == 0) { const int is_ = (nch - 1) * 32 + th * 16 + tl, tg = d ? T - 1 - is_ : is_; P_SBON[((size_t)(r0seq + tg) * 8 + h) * 2 + d] = sb_def; }
    }
  }
  if (item >= 128) {
    const int nb = gridDim.x - 128;
    for (int tile = item - 128; tile < NTOK / 32; tile += nb) pool_tile(z, P_RH, tile, tid);
  }
}

__device__ __forceinline__ void post_phase(PREF p, char* smem, const int wid_u) {
  bf16_t* Ag = (bf16_t*)smem;
  bf16_t* vt = (bf16_t*)(smem + 12800);
  float* ys = (float*)(smem + 12800 + 33280);
  const bf16_t* z = P_RU;
  const bf16_t* yf = P_RY;
  const bf16_t* ybk = P_RY + (size_t)NTOK * 512;
  bf16_t* mo = P_RH;
  const int tid = opaque_tid(), w = tid >> 6, lane = tid & 63, fr = lane & 15, fq = lane >> 4;
  bf16x8 Bg[4][6];
#pragma unroll
  for (int nt = 0; nt < 4; ++nt)
#pragma unroll
    for (int ks = 0; ks < 6; ++ks) {
      float o[8];
#pragma unroll
      for (int q = 0; q < 8; ++q) { const int k = ks * 32 + fq * 8 + q; o[q] = k < 160 ? p.g2[(size_t)k * 512 + w * 64 + nt * 16 + fr] : 0.f; }
      uint4 u = pack8(o);
      Bg[nt][ks] = *reinterpret_cast<bf16x8*>(&u);
    }
  float lng[4], lnb[4];
#pragma unroll
  for (int nt = 0; nt < 4; ++nt) { lng[nt] = p.lnx_g[w * 64 + nt * 16 + fr]; lnb[nt] = p.lnx_b[w * 64 + nt * 16 + fr]; }

  for (int tile = blockIdx.x; tile < NTOK / 32; tile += gridDim.x) {
    const int row0 = tile * 32;
    int s, t0, T;
    row_seq(row0, s, t0, T);
    for (int idx = tid; idx < 32 * 24; idx += NTHR) {
      const int tok = idx / 24, oc = idx % 24;
      float o[8];
      if (oc < 20) {
        load_shift8(z, row0 + tok, t0 + tok, T, 2304 + oc * 8, p.shift_mu, o);
#pragma unroll
        for (int q = 0; q < 8; ++q) o[q] = sigmoidf_(o[q]);
      } else {
#pragma unroll
        for (int q = 0; q < 8; ++q) o[q] = 0.f;
      }
      *(uint4*)(Ag + tok * 200 + oc * 8) = pack8(o);
    }
#pragma unroll 1
    for (int half_ = 0; half_ < 2; ++half_) {
      uint4 zc[2], zp[2], zn[2], ya[2], yb4[2];
#pragma unroll
      for (int i = 0; i < 2; ++i) {
        const int idx = tid + (half_ * 2 + i) * NTHR, tok = idx >> 6, oc = idx & 63, row = row0 + tok, t = t0 + tok;
        const bf16_t* pz = z + (size_t)row * ZLD + 1536 + oc * 8;
        zc[i] = *(const uint4*)pz;
        zp[i] = make_uint4(0, 0, 0, 0); zn[i] = zp[i];
        if (t > 0) zp[i] = *(const uint4*)(pz - ZLD);
        if (t < T - 1) zn[i] = *(const uint4*)(pz + ZLD);
        ya[i] = *(const uint4*)(yf + (size_t)row * 512 + oc * 8);
        yb4[i] = *(const uint4*)(ybk + (size_t)row * 512 + oc * 8);
      }
#pragma unroll
      for (int i = 0; i < 2; ++i) {
        const int idx = tid + (half_ * 2 + i) * NTHR, tok = idx >> 6, oc = idx & 63;
        float c[8], pv[8], nx[8], o[8];
        unpack8(zc[i], c); unpack8(zp[i], pv); unpack8(zn[i], nx);
#pragma unroll
        for (int q = 0; q < 8; ++q) o[q] = c[q] + (0.5f * (pv[q] + nx[q]) - c[q]) * p.shift_mu[1536 - 512 + oc * 8 + q];
        *(uint4*)(vt + tok * 520 + oc * 8) = pack8(o);
        float a[8], b[8];
        unpack8(ya[i], a); unpack8(yb4[i], b);
        *(f32x4*)(ys + tok * 516 + oc * 8) = (f32x4){a[0] + b[0], a[1] + b[1], a[2] + b[2], a[3] + b[3]};
        *(f32x4*)(ys + tok * 516 + oc * 8 + 4) = (f32x4){a[4] + b[4], a[5] + b[5], a[6] + b[6], a[7] + b[7]};
      }
    }
    __syncthreads();
    f32x4 acc[2][4] = {};
#pragma unroll
    for (int ks = 0; ks < 6; ++ks) {
      bf16x8 a[2];
#pragma unroll
      for (int mt = 0; mt < 2; ++mt) a[mt] = *reinterpret_cast<const bf16x8*>(Ag + (mt * 16 + fr) * 200 + ks * 32 + fq * 8);
#pragma unroll
      for (int mt = 0; mt < 2; ++mt)
#pragma unroll
        for (int nt = 0; nt < 4; ++nt) acc[mt][nt] = __builtin_amdgcn_mfma_f32_16x16x32_bf16(a[mt], Bg[nt][ks], acc[mt][nt], 0, 0, 0);
    }
#pragma unroll
    for (int mt = 0; mt < 2; ++mt)
#pragma unroll
      for (int jj = 0; jj < 4; ++jj) {
        const int tok = mt * 16 + fq * 4 + jj, row = row0 + tok;
        float yv[4], sm_ = 0.f;
#pragma unroll
        for (int nt = 0; nt < 4; ++nt) { yv[nt] = ys[tok * 516 + w * 64 + nt * 16 + fr]; sm_ += yv[nt]; }
        const float mean = row16_sum(sm_) * (1.f / 64.f);
        float vs = 0.f;
#pragma unroll
        for (int nt = 0; nt < 4; ++nt) { yv[nt] -= mean; vs += yv[nt] * yv[nt]; }
        const float rs = rsqrtf(row16_sum(vs) * (1.f / 64.f) + 64e-5f);
        const float2 sb2 = *(const float2*)(P_SBON + ((size_t)row * 8 + w) * 2);
        const float sbs = sb2.x + sb2.y;
#pragma unroll
        for (int nt = 0; nt < 4; ++nt) {
          const float vv = bf2f(vt[tok * 520 + w * 64 + nt * 16 + fr]);
          const float o = (yv[nt] * rs * lng[nt] + lnb[nt] + sbs * vv) * acc[mt][nt][jj];
          mo[(size_t)row * D + 512 + w * 64 + nt * 16 + fr] = (bf16_t)(cvt_pk_bf16(o, 0.f) & 0xffff);
        }
      }
    __syncthreads();
  }
}

#define XB_TMO      128
#define XB_XCNT(j)  (256  + 64 * (j))
#define XB_XSUB(j)  (1280 + 64 * (j))
#define XB_XGEN(j)  (2304 + 64 * (j))
#define XB_TOP      3328
#define XB_TOPGEN   3392
#define XCD_BAR_WORDS 3456
#define XB_SPIN_CAP (1u << 22)
__device__ __forceinline__ unsigned xb_ld(unsigned* p)              { return __hip_atomic_load(p, __ATOMIC_RELAXED, __HIP_MEMORY_SCOPE_AGENT); }
__device__ __forceinline__ unsigned xb_add(unsigned* p, unsigned v) { return __hip_atomic_fetch_add(p, v, __ATOMIC_RELAXED, __HIP_MEMORY_SCOPE_AGENT); }
__device__ __forceinline__ unsigned xb_xcc_id() { return (unsigned)__builtin_amdgcn_s_getreg((3 << 11) | 20) & 0xFu; }
#define XB_SPIN(cond, bar) do { unsigned _sp = 0; while (cond) { __builtin_amdgcn_s_sleep(1); \
    if ((++_sp & 255u) == 0u) { if (xb_ld(&(bar)[XB_TMO])) break; if (_sp > XB_SPIN_CAP) { atomicAdd(&(bar)[XB_TMO], 1u); break; } } } } while (0)
struct XcdBarrier { unsigned* bar; unsigned x; volatile LAS unsigned* st; };
__device__ __forceinline__ void xcd_barrier_complete(unsigned* bar, unsigned x, unsigned& nloc, unsigned& nx) {
  const unsigned G = gridDim.x * gridDim.y * gridDim.z;
  unsigned sum, cnt, mine, sp = 0u;
  for (;;) {
    sum = 0u; cnt = 0u; mine = 0u;
#pragma unroll
    for (unsigned j = 0; j < 16; ++j) { const unsigned c = xb_ld(&bar[XB_XCNT(j)]); sum += c; cnt += (c > 0u) ? 1u : 0u; mine = (j == x) ? c : mine; }
    if (sum == G) break;
    __builtin_amdgcn_s_sleep(1);
    if ((++sp & 255u) == 0u) { if (xb_ld(&bar[XB_TMO])) break; if (sp > XB_SPIN_CAP) { atomicAdd(&bar[XB_TMO], 1u); break; } }
  }
  nloc = mine > 0u ? mine : 1u; nx = cnt > 0u ? cnt : 1u;
}
__device__ __forceinline__ void xcd_barrier(PREF p, volatile LAS unsigned* st_, const int wid_u) {
  asm volatile("s_waitcnt vmcnt(0)" ::: "memory");
  __syncthreads();
  if (opaque_tid() == 0) {
    XcdBarrier b; b.bar = (unsigned*)(p.ws + OFF_BAR); b.x = xb_xcc_id(); b.st = st_;
    unsigned* bar = b.bar;
    __builtin_amdgcn_s_waitcnt(0);
    unsigned nloc = b.st[0], nx = b.st[1];
    if (nloc == 0u) { xcd_barrier_complete(bar, b.x, nloc, nx); b.st[0] = nloc; b.st[1] = nx; }
    const unsigned old = xb_add(&bar[XB_XSUB(b.x)], 1u);
    const unsigned gen = old / nloc;
    if (old + 1u == (gen + 1u) * nloc) {
      __builtin_amdgcn_fence(__ATOMIC_RELEASE, "agent");
      asm volatile("s_waitcnt vmcnt(0)" ::: "memory");
      const unsigned og = xb_add(&bar[XB_TOP], 1u);
      const unsigned tg = og / nx;
      if (og + 1u == (tg + 1u) * nx) xb_add(&bar[XB_TOPGEN], 1u);
      else XB_SPIN(xb_ld(&bar[XB_TOPGEN]) == tg, bar);
      __builtin_amdgcn_fence(__ATOMIC_ACQUIRE, "agent");
      xb_add(&bar[XB_XGEN(b.x)], 1u);
      asm volatile("s_waitcnt vmcnt(0)" ::: "memory");
    } else {
      XB_SPIN(xb_ld(&bar[XB_XGEN(b.x)]) == gen, bar);
      __builtin_amdgcn_fence(__ATOMIC_ACQUIRE, "agent");
      asm volatile("s_waitcnt vmcnt(0)" ::: "memory");
    }
  }
  __syncthreads();
}

constexpr int NPHASE = 14;
__device__ __forceinline__ void do_phase(PREF p, int ph, char* smem, const int wid_u) {
  if (ph == 0) prep_phase(p, smem, wid_u);
  else if (ph == 1) row_phase<0>(p.x_prompt, p.x_sample, nullptr, nullptr, P_RH, P_MOD, nullptr, p.n1_pre, 0, 0.f, 0, wid_u);
  else if (ph == 4 || ph == 10) {
    const bool f = ph == 4;
    float* outp = p.out;
    row_phase<1>(sel(f, p.x_prompt, (const float*)outp), sel(f, p.x_sample, (const float*)(outp + (size_t)NPROMPT * D)), outp, P_RY, P_RH, P_MOD,
                 sel(f, p.n1_post, p.nm_post), sel(f, p.nm_pre, p.n2_pre), f ? 2 : 5, f ? 0.5f : 1.0f, f ? 3 : 6, wid_u, !f);
  }
  else if (ph == 13) row_phase<2>(p.out, p.out + (size_t)NPROMPT * D, p.out, P_RY, nullptr, P_MOD, p.n2_post, nullptr, 8, 0.5f, 0, wid_u, true);
  else if (ph == 6) lora_prep_phase(p, wid_u);
  else if (ph == 7) scan_phase(p, smem, wid_u);
  else if (ph == 8) post_phase(p, smem, wid_u);
  else {
    const bf16_t *A, *Bt; bf16_t* C; int N, K, ldc, epi;
    if (ph == 2 || ph == 11) { A = P_RH; Bt = sel(ph == 2, P_W13A, P_W13B); C = P_RU; N = 2 * FF; K = D; ldc = FF; epi = 1; }
    else if (ph == 3 || ph == 12) { A = P_RU; Bt = sel(ph == 3, P_W2A, P_W2B); C = P_RY; N = D; K = FF; ldc = D; epi = 0; }
    else if (ph == 5) { A = P_RH; Bt = P_WINT; C = P_RU; N = ZLD; K = D; ldc = ZLD; epi = 0; }
    else { A = P_RH; Bt = P_WOUTT; C = P_RY; N = D; K = D; ldc = D; epi = 0; }
    gemm_phase(A, Bt, C, NTOK, N, K, ldc, epi, smem, wid_u);
  }
}

extern __shared__ __attribute__((aligned(16))) char dyn_smem[];

__global__ void __launch_bounds__(NTHR, 2) mega_kernel(Params p) {
  cg::grid_group grid = cg::this_grid();
  const int wid_u = __builtin_amdgcn_readfirstlane(threadIdx.x >> 6);
  typedef const __attribute__((address_space(4))) Params* KP;
  const KP kp0 = (KP)__builtin_amdgcn_kernarg_segment_ptr();
  volatile LAS unsigned* st = (volatile LAS unsigned*)((LAS char*)dyn_smem + (SMEM_BYTES - 16));
  if (threadIdx.x < 2) st[threadIdx.x] = 0u;
  __syncthreads();
  if (threadIdx.x == 0) (void)xb_add(&((unsigned*)(kp0->ws + OFF_BAR))[XB_XCNT(xb_xcc_id())], 1u);
#define RUN_PHASE(PH) do { KP kp = kp0; asm volatile("" : "+s"(kp)); do_phase(*kp, PH, dyn_smem, wid_u); \
    if (PH == 0) grid.sync(); \
    else if (PH + 1 < NPHASE) xcd_barrier(*kp, (volatile LAS unsigned*)((LAS char*)dyn_smem + (SMEM_BYTES - 16)), wid_u); } while (0)
  RUN_PHASE(0); RUN_PHASE(1); RUN_PHASE(2); RUN_PHASE(3); RUN_PHASE(4); RUN_PHASE(5); RUN_PHASE(6);
  RUN_PHASE(7); RUN_PHASE(8); RUN_PHASE(9); RUN_PHASE(10); RUN_PHASE(11); RUN_PHASE(12); RUN_PHASE(13);
#undef RUN_PHASE
}

__global__ void __launch_bounds__(NTHR, 2) phase_kernel(Params p, int ph) {
  const int wid_u = __builtin_amdgcn_readfirstlane(threadIdx.x >> 6);
  do_phase(*(const __attribute__((address_space(4))) Params*)__builtin_amdgcn_kernarg_segment_ptr(), ph, dyn_smem, wid_u);
}

extern "C" void kernel_launch(void* const* d_in, const int* in_sizes, int n_in, void* d_out, int out_size, void* d_ws, size_t ws_size,
                              hipStream_t stream) {
  Params p{};
  const float** f = (const float**)&p;
  for (int i = 0; i < 33; ++i) f[i] = (const float*)d_in[i];
  p.out = (float*)d_out;
  p.ws = (char*)d_ws;
  if (WS_NEED > ws_size) { fprintf(stderr, "workspace too small: need %zu have %zu\n", (size_t)WS_NEED, ws_size); return; }

#if ONE_LAUNCH
  static int grid_blocks = 0;
  if (!grid_blocks) {
    int dev = 0, cus = 0, per_cu = 0;
    (void)hipGetDevice(&dev);
    (void)hipDeviceGetAttribute(&cus, hipDeviceAttributeMultiprocessorCount, dev);
    (void)hipFuncSetAttribute((const void*)mega_kernel, hipFuncAttributeMaxDynamicSharedMemorySize, SMEM_BYTES);
    (void)hipOccupancyMaxActiveBlocksPerMultiprocessor(&per_cu, mega_kernel, NTHR, SMEM_BYTES);
    if (per_cu < 1) per_cu = 1;
    grid_blocks = cus * per_cu;
  }
  (void)hipMemsetAsync(p.ws + OFF_BAR, 0, XCD_BAR_WORDS * sizeof(unsigned), stream);
  void* args[] = {&p};
  hipError_t e = hipLaunchCooperativeKernel((const void*)mega_kernel, dim3(grid_blocks), dim3(NTHR), args, SMEM_BYTES, stream);
  if (e != hipSuccess) fprintf(stderr, "cooperative launch failed: %s (grid %d)\n", hipGetErrorString(e), grid_blocks);
#else
  static bool attr = false;
  if (!attr) { (void)hipFuncSetAttribute((const void*)phase_kernel, hipFuncAttributeMaxDynamicSharedMemorySize, SMEM_BYTES); attr = true; }
  for (int ph = 0; ph < NPHASE; ++ph) phase_kernel<<<256, NTHR, SMEM_BYTES, stream>>>(p, ph);
#endif
}
```

```cpp
#include <hip/hip_runtime.h>
#include <hip/hip_cooperative_groups.h>
#include <cstdio>
namespace cg = cooperative_groups;

#ifndef ONE_LAUNCH
#define ONE_LAUNCH 1
#endif

typedef unsigned short bf16_t;
typedef short bf16x8 __attribute__((ext_vector_type(8)));
typedef float f32x4 __attribute__((ext_vector_type(4)));
typedef float f32x2 __attribute__((ext_vector_type(2)));
typedef unsigned u32x2 __attribute__((ext_vector_type(2)));
#define LAS __attribute__((address_space(3)))

constexpr int D = 1024, FF = 2816, NTOK = 98304, NPROMPT = 32768, ZLD = 2560, PINW = 2464;
constexpr int NTHR = 512;
constexpr int SMEM_BYTES = 162320;

struct Params {
  const float *x_prompt, *x_sample, *c_prompt, *c_sample, *ada_w, *ada_b, *n1_pre, *n1_post, *f1_w1, *f1_w3, *f1_w2,
      *nm_pre, *nm_post, *w_in, *shift_mu, *pool_w, *pool_scale, *w0, *w2, *a0, *a2, *g2, *k_k, *k_a, *r_k, *lnx_g, *lnx_b,
      *w_out, *n2_pre, *n2_post, *f2_w1, *f2_w3, *f2_w2;
  float* out;
  char* ws;
};
#define PREF const __attribute__((address_space(4))) Params&
constexpr size_t al256(size_t b) { return (b + 255) & ~(size_t)255; }
constexpr size_t OFF_W13A = 0;
constexpr size_t OFF_W13B = OFF_W13A + al256((size_t)2 * FF * D * 2);
constexpr size_t OFF_W2A = OFF_W13B + al256((size_t)2 * FF * D * 2);
constexpr size_t OFF_W2B = OFF_W2A + al256((size_t)D * FF * 2);
constexpr size_t OFF_WINT = OFF_W2B + al256((size_t)D * FF * 2);
constexpr size_t OFF_WOUTT = OFF_WINT + al256((size_t)ZLD * D * 2);
constexpr size_t OFF_MOD = OFF_WOUTT + al256((size_t)D * D * 2);
constexpr size_t OFF_SBON = OFF_MOD + al256((size_t)16 * 9216 * 4);
constexpr size_t OFF_RH = OFF_SBON + al256((size_t)NTOK * 16 * 4);
constexpr size_t OFF_RY = OFF_RH + al256((size_t)NTOK * D * 2);
constexpr size_t OFF_RU = OFF_RY + al256((size_t)NTOK * D * 2);
constexpr size_t OFF_ALORA = OFF_RU + al256((size_t)NTOK * FF * 2);
constexpr size_t OFF_BAR = OFF_ALORA + al256((size_t)NTOK * 256 * 2);
constexpr size_t OFF_BTAB = OFF_BAR + 16384;
constexpr size_t WS_NEED = OFF_BTAB + (size_t)256 * 16384;
#define P_W13A ((bf16_t*)(p.ws + OFF_W13A))
#define P_W13B ((bf16_t*)(p.ws + OFF_W13B))
#define P_W2A ((bf16_t*)(p.ws + OFF_W2A))
#define P_W2B ((bf16_t*)(p.ws + OFF_W2B))
#define P_WINT ((bf16_t*)(p.ws + OFF_WINT))
#define P_WOUTT ((bf16_t*)(p.ws + OFF_WOUTT))
#define P_MOD ((float*)(p.ws + OFF_MOD))
#define P_SBON ((float*)(p.ws + OFF_SBON))
#define P_RH ((bf16_t*)(p.ws + OFF_RH))
#define P_RY ((bf16_t*)(p.ws + OFF_RY))
#define P_RU ((bf16_t*)(p.ws + OFF_RU))
#define P_ALORA ((bf16_t*)(p.ws + OFF_ALORA))

typedef __bf16 bf16x2_t __attribute__((ext_vector_type(2)));
__device__ __forceinline__ unsigned cvt_pk_bf16(float lo, float hi) {
  f32x2 v = {lo, hi};
  bf16x2_t b = __builtin_convertvector(v, bf16x2_t);
  return __builtin_bit_cast(unsigned, b);
}
__device__ __forceinline__ float bf_lo(unsigned u) { return __uint_as_float(u << 16); }
__device__ __forceinline__ float bf_hi(unsigned u) { return __uint_as_float(u & 0xffff0000u); }
__device__ __forceinline__ float bf2f(bf16_t b) { return __uint_as_float(((unsigned)b) << 16); }
__device__ __forceinline__ void unpack8(uint4 v, float* o) {
  o[0] = bf_lo(v.x); o[1] = bf_hi(v.x); o[2] = bf_lo(v.y); o[3] = bf_hi(v.y);
  o[4] = bf_lo(v.z); o[5] = bf_hi(v.z); o[6] = bf_lo(v.w); o[7] = bf_hi(v.w);
}
__device__ __forceinline__ uint4 pack8(const float* o) {
  uint4 v; v.x = cvt_pk_bf16(o[0], o[1]); v.y = cvt_pk_bf16(o[2], o[3]); v.z = cvt_pk_bf16(o[4], o[5]); v.w = cvt_pk_bf16(o[6], o[7]);
  return v;
}
__device__ __forceinline__ float sigmoidf_(float x) { return __builtin_amdgcn_rcpf(1.f + __expf(-x)); }
template <int CTRL> __device__ __forceinline__ float dpp_f(float x) {
  return __int_as_float(__builtin_amdgcn_update_dpp(0, __float_as_int(x), CTRL, 0xf, 0xf, false));
}
__device__ __forceinline__ float row16_sum(float x) {
  x += dpp_f<0x128>(x); x += dpp_f<0x124>(x); x += dpp_f<0x122>(x); x += dpp_f<0x121>(x);
  return x;
}
template <class T> __device__ __forceinline__ T sel(bool c, T a, T b) { return c ? a : b; }
__device__ __forceinline__ int opaque_tid_w(int wid) {
  int l;
  asm volatile("v_mbcnt_lo_u32_b32 %0, -1, 0\n\tv_mbcnt_hi_u32_b32 %0, -1, %0" : "=v"(l));
  return wid * 64 + l;
}
#define opaque_tid() opaque_tid_w(wid_u)
__device__ __forceinline__ float wave_sum(float v) {
  v = row16_sum(v);
  const float a = __int_as_float(__builtin_amdgcn_readlane(__float_as_int(v), 0)), b = __int_as_float(__builtin_amdgcn_readlane(__float_as_int(v), 16));
  const float c = __int_as_float(__builtin_amdgcn_readlane(__float_as_int(v), 32)), d = __int_as_float(__builtin_amdgcn_readlane(__float_as_int(v), 48));
  return (a + b) + (c + d);
}
__device__ __forceinline__ float quad_sum(float x) { x += dpp_f<0xB1>(x); x += dpp_f<0x4E>(x); return x; }
__device__ __forceinline__ int seq_start(int s) { return s < 8 ? s * 4096 : NPROMPT + (s - 8) * 8192; }
__device__ __forceinline__ void row_seq(int row, int& s, int& t, int& T) {
  if (row < NPROMPT) { s = row >> 12; t = row & 4095; T = 4096; }
  else { int r = row - NPROMPT; s = 8 + (r >> 13); t = r & 8191; T = 8192; }
}

__device__ __forceinline__ void tr_tile(const float* __restrict__ src, int ldsrc, int k0, int n0, int nvalid, bf16_t* __restrict__ dst, int ldd,
                        int kdst0, int mode, float* sm, const int tid) {
#pragma unroll
  for (int i = 0; i < 2; ++i) {
    const int r = (tid >> 4) + 32 * i, c = (tid & 15) * 4;
    float4 v = make_float4(0.f, 0.f, 0.f, 0.f);
    if (n0 + c < nvalid) v = *(const float4*)(src + (size_t)(k0 + r) * ldsrc + n0 + c);
    float* d = sm + r * 65 + c;
    d[0] = v.x; d[1] = v.y; d[2] = v.z; d[3] = v.w;
  }
  __syncthreads();
  {
    const int n = tid >> 3, kc = (tid & 7) * 8;
    float o[8];
#pragma unroll
    for (int j = 0; j < 8; ++j) o[j] = sm[(kc + j) * 65 + n];
    int nn = n0 + n, drow;
    const int c32 = nn & 31, slot = 16 * ((c32 >> 2) & 1) + 4 * (c32 >> 3) + (c32 & 3);
    if (mode == 0) drow = (nn & ~31) + slot;
    else drow = 256 * (nn >> 7) + (mode == 2 ? 128 : 0) + ((nn & 127) & ~31) + slot;
    *(uint4*)(dst + (size_t)drow * ldd + kdst0 + k0 + kc) = pack8(o);
  }
  __syncthreads();
}

__device__ __forceinline__ void prep_phase(PREF p, char* smem, const int wid_u) {
  float* sm = (float*)smem;
  const int tid = opaque_tid();
  constexpr int N_MOD = 144, N_EFF = 128, N_W13 = 4 * 704, N_W2 = 2 * 704, N_WIN = 640, N_WOUT = 128;
  constexpr int TOTAL = N_MOD + N_EFF + N_W13 + N_W2 + N_WIN + N_WOUT;
  for (int item = blockIdx.x; item < TOTAL; item += gridDim.x) {
    int it = item;
    if (it < N_MOD) {
      const int j0 = it * 64;
      float* sc = sm;
      float* red = sm + 16384;
      for (int idx = tid; idx < 16384; idx += NTHR) {
        const int s = idx >> 10, k = idx & 1023;
        const float* cp_ = p.c_prompt; const float* cs_ = p.c_sample;
        const float c = s < 8 ? cp_[s * 1024 + k] : cs_[(s - 8) * 1024 + k];
        sc[idx] = c / (1.f + __expf(-c));
      }
      __syncthreads();
      const int col = tid & 63, kg = tid >> 6;
      float acc[16];
#pragma unroll
      for (int s = 0; s < 16; ++s) acc[s] = 0.f;
      for (int k = kg * 128; k < kg * 128 + 128; ++k) {
        const float w = p.ada_w[(size_t)k * 9216 + j0 + col];
#pragma unroll
        for (int s = 0; s < 16; ++s) acc[s] += sc[s * 1024 + k] * w;
      }
#pragma unroll
      for (int s = 0; s < 16; ++s) red[(kg * 16 + s) * 64 + col] = acc[s];
      __syncthreads();
      for (int o = tid; o < 1024; o += NTHR) {
        const int s = o >> 6, c2 = o & 63;
        float v = p.ada_b[j0 + c2];
#pragma unroll
        for (int g = 0; g < 8; ++g) v += red[(g * 16 + s) * 64 + c2];
        P_MOD[s * 9216 + j0 + c2] = v;
      }
      __syncthreads();
      continue;
    }
    it -= N_MOD;
    if (it < N_EFF) {
      const int g = it >> 5, itile = (it >> 4) & 1, ntile = it & 15;
      float* As = sm;
      float* Bs = sm + 64 * 129;
      for (int idx = tid; idx < 64 * 128; idx += NTHR) {
        const int i = idx >> 7, j = idx & 127;
        As[i * 129 + j] = p.pool_w[((size_t)g * 128 + itile * 64 + i) * 128 + j] * p.pool_scale[g * 128 + j];
      }
      for (int idx = tid; idx < 128 * 64; idx += NTHR) {
        const int j = idx >> 6, nn = idx & 63;
        Bs[j * 65 + nn] = p.w_out[(size_t)(g * 128 + j) * 1024 + ntile * 64 + nn];
      }
      __syncthreads();
      const int i = tid >> 3, nn0 = (tid & 7) * 8;
      float acc[8];
#pragma unroll
      for (int q = 0; q < 8; ++q) acc[q] = 0.f;
      for (int j = 0; j < 128; ++j) {
        const float a = As[i * 129 + j];
#pragma unroll
        for (int q = 0; q < 8; ++q) acc[q] += a * Bs[j * 65 + nn0 + q];
      }
#pragma unroll
      for (int q = 0; q < 8; ++q)
      {
        const int nn = ntile * 64 + nn0 + q, c32 = nn & 31, slot = 16 * ((c32 >> 2) & 1) + 4 * (c32 >> 3) + (c32 & 3);
        P_WOUTT[(size_t)((nn & ~31) + slot) * 1024 + g * 128 + itile * 64 + i] = (bf16_t)(cvt_pk_bf16(acc[q], 0.f) & 0xffff);
      }
      __syncthreads();
      continue;
    }
    it -= N_EFF;
    if (it < N_W13) {
      const int which = it / 704, r = it % 704;
      const int kt = r / 44, ntl = r % 44;
      const float* src = sel(which < 2, sel(which == 0, p.f1_w1, p.f1_w3), sel(which == 2, p.f2_w1, p.f2_w3));
      bf16_t* dst = sel(which < 2, P_W13A, P_W13B);
      tr_tile(src, FF, kt * 64, ntl * 64, FF, dst, D, 0, (which & 1) ? 2 : 1, sm, tid);
      continue;
    }
    it -= N_W13;
    if (it < N_W2) {
      const int which = it / 704, r = it % 704;
      const int kt = r / 16, ntl = r % 16;
      tr_tile(sel(which != 0, p.f2_w2, p.f1_w2), D, kt * 64, ntl * 64, D, sel(which != 0, P_W2B, P_W2A), FF, 0, 0, sm, tid);
      continue;
    }
    it -= N_W2;
    if (it < N_WIN) {
      const int kt = it / 40, ntl = it % 40;
      tr_tile(p.w_in, PINW, kt * 64, ntl * 64, PINW, P_WINT, D, 0, 0, sm, tid);
      continue;
    }
    it -= N_WIN;
    {
      const int kt = it / 16, ntl = it % 16;
      tr_tile(p.w_out + (size_t)512 * 1024, D, kt * 64, ntl * 64, D, P_WOUTT, D, 512, 0, sm, tid);
    }
  }
}

template <int MODE>
__device__ __forceinline__ void row_phase(const float* __restrict__ xp, const float* __restrict__ xs, float* __restrict__ xout,
                          const bf16_t* __restrict__ y, bf16_t* __restrict__ h, const float* __restrict__ mod,
                          const float* __restrict__ npost, const float* __restrict__ npre, int gate_idx, float cgate, int shift_idx, const int wid_u,
                          const bool xin_bf = false) {
  const int tid_ = opaque_tid();
  const int lane = tid_ & 63;
  const int gw = blockIdx.x * 8 + (tid_ >> 6), GW = gridDim.x * 8;
  for (int chunk = gw; chunk < NTOK / 16; chunk += GW) {
    const int row0 = chunk * 16;
    int s, t, T;
    row_seq(row0, s, t, T);
    const float* md = mod + s * 9216;
    f32x4 Am[4], Bm[4], Gm[4];
#pragma unroll
    for (int i = 0; i < 4; ++i) {
      const int c = i * 256 + lane * 4;
      if (MODE != 2) {
        f32x4 np = *(const f32x4*)(npre + c), sc = *(const f32x4*)(md + (shift_idx + 1) * 1024 + c);
        Am[i] = np * (sc + 1.f);
        Bm[i] = *(const f32x4*)(md + shift_idx * 1024 + c);
      }
      if (MODE != 0) {
        f32x4 g = *(const f32x4*)(md + gate_idx * 1024 + c), po = *(const f32x4*)(npost + c);
        Gm[i] = g * po * cgate;
      }
    }
    for (int r = 0; r < 16; ++r) {
      const int row = row0 + r;
      const float* xr = (row < NPROMPT) ? xp + (size_t)row * D : xs + (size_t)(row - NPROMPT) * D;
      f32x4 xv[4];
      if (MODE != 0 && xin_bf) {
        const bf16_t* xb = (const bf16_t*)(xout + (size_t)row * D) + 1024;
#pragma unroll
        for (int i = 0; i < 4; ++i) {
          const u32x2 u = __builtin_nontemporal_load((const u32x2*)(xb + i * 256 + lane * 4));
          xv[i] = (f32x4){bf_lo(u.x), bf_hi(u.x), bf_lo(u.y), bf_hi(u.y)};
        }
      } else {
#pragma unroll
        for (int i = 0; i < 4; ++i) xv[i] = __builtin_nontemporal_load((const f32x4*)(xr + i * 256 + lane * 4));
      }
      if (MODE != 0) {
        f32x4 yv[4];
        float ss = 0.f;
#pragma unroll
        for (int i = 0; i < 4; ++i) {
          const u32x2 u = __builtin_nontemporal_load((const u32x2*)(y + (size_t)row * D + i * 256 + lane * 4));
          yv[i] = (f32x4){bf_lo(u.x), bf_hi(u.x), bf_lo(u.y), bf_hi(u.y)};
          ss += yv[i][0] * yv[i][0] + yv[i][1] * yv[i][1] + yv[i][2] * yv[i][2] + yv[i][3] * yv[i][3];
        }
        ss = wave_sum(ss);
        const float rs = rsqrtf(ss * (1.f / 1024.f) + 1e-6f);
#pragma unroll
        for (int i = 0; i < 4; ++i) {
          xv[i] = xv[i] + Gm[i] * yv[i] * rs;
          if (MODE == 2) __builtin_nontemporal_store(xv[i], (f32x4*)(xout + (size_t)row * D + i * 256 + lane * 4));
          else {
            uint2 u; u.x = cvt_pk_bf16(xv[i][0], xv[i][1]); u.y = cvt_pk_bf16(xv[i][2], xv[i][3]);
            *(uint2*)((bf16_t*)(xout + (size_t)row * D) + 1024 + i * 256 + lane * 4) = u;
          }
        }
      }
      if (MODE != 2) {
        float ss = 0.f;
#pragma unroll
        for (int i = 0; i < 4; ++i) ss += xv[i][0] * xv[i][0] + xv[i][1] * xv[i][1] + xv[i][2] * xv[i][2] + xv[i][3] * xv[i][3];
        ss = wave_sum(ss);
        const float rs = rsqrtf(ss * (1.f / 1024.f) + 1e-6f);
#pragma unroll
        for (int i = 0; i < 4; ++i) {
          f32x4 hv = xv[i] * rs * Am[i] + Bm[i];
          uint2 u; u.x = cvt_pk_bf16(hv[0], hv[1]); u.y = cvt_pk_bf16(hv[2], hv[3]);
          *(uint2*)(h + (size_t)row * D + i * 256 + lane * 4) = u;
        }
      }
    }
  }
}

constexpr int BM = 256, BK = 64, HALF = 128, NXCD = 8, WGM = 4, HT = HALF * BK;
__device__ __forceinline__ int lds_byte(int r, int c) {
  int st = (r >> 4) * 2 + (c >> 5), rr = r & 15, cc = c & 31, ob = rr * 64 + cc * 2;
  return st * 1024 + (ob ^ (((ob >> 9) & 1) << 5));
}
__device__ __forceinline__ void stage_rc(int b, int& R, int& C) {
  int st = b / 1024, sb = b % 1024, swz = sb ^ (((sb >> 9) & 1) << 5);
  R = (st >> 1) * 16 + swz / 64; C = (st & 1) * 32 + (swz % 64) / 2;
}

__device__ __forceinline__ bool gemm_unit(int i, int nM, int nN, int nwg, int& pm, int& pn) {
  const long L = (long)i * gridDim.x + blockIdx.x;
  if (L >= nwg) return false;
  int wgid = (int)L;
  { int q = nwg / NXCD, r = nwg % NXCD, xcd = wgid % NXCD, off = wgid / NXCD;
    wgid = (xcd < r ? xcd * (q + 1) : r * (q + 1) + (xcd - r) * q) + off; }
  const int nig = WGM * nN, gid = wgid / nig, fm = gid * WGM, gsz = min(nM - fm, WGM);
  pm = fm + ((wgid % nig) % gsz); pn = (wgid % nig) / gsz;
  return true;
}

__device__ __forceinline__ void gemm_phase(const bf16_t* __restrict__ A, const bf16_t* __restrict__ Bt, bf16_t* __restrict__ C, int M, int N, int K,
                                           int ldc, const int EPI, char* smem, const int wid_u) {
  const int nM = M / BM, nN = N / BM, nwg = nM * nN;
  const int tid = opaque_tid();
  LAS bf16_t* shm = (LAS bf16_t*)smem;
#define SA(b, h) (shm + ((b) * 2 + (h)) * HT)
#define SB(b, h) (shm + (4 + (b) * 2 + (h)) * HT)
#define STG(P, GB) do { const char* _gb = (GB); \
    _Pragma("unroll") for (int _i = 0; _i < 2; ++_i) { \
      __builtin_amdgcn_global_load_lds((const unsigned*)(_gb + voff[_i]), \
        (LAS unsigned*)((LAS char*)(P) + ldsw + _i * 8192), 16, 0, 0); } } while (0)
#define LDA(dst, b, h) _Pragma("unroll") for (int m = 0; m < 4; ++m) _Pragma("unroll") for (int k = 0; k < 2; ++k) \
    dst[m][k] = *(const LAS bf16x8*)((LAS char*)SA(b, h) + aoff + m * 2048 + k * 1024)
#define LDB(dst, b, h) _Pragma("unroll") for (int n = 0; n < 2; ++n) _Pragma("unroll") for (int k = 0; k < 2; ++k) \
    dst[n][k] = *(const LAS bf16x8*)((LAS char*)SB(b, h) + boff + n * 2048 + k * 1024)
#define MMA(ai, bj, At_, Bt_) do { __builtin_amdgcn_s_setprio(1); \
    _Pragma("unroll") for (int m = 0; m < 4; ++m) _Pragma("unroll") for (int n = 0; n < 2; ++n) _Pragma("unroll") for (int k = 0; k < 2; ++k) \
      acc[ai][bj][m][n] = __builtin_amdgcn_mfma_f32_16x16x32_bf16(Bt_[n][k], At_[m][k], acc[ai][bj][m][n], 0, 0, 0); \
    __builtin_amdgcn_s_setprio(0); } while (0)
#define WAIT_V(n) asm volatile("s_waitcnt vmcnt(" #n ")" ::: "memory")
#define WAIT_L(n) asm volatile("s_waitcnt lgkmcnt(" #n ")" ::: "memory")
#define BAR __builtin_amdgcn_s_barrier()
#define SCHED __builtin_amdgcn_sched_barrier(0)
  const int wid = __builtin_amdgcn_readfirstlane(tid >> 6), lane = tid & 63, wr = wid >> 2, wc = wid & 3, fr = lane & 15, fq = lane >> 4;
  const int aoff = lds_byte(wr * 64 + fr, fq * 8), boff = lds_byte(wc * 32 + fr, fq * 8);
  unsigned voff[2];
  const int ldsw = wid * 1024;
#pragma unroll
  for (int _i = 0; _i < 2; ++_i) { int _r, _c; stage_rc(tid * 16 + _i * 8192, _r, _c); voff[_i] = (unsigned)(_r * K + _c) * 2u; }
  const int nt = K / BK;
  const size_t kstep = (size_t)BK * 2, hstep = (size_t)HALF * K * 2, tstep = 2 * hstep;
  int pm, pn, npm = 0, npn = 0, ui = 0;
  if (!gemm_unit(0, nM, nN, nwg, pm, pn)) return;
  f32x4 acc[2][2][4][2];
#pragma unroll
  for (int a = 0; a < 2; ++a)
#pragma unroll
    for (int b = 0; b < 2; ++b)
#pragma unroll
      for (int m = 0; m < 4; ++m)
#pragma unroll
        for (int n = 0; n < 2; ++n) acc[a][b][m][n] = (f32x4){0.f, 0.f, 0.f, 0.f};
  bf16x8 At[4][2], B0[2][2], B1[2][2];
  const char* cA = (const char*)A + (size_t)pm * tstep;
  const char* cB = (const char*)Bt + (size_t)pn * tstep;
  STG(SB(0, 0), cB); STG(SA(0, 0), cA); STG(SB(0, 1), cB + hstep); STG(SA(0, 1), cA + hstep);
  if (wr == 1) BAR;
  WAIT_V(4); BAR;
  STG(SB(1, 0), cB + kstep); STG(SA(1, 0), cA + kstep); STG(SB(1, 1), cB + hstep + kstep);
  WAIT_V(6); BAR;
  for (;;) {
    const bool has_next = gemm_unit(ui + 1, nM, nN, nwg, npm, npn);
    const char* nA = has_next ? (const char*)A + (size_t)npm * tstep : cA;
    const char* nB = has_next ? (const char*)Bt + (size_t)npn * tstep : cB;
    for (int t = 0; t < nt; t += 2) {
      const bool last = (t == nt - 2);
      const char* a1 = cA + (size_t)(t + 1) * kstep;
      const char* a2 = last ? nA : cA + (size_t)(t + 2) * kstep;
      const char* b2 = last ? nB : cB + (size_t)(t + 2) * kstep;
      const char* a3 = a2 + kstep;
      const char* b3 = b2 + kstep;
      LDB(B0, 0, 0); SCHED; LDA(At, 0, 0); STG(SA(1, 1), a1 + hstep);
      WAIT_L(8); BAR; WAIT_L(0); MMA(0, 0, At, B0); BAR; SCHED;
      LDB(B1, 0, 1); STG(SB(0, 0), b2);
      BAR; WAIT_L(0); MMA(0, 1, At, B1); BAR;
      LDA(At, 0, 1); STG(SA(0, 0), a2);
      BAR; WAIT_L(0); MMA(1, 0, At, B0); BAR; SCHED;
      STG(SB(0, 1), b2 + hstep);
      WAIT_V(6); BAR; MMA(1, 1, At, B1); BAR;
      LDB(B0, 1, 0); SCHED; LDA(At, 1, 0); STG(SA(0, 1), a2 + hstep);
      WAIT_L(8); BAR; WAIT_L(0); MMA(0, 0, At, B0); BAR; SCHED;
      LDB(B1, 1, 1); STG(SB(1, 0), b3);
      BAR; WAIT_L(0); MMA(0, 1, At, B1); BAR;
      LDA(At, 1, 1); STG(SA(1, 0), a3);
      BAR; WAIT_L(0); MMA(1, 0, At, B0); BAR; SCHED;
      STG(SB(1, 1), b3 + hstep);
      WAIT_V(6); BAR; MMA(1, 1, At, B1); BAR;
    }
    {
      const int brow = pm * BM, bcol = pn * BM;
#pragma unroll
      for (int ai = 0; ai < 2; ++ai)
#pragma unroll
        for (int m = 0; m < 4; ++m) {
          const size_t row = (size_t)(brow + ai * HALF + wr * 64 + m * 16 + fr);
          if (EPI == 0) {
#pragma unroll
            for (int bj = 0; bj < 2; ++bj) {
              const f32x4 v0 = acc[ai][bj][m][0], v1 = acc[ai][bj][m][1];
              uint4 u; u.x = cvt_pk_bf16(v0[0], v0[1]); u.y = cvt_pk_bf16(v0[2], v0[3]); u.z = cvt_pk_bf16(v1[0], v1[1]); u.w = cvt_pk_bf16(v1[2], v1[3]);
              *(uint4*)(C + row * ldc + bcol + bj * HALF + wc * 32 + fq * 8) = u;
            }
          } else {
            float o[8];
#pragma unroll
            for (int n = 0; n < 2; ++n) {
              const f32x4 a = acc[ai][0][m][n], b = acc[ai][1][m][n];
#pragma unroll
              for (int j = 0; j < 4; ++j) o[n * 4 + j] = a[j] * __builtin_amdgcn_rcpf(1.f + __expf(-a[j])) * b[j];
            }
            *(uint4*)(C + row * ldc + (bcol >> 1) + wc * 32 + fq * 8) = pack8(o);
          }
        }
    }
    if (!has_next) break;
#pragma unroll
    for (int a = 0; a < 2; ++a)
#pragma unroll
      for (int b = 0; b < 2; ++b)
#pragma unroll
        for (int m = 0; m < 4; ++m)
#pragma unroll
          for (int n = 0; n < 2; ++n) acc[a][b][m][n] = (f32x4){0.f, 0.f, 0.f, 0.f};
    pm = npm; pn = npn; cA = nA; cB = nB; ++ui;
  }
  WAIT_V(0);
  if (wr == 0) BAR;
  BAR;
#undef SA
#undef SB
#undef STG
#undef LDA
#undef LDB
#undef MMA
}

__device__ __forceinline__ void load_shift16(const bf16_t* __restrict__ z, int row, int t, int T, int col, const float* __restrict__ mu, float* o) {
  const bf16_t* pz = z + (size_t)row * ZLD + col;
  uint4 c0 = *(const uint4*)pz, c1 = *(const uint4*)(pz + 8);
  uint4 p0 = make_uint4(0, 0, 0, 0), p1 = p0, n0 = p0, n1 = p0;
  if (t > 0) { p0 = *(const uint4*)(pz - ZLD); p1 = *(const uint4*)(pz - ZLD + 8); }
  if (t < T - 1) { n0 = *(const uint4*)(pz + ZLD); n1 = *(const uint4*)(pz + ZLD + 8); }
  float c[16], pv[16], nx[16];
  unpack8(c0, c); unpack8(c1, c + 8); unpack8(p0, pv); unpack8(p1, pv + 8); unpack8(n0, nx); unpack8(n1, nx + 8);
#pragma unroll
  for (int q = 0; q < 16; ++q) o[q] = c[q] + (0.5f * (pv[q] + nx[q]) - c[q]) * mu[col - 512 + q];
}
__device__ __forceinline__ void load_shift8(const bf16_t* __restrict__ z, int row, int t, int T, int col, const float* __restrict__ mu, float* o) {
  const bf16_t* pz = z + (size_t)row * ZLD + col;
  uint4 c0 = *(const uint4*)pz;
  uint4 p0 = make_uint4(0, 0, 0, 0), n0 = p0;
  if (t > 0) p0 = *(const uint4*)(pz - ZLD);
  if (t < T - 1) n0 = *(const uint4*)(pz + ZLD);
  float c[8], pv[8], nx[8];
  unpack8(c0, c); unpack8(p0, pv); unpack8(n0, nx);
#pragma unroll
  for (int q = 0; q < 8; ++q) o[q] = c[q] + (0.5f * (pv[q] + nx[q]) - c[q]) * mu[col - 512 + q];
}

constexpr int TC = 32;
constexpr int SV = TC * 64;
struct Raw8 { uint4 c, p, n; };
__device__ __forceinline__ void lp_load(Raw8& r, const bf16_t* __restrict__ z, int task) {
  r.c = make_uint4(0, 0, 0, 0); r.p = r.c; r.n = r.c;
  if (task < NTOK * 32) {
    const int row = task >> 5, oc = task & 31;
    int s, t, T;
    row_seq(row, s, t, T);
    const bf16_t* pz = z + (size_t)row * ZLD + 2048 + oc * 8;
    r.c = *(const uint4*)pz;
    if (t > 0) r.p = *(const uint4*)(pz - ZLD);
    if (t < T - 1) r.n = *(const uint4*)(pz + ZLD);
  }
}
__device__ __forceinline__ void lp_store(const Raw8& r, bf16_t* __restrict__ al, const float* __restrict__ mu, int task) {
  if (task < NTOK * 32) {
    const int row = task >> 5, oc = task & 31;
    float c[8], pv[8], nx[8], o[8];
    unpack8(r.c, c); unpack8(r.p, pv); unpack8(r.n, nx);
#pragma unroll
    for (int q = 0; q < 8; ++q) o[q] = c[q] + (0.5f * (pv[q] + nx[q]) - c[q]) * mu[2048 - 512 + oc * 8 + q];
    if (oc < 16) {
#pragma unroll
      for (int q = 0; q < 8; ++q) { const float e = __expf(2.f * o[q]); o[q] = 1.f - 2.f * __builtin_amdgcn_rcpf(e + 1.f); }
    }
    *(uint4*)(al + (size_t)row * 256 + oc * 8) = pack8(o);
  }
}
__device__ __forceinline__ void lora_prep_phase(PREF p, const int wid_u) {
  const int tid = opaque_tid();
  const bf16_t* z = P_RU;
  bf16_t* al = P_ALORA;
  const float* mu = p.shift_mu;
  const int stride = gridDim.x * NTHR;
#pragma unroll 1
  for (int task0 = blockIdx.x * NTHR + tid; task0 < NTOK * 32; task0 += 4 * stride) {
    Raw8 r0, r1, r2, r3;
    lp_load(r0, z, task0); lp_load(r1, z, task0 + stride); lp_load(r2, z, task0 + 2 * stride); lp_load(r3, z, task0 + 3 * stride);
    lp_store(r0, al, mu, task0); lp_store(r1, al, mu, task0 + stride); lp_store(r2, al, mu, task0 + 2 * stride); lp_store(r3, al, mu, task0 + 3 * stride);
  }
}

template <int HALF>
__device__ __forceinline__ void pool_seg(const bf16_t* __restrict__ z, bf16_t* __restrict__ mo, int row_base, int tbase, int T, int c0) {
  constexpr int NR = 2 * HALF + 3;
  float acc[4][8], zc[4][8];
#pragma unroll
  for (int i = 0; i < 4; ++i)
#pragma unroll
    for (int q = 0; q < 8; ++q) { acc[i][q] = 0.f; zc[i][q] = 0.f; }
#pragma unroll
  for (int r = 0; r < NR; ++r) {
    const int tt = tbase - HALF + r;
    uint4 u = make_uint4(0, 0, 0, 0);
    if (tt >= 0 && tt < T) u = *(const uint4*)(z + (size_t)(row_base - HALF + r) * ZLD + c0);
    float v[8];
    unpack8(u, v);
#pragma unroll
    for (int i = 0; i < 4; ++i) {
      if (r >= i && r < i + 2 * HALF) {
#pragma unroll
        for (int q = 0; q < 8; ++q) acc[i][q] += v[q];
      }
      if (r == HALF + i) {
#pragma unroll
        for (int q = 0; q < 8; ++q) zc[i][q] = v[q];
      }
    }
  }
#pragma unroll
  for (int i = 0; i < 4; ++i) {
    const int ti = tbase + i;
    const float ic = 1.f / (float)(min(ti + HALF, T) - max(ti - HALF, 0));
    float o[8];
#pragma unroll
    for (int q = 0; q < 8; ++q) o[q] = acc[i][q] * ic - zc[i][q];
    *(uint4*)(mo + (size_t)(row_base + i) * D + c0) = pack8(o);
  }
}
__device__ __forceinline__ void pool_tile(const bf16_t* __restrict__ z, bf16_t* __restrict__ mo, int tile, int tid) {
  const int row0 = tile * 32;
  int s, t0, T;
  row_seq(row0, s, t0, T);
  const int oc = tid >> 3, seg = tid & 7, c0 = oc * 8, grp = __builtin_amdgcn_readfirstlane(oc >> 4);
  const int rb = row0 + seg * 4, tb = t0 + seg * 4;
  if (grp == 0) pool_seg<1>(z, mo, rb, tb, T, c0);
  else if (grp == 1) pool_seg<2>(z, mo, rb, tb, T, c0);
  else if (grp == 2) pool_seg<4>(z, mo, rb, tb, T, c0);
  else pool_seg<8>(z, mo, rb, tb, T, c0);
}

struct Raw16 { uint4 c0, c1, p0, p1, n0, n1; };
__device__ __forceinline__ void load_raw16(Raw16& r, const bf16_t* __restrict__ z, int row, int t, int T, int col) {
  const bf16_t* pz = z + (unsigned)(row * ZLD + col);
  r.c0 = *(const uint4*)pz; r.c1 = *(const uint4*)(pz + 8);
  r.p0 = make_uint4(0, 0, 0, 0); r.p1 = r.p0; r.n0 = r.p0; r.n1 = r.p0;
  if (t > 0) { r.p0 = *(const uint4*)(pz - ZLD); r.p1 = *(const uint4*)(pz - ZLD + 8); }
  if (t < T - 1) { r.n0 = *(const uint4*)(pz + ZLD); r.n1 = *(const uint4*)(pz + ZLD + 8); }
}
__device__ __forceinline__ void shift16(const Raw16& r, const float* c1, const float* c2, float* o) {
  float c[16], pv[16], nx[16];
  unpack8(r.c0, c); unpack8(r.c1, c + 8); unpack8(r.p0, pv); unpack8(r.p1, pv + 8); unpack8(r.n0, nx); unpack8(r.n1, nx + 8);
#pragma unroll
  for (int q = 0; q < 16; ++q) o[q] = c[q] * c1[q] + (pv[q] + nx[q]) * c2[q];
}
__device__ __forceinline__ bf16x8 ldfrag(const bf16_t* base, int stride, int row0, int k0, int fr, int fq) {
  return *reinterpret_cast<const bf16x8*>(base + (row0 + fr) * stride + k0 + fq * 8);
}
__device__ __forceinline__ uint2 pack4(f32x4 v) { uint2 u; u.x = cvt_pk_bf16(v[0], v[1]); u.y = cvt_pk_bf16(v[2], v[3]); return u; }
#define MFMA16(a, b, c) __builtin_amdgcn_mfma_f32_16x16x32_bf16(a, b, c, 0, 0, 0)

constexpr int CS_NAB = 0, CS_NAK = 4096, CS_NBRT = 8192, CS_NKRT = 10752, CS_QT = 13312, CS_W = 15872, CS_Z = 20992, CS_GT = 26112,
              CS_RYT = 35328, CS_VN = 39936;
constexpr int CS_AT = 49152, CS_RT = CS_AT + 4608, CS_BT = CS_RT + 4608, CS_KT = CS_BT + 4608, CS_BB = 67584, CS_KB = CS_BB + 5120,
              CS_VT = CS_KB + 5120, CS_ATT = 82944, CS_PL = 92160, CS_SBF = 92416, CS_STEP = 110848, CS_CST = 160000;

__device__ __forceinline__ void lds_barrier() {
  asm volatile("s_waitcnt lgkmcnt(0)" ::: "memory");
  __builtin_amdgcn_s_barrier();
  asm volatile("" ::: "memory");
}
template <int Q> __device__ __forceinline__ float quad_bcast(float x) { return dpp_f<Q * 0x55>(x); }

template <int S0> __device__ __forceinline__ void solve_steps(float (&x)[8], const float* nab, int seg) {
  if constexpr (S0 < 32) {
    const float xs = quad_bcast<(S0 >> 3)>(x[S0 & 7]);
    const f32x4 n0 = *(const f32x4*)(nab + S0 * 32 + seg * 8), n1 = *(const f32x4*)(nab + S0 * 32 + seg * 8 + 4);
    x[0] += xs * n0[0]; x[1] += xs * n0[1]; x[2] += xs * n0[2]; x[3] += xs * n0[3];
    x[4] += xs * n1[0]; x[5] += xs * n1[1]; x[6] += xs * n1[2]; x[7] += xs * n1[3];
    solve_steps<S0 + 1>(x, nab, seg);
  }
}

template <int S0> __device__ __forceinline__ void solve16(float (&x)[8], const float* nb) {
  if constexpr (S0 < 16) {
    const float xs = (S0 >> 3) ? dpp_f<0xF5>(x[S0 & 7]) : dpp_f<0xA0>(x[S0 & 7]);
    const f32x4 n0 = *(const f32x4*)(nb + S0 * 32), n1 = *(const f32x4*)(nb + S0 * 32 + 4);
    x[0] += xs * n0[0]; x[1] += xs * n0[1]; x[2] += xs * n0[2]; x[3] += xs * n0[3];
    x[4] += xs * n1[0]; x[5] += xs * n1[1]; x[6] += xs * n1[2]; x[7] += xs * n1[3];
    if constexpr ((S0 & 3) == 3) __builtin_amdgcn_sched_barrier(0);
    solve16<S0 + 1>(x, nb);
  }
}

__device__ __forceinline__ void scan_phase(PREF p, char* smem, const int wid_u) {
  float* stepbuf = (float*)(smem + CS_STEP);
  float* Nab = (float*)(smem + CS_NAB);
  bf16_t* NakT = (bf16_t*)(smem + CS_NAK);
  bf16_t* VNb = (bf16_t*)(smem + CS_VN);
  bf16_t* T11b = (bf16_t*)(smem + CS_VN + 5120);
  bf16_t* M1T = (bf16_t*)(smem + CS_VN + 5120 + 1280);
  bf16_t* NbrT = (bf16_t*)(smem + CS_NBRT);
  bf16_t* NkrT = (bf16_t*)(smem + CS_NKRT);
  bf16_t* TT = (bf16_t*)(smem + CS_QT);
  bf16_t* Wb = (bf16_t*)(smem + CS_W);
  bf16_t* Zb = (bf16_t*)(smem + CS_Z);
  bf16_t* GT = (bf16_t*)(smem + CS_GT);
  bf16_t* RyT = (bf16_t*)(smem + CS_RYT);
  bf16_t* At = (bf16_t*)(smem + CS_AT);
  bf16_t* Rt = (bf16_t*)(smem + CS_RT);
  bf16_t* Bt = (bf16_t*)(smem + CS_BT);
  bf16_t* Kt = (bf16_t*)(smem + CS_KT);
  bf16_t* Bb = (bf16_t*)(smem + CS_BB);
  bf16_t* Kb = (bf16_t*)(smem + CS_KB);
  bf16_t* VT = (bf16_t*)(smem + CS_VT);
  bf16_t* AtTb = (bf16_t*)(smem + CS_ATT);
  float* PLs = (float*)(smem + CS_PL);
  bf16_t* Sbf = (bf16_t*)(smem + CS_SBF);
  float* cst = (float*)(smem + CS_CST);
  const bf16_t* z = P_RU;
  const int tid = opaque_tid();
  const int wave = __builtin_amdgcn_readfirstlane(tid >> 6), lane = tid & 63, fr = lane & 15, fq = lane >> 4;
  const int item = blockIdx.x;
  if (item < 256) {
    const int s = item < 128 ? 8 + (item >> 4) : ((item - 128) >> 4);
    const int h = (item & 15) >> 1, d = item & 1;
    const int T = s < 8 ? 4096 : 8192, r0seq = seq_start(s), nch = T / 32;
    bf16_t* yout = P_RY + (size_t)d * NTOK * 512;
    {
      const int g = tid >> 6, k = tid & 63;
      const float muk = p.shift_mu[1024 - 512 + h * 64 + k], mur = p.shift_mu[512 - 512 + h * 64 + k], muv = p.shift_mu[1536 - 512 + h * 64 + k];
      float v;
      if (g == 0) v = 0.5f * muk;
      else if (g == 1) v = 0.5f * mur;
      else if (g == 2) v = 1.f - muk;
      else if (g == 3) v = 1.f - mur;
      else if (g == 4) v = 1.f - muv;
      else if (g == 5) v = p.k_k[h * 64 + k];
      else if (g == 6) v = p.k_a[h * 64 + k];
      else v = p.r_k[h * 64 + k];
      cst[g * 64 + k] = v;
      if (g == 0) cst[8 * 64 + k] = 0.5f * muv;
      for (int i = tid; i < 2 * 64 * 72 / 2; i += NTHR) ((unsigned*)Sbf)[i] = 0u;
    }
    const int role = wave >> 1, th = wave & 1;
    const int tl = lane >> 2, cq = lane & 3;
    uint4* Btab0 = (uint4*)(p.ws + OFF_BTAB);
    const unsigned bti = (unsigned)(item * 1024 + (role & 1) * 512 + lane);
    float bias[4] = {0.f, 0.f, 0.f, 0.f};
    if (role < 2) {
      const float* lsrc = sel(role != 0, p.a2, p.w2) + (size_t)d * 64 * 512 + h * 64;
      if (th == 0) {
#pragma unroll
        for (int nt = 0; nt < 4; ++nt)
#pragma unroll
          for (int ks = 0; ks < 2; ++ks) {
            float o[8];
#pragma unroll
            for (int q = 0; q < 8; ++q) o[q] = lsrc[(size_t)(ks * 32 + fq * 8 + q) * 512 + nt * 16 + fr];
            Btab0[bti + (unsigned)((nt * 2 + ks) * 64)] = pack8(o);
          }
      }
#pragma unroll
      for (int nt = 0; nt < 4; ++nt) bias[nt] = sel(role != 0, p.a0, p.w0)[d * 512 + h * 64 + nt * 16 + fr];
    }
    const int colA = (role == 2 ? 512 : 1024) + h * 64 + cq * 16;
    const int colB = 1536 + h * 64 + cq * 16;
    const int alo = (role == 0 ? d * 64 : 128 + d * 64) + fq * 8;
    Raw16 ra, rb;
    {
      const int j = th * 16 + tl, t = d ? T - 1 - j : j, row = r0seq + t;
      if (role >= 2) load_raw16(ra, z, row, t, T, colA);
      if (role == 3) load_raw16(rb, z, row, t, T, colB);
      if (role < 2) {
        const int j2 = th * 16 + fr, t2 = d ? T - 1 - j2 : j2;
        const bf16_t* ap = P_ALORA + (unsigned)((r0seq + t2) * 256 + alo);
        ra.c0 = *(const uint4*)ap; ra.c1 = *(const uint4*)(ap + 32);
      }
    }
    f32x4 Sa = {0.f, 0.f, 0.f, 0.f}, Sb = Sa;
    uint2 y_def = make_uint2(0u, 0u);
    float sb_def = 0.f;
    const int mt = wave >> 1, hn = wave & 1, nt0 = 2 * hn, nt1 = 2 * hn + 1;
    asm volatile("s_waitcnt vmcnt(0)" ::: "memory");
    __syncthreads();

    {
      {
        const int j = th * 16 + tl;
        float v16[16];
        if (role < 2) {
          f32x4 acc[4] = {};
          unsigned bti_ = bti;
          asm volatile("" : "+v"(bti_));
#pragma unroll
          for (int ks = 0; ks < 2; ++ks) {
            const uint4 au = ks == 0 ? ra.c0 : ra.c1;
            const bf16x8 a = *reinterpret_cast<const bf16x8*>(&au);
#pragma unroll
            for (int nt = 0; nt < 4; ++nt) { const uint4 bu = Btab0[bti_ + (unsigned)((nt * 2 + ks) * 64)]; acc[nt] = MFMA16(a, *reinterpret_cast<const bf16x8*>(&bu), acc[nt]); }
          }
          if (role == 0) {
#pragma unroll
            for (int nt = 0; nt < 4; ++nt)
#pragma unroll
              for (int jj = 0; jj < 4; ++jj) {
                const float sg = sigmoidf_(bias[nt] + acc[nt][jj]);
                stepbuf[0 * SV + (th * 16 + fq * 4 + jj) * 64 + nt * 16 + fr] = __expf(-0.6065306597126334f * sg);
              }
            __builtin_amdgcn_wave_barrier();
            {
              float wl[16];
#pragma unroll
              for (int i = 0; i < 16; ++i) wl[i] = stepbuf[0 * SV + (th * 16 + i) * 64 + lane];
              float pr = 1.f;
#pragma unroll
              for (int i = 0; i < 16; ++i) { pr *= wl[i]; stepbuf[0 * SV + (th * 16 + i) * 64 + lane] = pr; }
            }
          } else {
#pragma unroll
            for (int nt = 0; nt < 4; ++nt)
#pragma unroll
              for (int jj = 0; jj < 4; ++jj) stepbuf[4 * SV + (th * 16 + fq * 4 + jj) * 64 + nt * 16 + fr] = sigmoidf_(bias[nt] + acc[nt][jj]);
          }
        } else if (role == 2) {
          shift16(ra, cst + 3 * 64 + cq * 16, cst + 1 * 64 + cq * 16, v16);
#pragma unroll
          for (int q = 0; q < 4; ++q) *(f32x4*)(stepbuf + 2 * SV + j * 64 + cq * 16 + q * 4) = (f32x4){v16[q * 4], v16[q * 4 + 1], v16[q * 4 + 2], v16[q * 4 + 3]};
        } else {
          shift16(ra, cst + 2 * 64 + cq * 16, cst + 0 * 64 + cq * 16, v16);
          float kk[16], ss = 0.f;
#pragma unroll
          for (int q = 0; q < 16; ++q) { kk[q] = v16[q] * cst[5 * 64 + cq * 16 + q]; ss += kk[q] * kk[q]; }
          ss = quad_sum(ss);
          const float inv = 1.f / fmaxf(sqrtf(ss), 1e-12f);
#pragma unroll
          for (int q = 0; q < 4; ++q) {
            *(f32x4*)(stepbuf + 1 * SV + j * 64 + cq * 16 + q * 4) = (f32x4){v16[q * 4], v16[q * 4 + 1], v16[q * 4 + 2], v16[q * 4 + 3]};
            *(f32x4*)(stepbuf + 3 * SV + j * 64 + cq * 16 + q * 4) = (f32x4){-kk[q * 4] * inv, -kk[q * 4 + 1] * inv, -kk[q * 4 + 2] * inv, -kk[q * 4 + 3] * inv};
          }
          shift16(rb, cst + 4 * 64 + cq * 16, cst + 8 * 64 + cq * 16, v16);
#pragma unroll
          for (int q = 0; q < 4; ++q) *(f32x4*)(stepbuf + 5 * SV + j * 64 + cq * 16 + q * 4) = (f32x4){v16[q * 4], v16[q * 4 + 1], v16[q * 4 + 2], v16[q * 4 + 3]};
        }
      }
      if (1 < nch) {
        const int is2 = 32 + th * 16 + tl;
        const int t2 = d ? T - 1 - is2 : is2;
        const int row2 = r0seq + t2;
        if (role >= 2) load_raw16(ra, z, row2, t2, T, colA);
        if (role == 3) load_raw16(rb, z, row2, t2, T, colB);
        if (role < 2) {
          const int is3 = 32 + th * 16 + fr, t3 = d ? T - 1 - is3 : is3;
          const bf16_t* ap = P_ALORA + (unsigned)((r0seq + t3) * 256 + alo);
          ra.c0 = *(const uint4*)ap; ra.c1 = *(const uint4*)(ap + 32);
        }
      }
      lds_barrier();
    }
    for (int c = 0; c < nch; ++c) {
      {
        const int k = lane, seg = wave;
        const float* sw = stepbuf + 0 * SV + k;
        const float P15 = sw[15 * 64];
        const float hiF = seg >= 4 ? P15 : 1.f;
        float P[5];
        P[0] = seg == 0 ? 1.f : sw[(4 * seg - 1) * 64] * (seg > 4 ? P15 : 1.f);
#pragma unroll
        for (int i = 0; i < 4; ++i) P[i + 1] = sw[(4 * seg + i) * 64] * hiF;
        const float PL = sw[31 * 64] * P15;
        if (role == 2) {
          const int j = th * 16 + tl;
          float bs = 0.f;
#pragma unroll
          for (int q = 0; q < 16; ++q) {
            const float kd_ = stepbuf[1 * SV + j * 64 + cq * 16 + q] * (1.f + (stepbuf[4 * SV + j * 64 + cq * 16 + q] - 1.f) * cst[6 * 64 + cq * 16 + q]);
            bs += stepbuf[2 * SV + j * 64 + cq * 16 + q] * kd_ * cst[7 * 64 + cq * 16 + q];
          }
          bs = quad_sum(bs);
          sb_def = bs;
        }
        f32x4 bb, kb, at, vv;
#pragma unroll
        for (int i = 0; i < 4; ++i) {
          const int t = 4 * seg + i;
          const float inv = __builtin_amdgcn_rcpf(P[i + 1]);
          const float nav = stepbuf[3 * SV + t * 64 + k], av = stepbuf[4 * SV + t * 64 + k];
          const float a_ = P[i] * nav;
          const float rraw = stepbuf[2 * SV + t * 64 + k];
          const float kraw = stepbuf[1 * SV + t * 64 + k] * (1.f + (av - 1.f) * cst[6 * 64 + k]);
          const float r_ = P[i + 1] * rraw;
          const float b_ = -nav * av * inv;
          const float k_ = kraw * inv;

          At[t * 72 + k] = (bf16_t)(cvt_pk_bf16(a_, 0.f) & 0xffff);
          Rt[t * 72 + k] = (bf16_t)(cvt_pk_bf16(r_, 0.f) & 0xffff);
          Bt[t * 72 + k] = (bf16_t)(cvt_pk_bf16(b_, 0.f) & 0xffff);
          Kt[t * 72 + k] = (bf16_t)(cvt_pk_bf16(k_, 0.f) & 0xffff);
          bb[i] = b_ * PL; kb[i] = k_ * PL; at[i] = a_;
          vv[i] = stepbuf[5 * SV + t * 64 + k];
        }
        *(uint2*)(Bb + k * 40 + 4 * seg) = pack4(bb);
        *(uint2*)(Kb + k * 40 + 4 * seg) = pack4(kb);
        *(uint2*)(VT + k * 40 + 4 * seg) = pack4(vv);
        *(uint2*)(AtTb + k * 40 + 4 * seg) = pack4(at);
        if (seg == 0) PLs[k] = PL;
      }
      lds_barrier();
      {
        const int mat = wave >> 1, mts = wave & 1;
        const bf16_t* As = (mat & 1) ? Kt : Bt;
        const bf16_t* Bs = (mat & 2) ? Rt : At;
        f32x4 acc[2] = {};
#pragma unroll
        for (int ks = 0; ks < 2; ++ks) {
          const bf16x8 a = ldfrag(As, 72, mts * 16, ks * 32, fr, fq);
#pragma unroll
          for (int nt = 0; nt < 2; ++nt) acc[nt] = MFMA16(a, ldfrag(Bs, 72, nt * 16, ks * 32, fr, fq), acc[nt]);
        }
#pragma unroll
        for (int nt = 0; nt < 2; ++nt) {
          const int tcol = nt * 16 + fr;
          f32x4 v = acc[nt];
#pragma unroll
          for (int jj = 0; jj < 4; ++jj) {
            const int srow = mts * 16 + fq * 4 + jj;
            const bool keep = (mat & 2) ? (srow <= tcol) : (srow < tcol);
            v[jj] = keep ? v[jj] : 0.f;
          }
          if (mat == 0) {
#pragma unroll
            for (int jj = 0; jj < 4; ++jj) Nab[(mts * 16 + fq * 4 + jj) * 32 + tcol] = v[jj];
          } else {
            bf16_t* dst = mat == 1 ? NakT : mat == 2 ? NbrT : NkrT;
            *(uint2*)(dst + tcol * 40 + mts * 16 + fq * 4) = pack4(v);
          }
        }
      }
      lds_barrier();
      if (wave == 4) {
        const int irow = lane >> 1, hb = lane & 1, blk = lane >> 5, il = irow & 15;
        float x[8];
#pragma unroll
        for (int i = 0; i < 8; ++i) x[i] = (hb * 8 + i == il) ? 1.f : 0.f;
        const float* nb = Nab + (blk * 16) * 32 + blk * 16 + hb * 8;
        solve16<0>(x, nb);
#pragma unroll
        for (int i = 0; i < 8; ++i) TT[(blk * 16 + hb * 8 + i) * 40 + blk * 16 + il] = (bf16_t)(cvt_pk_bf16(x[i], 0.f) & 0xffff);
        if (blk == 0) *(uint4*)(T11b + il * 40 + hb * 8) = pack8(x);
        __builtin_amdgcn_wave_barrier();
        const f32x4 zero = {0.f, 0.f, 0.f, 0.f};
        bf16x8 zf;
#pragma unroll
        for (int i = 0; i < 8; ++i) zf[i] = 0;
        bf16x8 n12 = zf, t22 = zf, t11 = zf;
        if (fq < 2) {
          float o[8];
          const f32x4 n0 = *(const f32x4*)(Nab + fr * 32 + 16 + fq * 8), n1 = *(const f32x4*)(Nab + fr * 32 + 16 + fq * 8 + 4);
          o[0] = n0[0]; o[1] = n0[1]; o[2] = n0[2]; o[3] = n0[3]; o[4] = n1[0]; o[5] = n1[1]; o[6] = n1[2]; o[7] = n1[3];
          uint4 u = pack8(o);
          n12 = *reinterpret_cast<bf16x8*>(&u);
          t22 = *reinterpret_cast<const bf16x8*>(TT + (16 + fr) * 40 + 16 + fq * 8);
          t11 = *reinterpret_cast<const bf16x8*>(T11b + fr * 40 + fq * 8);
        }
        const f32x4 m1 = MFMA16(n12, t22, zero);
        *(uint2*)(M1T + fr * 40 + fq * 4) = pack4(m1);
        __builtin_amdgcn_wave_barrier();
        bf16x8 m1f = zf;
        if (fq < 2) m1f = *reinterpret_cast<const bf16x8*>(M1T + fr * 40 + fq * 8);
        const f32x4 t12 = MFMA16(t11, m1f, zero);
        *(uint2*)(TT + (16 + fr) * 40 + fq * 4) = pack4(t12);
      } else if (wave == 5) {
        unsigned z0;
        asm volatile("v_mov_b32 %0, 0" : "=v"(z0));
        *(uint2*)(TT + (lane >> 2) * 40 + 16 + (lane & 3) * 4) = make_uint2(z0, z0);
      } else if (wave == 2 || wave == 3 || wave >= 6) {
        const int vtile = wave < 4 ? wave - 2 : wave - 4;
        const bf16x8 vf = ldfrag(VT, 40, vtile * 16, 0, fr, fq);
        const f32x4 zero = {0.f, 0.f, 0.f, 0.f};
#pragma unroll
        for (int tt = 0; tt < 2; ++tt) {
          const f32x4 acc = MFMA16(ldfrag(NakT, 40, tt * 16, 0, fr, fq), vf, zero);
          *(uint2*)(VNb + (vtile * 16 + fr) * 40 + tt * 16 + fq * 4) = pack4(acc);
        }
      }
      if (c + 1 < nch) {
      {
        const int j = th * 16 + tl;
        float v16[16];
        if (role < 2) {
          f32x4 acc[4] = {};
          unsigned bti_ = bti;
          asm volatile("" : "+v"(bti_));
#pragma unroll
          for (int ks = 0; ks < 2; ++ks) {
            const uint4 au = ks == 0 ? ra.c0 : ra.c1;
            const bf16x8 a = *reinterpret_cast<const bf16x8*>(&au);
#pragma unroll
            for (int nt = 0; nt < 4; ++nt) { const uint4 bu = Btab0[bti_ + (unsigned)((nt * 2 + ks) * 64)]; acc[nt] = MFMA16(a, *reinterpret_cast<const bf16x8*>(&bu), acc[nt]); }
          }
          if (role == 0) {
#pragma unroll
            for (int nt = 0; nt < 4; ++nt)
#pragma unroll
              for (int jj = 0; jj < 4; ++jj) {
                const float sg = sigmoidf_(bias[nt] + acc[nt][jj]);
                stepbuf[0 * SV + (th * 16 + fq * 4 + jj) * 64 + nt * 16 + fr] = __expf(-0.6065306597126334f * sg);
              }
            __builtin_amdgcn_wave_barrier();
            {
              float wl[16];
#pragma unroll
              for (int i = 0; i < 16; ++i) wl[i] = stepbuf[0 * SV + (th * 16 + i) * 64 + lane];
              float pr = 1.f;
#pragma unroll
              for (int i = 0; i < 16; ++i) { pr *= wl[i]; stepbuf[0 * SV + (th * 16 + i) * 64 + lane] = pr; }
            }
          } else {
#pragma unroll
            for (int nt = 0; nt < 4; ++nt)
#pragma unroll
              for (int jj = 0; jj < 4; ++jj) stepbuf[4 * SV + (th * 16 + fq * 4 + jj) * 64 + nt * 16 + fr] = sigmoidf_(bias[nt] + acc[nt][jj]);
          }
        } else if (role == 2) {
          shift16(ra, cst + 3 * 64 + cq * 16, cst + 1 * 64 + cq * 16, v16);
#pragma unroll
          for (int q = 0; q < 4; ++q) *(f32x4*)(stepbuf + 2 * SV + j * 64 + cq * 16 + q * 4) = (f32x4){v16[q * 4], v16[q * 4 + 1], v16[q * 4 + 2], v16[q * 4 + 3]};
        } else {
          shift16(ra, cst + 2 * 64 + cq * 16, cst + 0 * 64 + cq * 16, v16);
          float kk[16], ss = 0.f;
#pragma unroll
          for (int q = 0; q < 16; ++q) { kk[q] = v16[q] * cst[5 * 64 + cq * 16 + q]; ss += kk[q] * kk[q]; }
          ss = quad_sum(ss);
          const float inv = 1.f / fmaxf(sqrtf(ss), 1e-12f);
#pragma unroll
          for (int q = 0; q < 4; ++q) {
            *(f32x4*)(stepbuf + 1 * SV + j * 64 + cq * 16 + q * 4) = (f32x4){v16[q * 4], v16[q * 4 + 1], v16[q * 4 + 2], v16[q * 4 + 3]};
            *(f32x4*)(stepbuf + 3 * SV + j * 64 + cq * 16 + q * 4) = (f32x4){-kk[q * 4] * inv, -kk[q * 4 + 1] * inv, -kk[q * 4 + 2] * inv, -kk[q * 4 + 3] * inv};
          }
          shift16(rb, cst + 4 * 64 + cq * 16, cst + 8 * 64 + cq * 16, v16);
#pragma unroll
          for (int q = 0; q < 4; ++q) *(f32x4*)(stepbuf + 5 * SV + j * 64 + cq * 16 + q * 4) = (f32x4){v16[q * 4], v16[q * 4 + 1], v16[q * 4 + 2], v16[q * 4 + 3]};
        }
      }
      }
      if (c > 0) {
        const int ip = (c - 1) * 32 + hn * 16 + fr, tp = d ? T - 1 - ip : ip;
        *(uint2*)(yout + (size_t)(r0seq + tp) * 512 + h * 64 + mt * 16 + fq * 4) = y_def;
      }
      if (role == 2 && cq == 0) { const int is_ = c * 32 + th * 16 + tl, tg = d ? T - 1 - is_ : is_; P_SBON[((size_t)(r0seq + tg) * 8 + h) * 2 + d] = sb_def; }
      if (c + 2 < nch) {
        const int is2 = (c + 2) * 32 + th * 16 + tl;
        const int t2 = d ? T - 1 - is2 : is2;
        const int row2 = r0seq + t2;
        if (role >= 2) load_raw16(ra, z, row2, t2, T, colA);
        if (role == 3) load_raw16(rb, z, row2, t2, T, colB);
        if (role < 2) {
          const int is3 = (c + 2) * 32 + th * 16 + fr, t3 = d ? T - 1 - is3 : is3;
          const bf16_t* ap = P_ALORA + (unsigned)((r0seq + t3) * 256 + alo);
          ra.c0 = *(const uint4*)ap; ra.c1 = *(const uint4*)(ap + 32);
        }
      }
      lds_barrier();
      {
        const int tt = wave & 1, rt = wave >> 1;
        const f32x4 zero = {0.f, 0.f, 0.f, 0.f};
        const bf16x8 tf = ldfrag(TT, 40, tt * 16, 0, fr, fq);
        const f32x4 zacc = MFMA16(tf, ldfrag(VNb, 40, rt * 16, 0, fr, fq), zero);
        const f32x4 wacc = MFMA16(tf, ldfrag(AtTb, 40, rt * 16, 0, fr, fq), zero);
        *(uint2*)(Zb + (rt * 16 + fr) * 40 + tt * 16 + fq * 4) = pack4(zacc);
        *(uint2*)(Wb + (rt * 16 + fr) * 40 + tt * 16 + fq * 4) = pack4(wacc);
      }
      lds_barrier();
      f32x4 yacc = {0.f, 0.f, 0.f, 0.f};
      {
        const float pl0 = PLs[nt0 * 16 + fr], pl1 = PLs[nt1 * 16 + fr];
        Sa = Sa * pl0; Sb = Sb * pl1;
        const bf16x8 zf = ldfrag(Zb, 40, mt * 16, 0, fr, fq), vf = ldfrag(VT, 40, mt * 16, 0, fr, fq), wf = ldfrag(Wb, 40, mt * 16, 0, fr, fq);
        const bf16x8 bb0 = ldfrag(Bb, 40, nt0 * 16, 0, fr, fq), bb1 = ldfrag(Bb, 40, nt1 * 16, 0, fr, fq);
        const bf16x8 kb0 = ldfrag(Kb, 40, nt0 * 16, 0, fr, fq), kb1 = ldfrag(Kb, 40, nt1 * 16, 0, fr, fq);
        const bf16x8 nbr = ldfrag(NbrT, 40, hn * 16, 0, fr, fq), nkr = ldfrag(NkrT, 40, hn * 16, 0, fr, fq);
        Sa = MFMA16(zf, bb0, Sa); Sa = MFMA16(vf, kb0, Sa);
        Sb = MFMA16(zf, bb1, Sb); Sb = MFMA16(vf, kb1, Sb);
        yacc = MFMA16(zf, nbr, yacc); yacc = MFMA16(vf, nkr, yacc);
        const f32x4 zero = {0.f, 0.f, 0.f, 0.f};
        const f32x4 g0 = MFMA16(wf, bb0, zero), g1 = MFMA16(wf, bb1, zero);
        f32x4 ry = MFMA16(wf, nbr, zero);
        *(uint2*)(GT + (nt0 * 16 + fr) * 72 + mt * 16 + fq * 4) = pack4(g0);
        *(uint2*)(GT + (nt1 * 16 + fr) * 72 + mt * 16 + fq * 4) = pack4(g1);
        const uint2 rr = *(const uint2*)(Rt + (hn * 16 + fr) * 72 + mt * 16 + fq * 4);
        ry[0] += bf_lo(rr.x); ry[1] += bf_hi(rr.x); ry[2] += bf_lo(rr.y); ry[3] += bf_hi(rr.y);
        *(uint2*)(RyT + (hn * 16 + fr) * 72 + mt * 16 + fq * 4) = pack4(ry);
      }
      lds_barrier();
      {
        const bf16_t* Scur = Sbf + (c & 1) * 64 * 72;
        bf16_t* Snext = Sbf + ((c + 1) & 1) * 64 * 72;
#pragma unroll
        for (int ks = 0; ks < 2; ++ks) {
          const bf16x8 af = ldfrag(Scur, 72, mt * 16, ks * 32, fr, fq);
          Sa = MFMA16(af, ldfrag(GT, 72, nt0 * 16, ks * 32, fr, fq), Sa);
          Sb = MFMA16(af, ldfrag(GT, 72, nt1 * 16, ks * 32, fr, fq), Sb);
          yacc = MFMA16(af, ldfrag(RyT, 72, hn * 16, ks * 32, fr, fq), yacc);
        }
        y_def = pack4(yacc);
#pragma unroll
        for (int jj = 0; jj < 4; ++jj) {
          Snext[(mt * 16 + fq * 4 + jj) * 72 + nt0 * 16 + fr] = (bf16_t)(cvt_pk_bf16(Sa[jj], 0.f) & 0xffff);
          Snext[(mt * 16 + fq * 4 + jj) * 72 + nt1 * 16 + fr] = (bf16_t)(cvt_pk_bf16(Sb[jj], 0.f) & 0xffff);
        }
      }
      lds_barrier();
    }
    {
      const int ip = (nch - 1) * 32 + hn * 16 + fr, tp = d ? T - 1 - ip : ip;
      *(uint2*)(yout + (size_t)(r0seq + tp) * 512 + h * 64 + mt * 16 + fq * 4) = y_def;
    }
  }
  if (item >= 128) {
    const int nb = gridDim.x - 128;
    for (int tile = item - 128; tile < NTOK / 32; tile += nb) pool_tile(z, P_RH, tile, tid);
  }
}

__device__ __forceinline__ void post_phase(PREF p, char* smem, const int wid_u) {
  bf16_t* Ag = (bf16_t*)smem;
  bf16_t* vt = (bf16_t*)(smem + 12800);
  float* ys = (float*)(smem + 12800 + 33280);
  const bf16_t* z = P_RU;
  const bf16_t* yf = P_RY;
  const bf16_t* ybk = P_RY + (size_t)NTOK * 512;
  bf16_t* mo = P_RH;
  const int tid = opaque_tid(), w = tid >> 6, lane = tid & 63, fr = lane & 15, fq = lane >> 4;
  bf16x8 Bg[4][6];
#pragma unroll
  for (int nt = 0; nt < 4; ++nt)
#pragma unroll
    for (int ks = 0; ks < 6; ++ks) {
      float o[8];
#pragma unroll
      for (int q = 0; q < 8; ++q) { const int k = ks * 32 + fq * 8 + q; o[q] = k < 160 ? p.g2[(size_t)k * 512 + w * 64 + nt * 16 + fr] : 0.f; }
      uint4 u = pack8(o);
      Bg[nt][ks] = *reinterpret_cast<bf16x8*>(&u);
    }
  float lng[4], lnb[4];
#pragma unroll
  for (int nt = 0; nt < 4; ++nt) { lng[nt] = p.lnx_g[w * 64 + nt * 16 + fr]; lnb[nt] = p.lnx_b[w * 64 + nt * 16 + fr]; }

  for (int tile = blockIdx.x; tile < NTOK / 32; tile += gridDim.x) {
    const int row0 = tile * 32;
    int s, t0, T;
    row_seq(row0, s, t0, T);
    for (int idx = tid; idx < 32 * 24; idx += NTHR) {
      const int tok = idx / 24, oc = idx % 24;
      float o[8];
      if (oc < 20) {
        load_shift8(z, row0 + tok, t0 + tok, T, 2304 + oc * 8, p.shift_mu, o);
#pragma unroll
        for (int q = 0; q < 8; ++q) o[q] = sigmoidf_(o[q]);
      } else {
#pragma unroll
        for (int q = 0; q < 8; ++q) o[q] = 0.f;
      }
      *(uint4*)(Ag + tok * 200 + oc * 8) = pack8(o);
    }
#pragma unroll 1
    for (int half_ = 0; half_ < 2; ++half_) {
      uint4 zc[2], zp[2], zn[2], ya[2], yb4[2];
#pragma unroll
      for (int i = 0; i < 2; ++i) {
        const int idx = tid + (half_ * 2 + i) * NTHR, tok = idx >> 6, oc = idx & 63, row = row0 + tok, t = t0 + tok;
        const bf16_t* pz = z + (size_t)row * ZLD + 1536 + oc * 8;
        zc[i] = *(const uint4*)pz;
        zp[i] = make_uint4(0, 0, 0, 0); zn[i] = zp[i];
        if (t > 0) zp[i] = *(const uint4*)(pz - ZLD);
        if (t < T - 1) zn[i] = *(const uint4*)(pz + ZLD);
        ya[i] = *(const uint4*)(yf + (size_t)row * 512 + oc * 8);
        yb4[i] = *(const uint4*)(ybk + (size_t)row * 512 + oc * 8);
      }
#pragma unroll
      for (int i = 0; i < 2; ++i) {
        const int idx = tid + (half_ * 2 + i) * NTHR, tok = idx >> 6, oc = idx & 63;
        float c[8], pv[8], nx[8], o[8];
        unpack8(zc[i], c); unpack8(zp[i], pv); unpack8(zn[i], nx);
#pragma unroll
        for (int q = 0; q < 8; ++q) o[q] = c[q] + (0.5f * (pv[q] + nx[q]) - c[q]) * p.shift_mu[1536 - 512 + oc * 8 + q];
        *(uint4*)(vt + tok * 520 + oc * 8) = pack8(o);
        float a[8], b[8];
        unpack8(ya[i], a); unpack8(yb4[i], b);
        *(f32x4*)(ys + tok * 516 + oc * 8) = (f32x4){a[0] + b[0], a[1] + b[1], a[2] + b[2], a[3] + b[3]};
        *(f32x4*)(ys + tok * 516 + oc * 8 + 4) = (f32x4){a[4] + b[4], a[5] + b[5], a[6] + b[6], a[7] + b[7]};
      }
    }
    __syncthreads();
    f32x4 acc[2][4] = {};
#pragma unroll
    for (int ks = 0; ks < 6; ++ks) {
      bf16x8 a[2];
#pragma unroll
      for (int mt = 0; mt < 2; ++mt) a[mt] = *reinterpret_cast<const bf16x8*>(Ag + (mt * 16 + fr) * 200 + ks * 32 + fq * 8);
#pragma unroll
      for (int mt = 0; mt < 2; ++mt)
#pragma unroll
        for (int nt = 0; nt < 4; ++nt) acc[mt][nt] = __builtin_amdgcn_mfma_f32_16x16x32_bf16(a[mt], Bg[nt][ks], acc[mt][nt], 0, 0, 0);
    }
#pragma unroll
    for (int mt = 0; mt < 2; ++mt)
#pragma unroll
      for (int jj = 0; jj < 4; ++jj) {
        const int tok = mt * 16 + fq * 4 + jj, row = row0 + tok;
        float yv[4], sm_ = 0.f;
#pragma unroll
        for (int nt = 0; nt < 4; ++nt) { yv[nt] = ys[tok * 516 + w * 64 + nt * 16 + fr]; sm_ += yv[nt]; }
        const float mean = row16_sum(sm_) * (1.f / 64.f);
        float vs = 0.f;
#pragma unroll
        for (int nt = 0; nt < 4; ++nt) { yv[nt] -= mean; vs += yv[nt] * yv[nt]; }
        const float rs = rsqrtf(row16_sum(vs) * (1.f / 64.f) + 64e-5f);
        const float2 sb2 = *(const float2*)(P_SBON + ((size_t)row * 8 + w) * 2);
        const float sbs = sb2.x + sb2.y;
#pragma unroll
        for (int nt = 0; nt < 4; ++nt) {
          const float vv = bf2f(vt[tok * 520 + w * 64 + nt * 16 + fr]);
          const float o = (yv[nt] * rs * lng[nt] + lnb[nt] + sbs * vv) * acc[mt][nt][jj];
          mo[(size_t)row * D + 512 + w * 64 + nt * 16 + fr] = (bf16_t)(cvt_pk_bf16(o, 0.f) & 0xffff);
        }
      }
    __syncthreads();
  }
}

#define XB_TMO      128
#define XB_XCNT(j)  (256  + 64 * (j))
#define XB_XSUB(j)  (1280 + 64 * (j))
#define XB_XGEN(j)  (2304 + 64 * (j))
#define XB_TOP      3328
#define XB_TOPGEN   3392
#define XCD_BAR_WORDS 3456
#define XB_SPIN_CAP (1u << 22)
__device__ __forceinline__ unsigned xb_ld(unsigned* p)              { return __hip_atomic_load(p, __ATOMIC_RELAXED, __HIP_MEMORY_SCOPE_AGENT); }
__device__ __forceinline__ unsigned xb_add(unsigned* p, unsigned v) { return __hip_atomic_fetch_add(p, v, __ATOMIC_RELAXED, __HIP_MEMORY_SCOPE_AGENT); }
__device__ __forceinline__ unsigned xb_xcc_id() { return (unsigned)__builtin_amdgcn_s_getreg((3 << 11) | 20) & 0xFu; }
#define XB_SPIN(cond, bar) do { unsigned _sp = 0; while (cond) { __builtin_amdgcn_s_sleep(1); \
    if ((++_sp & 255u) == 0u) { if (xb_ld(&(bar)[XB_TMO])) break; if (_sp > XB_SPIN_CAP) { atomicAdd(&(bar)[XB_TMO], 1u); break; } } } } while (0)
struct XcdBarrier { unsigned* bar; unsigned x; volatile LAS unsigned* st; };
__device__ __forceinline__ void xcd_barrier_complete(unsigned* bar, unsigned x, unsigned& nloc, unsigned& nx) {
  const unsigned G = gridDim.x * gridDim.y * gridDim.z;
  unsigned sum, cnt, mine, sp = 0u;
  for (;;) {
    sum = 0u; cnt = 0u; mine = 0u;
#pragma unroll
    for (unsigned j = 0; j < 16; ++j) { const unsigned c = xb_ld(&bar[XB_XCNT(j)]); sum += c; cnt += (c > 0u) ? 1u : 0u; mine = (j == x) ? c : mine; }
    if (sum == G) break;
    __builtin_amdgcn_s_sleep(1);
    if ((++sp & 255u) == 0u) { if (xb_ld(&bar[XB_TMO])) break; if (sp > XB_SPIN_CAP) { atomicAdd(&bar[XB_TMO], 1u); break; } }
  }
  nloc = mine > 0u ? mine : 1u; nx = cnt > 0u ? cnt : 1u;
}
__device__ __forceinline__ void xcd_barrier(PREF p, volatile LAS unsigned* st_, const int wid_u) {
  asm volatile("s_waitcnt vmcnt(0)" ::: "memory");
  __syncthreads();
  if (opaque_tid() == 0) {
    XcdBarrier b; b.bar = (unsigned*)(p.ws + OFF_BAR); b.x = xb_xcc_id(); b.st = st_;
    unsigned* bar = b.bar;
    __builtin_amdgcn_s_waitcnt(0);
    unsigned nloc = b.st[0], nx = b.st[1];
    if (nloc == 0u) { xcd_barrier_complete(bar, b.x, nloc, nx); b.st[0] = nloc; b.st[1] = nx; }
    const unsigned old = xb_add(&bar[XB_XSUB(b.x)], 1u);
    const unsigned gen = old / nloc;
    if (old + 1u == (gen + 1u) * nloc) {
      __builtin_amdgcn_fence(__ATOMIC_RELEASE, "agent");
      asm volatile("s_waitcnt vmcnt(0)" ::: "memory");
      const unsigned og = xb_add(&bar[XB_TOP], 1u);
      const unsigned tg = og / nx;
      if (og + 1u == (tg + 1u) * nx) xb_add(&bar[XB_TOPGEN], 1u);
      else XB_SPIN(xb_ld(&bar[XB_TOPGEN]) == tg, bar);
      __builtin_amdgcn_fence(__ATOMIC_ACQUIRE, "agent");
      xb_add(&bar[XB_XGEN(b.x)], 1u);
      asm volatile("s_waitcnt vmcnt(0)" ::: "memory");
    } else {
      XB_SPIN(xb_ld(&bar[XB_XGEN(b.x)]) == gen, bar);
      __builtin_amdgcn_fence(__ATOMIC_ACQUIRE, "agent");
      asm volatile("s_waitcnt vmcnt(0)" ::: "memory");
    }
  }
  __syncthreads();
}

constexpr int NPHASE = 14;
__device__ __forceinline__ void do_phase(PREF p, int ph, char* smem, const int wid_u) {
  if (ph == 0) prep_phase(p, smem, wid_u);
  else if (ph == 1) row_phase<0>(p.x_prompt, p.x_sample, nullptr, nullptr, P_RH, P_MOD, nullptr, p.n1_pre, 0, 0.f, 0, wid_u);
  else if (ph == 4 || ph == 10) {
    const bool f = ph == 4;
    float* outp = p.out;
    row_phase<1>(sel(f, p.x_prompt, (const float*)outp), sel(f, p.x_sample, (const float*)(outp + (size_t)NPROMPT * D)), outp, P_RY, P_RH, P_MOD,
                 sel(f, p.n1_post, p.nm_post), sel(f, p.nm_pre, p.n2_pre), f ? 2 : 5, f ? 0.5f : 1.0f, f ? 3 : 6, wid_u, !f);
  }
  else if (ph == 13) row_phase<2>(p.out, p.out + (size_t)NPROMPT * D, p.out, P_RY, nullptr, P_MOD, p.n2_post, nullptr, 8, 0.5f, 0, wid_u, true);
  else if (ph == 6) lora_prep_phase(p, wid_u);
  else if (ph == 7) scan_phase(p, smem, wid_u);
  else if (ph == 8) post_phase(p, smem, wid_u);
  else {
    const bf16_t *A, *Bt; bf16_t* C; int N, K, ldc, epi;
    if (ph == 2 || ph == 11) { A = P_RH; Bt = sel(ph == 2, P_W13A, P_W13B); C = P_RU; N = 2 * FF; K = D; ldc = FF; epi = 1; }
    else if (ph == 3 || ph == 12) { A = P_RU; Bt = sel(ph == 3, P_W2A, P_W2B); C = P_RY; N = D; K = FF; ldc = D; epi = 0; }
    else if (ph == 5) { A = P_RH; Bt = P_WINT; C = P_RU; N = ZLD; K = D; ldc = ZLD; epi = 0; }
    else { A = P_RH; Bt = P_WOUTT; C = P_RY; N = D; K = D; ldc = D; epi = 0; }
    gemm_phase(A, Bt, C, NTOK, N, K, ldc, epi, smem, wid_u);
  }
}

extern __shared__ __attribute__((aligned(16))) char dyn_smem[];

__global__ void __launch_bounds__(NTHR, 2) mega_kernel(Params p) {
  cg::grid_group grid = cg::this_grid();
  const int wid_u = __builtin_amdgcn_readfirstlane(threadIdx.x >> 6);
  typedef const __attribute__((address_space(4))) Params* KP;
  const KP kp0 = (KP)__builtin_amdgcn_kernarg_segment_ptr();
  volatile LAS unsigned* st = (volatile LAS unsigned*)((LAS char*)dyn_smem + (SMEM_BYTES - 16));
  if (threadIdx.x < 2) st[threadIdx.x] = 0u;
  __syncthreads();
  if (threadIdx.x == 0) (void)xb_add(&((unsigned*)(kp0->ws + OFF_BAR))[XB_XCNT(xb_xcc_id())], 1u);
#define RUN_PHASE(PH) do { KP kp = kp0; asm volatile("" : "+s"(kp)); do_phase(*kp, PH, dyn_smem, wid_u); \
    if (PH == 0) grid.sync(); \
    else if (PH + 1 < NPHASE) xcd_barrier(*kp, (volatile LAS unsigned*)((LAS char*)dyn_smem + (SMEM_BYTES - 16)), wid_u); } while (0)
  RUN_PHASE(0); RUN_PHASE(1); RUN_PHASE(2); RUN_PHASE(3); RUN_PHASE(4); RUN_PHASE(5); RUN_PHASE(6);
  RUN_PHASE(7); RUN_PHASE(8); RUN_PHASE(9); RUN_PHASE(10); RUN_PHASE(11); RUN_PHASE(12); RUN_PHASE(13);
#undef RUN_PHASE
}

__global__ void __launch_bounds__(NTHR, 2) phase_kernel(Params p, int ph) {
  const int wid_u = __builtin_amdgcn_readfirstlane(threadIdx.x >> 6);
  do_phase(*(const __attribute__((address_space(4))) Params*)__builtin_amdgcn_kernarg_segment_ptr(), ph, dyn_smem, wid_u);
}

extern "C" void kernel_launch(void* const* d_in, const int* in_sizes, int n_in, void* d_out, int out_size, void* d_ws, size_t ws_size,
                              hipStream_t stream) {
  Params p{};
  const float** f = (const float**)&p;
  for (int i = 0; i < 33; ++i) f[i] = (const float*)d_in[i];
  p.out = (float*)d_out;
  p.ws = (char*)d_ws;
  if (WS_NEED > ws_size) { fprintf(stderr, "workspace too small: need %zu have %zu\n", (size_t)WS_NEED, ws_size); return; }

#if ONE_LAUNCH
  static int grid_blocks = 0;
  if (!grid_blocks) {
    int dev = 0, cus = 0, per_cu = 0;
    (void)hipGetDevice(&dev);
    (void)hipDeviceGetAttribute(&cus, hipDeviceAttributeMultiprocessorCount, dev);
    (void)hipFuncSetAttribute((const void*)mega_kernel, hipFuncAttributeMaxDynamicSharedMemorySize, SMEM_BYTES);
    (void)hipOccupancyMaxActiveBlocksPerMultiprocessor(&per_cu, mega_kernel, NTHR, SMEM_BYTES);
    if (per_cu < 1) per_cu = 1;
    grid_blocks = cus * per_cu;
  }
  (void)hipMemsetAsync(p.ws + OFF_BAR, 0, XCD_BAR_WORDS * sizeof(unsigned), stream);
  void* args[] = {&p};
  hipError_t e = hipLaunchCooperativeKernel((const void*)mega_kernel, dim3(grid_blocks), dim3(NTHR), args, SMEM_BYTES, stream);
  if (e != hipSuccess) fprintf(stderr, "cooperative launch failed: %s (grid %d)\n", hipGetErrorString(e), grid_blocks);
#else
  static bool attr = false;
  if (!attr) { (void)hipFuncSetAttribute((const void*)phase_kernel, hipFuncAttributeMaxDynamicSharedMemorySize, SMEM_BYTES); attr = true; }
  for (int ph = 0; ph < NPHASE; ++ph) phase_kernel<<<256, NTHR, SMEM_BYTES, stream>>>(p, ph);
#endif
}
```

```cpp
#include <hip/hip_runtime.h>
#include <hip/hip_cooperative_groups.h>
#include <cstdio>
namespace cg = cooperative_groups;

#ifndef ONE_LAUNCH
#define ONE_LAUNCH 1
#endif

typedef unsigned short bf16_t;
typedef short bf16x8 __attribute__((ext_vector_type(8)));
typedef float f32x4 __attribute__((ext_vector_type(4)));
typedef float f32x2 __attribute__((ext_vector_type(2)));
typedef unsigned u32x2 __attribute__((ext_vector_type(2)));
#define LAS __attribute__((address_space(3)))

constexpr int D = 1024, FF = 2816, NTOK = 98304, NPROMPT = 32768, ZLD = 2560, PINW = 2464;
constexpr int NTHR = 512;
constexpr int SMEM_BYTES = 162320;

struct Params {
  const float *x_prompt, *x_sample, *c_prompt, *c_sample, *ada_w, *ada_b, *n1_pre, *n1_post, *f1_w1, *f1_w3, *f1_w2,
      *nm_pre, *nm_post, *w_in, *shift_mu, *pool_w, *pool_scale, *w0, *w2, *a0, *a2, *g2, *k_k, *k_a, *r_k, *lnx_g, *lnx_b,
      *w_out, *n2_pre, *n2_post, *f2_w1, *f2_w3, *f2_w2;
  float* out;
  char* ws;
};
#define PREF const __attribute__((address_space(4))) Params&
constexpr size_t al256(size_t b) { return (b + 255) & ~(size_t)255; }
constexpr size_t OFF_W13A = 0;
constexpr size_t OFF_W13B = OFF_W13A + al256((size_t)2 * FF * D * 2);
constexpr size_t OFF_W2A = OFF_W13B + al256((size_t)2 * FF * D * 2);
constexpr size_t OFF_W2B = OFF_W2A + al256((size_t)D * FF * 2);
constexpr size_t OFF_WINT = OFF_W2B + al256((size_t)D * FF * 2);
constexpr size_t OFF_WOUTT = OFF_WINT + al256((size_t)ZLD * D * 2);
constexpr size_t OFF_MOD = OFF_WOUTT + al256((size_t)D * D * 2);
constexpr size_t OFF_SBON = OFF_MOD + al256((size_t)16 * 9216 * 4);
constexpr size_t OFF_RH = OFF_SBON + al256((size_t)NTOK * 16 * 4);
constexpr size_t OFF_RY = OFF_RH + al256((size_t)NTOK * D * 2);
constexpr size_t OFF_RU = OFF_RY + al256((size_t)NTOK * D * 2);
constexpr size_t OFF_ALORA = OFF_RU + al256((size_t)NTOK * FF * 2);
constexpr size_t OFF_BAR = OFF_ALORA + al256((size_t)NTOK * 256 * 2);
constexpr size_t OFF_BTAB = OFF_BAR + 16384;
constexpr size_t WS_NEED = OFF_BTAB + (size_t)256 * 16384;
#define P_W13A ((bf16_t*)(p.ws + OFF_W13A))
#define P_W13B ((bf16_t*)(p.ws + OFF_W13B))
#define P_W2A ((bf16_t*)(p.ws + OFF_W2A))
#define P_W2B ((bf16_t*)(p.ws + OFF_W2B))
#define P_WINT ((bf16_t*)(p.ws + OFF_WINT))
#define P_WOUTT ((bf16_t*)(p.ws + OFF_WOUTT))
#define P_MOD ((float*)(p.ws + OFF_MOD))
#define P_SBON ((float*)(p.ws + OFF_SBON))
#define P_RH ((bf16_t*)(p.ws + OFF_RH))
#define P_RY ((bf16_t*)(p.ws + OFF_RY))
#define P_RU ((bf16_t*)(p.ws + OFF_RU))
#define P_ALORA ((bf16_t*)(p.ws + OFF_ALORA))

typedef __bf16 bf16x2_t __attribute__((ext_vector_type(2)));
__device__ __forceinline__ unsigned cvt_pk_bf16(float lo, float hi) {
  f32x2 v = {lo, hi};
  bf16x2_t b = __builtin_convertvector(v, bf16x2_t);
  return __builtin_bit_cast(unsigned, b);
}
__device__ __forceinline__ float bf_lo(unsigned u) { return __uint_as_float(u << 16); }
__device__ __forceinline__ float bf_hi(unsigned u) { return __uint_as_float(u & 0xffff0000u); }
__device__ __forceinline__ float bf2f(bf16_t b) { return __uint_as_float(((unsigned)b) << 16); }
__device__ __forceinline__ void unpack8(uint4 v, float* o) {
  o[0] = bf_lo(v.x); o[1] = bf_hi(v.x); o[2] = bf_lo(v.y); o[3] = bf_hi(v.y);
  o[4] = bf_lo(v.z); o[5] = bf_hi(v.z); o[6] = bf_lo(v.w); o[7] = bf_hi(v.w);
}
__device__ __forceinline__ uint4 pack8(const float* o) {
  uint4 v; v.x = cvt_pk_bf16(o[0], o[1]); v.y = cvt_pk_bf16(o[2], o[3]); v.z = cvt_pk_bf16(o[4], o[5]); v.w = cvt_pk_bf16(o[6], o[7]);
  return v;
}
__device__ __forceinline__ float sigmoidf_(float x) { return __builtin_amdgcn_rcpf(1.f + __expf(-x)); }
template <int CTRL> __device__ __forceinline__ float dpp_f(float x) {
  return __int_as_float(__builtin_amdgcn_update_dpp(0, __float_as_int(x), CTRL, 0xf, 0xf, false));
}
__device__ __forceinline__ float row16_sum(float x) {
  x += dpp_f<0x128>(x); x += dpp_f<0x124>(x); x += dpp_f<0x122>(x); x += dpp_f<0x121>(x);
  return x;
}
template <class T> __device__ __forceinline__ T sel(bool c, T a, T b) { return c ? a : b; }
__device__ __forceinline__ int opaque_tid_w(int wid) {
  int l;
  asm volatile("v_mbcnt_lo_u32_b32 %0, -1, 0\n\tv_mbcnt_hi_u32_b32 %0, -1, %0" : "=v"(l));
  return wid * 64 + l;
}
#define opaque_tid() opaque_tid_w(wid_u)
__device__ __forceinline__ float wave_sum(float v) {
  v = row16_sum(v);
  const float a = __int_as_float(__builtin_amdgcn_readlane(__float_as_int(v), 0)), b = __int_as_float(__builtin_amdgcn_readlane(__float_as_int(v), 16));
  const float c = __int_as_float(__builtin_amdgcn_readlane(__float_as_int(v), 32)), d = __int_as_float(__builtin_amdgcn_readlane(__float_as_int(v), 48));
  return (a + b) + (c + d);
}
__device__ __forceinline__ float quad_sum(float x) { x += dpp_f<0xB1>(x); x += dpp_f<0x4E>(x); return x; }
__device__ __forceinline__ int seq_start(int s) { return s < 8 ? s * 4096 : NPROMPT + (s - 8) * 8192; }
__device__ __forceinline__ void row_seq(int row, int& s, int& t, int& T) {
  if (row < NPROMPT) { s = row >> 12; t = row & 4095; T = 4096; }
  else { int r = row - NPROMPT; s = 8 + (r >> 13); t = r & 8191; T = 8192; }
}

__device__ __forceinline__ void tr_tile(const float* __restrict__ src, int ldsrc, int k0, int n0, int nvalid, bf16_t* __restrict__ dst, int ldd,
                        int kdst0, int mode, float* sm, const int tid) {
#pragma unroll
  for (int i = 0; i < 2; ++i) {
    const int r = (tid >> 4) + 32 * i, c = (tid & 15) * 4;
    float4 v = make_float4(0.f, 0.f, 0.f, 0.f);
    if (n0 + c < nvalid) v = *(const float4*)(src + (size_t)(k0 + r) * ldsrc + n0 + c);
    float* d = sm + r * 65 + c;
    d[0] = v.x; d[1] = v.y; d[2] = v.z; d[3] = v.w;
  }
  __syncthreads();
  {
    const int n = tid >> 3, kc = (tid & 7) * 8;
    float o[8];
#pragma unroll
    for (int j = 0; j < 8; ++j) o[j] = sm[(kc + j) * 65 + n];
    int nn = n0 + n, drow;
    const int c32 = nn & 31, slot = 16 * ((c32 >> 2) & 1) + 4 * (c32 >> 3) + (c32 & 3);
    if (mode == 0) drow = (nn & ~31) + slot;
    else drow = 256 * (nn >> 7) + (mode == 2 ? 128 : 0) + ((nn & 127) & ~31) + slot;
    *(uint4*)(dst + (size_t)drow * ldd + kdst0 + k0 + kc) = pack8(o);
  }
  __syncthreads();
}

__device__ __forceinline__ void prep_phase(PREF p, char* smem, const int wid_u) {
  float* sm = (float*)smem;
  const int tid = opaque_tid();
  constexpr int N_MOD = 144, N_EFF = 128, N_W13 = 4 * 704, N_W2 = 2 * 704, N_WIN = 640, N_WOUT = 128;
  constexpr int TOTAL = N_MOD + N_EFF + N_W13 + N_W2 + N_WIN + N_WOUT;
  for (int item = blockIdx.x; item < TOTAL; item += gridDim.x) {
    int it = item;
    if (it < N_MOD) {
      const int j0 = it * 64;
      float* sc = sm;
      float* red = sm + 16384;
      for (int idx = tid; idx < 16384; idx += NTHR) {
        const int s = idx >> 10, k = idx & 1023;
        const float* cp_ = p.c_prompt; const float* cs_ = p.c_sample;
        const float c = s < 8 ? cp_[s * 1024 + k] : cs_[(s - 8) * 1024 + k];
        sc[idx] = c / (1.f + __expf(-c));
      }
      __syncthreads();
      const int col = tid & 63, kg = tid >> 6;
      float acc[16];
#pragma unroll
      for (int s = 0; s < 16; ++s) acc[s] = 0.f;
      for (int k = kg * 128; k < kg * 128 + 128; ++k) {
        const float w = p.ada_w[(size_t)k * 9216 + j0 + col];
#pragma unroll
        for (int s = 0; s < 16; ++s) acc[s] += sc[s * 1024 + k] * w;
      }
#pragma unroll
      for (int s = 0; s < 16; ++s) red[(kg * 16 + s) * 64 + col] = acc[s];
      __syncthreads();
      for (int o = tid; o < 1024; o += NTHR) {
        const int s = o >> 6, c2 = o & 63;
        float v = p.ada_b[j0 + c2];
#pragma unroll
        for (int g = 0; g < 8; ++g) v += red[(g * 16 + s) * 64 + c2];
        P_MOD[s * 9216 + j0 + c2] = v;
      }
      __syncthreads();
      continue;
    }
    it -= N_MOD;
    if (it < N_EFF) {
      const int g = it >> 5, itile = (it >> 4) & 1, ntile = it & 15;
      float* As = sm;
      float* Bs = sm + 64 * 129;
      for (int idx = tid; idx < 64 * 128; idx += NTHR) {
        const int i = idx >> 7, j = idx & 127;
        As[i * 129 + j] = p.pool_w[((size_t)g * 128 + itile * 64 + i) * 128 + j] * p.pool_scale[g * 128 + j];
      }
      for (int idx = tid; idx < 128 * 64; idx += NTHR) {
        const int j = idx >> 6, nn = idx & 63;
        Bs[j * 65 + nn] = p.w_out[(size_t)(g * 128 + j) * 1024 + ntile * 64 + nn];
      }
      __syncthreads();
      const int i = tid >> 3, nn0 = (tid & 7) * 8;
      float acc[8];
#pragma unroll
      for (int q = 0; q < 8; ++q) acc[q] = 0.f;
      for (int j = 0; j < 128; ++j) {
        const float a = As[i * 129 + j];
#pragma unroll
        for (int q = 0; q < 8; ++q) acc[q] += a * Bs[j * 65 + nn0 + q];
      }
#pragma unroll
      for (int q = 0; q < 8; ++q)
      {
        const int nn = ntile * 64 + nn0 + q, c32 = nn & 31, slot = 16 * ((c32 >> 2) & 1) + 4 * (c32 >> 3) + (c32 & 3);
        P_WOUTT[(size_t)((nn & ~31) + slot) * 1024 + g * 128 + itile * 64 + i] = (bf16_t)(cvt_pk_bf16(acc[q], 0.f) & 0xffff);
      }
      __syncthreads();
      continue;
    }
    it -= N_EFF;
    if (it < N_W13) {
      const int which = it / 704, r = it % 704;
      const int kt = r / 44, ntl = r % 44;
      const float* src = sel(which < 2, sel(which == 0, p.f1_w1, p.f1_w3), sel(which == 2, p.f2_w1, p.f2_w3));
      bf16_t* dst = sel(which < 2, P_W13A, P_W13B);
      tr_tile(src, FF, kt * 64, ntl * 64, FF, dst, D, 0, (which & 1) ? 2 : 1, sm, tid);
      continue;
    }
    it -= N_W13;
    if (it < N_W2) {
      const int which = it / 704, r = it % 704;
      const int kt = r / 16, ntl = r % 16;
      tr_tile(sel(which != 0, p.f2_w2, p.f1_w2), D, kt * 64, ntl * 64, D, sel(which != 0, P_W2B, P_W2A), FF, 0, 0, sm, tid);
      continue;
    }
    it -= N_W2;
    if (it < N_WIN) {
      const int kt = it / 40, ntl = it % 40;
      tr_tile(p.w_in, PINW, kt * 64, ntl * 64, PINW, P_WINT, D, 0, 0, sm, tid);
      continue;
    }
    it -= N_WIN;
    {
      const int kt = it / 16, ntl = it % 16;
      tr_tile(p.w_out + (size_t)512 * 1024, D, kt * 64, ntl * 64, D, P_WOUTT, D, 512, 0, sm, tid);
    }
  }
}

template <int MODE>
__device__ __forceinline__ void row_phase(const float* __restrict__ xp, const float* __restrict__ xs, float* __restrict__ xout,
                          const bf16_t* __restrict__ y, bf16_t* __restrict__ h, const float* __restrict__ mod,
                          const float* __restrict__ npost, const float* __restrict__ npre, int gate_idx, float cgate, int shift_idx, const int wid_u,
                          const bool xin_bf = false) {
  const int tid_ = opaque_tid();
  const int lane = tid_ & 63;
  const int gw = blockIdx.x * 8 + (tid_ >> 6), GW = gridDim.x * 8;
  for (int chunk = gw; chunk < NTOK / 16; chunk += GW) {
    const int row0 = chunk * 16;
    int s, t, T;
    row_seq(row0, s, t, T);
    const float* md = mod + s * 9216;
    f32x4 Am[4], Bm[4], Gm[4];
#pragma unroll
    for (int i = 0; i < 4; ++i) {
      const int c = i * 256 + lane * 4;
      if (MODE != 2) {
        f32x4 np = *(const f32x4*)(npre + c), sc = *(const f32x4*)(md + (shift_idx + 1) * 1024 + c);
        Am[i] = np * (sc + 1.f);
        Bm[i] = *(const f32x4*)(md + shift_idx * 1024 + c);
      }
      if (MODE != 0) {
        f32x4 g = *(const f32x4*)(md + gate_idx * 1024 + c), po = *(const f32x4*)(npost + c);
        Gm[i] = g * po * cgate;
      }
    }
    for (int r = 0; r < 16; ++r) {
      const int row = row0 + r;
      const float* xr = (row < NPROMPT) ? xp + (size_t)row * D : xs + (size_t)(row - NPROMPT) * D;
      f32x4 xv[4];
      if (MODE != 0 && xin_bf) {
        const bf16_t* xb = (const bf16_t*)(xout + (size_t)row * D) + 1024;
#pragma unroll
        for (int i = 0; i < 4; ++i) {
          const u32x2 u = __builtin_nontemporal_load((const u32x2*)(xb + i * 256 + lane * 4));
          xv[i] = (f32x4){bf_lo(u.x), bf_hi(u.x), bf_lo(u.y), bf_hi(u.y)};
        }
      } else {
#pragma unroll
        for (int i = 0; i < 4; ++i) xv[i] = __builtin_nontemporal_load((const f32x4*)(xr + i * 256 + lane * 4));
      }
      if (MODE != 0) {
        f32x4 yv[4];
        float ss = 0.f;
#pragma unroll
        for (int i = 0; i < 4; ++i) {
          const u32x2 u = __builtin_nontemporal_load((const u32x2*)(y + (size_t)row * D + i * 256 + lane * 4));
          yv[i] = (f32x4){bf_lo(u.x), bf_hi(u.x), bf_lo(u.y), bf_hi(u.y)};
          ss += yv[i][0] * yv[i][0] + yv[i][1] * yv[i][1] + yv[i][2] * yv[i][2] + yv[i][3] * yv[i][3];
        }
        ss = wave_sum(ss);
        const float rs = rsqrtf(ss * (1.f / 1024.f) + 1e-6f);
#pragma unroll
        for (int i = 0; i < 4; ++i) {
          xv[i] = xv[i] + Gm[i] * yv[i] * rs;
          if (MODE == 2) __builtin_nontemporal_store(xv[i], (f32x4*)(xout + (size_t)row * D + i * 256 + lane * 4));
          else {
            uint2 u; u.x = cvt_pk_bf16(xv[i][0], xv[i][1]); u.y = cvt_pk_bf16(xv[i][2], xv[i][3]);
            *(uint2*)((bf16_t*)(xout + (size_t)row * D) + 1024 + i * 256 + lane * 4) = u;
          }
        }
      }
      if (MODE != 2) {
        float ss = 0.f;
#pragma unroll
        for (int i = 0; i < 4; ++i) ss += xv[i][0] * xv[i][0] + xv[i][1] * xv[i][1] + xv[i][2] * xv[i][2] + xv[i][3] * xv[i][3];
        ss = wave_sum(ss);
        const float rs = rsqrtf(ss * (1.f / 1024.f) + 1e-6f);
#pragma unroll
        for (int i = 0; i < 4; ++i) {
          f32x4 hv = xv[i] * rs * Am[i] + Bm[i];
          uint2 u; u.x = cvt_pk_bf16(hv[0], hv[1]); u.y = cvt_pk_bf16(hv[2], hv[3]);
          *(uint2*)(h + (size_t)row * D + i * 256 + lane * 4) = u;
        }
      }
    }
  }
}

constexpr int BM = 256, BK = 64, HALF = 128, NXCD = 8, WGM = 4, HT = HALF * BK;
__device__ __forceinline__ int lds_byte(int r, int c) {
  int st = (r >> 4) * 2 + (c >> 5), rr = r & 15, cc = c & 31, ob = rr * 64 + cc * 2;
  return st * 1024 + (ob ^ (((ob >> 9) & 1) << 5));
}
__device__ __forceinline__ void stage_rc(int b, int& R, int& C) {
  int st = b / 1024, sb = b % 1024, swz = sb ^ (((sb >> 9) & 1) << 5);
  R = (st >> 1) * 16 + swz / 64; C = (st & 1) * 32 + (swz % 64) / 2;
}

__device__ __forceinline__ bool gemm_unit(int i, int nM, int nN, int nwg, int& pm, int& pn) {
  const long L = (long)i * gridDim.x + blockIdx.x;
  if (L >= nwg) return false;
  int wgid = (int)L;
  { int q = nwg / NXCD, r = nwg % NXCD, xcd = wgid % NXCD, off = wgid / NXCD;
    wgid = (xcd < r ? xcd * (q + 1) : r * (q + 1) + (xcd - r) * q) + off; }
  const int nig = WGM * nN, gid = wgid / nig, fm = gid * WGM, gsz = min(nM - fm, WGM);
  pm = fm + ((wgid % nig) % gsz); pn = (wgid % nig) / gsz;
  return true;
}

__device__ __forceinline__ void gemm_phase(const bf16_t* __restrict__ A, const bf16_t* __restrict__ Bt, bf16_t* __restrict__ C, int M, int N, int K,
                                           int ldc, const int EPI, char* smem, const int wid_u) {
  const int nM = M / BM, nN = N / BM, nwg = nM * nN;
  const int tid = opaque_tid();
  LAS bf16_t* shm = (LAS bf16_t*)smem;
#define SA(b, h) (shm + ((b) * 2 + (h)) * HT)
#define SB(b, h) (shm + (4 + (b) * 2 + (h)) * HT)
#define STG(P, GB) do { const char* _gb = (GB); \
    _Pragma("unroll") for (int _i = 0; _i < 2; ++_i) { \
      __builtin_amdgcn_global_load_lds((const unsigned*)(_gb + voff[_i]), \
        (LAS unsigned*)((LAS char*)(P) + ldsw + _i * 8192), 16, 0, 0); } } while (0)
#define LDA(dst, b, h) _Pragma("unroll") for (int m = 0; m < 4; ++m) _Pragma("unroll") for (int k = 0; k < 2; ++k) \
    dst[m][k] = *(const LAS bf16x8*)((LAS char*)SA(b, h) + aoff + m * 2048 + k * 1024)
#define LDB(dst, b, h) _Pragma("unroll") for (int n = 0; n < 2; ++n) _Pragma("unroll") for (int k = 0; k < 2; ++k) \
    dst[n][k] = *(const LAS bf16x8*)((LAS char*)SB(b, h) + boff + n * 2048 + k * 1024)
#define MMA(ai, bj, At_, Bt_) do { __builtin_amdgcn_s_setprio(1); \
    _Pragma("unroll") for (int m = 0; m < 4; ++m) _Pragma("unroll") for (int n = 0; n < 2; ++n) _Pragma("unroll") for (int k = 0; k < 2; ++k) \
      acc[ai][bj][m][n] = __builtin_amdgcn_mfma_f32_16x16x32_bf16(Bt_[n][k], At_[m][k], acc[ai][bj][m][n], 0, 0, 0); \
    __builtin_amdgcn_s_setprio(0); } while (0)
#define WAIT_V(n) asm volatile("s_waitcnt vmcnt(" #n ")" ::: "memory")
#define WAIT_L(n) asm volatile("s_waitcnt lgkmcnt(" #n ")" ::: "memory")
#define BAR __builtin_amdgcn_s_barrier()
#define SCHED __builtin_amdgcn_sched_barrier(0)
  const int wid = __builtin_amdgcn_readfirstlane(tid >> 6), lane = tid & 63, wr = wid >> 2, wc = wid & 3, fr = lane & 15, fq = lane >> 4;
  const int aoff = lds_byte(wr * 64 + fr, fq * 8), boff = lds_byte(wc * 32 + fr, fq * 8);
  unsigned voff[2];
  const int ldsw = wid * 1024;
#pragma unroll
  for (int _i = 0; _i < 2; ++_i) { int _r, _c; stage_rc(tid * 16 + _i * 8192, _r, _c); voff[_i] = (unsigned)(_r * K + _c) * 2u; }
  const int nt = K / BK;
  const size_t kstep = (size_t)BK * 2, hstep = (size_t)HALF * K * 2, tstep = 2 * hstep;
  int pm, pn, npm = 0, npn = 0, ui = 0;
  if (!gemm_unit(0, nM, nN, nwg, pm, pn)) return;
  f32x4 acc[2][2][4][2];
#pragma unroll
  for (int a = 0; a < 2; ++a)
#pragma unroll
    for (int b = 0; b < 2; ++b)
#pragma unroll
      for (int m = 0; m < 4; ++m)
#pragma unroll
        for (int n = 0; n < 2; ++n) acc[a][b][m][n] = (f32x4){0.f, 0.f, 0.f, 0.f};
  bf16x8 At[4][2], B0[2][2], B1[2][2];
  const char* cA = (const char*)A + (size_t)pm * tstep;
  const char* cB = (const char*)Bt + (size_t)pn * tstep;
  STG(SB(0, 0), cB); STG(SA(0, 0), cA); STG(SB(0, 1), cB + hstep); STG(SA(0, 1), cA + hstep);
  if (wr == 1) BAR;
  WAIT_V(4); BAR;
  STG(SB(1, 0), cB + kstep); STG(SA(1, 0), cA + kstep); STG(SB(1, 1), cB + hstep + kstep);
  WAIT_V(6); BAR;
  for (;;) {
    const bool has_next = gemm_unit(ui + 1, nM, nN, nwg, npm, npn);
    const char* nA = has_next ? (const char*)A + (size_t)npm * tstep : cA;
    const char* nB = has_next ? (const char*)Bt + (size_t)npn * tstep : cB;
    for (int t = 0; t < nt; t += 2) {
      const bool last = (t == nt - 2);
      const char* a1 = cA + (size_t)(t + 1) * kstep;
      const char* a2 = last ? nA : cA + (size_t)(t + 2) * kstep;
      const char* b2 = last ? nB : cB + (size_t)(t + 2) * kstep;
      const char* a3 = a2 + kstep;
      const char* b3 = b2 + kstep;
      LDB(B0, 0, 0); SCHED; LDA(At, 0, 0); STG(SA(1, 1), a1 + hstep);
      WAIT_L(8); BAR; WAIT_L(0); MMA(0, 0, At, B0); BAR; SCHED;
      LDB(B1, 0, 1); STG(SB(0, 0), b2);
      BAR; WAIT_L(0); MMA(0, 1, At, B1); BAR;
      LDA(At, 0, 1); STG(SA(0, 0), a2);
      BAR; WAIT_L(0); MMA(1, 0, At, B0); BAR; SCHED;
      STG(SB(0, 1), b2 + hstep);
      WAIT_V(6); BAR; MMA(1, 1, At, B1); BAR;
      LDB(B0, 1, 0); SCHED; LDA(At, 1, 0); STG(SA(0, 1), a2 + hstep);
      WAIT_L(8); BAR; WAIT_L(0); MMA(0, 0, At, B0); BAR; SCHED;
      LDB(B1, 1, 1); STG(SB(1, 0), b3);
      BAR; WAIT_L(0); MMA(0, 1, At, B1); BAR;
      LDA(At, 1, 1); STG(SA(1, 0), a3);
      BAR; WAIT_L(0); MMA(1, 0, At, B0); BAR; SCHED;
      STG(SB(1, 1), b3 + hstep);
      WAIT_V(6); BAR; MMA(1, 1, At, B1); BAR;
    }
    {
      const int brow = pm * BM, bcol = pn * BM;
#pragma unroll
      for (int ai = 0; ai < 2; ++ai)
#pragma unroll
        for (int m = 0; m < 4; ++m) {
          const size_t row = (size_t)(brow + ai * HALF + wr * 64 + m * 16 + fr);
          if (EPI == 0) {
#pragma unroll
            for (int bj = 0; bj < 2; ++bj) {
              const f32x4 v0 = acc[ai][bj][m][0], v1 = acc[ai][bj][m][1];
              uint4 u; u.x = cvt_pk_bf16(v0[0], v0[1]); u.y = cvt_pk_bf16(v0[2], v0[3]); u.z = cvt_pk_bf16(v1[0], v1[1]); u.w = cvt_pk_bf16(v1[2], v1[3]);
              *(uint4*)(C + row * ldc + bcol + bj * HALF + wc * 32 + fq * 8) = u;
            }
          } else {
            float o[8];
#pragma unroll
            for (int n = 0; n < 2; ++n) {
              const f32x4 a = acc[ai][0][m][n], b = acc[ai][1][m][n];
#pragma unroll
              for (int j = 0; j < 4; ++j) o[n * 4 + j] = a[j] * __builtin_amdgcn_rcpf(1.f + __expf(-a[j])) * b[j];
            }
            *(uint4*)(C + row * ldc + (bcol >> 1) + wc * 32 + fq * 8) = pack8(o);
          }
        }
    }
    if (!has_next) break;
#pragma unroll
    for (int a = 0; a < 2; ++a)
#pragma unroll
      for (int b = 0; b < 2; ++b)
#pragma unroll
        for (int m = 0; m < 4; ++m)
#pragma unroll
          for (int n = 0; n < 2; ++n) acc[a][b][m][n] = (f32x4){0.f, 0.f, 0.f, 0.f};
    pm = npm; pn = npn; cA = nA; cB = nB; ++ui;
  }
  WAIT_V(0);
  if (wr == 0) BAR;
  BAR;
#undef SA
#undef SB
#undef STG
#undef LDA
#undef LDB
#undef MMA
}

__device__ __forceinline__ void load_shift16(const bf16_t* __restrict__ z, int row, int t, int T, int col, const float* __restrict__ mu, float* o) {
  const bf16_t* pz = z + (size_t)row * ZLD + col;
  uint4 c0 = *(const uint4*)pz, c1 = *(const uint4*)(pz + 8);
  uint4 p0 = make_uint4(0, 0, 0, 0), p1 = p0, n0 = p0, n1 = p0;
  if (t > 0) { p0 = *(const uint4*)(pz - ZLD); p1 = *(const uint4*)(pz - ZLD + 8); }
  if (t < T - 1) { n0 = *(const uint4*)(pz + ZLD); n1 = *(const uint4*)(pz + ZLD + 8); }
  float c[16], pv[16], nx[16];
  unpack8(c0, c); unpack8(c1, c + 8); unpack8(p0, pv); unpack8(p1, pv + 8); unpack8(n0, nx); unpack8(n1, nx + 8);
#pragma unroll
  for (int q = 0; q < 16; ++q) o[q] = c[q] + (0.5f * (pv[q] + nx[q]) - c[q]) * mu[col - 512 + q];
}
__device__ __forceinline__ void load_shift8(const bf16_t* __restrict__ z, int row, int t, int T, int col, const float* __restrict__ mu, float* o) {
  const bf16_t* pz = z + (size_t)row * ZLD + col;
  uint4 c0 = *(const uint4*)pz;
  uint4 p0 = make_uint4(0, 0, 0, 0), n0 = p0;
  if (t > 0) p0 = *(const uint4*)(pz - ZLD);
  if (t < T - 1) n0 = *(const uint4*)(pz + ZLD);
  float c[8], pv[8], nx[8];
  unpack8(c0, c); unpack8(p0, pv); unpack8(n0, nx);
#pragma unroll
  for (int q = 0; q < 8; ++q) o[q] = c[q] + (0.5f * (pv[q] + nx[q]) - c[q]) * mu[col - 512 + q];
}

constexpr int TC = 32;
constexpr int SV = TC * 64;
struct Raw8 { uint4 c, p, n; };
__device__ __forceinline__ void lp_load(Raw8& r, const bf16_t* __restrict__ z, int task) {
  r.c = make_uint4(0, 0, 0, 0); r.p = r.c; r.n = r.c;
  if (task < NTOK * 32) {
    const int row = task >> 5, oc = task & 31;
    int s, t, T;
    row_seq(row, s, t, T);
    const bf16_t* pz = z + (size_t)row * ZLD + 2048 + oc * 8;
    r.c = *(const uint4*)pz;
    if (t > 0) r.p = *(const uint4*)(pz - ZLD);
    if (t < T - 1) r.n = *(const uint4*)(pz + ZLD);
  }
}
__device__ __forceinline__ void lp_store(const Raw8& r, bf16_t* __restrict__ al, const float* __restrict__ mu, int task) {
  if (task < NTOK * 32) {
    const int row = task >> 5, oc = task & 31;
    float c[8], pv[8], nx[8], o[8];
    unpack8(r.c, c); unpack8(r.p, pv); unpack8(r.n, nx);
#pragma unroll
    for (int q = 0; q < 8; ++q) o[q] = c[q] + (0.5f * (pv[q] + nx[q]) - c[q]) * mu[2048 - 512 + oc * 8 + q];
    if (oc < 16) {
#pragma unroll
      for (int q = 0; q < 8; ++q) { const float e = __expf(2.f * o[q]); o[q] = 1.f - 2.f * __builtin_amdgcn_rcpf(e + 1.f); }
    }
    *(uint4*)(al + (size_t)row * 256 + oc * 8) = pack8(o);
  }
}
__device__ __forceinline__ void lora_prep_phase(PREF p, const int wid_u) {
  const int tid = opaque_tid();
  const bf16_t* z = P_RU;
  bf16_t* al = P_ALORA;
  const float* mu = p.shift_mu;
  const int stride = gridDim.x * NTHR;
#pragma unroll 1
  for (int task0 = blockIdx.x * NTHR + tid; task0 < NTOK * 32; task0 += 4 * stride) {
    Raw8 r0, r1, r2, r3;
    lp_load(r0, z, task0); lp_load(r1, z, task0 + stride); lp_load(r2, z, task0 + 2 * stride); lp_load(r3, z, task0 + 3 * stride);
    lp_store(r0, al, mu, task0); lp_store(r1, al, mu, task0 + stride); lp_store(r2, al, mu, task0 + 2 * stride); lp_store(r3, al, mu, task0 + 3 * stride);
  }
}

template <int HALF>
__device__ __forceinline__ void pool_seg(const bf16_t* __restrict__ z, bf16_t* __restrict__ mo, int row_base, int tbase, int T, int c0) {
  constexpr int NR = 2 * HALF + 3;
  float acc[4][8], zc[4][8];
#pragma unroll
  for (int i = 0; i < 4; ++i)
#pragma unroll
    for (int q = 0; q < 8; ++q) { acc[i][q] = 0.f; zc[i][q] = 0.f; }
#pragma unroll
  for (int r = 0; r < NR; ++r) {
    const int tt = tbase - HALF + r;
    uint4 u = make_uint4(0, 0, 0, 0);
    if (tt >= 0 && tt < T) u = *(const uint4*)(z + (size_t)(row_base - HALF + r) * ZLD + c0);
    float v[8];
    unpack8(u, v);
#pragma unroll
    for (int i = 0; i < 4; ++i) {
      if (r >= i && r < i + 2 * HALF) {
#pragma unroll
        for (int q = 0; q < 8; ++q) acc[i][q] += v[q];
      }
      if (r == HALF + i) {
#pragma unroll
        for (int q = 0; q < 8; ++q) zc[i][q] = v[q];
      }
    }
  }
#pragma unroll
  for (int i = 0; i < 4; ++i) {
    const int ti = tbase + i;
    const float ic = 1.f / (float)(min(ti + HALF, T) - max(ti - HALF, 0));
    float o[8];
#pragma unroll
    for (int q = 0; q < 8; ++q) o[q] = acc[i][q] * ic - zc[i][q];
    *(uint4*)(mo + (size_t)(row_base + i) * D + c0) = pack8(o);
  }
}
__device__ __forceinline__ void pool_tile(const bf16_t* __restrict__ z, bf16_t* __restrict__ mo, int tile, int tid) {
  const int row0 = tile * 32;
  int s, t0, T;
  row_seq(row0, s, t0, T);
  const int oc = tid >> 3, seg = tid & 7, c0 = oc * 8, grp = __builtin_amdgcn_readfirstlane(oc >> 4);
  const int rb = row0 + seg * 4, tb = t0 + seg * 4;
  if (grp == 0) pool_seg<1>(z, mo, rb, tb, T, c0);
  else if (grp == 1) pool_seg<2>(z, mo, rb, tb, T, c0);
  else if (grp == 2) pool_seg<4>(z, mo, rb, tb, T, c0);
  else pool_seg<8>(z, mo, rb, tb, T, c0);
}

struct Raw16 { uint4 c0, c1, p0, p1, n0, n1; };
__device__ __forceinline__ void load_raw16(Raw16& r, const bf16_t* __restrict__ z, int row, int t, int T, int col) {
  const bf16_t* pz = z + (unsigned)(row * ZLD + col);
  r.c0 = *(const uint4*)pz; r.c1 = *(const uint4*)(pz + 8);
  r.p0 = make_uint4(0, 0, 0, 0); r.p1 = r.p0; r.n0 = r.p0; r.n1 = r.p0;
  if (t > 0) { r.p0 = *(const uint4*)(pz - ZLD); r.p1 = *(const uint4*)(pz - ZLD + 8); }
  if (t < T - 1) { r.n0 = *(const uint4*)(pz + ZLD); r.n1 = *(const uint4*)(pz + ZLD + 8); }
}
__device__ __forceinline__ void shift16(const Raw16& r, const float* c1, const float* c2, float* o) {
  float c[16], pv[16], nx[16];
  unpack8(r.c0, c); unpack8(r.c1, c + 8); unpack8(r.p0, pv); unpack8(r.p1, pv + 8); unpack8(r.n0, nx); unpack8(r.n1, nx + 8);
#pragma unroll
  for (int q = 0; q < 16; ++q) o[q] = c[q] * c1[q] + (pv[q] + nx[q]) * c2[q];
}
__device__ __forceinline__ bf16x8 ldfrag(const bf16_t* base, int stride, int row0, int k0, int fr, int fq) {
  return *reinterpret_cast<const bf16x8*>(base + (row0 + fr) * stride + k0 + fq * 8);
}
__device__ __forceinline__ uint2 pack4(f32x4 v) { uint2 u; u.x = cvt_pk_bf16(v[0], v[1]); u.y = cvt_pk_bf16(v[2], v[3]); return u; }
#define MFMA16(a, b, c) __builtin_amdgcn_mfma_f32_16x16x32_bf16(a, b, c, 0, 0, 0)

constexpr int CS_NAB = 0, CS_NAK = 4096, CS_NBRT = 8192, CS_NKRT = 10752, CS_QT = 13312, CS_W = 15872, CS_Z = 20992, CS_GT = 26112,
              CS_RYT = 35328, CS_VN = 39936;
constexpr int CS_AT = 49152, CS_RT = CS_AT + 4608, CS_BT = CS_RT + 4608, CS_KT = CS_BT + 4608, CS_BB = 67584, CS_KB = CS_BB + 5120,
              CS_VT = CS_KB + 5120, CS_ATT = 82944, CS_PL = 92160, CS_SBF = 92416, CS_STEP = 110848, CS_CST = 160000;

__device__ __forceinline__ void lds_barrier() {
  asm volatile("s_waitcnt lgkmcnt(0)" ::: "memory");
  __builtin_amdgcn_s_barrier();
  asm volatile("" ::: "memory");
}
template <int Q> __device__ __forceinline__ float quad_bcast(float x) { return dpp_f<Q * 0x55>(x); }

template <int S0> __device__ __forceinline__ void solve_steps(float (&x)[8], const float* nab, int seg) {
  if constexpr (S0 < 32) {
    const float xs = quad_bcast<(S0 >> 3)>(x[S0 & 7]);
    const f32x4 n0 = *(const f32x4*)(nab + S0 * 32 + seg * 8), n1 = *(const f32x4*)(nab + S0 * 32 + seg * 8 + 4);
    x[0] += xs * n0[0]; x[1] += xs * n0[1]; x[2] += xs * n0[2]; x[3] += xs * n0[3];
    x[4] += xs * n1[0]; x[5] += xs * n1[1]; x[6] += xs * n1[2]; x[7] += xs * n1[3];
    solve_steps<S0 + 1>(x, nab, seg);
  }
}

template <int S0> __device__ __forceinline__ void solve16(float (&x)[8], const float* nb) {
  if constexpr (S0 < 16) {
    const float xs = (S0 >> 3) ? dpp_f<0xF5>(x[S0 & 7]) : dpp_f<0xA0>(x[S0 & 7]);
    const f32x4 n0 = *(const f32x4*)(nb + S0 * 32), n1 = *(const f32x4*)(nb + S0 * 32 + 4);
    x[0] += xs * n0[0]; x[1] += xs * n0[1]; x[2] += xs * n0[2]; x[3] += xs * n0[3];
    x[4] += xs * n1[0]; x[5] += xs * n1[1]; x[6] += xs * n1[2]; x[7] += xs * n1[3];
    if constexpr ((S0 & 3) == 3) __builtin_amdgcn_sched_barrier(0);
    solve16<S0 + 1>(x, nb);
  }
}

__device__ __forceinline__ void scan_phase(PREF p, char* smem, const int wid_u) {
  float* stepbuf = (float*)(smem + CS_STEP);
  float* Nab = (float*)(smem + CS_NAB);
  bf16_t* NakT = (bf16_t*)(smem + CS_NAK);
  bf16_t* VNb = (bf16_t*)(smem + CS_VN);
  bf16_t* T11b = (bf16_t*)(smem + CS_VN + 5120);
  bf16_t* M1T = (bf16_t*)(smem + CS_VN + 5120 + 1280);
  bf16_t* NbrT = (bf16_t*)(smem + CS_NBRT);
  bf16_t* NkrT = (bf16_t*)(smem + CS_NKRT);
  bf16_t* TT = (bf16_t*)(smem + CS_QT);
  bf16_t* Wb = (bf16_t*)(smem + CS_W);
  bf16_t* Zb = (bf16_t*)(smem + CS_Z);
  bf16_t* GT = (bf16_t*)(smem + CS_GT);
  bf16_t* RyT = (bf16_t*)(smem + CS_RYT);
  bf16_t* At = (bf16_t*)(smem + CS_AT);
  bf16_t* Rt = (bf16_t*)(smem + CS_RT);
  bf16_t* Bt = (bf16_t*)(smem + CS_BT);
  bf16_t* Kt = (bf16_t*)(smem + CS_KT);
  bf16_t* Bb = (bf16_t*)(smem + CS_BB);
  bf16_t* Kb = (bf16_t*)(smem + CS_KB);
  bf16_t* VT = (bf16_t*)(smem + CS_VT);
  bf16_t* AtTb = (bf16_t*)(smem + CS_ATT);
  float* PLs = (float*)(smem + CS_PL);
  bf16_t* Sbf = (bf16_t*)(smem + CS_SBF);
  float* cst = (float*)(smem + CS_CST);
  const bf16_t* z = P_RU;
  const int tid = opaque_tid();
  const int wave = __builtin_amdgcn_readfirstlane(tid >> 6), lane = tid & 63, fr = lane & 15, fq = lane >> 4;
  const int item = blockIdx.x;
  if (item < 256) {
    const int s = item < 128 ? 8 + (item >> 4) : ((item - 128) >> 4);
    const int h = (item & 15) >> 1, d = item & 1;
    const int T = s < 8 ? 4096 : 8192, r0seq = seq_start(s), nch = T / 32;
    bf16_t* yout = P_RY + (size_t)d * NTOK * 512;
    {
      const int g = tid >> 6, k = tid & 63;
      const float muk = p.shift_mu[1024 - 512 + h * 64 + k], mur = p.shift_mu[512 - 512 + h * 64 + k], muv = p.shift_mu[1536 - 512 + h * 64 + k];
      float v;
      if (g == 0) v = 0.5f * muk;
      else if (g == 1) v = 0.5f * mur;
      else if (g == 2) v = 1.f - muk;
      else if (g == 3) v = 1.f - mur;
      else if (g == 4) v = 1.f - muv;
      else if (g == 5) v = p.k_k[h * 64 + k];
      else if (g == 6) v = p.k_a[h * 64 + k];
      else v = p.r_k[h * 64 + k];
      cst[g * 64 + k] = v;
      if (g == 0) cst[8 * 64 + k] = 0.5f * muv;
      for (int i = tid; i < 2 * 64 * 72 / 2; i += NTHR) ((unsigned*)Sbf)[i] = 0u;
    }
    const int role = wave >> 1, th = wave & 1;
    const int tl = lane >> 2, cq = lane & 3;
    uint4* Btab0 = (uint4*)(p.ws + OFF_BTAB);
    const unsigned bti = (unsigned)(item * 1024 + (role & 1) * 512 + lane);
    float bias[4] = {0.f, 0.f, 0.f, 0.f};
    if (role < 2) {
      const float* lsrc = sel(role != 0, p.a2, p.w2) + (size_t)d * 64 * 512 + h * 64;
      if (th == 0) {
#pragma unroll
        for (int nt = 0; nt < 4; ++nt)
#pragma unroll
          for (int ks = 0; ks < 2; ++ks) {
            float o[8];
#pragma unroll
            for (int q = 0; q < 8; ++q) o[q] = lsrc[(size_t)(ks * 32 + fq * 8 + q) * 512 + nt * 16 + fr];
            Btab0[bti + (unsigned)((nt * 2 + ks) * 64)] = pack8(o);
          }
      }
#pragma unroll
      for (int nt = 0; nt < 4; ++nt) bias[nt] = sel(role != 0, p.a0, p.w0)[d * 512 + h * 64 + nt * 16 + fr];
    }
    const int colA = (role == 2 ? 512 : 1024) + h * 64 + cq * 16;
    const int colB = 1536 + h * 64 + cq * 16;
    const int alo = (role == 0 ? d * 64 : 128 + d * 64) + fq * 8;
    Raw16 ra, rb;
    {
      const int j = th * 16 + tl, t = d ? T - 1 - j : j, row = r0seq + t;
      if (role >= 2) load_raw16(ra, z, row, t, T, colA);
      if (role == 3) load_raw16(rb, z, row, t, T, colB);
      if (role < 2) {
        const int j2 = th * 16 + fr, t2 = d ? T - 1 - j2 : j2;
        const bf16_t* ap = P_ALORA + (unsigned)((r0seq + t2) * 256 + alo);
        ra.c0 = *(const uint4*)ap; ra.c1 = *(const uint4*)(ap + 32);
      }
    }
    f32x4 Sa = {0.f, 0.f, 0.f, 0.f}, Sb = Sa;
    uint2 y_def = make_uint2(0u, 0u);
    float sb_def = 0.f;
    const int mt = wave >> 1, hn = wave & 1, nt0 = 2 * hn, nt1 = 2 * hn + 1;
    asm volatile("s_waitcnt vmcnt(0)" ::: "memory");
    __syncthreads();

    {
      {
        const int j = th * 16 + tl;
        float v16[16];
        if (role < 2) {
          f32x4 acc[4] = {};
          unsigned bti_ = bti;
          asm volatile("" : "+v"(bti_));
#pragma unroll
          for (int ks = 0; ks < 2; ++ks) {
            const uint4 au = ks == 0 ? ra.c0 : ra.c1;
            const bf16x8 a = *reinterpret_cast<const bf16x8*>(&au);
#pragma unroll
            for (int nt = 0; nt < 4; ++nt) { const uint4 bu = Btab0[bti_ + (unsigned)((nt * 2 + ks) * 64)]; acc[nt] = MFMA16(a, *reinterpret_cast<const bf16x8*>(&bu), acc[nt]); }
          }
          if (role == 0) {
#pragma unroll
            for (int nt = 0; nt < 4; ++nt)
#pragma unroll
              for (int jj = 0; jj < 4; ++jj) {
                const float sg = sigmoidf_(bias[nt] + acc[nt][jj]);
                stepbuf[0 * SV + (th * 16 + fq * 4 + jj) * 64 + nt * 16 + fr] = __expf(-0.6065306597126334f * sg);
              }
            __builtin_amdgcn_wave_barrier();
            {
              float wl[16];
#pragma unroll
              for (int i = 0; i < 16; ++i) wl[i] = stepbuf[0 * SV + (th * 16 + i) * 64 + lane];
              float pr = 1.f;
#pragma unroll
              for (int i = 0; i < 16; ++i) { pr *= wl[i]; stepbuf[0 * SV + (th * 16 + i) * 64 + lane] = pr; }
            }
          } else {
#pragma unroll
            for (int nt = 0; nt < 4; ++nt)
#pragma unroll
              for (int jj = 0; jj < 4; ++jj) stepbuf[4 * SV + (th * 16 + fq * 4 + jj) * 64 + nt * 16 + fr] = sigmoidf_(bias[nt] + acc[nt][jj]);
          }
        } else if (role == 2) {
          shift16(ra, cst + 3 * 64 + cq * 16, cst + 1 * 64 + cq * 16, v16);
#pragma unroll
          for (int q = 0; q < 4; ++q) *(f32x4*)(stepbuf + 2 * SV + j * 64 + cq * 16 + q * 4) = (f32x4){v16[q * 4], v16[q * 4 + 1], v16[q * 4 + 2], v16[q * 4 + 3]};
        } else {
          shift16(ra, cst + 2 * 64 + cq * 16, cst + 0 * 64 + cq * 16, v16);
          float kk[16], ss = 0.f;
#pragma unroll
          for (int q = 0; q < 16; ++q) { kk[q] = v16[q] * cst[5 * 64 + cq * 16 + q]; ss += kk[q] * kk[q]; }
          ss = quad_sum(ss);
          const float inv = 1.f / fmaxf(sqrtf(ss), 1e-12f);
#pragma unroll
          for (int q = 0; q < 4; ++q) {
            *(f32x4*)(stepbuf + 1 * SV + j * 64 + cq * 16 + q * 4) = (f32x4){v16[q * 4], v16[q * 4 + 1], v16[q * 4 + 2], v16[q * 4 + 3]};
            *(f32x4*)(stepbuf + 3 * SV + j * 64 + cq * 16 + q * 4) = (f32x4){-kk[q * 4] * inv, -kk[q * 4 + 1] * inv, -kk[q * 4 + 2] * inv, -kk[q * 4 + 3] * inv};
          }
          shift16(rb, cst + 4 * 64 + cq * 16, cst + 8 * 64 + cq * 16, v16);
#pragma unroll
          for (int q = 0; q < 4; ++q) *(f32x4*)(stepbuf + 5 * SV + j * 64 + cq * 16 + q * 4) = (f32x4){v16[q * 4], v16[q * 4 + 1], v16[q * 4 + 2], v16[q * 4 + 3]};
        }
      }
      if (1 < nch) {
        const int is2 = 32 + th * 16 + tl;
        const int t2 = d ? T - 1 - is2 : is2;
        const int row2 = r0seq + t2;
        if (role >= 2) load_raw16(ra, z, row2, t2, T, colA);
        if (role == 3) load_raw16(rb, z, row2, t2, T, colB);
        if (role < 2) {
          const int is3 = 32 + th * 16 + fr, t3 = d ? T - 1 - is3 : is3;
          const bf16_t* ap = P_ALORA + (unsigned)((r0seq + t3) * 256 + alo);
          ra.c0 = *(const uint4*)ap; ra.c1 = *(const uint4*)(ap + 32);
        }
      }
      lds_barrier();
    }
    {
      {
        const int k = lane, seg = wave;
        const float* sw = stepbuf + 0 * SV + k;
        const float P15 = sw[15 * 64];
        const float hiF = seg >= 4 ? P15 : 1.f;
        float P[5];
        P[0] = seg == 0 ? 1.f : sw[(4 * seg - 1) * 64] * (seg > 4 ? P15 : 1.f);
#pragma unroll
        for (int i = 0; i < 4; ++i) P[i + 1] = sw[(4 * seg + i) * 64] * hiF;
        const float PL = sw[31 * 64] * P15;
        if (role == 2) {
          const int j = th * 16 + tl;
          float bs = 0.f;
#pragma unroll
          for (int q = 0; q < 16; ++q) {
            const float kd_ = stepbuf[1 * SV + j * 64 + cq * 16 + q] * (1.f + (stepbuf[4 * SV + j * 64 + cq * 16 + q] - 1.f) * cst[6 * 64 + cq * 16 + q]);
            bs += stepbuf[2 * SV + j * 64 + cq * 16 + q] * kd_ * cst[7 * 64 + cq * 16 + q];
          }
          bs = quad_sum(bs);
          sb_def = bs;
        }
        f32x4 bb, kb, at, vv;
#pragma unroll
        for (int i = 0; i < 4; ++i) {
          const int t = 4 * seg + i;
          const float inv = __builtin_amdgcn_rcpf(P[i + 1]);
          const float nav = stepbuf[3 * SV + t * 64 + k], av = stepbuf[4 * SV + t * 64 + k];
          const float a_ = P[i] * nav;
          const float rraw = stepbuf[2 * SV + t * 64 + k];
          const float kraw = stepbuf[1 * SV + t * 64 + k] * (1.f + (av - 1.f) * cst[6 * 64 + k]);
          const float r_ = P[i + 1] * rraw;
          const float b_ = -nav * av * inv;
          const float k_ = kraw * inv;

          At[t * 72 + k] = (bf16_t)(cvt_pk_bf16(a_, 0.f) & 0xffff);
          Rt[t * 72 + k] = (bf16_t)(cvt_pk_bf16(r_, 0.f) & 0xffff);
          Bt[t * 72 + k] = (bf16_t)(cvt_pk_bf16(b_, 0.f) & 0xffff);
          Kt[t * 72 + k] = (bf16_t)(cvt_pk_bf16(k_, 0.f) & 0xffff);
          bb[i] = b_ * PL; kb[i] = k_ * PL; at[i] = a_;
          vv[i] = stepbuf[5 * SV + t * 64 + k];
        }
        *(uint2*)(Bb + k * 40 + 4 * seg) = pack4(bb);
        *(uint2*)(Kb + k * 40 + 4 * seg) = pack4(kb);
        *(uint2*)(VT + k * 40 + 4 * seg) = pack4(vv);
        *(uint2*)(AtTb + k * 40 + 4 * seg) = pack4(at);
        if (seg == 0) PLs[k] = PL;
      }
      lds_barrier();
    }
    for (int c = 0; c < nch; ++c) {
      {
        const int mat = wave >> 1, mts = wave & 1;
        const bf16_t* As = (mat & 1) ? Kt : Bt;
        const bf16_t* Bs = (mat & 2) ? Rt : At;
        f32x4 acc[2] = {};
#pragma unroll
        for (int ks = 0; ks < 2; ++ks) {
          const bf16x8 a = ldfrag(As, 72, mts * 16, ks * 32, fr, fq);
#pragma unroll
          for (int nt = 0; nt < 2; ++nt) acc[nt] = MFMA16(a, ldfrag(Bs, 72, nt * 16, ks * 32, fr, fq), acc[nt]);
        }
#pragma unroll
        for (int nt = 0; nt < 2; ++nt) {
          const int tcol = nt * 16 + fr;
          f32x4 v = acc[nt];
#pragma unroll
          for (int jj = 0; jj < 4; ++jj) {
            const int srow = mts * 16 + fq * 4 + jj;
            const bool keep = (mat & 2) ? (srow <= tcol) : (srow < tcol);
            v[jj] = keep ? v[jj] : 0.f;
          }
          if (mat == 0) {
#pragma unroll
            for (int jj = 0; jj < 4; ++jj) Nab[(mts * 16 + fq * 4 + jj) * 32 + tcol] = v[jj];
          } else {
            bf16_t* dst = mat == 1 ? NakT : mat == 2 ? NbrT : NkrT;
            *(uint2*)(dst + tcol * 40 + mts * 16 + fq * 4) = pack4(v);
          }
        }
      }
      lds_barrier();
      if (wave == 4) {
        const int irow = lane >> 1, hb = lane & 1, blk = lane >> 5, il = irow & 15;
        float x[8];
#pragma unroll
        for (int i = 0; i < 8; ++i) x[i] = (hb * 8 + i == il) ? 1.f : 0.f;
        const float* nb = Nab + (blk * 16) * 32 + blk * 16 + hb * 8;
        solve16<0>(x, nb);
#pragma unroll
        for (int i = 0; i < 8; ++i) TT[(blk * 16 + hb * 8 + i) * 40 + blk * 16 + il] = (bf16_t)(cvt_pk_bf16(x[i], 0.f) & 0xffff);
        if (blk == 0) *(uint4*)(T11b + il * 40 + hb * 8) = pack8(x);
        __builtin_amdgcn_wave_barrier();
        const f32x4 zero = {0.f, 0.f, 0.f, 0.f};
        bf16x8 zf;
#pragma unroll
        for (int i = 0; i < 8; ++i) zf[i] = 0;
        bf16x8 n12 = zf, t22 = zf, t11 = zf;
        if (fq < 2) {
          float o[8];
          const f32x4 n0 = *(const f32x4*)(Nab + fr * 32 + 16 + fq * 8), n1 = *(const f32x4*)(Nab + fr * 32 + 16 + fq * 8 + 4);
          o[0] = n0[0]; o[1] = n0[1]; o[2] = n0[2]; o[3] = n0[3]; o[4] = n1[0]; o[5] = n1[1]; o[6] = n1[2]; o[7] = n1[3];
          uint4 u = pack8(o);
          n12 = *reinterpret_cast<bf16x8*>(&u);
          t22 = *reinterpret_cast<const bf16x8*>(TT + (16 + fr) * 40 + 16 + fq * 8);
          t11 = *reinterpret_cast<const bf16x8*>(T11b + fr * 40 + fq * 8);
        }
        const f32x4 m1 = MFMA16(n12, t22, zero);
        *(uint2*)(M1T + fr * 40 + fq * 4) = pack4(m1);
        __builtin_amdgcn_wave_barrier();
        bf16x8 m1f = zf;
        if (fq < 2) m1f = *reinterpret_cast<const bf16x8*>(M1T + fr * 40 + fq * 8);
        const f32x4 t12 = MFMA16(t11, m1f, zero);
        *(uint2*)(TT + (16 + fr) * 40 + fq * 4) = pack4(t12);
      } else if (wave == 5) {
        unsigned z0;
        asm volatile("v_mov_b32 %0, 0" : "=v"(z0));
        *(uint2*)(TT + (lane >> 2) * 40 + 16 + (lane & 3) * 4) = make_uint2(z0, z0);
      } else if (wave == 2 || wave == 3 || wave >= 6) {
        const int vtile = wave < 4 ? wave - 2 : wave - 4;
        const bf16x8 vf = ldfrag(VT, 40, vtile * 16, 0, fr, fq);
        const f32x4 zero = {0.f, 0.f, 0.f, 0.f};
#pragma unroll
        for (int tt = 0; tt < 2; ++tt) {
          const f32x4 acc = MFMA16(ldfrag(NakT, 40, tt * 16, 0, fr, fq), vf, zero);
          *(uint2*)(VNb + (vtile * 16 + fr) * 40 + tt * 16 + fq * 4) = pack4(acc);
        }
      }
      if (c + 1 < nch) {
      {
        const int j = th * 16 + tl;
        float v16[16];
        if (role < 2) {
          f32x4 acc[4] = {};
          unsigned bti_ = bti;
          asm volatile("" : "+v"(bti_));
#pragma unroll
          for (int ks = 0; ks < 2; ++ks) {
            const uint4 au = ks == 0 ? ra.c0 : ra.c1;
            const bf16x8 a = *reinterpret_cast<const bf16x8*>(&au);
#pragma unroll
            for (int nt = 0; nt < 4; ++nt) { const uint4 bu = Btab0[bti_ + (unsigned)((nt * 2 + ks) * 64)]; acc[nt] = MFMA16(a, *reinterpret_cast<const bf16x8*>(&bu), acc[nt]); }
          }
          if (role == 0) {
#pragma unroll
            for (int nt = 0; nt < 4; ++nt)
#pragma unroll
              for (int jj = 0; jj < 4; ++jj) {
                const float sg = sigmoidf_(bias[nt] + acc[nt][jj]);
                stepbuf[0 * SV + (th * 16 + fq * 4 + jj) * 64 + nt * 16 + fr] = __expf(-0.6065306597126334f * sg);
              }
            __builtin_amdgcn_wave_barrier();
            {
              float wl[16];
#pragma unroll
              for (int i = 0; i < 16; ++i) wl[i] = stepbuf[0 * SV + (th * 16 + i) * 64 + lane];
              float pr = 1.f;
#pragma unroll
              for (int i = 0; i < 16; ++i) { pr *= wl[i]; stepbuf[0 * SV + (th * 16 + i) * 64 + lane] = pr; }
            }
          } else {
#pragma unroll
            for (int nt = 0; nt < 4; ++nt)
#pragma unroll
              for (int jj = 0; jj < 4; ++jj) stepbuf[4 * SV + (th * 16 + fq * 4 + jj) * 64 + nt * 16 + fr] = sigmoidf_(bias[nt] + acc[nt][jj]);
          }
        } else if (role == 2) {
          shift16(ra, cst + 3 * 64 + cq * 16, cst + 1 * 64 + cq * 16, v16);
#pragma unroll
          for (int q = 0; q < 4; ++q) *(f32x4*)(stepbuf + 2 * SV + j * 64 + cq * 16 + q * 4) = (f32x4){v16[q * 4], v16[q * 4 + 1], v16[q * 4 + 2], v16[q * 4 + 3]};
        } else {
          shift16(ra, cst + 2 * 64 + cq * 16, cst + 0 * 64 + cq * 16, v16);
          float kk[16], ss = 0.f;
#pragma unroll
          for (int q = 0; q < 16; ++q) { kk[q] = v16[q] * cst[5 * 64 + cq * 16 + q]; ss += kk[q] * kk[q]; }
          ss = quad_sum(ss);
          const float inv = 1.f / fmaxf(sqrtf(ss), 1e-12f);
#pragma unroll
          for (int q = 0; q < 4; ++q) {
            *(f32x4*)(stepbuf + 1 * SV + j * 64 + cq * 16 + q * 4) = (f32x4){v16[q * 4], v16[q * 4 + 1], v16[q * 4 + 2], v16[q * 4 + 3]};
            *(f32x4*)(stepbuf + 3 * SV + j * 64 + cq * 16 + q * 4) = (f32x4){-kk[q * 4] * inv, -kk[q * 4 + 1] * inv, -kk[q * 4 + 2] * inv, -kk[q * 4 + 3] * inv};
          }
          shift16(rb, cst + 4 * 64 + cq * 16, cst + 8 * 64 + cq * 16, v16);
#pragma unroll
          for (int q = 0; q < 4; ++q) *(f32x4*)(stepbuf + 5 * SV + j * 64 + cq * 16 + q * 4) = (f32x4){v16[q * 4], v16[q * 4 + 1], v16[q * 4 + 2], v16[q * 4 + 3]};
        }
      }
      }
      if (c > 0) {
        const int ip = (c - 1) * 32 + hn * 16 + fr, tp = d ? T - 1 - ip : ip;
        *(uint2*)(yout + (size_t)(r0seq + tp) * 512 + h * 64 + mt * 16 + fq * 4) = y_def;
      }
      if (role == 2 && cq == 0) { const int is_ = c * 32 + th * 16 + tl, tg = d ? T - 1 - is_ : is_; P_SBON[((size_t)(r0seq + tg) * 8 + h) * 2 + d] = sb_def; }
      if (c + 2 < nch) {
        const int is2 = (c + 2) * 32 + th * 16 + tl;
        const int t2 = d ? T - 1 - is2 : is2;
        const int row2 = r0seq + t2;
        if (role >= 2) load_raw16(ra, z, row2, t2, T, colA);
        if (role == 3) load_raw16(rb, z, row2, t2, T, colB);
        if (role < 2) {
          const int is3 = (c + 2) * 32 + th * 16 + fr, t3 = d ? T - 1 - is3 : is3;
          const bf16_t* ap = P_ALORA + (unsigned)((r0seq + t3) * 256 + alo);
          ra.c0 = *(const uint4*)ap; ra.c1 = *(const uint4*)(ap + 32);
        }
      }
      lds_barrier();
      {
        const int tt = wave & 1, rt = wave >> 1;
        const f32x4 zero = {0.f, 0.f, 0.f, 0.f};
        const bf16x8 tf = ldfrag(TT, 40, tt * 16, 0, fr, fq);
        const f32x4 zacc = MFMA16(tf, ldfrag(VNb, 40, rt * 16, 0, fr, fq), zero);
        const f32x4 wacc = MFMA16(tf, ldfrag(AtTb, 40, rt * 16, 0, fr, fq), zero);
        *(uint2*)(Zb + (rt * 16 + fr) * 40 + tt * 16 + fq * 4) = pack4(zacc);
        *(uint2*)(Wb + (rt * 16 + fr) * 40 + tt * 16 + fq * 4) = pack4(wacc);
      }
      lds_barrier();
      f32x4 yacc = {0.f, 0.f, 0.f, 0.f};
      {
        const float pl0 = PLs[nt0 * 16 + fr], pl1 = PLs[nt1 * 16 + fr];
        Sa = Sa * pl0; Sb = Sb * pl1;
        const bf16x8 zf = ldfrag(Zb, 40, mt * 16, 0, fr, fq), vf = ldfrag(VT, 40, mt * 16, 0, fr, fq), wf = ldfrag(Wb, 40, mt * 16, 0, fr, fq);
        const bf16x8 bb0 = ldfrag(Bb, 40, nt0 * 16, 0, fr, fq), bb1 = ldfrag(Bb, 40, nt1 * 16, 0, fr, fq);
        const bf16x8 kb0 = ldfrag(Kb, 40, nt0 * 16, 0, fr, fq), kb1 = ldfrag(Kb, 40, nt1 * 16, 0, fr, fq);
        const bf16x8 nbr = ldfrag(NbrT, 40, hn * 16, 0, fr, fq), nkr = ldfrag(NkrT, 40, hn * 16, 0, fr, fq);
        Sa = MFMA16(zf, bb0, Sa); Sa = MFMA16(vf, kb0, Sa);
        Sb = MFMA16(zf, bb1, Sb); Sb = MFMA16(vf, kb1, Sb);
        yacc = MFMA16(zf, nbr, yacc); yacc = MFMA16(vf, nkr, yacc);
        const f32x4 zero = {0.f, 0.f, 0.f, 0.f};
        const f32x4 g0 = MFMA16(wf, bb0, zero), g1 = MFMA16(wf, bb1, zero);
        f32x4 ry = MFMA16(wf, nbr, zero);
        *(uint2*)(GT + (nt0 * 16 + fr) * 72 + mt * 16 + fq * 4) = pack4(g0);
        *(uint2*)(GT + (nt1 * 16 + fr) * 72 + mt * 16 + fq * 4) = pack4(g1);
        const uint2 rr = *(const uint2*)(Rt + (hn * 16 + fr) * 72 + mt * 16 + fq * 4);
        ry[0] += bf_lo(rr.x); ry[1] += bf_hi(rr.x); ry[2] += bf_lo(rr.y); ry[3] += bf_hi(rr.y);
        *(uint2*)(RyT + (hn * 16 + fr) * 72 + mt * 16 + fq * 4) = pack4(ry);
      }
      lds_barrier();
      {
        const bf16_t* Scur = Sbf + (c & 1) * 64 * 72;
        bf16_t* Snext = Sbf + ((c + 1) & 1) * 64 * 72;
#pragma unroll
        for (int ks = 0; ks < 2; ++ks) {
          const bf16x8 af = ldfrag(Scur, 72, mt * 16, ks * 32, fr, fq);
          Sa = MFMA16(af, ldfrag(GT, 72, nt0 * 16, ks * 32, fr, fq), Sa);
          Sb = MFMA16(af, ldfrag(GT, 72, nt1 * 16, ks * 32, fr, fq), Sb);
          yacc = MFMA16(af, ldfrag(RyT, 72, hn * 16, ks * 32, fr, fq), yacc);
        }
        y_def = pack4(yacc);
#pragma unroll
        for (int jj = 0; jj < 4; ++jj) {
          Snext[(mt * 16 + fq * 4 + jj) * 72 + nt0 * 16 + fr] = (bf16_t)(cvt_pk_bf16(Sa[jj], 0.f) & 0xffff);
          Snext[(mt * 16 + fq * 4 + jj) * 72 + nt1 * 16 + fr] = (bf16_t)(cvt_pk_bf16(Sb[jj], 0.f) & 0xffff);
        }
      }
      if (c + 1 < nch) {
      {
        const int k = lane, seg = wave;
        const float* sw = stepbuf + 0 * SV + k;
        const float P15 = sw[15 * 64];
        const float hiF = seg >= 4 ? P15 : 1.f;
        float P[5];
        P[0] = seg == 0 ? 1.f : sw[(4 * seg - 1) * 64] * (seg > 4 ? P15 : 1.f);
#pragma unroll
        for (int i = 0; i < 4; ++i) P[i + 1] = sw[(4 * seg + i) * 64] * hiF;
        const float PL = sw[31 * 64] * P15;
        if (role == 2) {
          const int j = th * 16 + tl;
          float bs = 0.f;
#pragma unroll
          for (int q = 0; q < 16; ++q) {
            const float kd_ = stepbuf[1 * SV + j * 64 + cq * 16 + q] * (1.f + (stepbuf[4 * SV + j * 64 + cq * 16 + q] - 1.f) * cst[6 * 64 + cq * 16 + q]);
            bs += stepbuf[2 * SV + j * 64 + cq * 16 + q] * kd_ * cst[7 * 64 + cq * 16 + q];
          }
          bs = quad_sum(bs);
          sb_def = bs;
        }
        f32x4 bb, kb, at, vv;
#pragma unroll
        for (int i = 0; i < 4; ++i) {
          const int t = 4 * seg + i;
          const float inv = __builtin_amdgcn_rcpf(P[i + 1]);
          const float nav = stepbuf[3 * SV + t * 64 + k], av = stepbuf[4 * SV + t * 64 + k];
          const float a_ = P[i] * nav;
          const float rraw = stepbuf[2 * SV + t * 64 + k];
          const float kraw = stepbuf[1 * SV + t * 64 + k] * (1.f + (av - 1.f) * cst[6 * 64 + k]);
          const float r_ = P[i + 1] * rraw;
          const float b_ = -nav * av * inv;
          const float k_ = kraw * inv;

          At[t * 72 + k] = (bf16_t)(cvt_pk_bf16(a_, 0.f) & 0xffff);
          Rt[t * 72 + k] = (bf16_t)(cvt_pk_bf16(r_, 0.f) & 0xffff);
          Bt[t * 72 + k] = (bf16_t)(cvt_pk_bf16(b_, 0.f) & 0xffff);
          Kt[t * 72 + k] = (bf16_t)(cvt_pk_bf16(k_, 0.f) & 0xffff);
          bb[i] = b_ * PL; kb[i] = k_ * PL; at[i] = a_;
          vv[i] = stepbuf[5 * SV + t * 64 + k];
        }
        *(uint2*)(Bb + k * 40 + 4 * seg) = pack4(bb);
        *(uint2*)(Kb + k * 40 + 4 * seg) = pack4(kb);
        *(uint2*)(VT + k * 40 + 4 * seg) = pack4(vv);
        *(uint2*)(AtTb + k * 40 + 4 * seg) = pack4(at);
        if (seg == 0) PLs[k] = PL;
      }
      }
      lds_barrier();
    }
    {
      const int ip = (nch - 1) * 32 + hn * 16 + fr, tp = d ? T - 1 - ip : ip;
      *(uint2*)(yout + (size_t)(r0seq + tp) * 512 + h * 64 + mt * 16 + fq * 4) = y_def;
    }
  }
  if (item >= 128) {
    const int nb = gridDim.x - 128;
    for (int tile = item - 128; tile < NTOK / 32; tile += nb) pool_tile(z, P_RH, tile, tid);
  }
}

__device__ __forceinline__ void post_phase(PREF p, char* smem, const int wid_u) {
  bf16_t* Ag = (bf16_t*)smem;
  bf16_t* vt = (bf16_t*)(smem + 12800);
  float* ys = (float*)(smem + 12800 + 33280);
  const bf16_t* z = P_RU;
  const bf16_t* yf = P_RY;
  const bf16_t* ybk = P_RY + (size_t)NTOK * 512;
  bf16_t* mo = P_RH;
  const int tid = opaque_tid(), w = tid >> 6, lane = tid & 63, fr = lane & 15, fq = lane >> 4;
  bf16x8 Bg[4][6];
#pragma unroll
  for (int nt = 0; nt < 4; ++nt)
#pragma unroll
    for (int ks = 0; ks < 6; ++ks) {
      float o[8];
#pragma unroll
      for (int q = 0; q < 8; ++q) { const int k = ks * 32 + fq * 8 + q; o[q] = k < 160 ? p.g2[(size_t)k * 512 + w * 64 + nt * 16 + fr] : 0.f; }
      uint4 u = pack8(o);
      Bg[nt][ks] = *reinterpret_cast<bf16x8*>(&u);
    }
  float lng[4], lnb[4];
#pragma unroll
  for (int nt = 0; nt < 4; ++nt) { lng[nt] = p.lnx_g[w * 64 + nt * 16 + fr]; lnb[nt] = p.lnx_b[w * 64 + nt * 16 + fr]; }

  for (int tile = blockIdx.x; tile < NTOK / 32; tile += gridDim.x) {
    const int row0 = tile * 32;
    int s, t0, T;
    row_seq(row0, s, t0, T);
    for (int idx = tid; idx < 32 * 24; idx += NTHR) {
      const int tok = idx / 24, oc = idx % 24;
      float o[8];
      if (oc < 20) {
        load_shift8(z, row0 + tok, t0 + tok, T, 2304 + oc * 8, p.shift_mu, o);
#pragma unroll
        for (int q = 0; q < 8; ++q) o[q] = sigmoidf_(o[q]);
      } else {
#pragma unroll
        for (int q = 0; q < 8; ++q) o[q] = 0.f;
      }
      *(uint4*)(Ag + tok * 200 + oc * 8) = pack8(o);
    }
#pragma unroll 1
    for (int half_ = 0; half_ < 2; ++half_) {
      uint4 zc[2], zp[2], zn[2], ya[2], yb4[2];
#pragma unroll
      for (int i = 0; i < 2; ++i) {
        const int idx = tid + (half_ * 2 + i) * NTHR, tok = idx >> 6, oc = idx & 63, row = row0 + tok, t = t0 + tok;
        const bf16_t* pz = z + (size_t)row * ZLD + 1536 + oc * 8;
        zc[i] = *(const uint4*)pz;
        zp[i] = make_uint4(0, 0, 0, 0); zn[i] = zp[i];
        if (t > 0) zp[i] = *(const uint4*)(pz - ZLD);
        if (t < T - 1) zn[i] = *(const uint4*)(pz + ZLD);
        ya[i] = *(const uint4*)(yf + (size_t)row * 512 + oc * 8);
        yb4[i] = *(const uint4*)(ybk + (size_t)row * 512 + oc * 8);
      }
#pragma unroll
      for (int i = 0; i < 2; ++i) {
        const int idx = tid + (half_ * 2 + i) * NTHR, tok = idx >> 6, oc = idx & 63;
        float c[8], pv[8], nx[8], o[8];
        unpack8(zc[i], c); unpack8(zp[i], pv); unpack8(zn[i], nx);
#pragma unroll
        for (int q = 0; q < 8; ++q) o[q] = c[q] + (0.5f * (pv[q] + nx[q]) - c[q]) * p.shift_mu[1536 - 512 + oc * 8 + q];
        *(uint4*)(vt + tok * 520 + oc * 8) = pack8(o);
        float a[8], b[8];
        unpack8(ya[i], a); unpack8(yb4[i], b);
        *(f32x4*)(ys + tok * 516 + oc * 8) = (f32x4){a[0] + b[0], a[1] + b[1], a[2] + b[2], a[3] + b[3]};
        *(f32x4*)(ys + tok * 516 + oc * 8 + 4) = (f32x4){a[4] + b[4], a[5] + b[5], a[6] + b[6], a[7] + b[7]};
      }
    }
    __syncthreads();
    f32x4 acc[2][4] = {};
#pragma unroll
    for (int ks = 0; ks < 6; ++ks) {
      bf16x8 a[2];
#pragma unroll
      for (int mt = 0; mt < 2; ++mt) a[mt] = *reinterpret_cast<const bf16x8*>(Ag + (mt * 16 + fr) * 200 + ks * 32 + fq * 8);
#pragma unroll
      for (int mt = 0; mt < 2; ++mt)
#pragma unroll
        for (int nt = 0; nt < 4; ++nt) acc[mt][nt] = __builtin_amdgcn_mfma_f32_16x16x32_bf16(a[mt], Bg[nt][ks], acc[mt][nt], 0, 0, 0);
    }
#pragma unroll
    for (int mt = 0; mt < 2; ++mt)
#pragma unroll
      for (int jj = 0; jj < 4; ++jj) {
        const int tok = mt * 16 + fq * 4 + jj, row = row0 + tok;
        float yv[4], sm_ = 0.f;
#pragma unroll
        for (int nt = 0; nt < 4; ++nt) { yv[nt] = ys[tok * 516 + w * 64 + nt * 16 + fr]; sm_ += yv[nt]; }
        const float mean = row16_sum(sm_) * (1.f / 64.f);
        float vs = 0.f;
#pragma unroll
        for (int nt = 0; nt < 4; ++nt) { yv[nt] -= mean; vs += yv[nt] * yv[nt]; }
        const float rs = rsqrtf(row16_sum(vs) * (1.f / 64.f) + 64e-5f);
        const float2 sb2 = *(const float2*)(P_SBON + ((size_t)row * 8 + w) * 2);
        const float sbs = sb2.x + sb2.y;
#pragma unroll
        for (int nt = 0; nt < 4; ++nt) {
          const float vv = bf2f(vt[tok * 520 + w * 64 + nt * 16 + fr]);
          const float o = (yv[nt] * rs * lng[nt] + lnb[nt] + sbs * vv) * acc[mt][nt][jj];
          mo[(size_t)row * D + 512 + w * 64 + nt * 16 + fr] = (bf16_t)(cvt_pk_bf16(o, 0.f) & 0xffff);
        }
      }
    __syncthreads();
  }
}

#define XB_TMO      128
#define XB_XCNT(j)  (256  + 64 * (j))
#define XB_XSUB(j)  (1280 + 64 * (j))
#define XB_XGEN(j)  (2304 + 64 * (j))
#define XB_TOP      3328
#define XB_TOPGEN   3392
#define XCD_BAR_WORDS 3456
#define XB_SPIN_CAP (1u << 22)
__device__ __forceinline__ unsigned xb_ld(unsigned* p)              { return __hip_atomic_load(p, __ATOMIC_RELAXED, __HIP_MEMORY_SCOPE_AGENT); }
__device__ __forceinline__ unsigned xb_add(unsigned* p, unsigned v) { return __hip_atomic_fetch_add(p, v, __ATOMIC_RELAXED, __HIP_MEMORY_SCOPE_AGENT); }
__device__ __forceinline__ unsigned xb_xcc_id() { return (unsigned)__builtin_amdgcn_s_getreg((3 << 11) | 20) & 0xFu; }
#define XB_SPIN(cond, bar) do { unsigned _sp = 0; while (cond) { __builtin_amdgcn_s_sleep(1); \
    if ((++_sp & 255u) == 0u) { if (xb_ld(&(bar)[XB_TMO])) break; if (_sp > XB_SPIN_CAP) { atomicAdd(&(bar)[XB_TMO], 1u); break; } } } } while (0)
struct XcdBarrier { unsigned* bar; unsigned x; volatile LAS unsigned* st; };
__device__ __forceinline__ void xcd_barrier_complete(unsigned* bar, unsigned x, unsigned& nloc, unsigned& nx) {
  const unsigned G = gridDim.x * gridDim.y * gridDim.z;
  unsigned sum, cnt, mine, sp = 0u;
  for (;;) {
    sum = 0u; cnt = 0u; mine = 0u;
#pragma unroll
    for (unsigned j = 0; j < 16; ++j) { const unsigned c = xb_ld(&bar[XB_XCNT(j)]); sum += c; cnt += (c > 0u) ? 1u : 0u; mine = (j == x) ? c : mine; }
    if (sum == G) break;
    __builtin_amdgcn_s_sleep(1);
    if ((++sp & 255u) == 0u) { if (xb_ld(&bar[XB_TMO])) break; if (sp > XB_SPIN_CAP) { atomicAdd(&bar[XB_TMO], 1u); break; } }
  }
  nloc = mine > 0u ? mine : 1u; nx = cnt > 0u ? cnt : 1u;
}
__device__ __forceinline__ void xcd_barrier(PREF p, volatile LAS unsigned* st_, const int wid_u) {
  asm volatile("s_waitcnt vmcnt(0)" ::: "memory");
  __syncthreads();
  if (opaque_tid() == 0) {
    XcdBarrier b; b.bar = (unsigned*)(p.ws + OFF_BAR); b.x = xb_xcc_id(); b.st = st_;
    unsigned* bar = b.bar;
    __builtin_amdgcn_s_waitcnt(0);
    unsigned nloc = b.st[0], nx = b.st[1];
    if (nloc == 0u) { xcd_barrier_complete(bar, b.x, nloc, nx); b.st[0] = nloc; b.st[1] = nx; }
    const unsigned old = xb_add(&bar[XB_XSUB(b.x)], 1u);
    const unsigned gen = old / nloc;
    if (old + 1u == (gen + 1u) * nloc) {
      __builtin_amdgcn_fence(__ATOMIC_RELEASE, "agent");
      asm volatile("s_waitcnt vmcnt(0)" ::: "memory");
      const unsigned og = xb_add(&bar[XB_TOP], 1u);
      const unsigned tg = og / nx;
      if (og + 1u == (tg + 1u) * nx) xb_add(&bar[XB_TOPGEN], 1u);
      else XB_SPIN(xb_ld(&bar[XB_TOPGEN]) == tg, bar);
      __builtin_amdgcn_fence(__ATOMIC_ACQUIRE, "agent");
      xb_add(&bar[XB_XGEN(b.x)], 1u);
      asm volatile("s_waitcnt vmcnt(0)" ::: "memory");
    } else {
      XB_SPIN(xb_ld(&bar[XB_XGEN(b.x)]) == gen, bar);
      __builtin_amdgcn_fence(__ATOMIC_ACQUIRE, "agent");
      asm volatile("s_waitcnt vmcnt(0)" ::: "memory");
    }
  }
  __syncthreads();
}

constexpr int NPHASE = 14;
__device__ __forceinline__ void do_phase(PREF p, int ph, char* smem, const int wid_u) {
  if (ph == 0) prep_phase(p, smem, wid_u);
  else if (ph == 1) row_phase<0>(p.x_prompt, p.x_sample, nullptr, nullptr, P_RH, P_MOD, nullptr, p.n1_pre, 0, 0.f, 0, wid_u);
  else if (ph == 4 || ph == 10) {
    const bool f = ph == 4;
    float* outp = p.out;
    row_phase<1>(sel(f, p.x_prompt, (const float*)outp), sel(f, p.x_sample, (const float*)(outp + (size_t)NPROMPT * D)), outp, P_RY, P_RH, P_MOD,
                 sel(f, p.n1_post, p.nm_post), sel(f, p.nm_pre, p.n2_pre), f ? 2 : 5, f ? 0.5f : 1.0f, f ? 3 : 6, wid_u, !f);
  }
  else if (ph == 13) row_phase<2>(p.out, p.out + (size_t)NPROMPT * D, p.out, P_RY, nullptr, P_MOD, p.n2_post, nullptr, 8, 0.5f, 0, wid_u, true);
  else if (ph == 6) lora_prep_phase(p, wid_u);
  else if (ph == 7) scan_phase(p, smem, wid_u);
  else if (ph == 8) post_phase(p, smem, wid_u);
  else {
    const bf16_t *A, *Bt; bf16_t* C; int N, K, ldc, epi;
    if (ph == 2 || ph == 11) { A = P_RH; Bt = sel(ph == 2, P_W13A, P_W13B); C = P_RU; N = 2 * FF; K = D; ldc = FF; epi = 1; }
    else if (ph == 3 || ph == 12) { A = P_RU; Bt = sel(ph == 3, P_W2A, P_W2B); C = P_RY; N = D; K = FF; ldc = D; epi = 0; }
    else if (ph == 5) { A = P_RH; Bt = P_WINT; C = P_RU; N = ZLD; K = D; ldc = ZLD; epi = 0; }
    else { A = P_RH; Bt = P_WOUTT; C = P_RY; N = D; K = D; ldc = D; epi = 0; }
    gemm_phase(A, Bt, C, NTOK, N, K, ldc, epi, smem, wid_u);
  }
}

extern __shared__ __attribute__((aligned(16))) char dyn_smem[];

__global__ void __launch_bounds__(NTHR, 2) mega_kernel(Params p) {
  cg::grid_group grid = cg::this_grid();
  const int wid_u = __builtin_amdgcn_readfirstlane(threadIdx.x >> 6);
  typedef const __attribute__((address_space(4))) Params* KP;
  const KP kp0 = (KP)__builtin_amdgcn_kernarg_segment_ptr();
  volatile LAS unsigned* st = (volatile LAS unsigned*)((LAS char*)dyn_smem + (SMEM_BYTES - 16));
  if (threadIdx.x < 2) st[threadIdx.x] = 0u;
  __syncthreads();
  if (threadIdx.x == 0) (void)xb_add(&((unsigned*)(kp0->ws + OFF_BAR))[XB_XCNT(xb_xcc_id())], 1u);
#define RUN_PHASE(PH) do { KP kp = kp0; asm volatile("" : "+s"(kp)); do_phase(*kp, PH, dyn_smem, wid_u); \
    if (PH == 0) grid.sync(); \
    else if (PH + 1 < NPHASE) xcd_barrier(*kp, (volatile LAS unsigned*)((LAS char*)dyn_smem + (SMEM_BYTES - 16)), wid_u); } while (0)
  RUN_PHASE(0); RUN_PHASE(1); RUN_PHASE(2); RUN_PHASE(3); RUN_PHASE(4); RUN_PHASE(5); RUN_PHASE(6);
  RUN_PHASE(7); RUN_PHASE(8); RUN_PHASE(9); RUN_PHASE(10); RUN_PHASE(11); RUN_PHASE(12); RUN_PHASE(13);
#undef RUN_PHASE
}

__global__ void __launch_bounds__(NTHR, 2) phase_kernel(Params p, int ph) {
  const int wid_u = __builtin_amdgcn_readfirstlane(threadIdx.x >> 6);
  do_phase(*(const __attribute__((address_space(4))) Params*)__builtin_amdgcn_kernarg_segment_ptr(), ph, dyn_smem, wid_u);
}

extern "C" void kernel_launch(void* const* d_in, const int* in_sizes, int n_in, void* d_out, int out_size, void* d_ws, size_t ws_size,
                              hipStream_t stream) {
  Params p{};
  const float** f = (const float**)&p;
  for (int i = 0; i < 33; ++i) f[i] = (const float*)d_in[i];
  p.out = (float*)d_out;
  p.ws = (char*)d_ws;
  if (WS_NEED > ws_size) { fprintf(stderr, "workspace too small: need %zu have %zu\n", (size_t)WS_NEED, ws_size); return; }

#if ONE_LAUNCH
  static int grid_blocks = 0;
  if (!grid_blocks) {
    int dev = 0, cus = 0, per_cu = 0;
    (void)hipGetDevice(&dev);
    (void)hipDeviceGetAttribute(&cus, hipDeviceAttributeMultiprocessorCount, dev);
    (void)hipFuncSetAttribute((const void*)mega_kernel, hipFuncAttributeMaxDynamicSharedMemorySize, SMEM_BYTES);
    (void)hipOccupancyMaxActiveBlocksPerMultiprocessor(&per_cu, mega_kernel, NTHR, SMEM_BYTES);
    if (per_cu < 1) per_cu = 1;
    grid_blocks = cus * per_cu;
  }
  (void)hipMemsetAsync(p.ws + OFF_BAR, 0, XCD_BAR_WORDS * sizeof(unsigned), stream);
  void* args[] = {&p};
  hipError_t e = hipLaunchCooperativeKernel((const void*)mega_kernel, dim3(grid_blocks), dim3(NTHR), args, SMEM_BYTES, stream);
  if (e != hipSuccess) fprintf(stderr, "cooperative launch failed: %s (grid %d)\n", hipGetErrorString(e), grid_blocks);
#else
  static bool attr = false;
  if (!attr) { (void)hipFuncSetAttribute((const void*)phase_kernel, hipFuncAttributeMaxDynamicSharedMemorySize, SMEM_BYTES); attr = true; }
  for (int ph = 0; ph < NPHASE; ++ph) phase_kernel<<<256, NTHR, SMEM_BYTES, stream>>>(p, ph);
#endif
}
```
